# Optimizing an MI355X kernel written in HIP

```python
import math
import jax
import jax.numpy as jnp
from jax import lax
import numpy as np

D_MODEL = 1024
BATCH = 8
SEQ = 8192
DEPTH = 2

GRID_W = 64
HEAD_DIM = 64
N_BRANCH = 4
BRANCH_W = 512
A_HEADS = 4
A_QK_W = A_HEADS * 2 * HEAD_DIM
A_V_W = A_HEADS * 2 * HEAD_DIM
B_PATTERNS = ((128, 1), (512, 4), (2048, 16))
B_HEADS = 8
B_QBLOCK = 64
B_W = B_HEADS * HEAD_DIM
C_HEADS = 8
C_W = C_HEADS * HEAD_DIM
NA_KH = 8
NA_KW = 16
NA_COLBLOCK = 16
NA_COLSPAN = 32
D_HEADS = 8
D_KV_HEADS = 2
D_Q_W = D_HEADS * HEAD_DIM
D_KV_W = D_KV_HEADS * HEAD_DIM
ROPE_THETA = 10000.0
Q_BLOCK = 128
D_FF = 4 * D_MODEL
GATE_W = N_BRANCH * D_MODEL
IN_W = 2 * A_QK_W + A_V_W + 3 * B_W * 3 + 3 * C_W + D_Q_W + 2 * D_KV_W + GATE_W
EPS = 1e-6
NEG_INF = -1e30
F32 = jnp.float32

kernel_name = 'hybrid_gated_multimixer_encoder'


def rms_norm(x, g):
    xf = x.astype(F32)
    y = xf * lax.rsqrt(jnp.mean(xf * xf, axis=-1, keepdims=True) + EPS)
    return (y * g.astype(F32)).astype(x.dtype)


def alibi_slopes(n):
    return jnp.asarray(np.array([2.0 ** (-8.0 * (i + 1) / n) for i in range(n)], dtype=np.float32))


def split_cols(x, sizes):
    points, acc = [], 0
    for s in sizes[:-1]:
        acc += s
        points.append(acc)
    return jnp.split(x, points, axis=-1)


def diff_attention(q, k, v, lam, subln_g, out_scale):
    B_, S, H = q.shape[:3]
    nb = S // Q_BLOCK
    slopes = alibi_slopes(H)
    pos = jnp.arange(S)
    scale = HEAD_DIM ** -0.5
    qb = q.reshape(B_, nb, Q_BLOCK, H, 2, HEAD_DIM).transpose(1, 0, 2, 3, 4, 5)

    def block(args):
        i, qi = args
        tq = i * Q_BLOCK + jnp.arange(Q_BLOCK)
        dist = jnp.abs(tq[:, None] - pos[None, :]).astype(F32)
        bias = -slopes[:, None, None] * dist[None]
        s = jnp.einsum('bqhcd,bshcd->bhcqs', qi, k, preferred_element_type=F32) * scale
        p = jax.nn.softmax(s + bias[None, :, None], axis=-1)
        a = p[:, :, 0] - lam * p[:, :, 1]
        return jnp.einsum('bhqs,bshe->bqhe', a.astype(v.dtype), v)

    o = lax.map(block, (jnp.arange(nb), qb))
    o = o.transpose(1, 0, 2, 3, 4).reshape(B_, S, H, 2 * HEAD_DIM)
    o = rms_norm(o, subln_g) * out_scale
    return o.reshape(B_, S, H * 2 * HEAD_DIM)


def dilated_pattern(q, k, v, dil, radius, slopes):
    B_, S, H, Dh = q.shape
    L = S // dil
    nb = -(-L // B_QBLOCK)
    Lp = nb * B_QBLOCK
    pad = Lp - L

    def to_sub(x):
        return x.reshape(B_, L, dil, H, Dh).transpose(0, 2, 1, 3, 4)

    qs = jnp.pad(to_sub(q), ((0, 0), (0, 0), (0, pad), (0, 0), (0, 0)))
    ks = jnp.pad(to_sub(k), ((0, 0), (0, 0), (radius, pad + radius), (0, 0), (0, 0)))
    vs = jnp.pad(to_sub(v), ((0, 0), (0, 0), (radius, pad + radius), (0, 0), (0, 0)))
    span = B_QBLOCK + 2 * radius
    kidx = jnp.arange(nb)[:, None] * B_QBLOCK + jnp.arange(span)[None, :]
    kb = ks[:, :, kidx]
    vb = vs[:, :, kidx]
    qb = qs.reshape(B_, dil, nb, B_QBLOCK, H, Dh)
    qpos = jnp.arange(Lp).reshape(nb, B_QBLOCK)
    kpos = kidx - radius
    rel = kpos[:, None, :] - qpos[:, :, None]
    valid = (jnp.abs(rel) <= radius) & (kpos[:, None, :] >= 0) & (kpos[:, None, :] < L)
    dist = (jnp.abs(rel) * dil).astype(F32)
    bias = -slopes[None, :, None, None] * dist[:, None]
    s = jnp.einsum('bjnqhd,bjnkhd->bjnhqk', qb, kb, preferred_element_type=F32) * (Dh ** -0.5) + bias
    s = jnp.where(valid[:, None], s, NEG_INF)
    m = jnp.max(s, axis=-1)
    p = jnp.exp(s - m[..., None])
    den = jnp.sum(p, axis=-1)
    o = jnp.einsum('bjnhqk,bjnkhd->bjnqhd', p.astype(v.dtype), vb, preferred_element_type=F32)
    o = o / den.transpose(0, 1, 2, 4, 3)[..., None]
    o = o.reshape(B_, dil, Lp, H, Dh)[:, :, :L].transpose(0, 2, 1, 3, 4).reshape(B_, S, H, Dh)

    def back(t):
        t = t.transpose(0, 1, 2, 4, 3).reshape(B_, dil, Lp, H)[:, :, :L]
        return t.transpose(0, 2, 1, 3).reshape(B_, S, H)

    return o, back(m), back(den)


def dilated_mixture(b_qkv):
    B_, S = b_qkv.shape[:2]
    slopes = alibi_slopes(B_HEADS)
    outs, ms, dens = [], [], []
    for g, (window, dil) in enumerate(B_PATTERNS):
        o, m, den = dilated_pattern(b_qkv[:, :, g, 0], b_qkv[:, :, g, 1], b_qkv[:, :, g, 2],
                                    dil, window // (2 * dil), slopes)
        outs.append(o)
        ms.append(m)
        dens.append(den)
    m_star = jnp.max(jnp.stack(ms), axis=0)
    ws = [d * jnp.exp(m - m_star) for d, m in zip(dens, ms)]
    num = ws[0][..., None] * outs[0]
    tot = ws[0]
    for w, o in zip(ws[1:], outs[1:]):
        num = num + w[..., None] * o
        tot = tot + w
    out = num / tot[..., None]
    return out.astype(b_qkv.dtype).reshape(B_, S, B_W)


def neighbourhood_attention(q, k, v, rpb):
    B_, S, H, Dh = q.shape
    rows = S // GRID_W
    kh = min(NA_KH, rows)
    ncb = GRID_W // NA_COLBLOCK
    K = kh * NA_COLSPAN
    qg = q.reshape(B_, rows, GRID_W, H, Dh)
    kg = k.reshape(B_, rows, GRID_W, H, Dh)
    vg = v.reshape(B_, rows, GRID_W, H, Dh)
    qcol = jnp.arange(GRID_W).reshape(ncb, NA_COLBLOCK)
    qstart = jnp.clip(qcol - NA_KW // 2, 0, GRID_W - NA_KW)
    kstart = jnp.clip(jnp.arange(ncb) * NA_COLBLOCK - NA_KW // 2, 0, GRID_W - NA_COLSPAN)
    kcol = kstart[:, None] + jnp.arange(NA_COLSPAN)[None, :]
    col_ok = (kcol[:, None, :] >= qstart[:, :, None]) & (kcol[:, None, :] < qstart[:, :, None] + NA_KW)
    mask = jnp.broadcast_to(col_ok[:, :, None, :], (ncb, NA_COLBLOCK, kh, NA_COLSPAN)).reshape(ncb, NA_COLBLOCK, K)
    col_idx = jnp.clip(kcol[:, None, :] - qcol[:, :, None] + NA_KW - 1, 0, 2 * NA_KW - 2)

    def row_fn(r):
        rs = jnp.clip(r - kh // 2, 0, rows - kh)
        kr = lax.dynamic_slice_in_dim(kg, rs, kh, axis=1)[:, :, kcol]
        vr = lax.dynamic_slice_in_dim(vg, rs, kh, axis=1)[:, :, kcol]
        kr = kr.transpose(0, 2, 1, 3, 4, 5).reshape(B_, ncb, K, H, Dh)
        vr = vr.transpose(0, 2, 1, 3, 4, 5).reshape(B_, ncb, K, H, Dh)
        qr = lax.dynamic_index_in_dim(qg, r, axis=1, keepdims=False).reshape(B_, ncb, NA_COLBLOCK, H, Dh)
        row_idx = rs + jnp.arange(kh) - r + NA_KH - 1
        bias = rpb[:, row_idx[None, None, :, None], col_idx[:, :, None, :]]
        bias = bias.reshape(H, ncb, NA_COLBLOCK, K).astype(F32)
        s = jnp.einsum('bcqhd,bckhd->bhcqk', qr, kr, preferred_element_type=F32) * (Dh ** -0.5) + bias[None]
        s = jnp.where(mask[None, None], s, NEG_INF)
        p = jax.nn.softmax(s, axis=-1)
        o = jnp.einsum('bhcqk,bckhd->bcqhd', p.astype(vr.dtype), vr)
        return o.reshape(B_, GRID_W, H, Dh)

    o = lax.map(row_fn, jnp.arange(rows))
    return o.transpose(1, 0, 2, 3, 4).reshape(B_, S, H * Dh)


def _rotate(x, pos):
    n = x.shape[-1] // 2
    inv = ROPE_THETA ** (-jnp.arange(n, dtype=F32) / n)
    ang = pos.astype(F32)[:, None] * inv[None, :]
    cos = jnp.cos(ang)[None, :, None, :]
    sin = jnp.sin(ang)[None, :, None, :]
    x1, x2 = x[..., :n], x[..., n:]
    return jnp.concatenate([x1 * cos - x2 * sin, x2 * cos + x1 * sin], axis=-1)


def axial_rope(x, row_pos, col_pos):
    xf = x.astype(F32)
    half = x.shape[-1] // 2
    out = jnp.concatenate([_rotate(xf[..., :half], row_pos), _rotate(xf[..., half:], col_pos)], axis=-1)
    return out.astype(x.dtype)


def gqa_attention(q, k, v):
    B_, S, Hq, Dh = q.shape
    Hkv = k.shape[2]
    rep = Hq // Hkv
    nb = S // Q_BLOCK
    qb = q.reshape(B_, nb, Q_BLOCK, Hkv, rep, Dh).transpose(1, 0, 2, 3, 4, 5)

    def block(qi):
        s = jnp.einsum('bqgrd,bsgd->bgrqs', qi, k, preferred_element_type=F32) * (Dh ** -0.5)
        p = jax.nn.softmax(s, axis=-1)
        return jnp.einsum('bgrqs,bsgd->bqgrd', p.astype(v.dtype), v)

    o = lax.map(block, qb)
    return o.transpose(1, 0, 2, 3, 4, 5).reshape(B_, S, Hq * Dh)


def setup_inputs(seed: int = 0) -> dict:
    key = jax.random.key(seed)
    ks = jax.random.split(key, 14)

    def nrm(k, shape, scale):
        return scale * jax.random.normal(k, shape, F32)

    return {
        'x': nrm(ks[0], (BATCH, SEQ, D_MODEL), 1.0),
        'norm_mix': 1.0 + nrm(ks[1], (DEPTH, D_MODEL), 0.05),
        'w_in': nrm(ks[2], (DEPTH, D_MODEL, IN_W), D_MODEL ** -0.5),
        'b_gate': nrm(ks[3], (DEPTH, GATE_W), 0.1),
        'diff_lambda': nrm(ks[4], (DEPTH, 4, HEAD_DIM), 0.1),
        'diff_subln': 1.0 + nrm(ks[5], (DEPTH, 2 * HEAD_DIM), 0.05),
        'na_rpb': nrm(ks[6], (DEPTH, C_HEADS, 2 * NA_KH - 1, 2 * NA_KW - 1), 0.1),
        'qk_norm': 1.0 + nrm(ks[7], (DEPTH, 2, HEAD_DIM), 0.05),
        'w_branch': nrm(ks[8], (DEPTH, N_BRANCH, BRANCH_W, D_MODEL), BRANCH_W ** -0.5),
        'w_out': nrm(ks[9], (DEPTH, D_MODEL, D_MODEL), D_MODEL ** -0.5),
        'norm_ffn': 1.0 + nrm(ks[10], (DEPTH, D_MODEL), 0.05),
        'w_ff1': nrm(ks[11], (DEPTH, D_MODEL, D_FF), D_MODEL ** -0.5),
        'w_ff2': nrm(ks[12], (DEPTH, D_FF, D_MODEL), D_FF ** -0.5),
        'norm_final': 1.0 + nrm(ks[13], (D_MODEL,), 0.05),
    }


def reference(x, norm_mix, w_in, b_gate, diff_lambda, diff_subln, na_rpb, qk_norm, w_branch, w_out,
              norm_ffn, w_ff1, w_ff2, norm_final):
    B_, S, _ = x.shape
    pos = jnp.arange(S)
    row_pos = pos // GRID_W
    col_pos = pos % GRID_W
    sizes = [A_QK_W, A_QK_W, A_V_W, len(B_PATTERNS) * 3 * B_W, C_W, C_W, C_W, D_Q_W, D_KV_W, D_KV_W, GATE_W]
    for l in range(DEPTH):
        h = rms_norm(x, norm_mix[l])
        proj = jnp.einsum('bsd,de->bse', h, w_in[l])
        a_q, a_k, a_v, b_qkv, c_q, c_k, c_v, d_q, d_k, d_v, gate = split_cols(proj, sizes)

        lamp = diff_lambda[l].astype(F32)
        lam_init = 0.8 - 0.6 * math.exp(-0.3 * l)
        lam = jnp.exp(jnp.sum(lamp[0] * lamp[1])) - jnp.exp(jnp.sum(lamp[2] * lamp[3])) + lam_init
        y_a = diff_attention(a_q.reshape(B_, S, A_HEADS, 2, HEAD_DIM), a_k.reshape(B_, S, A_HEADS, 2, HEAD_DIM),
                             a_v.reshape(B_, S, A_HEADS, 2 * HEAD_DIM), lam, diff_subln[l], 1.0 - lam_init)

        y_b = dilated_mixture(b_qkv.reshape(B_, S, len(B_PATTERNS), 3, B_HEADS, HEAD_DIM))

        y_c = neighbourhood_attention(c_q.reshape(B_, S, C_HEADS, HEAD_DIM), c_k.reshape(B_, S, C_HEADS, HEAD_DIM),
                                      c_v.reshape(B_, S, C_HEADS, HEAD_DIM), na_rpb[l])

        qd = axial_rope(rms_norm(d_q.reshape(B_, S, D_HEADS, HEAD_DIM), qk_norm[l, 0]), row_pos, col_pos)
        kd = axial_rope(rms_norm(d_k.reshape(B_, S, D_KV_HEADS, HEAD_DIM), qk_norm[l, 1]), row_pos, col_pos)
        y_d = gqa_attention(qd, kd, d_v.reshape(B_, S, D_KV_HEADS, HEAD_DIM))

        g = jax.nn.sigmoid((gate + b_gate[l]).astype(F32)).astype(x.dtype).reshape(B_, S, N_BRANCH, D_MODEL)
        branches = (y_a, y_b, y_c, y_d)
        merged = g[:, :, 0] * jnp.einsum('bsk,kd->bsd', branches[0], w_branch[l, 0])
        for n in range(1, N_BRANCH):
            merged = merged + g[:, :, n] * jnp.einsum('bsk,kd->bsd', branches[n], w_branch[l, n])
        x = x + jnp.einsum('bsd,de->bse', merged, w_out[l])

        u = jax.nn.relu(jnp.einsum('bsd,df->bsf', rms_norm(x, norm_ffn[l]), w_ff1[l]))
        x = x + jnp.einsum('bsf,fd->bsd', u * u, w_ff2[l])
    return rms_norm(x, norm_final)
```

```cpp
#include <hip/hip_runtime.h>
#include <hip/hip_cooperative_groups.h>
#include <hip/hip_bf16.h>
#include <cstdio>
#include <cstdint>
#include <cmath>
namespace cg = cooperative_groups;

constexpr int BATCH = 8, SEQ = 8192, DM = 1024, NTOK = BATCH * SEQ, INW = 12544, DFF = 4096, DEPTH = 2;
constexpr int GB = 2, TG = GB * SEQ, NGRP = BATCH / GB;
constexpr float EPS = 1e-6f;
constexpr float LOG2E = 1.4426950408889634f;
constexpr float C2 = 0.125f * LOG2E;
constexpr int COL_AQ = 0, COL_AK = 512, COL_AV = 1024, COL_B = 1536, COL_CQ = 6144, COL_CK = 6656, COL_CV = 7168, COL_DQ = 7680, COL_DK = 8192, COL_DV = 8320, COL_GATE = 8448;
constexpr size_t MiB = 1u << 20;
constexpr size_t WS_WIN = 0, WS_WBR = 49 * MiB, WS_WOUT = 57 * MiB, WS_W1 = 61 * MiB, WS_W2 = 77 * MiB, WS_STAT = 93 * MiB, WS_H = 96 * MiB, WS_ATMP = 128 * MiB,
                 WS_BTMP = 160 * MiB, WS_Y = 208 * MiB, WS_MERGED = 272 * MiB, WS_Z = 304 * MiB, WS_PROJ = 432 * MiB, WS_END = 824 * MiB;
constexpr int LDS_BYTES = 147456, TAB_OFF = 131072;

#define LAS __attribute__((address_space(3)))
typedef unsigned short bf16_t;
typedef short bf16x8 __attribute__((ext_vector_type(8)));
typedef float f32x4 __attribute__((ext_vector_type(4)));
typedef unsigned u32x4 __attribute__((ext_vector_type(4)));
typedef unsigned u32x2 __attribute__((ext_vector_type(2)));

__device__ __forceinline__ unsigned f2bf(float f) { unsigned u = __builtin_bit_cast(unsigned, f); return (u + 0x7fffu + ((u >> 16) & 1u)) >> 16; }
__device__ __forceinline__ unsigned pk2(float lo, float hi) { return f2bf(lo) | (f2bf(hi) << 16); }
__device__ __forceinline__ float bflo(unsigned w) { return __uint_as_float(w << 16); }
__device__ __forceinline__ float bfhi(unsigned w) { return __uint_as_float(w & 0xffff0000u); }
__device__ __forceinline__ float wave_sum(float v) {
#pragma unroll
    for (int o = 1; o < 64; o <<= 1) v += __shfl_xor(v, o);
    return v;
}

namespace pg8 {
constexpr int BM = 256, BK = 64, HALF = 128, HTB = HALF * BK * 2, STAGE_BYTES = 8 * HTB, NXCD = 8, WGM = 8;
__host__ __device__ __forceinline__ int lds_byte(int r, int c) { const int st = (r >> 4) * 2 + (c >> 5), rr = r & 15, cc = c & 31, ob = rr * 64 + cc * 2; return st * 1024 + (ob ^ (((ob >> 9) & 1) << 5)); }
__host__ __device__ __forceinline__ void stage_rc(int b, int& R, int& C) { const int st = b / 1024, sb = b % 1024, swz = sb ^ (((sb >> 9) & 1) << 5); R = (st >> 1) * 16 + swz / 64; C = (st & 1) * 32 + (swz % 64) / 2; }
__host__ __device__ __forceinline__ int perm32(int rho) { const int n = rho >> 4, i = rho & 15; return 8 * (i >> 2) + 4 * n + (i & 3); }

struct Unit { int pm, pn; };
struct Gemm { const bf16_t* A; const bf16_t* Bt; int lda, ldb, K, adiv, astride; };

struct StaticOrder {
    int nM, nN, nwg, G, c;
    __device__ void init(int M, int N, int G_, int c_) { nM = M / BM; nN = N / BM; nwg = nM * nN; G = G_; c = c_; }
    __device__ bool next(int i, Unit& u) const {
        const long L = (long)i * G + c; if (L >= nwg) return false;
        int wgid = (int)L; { const int q = nwg / NXCD, r = nwg % NXCD, xcd = wgid % NXCD, off = wgid / NXCD; wgid = (xcd < r ? xcd * (q + 1) : r * (q + 1) + (xcd - r) * q) + off; }
        const int nig = WGM * nN, gid = wgid / nig, fm = gid * WGM, gsz = (nM - fm) < WGM ? (nM - fm) : WGM;
        u.pm = fm + ((wgid % nig) % gsz); u.pn = (wgid % nig) / gsz; return true;
    }
};

__device__ __forceinline__ unsigned cvt_pk_bf16(float lo, float hi) { unsigned r; asm volatile("v_cvt_pk_bf16_f32 %0, %1, %2" : "=v"(r) : "v"(lo), "v"(hi)); return r; }

template <int MODE> struct Epi {
    bf16_t* O; float* Of; const float* base; const float* bias; int ldc;
    __device__ __forceinline__ void operator()(const f32x4 (&acc)[2][2][4][2], const Unit& u, int wr, int wc, int fr, int fq) const {
        const int row0 = u.pm * BM + wr * 64 + fr, col0 = u.pn * BM + wc * 32 + 8 * fq;
        int kind = 0; float sc = 1.f;
        if (MODE == 0) { const int pn = u.pn; if (pn >= 33) kind = 2; else if (pn < 2 || pn == 6 || pn == 7 || pn == 12 || pn == 13 || pn == 18 || pn == 19 || pn == 24 || pn == 25) sc = C2; }
#pragma unroll
        for (int ai = 0; ai < 2; ++ai)
#pragma unroll
            for (int m = 0; m < 4; ++m) { const size_t roff = (size_t)(row0 + ai * HALF + m * 16) * ldc;
#pragma unroll
                for (int bj = 0; bj < 2; ++bj) { const int col = col0 + bj * HALF; f32x4 v0 = acc[ai][bj][m][0], v1 = acc[ai][bj][m][1];
                    if (MODE == 3) {
                        const f32x4 b0 = *(const f32x4*)(base + roff + col), b1 = *(const f32x4*)(base + roff + col + 4);
                        *(f32x4*)(Of + roff + col) = b0 + v0; *(f32x4*)(Of + roff + col + 4) = b1 + v1;
                    } else {
                        if (MODE == 0) {
                            if (kind == 2) { const f32x4 g0 = *(const f32x4*)(bias + col - COL_GATE), g1 = *(const f32x4*)(bias + col - COL_GATE + 4);
#pragma unroll
                                for (int e = 0; e < 4; ++e) { v0[e] = 1.f / (1.f + __expf(-(v0[e] + g0[e]))); v1[e] = 1.f / (1.f + __expf(-(v1[e] + g1[e]))); } }
                            else { v0 = v0 * sc; v1 = v1 * sc; }
                        }
                        if (MODE == 2) {
#pragma unroll
                            for (int e = 0; e < 4; ++e) { const float a = fmaxf(v0[e], 0.f), b = fmaxf(v1[e], 0.f); v0[e] = a * a; v1[e] = b * b; } }
                        u32x4 w; w.x = cvt_pk_bf16(v0[0], v0[1]); w.y = cvt_pk_bf16(v0[2], v0[3]); w.z = cvt_pk_bf16(v1[0], v1[1]); w.w = cvt_pk_bf16(v1[2], v1[3]);
                        *(u32x4*)(O + roff + col) = w;
                    } } }
    }
};

template <class EpiT>
__device__ __forceinline__ void gemm_phase(LAS unsigned char* lds, const Gemm g, const StaticOrder& S, const EpiT& E) {
    int tid_ = threadIdx.x; asm volatile("" : "+v"(tid_));
    const int tid = tid_, wid = __builtin_amdgcn_readfirstlane(tid >> 6), lane = tid & 63, wr = wid >> 2, wc = wid & 3, fr = lane & 15, fq = lane >> 4;
    const int K = g.K, nt = K / BK;
    unsigned voffA[2], voffB[2];
#pragma unroll
    for (int i = 0; i < 2; ++i) { int R, C; stage_rc(tid * 16 + i * 8192, R, C); const int Rb = (R & ~31) + perm32(R & 31);
        voffA[i] = (unsigned)(R * g.lda + C) * 2u; voffB[i] = (unsigned)(Rb * g.ldb + C) * 2u; }
    const size_t kstep = (size_t)(BK * 2);
    const size_t hA = (size_t)HALF * g.lda * 2, hB = (size_t)HALF * g.ldb * 2;
    const size_t tA = 2 * hA, tB = 2 * hB;
    const unsigned ldsw = (unsigned)wid * 1024u;
    const int aoff = lds_byte(wr * 64 + fr, fq * 8), boff = lds_byte(wc * 32 + fr, fq * 8);
#define PG8_SA(b, h) (((b) * 2 + (h)) * HTB)
#define PG8_SB(b, h) ((4 + (b) * 2 + (h)) * HTB)
#define PG8_STAGE(bufoff, gbase, voff) do { _Pragma("unroll") for (int _i = 0; _i < 2; ++_i) \
        __builtin_amdgcn_global_load_lds((const unsigned*)((const char*)(gbase) + (voff)[_i]), (LAS unsigned*)(lds + (bufoff) + ldsw + _i * 8192), 16, 0, 0); } while (0)
#define PG8_LDA(dst, b, h) do { _Pragma("unroll") for (int m = 0; m < 4; ++m) _Pragma("unroll") for (int k = 0; k < 2; ++k) dst[m][k] = *(const LAS bf16x8*)(lds + PG8_SA(b, h) + aoff + m * 2048 + k * 1024); } while (0)
#define PG8_LDB(dst, b, h) do { _Pragma("unroll") for (int n = 0; n < 2; ++n) _Pragma("unroll") for (int k = 0; k < 2; ++k) dst[n][k] = *(const LAS bf16x8*)(lds + PG8_SB(b, h) + boff + n * 2048 + k * 1024); } while (0)
#define PG8_MMA(ai, bj, At, Bt) do { __builtin_amdgcn_s_setprio(1); _Pragma("unroll") for (int m = 0; m < 4; ++m) _Pragma("unroll") for (int n = 0; n < 2; ++n) _Pragma("unroll") for (int k = 0; k < 2; ++k) \
        acc[ai][bj][m][n] = __builtin_amdgcn_mfma_f32_16x16x32_bf16(Bt[n][k], At[m][k], acc[ai][bj][m][n], 0, 0, 0); __builtin_amdgcn_s_setprio(0); } while (0)
#define PG8_WAIT_V(n) asm volatile("s_waitcnt vmcnt(" #n ")" ::: "memory")
#define PG8_WAIT_L(n) asm volatile("s_waitcnt lgkmcnt(" #n ")" ::: "memory")
#define PG8_BAR __builtin_amdgcn_s_barrier()
#define PG8_SCHED __builtin_amdgcn_sched_barrier(0)
#define PG8_PA(u) ((const char*)g.A + (size_t)(u).pm * tA + (size_t)((u).pn / g.adiv) * (size_t)g.astride * 2)
#define PG8_PB(u) ((const char*)g.Bt + (size_t)(u).pn * tB)
    Unit cur, nxt; int ui = 0;
    if (!S.next(0, cur)) return;
    f32x4 acc[2][2][4][2];
#pragma unroll
    for (int a = 0; a < 2; ++a)
#pragma unroll
        for (int b = 0; b < 2; ++b)
#pragma unroll
            for (int m = 0; m < 4; ++m)
#pragma unroll
                for (int n = 0; n < 2; ++n) acc[a][b][m][n] = (f32x4){0.f, 0.f, 0.f, 0.f};
    bf16x8 At[4][2], B0[2][2], B1[2][2];
    const char* cA = PG8_PA(cur); const char* cB = PG8_PB(cur);
    PG8_STAGE(PG8_SB(0, 0), cB, voffB); PG8_STAGE(PG8_SB(0, 1), cB + hB, voffB); PG8_STAGE(PG8_SA(0, 0), cA, voffA); PG8_STAGE(PG8_SA(0, 1), cA + hA, voffA);
    if (wr == 1) PG8_BAR;
    PG8_WAIT_V(2); PG8_BAR;
    PG8_STAGE(PG8_SB(1, 0), cB + kstep, voffB); PG8_STAGE(PG8_SA(1, 0), cA + kstep, voffA); PG8_STAGE(PG8_SB(1, 1), cB + hB + kstep, voffB);
    PG8_WAIT_V(6); PG8_BAR;
    for (;;) {
        const bool has_next = S.next(ui + 1, nxt);
        const char* nA = has_next ? PG8_PA(nxt) : cA; const char* nB = has_next ? PG8_PB(nxt) : cB;
        for (int t = 0; t < nt; t += 2) {
            const bool last = (t == nt - 2);
            const char* a1 = cA + (size_t)(t + 1) * kstep;
            const char* a2 = last ? nA : cA + (size_t)(t + 2) * kstep; const char* b2 = last ? nB : cB + (size_t)(t + 2) * kstep;
            const char* a3 = a2 + kstep; const char* b3 = b2 + kstep;
            PG8_LDB(B0, 0, 0); PG8_LDB(B1, 0, 1); PG8_SCHED; PG8_LDA(At, 0, 0); PG8_STAGE(PG8_SA(1, 1), a1 + hA, voffA);
            PG8_WAIT_V(8); PG8_WAIT_L(0); PG8_BAR; PG8_MMA(0, 0, At, B0); PG8_MMA(0, 1, At, B1); PG8_BAR; PG8_SCHED;
            PG8_LDA(At, 0, 1); PG8_STAGE(PG8_SB(0, 0), b2, voffB); PG8_STAGE(PG8_SB(0, 1), b2 + hB, voffB); PG8_STAGE(PG8_SA(0, 0), a2, voffA);
            PG8_WAIT_V(8); PG8_WAIT_L(0); PG8_BAR; PG8_MMA(1, 0, At, B0); PG8_MMA(1, 1, At, B1); PG8_BAR; PG8_SCHED;
            PG8_LDB(B0, 1, 0); PG8_LDB(B1, 1, 1); PG8_SCHED; PG8_LDA(At, 1, 0); PG8_STAGE(PG8_SA(0, 1), a2 + hA, voffA);
            PG8_WAIT_V(8); PG8_WAIT_L(0); PG8_BAR; PG8_MMA(0, 0, At, B0); PG8_MMA(0, 1, At, B1); PG8_BAR; PG8_SCHED;
            PG8_LDA(At, 1, 1); PG8_STAGE(PG8_SB(1, 0), b3, voffB); PG8_STAGE(PG8_SB(1, 1), b3 + hB, voffB); PG8_STAGE(PG8_SA(1, 0), a3, voffA);
            PG8_WAIT_V(8); PG8_WAIT_L(0); PG8_BAR; PG8_MMA(1, 0, At, B0); PG8_MMA(1, 1, At, B1); PG8_BAR; PG8_SCHED;
        }
        if (wr == 0) PG8_BAR;
        E(acc, cur, wr, wc, fr, fq);
        if (!has_next) break;
#pragma unroll
        for (int a = 0; a < 2; ++a)
#pragma unroll
            for (int b = 0; b < 2; ++b)
#pragma unroll
                for (int m = 0; m < 4; ++m)
#pragma unroll
                    for (int n = 0; n < 2; ++n) acc[a][b][m][n] = (f32x4){0.f, 0.f, 0.f, 0.f};
        cur = nxt; cA = nA; cB = nB; ++ui;
        if (wr == 1) PG8_BAR;
    }
    PG8_WAIT_V(0);
    PG8_BAR;
#undef PG8_SA
#undef PG8_SB
#undef PG8_STAGE
#undef PG8_LDA
#undef PG8_LDB
#undef PG8_MMA
#undef PG8_WAIT_V
#undef PG8_WAIT_L
#undef PG8_BAR
#undef PG8_SCHED
#undef PG8_PA
#undef PG8_PB
}
}

namespace attn_body {
using bf16 = __hip_bfloat16;
using s16x4 = __attribute__((ext_vector_type(4))) short;
using f32x16 = __attribute__((ext_vector_type(16))) float;
constexpr int NW = 8, QBLK = 32, QB = QBLK * NW, KVBLK = 64;
constexpr int MA = 0, MB = 1, MC = 2, MD = 3;
__device__ __forceinline__ int crow(int r, int hi) { return (r & 3) + 8 * (r >> 2) + 4 * hi; }
#define SBAR() __builtin_amdgcn_sched_barrier(0)
constexpr int NSLOT = 3, SLOTB = 8192;
constexpr int LDS_K = 0, LDS_V = NSLOT * SLOTB, LDS_WS = 2 * NSLOT * SLOTB, LDS_OST = LDS_WS + NW * 64 * 4, LDS_ATT = LDS_OST + NW * 4096;
typedef __attribute__((address_space(3))) const char* lds_cptr;
typedef __attribute__((address_space(3))) const float* lds_fptr;

struct AttnArgs {
    const bf16* Q; const bf16* K; const bf16* V; bf16* O;
    int qs, ks, os;
    int NT, tlo, thi;
    float s2;
    int q0;
    int kb;
    float* stat; int ss;
    lds_fptr tab;
};

__device__ __forceinline__ void glds16(const void* gsrc, unsigned lds_dst) { unsigned keep;
  asm volatile("s_mov_b32 %0, m0\n\ts_mov_b32 m0, %2\n\ts_nop 0\n\tglobal_load_lds_dwordx4 %1, off\n\ts_mov_b32 m0, %0" : "=&s"(keep) : "v"(gsrc), "s"(lds_dst) : "memory"); }
__device__ __forceinline__ float max3f(float a, float b, float c) { float r; asm("v_max3_f32 %0, %1, %2, %3" : "=v"(r) : "v"(a), "v"(b), "v"(c)); return r; }
__device__ __forceinline__ float max2f(float a, float b) { float r; asm("v_max_f32_e32 %0, %1, %2" : "=v"(r) : "v"(a), "v"(b)); return r; }
__device__ __forceinline__ float fadd_s(float a, float b) { float r; asm("v_add_f32_e32 %0, %1, %2" : "=v"(r) : "v"(a), "v"(b)); return r; }
__device__ __forceinline__ float fsub_s(float a, float b) { float r; asm("v_sub_f32_e32 %0, %1, %2" : "=v"(r) : "v"(a), "v"(b)); return r; }
typedef float f32x2_t __attribute__((ext_vector_type(2))); typedef __bf16 bf16x2_t __attribute__((ext_vector_type(2)));
__device__ __forceinline__ unsigned cvtpk_s(float lo, float hi) { f32x2_t v = {lo, hi}; bf16x2_t b = __builtin_convertvector(v, bf16x2_t); return __builtin_bit_cast(unsigned, b); }
#define WAIT_BAR(N) asm volatile("s_waitcnt vmcnt(" #N ") lgkmcnt(0)\n\ts_barrier" ::: "memory")

__device__ __forceinline__ void qkt(f32x16& p0, f32x16& p1, const char* Kslot, const bf16x8* qr, const f32x16& negm, int r32, int hi) {
  const char* kb = Kslot + hi * 1024 + r32 * 16;
  #pragma unroll
  for (int d0 = 0; d0 < 4; ++d0) {
    const bf16x8 b0 = *reinterpret_cast<const bf16x8*>(kb + d0 * 2048);
    const bf16x8 b1 = *reinterpret_cast<const bf16x8*>(kb + d0 * 2048 + 512);
    if (d0 == 0) { p0 = __builtin_amdgcn_mfma_f32_32x32x16_bf16(b0, qr[0], negm, 0, 0, 0); p1 = __builtin_amdgcn_mfma_f32_32x32x16_bf16(b1, qr[0], negm, 0, 0, 0); }
    else { p0 = __builtin_amdgcn_mfma_f32_32x32x16_bf16(b0, qr[d0], p0, 0, 0, 0); p1 = __builtin_amdgcn_mfma_f32_32x32x16_bf16(b1, qr[d0], p1, 0, 0, 0); } }
}
typedef short v4i16_t __attribute__((ext_vector_type(4)));
__device__ __forceinline__ void kload8(bf16x8* kf, lds_cptr kp) {
  kf[0] = *(const LAS bf16x8*)(kp);        kf[1] = *(const LAS bf16x8*)(kp + 512);
  kf[2] = *(const LAS bf16x8*)(kp + 2048); kf[3] = *(const LAS bf16x8*)(kp + 2560);
  kf[4] = *(const LAS bf16x8*)(kp + 4096); kf[5] = *(const LAS bf16x8*)(kp + 4608);
  kf[6] = *(const LAS bf16x8*)(kp + 6144); kf[7] = *(const LAS bf16x8*)(kp + 6656);
}
__device__ __forceinline__ void kload2(bf16x8* kf, lds_cptr kp, int j) { kf[2 * j] = *(const LAS bf16x8*)(kp + j * 2048); kf[2 * j + 1] = *(const LAS bf16x8*)(kp + j * 2048 + 512); }
__device__ __forceinline__ s16x4 vtr(lds_cptr p) { return __builtin_bit_cast(s16x4, __builtin_amdgcn_ds_read_tr16_b64_v4i16((LAS v4i16_t*)p)); }
__device__ __forceinline__ float rowmax(const f32x16& p0, const f32x16& p1) {
  float a = max3f(p0[0], p0[1], p1[0]), b = max3f(p0[2], p0[3], p1[1]); a = max3f(a, p1[2], p1[3]);
  #pragma unroll
  for (int r = 4; r < 16; r += 4) { a = max3f(a, p0[r], p0[r + 1]); b = max3f(b, p0[r + 2], p0[r + 3]); a = max3f(a, p1[r], p1[r + 1]); b = max3f(b, p1[r + 2], p1[r + 3]); }
  const float m = max2f(a, b);
  auto rr = __builtin_amdgcn_permlane32_swap(__float_as_uint(m), __float_as_uint(m), false, false);
  return max2f(__uint_as_float(rr[0]), __uint_as_float(rr[1]));
}
__device__ __forceinline__ void pv(f32x16* o, int vb, bf16x8 pa0, bf16x8 pa1, bf16x8 pa2, bf16x8 pa3) {
  #pragma unroll
  for (int d0 = 0; d0 < 2; ++d0) { s16x4 lo[4], hi[4];
    #pragma unroll
    for (int ks = 0; ks < 4; ++ks) {
      asm volatile("ds_read_b64_tr_b16 %0,%1 offset:%c2" : "=&v"(lo[ks]) : "v"(vb), "i"(d0 * 4096 + ks * 1024) : "memory");
      asm volatile("ds_read_b64_tr_b16 %0,%1 offset:%c2" : "=&v"(hi[ks]) : "v"(vb), "i"(d0 * 4096 + ks * 1024 + 512) : "memory"); }
    asm volatile("s_waitcnt lgkmcnt(0)" ::: "memory"); SBAR();
    #define PK(k) (bf16x8){lo[k][0], lo[k][1], lo[k][2], lo[k][3], hi[k][0], hi[k][1], hi[k][2], hi[k][3]}
    o[d0] = __builtin_amdgcn_mfma_f32_32x32x16_bf16(pa0, PK(0), o[d0], 0, 0, 0);
    o[d0] = __builtin_amdgcn_mfma_f32_32x32x16_bf16(pa1, PK(1), o[d0], 0, 0, 0);
    o[d0] = __builtin_amdgcn_mfma_f32_32x32x16_bf16(pa2, PK(2), o[d0], 0, 0, 0);
    o[d0] = __builtin_amdgcn_mfma_f32_32x32x16_bf16(pa3, PK(3), o[d0], 0, 0, 0);
    #undef PK
  }
}

template <int MODE> __device__ __forceinline__ void score_hook(f32x16& c0, f32x16& c1, int t, const AttnArgs& a, int qrel, int hi, int wid, int r32, float mh) {
  if constexpr (MODE == MA) {
    const float dq = (float)(a.q0 + qrel - 64 * t - 4 * hi), ns = -a.s2;
    #pragma unroll
    for (int r = 0; r < 16; ++r) { const float kf = (float)((r & 3) + 8 * (r >> 2)); c0[r] = fmaf(ns, fabsf(dq - kf), c0[r]); c1[r] = fmaf(ns, fabsf(dq - (kf + 32.f)), c1[r]); }
  }
  if constexpr (MODE == MB) {
    const bool tv = (t >= a.tlo) && (t <= a.thi);
    const float dq = (float)(qrel + 64 - 64 * t - 4 * hi), ns = -a.s2;
    #pragma unroll
    for (int r = 0; r < 16; ++r) { const float kf = (float)((r & 3) + 8 * (r >> 2)); const float d0 = fabsf(dq - kf), d1 = fabsf(dq - (kf + 32.f));
      c0[r] = (tv && d0 <= 64.f) ? fmaf(ns, d0, c0[r] - mh) : -INFINITY; c1[r] = (tv && d1 <= 64.f) ? fmaf(ns, d1, c1[r] - mh) : -INFINITY;
      if ((r & 3) == 3) __builtin_amdgcn_sched_barrier(0); }
  }
  if constexpr (MODE == MC) {
    const int qrow = a.q0 + (wid >> 1), rs = min(max(qrow - 4, 0), 120), krow = a.kb + t;
    if (krow < rs || krow >= rs + 8) {
      #pragma unroll
      for (int r = 0; r < 16; ++r) { c0[r] = -INFINITY; c1[r] = -INFINITY; }
    } else {
      const int qc = (wid & 1) * 32 + r32, cs = min(max(qc - 8, 0), 48);
      const lds_fptr tp = a.tab + (krow - qrow + 7) * 31 + (15 - qc + 4 * hi);
      const int kd = 4 * hi - cs;
      #pragma unroll
      for (int r = 0; r < 16; ++r) { const int kc = (r & 3) + 8 * (r >> 2);
        const float b0 = tp[kc], b1 = tp[kc + 32];
        c0[r] = ((unsigned)(kd + kc) < 16u) ? c0[r] + (b0 - mh) : -INFINITY; c1[r] = ((unsigned)(kd + kc + 32) < 16u) ? c1[r] + (b1 - mh) : -INFINITY;
        if ((r & 3) == 3) __builtin_amdgcn_sched_barrier(0); }
    }
  }
}

template <int MODE, int THRL> __device__ __forceinline__ void attn_unit(const AttnArgs& A_, char* shm) {
  int tid_ = threadIdx.x; asm volatile("" : "+v"(tid_));
  const int tid = tid_, lane = tid & 63, r32 = lane & 31, hi = lane >> 5; const int wid = __builtin_amdgcn_readfirstlane(tid >> 6);
  const bf16* Qw = A_.Q + (wid * QBLK) * A_.qs;
  const unsigned lds0 = (unsigned)(uintptr_t)shm;
  float* wsf = (float*)(shm + LDS_WS) + wid * 64;
  const int ks = A_.ks;
  const bf16* ksrc = A_.K + (lane * ks + wid * 8);
  const bf16* vsrc = A_.V + ((16 * (wid & 3) + (lane >> 2)) * ks + (wid >> 2) * 32 + (lane & 3) * 8);
  const unsigned kdst = lds0 + LDS_K + wid * 1024, vdst = lds0 + LDS_V + wid * 1024;
  #define TT(t) ((MODE == MB) ? min(max((int)(t), A_.tlo), A_.thi) : (int)(t))
  #define DMA_K(t, slot) glds16(ksrc + TT(t) * KVBLK * ks, (unsigned)__builtin_amdgcn_readfirstlane(kdst + (slot)))
  #define DMA_V(t, slot) glds16(vsrc + TT(t) * KVBLK * ks, (unsigned)__builtin_amdgcn_readfirstlane(vdst + (slot)))
  const int vb0 = (int)(lds0 + LDS_V) + ((lane >> 4) & 1) * 32 + (lane & 3) * 8 + (4 * hi + ((lane & 15) >> 2)) * 64;
  const char* Kbase = shm + LDS_K; bf16x8 kf[8];
  const lds_cptr shm3 = (lds_cptr)shm; const lds_cptr kp0 = shm3 + LDS_K + hi * 1024 + r32 * 16; const lds_cptr vp0 = shm3 + LDS_V + ((lane >> 4) & 1) * 32 + (lane & 3) * 8 + (4 * hi + ((lane & 15) >> 2)) * 64;
  const int NT = A_.NT;
  DMA_K(0, 0); DMA_V(0, 0); DMA_K(1, SLOTB);
  bf16x8 qr[4];
  #pragma unroll
  for (int d0 = 0; d0 < 4; ++d0) qr[d0] = *reinterpret_cast<const bf16x8*>(&Qw[r32 * A_.qs + d0 * 16 + hi * 8]);
  float mhat = 0.f, l_reg = 0.f; f32x16 o[2]; o[0] = f32x16{}; o[1] = f32x16{}; f32x16 negm = f32x16{}; asm volatile("" : "+v"(negm));
  const int qrel = wid * QBLK + r32;
  constexpr bool NEGM = (MODE == MA || MODE == MD);
  #define CIN (NEGM ? negm : f32x16{})
  #define CMASK(P0, P1, t) score_hook<MODE>(P0, P1, (t), A_, qrel, hi, wid, r32, mhat)
  bool resc = false;
  #define START(P0, P1) do { const float rm = rowmax(P0, P1); resc = false; \
    { const float dl = (MODE == MB || MODE == MC) ? fmaxf(rm, -2048.f) : rm; mhat = fadd_s(mhat, dl); \
      _Pragma("unroll") for (int r = 0; r < 16; ++r) { P0[r] = fsub_s(P0[r], dl); P1[r] = fsub_s(P1[r], dl); } \
      if (NEGM) { _Pragma("unroll") for (int r = 0; r < 16; ++r) negm[r] = -mhat; asm volatile("" : "+v"(negm)); } } \
    _Pragma("unroll") for (int r = 0; r < 16; ++r) P0[r] = __builtin_amdgcn_exp2f(P0[r]); } while (0)
  #define RESC() do { if (resc) { asm volatile("s_waitcnt lgkmcnt(0)" ::: "memory"); \
      _Pragma("unroll") for (int d_ = 0; d_ < 2; ++d_) _Pragma("unroll") for (int r = 0; r < 16; ++r) o[d_][r] *= wsf[crow(r, hi)]; } } while (0)
  f32x16 pA0, pA1, pB0, pB1;
  int sl_prev = 0, sl_cur = 0, sl_next = SLOTB;
  #define ROT() do { sl_prev = sl_cur; sl_cur = sl_next; sl_next = (sl_next == (NSLOT - 1) * SLOTB) ? 0 : sl_next + SLOTB; } while (0)
  DMA_K(2, 2 * SLOTB);
  WAIT_BAR(3);
  qkt(pA0, pA1, Kbase, qr, negm, r32, hi); asm volatile("s_nop 15\n\ts_nop 7" : "+v"(pA0), "+v"(pA1)); CMASK(pA0, pA1, 0);
  START(pA0, pA1);
  _Pragma("unroll") for (int r = 0; r < 16; ++r) pA1[r] = __builtin_amdgcn_exp2f(pA1[r]);
  WAIT_BAR(0);
  DMA_K(3, 0); DMA_V(1, SLOTB);
  ROT();
  kload8(kf, kp0 + sl_cur);
  WAIT_BAR(2);
  s16x4 vlo[8], vhi[8]; u32x4 pw0, pw1, pw2, pw3;
  #define PKW(P, B) cvtpk_s(P[B], P[B + 1])
  #define PAF(k) __builtin_bit_cast(bf16x8, pw##k)
  #define VFR(i) (bf16x8){vlo[i][0], vlo[i][1], vlo[i][2], vlo[i][3], vhi[i][0], vhi[i][1], vhi[i][2], vhi[i][3]}
  #define PIN(x) asm volatile("" : "+v"(x))
  #define MX3(a, b, c) __builtin_fmaxf(__builtin_fmaxf((a), (b)), (c))
  #define GAPA(MF, A0, A1, A2, A3, W0, W1, PW) do { MF; sacc += A0; sacc += A1; sacc += A2; sacc += A3; PIN(sacc); W0; W1; PIN(PW); SBAR(); } while (0)
  #define EX(v) __builtin_amdgcn_exp2f(v)
  #define GAPB(MF, X, B) do { MF; X[B] = EX(X[B]); X[B + 1] = EX(X[B + 1]); X[B + 2] = EX(X[B + 2]); X[B + 3] = EX(X[B + 3]); PIN(X); SBAR(); } while (0)
  #define VRD(i) do { vlo[i] = vtr(vp_ + (((i) >> 2) * 4096 + ((i) & 3) * 1024)); vhi[i] = vtr(vp_ + (((i) >> 2) * 4096 + ((i) & 3) * 1024 + 512)); } while (0)
  #define KRD(G, j) do { if (G) { kload2(kf, kp0 + sl_next, j); SBAR(); } } while (0)
  #define STEP(C0, C1, P0, P1, t, GK, GV, GL) do { SBAR(); \
    const lds_cptr vp_ = vp0 + sl_prev; \
    VRD(0); SBAR(); float sacc = (P0[0] + P0[1]); \
    GAPA(C0 = __builtin_amdgcn_mfma_f32_32x32x16_bf16(kf[0], qr[0], CIN, 0, 0, 0), P0[2], P0[3], P0[4], P0[5],     pw0[0] = PKW(P0, 0), pw0[1] = PKW(P0, 2), pw0); \
    VRD(4); SBAR(); GAPA(C1 = __builtin_amdgcn_mfma_f32_32x32x16_bf16(kf[1], qr[0], CIN, 0, 0, 0), P0[6], P0[7], P0[8], P0[9],     pw0[2] = PKW(P0, 4), pw0[3] = PKW(P0, 6), pw0); \
    VRD(1); SBAR(); GAPA(C0 = __builtin_amdgcn_mfma_f32_32x32x16_bf16(kf[2], qr[1], C0, 0, 0, 0),   P0[10], P0[11], P0[12], P0[13], pw1[0] = PKW(P0, 8), pw1[1] = PKW(P0, 10), pw1); \
    VRD(5); SBAR(); GAPA(C1 = __builtin_amdgcn_mfma_f32_32x32x16_bf16(kf[3], qr[1], C1, 0, 0, 0),   P0[14], P0[15], P1[0], P1[1],   pw1[2] = PKW(P0, 12), pw1[3] = PKW(P0, 14), pw1); \
    VRD(2); SBAR(); GAPA(C0 = __builtin_amdgcn_mfma_f32_32x32x16_bf16(kf[4], qr[2], C0, 0, 0, 0),   P1[2], P1[3], P1[4], P1[5],     pw2[0] = PKW(P1, 0), pw2[1] = PKW(P1, 2), pw2); \
    VRD(6); SBAR(); GAPA(C1 = __builtin_amdgcn_mfma_f32_32x32x16_bf16(kf[5], qr[2], C1, 0, 0, 0),   P1[6], P1[7], P1[8], P1[9],     pw2[2] = PKW(P1, 4), pw2[3] = PKW(P1, 6), pw2); \
    VRD(3); SBAR(); GAPA(C0 = __builtin_amdgcn_mfma_f32_32x32x16_bf16(kf[6], qr[3], C0, 0, 0, 0),   P1[10], P1[11], P1[12], P1[13], pw3[0] = PKW(P1, 8), pw3[1] = PKW(P1, 10), pw3); \
    VRD(7); SBAR(); GAPA(C1 = __builtin_amdgcn_mfma_f32_32x32x16_bf16(kf[7], qr[3], C1, 0, 0, 0),   P1[14], P1[15], 0.f, 0.f,       pw3[2] = PKW(P1, 12), pw3[3] = PKW(P1, 14), pw3); \
    l_reg += sacc; \
    if (GK) { DMA_K((t) + 3, sl_cur); } if (GV) { DMA_V((t) + 1, sl_next); } \
    CMASK(C0, C1, t); \
    { float a = MX3(C0[0], C0[1], C1[0]), b = MX3(C0[2], C0[3], C1[1]); a = MX3(a, C1[2], C1[3]); \
      _Pragma("unroll") for (int r = 4; r < 16; r += 4) { a = MX3(a, C0[r], C0[r + 1]); b = MX3(b, C0[r + 2], C0[r + 3]); a = MX3(a, C1[r], C1[r + 1]); b = MX3(b, C1[r + 2], C1[r + 3]); } \
      float rm = __builtin_fmaxf(a, b); { auto rr = __builtin_amdgcn_permlane32_swap(__float_as_uint(rm), __float_as_uint(rm), false, false); rm = __builtin_fmaxf(__uint_as_float(rr[0]), __uint_as_float(rr[1])); } \
      resc = false; \
      if (__builtin_expect(__any(rm > (float)THRL), 0)) { const float dl = __builtin_fmaxf(rm, 0.f); mhat += dl; \
        _Pragma("unroll") for (int r = 0; r < 16; ++r) { C0[r] -= dl; C1[r] -= dl; } \
        if (NEGM) { _Pragma("unroll") for (int r = 0; r < 16; ++r) negm[r] = -mhat; asm volatile("" : "+v"(negm)); } \
        const float f = __builtin_amdgcn_exp2f(-dl); l_reg *= f; if (hi == 0) wsf[r32] = f; resc = true; } } \
    SBAR(); \
    GAPB(o[0] = __builtin_amdgcn_mfma_f32_32x32x16_bf16(PAF(0), VFR(0), o[0], 0, 0, 0), C0, 0); \
    GAPB(o[1] = __builtin_amdgcn_mfma_f32_32x32x16_bf16(PAF(0), VFR(4), o[1], 0, 0, 0), C0, 4); \
    KRD(GL, 0); GAPB(o[0] = __builtin_amdgcn_mfma_f32_32x32x16_bf16(PAF(1), VFR(1), o[0], 0, 0, 0), C0, 8); \
    KRD(GL, 1); GAPB(o[1] = __builtin_amdgcn_mfma_f32_32x32x16_bf16(PAF(1), VFR(5), o[1], 0, 0, 0), C0, 12); \
    KRD(GL, 2); GAPB(o[0] = __builtin_amdgcn_mfma_f32_32x32x16_bf16(PAF(2), VFR(2), o[0], 0, 0, 0), C1, 0); \
    KRD(GL, 3); GAPB(o[1] = __builtin_amdgcn_mfma_f32_32x32x16_bf16(PAF(2), VFR(6), o[1], 0, 0, 0), C1, 4); \
    GAPB(o[0] = __builtin_amdgcn_mfma_f32_32x32x16_bf16(PAF(3), VFR(3), o[0], 0, 0, 0), C1, 8); \
    GAPB(o[1] = __builtin_amdgcn_mfma_f32_32x32x16_bf16(PAF(3), VFR(7), o[1], 0, 0, 0), C1, 12); \
    } while (0)
  int t = 1;
  for (; t + 5 < NT; t += 2) {
    STEP(pB0, pB1, pA0, pA1, t, true, true, true);     WAIT_BAR(2); RESC(); ROT();
    STEP(pA0, pA1, pB0, pB1, t + 1, true, true, true); WAIT_BAR(2); RESC(); ROT();
  }
  #define ENDW(tt) do { if ((tt) + 3 < NT) { WAIT_BAR(2); } else if ((tt) + 2 < NT) { WAIT_BAR(1); } else { WAIT_BAR(0); } } while (0)
  for (; t + 1 < NT; t += 2) {
    STEP(pB0, pB1, pA0, pA1, t, (t + 3 < NT), (t + 1 < NT), (t + 1 < NT));         ENDW(t);     RESC(); ROT();
    STEP(pA0, pA1, pB0, pB1, t + 1, (t + 4 < NT), (t + 2 < NT), (t + 2 < NT));     ENDW(t + 1); RESC(); ROT();
  }
  STEP(pB0, pB1, pA0, pA1, NT - 1, false, false, false); RESC();
  { float sacc = pB0[0] + pB0[1]; _Pragma("unroll") for (int r = 2; r < 16; ++r) sacc += pB0[r]; _Pragma("unroll") for (int r = 0; r < 16; ++r) sacc += pB1[r]; l_reg += sacc;
    pw0 = (u32x4){PKW(pB0, 0), PKW(pB0, 2), PKW(pB0, 4), PKW(pB0, 6)}; pw1 = (u32x4){PKW(pB0, 8), PKW(pB0, 10), PKW(pB0, 12), PKW(pB0, 14)}; pw2 = (u32x4){PKW(pB1, 0), PKW(pB1, 2), PKW(pB1, 4), PKW(pB1, 6)}; pw3 = (u32x4){PKW(pB1, 8), PKW(pB1, 10), PKW(pB1, 12), PKW(pB1, 14)};
    SBAR(); pv(o, vb0 + sl_cur, PAF(0), PAF(1), PAF(2), PAF(3)); }
  #undef PKW
  #undef PAF
  #undef VFR
  #undef PIN
  #undef MX3
  #undef GAPA
  #undef GAPB
  #undef EX
  #undef VRD
  #undef KRD
  #undef STEP
  #undef ENDW
  { auto rr = __builtin_amdgcn_permlane32_swap(__float_as_uint(l_reg), __float_as_uint(l_reg), false, false); l_reg = __uint_as_float(rr[0]) + __uint_as_float(rr[1]); }
  if (MODE == MB) { if (hi == 0) { float* sp = A_.stat + (wid * QBLK + r32) * A_.ss; sp[0] = mhat; sp[1] = l_reg; } }
  if (hi == 0) wsf[32 + r32] = l_reg; asm volatile("s_waitcnt lgkmcnt(0)" ::: "memory");
  float rli[16];
  #pragma unroll
  for (int r = 0; r < 16; ++r) rli[r] = __builtin_amdgcn_rcpf(wsf[32 + crow(r, hi)]);
  bf16* Ow = A_.O + (wid * QBLK) * A_.os;
  { bf16* stg = (bf16*)(shm + LDS_OST) + wid * 2048;
    #pragma unroll
    for (int r = 0; r < 16; ++r) { const int orow = crow(r, hi);
      #pragma unroll
      for (int d0 = 0; d0 < 2; ++d0) stg[orow * 64 + d0 * 32 + r32] = __float2bfloat16(o[d0][r] * rli[r]); }
    asm volatile("s_waitcnt lgkmcnt(0)" ::: "memory");
    #pragma unroll
    for (int i = 0; i < 4; ++i) { const int row = i * 8 + (lane >> 3), ch = lane & 7; const u32x4 v = *(const u32x4*)(stg + row * 64 + ch * 8); *(u32x4*)(Ow + row * A_.os + ch * 8) = v; } }
  asm volatile("s_waitcnt lgkmcnt(0)\n\ts_barrier" ::: "memory");
  #undef DMA_K
  #undef DMA_V
  #undef TT
  #undef CMASK
  #undef CIN
  #undef START
  #undef RESC
  #undef ROT
}
#undef SBAR
#undef WAIT_BAR
}

__device__ __forceinline__ void transpose_item(const float* W, int K, int N, bf16_t* WT, LAS float* scr, int item, int lane) {
    const int nblk = N / 32, kb = item / nblk, nb = item % nblk, k0 = 64 * kb, n0 = 32 * nb;
#pragma unroll 8
    for (int i = 0; i < 32; ++i) { const int kk = 2 * i + (lane >> 5); scr[kk * 33 + (lane & 31)] = W[(size_t)(k0 + kk) * N + n0 + (lane & 31)]; }
    asm volatile("s_waitcnt lgkmcnt(0)" ::: "memory");
    const int c = lane & 7;
#pragma unroll
    for (int j = 0; j < 4; ++j) { const int n = (lane >> 3) + 8 * j; const LAS float* s = scr + (8 * c) * 33 + n;
        u32x4 o; o.x = pk2(s[0 * 33], s[1 * 33]); o.y = pk2(s[2 * 33], s[3 * 33]); o.z = pk2(s[4 * 33], s[5 * 33]); o.w = pk2(s[6 * 33], s[7 * 33]);
        *(u32x4*)(WT + (size_t)(n0 + n) * K + k0 + 8 * c) = o; }
    asm volatile("s_waitcnt lgkmcnt(0)" ::: "memory");
}
__device__ __forceinline__ void rms_row_bf16(const float* xrow, const float* g, bf16_t* orow, int lane) {
    const f32x4* xr = (const f32x4*)xrow + lane; const f32x4* gr = (const f32x4*)g + lane;
    f32x4 v[4]; float s = 0.f;
#pragma unroll
    for (int j = 0; j < 4; ++j) { v[j] = xr[64 * j]; s += (v[j].x * v[j].x + v[j].y * v[j].y) + (v[j].z * v[j].z + v[j].w * v[j].w); }
    const float rs = rsqrtf(wave_sum(s) * (1.f / DM) + EPS);
    u32x2* o8 = (u32x2*)orow + lane;
#pragma unroll
    for (int j = 0; j < 4; ++j) { const f32x4 gg = gr[64 * j]; u32x2 w; w.x = pk2(v[j].x * rs * gg.x, v[j].y * rs * gg.y); w.y = pk2(v[j].z * rs * gg.z, v[j].w * rs * gg.w); o8[64 * j] = w; }
}
__device__ __forceinline__ void sincos_red(float a, float& s, float& c) {
    const float q = rintf(a * 0.636619772367581f); const int iq = (int)q;
    float r = fmaf(q, -1.5703125f, a); r = fmaf(q, -4.837512969970703125e-4f, r); r = fmaf(q, -7.54978995489188216e-8f, r);
    const float r2 = r * r;
    const float sp = r + r * r2 * (-1.6666654611e-1f + r2 * (8.3321608736e-3f + r2 * (-1.9515295891e-4f)));
    const float cp = 1.0f - 0.5f * r2 + r2 * r2 * (4.166664568298827e-2f + r2 * (-1.388731625493765e-3f + r2 * 2.443315711809948e-5f));
    const int k = iq & 3;
    s = (k == 0) ? sp : (k == 1) ? cp : (k == 2) ? -sp : -cp;
    c = (k == 0) ? cp : (k == 1) ? -sp : (k == 2) ? -cp : sp;
}

struct Args { const float* in[14]; float* out; unsigned char* ws; };

__global__ void __launch_bounds__(512) mk_fwd(Args args) {
    extern __shared__ __attribute__((aligned(16))) unsigned char lds[];
    cg::grid_group grid = cg::this_grid();
    const int tid0 = threadIdx.x, wave = __builtin_amdgcn_readfirstlane(tid0 >> 6);
#define FRESH_LANE() int tid = tid0; asm volatile("" : "+v"(tid)); const int lane = tid & 63
    const int G = gridDim.x, bx = blockIdx.x;
    const int vcu = (G % 8 == 0) ? (bx % 8) * (G / 8) + bx / 8 : bx;
    const int gw = vcu * 8 + wave, NGW = G * 8;
    LAS unsigned char* ldsl = (LAS unsigned char*)lds;
#define ws (args.ws)
#define x_in (args.in[0])
#define norm_mix (args.in[1])
#define w_in (args.in[2])
#define b_gate (args.in[3])
#define diff_lambda (args.in[4])
#define diff_subln (args.in[5])
#define na_rpb (args.in[6])
#define qk_norm (args.in[7])
#define w_branch (args.in[8])
#define w_out (args.in[9])
#define norm_ffn (args.in[10])
#define w_ff1 (args.in[11])
#define w_ff2 (args.in[12])
#define norm_final (args.in[13])
#define xout (args.out)
#define WinT ((bf16_t*)(ws + WS_WIN))
#define WbrT ((bf16_t*)(ws + WS_WBR))
#define WoutT ((bf16_t*)(ws + WS_WOUT))
#define W1T ((bf16_t*)(ws + WS_W1))
#define W2T ((bf16_t*)(ws + WS_W2))
#define STAT ((float*)(ws + WS_STAT))
#define H ((bf16_t*)(ws + WS_H))
#define ATMP ((bf16_t*)(ws + WS_ATMP))
#define BTMP ((bf16_t*)(ws + WS_BTMP))
#define Y ((bf16_t*)(ws + WS_Y))
#define MERGED ((bf16_t*)(ws + WS_MERGED))
#define Z ((bf16_t*)(ws + WS_Z))
#define U ((bf16_t*)(ws + WS_Z))
#define PROJ ((bf16_t*)(ws + WS_PROJ))

    {
        FRESH_LANE();
        LAS float* scr = (LAS float*)(ldsl + wave * 16384);
        constexpr int I_IN = (DM / 64) * (INW / 32), I_BR = (512 / 64) * (DM / 32), I_OUT = (DM / 64) * (DM / 32), I_1 = (DM / 64) * (DFF / 32), I_2 = (DFF / 64) * (DM / 32);
        constexpr int NITEMS = 2 * I_IN + 8 * I_BR + 2 * I_OUT + 2 * I_1 + 2 * I_2;
        for (int it = gw; it < NITEMS; it += NGW) {
            int r = it;
            if (r < 2 * I_IN) { const int l = r / I_IN; transpose_item(w_in + (size_t)l * DM * INW, DM, INW, WinT + (size_t)l * INW * DM, scr, r % I_IN, lane); continue; } r -= 2 * I_IN;
            if (r < 8 * I_BR) { const int ln = r / I_BR; transpose_item(w_branch + (size_t)ln * 512 * DM, 512, DM, WbrT + (size_t)ln * DM * 512, scr, r % I_BR, lane); continue; } r -= 8 * I_BR;
            if (r < 2 * I_OUT) { const int l = r / I_OUT; transpose_item(w_out + (size_t)l * DM * DM, DM, DM, WoutT + (size_t)l * DM * DM, scr, r % I_OUT, lane); continue; } r -= 2 * I_OUT;
            if (r < 2 * I_1) { const int l = r / I_1; transpose_item(w_ff1 + (size_t)l * DM * DFF, DM, DFF, W1T + (size_t)l * DFF * DM, scr, r % I_1, lane); continue; } r -= 2 * I_1;
            { const int l = r / I_2; transpose_item(w_ff2 + (size_t)l * DFF * DM, DFF, DM, W2T + (size_t)l * DM * DFF, scr, r % I_2, lane); }
        }
        for (int m = gw; m < TG; m += NGW) rms_row_bf16(x_in + (size_t)m * DM, norm_mix, H + (size_t)m * DM, lane);
    }
    grid.sync();

    for (int l = 0; l < DEPTH; ++l) {
        const float lam_init = 0.8f - 0.6f * __expf(-0.3f * (float)l);
        float lam;
        { FRESH_LANE(); const float* lp = diff_lambda + l * 256; const float a = lp[lane] * lp[64 + lane], b = lp[128 + lane] * lp[192 + lane]; lam = expf(wave_sum(a)) - expf(wave_sum(b)) + lam_init; lam = __uint_as_float(__builtin_amdgcn_readfirstlane(__float_as_uint(lam))); }
        const float out_scale = 1.f - lam_init;
        { FRESH_LANE(); LAS float* tab = (LAS float*)(ldsl + TAB_OFF); for (int i = tid; i < 8 * 465; i += 512) tab[i] = na_rpb[l * 8 * 465 + i] * LOG2E; }
        __syncthreads();
        for (int grp = 0; grp < NGRP; ++grp) {
            const size_t tok0 = (size_t)grp * TG;
            const float* xsrc = (l == 0) ? x_in : xout;
            {
                pg8::Gemm g{H, WinT + (size_t)l * INW * DM, DM, DM, DM, 1 << 30, 0}; pg8::StaticOrder S; S.init(TG, INW, G, bx);
                pg8::Epi<0> E{PROJ, nullptr, nullptr, b_gate + l * 4096, INW};
                pg8::gemm_phase(ldsl, g, S, E);
            }
            grid.sync();
            {
                FRESH_LANE();
                const float inv = exp2f(-(float)(lane & 15) * 0.8304820237218406f);
                const float gq = qk_norm[l * 128 + lane], gk = qk_norm[l * 128 + 64 + lane];
                for (int m = gw; m < TG; m += NGW) {
                    const int s = (int)((tok0 + m) % SEQ); const float pos = (float)((lane < 32) ? (s >> 6) : (s & 63));
                    float sn, cs; sincos_red(pos * inv, sn, cs);
                    bf16_t* row = PROJ + (size_t)m * INW + COL_DQ;
#pragma unroll
                    for (int hd = 0; hd < 10; ++hd) {
                        const float v = __uint_as_float((unsigned)row[hd * 64 + lane] << 16);
                        const float rn = rsqrtf(wave_sum(v * v) * (1.f / 64.f) + EPS);
                        const float y = v * rn * (hd < 8 ? gq : gk);
                        const float p = __shfl_xor(y, 16);
                        float o = ((lane >> 4) & 1) ? (y * cs + p * sn) : (y * cs - p * sn);
                        if (hd < 8) o *= C2;
                        row[hd * 64 + lane] = (bf16_t)f2bf(o);
                    }
                }
            }
            grid.sync();
            {
                using namespace attn_body;
                char* shm = (char*)lds;
                for (int u = vcu; u < GB * 24 * 32; u += G) {
                    const int sg = u >> 5, qb = u & 31, bb = sg / 24, k = sg % 24; const size_t tb = (size_t)bb * SEQ;
                    AttnArgs a{}; a.qs = INW; a.ks = INW; a.NT = 128; a.tlo = 0; a.thi = 127;
                    if (k < 16) { const int hh = k >> 2, comp = (k >> 1) & 1, vh = k & 1;
                        a.Q = (const bf16*)(PROJ + (tb + qb * 256) * INW + COL_AQ + hh * 128 + comp * 64); a.K = (const bf16*)(PROJ + tb * INW + COL_AK + hh * 128 + comp * 64);
                        a.V = (const bf16*)(PROJ + tb * INW + COL_AV + hh * 128 + vh * 64); a.O = (bf16*)(ATMP + (tb + qb * 256) * 1024 + (hh * 2 + comp) * 128 + vh * 64); a.os = 1024;
                        a.s2 = exp2f(-2.f * (float)(hh + 1)) * LOG2E; a.q0 = qb * 256;
                        attn_unit<MA, 8>(a, shm);
                    } else { const int h = k - 16;
                        a.Q = (const bf16*)(PROJ + (tb + qb * 256) * INW + COL_DQ + h * 64); a.K = (const bf16*)(PROJ + tb * INW + COL_DK + (h >> 2) * 64);
                        a.V = (const bf16*)(PROJ + tb * INW + COL_DV + (h >> 2) * 64); a.O = (bf16*)(Y + (tb + qb * 256) * 2048 + 1536 + h * 64); a.os = 2048;
                        attn_unit<MD, 8>(a, shm);
                    }
                }
                for (int u = vcu; u < GB * 24 * 32; u += G) {
                    const int sg = u >> 5, blk = u & 31, bb = sg / 24, k = sg % 24, gp = k >> 3, h = k & 7, dsh = 2 * gp, dil = 1 << dsh;
                    const int nblk = 32 >> dsh, res = blk / nblk, i0 = (blk % nblk) * 256, L = SEQ >> dsh;
                    const long tq = (long)bb * SEQ + res + (long)i0 * dil, tk = (long)bb * SEQ + res + (long)(i0 - 64) * dil;
                    AttnArgs a{}; a.qs = dil * INW; a.ks = dil * INW; a.os = dil * 1536; a.NT = 6; a.tlo = (i0 == 0) ? 1 : 0; a.thi = (i0 + 256 == L) ? 4 : 5;
                    const int cq = COL_B + gp * 1536 + h * 64;
                    a.Q = (const bf16*)(PROJ + tq * INW + cq); a.K = (const bf16*)(PROJ + tk * INW + cq + 512); a.V = (const bf16*)(PROJ + tk * INW + cq + 1024);
                    a.O = (bf16*)(BTMP + tq * 1536 + gp * 512 + h * 64);
                    a.s2 = exp2f(-(float)(h + 1)) * (float)dil * LOG2E; a.stat = STAT + (tq * 24 + gp * 8 + h) * 2; a.ss = dil * 48;
                    attn_unit<MB, 8>(a, shm);
                }
                for (int u = vcu; u < GB * 8 * 32; u += G) {
                    const int sg = u >> 5, qb = u & 31, bb = sg >> 3, h = sg & 7, r0 = 4 * qb, kb = min(max(r0 - 4, 0), 116); const size_t tb = (size_t)bb * SEQ;
                    AttnArgs a{}; a.qs = INW; a.ks = INW; a.os = 2048; a.NT = 12; a.tlo = 0; a.thi = 11; a.q0 = r0; a.kb = kb;
                    a.Q = (const bf16*)(PROJ + (tb + r0 * 64) * INW + COL_CQ + h * 64); a.K = (const bf16*)(PROJ + (tb + kb * 64) * INW + COL_CK + h * 64);
                    a.V = (const bf16*)(PROJ + (tb + kb * 64) * INW + COL_CV + h * 64); a.O = (bf16*)(Y + (tb + r0 * 64) * 2048 + 1024 + h * 64);
                    a.tab = (lds_fptr)((lds_cptr)shm + TAB_OFF) + h * 465;
                    attn_unit<MC, 8>(a, shm);
                }
            }
            grid.sync();
            {
                FRESH_LANE();
                const float g0 = diff_subln[l * 128 + 2 * lane], g1 = diff_subln[l * 128 + 2 * lane + 1];
                for (int m = gw; m < TG; m += NGW) {
                    const unsigned* at = (const unsigned*)(ATMP + (size_t)m * 1024); unsigned* yr = (unsigned*)(Y + (size_t)m * 2048);
#pragma unroll
                    for (int hh = 0; hh < 4; ++hh) {
                        const unsigned w0 = at[(hh * 2) * 64 + lane], w1 = at[(hh * 2 + 1) * 64 + lane];
                        const float d0 = bflo(w0) - lam * bflo(w1), d1 = bfhi(w0) - lam * bfhi(w1);
                        const float rn = rsqrtf(wave_sum(d0 * d0 + d1 * d1) * (1.f / 128.f) + EPS) * out_scale;
                        yr[hh * 64 + lane] = pk2(d0 * rn * g0, d1 * rn * g1);
                    }
                    const int h = lane >> 3, d8 = (lane & 7) * 8;
                    const float* st = STAT + (size_t)m * 48 + h * 2;
                    const float m0 = st[0], l0 = st[1], m1 = st[16], l1 = st[17], m2 = st[32], l2 = st[33];
                    const float ms = fmaxf(m0, fmaxf(m1, m2));
                    const float w0 = l0 * exp2f(m0 - ms), w1 = l1 * exp2f(m1 - ms), w2 = l2 * exp2f(m2 - ms); const float inv = 1.f / (w0 + w1 + w2);
                    const bf16_t* bt = BTMP + (size_t)m * 1536 + h * 64 + d8;
                    const u32x4 a0 = *(const u32x4*)bt, a1 = *(const u32x4*)(bt + 512), a2 = *(const u32x4*)(bt + 1024);
                    u32x4 o;
#pragma unroll
                    for (int e = 0; e < 4; ++e) { const float lo = (w0 * bflo(a0[e]) + w1 * bflo(a1[e]) + w2 * bflo(a2[e])) * inv, hi = (w0 * bfhi(a0[e]) + w1 * bfhi(a1[e]) + w2 * bfhi(a2[e])) * inv; o[e] = pk2(lo, hi); }
                    *(u32x4*)(Y + (size_t)m * 2048 + 512 + h * 64 + d8) = o;
                }
            }
            grid.sync();
            {
                pg8::Gemm g{Y, WbrT + (size_t)l * 4096 * 512, 2048, 512, 512, 4, 512}; pg8::StaticOrder S; S.init(TG, 4096, G, bx);
                pg8::Epi<1> E{Z, nullptr, nullptr, nullptr, 4096};
                pg8::gemm_phase(ldsl, g, S, E);
            }
            grid.sync();
            { FRESH_LANE();
            for (int m = gw; m < TG; m += NGW) {
                const bf16_t* gr = PROJ + (size_t)m * INW + COL_GATE; const bf16_t* zr = Z + (size_t)m * 4096;
#pragma unroll
                for (int j = 0; j < 2; ++j) { const int c = lane * 8 + j * 512; float acc[8] = {0.f, 0.f, 0.f, 0.f, 0.f, 0.f, 0.f, 0.f};
#pragma unroll
                    for (int n = 0; n < 4; ++n) { const u32x4 gv = *(const u32x4*)(gr + n * 1024 + c), zv = *(const u32x4*)(zr + n * 1024 + c);
#pragma unroll
                        for (int e = 0; e < 4; ++e) { acc[2 * e] += bflo(gv[e]) * bflo(zv[e]); acc[2 * e + 1] += bfhi(gv[e]) * bfhi(zv[e]); } }
                    u32x4 o; o.x = pk2(acc[0], acc[1]); o.y = pk2(acc[2], acc[3]); o.z = pk2(acc[4], acc[5]); o.w = pk2(acc[6], acc[7]);
                    *(u32x4*)(MERGED + (size_t)m * DM + c) = o; }
            } }
            grid.sync();
            {
                pg8::Gemm g{MERGED, WoutT + (size_t)l * DM * DM, DM, DM, DM, 1 << 30, 0}; pg8::StaticOrder S; S.init(TG, DM, G, bx);
                pg8::Epi<3> E{nullptr, xout + tok0 * DM, xsrc + tok0 * DM, nullptr, DM};
                pg8::gemm_phase(ldsl, g, S, E);
            }
            grid.sync();
            { FRESH_LANE(); for (int m = gw; m < TG; m += NGW) rms_row_bf16(xout + (tok0 + m) * DM, norm_ffn + l * DM, H + (size_t)m * DM, lane); }
            grid.sync();
            {
                pg8::Gemm g{H, W1T + (size_t)l * DFF * DM, DM, DM, DM, 1 << 30, 0}; pg8::StaticOrder S; S.init(TG, DFF, G, bx);
                pg8::Epi<2> E{U, nullptr, nullptr, nullptr, DFF};
                pg8::gemm_phase(ldsl, g, S, E);
            }
            grid.sync();
            {
                pg8::Gemm g{U, W2T + (size_t)l * DM * DFF, DFF, DFF, DFF, 1 << 30, 0}; pg8::StaticOrder S; S.init(TG, DM, G, bx);
                pg8::Epi<3> E{nullptr, xout + tok0 * DM, xout + tok0 * DM, nullptr, DM};
                pg8::gemm_phase(ldsl, g, S, E);
            }
            {
                const int ng = grp + 1, nl = (ng == NGRP) ? l + 1 : l, ngrp = (ng == NGRP) ? 0 : ng;
                if (nl < DEPTH) {
                    if (nl != l) grid.sync();
                    FRESH_LANE(); const float* xs = (nl == 0) ? x_in : xout; const size_t nt0 = (size_t)ngrp * TG;
                    for (int m = gw; m < TG; m += NGW) rms_row_bf16(xs + (nt0 + m) * DM, norm_mix + nl * DM, H + (size_t)m * DM, lane);
                }
            }
            grid.sync();
        }
    }
    FRESH_LANE();
    for (int m = gw; m < NTOK; m += NGW) {
        f32x4* o = (f32x4*)(xout + (size_t)m * DM) + lane; const f32x4* g4 = (const f32x4*)norm_final + lane;
        f32x4 v[4]; float s = 0.f;
#pragma unroll
        for (int j = 0; j < 4; ++j) { v[j] = o[64 * j]; s += (v[j].x * v[j].x + v[j].y * v[j].y) + (v[j].z * v[j].z + v[j].w * v[j].w); }
        const float r = rsqrtf(wave_sum(s) * (1.f / DM) + EPS);
#pragma unroll
        for (int j = 0; j < 4; ++j) { const f32x4 g = g4[64 * j]; o[64 * j] = (f32x4){v[j].x * r * g.x, v[j].y * r * g.y, v[j].z * r * g.z, v[j].w * r * g.w}; }
    }
}

#undef ws
#undef x_in
#undef norm_mix
#undef w_in
#undef b_gate
#undef diff_lambda
#undef diff_subln
#undef na_rpb
#undef qk_norm
#undef w_branch
#undef w_out
#undef norm_ffn
#undef w_ff1
#undef w_ff2
#undef norm_final
#undef xout
#undef WinT
#undef WbrT
#undef WoutT
#undef W1T
#undef W2T
#undef STAT
#undef H
#undef ATMP
#undef BTMP
#undef Y
#undef MERGED
#undef Z
#undef U
#undef PROJ

extern "C" void kernel_launch(void* const* d_in, const int* in_sizes, int n_in, void* d_out, int out_size, void* d_ws, size_t ws_size, hipStream_t stream) {
    static int grid_blocks = 0;
    if (!grid_blocks) {
        int dev = 0, cus = 0, per_cu = 0;
        (void)hipGetDevice(&dev);
        (void)hipDeviceGetAttribute(&cus, hipDeviceAttributeMultiprocessorCount, dev);
        (void)hipFuncSetAttribute((const void*)mk_fwd, hipFuncAttributeMaxDynamicSharedMemorySize, LDS_BYTES);
        (void)hipOccupancyMaxActiveBlocksPerMultiprocessor(&per_cu, (const void*)mk_fwd, 512, LDS_BYTES);
        if (per_cu < 1) per_cu = 1;
        grid_blocks = cus * per_cu;
        if (ws_size < WS_END || n_in != 14) { fprintf(stderr, "kernel_launch: workspace %zu < %zu or n_in %d != 14\n", ws_size, (size_t)WS_END, n_in); grid_blocks = -1; }
    }
    if (grid_blocks < 0) return;
    Args a{};
    for (int i = 0; i < 14; ++i) a.in[i] = (const float*)d_in[i];
    a.out = (float*)d_out; a.ws = (unsigned char*)d_ws;
    void* kargs[] = {&a};
    hipError_t e = hipLaunchCooperativeKernel((const void*)mk_fwd, dim3(grid_blocks), dim3(512), kargs, LDS_BYTES, stream);
    if (e != hipSuccess) fprintf(stderr, "cooperative launch failed: %s (grid %d)\n", hipGetErrorString(e), grid_blocks);
}
```

```cpp
#include <hip/hip_runtime.h>
#include <hip/hip_cooperative_groups.h>
#include <hip/hip_bf16.h>
#include <cstdio>
#include <cstdint>
#include <cmath>
namespace cg = cooperative_groups;

constexpr int BATCH = 8, SEQ = 8192, DM = 1024, NTOK = BATCH * SEQ, INW = 12544, DFF = 4096, DEPTH = 2;
constexpr int GB = 2, TG = GB * SEQ, NGRP = BATCH / GB;
constexpr float EPS = 1e-6f;
constexpr float LOG2E = 1.4426950408889634f;
constexpr float C2 = 0.125f * LOG2E;
constexpr int COL_AQ = 0, COL_AK = 512, COL_AV = 1024, COL_B = 1536, COL_CQ = 6144, COL_CK = 6656, COL_CV = 7168, COL_DQ = 7680, COL_DK = 8192, COL_DV = 8320, COL_GATE = 8448;
constexpr size_t MiB = 1u << 20;
constexpr size_t WS_WIN = 0, WS_WBR = 49 * MiB, WS_WOUT = 57 * MiB, WS_W1 = 61 * MiB, WS_W2 = 77 * MiB, WS_STAT = 93 * MiB, WS_H = 96 * MiB, WS_ATMP = 128 * MiB,
                 WS_BTMP = 160 * MiB, WS_Y = 208 * MiB, WS_MERGED = 272 * MiB, WS_Z = 304 * MiB, WS_PROJ = 432 * MiB, WS_NRM = 824 * MiB, WS_END = 825 * MiB;
constexpr int LDS_BYTES = 147456, TAB_OFF = 131072;

#define LAS __attribute__((address_space(3)))
typedef unsigned short bf16_t;
typedef short bf16x8 __attribute__((ext_vector_type(8)));
typedef float f32x4 __attribute__((ext_vector_type(4)));
typedef unsigned u32x4 __attribute__((ext_vector_type(4)));
typedef unsigned u32x2 __attribute__((ext_vector_type(2)));

__device__ __forceinline__ unsigned f2bf(float f) { unsigned u = __builtin_bit_cast(unsigned, f); return (u + 0x7fffu + ((u >> 16) & 1u)) >> 16; }
__device__ __forceinline__ unsigned pk2(float lo, float hi) { return f2bf(lo) | (f2bf(hi) << 16); }
__device__ __forceinline__ float bflo(unsigned w) { return __uint_as_float(w << 16); }
__device__ __forceinline__ float bfhi(unsigned w) { return __uint_as_float(w & 0xffff0000u); }
__device__ __forceinline__ float wave_sum(float v) {
#pragma unroll
    for (int o = 1; o < 64; o <<= 1) v += __shfl_xor(v, o);
    return v;
}

namespace pg8 {
constexpr int BM = 256, BK = 64, HALF = 128, HTB = HALF * BK * 2, STAGE_BYTES = 8 * HTB, NXCD = 8, WGM = 8;
__host__ __device__ __forceinline__ int lds_byte(int r, int c) { const int st = (r >> 4) * 2 + (c >> 5), rr = r & 15, cc = c & 31, ob = rr * 64 + cc * 2; return st * 1024 + (ob ^ (((ob >> 9) & 1) << 5)); }
__host__ __device__ __forceinline__ void stage_rc(int b, int& R, int& C) { const int st = b / 1024, sb = b % 1024, swz = sb ^ (((sb >> 9) & 1) << 5); R = (st >> 1) * 16 + swz / 64; C = (st & 1) * 32 + (swz % 64) / 2; }
__host__ __device__ __forceinline__ int perm32(int rho) { const int n = rho >> 4, i = rho & 15; return 8 * (i >> 2) + 4 * n + (i & 3); }

struct Unit { int pm, pn; };
struct Gemm { const bf16_t* A; const bf16_t* Bt; int lda, ldb, K, adiv, astride; };

struct StaticOrder {
    int nM, nN, nwg, G, c;
    __device__ void init(int M, int N, int G_, int c_) { nM = M / BM; nN = N / BM; nwg = nM * nN; G = G_; c = c_; }
    __device__ bool next(int i, Unit& u) const {
        const long L = (long)i * G + c; if (L >= nwg) return false;
        int wgid = (int)L; { const int q = nwg / NXCD, r = nwg % NXCD, xcd = wgid % NXCD, off = wgid / NXCD; wgid = (xcd < r ? xcd * (q + 1) : r * (q + 1) + (xcd - r) * q) + off; }
        const int nig = WGM * nN, gid = wgid / nig, fm = gid * WGM, gsz = (nM - fm) < WGM ? (nM - fm) : WGM;
        u.pm = fm + ((wgid % nig) % gsz); u.pn = (wgid % nig) / gsz; return true;
    }
};

__device__ __forceinline__ unsigned cvt_pk_bf16(float lo, float hi) { unsigned r; asm volatile("v_cvt_pk_bf16_f32 %0, %1, %2" : "=v"(r) : "v"(lo), "v"(hi)); return r; }

template <int MODE> struct Epi {
    bf16_t* O; float* Of; const float* base; const float* bias; int ldc;
    __device__ __forceinline__ void operator()(const f32x4 (&acc)[2][2][4][2], const Unit& u, int wr, int wc, int fr, int fq) const {
        const int row0 = u.pm * BM + wr * 64 + fr, col0 = u.pn * BM + wc * 32 + 8 * fq;
        int kind = 0; float sc = 1.f;
        if (MODE == 0) { const int pn = u.pn; if (pn >= 33) kind = 2; else if (pn < 2 || pn == 6 || pn == 7 || pn == 12 || pn == 13 || pn == 18 || pn == 19 || pn == 24 || pn == 25) sc = C2; }
#pragma unroll
        for (int ai = 0; ai < 2; ++ai)
#pragma unroll
            for (int m = 0; m < 4; ++m) { const size_t roff = (size_t)(row0 + ai * HALF + m * 16) * ldc;
#pragma unroll
                for (int bj = 0; bj < 2; ++bj) { const int col = col0 + bj * HALF; f32x4 v0 = acc[ai][bj][m][0], v1 = acc[ai][bj][m][1];
                    if (MODE == 3) {
                        const f32x4 b0 = *(const f32x4*)(base + roff + col), b1 = *(const f32x4*)(base + roff + col + 4);
                        *(f32x4*)(Of + roff + col) = b0 + v0; *(f32x4*)(Of + roff + col + 4) = b1 + v1;
                    } else {
                        if (MODE == 0) {
                            if (kind == 2) { const f32x4 g0 = *(const f32x4*)(bias + col - COL_GATE), g1 = *(const f32x4*)(bias + col - COL_GATE + 4);
#pragma unroll
                                for (int e = 0; e < 4; ++e) { v0[e] = 1.f / (1.f + __expf(-(v0[e] + g0[e]))); v1[e] = 1.f / (1.f + __expf(-(v1[e] + g1[e]))); } }
                            else { v0 = v0 * sc; v1 = v1 * sc; }
                        }
                        if (MODE == 2) {
#pragma unroll
                            for (int e = 0; e < 4; ++e) { const float a = fmaxf(v0[e], 0.f), b = fmaxf(v1[e], 0.f); v0[e] = a * a; v1[e] = b * b; } }
                        u32x4 w; w.x = cvt_pk_bf16(v0[0], v0[1]); w.y = cvt_pk_bf16(v0[2], v0[3]); w.z = cvt_pk_bf16(v1[0], v1[1]); w.w = cvt_pk_bf16(v1[2], v1[3]);
                        *(u32x4*)(O + roff + col) = w;
                    } } }
    }
};

template <class EpiT>
__device__ __forceinline__ void gemm_phase(LAS unsigned char* lds, const Gemm g, const StaticOrder& S, const EpiT& E) {
    int tid_ = threadIdx.x; asm volatile("" : "+v"(tid_));
    const int tid = tid_, wid = __builtin_amdgcn_readfirstlane(tid >> 6), lane = tid & 63, wr = wid >> 2, wc = wid & 3, fr = lane & 15, fq = lane >> 4;
    const int K = g.K, nt = K / BK;
    unsigned voffA[2], voffB[2];
#pragma unroll
    for (int i = 0; i < 2; ++i) { int R, C; stage_rc(tid * 16 + i * 8192, R, C); const int Rb = (R & ~31) + perm32(R & 31);
        voffA[i] = (unsigned)(R * g.lda + C) * 2u; voffB[i] = (unsigned)(Rb * g.ldb + C) * 2u; }
    const size_t kstep = (size_t)(BK * 2);
    const size_t hA = (size_t)HALF * g.lda * 2, hB = (size_t)HALF * g.ldb * 2;
    const size_t tA = 2 * hA, tB = 2 * hB;
    const unsigned ldsw = (unsigned)wid * 1024u;
    const int aoff = lds_byte(wr * 64 + fr, fq * 8), boff = lds_byte(wc * 32 + fr, fq * 8);
#define PG8_SA(b, h) (((b) * 2 + (h)) * HTB)
#define PG8_SB(b, h) ((4 + (b) * 2 + (h)) * HTB)
#define PG8_STAGE(bufoff, gbase, voff) do { _Pragma("unroll") for (int _i = 0; _i < 2; ++_i) \
        __builtin_amdgcn_global_load_lds((const unsigned*)((const char*)(gbase) + (voff)[_i]), (LAS unsigned*)(lds + (bufoff) + ldsw + _i * 8192), 16, 0, 0); } while (0)
#define PG8_LDA(dst, b, h) do { _Pragma("unroll") for (int m = 0; m < 4; ++m) _Pragma("unroll") for (int k = 0; k < 2; ++k) dst[m][k] = *(const LAS bf16x8*)(lds + PG8_SA(b, h) + aoff + m * 2048 + k * 1024); } while (0)
#define PG8_LDB(dst, b, h) do { _Pragma("unroll") for (int n = 0; n < 2; ++n) _Pragma("unroll") for (int k = 0; k < 2; ++k) dst[n][k] = *(const LAS bf16x8*)(lds + PG8_SB(b, h) + boff + n * 2048 + k * 1024); } while (0)
#define PG8_MMA(ai, bj, At, Bt) do { __builtin_amdgcn_s_setprio(1); _Pragma("unroll") for (int m = 0; m < 4; ++m) _Pragma("unroll") for (int n = 0; n < 2; ++n) _Pragma("unroll") for (int k = 0; k < 2; ++k) \
        acc[ai][bj][m][n] = __builtin_amdgcn_mfma_f32_16x16x32_bf16(Bt[n][k], At[m][k], acc[ai][bj][m][n], 0, 0, 0); __builtin_amdgcn_s_setprio(0); } while (0)
#define PG8_WAIT_V(n) asm volatile("s_waitcnt vmcnt(" #n ")" ::: "memory")
#define PG8_WAIT_L(n) asm volatile("s_waitcnt lgkmcnt(" #n ")" ::: "memory")
#define PG8_BAR __builtin_amdgcn_s_barrier()
#define PG8_SCHED __builtin_amdgcn_sched_barrier(0)
#define PG8_PA(u) ((const char*)g.A + (size_t)(u).pm * tA + (size_t)((u).pn / g.adiv) * (size_t)g.astride * 2)
#define PG8_PB(u) ((const char*)g.Bt + (size_t)(u).pn * tB)
    Unit cur, nxt; int ui = 0;
    if (!S.next(0, cur)) return;
    f32x4 acc[2][2][4][2];
#pragma unroll
    for (int a = 0; a < 2; ++a)
#pragma unroll
        for (int b = 0; b < 2; ++b)
#pragma unroll
            for (int m = 0; m < 4; ++m)
#pragma unroll
                for (int n = 0; n < 2; ++n) acc[a][b][m][n] = (f32x4){0.f, 0.f, 0.f, 0.f};
    bf16x8 At[4][2], B0[2][2], B1[2][2];
    const char* cA = PG8_PA(cur); const char* cB = PG8_PB(cur);
    PG8_STAGE(PG8_SB(0, 0), cB, voffB); PG8_STAGE(PG8_SB(0, 1), cB + hB, voffB); PG8_STAGE(PG8_SA(0, 0), cA, voffA); PG8_STAGE(PG8_SA(0, 1), cA + hA, voffA);
    if (wr == 1) PG8_BAR;
    PG8_WAIT_V(2); PG8_BAR;
    PG8_STAGE(PG8_SB(1, 0), cB + kstep, voffB); PG8_STAGE(PG8_SA(1, 0), cA + kstep, voffA); PG8_STAGE(PG8_SB(1, 1), cB + hB + kstep, voffB);
    PG8_WAIT_V(6); PG8_BAR;
    for (;;) {
        const bool has_next = S.next(ui + 1, nxt);
        const char* nA = has_next ? PG8_PA(nxt) : cA; const char* nB = has_next ? PG8_PB(nxt) : cB;
        for (int t = 0; t < nt; t += 2) {
            const bool last = (t == nt - 2);
            const char* a1 = cA + (size_t)(t + 1) * kstep;
            const char* a2 = last ? nA : cA + (size_t)(t + 2) * kstep; const char* b2 = last ? nB : cB + (size_t)(t + 2) * kstep;
            const char* a3 = a2 + kstep; const char* b3 = b2 + kstep;
            PG8_LDB(B0, 0, 0); PG8_LDB(B1, 0, 1); PG8_SCHED; PG8_LDA(At, 0, 0); PG8_STAGE(PG8_SA(1, 1), a1 + hA, voffA);
            PG8_WAIT_V(8); PG8_WAIT_L(0); PG8_BAR; PG8_MMA(0, 0, At, B0); PG8_MMA(0, 1, At, B1); PG8_BAR; PG8_SCHED;
            PG8_LDA(At, 0, 1); PG8_STAGE(PG8_SB(0, 0), b2, voffB); PG8_STAGE(PG8_SB(0, 1), b2 + hB, voffB); PG8_STAGE(PG8_SA(0, 0), a2, voffA);
            PG8_WAIT_V(8); PG8_WAIT_L(0); PG8_BAR; PG8_MMA(1, 0, At, B0); PG8_MMA(1, 1, At, B1); PG8_BAR; PG8_SCHED;
            PG8_LDB(B0, 1, 0); PG8_LDB(B1, 1, 1); PG8_SCHED; PG8_LDA(At, 1, 0); PG8_STAGE(PG8_SA(0, 1), a2 + hA, voffA);
            PG8_WAIT_V(8); PG8_WAIT_L(0); PG8_BAR; PG8_MMA(0, 0, At, B0); PG8_MMA(0, 1, At, B1); PG8_BAR; PG8_SCHED;
            PG8_LDA(At, 1, 1); PG8_STAGE(PG8_SB(1, 0), b3, voffB); PG8_STAGE(PG8_SB(1, 1), b3 + hB, voffB); PG8_STAGE(PG8_SA(1, 0), a3, voffA);
            PG8_WAIT_V(8); PG8_WAIT_L(0); PG8_BAR; PG8_MMA(1, 0, At, B0); PG8_MMA(1, 1, At, B1); PG8_BAR; PG8_SCHED;
        }
        if (wr == 0) PG8_BAR;
        E(acc, cur, wr, wc, fr, fq);
        if (!has_next) break;
#pragma unroll
        for (int a = 0; a < 2; ++a)
#pragma unroll
            for (int b = 0; b < 2; ++b)
#pragma unroll
                for (int m = 0; m < 4; ++m)
#pragma unroll
                    for (int n = 0; n < 2; ++n) acc[a][b][m][n] = (f32x4){0.f, 0.f, 0.f, 0.f};
        cur = nxt; cA = nA; cB = nB; ++ui;
        if (wr == 1) PG8_BAR;
    }
    PG8_WAIT_V(0);
    PG8_BAR;
#undef PG8_SA
#undef PG8_SB
#undef PG8_STAGE
#undef PG8_LDA
#undef PG8_LDB
#undef PG8_MMA
#undef PG8_WAIT_V
#undef PG8_WAIT_L
#undef PG8_BAR
#undef PG8_SCHED
#undef PG8_PA
#undef PG8_PB
}
}

namespace attn_body {
using bf16 = __hip_bfloat16;
using s16x4 = __attribute__((ext_vector_type(4))) short;
using f32x16 = __attribute__((ext_vector_type(16))) float;
constexpr int NW = 8, QBLK = 32, QB = QBLK * NW, KVBLK = 64;
constexpr int MA = 0, MB = 1, MC = 2, MD = 3;
__device__ __forceinline__ int crow(int r, int hi) { return (r & 3) + 8 * (r >> 2) + 4 * hi; }
#define SBAR() __builtin_amdgcn_sched_barrier(0)
constexpr int NSLOT = 3, SLOTB = 8192;
constexpr int LDS_K = 0, LDS_V = NSLOT * SLOTB, LDS_WS = 2 * NSLOT * SLOTB, LDS_OST = LDS_WS + NW * 64 * 4, LDS_ATT = LDS_OST + NW * 4096;
typedef __attribute__((address_space(3))) const char* lds_cptr;
typedef __attribute__((address_space(3))) const float* lds_fptr;

struct AttnArgs {
    const bf16* Q; const bf16* K; const bf16* V; bf16* O;
    int qs, ks, os;
    int NT, tlo, thi;
    float s2;
    int q0;
    int kb;
    float* stat; int ss;
    lds_fptr tab;
};

__device__ __forceinline__ void glds16(const void* gsrc, unsigned lds_dst) { unsigned keep;
  asm volatile("s_mov_b32 %0, m0\n\ts_mov_b32 m0, %2\n\ts_nop 0\n\tglobal_load_lds_dwordx4 %1, off\n\ts_mov_b32 m0, %0" : "=&s"(keep) : "v"(gsrc), "s"(lds_dst) : "memory"); }
__device__ __forceinline__ float max3f(float a, float b, float c) { float r; asm("v_max3_f32 %0, %1, %2, %3" : "=v"(r) : "v"(a), "v"(b), "v"(c)); return r; }
__device__ __forceinline__ float max2f(float a, float b) { float r; asm("v_max_f32_e32 %0, %1, %2" : "=v"(r) : "v"(a), "v"(b)); return r; }
__device__ __forceinline__ float fadd_s(float a, float b) { float r; asm("v_add_f32_e32 %0, %1, %2" : "=v"(r) : "v"(a), "v"(b)); return r; }
__device__ __forceinline__ float fsub_s(float a, float b) { float r; asm("v_sub_f32_e32 %0, %1, %2" : "=v"(r) : "v"(a), "v"(b)); return r; }
typedef float f32x2_t __attribute__((ext_vector_type(2))); typedef __bf16 bf16x2_t __attribute__((ext_vector_type(2)));
__device__ __forceinline__ unsigned cvtpk_s(float lo, float hi) { f32x2_t v = {lo, hi}; bf16x2_t b = __builtin_convertvector(v, bf16x2_t); return __builtin_bit_cast(unsigned, b); }
#define WAIT_BAR(N) asm volatile("s_waitcnt vmcnt(" #N ") lgkmcnt(0)\n\ts_barrier" ::: "memory")

__device__ __forceinline__ void qkt(f32x16& p0, f32x16& p1, const char* Kslot, const bf16x8* qr, const f32x16& negm, int r32, int hi) {
  const char* kb = Kslot + hi * 1024 + r32 * 16;
  #pragma unroll
  for (int d0 = 0; d0 < 4; ++d0) {
    const bf16x8 b0 = *reinterpret_cast<const bf16x8*>(kb + d0 * 2048);
    const bf16x8 b1 = *reinterpret_cast<const bf16x8*>(kb + d0 * 2048 + 512);
    if (d0 == 0) { p0 = __builtin_amdgcn_mfma_f32_32x32x16_bf16(b0, qr[0], negm, 0, 0, 0); p1 = __builtin_amdgcn_mfma_f32_32x32x16_bf16(b1, qr[0], negm, 0, 0, 0); }
    else { p0 = __builtin_amdgcn_mfma_f32_32x32x16_bf16(b0, qr[d0], p0, 0, 0, 0); p1 = __builtin_amdgcn_mfma_f32_32x32x16_bf16(b1, qr[d0], p1, 0, 0, 0); } }
}
typedef short v4i16_t __attribute__((ext_vector_type(4)));
__device__ __forceinline__ void kload8(bf16x8* kf, lds_cptr kp) {
  kf[0] = *(const LAS bf16x8*)(kp);        kf[1] = *(const LAS bf16x8*)(kp + 512);
  kf[2] = *(const LAS bf16x8*)(kp + 2048); kf[3] = *(const LAS bf16x8*)(kp + 2560);
  kf[4] = *(const LAS bf16x8*)(kp + 4096); kf[5] = *(const LAS bf16x8*)(kp + 4608);
  kf[6] = *(const LAS bf16x8*)(kp + 6144); kf[7] = *(const LAS bf16x8*)(kp + 6656);
}
__device__ __forceinline__ void kload2(bf16x8* kf, lds_cptr kp, int j) { kf[2 * j] = *(const LAS bf16x8*)(kp + j * 2048); kf[2 * j + 1] = *(const LAS bf16x8*)(kp + j * 2048 + 512); }
__device__ __forceinline__ s16x4 vtr(lds_cptr p) { return __builtin_bit_cast(s16x4, __builtin_amdgcn_ds_read_tr16_b64_v4i16((LAS v4i16_t*)p)); }
__device__ __forceinline__ float rowmax(const f32x16& p0, const f32x16& p1) {
  float a = max3f(p0[0], p0[1], p1[0]), b = max3f(p0[2], p0[3], p1[1]); a = max3f(a, p1[2], p1[3]);
  #pragma unroll
  for (int r = 4; r < 16; r += 4) { a = max3f(a, p0[r], p0[r + 1]); b = max3f(b, p0[r + 2], p0[r + 3]); a = max3f(a, p1[r], p1[r + 1]); b = max3f(b, p1[r + 2], p1[r + 3]); }
  const float m = max2f(a, b);
  auto rr = __builtin_amdgcn_permlane32_swap(__float_as_uint(m), __float_as_uint(m), false, false);
  return max2f(__uint_as_float(rr[0]), __uint_as_float(rr[1]));
}
__device__ __forceinline__ void pv(f32x16* o, int vb, bf16x8 pa0, bf16x8 pa1, bf16x8 pa2, bf16x8 pa3) {
  #pragma unroll
  for (int d0 = 0; d0 < 2; ++d0) { s16x4 lo[4], hi[4];
    #pragma unroll
    for (int ks = 0; ks < 4; ++ks) {
      asm volatile("ds_read_b64_tr_b16 %0,%1 offset:%c2" : "=&v"(lo[ks]) : "v"(vb), "i"(d0 * 4096 + ks * 1024) : "memory");
      asm volatile("ds_read_b64_tr_b16 %0,%1 offset:%c2" : "=&v"(hi[ks]) : "v"(vb), "i"(d0 * 4096 + ks * 1024 + 512) : "memory"); }
    asm volatile("s_waitcnt lgkmcnt(0)" ::: "memory"); SBAR();
    #define PK(k) (bf16x8){lo[k][0], lo[k][1], lo[k][2], lo[k][3], hi[k][0], hi[k][1], hi[k][2], hi[k][3]}
    o[d0] = __builtin_amdgcn_mfma_f32_32x32x16_bf16(pa0, PK(0), o[d0], 0, 0, 0);
    o[d0] = __builtin_amdgcn_mfma_f32_32x32x16_bf16(pa1, PK(1), o[d0], 0, 0, 0);
    o[d0] = __builtin_amdgcn_mfma_f32_32x32x16_bf16(pa2, PK(2), o[d0], 0, 0, 0);
    o[d0] = __builtin_amdgcn_mfma_f32_32x32x16_bf16(pa3, PK(3), o[d0], 0, 0, 0);
    #undef PK
  }
}

template <int MODE> __device__ __forceinline__ void score_hook(f32x16& c0, f32x16& c1, int t, const AttnArgs& a, int qrel, int hi, int wid, int r32, float mh) {
  if constexpr (MODE == MA) {
    const int wlo = a.q0 + wid * QBLK, sd = (64 * t + 63 < wlo) ? 1 : ((64 * t > wlo + 31) ? -1 : 0);
    if (sd != 0) { const float sv = (float)sd * a.s2;
      #pragma unroll
      for (int r = 0; r < 16; ++r) { const float kf = (float)((r & 3) + 8 * (r >> 2)); c0[r] = fmaf(kf, sv, c0[r]); c1[r] = fmaf(kf + 32.f, sv, c1[r]); if ((r & 3) == 3) __builtin_amdgcn_sched_barrier(0); }
    } else {
      const float dq = (float)(a.q0 + qrel - 64 * t - 4 * hi), ns = -a.s2;
      #pragma unroll
      for (int r = 0; r < 16; ++r) { const float kf = (float)((r & 3) + 8 * (r >> 2)); c0[r] = fmaf(ns, fabsf(dq - kf), c0[r]); c1[r] = fmaf(ns, fabsf(dq - (kf + 32.f)), c1[r]); if ((r & 1) == 1) __builtin_amdgcn_sched_barrier(0); }
    }
  }
  if constexpr (MODE == MB) {
    const bool tv = (t >= a.tlo) && (t <= a.thi);
    const float dq = (float)(qrel + 64 - 64 * t - 4 * hi), ns = -a.s2;
    #pragma unroll
    for (int r = 0; r < 16; ++r) { const float kf = (float)((r & 3) + 8 * (r >> 2)); const float d0 = fabsf(dq - kf), d1 = fabsf(dq - (kf + 32.f));
      c0[r] = (tv && d0 <= 64.f) ? fmaf(ns, d0, c0[r] - mh) : -INFINITY; c1[r] = (tv && d1 <= 64.f) ? fmaf(ns, d1, c1[r] - mh) : -INFINITY;
      if ((r & 3) == 3) __builtin_amdgcn_sched_barrier(0); }
  }
  if constexpr (MODE == MC) {
    const int qrow = a.q0 + (wid >> 1), rs = min(max(qrow - 4, 0), 120), krow = a.kb + t;
    if (krow < rs || krow >= rs + 8) {
      #pragma unroll
      for (int r = 0; r < 16; ++r) { c0[r] = -INFINITY; c1[r] = -INFINITY; }
    } else {
      const int qc = (wid & 1) * 32 + r32, cs = min(max(qc - 8, 0), 48);
      const lds_fptr tp = a.tab + (krow - qrow + 7) * 31 + (15 - qc + 4 * hi);
      const int kd = 4 * hi - cs;
      #pragma unroll
      for (int r = 0; r < 16; ++r) { const int kc = (r & 3) + 8 * (r >> 2);
        const float b0 = tp[kc], b1 = tp[kc + 32];
        c0[r] = ((unsigned)(kd + kc) < 16u) ? c0[r] + (b0 - mh) : -INFINITY; c1[r] = ((unsigned)(kd + kc + 32) < 16u) ? c1[r] + (b1 - mh) : -INFINITY;
        if ((r & 3) == 3) __builtin_amdgcn_sched_barrier(0); }
    }
  }
}

template <int MODE, int THRL> __device__ __forceinline__ void attn_unit(const AttnArgs& A_, char* shm) {
  int tid_ = threadIdx.x; asm volatile("" : "+v"(tid_));
  const int tid = tid_, lane = tid & 63, r32 = lane & 31, hi = lane >> 5; const int wid = __builtin_amdgcn_readfirstlane(tid >> 6);
  const bf16* Qw = A_.Q + (wid * QBLK) * A_.qs;
  const unsigned lds0 = (unsigned)(uintptr_t)shm;
  float* wsf = (float*)(shm + LDS_WS) + wid * 64;
  const int ks = A_.ks;
  const bf16* ksrc = A_.K + (lane * ks + wid * 8);
  const bf16* vsrc = A_.V + ((16 * (wid & 3) + (lane >> 2)) * ks + (wid >> 2) * 32 + (lane & 3) * 8);
  const unsigned kdst = lds0 + LDS_K + wid * 1024, vdst = lds0 + LDS_V + wid * 1024;
  #define TT(t) ((MODE == MB) ? min(max((int)(t), A_.tlo), A_.thi) : (int)(t))
  #define DMA_K(t, slot) glds16(ksrc + TT(t) * KVBLK * ks, (unsigned)__builtin_amdgcn_readfirstlane(kdst + (slot)))
  #define DMA_V(t, slot) glds16(vsrc + TT(t) * KVBLK * ks, (unsigned)__builtin_amdgcn_readfirstlane(vdst + (slot)))
  const int vb0 = (int)(lds0 + LDS_V) + ((lane >> 4) & 1) * 32 + (lane & 3) * 8 + (4 * hi + ((lane & 15) >> 2)) * 64;
  const char* Kbase = shm + LDS_K; bf16x8 kf[8];
  const lds_cptr shm3 = (lds_cptr)shm; const lds_cptr kp0 = shm3 + LDS_K + hi * 1024 + r32 * 16; const lds_cptr vp0 = shm3 + LDS_V + ((lane >> 4) & 1) * 32 + (lane & 3) * 8 + (4 * hi + ((lane & 15) >> 2)) * 64;
  const int NT = A_.NT;
  DMA_K(0, 0); DMA_V(0, 0); DMA_K(1, SLOTB);
  bf16x8 qr[4];
  #pragma unroll
  for (int d0 = 0; d0 < 4; ++d0) qr[d0] = *reinterpret_cast<const bf16x8*>(&Qw[r32 * A_.qs + d0 * 16 + hi * 8]);
  float mhat = 0.f, l_reg = 0.f; f32x16 o[2]; o[0] = f32x16{}; o[1] = f32x16{}; f32x16 negm = f32x16{}; asm volatile("" : "+v"(negm));
  const int qrel = wid * QBLK + r32;
  constexpr bool NEGM = (MODE == MA || MODE == MD);
  #define CIN (NEGM ? negm : f32x16{})
  #define NEGM_SET(tn) do { float nb_ = -mhat; \
      if (MODE == MA) { const int wlo_ = A_.q0 + wid * QBLK, sd_ = (64 * (tn) + 63 < wlo_) ? 1 : ((64 * (tn) > wlo_ + 31) ? -1 : 0); \
        if (sd_ != 0) nb_ = fmaf(-(float)sd_ * A_.s2, (float)(A_.q0 + qrel - 64 * (tn) - 4 * hi), nb_); } \
      _Pragma("unroll") for (int r = 0; r < 16; ++r) negm[r] = nb_; asm volatile("" : "+v"(negm)); } while (0)
  #define CMASK(P0, P1, t) score_hook<MODE>(P0, P1, (t), A_, qrel, hi, wid, r32, mhat)
  bool resc = false;
  #define START(P0, P1) do { const float rm = rowmax(P0, P1); resc = false; \
    { const float dl = (MODE == MB || MODE == MC) ? fmaxf(rm, -2048.f) : rm; mhat = fadd_s(mhat, dl); \
      _Pragma("unroll") for (int r = 0; r < 16; ++r) { P0[r] = fsub_s(P0[r], dl); P1[r] = fsub_s(P1[r], dl); } \
      if (NEGM) { NEGM_SET(1); } } \
    _Pragma("unroll") for (int r = 0; r < 16; ++r) P0[r] = __builtin_amdgcn_exp2f(P0[r]); } while (0)
  #define RESC() do { if (resc) { asm volatile("s_waitcnt lgkmcnt(0)" ::: "memory"); \
      _Pragma("unroll") for (int d_ = 0; d_ < 2; ++d_) _Pragma("unroll") for (int r = 0; r < 16; ++r) o[d_][r] *= wsf[crow(r, hi)]; } } while (0)
  f32x16 pA0, pA1, pB0, pB1;
  int sl_prev = 0, sl_cur = 0, sl_next = SLOTB;
  #define ROT() do { sl_prev = sl_cur; sl_cur = sl_next; sl_next = (sl_next == (NSLOT - 1) * SLOTB) ? 0 : sl_next + SLOTB; } while (0)
  DMA_K(2, 2 * SLOTB);
  if (MODE == MA) { NEGM_SET(0); }
  WAIT_BAR(3);
  qkt(pA0, pA1, Kbase, qr, negm, r32, hi); asm volatile("s_nop 15\n\ts_nop 7" : "+v"(pA0), "+v"(pA1)); CMASK(pA0, pA1, 0);
  START(pA0, pA1);
  _Pragma("unroll") for (int r = 0; r < 16; ++r) pA1[r] = __builtin_amdgcn_exp2f(pA1[r]);
  WAIT_BAR(0);
  DMA_K(3, 0); DMA_V(1, SLOTB);
  ROT();
  kload8(kf, kp0 + sl_cur);
  WAIT_BAR(2);
  s16x4 vlo[8], vhi[8]; u32x4 pw0, pw1, pw2, pw3;
  #define PKW(P, B) cvtpk_s(P[B], P[B + 1])
  #define PAF(k) __builtin_bit_cast(bf16x8, pw##k)
  #define VFR(i) (bf16x8){vlo[i][0], vlo[i][1], vlo[i][2], vlo[i][3], vhi[i][0], vhi[i][1], vhi[i][2], vhi[i][3]}
  #define PIN(x) asm volatile("" : "+v"(x))
  #define MX3(a, b, c) __builtin_fmaxf(__builtin_fmaxf((a), (b)), (c))
  #define GAPA(MF, A0, A1, A2, A3, W0, W1, PW) do { MF; sacc += A0; sacc += A1; sacc += A2; sacc += A3; PIN(sacc); W0; W1; PIN(PW); SBAR(); } while (0)
  #define EX(v) __builtin_amdgcn_exp2f(v)
  #define GAPB(MF, X, B) do { MF; X[B] = EX(X[B]); X[B + 1] = EX(X[B + 1]); X[B + 2] = EX(X[B + 2]); X[B + 3] = EX(X[B + 3]); PIN(X); SBAR(); } while (0)
  #define VRD(i) do { vlo[i] = vtr(vp_ + (((i) >> 2) * 4096 + ((i) & 3) * 1024)); vhi[i] = vtr(vp_ + (((i) >> 2) * 4096 + ((i) & 3) * 1024 + 512)); } while (0)
  #define KRD(G, j) do { if (G) { kload2(kf, kp0 + sl_next, j); SBAR(); } } while (0)
  #define STEP(C0, C1, P0, P1, t, GK, GV, GL) do { SBAR(); \
    const lds_cptr vp_ = vp0 + sl_prev; \
    VRD(0); SBAR(); float sacc = (P0[0] + P0[1]); \
    GAPA(C0 = __builtin_amdgcn_mfma_f32_32x32x16_bf16(kf[0], qr[0], CIN, 0, 0, 0), P0[2], P0[3], P0[4], P0[5],     pw0[0] = PKW(P0, 0), pw0[1] = PKW(P0, 2), pw0); \
    VRD(4); SBAR(); GAPA(C1 = __builtin_amdgcn_mfma_f32_32x32x16_bf16(kf[1], qr[0], CIN, 0, 0, 0), P0[6], P0[7], P0[8], P0[9],     pw0[2] = PKW(P0, 4), pw0[3] = PKW(P0, 6), pw0); \
    VRD(1); SBAR(); GAPA(C0 = __builtin_amdgcn_mfma_f32_32x32x16_bf16(kf[2], qr[1], C0, 0, 0, 0),   P0[10], P0[11], P0[12], P0[13], pw1[0] = PKW(P0, 8), pw1[1] = PKW(P0, 10), pw1); \
    VRD(5); SBAR(); GAPA(C1 = __builtin_amdgcn_mfma_f32_32x32x16_bf16(kf[3], qr[1], C1, 0, 0, 0),   P0[14], P0[15], P1[0], P1[1],   pw1[2] = PKW(P0, 12), pw1[3] = PKW(P0, 14), pw1); \
    VRD(2); SBAR(); GAPA(C0 = __builtin_amdgcn_mfma_f32_32x32x16_bf16(kf[4], qr[2], C0, 0, 0, 0),   P1[2], P1[3], P1[4], P1[5],     pw2[0] = PKW(P1, 0), pw2[1] = PKW(P1, 2), pw2); \
    VRD(6); SBAR(); GAPA(C1 = __builtin_amdgcn_mfma_f32_32x32x16_bf16(kf[5], qr[2], C1, 0, 0, 0),   P1[6], P1[7], P1[8], P1[9],     pw2[2] = PKW(P1, 4), pw2[3] = PKW(P1, 6), pw2); \
    VRD(3); SBAR(); GAPA(C0 = __builtin_amdgcn_mfma_f32_32x32x16_bf16(kf[6], qr[3], C0, 0, 0, 0),   P1[10], P1[11], P1[12], P1[13], pw3[0] = PKW(P1, 8), pw3[1] = PKW(P1, 10), pw3); \
    VRD(7); SBAR(); GAPA(C1 = __builtin_amdgcn_mfma_f32_32x32x16_bf16(kf[7], qr[3], C1, 0, 0, 0),   P1[14], P1[15], 0.f, 0.f,       pw3[2] = PKW(P1, 12), pw3[3] = PKW(P1, 14), pw3); \
    l_reg += sacc; \
    if (GK) { DMA_K((t) + 3, sl_cur); } if (GV) { DMA_V((t) + 1, sl_next); } \
    CMASK(C0, C1, t); \
    { float a = MX3(C0[0], C0[1], C1[0]), b = MX3(C0[2], C0[3], C1[1]); a = MX3(a, C1[2], C1[3]); \
      _Pragma("unroll") for (int r = 4; r < 16; r += 4) { a = MX3(a, C0[r], C0[r + 1]); b = MX3(b, C0[r + 2], C0[r + 3]); a = MX3(a, C1[r], C1[r + 1]); b = MX3(b, C1[r + 2], C1[r + 3]); } \
      float rm = __builtin_fmaxf(a, b); { auto rr = __builtin_amdgcn_permlane32_swap(__float_as_uint(rm), __float_as_uint(rm), false, false); rm = __builtin_fmaxf(__uint_as_float(rr[0]), __uint_as_float(rr[1])); } \
      resc = false; \
      if (__builtin_expect(__any(rm > (float)THRL), 0)) { const float dl = __builtin_fmaxf(rm, 0.f); mhat += dl; \
        _Pragma("unroll") for (int r = 0; r < 16; ++r) { C0[r] -= dl; C1[r] -= dl; } \
        if (MODE == MD) { NEGM_SET(0); } \
        const float f = __builtin_amdgcn_exp2f(-dl); l_reg *= f; if (hi == 0) wsf[r32] = f; resc = true; } \
      if (MODE == MA) { NEGM_SET((t) + 1); } } \
    SBAR(); \
    GAPB(o[0] = __builtin_amdgcn_mfma_f32_32x32x16_bf16(PAF(0), VFR(0), o[0], 0, 0, 0), C0, 0); \
    GAPB(o[1] = __builtin_amdgcn_mfma_f32_32x32x16_bf16(PAF(0), VFR(4), o[1], 0, 0, 0), C0, 4); \
    KRD(GL, 0); GAPB(o[0] = __builtin_amdgcn_mfma_f32_32x32x16_bf16(PAF(1), VFR(1), o[0], 0, 0, 0), C0, 8); \
    KRD(GL, 1); GAPB(o[1] = __builtin_amdgcn_mfma_f32_32x32x16_bf16(PAF(1), VFR(5), o[1], 0, 0, 0), C0, 12); \
    KRD(GL, 2); GAPB(o[0] = __builtin_amdgcn_mfma_f32_32x32x16_bf16(PAF(2), VFR(2), o[0], 0, 0, 0), C1, 0); \
    KRD(GL, 3); GAPB(o[1] = __builtin_amdgcn_mfma_f32_32x32x16_bf16(PAF(2), VFR(6), o[1], 0, 0, 0), C1, 4); \
    GAPB(o[0] = __builtin_amdgcn_mfma_f32_32x32x16_bf16(PAF(3), VFR(3), o[0], 0, 0, 0), C1, 8); \
    GAPB(o[1] = __builtin_amdgcn_mfma_f32_32x32x16_bf16(PAF(3), VFR(7), o[1], 0, 0, 0), C1, 12); \
    } while (0)
  int t = 1;
  for (; t + 5 < NT; t += 2) {
    STEP(pB0, pB1, pA0, pA1, t, true, true, true);     WAIT_BAR(2); RESC(); ROT();
    STEP(pA0, pA1, pB0, pB1, t + 1, true, true, true); WAIT_BAR(2); RESC(); ROT();
  }
  #define ENDW(tt) do { if ((tt) + 3 < NT) { WAIT_BAR(2); } else if ((tt) + 2 < NT) { WAIT_BAR(1); } else { WAIT_BAR(0); } } while (0)
  for (; t + 1 < NT; t += 2) {
    STEP(pB0, pB1, pA0, pA1, t, (t + 3 < NT), (t + 1 < NT), (t + 1 < NT));         ENDW(t);     RESC(); ROT();
    STEP(pA0, pA1, pB0, pB1, t + 1, (t + 4 < NT), (t + 2 < NT), (t + 2 < NT));     ENDW(t + 1); RESC(); ROT();
  }
  STEP(pB0, pB1, pA0, pA1, NT - 1, false, false, false); RESC();
  { float sacc = pB0[0] + pB0[1]; _Pragma("unroll") for (int r = 2; r < 16; ++r) sacc += pB0[r]; _Pragma("unroll") for (int r = 0; r < 16; ++r) sacc += pB1[r]; l_reg += sacc;
    pw0 = (u32x4){PKW(pB0, 0), PKW(pB0, 2), PKW(pB0, 4), PKW(pB0, 6)}; pw1 = (u32x4){PKW(pB0, 8), PKW(pB0, 10), PKW(pB0, 12), PKW(pB0, 14)}; pw2 = (u32x4){PKW(pB1, 0), PKW(pB1, 2), PKW(pB1, 4), PKW(pB1, 6)}; pw3 = (u32x4){PKW(pB1, 8), PKW(pB1, 10), PKW(pB1, 12), PKW(pB1, 14)};
    SBAR(); pv(o, vb0 + sl_cur, PAF(0), PAF(1), PAF(2), PAF(3)); }
  #undef PKW
  #undef PAF
  #undef VFR
  #undef PIN
  #undef MX3
  #undef GAPA
  #undef GAPB
  #undef EX
  #undef VRD
  #undef KRD
  #undef STEP
  #undef ENDW
  { auto rr = __builtin_amdgcn_permlane32_swap(__float_as_uint(l_reg), __float_as_uint(l_reg), false, false); l_reg = __uint_as_float(rr[0]) + __uint_as_float(rr[1]); }
  if (MODE == MB) { if (hi == 0) { float* sp = A_.stat + (wid * QBLK + r32) * A_.ss; sp[0] = mhat; sp[1] = l_reg; } }
  if (hi == 0) wsf[32 + r32] = l_reg; asm volatile("s_waitcnt lgkmcnt(0)" ::: "memory");
  float rli[16];
  #pragma unroll
  for (int r = 0; r < 16; ++r) rli[r] = __builtin_amdgcn_rcpf(wsf[32 + crow(r, hi)]);
  bf16* Ow = A_.O + (wid * QBLK) * A_.os;
  { bf16* stg = (bf16*)(shm + LDS_OST) + wid * 2048;
    #pragma unroll
    for (int r = 0; r < 16; ++r) { const int orow = crow(r, hi);
      #pragma unroll
      for (int d0 = 0; d0 < 2; ++d0) stg[orow * 64 + d0 * 32 + r32] = __float2bfloat16(o[d0][r] * rli[r]); }
    asm volatile("s_waitcnt lgkmcnt(0)" ::: "memory");
    #pragma unroll
    for (int i = 0; i < 4; ++i) { const int row = i * 8 + (lane >> 3), ch = lane & 7; const u32x4 v = *(const u32x4*)(stg + row * 64 + ch * 8); *(u32x4*)(Ow + row * A_.os + ch * 8) = v; } }
  asm volatile("s_waitcnt lgkmcnt(0)\n\ts_barrier" ::: "memory");
  #undef DMA_K
  #undef DMA_V
  #undef TT
  #undef CMASK
  #undef CIN
  #undef NEGM_SET
  #undef START
  #undef RESC
  #undef ROT
}
#undef SBAR
#undef WAIT_BAR
}

__device__ __forceinline__ void transpose_item(const float* W, int K, int N, bf16_t* WT, LAS float* scr, int item, int lane) {
    const int nblk = N / 32, kb = item / nblk, nb = item % nblk, k0 = 64 * kb, n0 = 32 * nb;
#pragma unroll 8
    for (int i = 0; i < 32; ++i) { const int kk = 2 * i + (lane >> 5); scr[kk * 33 + (lane & 31)] = W[(size_t)(k0 + kk) * N + n0 + (lane & 31)]; }
    asm volatile("s_waitcnt lgkmcnt(0)" ::: "memory");
    const int c = lane & 7;
#pragma unroll
    for (int j = 0; j < 4; ++j) { const int n = (lane >> 3) + 8 * j; const LAS float* s = scr + (8 * c) * 33 + n;
        u32x4 o; o.x = pk2(s[0 * 33], s[1 * 33]); o.y = pk2(s[2 * 33], s[3 * 33]); o.z = pk2(s[4 * 33], s[5 * 33]); o.w = pk2(s[6 * 33], s[7 * 33]);
        *(u32x4*)(WT + (size_t)(n0 + n) * K + k0 + 8 * c) = o; }
    asm volatile("s_waitcnt lgkmcnt(0)" ::: "memory");
}
__device__ __forceinline__ void rms_row_bf16(const float* xrow, const float* g, bf16_t* orow, int lane) {
    const f32x4* xr = (const f32x4*)xrow + lane; const f32x4* gr = (const f32x4*)g + lane;
    f32x4 v[4]; float s = 0.f;
#pragma unroll
    for (int j = 0; j < 4; ++j) { v[j] = xr[64 * j]; s += (v[j].x * v[j].x + v[j].y * v[j].y) + (v[j].z * v[j].z + v[j].w * v[j].w); }
    const float rs = rsqrtf(wave_sum(s) * (1.f / DM) + EPS);
    u32x2* o8 = (u32x2*)orow + lane;
#pragma unroll
    for (int j = 0; j < 4; ++j) { const f32x4 gg = gr[64 * j]; u32x2 w; w.x = pk2(v[j].x * rs * gg.x, v[j].y * rs * gg.y); w.y = pk2(v[j].z * rs * gg.z, v[j].w * rs * gg.w); o8[64 * j] = w; }
}
__device__ __forceinline__ void sincos_red(float a, float& s, float& c) {
    const float q = rintf(a * 0.636619772367581f); const int iq = (int)q;
    float r = fmaf(q, -1.5703125f, a); r = fmaf(q, -4.837512969970703125e-4f, r); r = fmaf(q, -7.54978995489188216e-8f, r);
    const float r2 = r * r;
    const float sp = r + r * r2 * (-1.6666654611e-1f + r2 * (8.3321608736e-3f + r2 * (-1.9515295891e-4f)));
    const float cp = 1.0f - 0.5f * r2 + r2 * r2 * (4.166664568298827e-2f + r2 * (-1.388731625493765e-3f + r2 * 2.443315711809948e-5f));
    const int k = iq & 3;
    s = (k == 0) ? sp : (k == 1) ? cp : (k == 2) ? -sp : -cp;
    c = (k == 0) ? cp : (k == 1) ? -sp : (k == 2) ? -cp : sp;
}

struct Args { const float* in[14]; float* out; unsigned char* ws; };

__global__ void __launch_bounds__(512) mk_fwd(Args args) {
    extern __shared__ __attribute__((aligned(16))) unsigned char lds[];
    cg::grid_group grid = cg::this_grid();
    const int tid0 = threadIdx.x, wave = __builtin_amdgcn_readfirstlane(tid0 >> 6);
#define FRESH_LANE() int tid = tid0; asm volatile("" : "+v"(tid)); const int lane = tid & 63
    const int G = gridDim.x, bx = blockIdx.x;
    const int vcu = (G % 8 == 0) ? (bx % 8) * (G / 8) + bx / 8 : bx;
    const int gw = vcu * 8 + wave, NGW = G * 8;
    LAS unsigned char* ldsl = (LAS unsigned char*)lds;
#define ws (args.ws)
#define x_in (args.in[0])
#define norm_mix (args.in[1])
#define w_in (args.in[2])
#define b_gate (args.in[3])
#define diff_lambda (args.in[4])
#define diff_subln (args.in[5])
#define na_rpb (args.in[6])
#define qk_norm (args.in[7])
#define w_branch (args.in[8])
#define w_out (args.in[9])
#define norm_ffn (args.in[10])
#define w_ff1 (args.in[11])
#define w_ff2 (args.in[12])
#define norm_final (args.in[13])
#define xout (args.out)
#define WinT ((bf16_t*)(ws + WS_WIN))
#define WbrT ((bf16_t*)(ws + WS_WBR))
#define WoutT ((bf16_t*)(ws + WS_WOUT))
#define W1T ((bf16_t*)(ws + WS_W1))
#define W2T ((bf16_t*)(ws + WS_W2))
#define STAT ((float*)(ws + WS_STAT))
#define H ((bf16_t*)(ws + WS_H))
#define ATMP ((bf16_t*)(ws + WS_ATMP))
#define BTMP ((bf16_t*)(ws + WS_BTMP))
#define Y ((bf16_t*)(ws + WS_Y))
#define MERGED ((bf16_t*)(ws + WS_MERGED))
#define Z ((bf16_t*)(ws + WS_Z))
#define U ((bf16_t*)(ws + WS_Z))
#define PROJ ((bf16_t*)(ws + WS_PROJ))
#define NRMQ ((unsigned*)(ws + WS_NRM))
#define NRMK ((unsigned*)(ws + WS_NRM) + 1024)

    {
        FRESH_LANE();
        LAS float* scr = (LAS float*)(ldsl + wave * 16384);
        constexpr int I_IN = (DM / 64) * (INW / 32), I_BR = (512 / 64) * (DM / 32), I_OUT = (DM / 64) * (DM / 32), I_1 = (DM / 64) * (DFF / 32), I_2 = (DFF / 64) * (DM / 32);
        constexpr int NITEMS = 2 * I_IN + 8 * I_BR + 2 * I_OUT + 2 * I_1 + 2 * I_2;
        for (int it = gw; it < NITEMS; it += NGW) {
            int r = it;
            if (r < 2 * I_IN) { const int l = r / I_IN; transpose_item(w_in + (size_t)l * DM * INW, DM, INW, WinT + (size_t)l * INW * DM, scr, r % I_IN, lane); continue; } r -= 2 * I_IN;
            if (r < 8 * I_BR) { const int ln = r / I_BR; transpose_item(w_branch + (size_t)ln * 512 * DM, 512, DM, WbrT + (size_t)ln * DM * 512, scr, r % I_BR, lane); continue; } r -= 8 * I_BR;
            if (r < 2 * I_OUT) { const int l = r / I_OUT; transpose_item(w_out + (size_t)l * DM * DM, DM, DM, WoutT + (size_t)l * DM * DM, scr, r % I_OUT, lane); continue; } r -= 2 * I_OUT;
            if (r < 2 * I_1) { const int l = r / I_1; transpose_item(w_ff1 + (size_t)l * DM * DFF, DM, DFF, W1T + (size_t)l * DFF * DM, scr, r % I_1, lane); continue; } r -= 2 * I_1;
            { const int l = r / I_2; transpose_item(w_ff2 + (size_t)l * DFF * DM, DFF, DM, W2T + (size_t)l * DM * DFF, scr, r % I_2, lane); }
        }
        for (int m = gw; m < TG; m += NGW) rms_row_bf16(x_in + (size_t)m * DM, norm_mix, H + (size_t)m * DM, lane);
    }
    grid.sync();

    for (int l = 0; l < DEPTH; ++l) {
        const float lam_init = 0.8f - 0.6f * __expf(-0.3f * (float)l);
        float lam;
        { FRESH_LANE(); const float* lp = diff_lambda + l * 256; const float a = lp[lane] * lp[64 + lane], b = lp[128 + lane] * lp[192 + lane]; lam = expf(wave_sum(a)) - expf(wave_sum(b)) + lam_init; lam = __uint_as_float(__builtin_amdgcn_readfirstlane(__float_as_uint(lam))); }
        const float out_scale = 1.f - lam_init;
        { FRESH_LANE(); LAS float* tab = (LAS float*)(ldsl + TAB_OFF); for (int i = tid; i < 8 * 465; i += 512) tab[i] = na_rpb[l * 8 * 465 + i] * LOG2E; }
        __syncthreads();
        for (int grp = 0; grp < NGRP; ++grp) {
            const size_t tok0 = (size_t)grp * TG;
            const float* xsrc = (l == 0) ? x_in : xout;
            {
                pg8::Gemm g{H, WinT + (size_t)l * INW * DM, DM, DM, DM, 1 << 30, 0}; pg8::StaticOrder S; S.init(TG, INW, G, bx);
                if (bx == 0) { for (int i = tid0; i < 1024 + 16; i += 512) NRMQ[i] = 0u; }
                pg8::Epi<0> E{PROJ, nullptr, nullptr, b_gate + l * 4096, INW};
                pg8::gemm_phase(ldsl, g, S, E);
            }
            grid.sync();
            {
                FRESH_LANE();
                const float inv = exp2f(-(float)(lane & 15) * 0.8304820237218406f);
                const float gq = qk_norm[l * 128 + lane], gk = qk_norm[l * 128 + 64 + lane];
                const int per = (TG + NGW - 1) / NGW;
                float mq = 0.f, mk = 0.f; int cu = -1;
                for (int i = 0; i < per; ++i) {
                    const int m = gw * per + i; if (m >= TG) break;
                    if ((m >> 8) != cu) { if (cu >= 0 && (lane & 7) == 0) { atomicMax(NRMQ + cu * 8 + (lane >> 3), __float_as_uint(mq)); atomicMax(NRMK + (cu >> 5) * 8 + (lane >> 3), __float_as_uint(mk)); } cu = m >> 8; mq = 0.f; mk = 0.f; }
                    const int s = (int)((tok0 + m) % SEQ); const float pos = (float)((lane < 32) ? (s >> 6) : (s & 63));
                    float sn, cs; sincos_red(pos * inv, sn, cs);
                    { const bf16_t* ar = PROJ + (size_t)m * INW; const u32x4 qv = *(const u32x4*)(ar + COL_AQ + lane * 8), kv = *(const u32x4*)(ar + COL_AK + lane * 8);
                      float nq = 0.f, nk = 0.f;
#pragma unroll
                      for (int e = 0; e < 4; ++e) { nq += bflo(qv[e]) * bflo(qv[e]) + bfhi(qv[e]) * bfhi(qv[e]); nk += bflo(kv[e]) * bflo(kv[e]) + bfhi(kv[e]) * bfhi(kv[e]); }
                      nq += __shfl_xor(nq, 1); nk += __shfl_xor(nk, 1); nq += __shfl_xor(nq, 2); nk += __shfl_xor(nk, 2); nq += __shfl_xor(nq, 4); nk += __shfl_xor(nk, 4);
                      mq = fmaxf(mq, sqrtf(nq)); mk = fmaxf(mk, sqrtf(nk)); }
                    bf16_t* row = PROJ + (size_t)m * INW + COL_DQ;
#pragma unroll
                    for (int hd = 0; hd < 10; ++hd) {
                        const float v = __uint_as_float((unsigned)row[hd * 64 + lane] << 16);
                        const float rn = rsqrtf(wave_sum(v * v) * (1.f / 64.f) + EPS);
                        const float y = v * rn * (hd < 8 ? gq : gk);
                        const float p = __shfl_xor(y, 16);
                        float o = ((lane >> 4) & 1) ? (y * cs + p * sn) : (y * cs - p * sn);
                        if (hd < 8) o *= C2;
                        row[hd * 64 + lane] = (bf16_t)f2bf(o);
                    }
                }
                if (cu >= 0 && (lane & 7) == 0) { atomicMax(NRMQ + cu * 8 + (lane >> 3), __float_as_uint(mq)); atomicMax(NRMK + (cu >> 5) * 8 + (lane >> 3), __float_as_uint(mk)); }
            }
            grid.sync();
            {
                using namespace attn_body;
                char* shm = (char*)lds;
                for (int u = vcu; u < GB * 24 * 32; u += G) {
                    const int si = u >> 8, sx = (u >> 5) & 7, qb = u & 31; int bb, k;
                    if (si < 4) { const int j = si * 8 + sx; bb = j >> 4; k = 8 + (j & 15); } else { bb = sx >> 2; k = (si - 4) * 4 + (sx & 3); }
                    const size_t tb = (size_t)bb * SEQ;
                    AttnArgs a{}; a.qs = INW; a.ks = INW; a.NT = 128; a.tlo = 0; a.thi = 127;
                    if (k < 16) { const int hh = k >> 2, comp = (k >> 1) & 1, vh = k & 1;
                        a.Q = (const bf16*)(PROJ + (tb + qb * 256) * INW + COL_AQ + hh * 128 + comp * 64); a.K = (const bf16*)(PROJ + tb * INW + COL_AK + hh * 128 + comp * 64);
                        a.V = (const bf16*)(PROJ + tb * INW + COL_AV + hh * 128 + vh * 64); a.O = (bf16*)(ATMP + (tb + qb * 256) * 1024 + (hh * 2 + comp) * 128 + vh * 64); a.os = 1024;
                        a.s2 = exp2f(-2.f * (float)(hh + 1)) * LOG2E;
                        const float Bs = __uint_as_float(NRMQ[(bb * 32 + qb) * 8 + hh * 2 + comp]) * __uint_as_float(NRMK[bb * 8 + hh * 2 + comp]) * 1.02f + 0.25f;
                        const float dlim = fminf((150.f + 2.f * Bs) / a.s2, 1.0e6f), q0f = (float)(qb * 256);
                        int tlo = max(0, (int)floorf((q0f - 63.f - dlim) * (1.f / 64.f))), thi = min(127, (int)ceilf((q0f + 255.f + dlim) * (1.f / 64.f)));
                        if (((thi - tlo + 1) & 1) != 0) { if (tlo > 0) --tlo; else ++thi; }
                        tlo = __builtin_amdgcn_readfirstlane(tlo); thi = __builtin_amdgcn_readfirstlane(thi);
                        a.K += (size_t)tlo * 64 * INW; a.V += (size_t)tlo * 64 * INW; a.q0 = qb * 256 - 64 * tlo; a.NT = thi - tlo + 1;
                        attn_unit<MA, 8>(a, shm);
                    } else { const int h = k - 16;
                        a.Q = (const bf16*)(PROJ + (tb + qb * 256) * INW + COL_DQ + h * 64); a.K = (const bf16*)(PROJ + tb * INW + COL_DK + (h >> 2) * 64);
                        a.V = (const bf16*)(PROJ + tb * INW + COL_DV + (h >> 2) * 64); a.O = (bf16*)(Y + (tb + qb * 256) * 2048 + 1536 + h * 64); a.os = 2048;
                        attn_unit<MD, 8>(a, shm);
                    }
                }
                for (int u = vcu; u < GB * 24 * 32; u += G) {
                    const int sg = u >> 5, blk = u & 31, bb = sg / 24, k = sg % 24, gp = k >> 3, h = k & 7, dsh = 2 * gp, dil = 1 << dsh;
                    const int nblk = 32 >> dsh, res = blk / nblk, i0 = (blk % nblk) * 256, L = SEQ >> dsh;
                    const long tq = (long)bb * SEQ + res + (long)i0 * dil, tk = (long)bb * SEQ + res + (long)(i0 - 64) * dil;
                    AttnArgs a{}; a.qs = dil * INW; a.ks = dil * INW; a.os = dil * 1536; a.NT = 6; a.tlo = (i0 == 0) ? 1 : 0; a.thi = (i0 + 256 == L) ? 4 : 5;
                    const int cq = COL_B + gp * 1536 + h * 64;
                    a.Q = (const bf16*)(PROJ + tq * INW + cq); a.K = (const bf16*)(PROJ + tk * INW + cq + 512); a.V = (const bf16*)(PROJ + tk * INW + cq + 1024);
                    a.O = (bf16*)(BTMP + tq * 1536 + gp * 512 + h * 64);
                    a.s2 = exp2f(-(float)(h + 1)) * (float)dil * LOG2E; a.stat = STAT + (tq * 24 + gp * 8 + h) * 2; a.ss = dil * 48;
                    attn_unit<MB, 8>(a, shm);
                }
                for (int u = vcu; u < GB * 8 * 32; u += G) {
                    const int sg = u >> 5, qb = u & 31, bb = sg >> 3, h = sg & 7, r0 = 4 * qb, kb = min(max(r0 - 4, 0), 116); const size_t tb = (size_t)bb * SEQ;
                    AttnArgs a{}; a.qs = INW; a.ks = INW; a.os = 2048; a.NT = 12; a.tlo = 0; a.thi = 11; a.q0 = r0; a.kb = kb;
                    a.Q = (const bf16*)(PROJ + (tb + r0 * 64) * INW + COL_CQ + h * 64); a.K = (const bf16*)(PROJ + (tb + kb * 64) * INW + COL_CK + h * 64);
                    a.V = (const bf16*)(PROJ + (tb + kb * 64) * INW + COL_CV + h * 64); a.O = (bf16*)(Y + (tb + r0 * 64) * 2048 + 1024 + h * 64);
                    a.tab = (lds_fptr)((lds_cptr)shm + TAB_OFF) + h * 465;
                    attn_unit<MC, 8>(a, shm);
                }
            }
            grid.sync();
            {
                FRESH_LANE();
                const float g0 = diff_subln[l * 128 + 2 * lane], g1 = diff_subln[l * 128 + 2 * lane + 1];
                for (int m = gw; m < TG; m += NGW) {
                    const unsigned* at = (const unsigned*)(ATMP + (size_t)m * 1024); unsigned* yr = (unsigned*)(Y + (size_t)m * 2048);
#pragma unroll
                    for (int hh = 0; hh < 4; ++hh) {
                        const unsigned w0 = at[(hh * 2) * 64 + lane], w1 = at[(hh * 2 + 1) * 64 + lane];
                        const float d0 = bflo(w0) - lam * bflo(w1), d1 = bfhi(w0) - lam * bfhi(w1);
                        const float rn = rsqrtf(wave_sum(d0 * d0 + d1 * d1) * (1.f / 128.f) + EPS) * out_scale;
                        yr[hh * 64 + lane] = pk2(d0 * rn * g0, d1 * rn * g1);
                    }
                    const int h = lane >> 3, d8 = (lane & 7) * 8;
                    const float* st = STAT + (size_t)m * 48 + h * 2;
                    const float m0 = st[0], l0 = st[1], m1 = st[16], l1 = st[17], m2 = st[32], l2 = st[33];
                    const float ms = fmaxf(m0, fmaxf(m1, m2));
                    const float w0 = l0 * exp2f(m0 - ms), w1 = l1 * exp2f(m1 - ms), w2 = l2 * exp2f(m2 - ms); const float inv = 1.f / (w0 + w1 + w2);
                    const bf16_t* bt = BTMP + (size_t)m * 1536 + h * 64 + d8;
                    const u32x4 a0 = *(const u32x4*)bt, a1 = *(const u32x4*)(bt + 512), a2 = *(const u32x4*)(bt + 1024);
                    u32x4 o;
#pragma unroll
                    for (int e = 0; e < 4; ++e) { const float lo = (w0 * bflo(a0[e]) + w1 * bflo(a1[e]) + w2 * bflo(a2[e])) * inv, hi = (w0 * bfhi(a0[e]) + w1 * bfhi(a1[e]) + w2 * bfhi(a2[e])) * inv; o[e] = pk2(lo, hi); }
                    *(u32x4*)(Y + (size_t)m * 2048 + 512 + h * 64 + d8) = o;
                }
            }
            grid.sync();
            {
                pg8::Gemm g{Y, WbrT + (size_t)l * 4096 * 512, 2048, 512, 512, 4, 512}; pg8::StaticOrder S; S.init(TG, 4096, G, bx);
                pg8::Epi<1> E{Z, nullptr, nullptr, nullptr, 4096};
                pg8::gemm_phase(ldsl, g, S, E);
            }
            grid.sync();
            { FRESH_LANE();
            for (int m = gw; m < TG; m += NGW) {
                const bf16_t* gr = PROJ + (size_t)m * INW + COL_GATE; const bf16_t* zr = Z + (size_t)m * 4096;
#pragma unroll
                for (int j = 0; j < 2; ++j) { const int c = lane * 8 + j * 512; float acc[8] = {0.f, 0.f, 0.f, 0.f, 0.f, 0.f, 0.f, 0.f};
#pragma unroll
                    for (int n = 0; n < 4; ++n) { const u32x4 gv = *(const u32x4*)(gr + n * 1024 + c), zv = *(const u32x4*)(zr + n * 1024 + c);
#pragma unroll
                        for (int e = 0; e < 4; ++e) { acc[2 * e] += bflo(gv[e]) * bflo(zv[e]); acc[2 * e + 1] += bfhi(gv[e]) * bfhi(zv[e]); } }
                    u32x4 o; o.x = pk2(acc[0], acc[1]); o.y = pk2(acc[2], acc[3]); o.z = pk2(acc[4], acc[5]); o.w = pk2(acc[6], acc[7]);
                    *(u32x4*)(MERGED + (size_t)m * DM + c) = o; }
            } }
            grid.sync();
            {
                pg8::Gemm g{MERGED, WoutT + (size_t)l * DM * DM, DM, DM, DM, 1 << 30, 0}; pg8::StaticOrder S; S.init(TG, DM, G, bx);
                pg8::Epi<3> E{nullptr, xout + tok0 * DM, xsrc + tok0 * DM, nullptr, DM};
                pg8::gemm_phase(ldsl, g, S, E);
            }
            grid.sync();
            { FRESH_LANE(); for (int m = gw; m < TG; m += NGW) rms_row_bf16(xout + (tok0 + m) * DM, norm_ffn + l * DM, H + (size_t)m * DM, lane); }
            grid.sync();
            {
                pg8::Gemm g{H, W1T + (size_t)l * DFF * DM, DM, DM, DM, 1 << 30, 0}; pg8::StaticOrder S; S.init(TG, DFF, G, bx);
                pg8::Epi<2> E{U, nullptr, nullptr, nullptr, DFF};
                pg8::gemm_phase(ldsl, g, S, E);
            }
            grid.sync();
            {
                pg8::Gemm g{U, W2T + (size_t)l * DM * DFF, DFF, DFF, DFF, 1 << 30, 0}; pg8::StaticOrder S; S.init(TG, DM, G, bx);
                pg8::Epi<3> E{nullptr, xout + tok0 * DM, xout + tok0 * DM, nullptr, DM};
                pg8::gemm_phase(ldsl, g, S, E);
            }
            {
                const int ng = grp + 1, nl = (ng == NGRP) ? l + 1 : l, ngrp = (ng == NGRP) ? 0 : ng;
                if (nl < DEPTH) {
                    if (nl != l) grid.sync();
                    FRESH_LANE(); const float* xs = (nl == 0) ? x_in : xout; const size_t nt0 = (size_t)ngrp * TG;
                    for (int m = gw; m < TG; m += NGW) rms_row_bf16(xs + (nt0 + m) * DM, norm_mix + nl * DM, H + (size_t)m * DM, lane);
                }
            }
            grid.sync();
        }
    }
    FRESH_LANE();
    for (int m = gw; m < NTOK; m += NGW) {
        f32x4* o = (f32x4*)(xout + (size_t)m * DM) + lane; const f32x4* g4 = (const f32x4*)norm_final + lane;
        f32x4 v[4]; float s = 0.f;
#pragma unroll
        for (int j = 0; j < 4; ++j) { v[j] = o[64 * j]; s += (v[j].x * v[j].x + v[j].y * v[j].y) + (v[j].z * v[j].z + v[j].w * v[j].w); }
        const float r = rsqrtf(wave_sum(s) * (1.f / DM) + EPS);
#pragma unroll
        for (int j = 0; j < 4; ++j) { const f32x4 g = g4[64 * j]; o[64 * j] = (f32x4){v[j].x * r * g.x, v[j].y * r * g.y, v[j].z * r * g.z, v[j].w * r * g.w}; }
    }
}

#undef ws
#undef x_in
#undef norm_mix
#undef w_in
#undef b_gate
#undef diff_lambda
#undef diff_subln
#undef na_rpb
#undef qk_norm
#undef w_branch
#undef w_out
#undef norm_ffn
#undef w_ff1
#undef w_ff2
#undef norm_final
#undef xout
#undef WinT
#undef WbrT
#undef WoutT
#undef W1T
#undef W2T
#undef STAT
#undef H
#undef ATMP
#undef BTMP
#undef Y
#undef MERGED
#undef Z
#undef U
#undef PROJ
#undef NRMQ
#undef NRMK

extern "C" void kernel_launch(void* const* d_in, const int* in_sizes, int n_in, void* d_out, int out_size, void* d_ws, size_t ws_size, hipStream_t stream) {
    static int grid_blocks = 0;
    if (!grid_blocks) {
        int dev = 0, cus = 0, per_cu = 0;
        (void)hipGetDevice(&dev);
        (void)hipDeviceGetAttribute(&cus, hipDeviceAttributeMultiprocessorCount, dev);
        (void)hipFuncSetAttribute((const void*)mk_fwd, hipFuncAttributeMaxDynamicSharedMemorySize, LDS_BYTES);
        (void)hipOccupancyMaxActiveBlocksPerMultiprocessor(&per_cu, (const void*)mk_fwd, 512, LDS_BYTES);
        if (per_cu < 1) per_cu = 1;
        grid_blocks = cus * per_cu;
        if (ws_size < WS_END || n_in != 14) { fprintf(stderr, "kernel_launch: workspace %zu < %zu or n_in %d != 14\n", ws_size, (size_t)WS_END, n_in); grid_blocks = -1; }
    }
    if (grid_blocks < 0) return;
    Args a{};
    for (int i = 0; i < 14; ++i) a.in[i] = (const float*)d_in[i];
    a.out = (float*)d_out; a.ws = (unsigned char*)d_ws;
    void* kargs[] = {&a};
    hipError_t e = hipLaunchCooperativeKernel((const void*)mk_fwd, dim3(grid_blocks), dim3(512), kargs, LDS_BYTES, stream);
    if (e != hipSuccess) fprintf(stderr, "cooperative launch failed: %s (grid %d)\n", hipGetErrorString(e), grid_blocks);
}
```

```cpp
#include <hip/hip_runtime.h>
#include <hip/hip_cooperative_groups.h>
#include <hip/hip_bf16.h>
#include <cstdio>
#include <cstdint>
#include <cmath>
namespace cg = cooperative_groups;

constexpr int BATCH = 8, SEQ = 8192, DM = 1024, NTOK = BATCH * SEQ, INW = 12544, DFF = 4096, DEPTH = 2;
constexpr int GB = 2, TG = GB * SEQ, NGRP = BATCH / GB;
constexpr float EPS = 1e-6f;
constexpr float LOG2E = 1.4426950408889634f;
constexpr float C2 = 0.125f * LOG2E;
constexpr int COL_AQ = 0, COL_AK = 512, COL_AV = 1024, COL_B = 1536, COL_CQ = 6144, COL_CK = 6656, COL_CV = 7168, COL_DQ = 7680, COL_DK = 8192, COL_DV = 8320, COL_GATE = 8448;
constexpr size_t MiB = 1u << 20;
constexpr size_t WS_WIN = 0, WS_WBR = 49 * MiB, WS_WOUT = 57 * MiB, WS_W1 = 61 * MiB, WS_W2 = 77 * MiB, WS_STAT = 93 * MiB, WS_H = 96 * MiB, WS_ATMP = 128 * MiB,
                 WS_BTMP = 160 * MiB, WS_Y = 208 * MiB, WS_MERGED = 272 * MiB, WS_Z = 304 * MiB, WS_PROJ = 432 * MiB, WS_NRM = 824 * MiB, WS_BAR = 824 * MiB + 512 * 1024, WS_END = 825 * MiB;
constexpr int LDS_BYTES = 147456, TAB_OFF = 131072, MISC_OFF = 147072;

#define LAS __attribute__((address_space(3)))
typedef unsigned short bf16_t;
typedef short bf16x8 __attribute__((ext_vector_type(8)));
typedef float f32x4 __attribute__((ext_vector_type(4)));
typedef unsigned u32x4 __attribute__((ext_vector_type(4)));
typedef unsigned u32x2 __attribute__((ext_vector_type(2)));

__device__ __forceinline__ unsigned f2bf(float f) { unsigned u = __builtin_bit_cast(unsigned, f); return (u + 0x7fffu + ((u >> 16) & 1u)) >> 16; }
__device__ __forceinline__ unsigned pk2(float lo, float hi) { return f2bf(lo) | (f2bf(hi) << 16); }
__device__ __forceinline__ float bflo(unsigned w) { return __uint_as_float(w << 16); }
__device__ __forceinline__ float bfhi(unsigned w) { return __uint_as_float(w & 0xffff0000u); }
__device__ __forceinline__ float wave_sum(float v) {
#pragma unroll
    for (int o = 1; o < 64; o <<= 1) v += __shfl_xor(v, o);
    return v;
}

namespace pg8 {
constexpr int BM = 256, BK = 64, HALF = 128, HTB = HALF * BK * 2, STAGE_BYTES = 8 * HTB, NXCD = 8, WGM = 8;
__host__ __device__ __forceinline__ int lds_byte(int r, int c) { const int st = (r >> 4) * 2 + (c >> 5), rr = r & 15, cc = c & 31, ob = rr * 64 + cc * 2; return st * 1024 + (ob ^ (((ob >> 9) & 1) << 5)); }
__host__ __device__ __forceinline__ void stage_rc(int b, int& R, int& C) { const int st = b / 1024, sb = b % 1024, swz = sb ^ (((sb >> 9) & 1) << 5); R = (st >> 1) * 16 + swz / 64; C = (st & 1) * 32 + (swz % 64) / 2; }
__host__ __device__ __forceinline__ int perm32(int rho) { const int n = rho >> 4, i = rho & 15; return 8 * (i >> 2) + 4 * n + (i & 3); }

struct Unit { int pm, pn; };
struct Gemm { const bf16_t* A; const bf16_t* Bt; int lda, ldb, K, adiv, astride; };

struct StaticOrder {
    int nM, nN, nwg, G, c;
    __device__ void init(int M, int N, int G_, int c_) { nM = M / BM; nN = N / BM; nwg = nM * nN; G = G_; c = c_; }
    __device__ bool next(int i, Unit& u) const {
        const long L = (long)i * G + c; if (L >= nwg) return false;
        int wgid = (int)L; { const int q = nwg / NXCD, r = nwg % NXCD, xcd = wgid % NXCD, off = wgid / NXCD; wgid = (xcd < r ? xcd * (q + 1) : r * (q + 1) + (xcd - r) * q) + off; }
        const int nig = WGM * nN, gid = wgid / nig, fm = gid * WGM, gsz = (nM - fm) < WGM ? (nM - fm) : WGM;
        u.pm = fm + ((wgid % nig) % gsz); u.pn = (wgid % nig) / gsz; return true;
    }
};

__device__ __forceinline__ unsigned cvt_pk_bf16(float lo, float hi) { unsigned r; asm volatile("v_cvt_pk_bf16_f32 %0, %1, %2" : "=v"(r) : "v"(lo), "v"(hi)); return r; }

template <int MODE> struct Epi {
    bf16_t* O; float* Of; const float* base; const float* bias; int ldc;
    __device__ __forceinline__ void operator()(const f32x4 (&acc)[2][2][4][2], const Unit& u, int wr, int wc, int fr, int fq) const {
        const int row0 = u.pm * BM + wr * 64 + fr, col0 = u.pn * BM + wc * 32 + 8 * fq;
        int kind = 0; float sc = 1.f;
        if (MODE == 0) { const int pn = u.pn; if (pn >= 33) kind = 2; else if (pn < 2 || pn == 6 || pn == 7 || pn == 12 || pn == 13 || pn == 18 || pn == 19 || pn == 24 || pn == 25) sc = C2; }
#pragma unroll
        for (int ai = 0; ai < 2; ++ai)
#pragma unroll
            for (int m = 0; m < 4; ++m) { const size_t roff = (size_t)(row0 + ai * HALF + m * 16) * ldc;
#pragma unroll
                for (int bj = 0; bj < 2; ++bj) { const int col = col0 + bj * HALF; f32x4 v0 = acc[ai][bj][m][0], v1 = acc[ai][bj][m][1];
                    if (MODE == 3) {
                        const f32x4 b0 = *(const f32x4*)(base + roff + col), b1 = *(const f32x4*)(base + roff + col + 4);
                        *(f32x4*)(Of + roff + col) = b0 + v0; *(f32x4*)(Of + roff + col + 4) = b1 + v1;
                    } else {
                        if (MODE == 0) {
                            if (kind == 2) { const f32x4 g0 = *(const f32x4*)(bias + col - COL_GATE), g1 = *(const f32x4*)(bias + col - COL_GATE + 4);
#pragma unroll
                                for (int e = 0; e < 4; ++e) { v0[e] = 1.f / (1.f + __expf(-(v0[e] + g0[e]))); v1[e] = 1.f / (1.f + __expf(-(v1[e] + g1[e]))); } }
                            else { v0 = v0 * sc; v1 = v1 * sc; }
                        }
                        if (MODE == 2) {
#pragma unroll
                            for (int e = 0; e < 4; ++e) { const float a = fmaxf(v0[e], 0.f), b = fmaxf(v1[e], 0.f); v0[e] = a * a; v1[e] = b * b; } }
                        u32x4 w; w.x = cvt_pk_bf16(v0[0], v0[1]); w.y = cvt_pk_bf16(v0[2], v0[3]); w.z = cvt_pk_bf16(v1[0], v1[1]); w.w = cvt_pk_bf16(v1[2], v1[3]);
                        *(u32x4*)(O + roff + col) = w;
                    } } }
    }
};

template <class EpiT>
__device__ __forceinline__ void gemm_phase(LAS unsigned char* lds, const Gemm g, const StaticOrder& S, const EpiT& E) {
    int tid_ = threadIdx.x; asm volatile("" : "+v"(tid_));
    const int tid = tid_, wid = __builtin_amdgcn_readfirstlane(tid >> 6), lane = tid & 63, wr = wid >> 2, wc = wid & 3, fr = lane & 15, fq = lane >> 4;
    const int K = g.K, nt = K / BK;
    unsigned voffA[2], voffB[2];
#pragma unroll
    for (int i = 0; i < 2; ++i) { int R, C; stage_rc(tid * 16 + i * 8192, R, C); const int Rb = (R & ~31) + perm32(R & 31);
        voffA[i] = (unsigned)(R * g.lda + C) * 2u; voffB[i] = (unsigned)(Rb * g.ldb + C) * 2u; }
    const size_t kstep = (size_t)(BK * 2);
    const size_t hA = (size_t)HALF * g.lda * 2, hB = (size_t)HALF * g.ldb * 2;
    const size_t tA = 2 * hA, tB = 2 * hB;
    const unsigned ldsw = (unsigned)wid * 1024u;
    const int aoff = lds_byte(wr * 64 + fr, fq * 8), boff = lds_byte(wc * 32 + fr, fq * 8);
#define PG8_SA(b, h) (((b) * 2 + (h)) * HTB)
#define PG8_SB(b, h) ((4 + (b) * 2 + (h)) * HTB)
#define PG8_STAGE(bufoff, gbase, voff) do { _Pragma("unroll") for (int _i = 0; _i < 2; ++_i) \
        __builtin_amdgcn_global_load_lds((const unsigned*)((const char*)(gbase) + (voff)[_i]), (LAS unsigned*)(lds + (bufoff) + ldsw + _i * 8192), 16, 0, 0); } while (0)
#define PG8_LDA(dst, b, h) do { _Pragma("unroll") for (int m = 0; m < 4; ++m) _Pragma("unroll") for (int k = 0; k < 2; ++k) dst[m][k] = *(const LAS bf16x8*)(lds + PG8_SA(b, h) + aoff + m * 2048 + k * 1024); } while (0)
#define PG8_LDB(dst, b, h) do { _Pragma("unroll") for (int n = 0; n < 2; ++n) _Pragma("unroll") for (int k = 0; k < 2; ++k) dst[n][k] = *(const LAS bf16x8*)(lds + PG8_SB(b, h) + boff + n * 2048 + k * 1024); } while (0)
#define PG8_MMA(ai, bj, At, Bt) do { __builtin_amdgcn_s_setprio(1); _Pragma("unroll") for (int m = 0; m < 4; ++m) _Pragma("unroll") for (int n = 0; n < 2; ++n) _Pragma("unroll") for (int k = 0; k < 2; ++k) \
        acc[ai][bj][m][n] = __builtin_amdgcn_mfma_f32_16x16x32_bf16(Bt[n][k], At[m][k], acc[ai][bj][m][n], 0, 0, 0); __builtin_amdgcn_s_setprio(0); } while (0)
#define PG8_WAIT_V(n) asm volatile("s_waitcnt vmcnt(" #n ")" ::: "memory")
#define PG8_WAIT_L(n) asm volatile("s_waitcnt lgkmcnt(" #n ")" ::: "memory")
#define PG8_BAR __builtin_amdgcn_s_barrier()
#define PG8_SCHED __builtin_amdgcn_sched_barrier(0)
#define PG8_PA(u) ((const char*)g.A + (size_t)(u).pm * tA + (size_t)((u).pn / g.adiv) * (size_t)g.astride * 2)
#define PG8_PB(u) ((const char*)g.Bt + (size_t)(u).pn * tB)
    Unit cur, nxt; int ui = 0;
    if (!S.next(0, cur)) return;
    f32x4 acc[2][2][4][2];
#pragma unroll
    for (int a = 0; a < 2; ++a)
#pragma unroll
        for (int b = 0; b < 2; ++b)
#pragma unroll
            for (int m = 0; m < 4; ++m)
#pragma unroll
                for (int n = 0; n < 2; ++n) acc[a][b][m][n] = (f32x4){0.f, 0.f, 0.f, 0.f};
    bf16x8 At[4][2], B0[2][2], B1[2][2];
    const char* cA = PG8_PA(cur); const char* cB = PG8_PB(cur);
    PG8_STAGE(PG8_SB(0, 0), cB, voffB); PG8_STAGE(PG8_SB(0, 1), cB + hB, voffB); PG8_STAGE(PG8_SA(0, 0), cA, voffA); PG8_STAGE(PG8_SA(0, 1), cA + hA, voffA);
    if (wr == 1) PG8_BAR;
    PG8_WAIT_V(2); PG8_BAR;
    PG8_STAGE(PG8_SB(1, 0), cB + kstep, voffB); PG8_STAGE(PG8_SA(1, 0), cA + kstep, voffA); PG8_STAGE(PG8_SB(1, 1), cB + hB + kstep, voffB);
    PG8_WAIT_V(6); PG8_BAR;
    for (;;) {
        const bool has_next = S.next(ui + 1, nxt);
        const char* nA = has_next ? PG8_PA(nxt) : cA; const char* nB = has_next ? PG8_PB(nxt) : cB;
        for (int t = 0; t < nt; t += 2) {
            const bool last = (t == nt - 2);
            const char* a1 = cA + (size_t)(t + 1) * kstep;
            const char* a2 = last ? nA : cA + (size_t)(t + 2) * kstep; const char* b2 = last ? nB : cB + (size_t)(t + 2) * kstep;
            const char* a3 = a2 + kstep; const char* b3 = b2 + kstep;
            PG8_LDB(B0, 0, 0); PG8_LDB(B1, 0, 1); PG8_SCHED; PG8_LDA(At, 0, 0); PG8_STAGE(PG8_SA(1, 1), a1 + hA, voffA);
            PG8_WAIT_V(8); PG8_WAIT_L(0); PG8_BAR; PG8_MMA(0, 0, At, B0); PG8_MMA(0, 1, At, B1); PG8_BAR; PG8_SCHED;
            PG8_LDA(At, 0, 1); PG8_STAGE(PG8_SB(0, 0), b2, voffB); PG8_STAGE(PG8_SB(0, 1), b2 + hB, voffB); PG8_STAGE(PG8_SA(0, 0), a2, voffA);
            PG8_WAIT_V(8); PG8_WAIT_L(0); PG8_BAR; PG8_MMA(1, 0, At, B0); PG8_MMA(1, 1, At, B1); PG8_BAR; PG8_SCHED;
            PG8_LDB(B0, 1, 0); PG8_LDB(B1, 1, 1); PG8_SCHED; PG8_LDA(At, 1, 0); PG8_STAGE(PG8_SA(0, 1), a2 + hA, voffA);
            PG8_WAIT_V(8); PG8_WAIT_L(0); PG8_BAR; PG8_MMA(0, 0, At, B0); PG8_MMA(0, 1, At, B1); PG8_BAR; PG8_SCHED;
            PG8_LDA(At, 1, 1); PG8_STAGE(PG8_SB(1, 0), b3, voffB); PG8_STAGE(PG8_SB(1, 1), b3 + hB, voffB); PG8_STAGE(PG8_SA(1, 0), a3, voffA);
            PG8_WAIT_V(8); PG8_WAIT_L(0); PG8_BAR; PG8_MMA(1, 0, At, B0); PG8_MMA(1, 1, At, B1); PG8_BAR; PG8_SCHED;
        }
        if (wr == 0) PG8_BAR;
        E(acc, cur, wr, wc, fr, fq);
        if (!has_next) break;
#pragma unroll
        for (int a = 0; a < 2; ++a)
#pragma unroll
            for (int b = 0; b < 2; ++b)
#pragma unroll
                for (int m = 0; m < 4; ++m)
#pragma unroll
                    for (int n = 0; n < 2; ++n) acc[a][b][m][n] = (f32x4){0.f, 0.f, 0.f, 0.f};
        cur = nxt; cA = nA; cB = nB; ++ui;
        if (wr == 1) PG8_BAR;
    }
    PG8_WAIT_V(0);
    PG8_BAR;
#undef PG8_SA
#undef PG8_SB
#undef PG8_STAGE
#undef PG8_LDA
#undef PG8_LDB
#undef PG8_MMA
#undef PG8_WAIT_V
#undef PG8_WAIT_L
#undef PG8_BAR
#undef PG8_SCHED
#undef PG8_PA
#undef PG8_PB
}
}

namespace attn_body {
using bf16 = __hip_bfloat16;
using s16x4 = __attribute__((ext_vector_type(4))) short;
using f32x16 = __attribute__((ext_vector_type(16))) float;
constexpr int NW = 8, QBLK = 32, QB = QBLK * NW, KVBLK = 64;
constexpr int MA = 0, MB = 1, MC = 2, MD = 3;
__device__ __forceinline__ int crow(int r, int hi) { return (r & 3) + 8 * (r >> 2) + 4 * hi; }
#define SBAR() __builtin_amdgcn_sched_barrier(0)
constexpr int NSLOT = 3, SLOTB = 8192;
constexpr int LDS_K = 0, LDS_V = NSLOT * SLOTB, LDS_WS = 2 * NSLOT * SLOTB, LDS_OST = LDS_WS + NW * 64 * 4, LDS_ATT = LDS_OST + NW * 4096;
typedef __attribute__((address_space(3))) const char* lds_cptr;
typedef __attribute__((address_space(3))) const float* lds_fptr;

struct AttnArgs {
    const bf16* Q; const bf16* K; const bf16* V; bf16* O;
    int qs, ks, os;
    int NT, tlo, thi;
    float s2;
    int q0;
    int kb;
    float* stat; int ss;
    lds_fptr tab;
};

__device__ __forceinline__ void glds16(const void* gsrc, unsigned lds_dst) { unsigned keep;
  asm volatile("s_mov_b32 %0, m0\n\ts_mov_b32 m0, %2\n\ts_nop 0\n\tglobal_load_lds_dwordx4 %1, off\n\ts_mov_b32 m0, %0" : "=&s"(keep) : "v"(gsrc), "s"(lds_dst) : "memory"); }
__device__ __forceinline__ float max3f(float a, float b, float c) { float r; asm("v_max3_f32 %0, %1, %2, %3" : "=v"(r) : "v"(a), "v"(b), "v"(c)); return r; }
__device__ __forceinline__ float max2f(float a, float b) { float r; asm("v_max_f32_e32 %0, %1, %2" : "=v"(r) : "v"(a), "v"(b)); return r; }
__device__ __forceinline__ float fadd_s(float a, float b) { float r; asm("v_add_f32_e32 %0, %1, %2" : "=v"(r) : "v"(a), "v"(b)); return r; }
__device__ __forceinline__ float fsub_s(float a, float b) { float r; asm("v_sub_f32_e32 %0, %1, %2" : "=v"(r) : "v"(a), "v"(b)); return r; }
typedef float f32x2_t __attribute__((ext_vector_type(2))); typedef __bf16 bf16x2_t __attribute__((ext_vector_type(2)));
__device__ __forceinline__ unsigned cvtpk_s(float lo, float hi) { f32x2_t v = {lo, hi}; bf16x2_t b = __builtin_convertvector(v, bf16x2_t); return __builtin_bit_cast(unsigned, b); }
#define WAIT_BAR(N) asm volatile("s_waitcnt vmcnt(" #N ") lgkmcnt(0)\n\ts_barrier" ::: "memory")

__device__ __forceinline__ void qkt(f32x16& p0, f32x16& p1, const char* Kslot, const bf16x8* qr, const f32x16& negm, int r32, int hi) {
  const char* kb = Kslot + hi * 1024 + r32 * 16;
  #pragma unroll
  for (int d0 = 0; d0 < 4; ++d0) {
    const bf16x8 b0 = *reinterpret_cast<const bf16x8*>(kb + d0 * 2048);
    const bf16x8 b1 = *reinterpret_cast<const bf16x8*>(kb + d0 * 2048 + 512);
    if (d0 == 0) { p0 = __builtin_amdgcn_mfma_f32_32x32x16_bf16(b0, qr[0], negm, 0, 0, 0); p1 = __builtin_amdgcn_mfma_f32_32x32x16_bf16(b1, qr[0], negm, 0, 0, 0); }
    else { p0 = __builtin_amdgcn_mfma_f32_32x32x16_bf16(b0, qr[d0], p0, 0, 0, 0); p1 = __builtin_amdgcn_mfma_f32_32x32x16_bf16(b1, qr[d0], p1, 0, 0, 0); } }
}
typedef short v4i16_t __attribute__((ext_vector_type(4)));
__device__ __forceinline__ void kload8(bf16x8* kf, lds_cptr kp) {
  kf[0] = *(const LAS bf16x8*)(kp);        kf[1] = *(const LAS bf16x8*)(kp + 512);
  kf[2] = *(const LAS bf16x8*)(kp + 2048); kf[3] = *(const LAS bf16x8*)(kp + 2560);
  kf[4] = *(const LAS bf16x8*)(kp + 4096); kf[5] = *(const LAS bf16x8*)(kp + 4608);
  kf[6] = *(const LAS bf16x8*)(kp + 6144); kf[7] = *(const LAS bf16x8*)(kp + 6656);
}
__device__ __forceinline__ void kload2(bf16x8* kf, lds_cptr kp, int j) { kf[2 * j] = *(const LAS bf16x8*)(kp + j * 2048); kf[2 * j + 1] = *(const LAS bf16x8*)(kp + j * 2048 + 512); }
__device__ __forceinline__ s16x4 vtr(lds_cptr p) { return __builtin_bit_cast(s16x4, __builtin_amdgcn_ds_read_tr16_b64_v4i16((LAS v4i16_t*)p)); }
__device__ __forceinline__ float rowmax(const f32x16& p0, const f32x16& p1) {
  float a = max3f(p0[0], p0[1], p1[0]), b = max3f(p0[2], p0[3], p1[1]); a = max3f(a, p1[2], p1[3]);
  #pragma unroll
  for (int r = 4; r < 16; r += 4) { a = max3f(a, p0[r], p0[r + 1]); b = max3f(b, p0[r + 2], p0[r + 3]); a = max3f(a, p1[r], p1[r + 1]); b = max3f(b, p1[r + 2], p1[r + 3]); }
  const float m = max2f(a, b);
  auto rr = __builtin_amdgcn_permlane32_swap(__float_as_uint(m), __float_as_uint(m), false, false);
  return max2f(__uint_as_float(rr[0]), __uint_as_float(rr[1]));
}
__device__ __forceinline__ void pv(f32x16* o, int vb, bf16x8 pa0, bf16x8 pa1, bf16x8 pa2, bf16x8 pa3) {
  #pragma unroll
  for (int d0 = 0; d0 < 2; ++d0) { s16x4 lo[4], hi[4];
    #pragma unroll
    for (int ks = 0; ks < 4; ++ks) {
      asm volatile("ds_read_b64_tr_b16 %0,%1 offset:%c2" : "=&v"(lo[ks]) : "v"(vb), "i"(d0 * 4096 + ks * 1024) : "memory");
      asm volatile("ds_read_b64_tr_b16 %0,%1 offset:%c2" : "=&v"(hi[ks]) : "v"(vb), "i"(d0 * 4096 + ks * 1024 + 512) : "memory"); }
    asm volatile("s_waitcnt lgkmcnt(0)" ::: "memory"); SBAR();
    #define PK(k) (bf16x8){lo[k][0], lo[k][1], lo[k][2], lo[k][3], hi[k][0], hi[k][1], hi[k][2], hi[k][3]}
    o[d0] = __builtin_amdgcn_mfma_f32_32x32x16_bf16(pa0, PK(0), o[d0], 0, 0, 0);
    o[d0] = __builtin_amdgcn_mfma_f32_32x32x16_bf16(pa1, PK(1), o[d0], 0, 0, 0);
    o[d0] = __builtin_amdgcn_mfma_f32_32x32x16_bf16(pa2, PK(2), o[d0], 0, 0, 0);
    o[d0] = __builtin_amdgcn_mfma_f32_32x32x16_bf16(pa3, PK(3), o[d0], 0, 0, 0);
    #undef PK
  }
}

template <int MODE> __device__ __forceinline__ void score_hook(f32x16& c0, f32x16& c1, int t, const AttnArgs& a, int qrel, int hi, int wid, int r32, float mh) {
  if constexpr (MODE == MA) {
    const int wlo = a.q0 + wid * QBLK, sd = (64 * t + 63 < wlo) ? 1 : ((64 * t > wlo + 31) ? -1 : 0);
    if (sd != 0) { const float sv = (float)sd * a.s2;
      #pragma unroll
      for (int r = 0; r < 16; ++r) { const float kf = (float)((r & 3) + 8 * (r >> 2)); c0[r] = fmaf(kf, sv, c0[r]); c1[r] = fmaf(kf + 32.f, sv, c1[r]); if ((r & 3) == 3) __builtin_amdgcn_sched_barrier(0); }
    } else {
      const float dq = (float)(a.q0 + qrel - 64 * t - 4 * hi), ns = -a.s2;
      #pragma unroll
      for (int r = 0; r < 16; ++r) { const float kf = (float)((r & 3) + 8 * (r >> 2)); c0[r] = fmaf(ns, fabsf(dq - kf), c0[r]); c1[r] = fmaf(ns, fabsf(dq - (kf + 32.f)), c1[r]); if ((r & 1) == 1) __builtin_amdgcn_sched_barrier(0); }
    }
  }
  if constexpr (MODE == MB) {
    const bool tv = (t >= a.tlo) && (t <= a.thi);
    const float dq = (float)(qrel + 64 - 64 * t - 4 * hi), ns = -a.s2;
    #pragma unroll
    for (int r = 0; r < 16; ++r) { const float kf = (float)((r & 3) + 8 * (r >> 2)); const float d0 = fabsf(dq - kf), d1 = fabsf(dq - (kf + 32.f));
      c0[r] = (tv && d0 <= 64.f) ? fmaf(ns, d0, c0[r] - mh) : -INFINITY; c1[r] = (tv && d1 <= 64.f) ? fmaf(ns, d1, c1[r] - mh) : -INFINITY;
      if ((r & 3) == 3) __builtin_amdgcn_sched_barrier(0); }
  }
  if constexpr (MODE == MC) {
    const int qrow = a.q0 + (wid >> 1), rs = min(max(qrow - 4, 0), 120), krow = a.kb + t;
    if (krow < rs || krow >= rs + 8) {
      #pragma unroll
      for (int r = 0; r < 16; ++r) { c0[r] = -INFINITY; c1[r] = -INFINITY; }
    } else {
      const int qc = (wid & 1) * 32 + r32, cs = min(max(qc - 8, 0), 48);
      const lds_fptr tp = a.tab + (krow - qrow + 7) * 31 + (15 - qc + 4 * hi);
      const int kd = 4 * hi - cs;
      #pragma unroll
      for (int r = 0; r < 16; ++r) { const int kc = (r & 3) + 8 * (r >> 2);
        const float b0 = tp[kc], b1 = tp[kc + 32];
        c0[r] = ((unsigned)(kd + kc) < 16u) ? c0[r] + (b0 - mh) : -INFINITY; c1[r] = ((unsigned)(kd + kc + 32) < 16u) ? c1[r] + (b1 - mh) : -INFINITY;
        if ((r & 3) == 3) __builtin_amdgcn_sched_barrier(0); }
    }
  }
}

template <int MODE, int THRL> __device__ __forceinline__ void attn_unit(const AttnArgs& A_, char* shm) {
  int tid_ = threadIdx.x; asm volatile("" : "+v"(tid_));
  const int tid = tid_, lane = tid & 63, r32 = lane & 31, hi = lane >> 5; const int wid = __builtin_amdgcn_readfirstlane(tid >> 6);
  const bf16* Qw = A_.Q + (wid * QBLK) * A_.qs;
  const unsigned lds0 = (unsigned)(uintptr_t)shm;
  float* wsf = (float*)(shm + LDS_WS) + wid * 64;
  const int ks = A_.ks;
  const bf16* ksrc = A_.K + (lane * ks + wid * 8);
  const bf16* vsrc = A_.V + ((16 * (wid & 3) + (lane >> 2)) * ks + (wid >> 2) * 32 + (lane & 3) * 8);
  const unsigned kdst = lds0 + LDS_K + wid * 1024, vdst = lds0 + LDS_V + wid * 1024;
  #define TT(t) ((MODE == MB) ? min(max((int)(t), A_.tlo), A_.thi) : (int)(t))
  #define DMA_K(t, slot) glds16(ksrc + TT(t) * KVBLK * ks, (unsigned)__builtin_amdgcn_readfirstlane(kdst + (slot)))
  #define DMA_V(t, slot) glds16(vsrc + TT(t) * KVBLK * ks, (unsigned)__builtin_amdgcn_readfirstlane(vdst + (slot)))
  const int vb0 = (int)(lds0 + LDS_V) + ((lane >> 4) & 1) * 32 + (lane & 3) * 8 + (4 * hi + ((lane & 15) >> 2)) * 64;
  const char* Kbase = shm + LDS_K; bf16x8 kf[8];
  const lds_cptr shm3 = (lds_cptr)shm; const lds_cptr kp0 = shm3 + LDS_K + hi * 1024 + r32 * 16; const lds_cptr vp0 = shm3 + LDS_V + ((lane >> 4) & 1) * 32 + (lane & 3) * 8 + (4 * hi + ((lane & 15) >> 2)) * 64;
  const int NT = A_.NT;
  DMA_K(0, 0); DMA_V(0, 0); DMA_K(1, SLOTB);
  bf16x8 qr[4];
  #pragma unroll
  for (int d0 = 0; d0 < 4; ++d0) qr[d0] = *reinterpret_cast<const bf16x8*>(&Qw[r32 * A_.qs + d0 * 16 + hi * 8]);
  float mhat = 0.f, l_reg = 0.f; f32x16 o[2]; o[0] = f32x16{}; o[1] = f32x16{}; f32x16 negm = f32x16{}; asm volatile("" : "+v"(negm));
  const int qrel = wid * QBLK + r32;
  constexpr bool NEGM = (MODE == MA || MODE == MD);
  #define CIN (NEGM ? negm : f32x16{})
  #define NEGM_SET(tn) do { float nb_ = -mhat; \
      if (MODE == MA) { const int wlo_ = A_.q0 + wid * QBLK, sd_ = (64 * (tn) + 63 < wlo_) ? 1 : ((64 * (tn) > wlo_ + 31) ? -1 : 0); \
        if (sd_ != 0) nb_ = fmaf(-(float)sd_ * A_.s2, (float)(A_.q0 + qrel - 64 * (tn) - 4 * hi), nb_); } \
      _Pragma("unroll") for (int r = 0; r < 16; ++r) negm[r] = nb_; asm volatile("" : "+v"(negm)); } while (0)
  #define CMASK(P0, P1, t) score_hook<MODE>(P0, P1, (t), A_, qrel, hi, wid, r32, mhat)
  bool resc = false;
  #define START(P0, P1) do { const float rm = rowmax(P0, P1); resc = false; \
    { const float dl = (MODE == MB || MODE == MC) ? fmaxf(rm, -2048.f) : rm; mhat = fadd_s(mhat, dl); \
      _Pragma("unroll") for (int r = 0; r < 16; ++r) { P0[r] = fsub_s(P0[r], dl); P1[r] = fsub_s(P1[r], dl); } \
      if (NEGM) { NEGM_SET(1); } } \
    _Pragma("unroll") for (int r = 0; r < 16; ++r) P0[r] = __builtin_amdgcn_exp2f(P0[r]); } while (0)
  #define RESC() do { if (resc) { asm volatile("s_waitcnt lgkmcnt(0)" ::: "memory"); \
      _Pragma("unroll") for (int d_ = 0; d_ < 2; ++d_) _Pragma("unroll") for (int r = 0; r < 16; ++r) o[d_][r] *= wsf[crow(r, hi)]; } } while (0)
  f32x16 pA0, pA1, pB0, pB1;
  int sl_prev = 0, sl_cur = 0, sl_next = SLOTB;
  #define ROT() do { sl_prev = sl_cur; sl_cur = sl_next; sl_next = (sl_next == (NSLOT - 1) * SLOTB) ? 0 : sl_next + SLOTB; } while (0)
  DMA_K(2, 2 * SLOTB);
  if (MODE == MA) { NEGM_SET(0); }
  WAIT_BAR(3);
  qkt(pA0, pA1, Kbase, qr, negm, r32, hi); asm volatile("s_nop 15\n\ts_nop 7" : "+v"(pA0), "+v"(pA1)); CMASK(pA0, pA1, 0);
  START(pA0, pA1);
  _Pragma("unroll") for (int r = 0; r < 16; ++r) pA1[r] = __builtin_amdgcn_exp2f(pA1[r]);
  WAIT_BAR(0);
  DMA_K(3, 0); DMA_V(1, SLOTB);
  ROT();
  kload8(kf, kp0 + sl_cur);
  WAIT_BAR(2);
  s16x4 vlo[8], vhi[8]; u32x4 pw0, pw1, pw2, pw3;
  #define PKW(P, B) cvtpk_s(P[B], P[B + 1])
  #define PAF(k) __builtin_bit_cast(bf16x8, pw##k)
  #define VFR(i) (bf16x8){vlo[i][0], vlo[i][1], vlo[i][2], vlo[i][3], vhi[i][0], vhi[i][1], vhi[i][2], vhi[i][3]}
  #define PIN(x) asm volatile("" : "+v"(x))
  #define MX3(a, b, c) __builtin_fmaxf(__builtin_fmaxf((a), (b)), (c))
  #define GAPA(MF, A0, A1, A2, A3, W0, W1, PW) do { MF; sacc += A0; sacc += A1; sacc += A2; sacc += A3; PIN(sacc); W0; W1; PIN(PW); SBAR(); } while (0)
  #define EX(v) __builtin_amdgcn_exp2f(v)
  #define GAPB(MF, X, B) do { MF; X[B] = EX(X[B]); X[B + 1] = EX(X[B + 1]); X[B + 2] = EX(X[B + 2]); X[B + 3] = EX(X[B + 3]); PIN(X); SBAR(); } while (0)
  #define VRD(i) do { vlo[i] = vtr(vp_ + (((i) >> 2) * 4096 + ((i) & 3) * 1024)); vhi[i] = vtr(vp_ + (((i) >> 2) * 4096 + ((i) & 3) * 1024 + 512)); } while (0)
  #define KRD(G, j) do { if (G) { kload2(kf, kp0 + sl_next, j); SBAR(); } } while (0)
  #define STEP(C0, C1, P0, P1, t, GK, GV, GL) do { SBAR(); \
    const lds_cptr vp_ = vp0 + sl_prev; \
    VRD(0); SBAR(); float sacc = (P0[0] + P0[1]); \
    GAPA(C0 = __builtin_amdgcn_mfma_f32_32x32x16_bf16(kf[0], qr[0], CIN, 0, 0, 0), P0[2], P0[3], P0[4], P0[5],     pw0[0] = PKW(P0, 0), pw0[1] = PKW(P0, 2), pw0); \
    VRD(4); SBAR(); GAPA(C1 = __builtin_amdgcn_mfma_f32_32x32x16_bf16(kf[1], qr[0], CIN, 0, 0, 0), P0[6], P0[7], P0[8], P0[9],     pw0[2] = PKW(P0, 4), pw0[3] = PKW(P0, 6), pw0); \
    VRD(1); SBAR(); GAPA(C0 = __builtin_amdgcn_mfma_f32_32x32x16_bf16(kf[2], qr[1], C0, 0, 0, 0),   P0[10], P0[11], P0[12], P0[13], pw1[0] = PKW(P0, 8), pw1[1] = PKW(P0, 10), pw1); \
    VRD(5); SBAR(); GAPA(C1 = __builtin_amdgcn_mfma_f32_32x32x16_bf16(kf[3], qr[1], C1, 0, 0, 0),   P0[14], P0[15], P1[0], P1[1],   pw1[2] = PKW(P0, 12), pw1[3] = PKW(P0, 14), pw1); \
    VRD(2); SBAR(); GAPA(C0 = __builtin_amdgcn_mfma_f32_32x32x16_bf16(kf[4], qr[2], C0, 0, 0, 0),   P1[2], P1[3], P1[4], P1[5],     pw2[0] = PKW(P1, 0), pw2[1] = PKW(P1, 2), pw2); \
    VRD(6); SBAR(); GAPA(C1 = __builtin_amdgcn_mfma_f32_32x32x16_bf16(kf[5], qr[2], C1, 0, 0, 0),   P1[6], P1[7], P1[8], P1[9],     pw2[2] = PKW(P1, 4), pw2[3] = PKW(P1, 6), pw2); \
    VRD(3); SBAR(); GAPA(C0 = __builtin_amdgcn_mfma_f32_32x32x16_bf16(kf[6], qr[3], C0, 0, 0, 0),   P1[10], P1[11], P1[12], P1[13], pw3[0] = PKW(P1, 8), pw3[1] = PKW(P1, 10), pw3); \
    VRD(7); SBAR(); GAPA(C1 = __builtin_amdgcn_mfma_f32_32x32x16_bf16(kf[7], qr[3], C1, 0, 0, 0),   P1[14], P1[15], 0.f, 0.f,       pw3[2] = PKW(P1, 12), pw3[3] = PKW(P1, 14), pw3); \
    l_reg += sacc; \
    if (GK) { DMA_K((t) + 3, sl_cur); } if (GV) { DMA_V((t) + 1, sl_next); } \
    CMASK(C0, C1, t); \
    { float a = MX3(C0[0], C0[1], C1[0]), b = MX3(C0[2], C0[3], C1[1]); a = MX3(a, C1[2], C1[3]); \
      _Pragma("unroll") for (int r = 4; r < 16; r += 4) { a = MX3(a, C0[r], C0[r + 1]); b = MX3(b, C0[r + 2], C0[r + 3]); a = MX3(a, C1[r], C1[r + 1]); b = MX3(b, C1[r + 2], C1[r + 3]); } \
      float rm = __builtin_fmaxf(a, b); { auto rr = __builtin_amdgcn_permlane32_swap(__float_as_uint(rm), __float_as_uint(rm), false, false); rm = __builtin_fmaxf(__uint_as_float(rr[0]), __uint_as_float(rr[1])); } \
      resc = false; \
      if (__builtin_expect(__any(rm > (float)THRL), 0)) { const float dl = __builtin_fmaxf(rm, 0.f); mhat += dl; \
        _Pragma("unroll") for (int r = 0; r < 16; ++r) { C0[r] -= dl; C1[r] -= dl; } \
        if (MODE == MD) { NEGM_SET(0); } \
        const float f = __builtin_amdgcn_exp2f(-dl); l_reg *= f; if (hi == 0) wsf[r32] = f; resc = true; } \
      if (MODE == MA) { NEGM_SET((t) + 1); } } \
    SBAR(); \
    GAPB(o[0] = __builtin_amdgcn_mfma_f32_32x32x16_bf16(PAF(0), VFR(0), o[0], 0, 0, 0), C0, 0); \
    GAPB(o[1] = __builtin_amdgcn_mfma_f32_32x32x16_bf16(PAF(0), VFR(4), o[1], 0, 0, 0), C0, 4); \
    KRD(GL, 0); GAPB(o[0] = __builtin_amdgcn_mfma_f32_32x32x16_bf16(PAF(1), VFR(1), o[0], 0, 0, 0), C0, 8); \
    KRD(GL, 1); GAPB(o[1] = __builtin_amdgcn_mfma_f32_32x32x16_bf16(PAF(1), VFR(5), o[1], 0, 0, 0), C0, 12); \
    KRD(GL, 2); GAPB(o[0] = __builtin_amdgcn_mfma_f32_32x32x16_bf16(PAF(2), VFR(2), o[0], 0, 0, 0), C1, 0); \
    KRD(GL, 3); GAPB(o[1] = __builtin_amdgcn_mfma_f32_32x32x16_bf16(PAF(2), VFR(6), o[1], 0, 0, 0), C1, 4); \
    GAPB(o[0] = __builtin_amdgcn_mfma_f32_32x32x16_bf16(PAF(3), VFR(3), o[0], 0, 0, 0), C1, 8); \
    GAPB(o[1] = __builtin_amdgcn_mfma_f32_32x32x16_bf16(PAF(3), VFR(7), o[1], 0, 0, 0), C1, 12); \
    } while (0)
  int t = 1;
  for (; t + 5 < NT; t += 2) {
    STEP(pB0, pB1, pA0, pA1, t, true, true, true);     WAIT_BAR(2); RESC(); ROT();
    STEP(pA0, pA1, pB0, pB1, t + 1, true, true, true); WAIT_BAR(2); RESC(); ROT();
  }
  #define ENDW(tt) do { if ((tt) + 3 < NT) { WAIT_BAR(2); } else if ((tt) + 2 < NT) { WAIT_BAR(1); } else { WAIT_BAR(0); } } while (0)
  for (; t + 1 < NT; t += 2) {
    STEP(pB0, pB1, pA0, pA1, t, (t + 3 < NT), (t + 1 < NT), (t + 1 < NT));         ENDW(t);     RESC(); ROT();
    STEP(pA0, pA1, pB0, pB1, t + 1, (t + 4 < NT), (t + 2 < NT), (t + 2 < NT));     ENDW(t + 1); RESC(); ROT();
  }
  STEP(pB0, pB1, pA0, pA1, NT - 1, false, false, false); RESC();
  { float sacc = pB0[0] + pB0[1]; _Pragma("unroll") for (int r = 2; r < 16; ++r) sacc += pB0[r]; _Pragma("unroll") for (int r = 0; r < 16; ++r) sacc += pB1[r]; l_reg += sacc;
    pw0 = (u32x4){PKW(pB0, 0), PKW(pB0, 2), PKW(pB0, 4), PKW(pB0, 6)}; pw1 = (u32x4){PKW(pB0, 8), PKW(pB0, 10), PKW(pB0, 12), PKW(pB0, 14)}; pw2 = (u32x4){PKW(pB1, 0), PKW(pB1, 2), PKW(pB1, 4), PKW(pB1, 6)}; pw3 = (u32x4){PKW(pB1, 8), PKW(pB1, 10), PKW(pB1, 12), PKW(pB1, 14)};
    SBAR(); pv(o, vb0 + sl_cur, PAF(0), PAF(1), PAF(2), PAF(3)); }
  #undef PKW
  #undef PAF
  #undef VFR
  #undef PIN
  #undef MX3
  #undef GAPA
  #undef GAPB
  #undef EX
  #undef VRD
  #undef KRD
  #undef STEP
  #undef ENDW
  { auto rr = __builtin_amdgcn_permlane32_swap(__float_as_uint(l_reg), __float_as_uint(l_reg), false, false); l_reg = __uint_as_float(rr[0]) + __uint_as_float(rr[1]); }
  if (MODE == MB) { if (hi == 0) { float* sp = A_.stat + (wid * QBLK + r32) * A_.ss; sp[0] = mhat; sp[1] = l_reg; } }
  if (hi == 0) wsf[32 + r32] = l_reg; asm volatile("s_waitcnt lgkmcnt(0)" ::: "memory");
  float rli[16];
  #pragma unroll
  for (int r = 0; r < 16; ++r) rli[r] = __builtin_amdgcn_rcpf(wsf[32 + crow(r, hi)]);
  bf16* Ow = A_.O + (wid * QBLK) * A_.os;
  { bf16* stg = (bf16*)(shm + LDS_OST) + wid * 2048;
    #pragma unroll
    for (int r = 0; r < 16; ++r) { const int orow = crow(r, hi);
      #pragma unroll
      for (int d0 = 0; d0 < 2; ++d0) stg[orow * 64 + d0 * 32 + r32] = __float2bfloat16(o[d0][r] * rli[r]); }
    asm volatile("s_waitcnt lgkmcnt(0)" ::: "memory");
    #pragma unroll
    for (int i = 0; i < 4; ++i) { const int row = i * 8 + (lane >> 3), ch = lane & 7; const u32x4 v = *(const u32x4*)(stg + row * 64 + ch * 8); *(u32x4*)(Ow + row * A_.os + ch * 8) = v; } }
  asm volatile("s_waitcnt lgkmcnt(0)\n\ts_barrier" ::: "memory");
  #undef DMA_K
  #undef DMA_V
  #undef TT
  #undef CMASK
  #undef CIN
  #undef NEGM_SET
  #undef START
  #undef RESC
  #undef ROT
}
#undef SBAR
#undef WAIT_BAR
}

__device__ __forceinline__ void transpose_item(const float* W, int K, int N, bf16_t* WT, LAS float* scr, int item, int lane) {
    const int nblk = N / 32, kb = item / nblk, nb = item % nblk, k0 = 64 * kb, n0 = 32 * nb;
#pragma unroll 8
    for (int i = 0; i < 32; ++i) { const int kk = 2 * i + (lane >> 5); scr[kk * 33 + (lane & 31)] = W[(size_t)(k0 + kk) * N + n0 + (lane & 31)]; }
    asm volatile("s_waitcnt lgkmcnt(0)" ::: "memory");
    const int c = lane & 7;
#pragma unroll
    for (int j = 0; j < 4; ++j) { const int n = (lane >> 3) + 8 * j; const LAS float* s = scr + (8 * c) * 33 + n;
        u32x4 o; o.x = pk2(s[0 * 33], s[1 * 33]); o.y = pk2(s[2 * 33], s[3 * 33]); o.z = pk2(s[4 * 33], s[5 * 33]); o.w = pk2(s[6 * 33], s[7 * 33]);
        *(u32x4*)(WT + (size_t)(n0 + n) * K + k0 + 8 * c) = o; }
    asm volatile("s_waitcnt lgkmcnt(0)" ::: "memory");
}
__device__ __forceinline__ void rms_row_bf16(const float* xrow, const float* g, bf16_t* orow, int lane) {
    const f32x4* xr = (const f32x4*)xrow + lane; const f32x4* gr = (const f32x4*)g + lane;
    f32x4 v[4]; float s = 0.f;
#pragma unroll
    for (int j = 0; j < 4; ++j) { v[j] = xr[64 * j]; s += (v[j].x * v[j].x + v[j].y * v[j].y) + (v[j].z * v[j].z + v[j].w * v[j].w); }
    const float rs = rsqrtf(wave_sum(s) * (1.f / DM) + EPS);
    u32x2* o8 = (u32x2*)orow + lane;
#pragma unroll
    for (int j = 0; j < 4; ++j) { const f32x4 gg = gr[64 * j]; u32x2 w; w.x = pk2(v[j].x * rs * gg.x, v[j].y * rs * gg.y); w.y = pk2(v[j].z * rs * gg.z, v[j].w * rs * gg.w); o8[64 * j] = w; }
}
__device__ __forceinline__ void sincos_red(float a, float& s, float& c) {
    const float q = rintf(a * 0.636619772367581f); const int iq = (int)q;
    float r = fmaf(q, -1.5703125f, a); r = fmaf(q, -4.837512969970703125e-4f, r); r = fmaf(q, -7.54978995489188216e-8f, r);
    const float r2 = r * r;
    const float sp = r + r * r2 * (-1.6666654611e-1f + r2 * (8.3321608736e-3f + r2 * (-1.9515295891e-4f)));
    const float cp = 1.0f - 0.5f * r2 + r2 * r2 * (4.166664568298827e-2f + r2 * (-1.388731625493765e-3f + r2 * 2.443315711809948e-5f));
    const int k = iq & 3;
    s = (k == 0) ? sp : (k == 1) ? cp : (k == 2) ? -sp : -cp;
    c = (k == 0) ? cp : (k == 1) ? -sp : (k == 2) ? -cp : sp;
}

#define XB_TMO      128
#define XB_XCNT(j)  (256  + 64 * (j))
#define XB_XSUB(j)  (1280 + 64 * (j))
#define XB_XGEN(j)  (2304 + 64 * (j))
#define XB_TOP      3328
#define XB_TOPGEN   3392
#define XCD_BAR_WORDS 3456
#define XB_SPIN_CAP (1u << 18)

__device__ __forceinline__ unsigned xb_ld(unsigned* p)              { return __hip_atomic_load(p, __ATOMIC_RELAXED, __HIP_MEMORY_SCOPE_AGENT); }
__device__ __forceinline__ unsigned xb_add(unsigned* p, unsigned v) { return __hip_atomic_fetch_add(p, v, __ATOMIC_RELAXED, __HIP_MEMORY_SCOPE_AGENT); }
__device__ __forceinline__ unsigned xb_xcc_id() { return (unsigned)__builtin_amdgcn_s_getreg((3 << 11) | 20) & 0xFu; }
#define XB_SPIN(cond, bar) do { unsigned _sp = 0; while (cond) { __builtin_amdgcn_s_sleep(1); \
    if ((++_sp & 255u) == 0u) { if (xb_ld(&(bar)[XB_TMO])) break; if (_sp > XB_SPIN_CAP) { atomicAdd(&(bar)[XB_TMO], 1u); break; } } } } while (0)

struct XcdBarrier {
    unsigned* bar; unsigned x;
    volatile LAS unsigned* st;
};

__device__ __forceinline__ XcdBarrier xcd_barrier_post(unsigned* bar, volatile LAS unsigned* st) {
    XcdBarrier b; b.bar = bar; b.x = xb_xcc_id(); b.st = st;
    if (threadIdx.x == 0) (void)xb_add(&bar[XB_XCNT(b.x)], 1u);
    return b;
}
__device__ __forceinline__ void xcd_barrier_complete(unsigned* bar, unsigned x, unsigned& nloc, unsigned& nx) {
    const unsigned G = gridDim.x * gridDim.y * gridDim.z;
    unsigned sum, cnt, mine, sp = 0u;
    for (;;) {
        sum = 0u; cnt = 0u; mine = 0u;
#pragma unroll
        for (unsigned j = 0; j < 16; ++j) { const unsigned c = xb_ld(&bar[XB_XCNT(j)]); sum += c; cnt += (c > 0u) ? 1u : 0u; mine = (j == x) ? c : mine; }
        if (sum == G) break;
        __builtin_amdgcn_s_sleep(1);
        if ((++sp & 255u) == 0u) { if (xb_ld(&bar[XB_TMO])) break; if (sp > XB_SPIN_CAP) { atomicAdd(&bar[XB_TMO], 1u); break; } }
    }
    nloc = mine > 0u ? mine : 1u; nx = cnt > 0u ? cnt : 1u;
}

__device__ __forceinline__ void xcd_barrier(const XcdBarrier& b) {
    asm volatile("s_waitcnt vmcnt(0)" ::: "memory");
    __syncthreads();
    if (threadIdx.x == 0) {
        unsigned* bar = b.bar;
        __builtin_amdgcn_s_waitcnt(0);
        unsigned nloc = b.st[0], nx = b.st[1];
        if (nloc == 0u) { xcd_barrier_complete(bar, b.x, nloc, nx); b.st[0] = nloc; b.st[1] = nx; }
        const unsigned old = xb_add(&bar[XB_XSUB(b.x)], 1u);
        const unsigned gen = old / nloc;
        if (old + 1u == (gen + 1u) * nloc) {
            __builtin_amdgcn_fence(__ATOMIC_RELEASE, "agent");
            asm volatile("s_waitcnt vmcnt(0)" ::: "memory");
            const unsigned og = xb_add(&bar[XB_TOP], 1u);
            const unsigned tg = og / nx;
            if (og + 1u == (tg + 1u) * nx) xb_add(&bar[XB_TOPGEN], 1u);
            else XB_SPIN(xb_ld(&bar[XB_TOPGEN]) == tg, bar);
            __builtin_amdgcn_fence(__ATOMIC_ACQUIRE, "agent");
            xb_add(&bar[XB_XGEN(b.x)], 1u);
            asm volatile("s_waitcnt vmcnt(0)" ::: "memory");
        } else {
            XB_SPIN(xb_ld(&bar[XB_XGEN(b.x)]) == gen, bar);
            __builtin_amdgcn_fence(__ATOMIC_ACQUIRE, "agent");
            asm volatile("s_waitcnt vmcnt(0)" ::: "memory");
        }
    }
    __syncthreads();
}


struct Args { const float* in[14]; float* out; unsigned char* ws; };

__global__ void __launch_bounds__(512) mk_fwd(Args args) {
    extern __shared__ __attribute__((aligned(16))) unsigned char lds[];
    cg::grid_group grid = cg::this_grid();
    const int tid0 = threadIdx.x, wave = __builtin_amdgcn_readfirstlane(tid0 >> 6);
#define FRESH_LANE() int tid = tid0; asm volatile("" : "+v"(tid)); const int lane = tid & 63
    const int G = gridDim.x, bx = blockIdx.x;
    const int vcu = (G % 8 == 0) ? (bx % 8) * (G / 8) + bx / 8 : bx;
    const int gw = vcu * 8 + wave, NGW = G * 8;
    LAS unsigned char* ldsl = (LAS unsigned char*)lds;
    if (tid0 < 8) ((LAS unsigned*)(ldsl + MISC_OFF))[tid0] = 0u;
    __syncthreads();
    const XcdBarrier xbar = xcd_barrier_post((unsigned*)(args.ws + WS_BAR), (volatile LAS unsigned*)(ldsl + MISC_OFF));
#define ws (args.ws)
#define x_in (args.in[0])
#define norm_mix (args.in[1])
#define w_in (args.in[2])
#define b_gate (args.in[3])
#define diff_lambda (args.in[4])
#define diff_subln (args.in[5])
#define na_rpb (args.in[6])
#define qk_norm (args.in[7])
#define w_branch (args.in[8])
#define w_out (args.in[9])
#define norm_ffn (args.in[10])
#define w_ff1 (args.in[11])
#define w_ff2 (args.in[12])
#define norm_final (args.in[13])
#define xout (args.out)
#define WinT ((bf16_t*)(ws + WS_WIN))
#define WbrT ((bf16_t*)(ws + WS_WBR))
#define WoutT ((bf16_t*)(ws + WS_WOUT))
#define W1T ((bf16_t*)(ws + WS_W1))
#define W2T ((bf16_t*)(ws + WS_W2))
#define STAT ((float*)(ws + WS_STAT))
#define H ((bf16_t*)(ws + WS_H))
#define ATMP ((bf16_t*)(ws + WS_ATMP))
#define BTMP ((bf16_t*)(ws + WS_BTMP))
#define Y ((bf16_t*)(ws + WS_Y))
#define MERGED ((bf16_t*)(ws + WS_MERGED))
#define Z ((bf16_t*)(ws + WS_Z))
#define U ((bf16_t*)(ws + WS_Z))
#define PROJ ((bf16_t*)(ws + WS_PROJ))
#define NRMQ ((unsigned*)(ws + WS_NRM))
#define NRMK ((unsigned*)(ws + WS_NRM) + 1024)

    {
        FRESH_LANE();
        LAS float* scr = (LAS float*)(ldsl + wave * 16384);
        constexpr int I_IN = (DM / 64) * (INW / 32), I_BR = (512 / 64) * (DM / 32), I_OUT = (DM / 64) * (DM / 32), I_1 = (DM / 64) * (DFF / 32), I_2 = (DFF / 64) * (DM / 32);
        constexpr int NITEMS = 2 * I_IN + 8 * I_BR + 2 * I_OUT + 2 * I_1 + 2 * I_2;
        for (int it = gw; it < NITEMS; it += NGW) {
            int r = it;
            if (r < 2 * I_IN) { const int l = r / I_IN; transpose_item(w_in + (size_t)l * DM * INW, DM, INW, WinT + (size_t)l * INW * DM, scr, r % I_IN, lane); continue; } r -= 2 * I_IN;
            if (r < 8 * I_BR) { const int ln = r / I_BR; transpose_item(w_branch + (size_t)ln * 512 * DM, 512, DM, WbrT + (size_t)ln * DM * 512, scr, r % I_BR, lane); continue; } r -= 8 * I_BR;
            if (r < 2 * I_OUT) { const int l = r / I_OUT; transpose_item(w_out + (size_t)l * DM * DM, DM, DM, WoutT + (size_t)l * DM * DM, scr, r % I_OUT, lane); continue; } r -= 2 * I_OUT;
            if (r < 2 * I_1) { const int l = r / I_1; transpose_item(w_ff1 + (size_t)l * DM * DFF, DM, DFF, W1T + (size_t)l * DFF * DM, scr, r % I_1, lane); continue; } r -= 2 * I_1;
            { const int l = r / I_2; transpose_item(w_ff2 + (size_t)l * DFF * DM, DFF, DM, W2T + (size_t)l * DM * DFF, scr, r % I_2, lane); }
        }
        for (int m = gw; m < TG; m += NGW) rms_row_bf16(x_in + (size_t)m * DM, norm_mix, H + (size_t)m * DM, lane);
    }
    grid.sync();

    for (int l = 0; l < DEPTH; ++l) {
        const float lam_init = 0.8f - 0.6f * __expf(-0.3f * (float)l);
        float lam;
        { FRESH_LANE(); const float* lp = diff_lambda + l * 256; const float a = lp[lane] * lp[64 + lane], b = lp[128 + lane] * lp[192 + lane]; lam = expf(wave_sum(a)) - expf(wave_sum(b)) + lam_init; lam = __uint_as_float(__builtin_amdgcn_readfirstlane(__float_as_uint(lam))); }
        const float out_scale = 1.f - lam_init;
        { FRESH_LANE(); LAS float* tab = (LAS float*)(ldsl + TAB_OFF); for (int i = tid; i < 8 * 465; i += 512) tab[i] = na_rpb[l * 8 * 465 + i] * LOG2E; }
        __syncthreads();
        for (int grp = 0; grp < NGRP; ++grp) {
            const size_t tok0 = (size_t)grp * TG;
            const float* xsrc = (l == 0) ? x_in : xout;
            {
                pg8::Gemm g{H, WinT + (size_t)l * INW * DM, DM, DM, DM, 1 << 30, 0}; pg8::StaticOrder S; S.init(TG, INW, G, bx);
                if (bx == 0) { for (int i = tid0; i < 1024 + 16; i += 512) NRMQ[i] = 0u; }
                pg8::Epi<0> E{PROJ, nullptr, nullptr, b_gate + l * 4096, INW};
                pg8::gemm_phase(ldsl, g, S, E);
            }
            xcd_barrier(xbar);
            {
                FRESH_LANE();
                const float inv = exp2f(-(float)(lane & 15) * 0.8304820237218406f);
                const float gq = qk_norm[l * 128 + lane], gk = qk_norm[l * 128 + 64 + lane];
                const int per = (TG + NGW - 1) / NGW;
                float mq = 0.f, mk = 0.f; int cu = -1;
                for (int i = 0; i < per; ++i) {
                    const int m = gw * per + i; if (m >= TG) break;
                    if ((m >> 8) != cu) { if (cu >= 0 && (lane & 7) == 0) { atomicMax(NRMQ + cu * 8 + (lane >> 3), __float_as_uint(mq)); atomicMax(NRMK + (cu >> 5) * 8 + (lane >> 3), __float_as_uint(mk)); } cu = m >> 8; mq = 0.f; mk = 0.f; }
                    const int s = (int)((tok0 + m) % SEQ); const float pos = (float)((lane < 32) ? (s >> 6) : (s & 63));
                    float sn, cs; sincos_red(pos * inv, sn, cs);
                    { const bf16_t* ar = PROJ + (size_t)m * INW; const u32x4 qv = *(const u32x4*)(ar + COL_AQ + lane * 8), kv = *(const u32x4*)(ar + COL_AK + lane * 8);
                      float nq = 0.f, nk = 0.f;
#pragma unroll
                      for (int e = 0; e < 4; ++e) { nq += bflo(qv[e]) * bflo(qv[e]) + bfhi(qv[e]) * bfhi(qv[e]); nk += bflo(kv[e]) * bflo(kv[e]) + bfhi(kv[e]) * bfhi(kv[e]); }
                      nq += __shfl_xor(nq, 1); nk += __shfl_xor(nk, 1); nq += __shfl_xor(nq, 2); nk += __shfl_xor(nk, 2); nq += __shfl_xor(nq, 4); nk += __shfl_xor(nk, 4);
                      mq = fmaxf(mq, sqrtf(nq)); mk = fmaxf(mk, sqrtf(nk)); }
                    bf16_t* row = PROJ + (size_t)m * INW + COL_DQ;
#pragma unroll
                    for (int hd = 0; hd < 10; ++hd) {
                        const float v = __uint_as_float((unsigned)row[hd * 64 + lane] << 16);
                        const float rn = rsqrtf(wave_sum(v * v) * (1.f / 64.f) + EPS);
                        const float y = v * rn * (hd < 8 ? gq : gk);
                        const float p = __shfl_xor(y, 16);
                        float o = ((lane >> 4) & 1) ? (y * cs + p * sn) : (y * cs - p * sn);
                        if (hd < 8) o *= C2;
                        row[hd * 64 + lane] = (bf16_t)f2bf(o);
                    }
                }
                if (cu >= 0 && (lane & 7) == 0) { atomicMax(NRMQ + cu * 8 + (lane >> 3), __float_as_uint(mq)); atomicMax(NRMK + (cu >> 5) * 8 + (lane >> 3), __float_as_uint(mk)); }
            }
            xcd_barrier(xbar);
            {
                using namespace attn_body;
                char* shm = (char*)lds;
                for (int u = vcu; u < GB * 24 * 32; u += G) {
                    const int si = u >> 8, sx = (u >> 5) & 7, qb = u & 31; int bb, k;
                    if (si < 4) { const int j = si * 8 + sx; bb = j >> 4; k = 8 + (j & 15); } else { bb = sx >> 2; k = (si - 4) * 4 + (sx & 3); }
                    const size_t tb = (size_t)bb * SEQ;
                    AttnArgs a{}; a.qs = INW; a.ks = INW; a.NT = 128; a.tlo = 0; a.thi = 127;
                    if (k < 16) { const int hh = k >> 2, comp = (k >> 1) & 1, vh = k & 1;
                        a.Q = (const bf16*)(PROJ + (tb + qb * 256) * INW + COL_AQ + hh * 128 + comp * 64); a.K = (const bf16*)(PROJ + tb * INW + COL_AK + hh * 128 + comp * 64);
                        a.V = (const bf16*)(PROJ + tb * INW + COL_AV + hh * 128 + vh * 64); a.O = (bf16*)(ATMP + (tb + qb * 256) * 1024 + (hh * 2 + comp) * 128 + vh * 64); a.os = 1024;
                        a.s2 = exp2f(-2.f * (float)(hh + 1)) * LOG2E;
                        const float Bs = __uint_as_float(NRMQ[(bb * 32 + qb) * 8 + hh * 2 + comp]) * __uint_as_float(NRMK[bb * 8 + hh * 2 + comp]) * 1.02f + 0.25f;
                        const float dlim = fminf((150.f + 2.f * Bs) / a.s2, 1.0e6f), q0f = (float)(qb * 256);
                        int tlo = max(0, (int)floorf((q0f - 63.f - dlim) * (1.f / 64.f))), thi = min(127, (int)ceilf((q0f + 255.f + dlim) * (1.f / 64.f)));
                        if (((thi - tlo + 1) & 1) != 0) { if (tlo > 0) --tlo; else ++thi; }
                        tlo = __builtin_amdgcn_readfirstlane(tlo); thi = __builtin_amdgcn_readfirstlane(thi);
                        a.K += (size_t)tlo * 64 * INW; a.V += (size_t)tlo * 64 * INW; a.q0 = qb * 256 - 64 * tlo; a.NT = thi - tlo + 1;
                        attn_unit<MA, 8>(a, shm);
                    } else { const int h = k - 16;
                        a.Q = (const bf16*)(PROJ + (tb + qb * 256) * INW + COL_DQ + h * 64); a.K = (const bf16*)(PROJ + tb * INW + COL_DK + (h >> 2) * 64);
                        a.V = (const bf16*)(PROJ + tb * INW + COL_DV + (h >> 2) * 64); a.O = (bf16*)(Y + (tb + qb * 256) * 2048 + 1536 + h * 64); a.os = 2048;
                        attn_unit<MD, 8>(a, shm);
                    }
                }
                for (int u = vcu; u < GB * 24 * 32; u += G) {
                    const int sg = u >> 5, blk = u & 31, bb = sg / 24, k = sg % 24, gp = k >> 3, h = k & 7, dsh = 2 * gp, dil = 1 << dsh;
                    const int nblk = 32 >> dsh, res = blk / nblk, i0 = (blk % nblk) * 256, L = SEQ >> dsh;
                    const long tq = (long)bb * SEQ + res + (long)i0 * dil, tk = (long)bb * SEQ + res + (long)(i0 - 64) * dil;
                    AttnArgs a{}; a.qs = dil * INW; a.ks = dil * INW; a.os = dil * 1536; a.NT = 6; a.tlo = (i0 == 0) ? 1 : 0; a.thi = (i0 + 256 == L) ? 4 : 5;
                    const int cq = COL_B + gp * 1536 + h * 64;
                    a.Q = (const bf16*)(PROJ + tq * INW + cq); a.K = (const bf16*)(PROJ + tk * INW + cq + 512); a.V = (const bf16*)(PROJ + tk * INW + cq + 1024);
                    a.O = (bf16*)(BTMP + tq * 1536 + gp * 512 + h * 64);
                    a.s2 = exp2f(-(float)(h + 1)) * (float)dil * LOG2E; a.stat = STAT + (tq * 24 + gp * 8 + h) * 2; a.ss = dil * 48;
                    attn_unit<MB, 8>(a, shm);
                }
                for (int u = vcu; u < GB * 8 * 32; u += G) {
                    const int sg = u >> 5, qb = u & 31, bb = sg >> 3, h = sg & 7, r0 = 4 * qb, kb = min(max(r0 - 4, 0), 116); const size_t tb = (size_t)bb * SEQ;
                    AttnArgs a{}; a.qs = INW; a.ks = INW; a.os = 2048; a.NT = 12; a.tlo = 0; a.thi = 11; a.q0 = r0; a.kb = kb;
                    a.Q = (const bf16*)(PROJ + (tb + r0 * 64) * INW + COL_CQ + h * 64); a.K = (const bf16*)(PROJ + (tb + kb * 64) * INW + COL_CK + h * 64);
                    a.V = (const bf16*)(PROJ + (tb + kb * 64) * INW + COL_CV + h * 64); a.O = (bf16*)(Y + (tb + r0 * 64) * 2048 + 1024 + h * 64);
                    a.tab = (lds_fptr)((lds_cptr)shm + TAB_OFF) + h * 465;
                    attn_unit<MC, 8>(a, shm);
                }
            }
            xcd_barrier(xbar);
            {
                FRESH_LANE();
                const float g0 = diff_subln[l * 128 + 2 * lane], g1 = diff_subln[l * 128 + 2 * lane + 1];
                for (int m = gw; m < TG; m += NGW) {
                    const unsigned* at = (const unsigned*)(ATMP + (size_t)m * 1024); unsigned* yr = (unsigned*)(Y + (size_t)m * 2048);
#pragma unroll
                    for (int hh = 0; hh < 4; ++hh) {
                        const unsigned w0 = at[(hh * 2) * 64 + lane], w1 = at[(hh * 2 + 1) * 64 + lane];
                        const float d0 = bflo(w0) - lam * bflo(w1), d1 = bfhi(w0) - lam * bfhi(w1);
                        const float rn = rsqrtf(wave_sum(d0 * d0 + d1 * d1) * (1.f / 128.f) + EPS) * out_scale;
                        yr[hh * 64 + lane] = pk2(d0 * rn * g0, d1 * rn * g1);
                    }
                    const int h = lane >> 3, d8 = (lane & 7) * 8;
                    const float* st = STAT + (size_t)m * 48 + h * 2;
                    const float m0 = st[0], l0 = st[1], m1 = st[16], l1 = st[17], m2 = st[32], l2 = st[33];
                    const float ms = fmaxf(m0, fmaxf(m1, m2));
                    const float w0 = l0 * exp2f(m0 - ms), w1 = l1 * exp2f(m1 - ms), w2 = l2 * exp2f(m2 - ms); const float inv = 1.f / (w0 + w1 + w2);
                    const bf16_t* bt = BTMP + (size_t)m * 1536 + h * 64 + d8;
                    const u32x4 a0 = *(const u32x4*)bt, a1 = *(const u32x4*)(bt + 512), a2 = *(const u32x4*)(bt + 1024);
                    u32x4 o;
#pragma unroll
                    for (int e = 0; e < 4; ++e) { const float lo = (w0 * bflo(a0[e]) + w1 * bflo(a1[e]) + w2 * bflo(a2[e])) * inv, hi = (w0 * bfhi(a0[e]) + w1 * bfhi(a1[e]) + w2 * bfhi(a2[e])) * inv; o[e] = pk2(lo, hi); }
                    *(u32x4*)(Y + (size_t)m * 2048 + 512 + h * 64 + d8) = o;
                }
            }
            xcd_barrier(xbar);
            {
                pg8::Gemm g{Y, WbrT + (size_t)l * 4096 * 512, 2048, 512, 512, 4, 512}; pg8::StaticOrder S; S.init(TG, 4096, G, bx);
                pg8::Epi<1> E{Z, nullptr, nullptr, nullptr, 4096};
                pg8::gemm_phase(ldsl, g, S, E);
            }
            xcd_barrier(xbar);
            { FRESH_LANE();
            for (int m = gw; m < TG; m += NGW) {
                const bf16_t* gr = PROJ + (size_t)m * INW + COL_GATE; const bf16_t* zr = Z + (size_t)m * 4096;
#pragma unroll
                for (int j = 0; j < 2; ++j) { const int c = lane * 8 + j * 512; float acc[8] = {0.f, 0.f, 0.f, 0.f, 0.f, 0.f, 0.f, 0.f};
#pragma unroll
                    for (int n = 0; n < 4; ++n) { const u32x4 gv = *(const u32x4*)(gr + n * 1024 + c), zv = *(const u32x4*)(zr + n * 1024 + c);
#pragma unroll
                        for (int e = 0; e < 4; ++e) { acc[2 * e] += bflo(gv[e]) * bflo(zv[e]); acc[2 * e + 1] += bfhi(gv[e]) * bfhi(zv[e]); } }
                    u32x4 o; o.x = pk2(acc[0], acc[1]); o.y = pk2(acc[2], acc[3]); o.z = pk2(acc[4], acc[5]); o.w = pk2(acc[6], acc[7]);
                    *(u32x4*)(MERGED + (size_t)m * DM + c) = o; }
            } }
            xcd_barrier(xbar);
            {
                pg8::Gemm g{MERGED, WoutT + (size_t)l * DM * DM, DM, DM, DM, 1 << 30, 0}; pg8::StaticOrder S; S.init(TG, DM, G, bx);
                pg8::Epi<3> E{nullptr, xout + tok0 * DM, xsrc + tok0 * DM, nullptr, DM};
                pg8::gemm_phase(ldsl, g, S, E);
            }
            xcd_barrier(xbar);
            { FRESH_LANE(); for (int m = gw; m < TG; m += NGW) rms_row_bf16(xout + (tok0 + m) * DM, norm_ffn + l * DM, H + (size_t)m * DM, lane); }
            xcd_barrier(xbar);
            {
                pg8::Gemm g{H, W1T + (size_t)l * DFF * DM, DM, DM, DM, 1 << 30, 0}; pg8::StaticOrder S; S.init(TG, DFF, G, bx);
                pg8::Epi<2> E{U, nullptr, nullptr, nullptr, DFF};
                pg8::gemm_phase(ldsl, g, S, E);
            }
            xcd_barrier(xbar);
            {
                pg8::Gemm g{U, W2T + (size_t)l * DM * DFF, DFF, DFF, DFF, 1 << 30, 0}; pg8::StaticOrder S; S.init(TG, DM, G, bx);
                pg8::Epi<3> E{nullptr, xout + tok0 * DM, xout + tok0 * DM, nullptr, DM};
                pg8::gemm_phase(ldsl, g, S, E);
            }
            {
                const int ng = grp + 1, nl = (ng == NGRP) ? l + 1 : l, ngrp = (ng == NGRP) ? 0 : ng;
                if (nl < DEPTH) {
                    if (nl != l) xcd_barrier(xbar);
                    FRESH_LANE(); const float* xs = (nl == 0) ? x_in : xout; const size_t nt0 = (size_t)ngrp * TG;
                    for (int m = gw; m < TG; m += NGW) rms_row_bf16(xs + (nt0 + m) * DM, norm_mix + nl * DM, H + (size_t)m * DM, lane);
                }
            }
            xcd_barrier(xbar);
        }
    }
    FRESH_LANE();
    for (int m = gw; m < NTOK; m += NGW) {
        f32x4* o = (f32x4*)(xout + (size_t)m * DM) + lane; const f32x4* g4 = (const f32x4*)norm_final + lane;
        f32x4 v[4]; float s = 0.f;
#pragma unroll
        for (int j = 0; j < 4; ++j) { v[j] = o[64 * j]; s += (v[j].x * v[j].x + v[j].y * v[j].y) + (v[j].z * v[j].z + v[j].w * v[j].w); }
        const float r = rsqrtf(wave_sum(s) * (1.f / DM) + EPS);
#pragma unroll
        for (int j = 0; j < 4; ++j) { const f32x4 g = g4[64 * j]; o[64 * j] = (f32x4){v[j].x * r * g.x, v[j].y * r * g.y, v[j].z * r * g.z, v[j].w * r * g.w}; }
    }
}

#undef ws
#undef x_in
#undef norm_mix
#undef w_in
#undef b_gate
#undef diff_lambda
#undef diff_subln
#undef na_rpb
#undef qk_norm
#undef w_branch
#undef w_out
#undef norm_ffn
#undef w_ff1
#undef w_ff2
#undef norm_final
#undef xout
#undef WinT
#undef WbrT
#undef WoutT
#undef W1T
#undef W2T
#undef STAT
#undef H
#undef ATMP
#undef BTMP
#undef Y
#undef MERGED
#undef Z
#undef U
#undef PROJ
#undef NRMQ
#undef NRMK

extern "C" void kernel_launch(void* const* d_in, const int* in_sizes, int n_in, void* d_out, int out_size, void* d_ws, size_t ws_size, hipStream_t stream) {
    static int grid_blocks = 0;
    if (!grid_blocks) {
        int dev = 0, cus = 0, per_cu = 0;
        (void)hipGetDevice(&dev);
        (void)hipDeviceGetAttribute(&cus, hipDeviceAttributeMultiprocessorCount, dev);
        (void)hipFuncSetAttribute((const void*)mk_fwd, hipFuncAttributeMaxDynamicSharedMemorySize, LDS_BYTES);
        (void)hipOccupancyMaxActiveBlocksPerMultiprocessor(&per_cu, (const void*)mk_fwd, 512, LDS_BYTES);
        if (per_cu < 1) per_cu = 1;
        grid_blocks = cus * per_cu;
        if (ws_size < WS_END || n_in != 14) { fprintf(stderr, "kernel_launch: workspace %zu < %zu or n_in %d != 14\n", ws_size, (size_t)WS_END, n_in); grid_blocks = -1; }
    }
    if (grid_blocks < 0) return;
    (void)hipMemsetAsync((char*)d_ws + WS_BAR, 0, 16384, stream);
    Args a{};
    for (int i = 0; i < 14; ++i) a.in[i] = (const float*)d_in[i];
    a.out = (float*)d_out; a.ws = (unsigned char*)d_ws;
    void* kargs[] = {&a};
    hipError_t e = hipLaunchCooperativeKernel((const void*)mk_fwd, dim3(grid_blocks), dim3(512), kargs, LDS_BYTES, stream);
    if (e != hipSuccess) fprintf(stderr, "cooperative launch failed: %s (grid %d)\n", hipGetErrorString(e), grid_blocks);
}
```

```cpp
#include <hip/hip_runtime.h>
#include <hip/hip_cooperative_groups.h>
#include <hip/hip_bf16.h>
#include <cstdio>
#include <cstdint>
#include <cmath>
namespace cg = cooperative_groups;

constexpr int BATCH = 8, SEQ = 8192, DM = 1024, NTOK = BATCH * SEQ, INW = 12544, DFF = 4096, DEPTH = 2;
constexpr int GB = 2, TG = GB * SEQ, NGRP = BATCH / GB;
constexpr float EPS = 1e-6f;
constexpr float LOG2E = 1.4426950408889634f;
constexpr float C2 = 0.125f * LOG2E;
constexpr int COL_AQ = 0, COL_AK = 512, COL_AV = 1024, COL_B = 1536, COL_CQ = 6144, COL_CK = 6656, COL_CV = 7168, COL_DQ = 7680, COL_DK = 8192, COL_DV = 8320, COL_GATE = 8448;
constexpr size_t MiB = 1u << 20;
constexpr size_t WS_WIN = 0, WS_WBR = 49 * MiB, WS_WOUT = 57 * MiB, WS_W1 = 61 * MiB, WS_W2 = 77 * MiB, WS_STAT = 93 * MiB, WS_H = 96 * MiB, WS_ATMP = 128 * MiB,
                 WS_BTMP = 160 * MiB, WS_Y = 208 * MiB, WS_MERGED = 272 * MiB, WS_Z = 304 * MiB, WS_PROJ = 432 * MiB, WS_NRM = 824 * MiB, WS_BAR = 824 * MiB + 512 * 1024, WS_END = 825 * MiB;
constexpr int LDS_BYTES = 147456, TAB_OFF = 131072, MISC_OFF = 147072;

#define LAS __attribute__((address_space(3)))
typedef unsigned short bf16_t;
typedef short bf16x8 __attribute__((ext_vector_type(8)));
typedef float f32x4 __attribute__((ext_vector_type(4)));
typedef unsigned u32x4 __attribute__((ext_vector_type(4)));
typedef unsigned u32x2 __attribute__((ext_vector_type(2)));

__device__ __forceinline__ unsigned f2bf(float f) { unsigned u = __builtin_bit_cast(unsigned, f); return (u + 0x7fffu + ((u >> 16) & 1u)) >> 16; }
__device__ __forceinline__ unsigned pk2(float lo, float hi) { return f2bf(lo) | (f2bf(hi) << 16); }
__device__ __forceinline__ float bflo(unsigned w) { return __uint_as_float(w << 16); }
__device__ __forceinline__ float bfhi(unsigned w) { return __uint_as_float(w & 0xffff0000u); }
__device__ __forceinline__ float wave_sum(float v) {
#pragma unroll
    for (int o = 1; o < 64; o <<= 1) v += __shfl_xor(v, o);
    return v;
}

namespace pg8 {
constexpr int BM = 256, BK = 64, HALF = 128, HTB = HALF * BK * 2, STAGE_BYTES = 8 * HTB, NXCD = 8, WGM = 8;
__host__ __device__ __forceinline__ int lds_byte(int r, int c) { const int st = (r >> 4) * 2 + (c >> 5), rr = r & 15, cc = c & 31, ob = rr * 64 + cc * 2; return st * 1024 + (ob ^ (((ob >> 9) & 1) << 5)); }
__host__ __device__ __forceinline__ void stage_rc(int b, int& R, int& C) { const int st = b / 1024, sb = b % 1024, swz = sb ^ (((sb >> 9) & 1) << 5); R = (st >> 1) * 16 + swz / 64; C = (st & 1) * 32 + (swz % 64) / 2; }
__host__ __device__ __forceinline__ int perm32(int rho) { const int n = rho >> 4, i = rho & 15; return 8 * (i >> 2) + 4 * n + (i & 3); }

struct Unit { int pm, pn; };
struct Gemm { const bf16_t* A; const bf16_t* Bt; int lda, ldb, K, adiv, astride; };

struct StaticOrder {
    int nM, nN, nwg, G, c;
    __device__ void init(int M, int N, int G_, int c_) { nM = M / BM; nN = N / BM; nwg = nM * nN; G = G_; c = c_; }
    __device__ bool next(int i, Unit& u) const {
        const long L = (long)i * G + c; if (L >= nwg) return false;
        int wgid = (int)L; { const int q = nwg / NXCD, r = nwg % NXCD, xcd = wgid % NXCD, off = wgid / NXCD; wgid = (xcd < r ? xcd * (q + 1) : r * (q + 1) + (xcd - r) * q) + off; }
        const int nig = WGM * nN, gid = wgid / nig, fm = gid * WGM, gsz = (nM - fm) < WGM ? (nM - fm) : WGM;
        u.pm = fm + ((wgid % nig) % gsz); u.pn = (wgid % nig) / gsz; return true;
    }
};

__device__ __forceinline__ unsigned cvt_pk_bf16(float lo, float hi) { unsigned r; asm volatile("v_cvt_pk_bf16_f32 %0, %1, %2" : "=v"(r) : "v"(lo), "v"(hi)); return r; }

template <int MODE> struct Epi {
    bf16_t* O; float* Of; const float* base; const float* bias; int ldc;
    __device__ __forceinline__ void operator()(const f32x4 (&acc)[2][2][4][2], const Unit& u, int wr, int wc, int fr, int fq) const {
        const int row0 = u.pm * BM + wr * 64 + fr, col0 = u.pn * BM + wc * 32 + 8 * fq;
        int kind = 0; float sc = 1.f;
        if (MODE == 0) { const int pn = u.pn; if (pn >= 33) kind = 2; else if (pn < 2 || pn == 6 || pn == 7 || pn == 12 || pn == 13 || pn == 18 || pn == 19 || pn == 24 || pn == 25) sc = C2; }
#pragma unroll
        for (int ai = 0; ai < 2; ++ai)
#pragma unroll
            for (int m = 0; m < 4; ++m) { const size_t roff = (size_t)(row0 + ai * HALF + m * 16) * ldc;
#pragma unroll
                for (int bj = 0; bj < 2; ++bj) { const int col = col0 + bj * HALF; f32x4 v0 = acc[ai][bj][m][0], v1 = acc[ai][bj][m][1];
                    if (MODE == 3) {
                        const f32x4 b0 = *(const f32x4*)(base + roff + col), b1 = *(const f32x4*)(base + roff + col + 4);
                        *(f32x4*)(Of + roff + col) = b0 + v0; *(f32x4*)(Of + roff + col + 4) = b1 + v1;
                    } else {
                        if (MODE == 0) {
                            if (kind == 2) { const f32x4 g0 = *(const f32x4*)(bias + col - COL_GATE), g1 = *(const f32x4*)(bias + col - COL_GATE + 4);
#pragma unroll
                                for (int e = 0; e < 4; ++e) { v0[e] = 1.f / (1.f + __expf(-(v0[e] + g0[e]))); v1[e] = 1.f / (1.f + __expf(-(v1[e] + g1[e]))); } }
                            else { v0 = v0 * sc; v1 = v1 * sc; }
                        }
                        if (MODE == 2) {
#pragma unroll
                            for (int e = 0; e < 4; ++e) { const float a = fmaxf(v0[e], 0.f), b = fmaxf(v1[e], 0.f); v0[e] = a * a; v1[e] = b * b; } }
                        u32x4 w; w.x = cvt_pk_bf16(v0[0], v0[1]); w.y = cvt_pk_bf16(v0[2], v0[3]); w.z = cvt_pk_bf16(v1[0], v1[1]); w.w = cvt_pk_bf16(v1[2], v1[3]);
                        *(u32x4*)(O + roff + col) = w;
                    } } }
    }
};

template <class EpiT>
__device__ __forceinline__ void gemm_phase(LAS unsigned char* lds, const Gemm g, const StaticOrder& S, const EpiT& E) {
    int tid_ = threadIdx.x; asm volatile("" : "+v"(tid_));
    const int tid = tid_, wid = __builtin_amdgcn_readfirstlane(tid >> 6), lane = tid & 63, wr = wid >> 2, wc = wid & 3, fr = lane & 15, fq = lane >> 4;
    const int K = g.K, nt = K / BK;
    unsigned voffA[2], voffB[2];
#pragma unroll
    for (int i = 0; i < 2; ++i) { int R, C; stage_rc(tid * 16 + i * 8192, R, C); const int Rb = (R & ~31) + perm32(R & 31);
        voffA[i] = (unsigned)(R * g.lda + C) * 2u; voffB[i] = (unsigned)(Rb * g.ldb + C) * 2u; }
    const size_t kstep = (size_t)(BK * 2);
    const size_t hA = (size_t)HALF * g.lda * 2, hB = (size_t)HALF * g.ldb * 2;
    const size_t tA = 2 * hA, tB = 2 * hB;
    const unsigned ldsw = (unsigned)wid * 1024u;
    const int aoff = lds_byte(wr * 64 + fr, fq * 8), boff = lds_byte(wc * 32 + fr, fq * 8);
#define PG8_SA(b, h) (((b) * 2 + (h)) * HTB)
#define PG8_SB(b, h) ((4 + (b) * 2 + (h)) * HTB)
#define PG8_STAGE(bufoff, gbase, voff) do { _Pragma("unroll") for (int _i = 0; _i < 2; ++_i) \
        __builtin_amdgcn_global_load_lds((const unsigned*)((const char*)(gbase) + (voff)[_i]), (LAS unsigned*)(lds + (bufoff) + ldsw + _i * 8192), 16, 0, 0); } while (0)
#define PG8_LDA(dst, b, h) do { _Pragma("unroll") for (int m = 0; m < 4; ++m) _Pragma("unroll") for (int k = 0; k < 2; ++k) dst[m][k] = *(const LAS bf16x8*)(lds + PG8_SA(b, h) + aoff + m * 2048 + k * 1024); } while (0)
#define PG8_LDB(dst, b, h) do { _Pragma("unroll") for (int n = 0; n < 2; ++n) _Pragma("unroll") for (int k = 0; k < 2; ++k) dst[n][k] = *(const LAS bf16x8*)(lds + PG8_SB(b, h) + boff + n * 2048 + k * 1024); } while (0)
#define PG8_MMA(ai, bj, At, Bt) do { __builtin_amdgcn_s_setprio(1); _Pragma("unroll") for (int m = 0; m < 4; ++m) _Pragma("unroll") for (int n = 0; n < 2; ++n) _Pragma("unroll") for (int k = 0; k < 2; ++k) \
        acc[ai][bj][m][n] = __builtin_amdgcn_mfma_f32_16x16x32_bf16(Bt[n][k], At[m][k], acc[ai][bj][m][n], 0, 0, 0); __builtin_amdgcn_s_setprio(0); } while (0)
#define PG8_WAIT_V(n) asm volatile("s_waitcnt vmcnt(" #n ")" ::: "memory")
#define PG8_WAIT_L(n) asm volatile("s_waitcnt lgkmcnt(" #n ")" ::: "memory")
#define PG8_BAR __builtin_amdgcn_s_barrier()
#define PG8_SCHED __builtin_amdgcn_sched_barrier(0)
#define PG8_PA(u) ((const char*)g.A + (size_t)(u).pm * tA + (size_t)((u).pn / g.adiv) * (size_t)g.astride * 2)
#define PG8_PB(u) ((const char*)g.Bt + (size_t)(u).pn * tB)
    Unit cur, nxt; int ui = 0;
    if (!S.next(0, cur)) return;
    f32x4 acc[2][2][4][2];
#pragma unroll
    for (int a = 0; a < 2; ++a)
#pragma unroll
        for (int b = 0; b < 2; ++b)
#pragma unroll
            for (int m = 0; m < 4; ++m)
#pragma unroll
                for (int n = 0; n < 2; ++n) acc[a][b][m][n] = (f32x4){0.f, 0.f, 0.f, 0.f};
    bf16x8 At[4][2], B0[2][2], B1[2][2];
    const char* cA = PG8_PA(cur); const char* cB = PG8_PB(cur);
    PG8_STAGE(PG8_SB(0, 0), cB, voffB); PG8_STAGE(PG8_SB(0, 1), cB + hB, voffB); PG8_STAGE(PG8_SA(0, 0), cA, voffA); PG8_STAGE(PG8_SA(0, 1), cA + hA, voffA);
    if (wr == 1) PG8_BAR;
    PG8_WAIT_V(2); PG8_BAR;
    PG8_STAGE(PG8_SB(1, 0), cB + kstep, voffB); PG8_STAGE(PG8_SA(1, 0), cA + kstep, voffA); PG8_STAGE(PG8_SB(1, 1), cB + hB + kstep, voffB);
    PG8_WAIT_V(6); PG8_BAR;
    for (;;) {
        const bool has_next = S.next(ui + 1, nxt);
        const char* nA = has_next ? PG8_PA(nxt) : cA; const char* nB = has_next ? PG8_PB(nxt) : cB;
        for (int t = 0; t < nt; t += 2) {
            const bool last = (t == nt - 2);
            const char* a1 = cA + (size_t)(t + 1) * kstep;
            const char* a2 = last ? nA : cA + (size_t)(t + 2) * kstep; const char* b2 = last ? nB : cB + (size_t)(t + 2) * kstep;
            const char* a3 = a2 + kstep; const char* b3 = b2 + kstep;
            PG8_LDB(B0, 0, 0); PG8_LDB(B1, 0, 1); PG8_SCHED; PG8_LDA(At, 0, 0); PG8_STAGE(PG8_SA(1, 1), a1 + hA, voffA);
            PG8_WAIT_V(8); PG8_WAIT_L(0); PG8_BAR; PG8_MMA(0, 0, At, B0); PG8_MMA(0, 1, At, B1); PG8_BAR; PG8_SCHED;
            PG8_LDA(At, 0, 1); PG8_STAGE(PG8_SB(0, 0), b2, voffB); PG8_STAGE(PG8_SB(0, 1), b2 + hB, voffB); PG8_STAGE(PG8_SA(0, 0), a2, voffA);
            PG8_WAIT_V(8); PG8_WAIT_L(0); PG8_BAR; PG8_MMA(1, 0, At, B0); PG8_MMA(1, 1, At, B1); PG8_BAR; PG8_SCHED;
            PG8_LDB(B0, 1, 0); PG8_LDB(B1, 1, 1); PG8_SCHED; PG8_LDA(At, 1, 0); PG8_STAGE(PG8_SA(0, 1), a2 + hA, voffA);
            PG8_WAIT_V(8); PG8_WAIT_L(0); PG8_BAR; PG8_MMA(0, 0, At, B0); PG8_MMA(0, 1, At, B1); PG8_BAR; PG8_SCHED;
            PG8_LDA(At, 1, 1); PG8_STAGE(PG8_SB(1, 0), b3, voffB); PG8_STAGE(PG8_SB(1, 1), b3 + hB, voffB); PG8_STAGE(PG8_SA(1, 0), a3, voffA);
            PG8_WAIT_V(8); PG8_WAIT_L(0); PG8_BAR; PG8_MMA(1, 0, At, B0); PG8_MMA(1, 1, At, B1); PG8_BAR; PG8_SCHED;
        }
        if (wr == 0) PG8_BAR;
        E(acc, cur, wr, wc, fr, fq);
        if (!has_next) break;
#pragma unroll
        for (int a = 0; a < 2; ++a)
#pragma unroll
            for (int b = 0; b < 2; ++b)
#pragma unroll
                for (int m = 0; m < 4; ++m)
#pragma unroll
                    for (int n = 0; n < 2; ++n) acc[a][b][m][n] = (f32x4){0.f, 0.f, 0.f, 0.f};
        cur = nxt; cA = nA; cB = nB; ++ui;
        if (wr == 1) PG8_BAR;
    }
    PG8_WAIT_V(0);
    PG8_BAR;
#undef PG8_SA
#undef PG8_SB
#undef PG8_STAGE
#undef PG8_LDA
#undef PG8_LDB
#undef PG8_MMA
#undef PG8_WAIT_V
#undef PG8_WAIT_L
#undef PG8_BAR
#undef PG8_SCHED
#undef PG8_PA
#undef PG8_PB
}
}

namespace attn_body {
using bf16 = __hip_bfloat16;
using s16x4 = __attribute__((ext_vector_type(4))) short;
using f32x16 = __attribute__((ext_vector_type(16))) float;
constexpr int NW = 8, QBLK = 32, QB = QBLK * NW, KVBLK = 64;
constexpr int MA = 0, MB = 1, MC = 2, MD = 3;
__device__ __forceinline__ int crow(int r, int hi) { return (r & 3) + 8 * (r >> 2) + 4 * hi; }
#define SBAR() __builtin_amdgcn_sched_barrier(0)
constexpr int NSLOT = 3, SLOTB = 8192;
constexpr int LDS_K = 0, LDS_V = NSLOT * SLOTB, LDS_WS = 2 * NSLOT * SLOTB, LDS_OST = LDS_WS + NW * 64 * 4, LDS_ATT = LDS_OST + NW * 4096;
typedef __attribute__((address_space(3))) const char* lds_cptr;
typedef __attribute__((address_space(3))) const float* lds_fptr;

struct AttnArgs {
    const bf16* Q; const bf16* K; const bf16* V; bf16* O;
    int qs, ks, os;
    int NT, tlo, thi;
    float s2;
    int q0;
    int kb;
    float* stat; int ss;
    lds_fptr tab;
};

__device__ __forceinline__ void glds16(const void* gsrc, unsigned lds_dst) { unsigned keep;
  asm volatile("s_mov_b32 %0, m0\n\ts_mov_b32 m0, %2\n\ts_nop 0\n\tglobal_load_lds_dwordx4 %1, off\n\ts_mov_b32 m0, %0" : "=&s"(keep) : "v"(gsrc), "s"(lds_dst) : "memory"); }
__device__ __forceinline__ float max3f(float a, float b, float c) { float r; asm("v_max3_f32 %0, %1, %2, %3" : "=v"(r) : "v"(a), "v"(b), "v"(c)); return r; }
__device__ __forceinline__ float max2f(float a, float b) { float r; asm("v_max_f32_e32 %0, %1, %2" : "=v"(r) : "v"(a), "v"(b)); return r; }
__device__ __forceinline__ float fadd_s(float a, float b) { float r; asm("v_add_f32_e32 %0, %1, %2" : "=v"(r) : "v"(a), "v"(b)); return r; }
__device__ __forceinline__ float fsub_s(float a, float b) { float r; asm("v_sub_f32_e32 %0, %1, %2" : "=v"(r) : "v"(a), "v"(b)); return r; }
typedef float f32x2_t __attribute__((ext_vector_type(2))); typedef __bf16 bf16x2_t __attribute__((ext_vector_type(2)));
__device__ __forceinline__ unsigned cvtpk_s(float lo, float hi) { f32x2_t v = {lo, hi}; bf16x2_t b = __builtin_convertvector(v, bf16x2_t); return __builtin_bit_cast(unsigned, b); }
#define WAIT_BAR(N) asm volatile("s_waitcnt vmcnt(" #N ") lgkmcnt(0)\n\ts_barrier" ::: "memory")

__device__ __forceinline__ void qkt(f32x16& p0, f32x16& p1, const char* Kslot, const bf16x8* qr, const f32x16& negm, int r32, int hi) {
  const char* kb = Kslot + hi * 1024 + r32 * 16;
  #pragma unroll
  for (int d0 = 0; d0 < 4; ++d0) {
    const bf16x8 b0 = *reinterpret_cast<const bf16x8*>(kb + d0 * 2048);
    const bf16x8 b1 = *reinterpret_cast<const bf16x8*>(kb + d0 * 2048 + 512);
    if (d0 == 0) { p0 = __builtin_amdgcn_mfma_f32_32x32x16_bf16(b0, qr[0], negm, 0, 0, 0); p1 = __builtin_amdgcn_mfma_f32_32x32x16_bf16(b1, qr[0], negm, 0, 0, 0); }
    else { p0 = __builtin_amdgcn_mfma_f32_32x32x16_bf16(b0, qr[d0], p0, 0, 0, 0); p1 = __builtin_amdgcn_mfma_f32_32x32x16_bf16(b1, qr[d0], p1, 0, 0, 0); } }
}
typedef short v4i16_t __attribute__((ext_vector_type(4)));
__device__ __forceinline__ void kload8(bf16x8* kf, lds_cptr kp) {
  kf[0] = *(const LAS bf16x8*)(kp);        kf[1] = *(const LAS bf16x8*)(kp + 512);
  kf[2] = *(const LAS bf16x8*)(kp + 2048); kf[3] = *(const LAS bf16x8*)(kp + 2560);
  kf[4] = *(const LAS bf16x8*)(kp + 4096); kf[5] = *(const LAS bf16x8*)(kp + 4608);
  kf[6] = *(const LAS bf16x8*)(kp + 6144); kf[7] = *(const LAS bf16x8*)(kp + 6656);
}
__device__ __forceinline__ void kload2(bf16x8* kf, lds_cptr kp, int j) { kf[2 * j] = *(const LAS bf16x8*)(kp + j * 2048); kf[2 * j + 1] = *(const LAS bf16x8*)(kp + j * 2048 + 512); }
__device__ __forceinline__ s16x4 vtr(lds_cptr p) { return __builtin_bit_cast(s16x4, __builtin_amdgcn_ds_read_tr16_b64_v4i16((LAS v4i16_t*)p)); }
__device__ __forceinline__ float rowmax(const f32x16& p0, const f32x16& p1) {
  float a = max3f(p0[0], p0[1], p1[0]), b = max3f(p0[2], p0[3], p1[1]); a = max3f(a, p1[2], p1[3]);
  #pragma unroll
  for (int r = 4; r < 16; r += 4) { a = max3f(a, p0[r], p0[r + 1]); b = max3f(b, p0[r + 2], p0[r + 3]); a = max3f(a, p1[r], p1[r + 1]); b = max3f(b, p1[r + 2], p1[r + 3]); }
  const float m = max2f(a, b);
  auto rr = __builtin_amdgcn_permlane32_swap(__float_as_uint(m), __float_as_uint(m), false, false);
  return max2f(__uint_as_float(rr[0]), __uint_as_float(rr[1]));
}
__device__ __forceinline__ void pv(f32x16* o, int vb, bf16x8 pa0, bf16x8 pa1, bf16x8 pa2, bf16x8 pa3) {
  #pragma unroll
  for (int d0 = 0; d0 < 2; ++d0) { s16x4 lo[4], hi[4];
    #pragma unroll
    for (int ks = 0; ks < 4; ++ks) {
      asm volatile("ds_read_b64_tr_b16 %0,%1 offset:%c2" : "=&v"(lo[ks]) : "v"(vb), "i"(d0 * 4096 + ks * 1024) : "memory");
      asm volatile("ds_read_b64_tr_b16 %0,%1 offset:%c2" : "=&v"(hi[ks]) : "v"(vb), "i"(d0 * 4096 + ks * 1024 + 512) : "memory"); }
    asm volatile("s_waitcnt lgkmcnt(0)" ::: "memory"); SBAR();
    #define PK(k) (bf16x8){lo[k][0], lo[k][1], lo[k][2], lo[k][3], hi[k][0], hi[k][1], hi[k][2], hi[k][3]}
    o[d0] = __builtin_amdgcn_mfma_f32_32x32x16_bf16(pa0, PK(0), o[d0], 0, 0, 0);
    o[d0] = __builtin_amdgcn_mfma_f32_32x32x16_bf16(pa1, PK(1), o[d0], 0, 0, 0);
    o[d0] = __builtin_amdgcn_mfma_f32_32x32x16_bf16(pa2, PK(2), o[d0], 0, 0, 0);
    o[d0] = __builtin_amdgcn_mfma_f32_32x32x16_bf16(pa3, PK(3), o[d0], 0, 0, 0);
    #undef PK
  }
}

template <int MODE> __device__ __forceinline__ void score_hook(f32x16& c0, f32x16& c1, int t, const AttnArgs& a, int qrel, int hi, int wid, int r32, float mh) {
  if constexpr (MODE == MA) {
    const int wlo = a.q0 + wid * QBLK, sd = (64 * t + 63 < wlo) ? 1 : ((64 * t > wlo + 31) ? -1 : 0);
    if (sd != 0) { const float sv = (float)sd * a.s2;
      #pragma unroll
      for (int r = 0; r < 16; ++r) { const float kf = (float)((r & 3) + 8 * (r >> 2)); c0[r] = fmaf(kf, sv, c0[r]); c1[r] = fmaf(kf + 32.f, sv, c1[r]); if ((r & 3) == 3) __builtin_amdgcn_sched_barrier(0); }
    } else {
      const float dq = (float)(a.q0 + qrel - 64 * t - 4 * hi), ns = -a.s2;
      #pragma unroll
      for (int r = 0; r < 16; ++r) { const float kf = (float)((r & 3) + 8 * (r >> 2)); c0[r] = fmaf(ns, fabsf(dq - kf), c0[r]); c1[r] = fmaf(ns, fabsf(dq - (kf + 32.f)), c1[r]); if ((r & 1) == 1) __builtin_amdgcn_sched_barrier(0); }
    }
  }
  if constexpr (MODE == MB) {
    const bool tv = (t >= a.tlo) && (t <= a.thi);
    const float dq = (float)(qrel + 64 - 64 * t - 4 * hi), ns = -a.s2;
    #pragma unroll
    for (int r = 0; r < 16; ++r) { const float kf = (float)((r & 3) + 8 * (r >> 2)); const float d0 = fabsf(dq - kf), d1 = fabsf(dq - (kf + 32.f));
      c0[r] = (tv && d0 <= 64.f) ? fmaf(ns, d0, c0[r] - mh) : -INFINITY; c1[r] = (tv && d1 <= 64.f) ? fmaf(ns, d1, c1[r] - mh) : -INFINITY;
      if ((r & 3) == 3) __builtin_amdgcn_sched_barrier(0); }
  }
  if constexpr (MODE == MC) {
    const int qrow = a.q0 + (wid >> 1), rs = min(max(qrow - 4, 0), 120), krow = a.kb + t;
    if (krow < rs || krow >= rs + 8) {
      #pragma unroll
      for (int r = 0; r < 16; ++r) { c0[r] = -INFINITY; c1[r] = -INFINITY; }
    } else {
      const int qc = (wid & 1) * 32 + r32, cs = min(max(qc - 8, 0), 48);
      const lds_fptr tp = a.tab + (krow - qrow + 7) * 31 + (15 - qc + 4 * hi);
      const int kd = 4 * hi - cs;
      #pragma unroll
      for (int r = 0; r < 16; ++r) { const int kc = (r & 3) + 8 * (r >> 2);
        const float b0 = tp[kc], b1 = tp[kc + 32];
        c0[r] = ((unsigned)(kd + kc) < 16u) ? c0[r] + (b0 - mh) : -INFINITY; c1[r] = ((unsigned)(kd + kc + 32) < 16u) ? c1[r] + (b1 - mh) : -INFINITY;
        if ((r & 3) == 3) __builtin_amdgcn_sched_barrier(0); }
    }
  }
}

template <int MODE, int THRL> __device__ __forceinline__ void attn_unit(const AttnArgs& A_, char* shm) {
  int tid_ = threadIdx.x; asm volatile("" : "+v"(tid_));
  const int tid = tid_, lane = tid & 63, r32 = lane & 31, hi = lane >> 5; const int wid = __builtin_amdgcn_readfirstlane(tid >> 6);
  const bf16* Qw = A_.Q + (wid * QBLK) * A_.qs;
  const unsigned lds0 = (unsigned)(uintptr_t)shm;
  float* wsf = (float*)(shm + LDS_WS) + wid * 64;
  const int ks = A_.ks;
  const bf16* ksrc = A_.K + (lane * ks + wid * 8);
  const bf16* vsrc = A_.V + ((16 * (wid & 3) + (lane >> 2)) * ks + (wid >> 2) * 32 + (lane & 3) * 8);
  const unsigned kdst = lds0 + LDS_K + wid * 1024, vdst = lds0 + LDS_V + wid * 1024;
  #define TT(t) ((MODE == MB) ? min(max((int)(t), A_.tlo), A_.thi) : (int)(t))
  #define DMA_K(t, slot) glds16(ksrc + TT(t) * KVBLK * ks, (unsigned)__builtin_amdgcn_readfirstlane(kdst + (slot)))
  #define DMA_V(t, slot) glds16(vsrc + TT(t) * KVBLK * ks, (unsigned)__builtin_amdgcn_readfirstlane(vdst + (slot)))
  const int vb0 = (int)(lds0 + LDS_V) + ((lane >> 4) & 1) * 32 + (lane & 3) * 8 + (4 * hi + ((lane & 15) >> 2)) * 64;
  const char* Kbase = shm + LDS_K; bf16x8 kf[8];
  const lds_cptr shm3 = (lds_cptr)shm; const lds_cptr kp0 = shm3 + LDS_K + hi * 1024 + r32 * 16; const lds_cptr vp0 = shm3 + LDS_V + ((lane >> 4) & 1) * 32 + (lane & 3) * 8 + (4 * hi + ((lane & 15) >> 2)) * 64;
  const int NT = A_.NT;
  DMA_K(0, 0); DMA_V(0, 0); DMA_K(1, SLOTB);
  bf16x8 qr[4];
  #pragma unroll
  for (int d0 = 0; d0 < 4; ++d0) qr[d0] = *reinterpret_cast<const bf16x8*>(&Qw[r32 * A_.qs + d0 * 16 + hi * 8]);
  float mhat = 0.f, l_reg = 0.f; f32x16 o[2]; o[0] = f32x16{}; o[1] = f32x16{}; f32x16 negm = f32x16{}; asm volatile("" : "+v"(negm));
  const int qrel = wid * QBLK + r32;
  constexpr bool NEGM = (MODE == MA || MODE == MD);
  #define CIN (NEGM ? negm : f32x16{})
  #define NEGM_SET(tn) do { float nb_ = -mhat; \
      if (MODE == MA) { const int wlo_ = A_.q0 + wid * QBLK, sd_ = (64 * (tn) + 63 < wlo_) ? 1 : ((64 * (tn) > wlo_ + 31) ? -1 : 0); \
        if (sd_ != 0) nb_ = fmaf(-(float)sd_ * A_.s2, (float)(A_.q0 + qrel - 64 * (tn) - 4 * hi), nb_); } \
      _Pragma("unroll") for (int r = 0; r < 16; ++r) negm[r] = nb_; asm volatile("" : "+v"(negm)); } while (0)
  #define CMASK(P0, P1, t) score_hook<MODE>(P0, P1, (t), A_, qrel, hi, wid, r32, mhat)
  bool resc = false;
  #define START(P0, P1) do { const float rm = rowmax(P0, P1); resc = false; \
    { const float dl = (MODE == MB || MODE == MC) ? fmaxf(rm, -2048.f) : rm; mhat = fadd_s(mhat, dl); \
      _Pragma("unroll") for (int r = 0; r < 16; ++r) { P0[r] = fsub_s(P0[r], dl); P1[r] = fsub_s(P1[r], dl); } \
      if (NEGM) { NEGM_SET(1); } } \
    _Pragma("unroll") for (int r = 0; r < 16; ++r) P0[r] = __builtin_amdgcn_exp2f(P0[r]); } while (0)
  #define RESC() do { if (resc) { asm volatile("s_waitcnt lgkmcnt(0)" ::: "memory"); \
      _Pragma("unroll") for (int d_ = 0; d_ < 2; ++d_) _Pragma("unroll") for (int r = 0; r < 16; ++r) o[d_][r] *= wsf[crow(r, hi)]; } } while (0)
  f32x16 pA0, pA1, pB0, pB1;
  int sl_prev = 0, sl_cur = 0, sl_next = SLOTB;
  #define ROT() do { sl_prev = sl_cur; sl_cur = sl_next; sl_next = (sl_next == (NSLOT - 1) * SLOTB) ? 0 : sl_next + SLOTB; } while (0)
  DMA_K(2, 2 * SLOTB);
  if (MODE == MA) { NEGM_SET(0); }
  WAIT_BAR(3);
  qkt(pA0, pA1, Kbase, qr, negm, r32, hi); asm volatile("s_nop 15\n\ts_nop 7" : "+v"(pA0), "+v"(pA1)); CMASK(pA0, pA1, 0);
  START(pA0, pA1);
  _Pragma("unroll") for (int r = 0; r < 16; ++r) pA1[r] = __builtin_amdgcn_exp2f(pA1[r]);
  WAIT_BAR(0);
  DMA_K(3, 0); DMA_V(1, SLOTB);
  ROT();
  kload8(kf, kp0 + sl_cur);
  WAIT_BAR(2);
  s16x4 vlo[8], vhi[8]; u32x4 pw0, pw1, pw2, pw3;
  #define PKW(P, B) cvtpk_s(P[B], P[B + 1])
  #define PAF(k) __builtin_bit_cast(bf16x8, pw##k)
  #define VFR(i) (bf16x8){vlo[i][0], vlo[i][1], vlo[i][2], vlo[i][3], vhi[i][0], vhi[i][1], vhi[i][2], vhi[i][3]}
  #define PIN(x) asm volatile("" : "+v"(x))
  #define MX3(a, b, c) __builtin_fmaxf(__builtin_fmaxf((a), (b)), (c))
  #define GAPA(MF, A0, A1, A2, A3, W0, W1, PW) do { MF; sacc += A0; sacc += A1; sacc += A2; sacc += A3; PIN(sacc); W0; W1; PIN(PW); SBAR(); } while (0)
  #define EX(v) __builtin_amdgcn_exp2f(v)
  #define GAPB(MF, X, B) do { MF; X[B] = EX(X[B]); X[B + 1] = EX(X[B + 1]); X[B + 2] = EX(X[B + 2]); X[B + 3] = EX(X[B + 3]); PIN(X); SBAR(); } while (0)
  #define VRD(i) do { vlo[i] = vtr(vp_ + (((i) >> 2) * 4096 + ((i) & 3) * 1024)); vhi[i] = vtr(vp_ + (((i) >> 2) * 4096 + ((i) & 3) * 1024 + 512)); } while (0)
  #define KRD(G, j) do { if (G) { kload2(kf, kp0 + sl_next, j); SBAR(); } } while (0)
  #define STEP(C0, C1, P0, P1, t, GK, GV, GL) do { SBAR(); \
    const lds_cptr vp_ = vp0 + sl_prev; \
    VRD(0); SBAR(); float sacc = (P0[0] + P0[1]); \
    GAPA(C0 = __builtin_amdgcn_mfma_f32_32x32x16_bf16(kf[0], qr[0], CIN, 0, 0, 0), P0[2], P0[3], P0[4], P0[5],     pw0[0] = PKW(P0, 0), pw0[1] = PKW(P0, 2), pw0); \
    VRD(4); SBAR(); GAPA(C1 = __builtin_amdgcn_mfma_f32_32x32x16_bf16(kf[1], qr[0], CIN, 0, 0, 0), P0[6], P0[7], P0[8], P0[9],     pw0[2] = PKW(P0, 4), pw0[3] = PKW(P0, 6), pw0); \
    VRD(1); SBAR(); GAPA(C0 = __builtin_amdgcn_mfma_f32_32x32x16_bf16(kf[2], qr[1], C0, 0, 0, 0),   P0[10], P0[11], P0[12], P0[13], pw1[0] = PKW(P0, 8), pw1[1] = PKW(P0, 10), pw1); \
    VRD(5); SBAR(); GAPA(C1 = __builtin_amdgcn_mfma_f32_32x32x16_bf16(kf[3], qr[1], C1, 0, 0, 0),   P0[14], P0[15], P1[0], P1[1],   pw1[2] = PKW(P0, 12), pw1[3] = PKW(P0, 14), pw1); \
    VRD(2); SBAR(); GAPA(C0 = __builtin_amdgcn_mfma_f32_32x32x16_bf16(kf[4], qr[2], C0, 0, 0, 0),   P1[2], P1[3], P1[4], P1[5],     pw2[0] = PKW(P1, 0), pw2[1] = PKW(P1, 2), pw2); \
    VRD(6); SBAR(); GAPA(C1 = __builtin_amdgcn_mfma_f32_32x32x16_bf16(kf[5], qr[2], C1, 0, 0, 0),   P1[6], P1[7], P1[8], P1[9],     pw2[2] = PKW(P1, 4), pw2[3] = PKW(P1, 6), pw2); \
    VRD(3); SBAR(); GAPA(C0 = __builtin_amdgcn_mfma_f32_32x32x16_bf16(kf[6], qr[3], C0, 0, 0, 0),   P1[10], P1[11], P1[12], P1[13], pw3[0] = PKW(P1, 8), pw3[1] = PKW(P1, 10), pw3); \
    VRD(7); SBAR(); GAPA(C1 = __builtin_amdgcn_mfma_f32_32x32x16_bf16(kf[7], qr[3], C1, 0, 0, 0),   P1[14], P1[15], 0.f, 0.f,       pw3[2] = PKW(P1, 12), pw3[3] = PKW(P1, 14), pw3); \
    l_reg += sacc; \
    if (GK) { DMA_K((t) + 3, sl_cur); } if (GV) { DMA_V((t) + 1, sl_next); } \
    CMASK(C0, C1, t); \
    { float a = MX3(C0[0], C0[1], C1[0]), b = MX3(C0[2], C0[3], C1[1]); a = MX3(a, C1[2], C1[3]); \
      _Pragma("unroll") for (int r = 4; r < 16; r += 4) { a = MX3(a, C0[r], C0[r + 1]); b = MX3(b, C0[r + 2], C0[r + 3]); a = MX3(a, C1[r], C1[r + 1]); b = MX3(b, C1[r + 2], C1[r + 3]); } \
      float rm = __builtin_fmaxf(a, b); { auto rr = __builtin_amdgcn_permlane32_swap(__float_as_uint(rm), __float_as_uint(rm), false, false); rm = __builtin_fmaxf(__uint_as_float(rr[0]), __uint_as_float(rr[1])); } \
      resc = false; \
      if (__builtin_expect(__any(rm > (float)THRL), 0)) { const float dl = __builtin_fmaxf(rm, 0.f); mhat += dl; \
        _Pragma("unroll") for (int r = 0; r < 16; ++r) { C0[r] -= dl; C1[r] -= dl; } \
        if (MODE == MD) { NEGM_SET(0); } \
        const float f = __builtin_amdgcn_exp2f(-dl); l_reg *= f; if (hi == 0) wsf[r32] = f; resc = true; } \
      if (MODE == MA) { NEGM_SET((t) + 1); } } \
    SBAR(); \
    GAPB(o[0] = __builtin_amdgcn_mfma_f32_32x32x16_bf16(PAF(0), VFR(0), o[0], 0, 0, 0), C0, 0); \
    GAPB(o[1] = __builtin_amdgcn_mfma_f32_32x32x16_bf16(PAF(0), VFR(4), o[1], 0, 0, 0), C0, 4); \
    KRD(GL, 0); GAPB(o[0] = __builtin_amdgcn_mfma_f32_32x32x16_bf16(PAF(1), VFR(1), o[0], 0, 0, 0), C0, 8); \
    KRD(GL, 1); GAPB(o[1] = __builtin_amdgcn_mfma_f32_32x32x16_bf16(PAF(1), VFR(5), o[1], 0, 0, 0), C0, 12); \
    KRD(GL, 2); GAPB(o[0] = __builtin_amdgcn_mfma_f32_32x32x16_bf16(PAF(2), VFR(2), o[0], 0, 0, 0), C1, 0); \
    KRD(GL, 3); GAPB(o[1] = __builtin_amdgcn_mfma_f32_32x32x16_bf16(PAF(2), VFR(6), o[1], 0, 0, 0), C1, 4); \
    GAPB(o[0] = __builtin_amdgcn_mfma_f32_32x32x16_bf16(PAF(3), VFR(3), o[0], 0, 0, 0), C1, 8); \
    GAPB(o[1] = __builtin_amdgcn_mfma_f32_32x32x16_bf16(PAF(3), VFR(7), o[1], 0, 0, 0), C1, 12); \
    } while (0)
  int t = 1;
  for (; t + 5 < NT; t += 2) {
    STEP(pB0, pB1, pA0, pA1, t, true, true, true);     WAIT_BAR(2); RESC(); ROT();
    STEP(pA0, pA1, pB0, pB1, t + 1, true, true, true); WAIT_BAR(2); RESC(); ROT();
  }
  #define ENDW(tt) do { if ((tt) + 3 < NT) { WAIT_BAR(2); } else if ((tt) + 2 < NT) { WAIT_BAR(1); } else { WAIT_BAR(0); } } while (0)
  for (; t + 1 < NT; t += 2) {
    STEP(pB0, pB1, pA0, pA1, t, (t + 3 < NT), (t + 1 < NT), (t + 1 < NT));         ENDW(t);     RESC(); ROT();
    STEP(pA0, pA1, pB0, pB1, t + 1, (t + 4 < NT), (t + 2 < NT), (t + 2 < NT));     ENDW(t + 1); RESC(); ROT();
  }
  STEP(pB0, pB1, pA0, pA1, NT - 1, false, false, false); RESC();
  { float sacc = pB0[0] + pB0[1]; _Pragma("unroll") for (int r = 2; r < 16; ++r) sacc += pB0[r]; _Pragma("unroll") for (int r = 0; r < 16; ++r) sacc += pB1[r]; l_reg += sacc;
    pw0 = (u32x4){PKW(pB0, 0), PKW(pB0, 2), PKW(pB0, 4), PKW(pB0, 6)}; pw1 = (u32x4){PKW(pB0, 8), PKW(pB0, 10), PKW(pB0, 12), PKW(pB0, 14)}; pw2 = (u32x4){PKW(pB1, 0), PKW(pB1, 2), PKW(pB1, 4), PKW(pB1, 6)}; pw3 = (u32x4){PKW(pB1, 8), PKW(pB1, 10), PKW(pB1, 12), PKW(pB1, 14)};
    SBAR(); pv(o, vb0 + sl_cur, PAF(0), PAF(1), PAF(2), PAF(3)); }
  #undef PKW
  #undef PAF
  #undef VFR
  #undef PIN
  #undef MX3
  #undef GAPA
  #undef GAPB
  #undef EX
  #undef VRD
  #undef KRD
  #undef STEP
  #undef ENDW
  { auto rr = __builtin_amdgcn_permlane32_swap(__float_as_uint(l_reg), __float_as_uint(l_reg), false, false); l_reg = __uint_as_float(rr[0]) + __uint_as_float(rr[1]); }
  if (MODE == MB) { if (hi == 0) { float* sp = A_.stat + (wid * QBLK + r32) * A_.ss; sp[0] = mhat; sp[1] = l_reg; } }
  if (hi == 0) wsf[32 + r32] = l_reg; asm volatile("s_waitcnt lgkmcnt(0)" ::: "memory");
  float rli[16];
  #pragma unroll
  for (int r = 0; r < 16; ++r) rli[r] = __builtin_amdgcn_rcpf(wsf[32 + crow(r, hi)]);
  bf16* Ow = A_.O + (wid * QBLK) * A_.os;
  { bf16* stg = (bf16*)(shm + LDS_OST) + wid * 2048;
    #pragma unroll
    for (int r = 0; r < 16; ++r) { const int orow = crow(r, hi);
      #pragma unroll
      for (int d0 = 0; d0 < 2; ++d0) stg[orow * 64 + d0 * 32 + r32] = __float2bfloat16(o[d0][r] * rli[r]); }
    asm volatile("s_waitcnt lgkmcnt(0)" ::: "memory");
    #pragma unroll
    for (int i = 0; i < 4; ++i) { const int row = i * 8 + (lane >> 3), ch = lane & 7; const u32x4 v = *(const u32x4*)(stg + row * 64 + ch * 8); *(u32x4*)(Ow + row * A_.os + ch * 8) = v; } }
  asm volatile("s_waitcnt lgkmcnt(0)\n\ts_barrier" ::: "memory");
  #undef DMA_K
  #undef DMA_V
  #undef TT
  #undef CMASK
  #undef CIN
  #undef NEGM_SET
  #undef START
  #undef RESC
  #undef ROT
}

constexpr int L8_K = 0, L8_V = 3 * 8192, L8_WS = L8_V + 3 * 16384, L8_QO = L8_WS + 2048, L8_END = L8_QO + 8 * 4096;
template <int THRL> __device__ __forceinline__ void attn_unit128(const AttnArgs& A_, char* shm) {
  int tid_ = threadIdx.x; asm volatile("" : "+v"(tid_));
  const int tid = tid_, lane = tid & 63, r32 = lane & 31, hi = lane >> 5; const int wid = __builtin_amdgcn_readfirstlane(tid >> 6);
  const bf16* Qw = A_.Q + (wid * QBLK) * A_.qs;
  const unsigned lds0 = (unsigned)(uintptr_t)shm;
  float* wsf = (float*)(shm + L8_WS) + wid * 64;
  const int ks = A_.ks;
  const bf16* ksrc = A_.K + (lane * ks + wid * 8);
  const bf16* vsrc = A_.V + ((16 * (wid & 3) + (lane >> 2)) * ks + (wid >> 2) * 32 + (lane & 3) * 8);
  const unsigned kdst = lds0 + L8_K + wid * 1024, vdst = lds0 + L8_V + wid * 1024;
  #define DMA_K(t, slot) glds16(ksrc + (int)(t) * KVBLK * ks, (unsigned)__builtin_amdgcn_readfirstlane(kdst + (slot)))
  #define DMA_V(t, slot) do { glds16(vsrc + (int)(t) * KVBLK * ks, (unsigned)__builtin_amdgcn_readfirstlane(vdst + 2 * (slot))); \
                              glds16(vsrc + (int)(t) * KVBLK * ks + 64, (unsigned)__builtin_amdgcn_readfirstlane(vdst + 2 * (slot) + 8192)); } while (0)
  const int vb0 = (int)(lds0 + L8_V) + ((lane >> 4) & 1) * 32 + (lane & 3) * 8 + (4 * hi + ((lane & 15) >> 2)) * 64;
  const char* Kbase = shm + L8_K; bf16x8 kf[8];
  const lds_cptr shm3 = (lds_cptr)shm; const lds_cptr kp0 = shm3 + L8_K + hi * 1024 + r32 * 16; const lds_cptr vp0 = shm3 + L8_V + ((lane >> 4) & 1) * 32 + (lane & 3) * 8 + (4 * hi + ((lane & 15) >> 2)) * 64;
  const lds_cptr qst = shm3 + L8_QO + wid * 4096 + lane * 16;
  const int NT = A_.NT;
  DMA_K(0, 0); DMA_V(0, 0); DMA_K(1, SLOTB);
  { bf16x8 qr[4];
    #pragma unroll
    for (int d0 = 0; d0 < 4; ++d0) qr[d0] = *reinterpret_cast<const bf16x8*>(&Qw[r32 * A_.qs + d0 * 16 + hi * 8]);
    #pragma unroll
    for (int d0 = 0; d0 < 4; ++d0) *(LAS bf16x8*)(shm3 + L8_QO + wid * 4096 + lane * 16 + d0 * 1024) = qr[d0]; }
  #define QLD(d0) (*(const LAS bf16x8*)(qst + (d0) * 1024))
  float mhat = 0.f, l_reg = 0.f; f32x16 o[4]; o[0] = f32x16{}; o[1] = f32x16{}; o[2] = f32x16{}; o[3] = f32x16{};
  const int qrel = wid * QBLK + r32;
  #define NB(tn) ({ float nb_ = -mhat; const int wlo_ = A_.q0 + wid * QBLK, sd_ = (64 * (tn) + 63 < wlo_) ? 1 : ((64 * (tn) > wlo_ + 31) ? -1 : 0); \
      if (sd_ != 0) nb_ = fmaf(-(float)sd_ * A_.s2, (float)(A_.q0 + qrel - 64 * (tn) - 4 * hi), nb_); nb_; })
  #define CMASK(P0, P1, t) score_hook<MA>(P0, P1, (t), A_, qrel, hi, wid, r32, mhat)
  bool resc = false;
  #define RESC() do { if (resc) { asm volatile("s_waitcnt lgkmcnt(0)" ::: "memory"); \
      _Pragma("unroll") for (int d_ = 0; d_ < 4; ++d_) _Pragma("unroll") for (int r = 0; r < 16; ++r) o[d_][r] *= wsf[crow(r, hi)]; } } while (0)
  f32x16 pA0, pA1, pB0, pB1;
  int sl_prev = 0, sl_cur = 0, sl_next = SLOTB;
  #define ROT() do { sl_prev = sl_cur; sl_cur = sl_next; sl_next = (sl_next == (NSLOT - 1) * SLOTB) ? 0 : sl_next + SLOTB; } while (0)
  DMA_K(2, 2 * SLOTB);
  WAIT_BAR(4);
  { f32x16 cin; const float nb0 = NB(0);
    #pragma unroll
    for (int r = 0; r < 16; ++r) cin[r] = nb0;
    bf16x8 qr[4];
    #pragma unroll
    for (int d0 = 0; d0 < 4; ++d0) qr[d0] = QLD(d0);
    qkt(pA0, pA1, Kbase, qr, cin, r32, hi); }
  asm volatile("s_nop 15\n\ts_nop 7" : "+v"(pA0), "+v"(pA1)); CMASK(pA0, pA1, 0);
  { const float rm = rowmax(pA0, pA1); mhat = fadd_s(mhat, rm);
    #pragma unroll
    for (int r = 0; r < 16; ++r) { pA0[r] = fsub_s(pA0[r], rm); pA1[r] = fsub_s(pA1[r], rm); }
    #pragma unroll
    for (int r = 0; r < 16; ++r) pA0[r] = __builtin_amdgcn_exp2f(pA0[r]);
    #pragma unroll
    for (int r = 0; r < 16; ++r) pA1[r] = __builtin_amdgcn_exp2f(pA1[r]); }
  WAIT_BAR(0);
  DMA_K(3, 0); DMA_V(1, SLOTB);
  ROT();
  kload8(kf, kp0 + sl_cur);
  WAIT_BAR(3);
  u32x4 pw0, pw1, pw2, pw3;
  #define PKW(P, B) cvtpk_s(P[B], P[B + 1])
  #define PAF(k) __builtin_bit_cast(bf16x8, pw##k)
  #define VFR(i) (bf16x8){vlo[i][0], vlo[i][1], vlo[i][2], vlo[i][3], vhi[i][0], vhi[i][1], vhi[i][2], vhi[i][3]}
  #define WFR(i) (bf16x8){wlo[i][0], wlo[i][1], wlo[i][2], wlo[i][3], whi[i][0], whi[i][1], whi[i][2], whi[i][3]}
  #define PIN(x) asm volatile("" : "+v"(x))
  #define MX3(a, b, c) __builtin_fmaxf(__builtin_fmaxf((a), (b)), (c))
  #define GAPA(MF, A0, A1, A2, A3, W0, W1, PW) do { MF; sacc += A0; sacc += A1; sacc += A2; sacc += A3; PIN(sacc); W0; W1; PIN(PW); SBAR(); } while (0)
  #define EX(v) __builtin_amdgcn_exp2f(v)
  #define GAPB(MF, X, B) do { MF; X[B] = EX(X[B]); X[B + 1] = EX(X[B + 1]); PIN(X); SBAR(); } while (0)
  #define VRD(i) do { vlo[i] = vtr(vp_ + (((i) >> 2) * 4096 + ((i) & 3) * 1024)); vhi[i] = vtr(vp_ + (((i) >> 2) * 4096 + ((i) & 3) * 1024 + 512)); } while (0)
  #define VRD2(i) do { wlo[i] = vtr(vp_ + (8192 + ((i) >> 2) * 4096 + ((i) & 3) * 1024)); whi[i] = vtr(vp_ + (8192 + ((i) >> 2) * 4096 + ((i) & 3) * 1024 + 512)); SBAR(); } while (0)
  #define KRD(G, j) do { if (G) { kload2(kf, kp0 + sl_next, j); SBAR(); } } while (0)
  #define FOFF(j) (((((j) & 1) + 2 * ((j) >> 3)) * 4096) + ((((j) >> 1) & 3) * 1024))
  #define FRD(j) do { fl[j] = vtr(vp_ + FOFF(j)); fh[j] = vtr(vp_ + FOFF(j) + 512); SBAR(); } while (0)
  #define FFR(j) (bf16x8){fl[j][0], fl[j][1], fl[j][2], fl[j][3], fh[j][0], fh[j][1], fh[j][2], fh[j][3]}
  #define STEP(C0, C1, P0, P1, t, GK, GV, GL) do { SBAR(); \
    const lds_cptr vp_ = vp0 + 2 * sl_prev; s16x4 fl[16], fh[16]; \
    { const float nb_t = NB(t); _Pragma("unroll") for (int r = 0; r < 16; ++r) { C0[r] = nb_t; C1[r] = nb_t; } } \
    bf16x8 q0_ = QLD(0), q1_ = QLD(1); SBAR(); float sacc = (P0[0] + P0[1]); \
    GAPA(C0 = __builtin_amdgcn_mfma_f32_32x32x16_bf16(kf[0], q0_, C0, 0, 0, 0), P0[2], P0[3], P0[4], P0[5],     pw0[0] = PKW(P0, 0), pw0[1] = PKW(P0, 2), pw0); \
    GAPA(C1 = __builtin_amdgcn_mfma_f32_32x32x16_bf16(kf[1], q0_, C1, 0, 0, 0), P0[6], P0[7], P0[8], P0[9],     pw0[2] = PKW(P0, 4), pw0[3] = PKW(P0, 6), pw0); \
    q0_ = QLD(2); SBAR(); \
    GAPA(C0 = __builtin_amdgcn_mfma_f32_32x32x16_bf16(kf[2], q1_, C0, 0, 0, 0),   P0[10], P0[11], P0[12], P0[13], pw1[0] = PKW(P0, 8), pw1[1] = PKW(P0, 10), pw1); \
    GAPA(C1 = __builtin_amdgcn_mfma_f32_32x32x16_bf16(kf[3], q1_, C1, 0, 0, 0),   P0[14], P0[15], P1[0], P1[1],   pw1[2] = PKW(P0, 12), pw1[3] = PKW(P0, 14), pw1); \
    q1_ = QLD(3); SBAR(); \
    GAPA(C0 = __builtin_amdgcn_mfma_f32_32x32x16_bf16(kf[4], q0_, C0, 0, 0, 0),   P1[2], P1[3], P1[4], P1[5],     pw2[0] = PKW(P1, 0), pw2[1] = PKW(P1, 2), pw2); \
    GAPA(C1 = __builtin_amdgcn_mfma_f32_32x32x16_bf16(kf[5], q0_, C1, 0, 0, 0),   P1[6], P1[7], P1[8], P1[9],     pw2[2] = PKW(P1, 4), pw2[3] = PKW(P1, 6), pw2); \
    GAPA(C0 = __builtin_amdgcn_mfma_f32_32x32x16_bf16(kf[6], q1_, C0, 0, 0, 0),   P1[10], P1[11], P1[12], P1[13], pw3[0] = PKW(P1, 8), pw3[1] = PKW(P1, 10), pw3); \
    GAPA(C1 = __builtin_amdgcn_mfma_f32_32x32x16_bf16(kf[7], q1_, C1, 0, 0, 0),   P1[14], P1[15], 0.f, 0.f,       pw3[2] = PKW(P1, 12), pw3[3] = PKW(P1, 14), pw3); \
    l_reg += sacc; \
    if (GK) { DMA_K((t) + 3, sl_cur); } if (GV) { DMA_V((t) + 1, sl_next); } \
    FRD(0); FRD(1); FRD(2); \
    CMASK(C0, C1, t); \
    { float a = MX3(C0[0], C0[1], C1[0]), b = MX3(C0[2], C0[3], C1[1]); a = MX3(a, C1[2], C1[3]); \
      _Pragma("unroll") for (int r = 4; r < 16; r += 4) { a = MX3(a, C0[r], C0[r + 1]); b = MX3(b, C0[r + 2], C0[r + 3]); a = MX3(a, C1[r], C1[r + 1]); b = MX3(b, C1[r + 2], C1[r + 3]); } \
      float rm = __builtin_fmaxf(a, b); { auto rr = __builtin_amdgcn_permlane32_swap(__float_as_uint(rm), __float_as_uint(rm), false, false); rm = __builtin_fmaxf(__uint_as_float(rr[0]), __uint_as_float(rr[1])); } \
      resc = false; \
      if (__builtin_expect(__any(rm > (float)THRL), 0)) { const float dl = __builtin_fmaxf(rm, 0.f); mhat += dl; \
        _Pragma("unroll") for (int r = 0; r < 16; ++r) { C0[r] -= dl; C1[r] -= dl; } \
        const float f = __builtin_amdgcn_exp2f(-dl); l_reg *= f; if (hi == 0) wsf[r32] = f; resc = true; } } \
    SBAR(); \
    GAPB(o[0] = __builtin_amdgcn_mfma_f32_32x32x16_bf16(PAF(0), FFR(0), o[0], 0, 0, 0), C0, 0);   FRD(3); \
    GAPB(o[1] = __builtin_amdgcn_mfma_f32_32x32x16_bf16(PAF(0), FFR(1), o[1], 0, 0, 0), C0, 2);   FRD(4); \
    GAPB(o[0] = __builtin_amdgcn_mfma_f32_32x32x16_bf16(PAF(1), FFR(2), o[0], 0, 0, 0), C0, 4);   FRD(5); \
    GAPB(o[1] = __builtin_amdgcn_mfma_f32_32x32x16_bf16(PAF(1), FFR(3), o[1], 0, 0, 0), C0, 6);   FRD(6); \
    GAPB(o[0] = __builtin_amdgcn_mfma_f32_32x32x16_bf16(PAF(2), FFR(4), o[0], 0, 0, 0), C0, 8);   FRD(7); \
    GAPB(o[1] = __builtin_amdgcn_mfma_f32_32x32x16_bf16(PAF(2), FFR(5), o[1], 0, 0, 0), C0, 10);  FRD(8); \
    GAPB(o[0] = __builtin_amdgcn_mfma_f32_32x32x16_bf16(PAF(3), FFR(6), o[0], 0, 0, 0), C0, 12);  FRD(9); \
    GAPB(o[1] = __builtin_amdgcn_mfma_f32_32x32x16_bf16(PAF(3), FFR(7), o[1], 0, 0, 0), C0, 14);  FRD(10); \
    KRD(GL, 0); GAPB(o[2] = __builtin_amdgcn_mfma_f32_32x32x16_bf16(PAF(0), FFR(8), o[2], 0, 0, 0), C1, 0);   FRD(11); \
    KRD(GL, 1); GAPB(o[3] = __builtin_amdgcn_mfma_f32_32x32x16_bf16(PAF(0), FFR(9), o[3], 0, 0, 0), C1, 2);   FRD(12); \
    KRD(GL, 2); GAPB(o[2] = __builtin_amdgcn_mfma_f32_32x32x16_bf16(PAF(1), FFR(10), o[2], 0, 0, 0), C1, 4);  FRD(13); \
    KRD(GL, 3); GAPB(o[3] = __builtin_amdgcn_mfma_f32_32x32x16_bf16(PAF(1), FFR(11), o[3], 0, 0, 0), C1, 6);  FRD(14); \
    GAPB(o[2] = __builtin_amdgcn_mfma_f32_32x32x16_bf16(PAF(2), FFR(12), o[2], 0, 0, 0), C1, 8);  FRD(15); \
    GAPB(o[3] = __builtin_amdgcn_mfma_f32_32x32x16_bf16(PAF(2), FFR(13), o[3], 0, 0, 0), C1, 10); \
    GAPB(o[2] = __builtin_amdgcn_mfma_f32_32x32x16_bf16(PAF(3), FFR(14), o[2], 0, 0, 0), C1, 12); \
    GAPB(o[3] = __builtin_amdgcn_mfma_f32_32x32x16_bf16(PAF(3), FFR(15), o[3], 0, 0, 0), C1, 14); \
    } while (0)
  int t = 1;
  for (; t + 5 < NT; t += 2) {
    STEP(pB0, pB1, pA0, pA1, t, true, true, true);     WAIT_BAR(3); RESC(); ROT();
    STEP(pA0, pA1, pB0, pB1, t + 1, true, true, true); WAIT_BAR(3); RESC(); ROT();
  }
  #define ENDW(tt) do { if ((tt) + 3 < NT) { WAIT_BAR(3); } else if ((tt) + 2 < NT) { WAIT_BAR(2); } else { WAIT_BAR(0); } } while (0)
  for (; t + 1 < NT; t += 2) {
    STEP(pB0, pB1, pA0, pA1, t, (t + 3 < NT), (t + 1 < NT), (t + 1 < NT));         ENDW(t);     RESC(); ROT();
    STEP(pA0, pA1, pB0, pB1, t + 1, (t + 4 < NT), (t + 2 < NT), (t + 2 < NT));     ENDW(t + 1); RESC(); ROT();
  }
  STEP(pB0, pB1, pA0, pA1, NT - 1, false, false, false); RESC();
  { float sacc = pB0[0] + pB0[1]; _Pragma("unroll") for (int r = 2; r < 16; ++r) sacc += pB0[r]; _Pragma("unroll") for (int r = 0; r < 16; ++r) sacc += pB1[r]; l_reg += sacc;
    pw0 = (u32x4){PKW(pB0, 0), PKW(pB0, 2), PKW(pB0, 4), PKW(pB0, 6)}; pw1 = (u32x4){PKW(pB0, 8), PKW(pB0, 10), PKW(pB0, 12), PKW(pB0, 14)}; pw2 = (u32x4){PKW(pB1, 0), PKW(pB1, 2), PKW(pB1, 4), PKW(pB1, 6)}; pw3 = (u32x4){PKW(pB1, 8), PKW(pB1, 10), PKW(pB1, 12), PKW(pB1, 14)};
    SBAR(); pv(o, vb0 + 2 * sl_cur, PAF(0), PAF(1), PAF(2), PAF(3)); pv(o + 2, vb0 + 2 * sl_cur + 8192, PAF(0), PAF(1), PAF(2), PAF(3)); }
  #undef PKW
  #undef PAF
  #undef VFR
  #undef WFR
  #undef PIN
  #undef MX3
  #undef GAPA
  #undef GAPB
  #undef EX
  #undef VRD
  #undef FOFF
  #undef FRD
  #undef FFR
  #undef KRD
  #undef STEP
  #undef ENDW
  { auto rr = __builtin_amdgcn_permlane32_swap(__float_as_uint(l_reg), __float_as_uint(l_reg), false, false); l_reg = __uint_as_float(rr[0]) + __uint_as_float(rr[1]); }
  if (hi == 0) wsf[32 + r32] = l_reg; asm volatile("s_waitcnt lgkmcnt(0)" ::: "memory");
  float rli[16];
  #pragma unroll
  for (int r = 0; r < 16; ++r) rli[r] = __builtin_amdgcn_rcpf(wsf[32 + crow(r, hi)]);
  bf16* Ow = A_.O + (wid * QBLK) * A_.os;
  { bf16* stg = (bf16*)(shm + L8_QO) + wid * 2048;
    #pragma unroll
    for (int hv = 0; hv < 2; ++hv) {
      #pragma unroll
      for (int r = 0; r < 16; ++r) { const int orow = crow(r, hi);
        #pragma unroll
        for (int d0 = 0; d0 < 2; ++d0) stg[orow * 64 + d0 * 32 + r32] = __float2bfloat16(o[2 * hv + d0][r] * rli[r]); }
      asm volatile("s_waitcnt lgkmcnt(0)" ::: "memory");
      #pragma unroll
      for (int i = 0; i < 4; ++i) { const int row = i * 8 + (lane >> 3), ch = lane & 7; const u32x4 v = *(const u32x4*)(stg + row * 64 + ch * 8); *(u32x4*)(Ow + row * A_.os + hv * 64 + ch * 8) = v; }
      asm volatile("s_waitcnt lgkmcnt(0)" ::: "memory"); } }
  asm volatile("s_waitcnt lgkmcnt(0)\n\ts_barrier" ::: "memory");
  #undef DMA_K
  #undef DMA_V
  #undef QLD
  #undef NB
  #undef CMASK
  #undef RESC
  #undef ROT
}
#undef SBAR
#undef WAIT_BAR
}

__device__ __forceinline__ void transpose_item(const float* W, int K, int N, bf16_t* WT, LAS float* scr, int item, int lane) {
    const int nblk = N / 32, kb = item / nblk, nb = item % nblk, k0 = 64 * kb, n0 = 32 * nb;
#pragma unroll 8
    for (int i = 0; i < 32; ++i) { const int kk = 2 * i + (lane >> 5); scr[kk * 33 + (lane & 31)] = W[(size_t)(k0 + kk) * N + n0 + (lane & 31)]; }
    asm volatile("s_waitcnt lgkmcnt(0)" ::: "memory");
    const int c = lane & 7;
#pragma unroll
    for (int j = 0; j < 4; ++j) { const int n = (lane >> 3) + 8 * j; const LAS float* s = scr + (8 * c) * 33 + n;
        u32x4 o; o.x = pk2(s[0 * 33], s[1 * 33]); o.y = pk2(s[2 * 33], s[3 * 33]); o.z = pk2(s[4 * 33], s[5 * 33]); o.w = pk2(s[6 * 33], s[7 * 33]);
        *(u32x4*)(WT + (size_t)(n0 + n) * K + k0 + 8 * c) = o; }
    asm volatile("s_waitcnt lgkmcnt(0)" ::: "memory");
}
__device__ __forceinline__ void rms_row_bf16(const float* xrow, const float* g, bf16_t* orow, int lane) {
    const f32x4* xr = (const f32x4*)xrow + lane; const f32x4* gr = (const f32x4*)g + lane;
    f32x4 v[4]; float s = 0.f;
#pragma unroll
    for (int j = 0; j < 4; ++j) { v[j] = xr[64 * j]; s += (v[j].x * v[j].x + v[j].y * v[j].y) + (v[j].z * v[j].z + v[j].w * v[j].w); }
    const float rs = rsqrtf(wave_sum(s) * (1.f / DM) + EPS);
    u32x2* o8 = (u32x2*)orow + lane;
#pragma unroll
    for (int j = 0; j < 4; ++j) { const f32x4 gg = gr[64 * j]; u32x2 w; w.x = pk2(v[j].x * rs * gg.x, v[j].y * rs * gg.y); w.y = pk2(v[j].z * rs * gg.z, v[j].w * rs * gg.w); o8[64 * j] = w; }
}
__device__ __forceinline__ void sincos_red(float a, float& s, float& c) {
    const float q = rintf(a * 0.636619772367581f); const int iq = (int)q;
    float r = fmaf(q, -1.5703125f, a); r = fmaf(q, -4.837512969970703125e-4f, r); r = fmaf(q, -7.54978995489188216e-8f, r);
    const float r2 = r * r;
    const float sp = r + r * r2 * (-1.6666654611e-1f + r2 * (8.3321608736e-3f + r2 * (-1.9515295891e-4f)));
    const float cp = 1.0f - 0.5f * r2 + r2 * r2 * (4.166664568298827e-2f + r2 * (-1.388731625493765e-3f + r2 * 2.443315711809948e-5f));
    const int k = iq & 3;
    s = (k == 0) ? sp : (k == 1) ? cp : (k == 2) ? -sp : -cp;
    c = (k == 0) ? cp : (k == 1) ? -sp : (k == 2) ? -cp : sp;
}

#define XB_TMO      128
#define XB_XCNT(j)  (256  + 64 * (j))
#define XB_XSUB(j)  (1280 + 64 * (j))
#define XB_XGEN(j)  (2304 + 64 * (j))
#define XB_TOP      3328
#define XB_TOPGEN   3392
#define XCD_BAR_WORDS 3456
#define XB_SPIN_CAP (1u << 18)

__device__ __forceinline__ unsigned xb_ld(unsigned* p)              { return __hip_atomic_load(p, __ATOMIC_RELAXED, __HIP_MEMORY_SCOPE_AGENT); }
__device__ __forceinline__ unsigned xb_add(unsigned* p, unsigned v) { return __hip_atomic_fetch_add(p, v, __ATOMIC_RELAXED, __HIP_MEMORY_SCOPE_AGENT); }
__device__ __forceinline__ unsigned xb_xcc_id() { return (unsigned)__builtin_amdgcn_s_getreg((3 << 11) | 20) & 0xFu; }
#define XB_SPIN(cond, bar) do { unsigned _sp = 0; while (cond) { __builtin_amdgcn_s_sleep(1); \
    if ((++_sp & 255u) == 0u) { if (xb_ld(&(bar)[XB_TMO])) break; if (_sp > XB_SPIN_CAP) { atomicAdd(&(bar)[XB_TMO], 1u); break; } } } } while (0)

struct XcdBarrier {
    unsigned* bar; unsigned x;
    volatile LAS unsigned* st;
};

__device__ __forceinline__ XcdBarrier xcd_barrier_post(unsigned* bar, volatile LAS unsigned* st) {
    XcdBarrier b; b.bar = bar; b.x = xb_xcc_id(); b.st = st;
    if (threadIdx.x == 0) (void)xb_add(&bar[XB_XCNT(b.x)], 1u);
    return b;
}
__device__ __forceinline__ void xcd_barrier_complete(unsigned* bar, unsigned x, unsigned& nloc, unsigned& nx) {
    const unsigned G = gridDim.x * gridDim.y * gridDim.z;
    unsigned sum, cnt, mine, sp = 0u;
    for (;;) {
        sum = 0u; cnt = 0u; mine = 0u;
#pragma unroll
        for (unsigned j = 0; j < 16; ++j) { const unsigned c = xb_ld(&bar[XB_XCNT(j)]); sum += c; cnt += (c > 0u) ? 1u : 0u; mine = (j == x) ? c : mine; }
        if (sum == G) break;
        __builtin_amdgcn_s_sleep(1);
        if ((++sp & 255u) == 0u) { if (xb_ld(&bar[XB_TMO])) break; if (sp > XB_SPIN_CAP) { atomicAdd(&bar[XB_TMO], 1u); break; } }
    }
    nloc = mine > 0u ? mine : 1u; nx = cnt > 0u ? cnt : 1u;
}

__device__ __forceinline__ void xcd_barrier(const XcdBarrier& b) {
    asm volatile("s_waitcnt vmcnt(0)" ::: "memory");
    __syncthreads();
    if (threadIdx.x == 0) {
        unsigned* bar = b.bar;
        __builtin_amdgcn_s_waitcnt(0);
        unsigned nloc = b.st[0], nx = b.st[1];
        if (nloc == 0u) { xcd_barrier_complete(bar, b.x, nloc, nx); b.st[0] = nloc; b.st[1] = nx; }
        const unsigned old = xb_add(&bar[XB_XSUB(b.x)], 1u);
        const unsigned gen = old / nloc;
        if (old + 1u == (gen + 1u) * nloc) {
            __builtin_amdgcn_fence(__ATOMIC_RELEASE, "agent");
            asm volatile("s_waitcnt vmcnt(0)" ::: "memory");
            const unsigned og = xb_add(&bar[XB_TOP], 1u);
            const unsigned tg = og / nx;
            if (og + 1u == (tg + 1u) * nx) xb_add(&bar[XB_TOPGEN], 1u);
            else XB_SPIN(xb_ld(&bar[XB_TOPGEN]) == tg, bar);
            __builtin_amdgcn_fence(__ATOMIC_ACQUIRE, "agent");
            xb_add(&bar[XB_XGEN(b.x)], 1u);
            asm volatile("s_waitcnt vmcnt(0)" ::: "memory");
        } else {
            XB_SPIN(xb_ld(&bar[XB_XGEN(b.x)]) == gen, bar);
            __builtin_amdgcn_fence(__ATOMIC_ACQUIRE, "agent");
            asm volatile("s_waitcnt vmcnt(0)" ::: "memory");
        }
    }
    __syncthreads();
}


struct Args { const float* in[14]; float* out; unsigned char* ws; };

__global__ void __launch_bounds__(512) mk_fwd(Args args) {
    extern __shared__ __attribute__((aligned(16))) unsigned char lds[];
    cg::grid_group grid = cg::this_grid();
    const int tid0 = threadIdx.x, wave = __builtin_amdgcn_readfirstlane(tid0 >> 6);
#define FRESH_LANE() int tid = tid0; asm volatile("" : "+v"(tid)); const int lane = tid & 63
    const int G = gridDim.x, bx = blockIdx.x;
    const int vcu = (G % 8 == 0) ? (bx % 8) * (G / 8) + bx / 8 : bx;
    const int gw = vcu * 8 + wave, NGW = G * 8;
    LAS unsigned char* ldsl = (LAS unsigned char*)lds;
    if (tid0 < 8) ((LAS unsigned*)(ldsl + MISC_OFF))[tid0] = 0u;
    __syncthreads();
    const XcdBarrier xbar = xcd_barrier_post((unsigned*)(args.ws + WS_BAR), (volatile LAS unsigned*)(ldsl + MISC_OFF));
#define ws (args.ws)
#define x_in (args.in[0])
#define norm_mix (args.in[1])
#define w_in (args.in[2])
#define b_gate (args.in[3])
#define diff_lambda (args.in[4])
#define diff_subln (args.in[5])
#define na_rpb (args.in[6])
#define qk_norm (args.in[7])
#define w_branch (args.in[8])
#define w_out (args.in[9])
#define norm_ffn (args.in[10])
#define w_ff1 (args.in[11])
#define w_ff2 (args.in[12])
#define norm_final (args.in[13])
#define xout (args.out)
#define WinT ((bf16_t*)(ws + WS_WIN))
#define WbrT ((bf16_t*)(ws + WS_WBR))
#define WoutT ((bf16_t*)(ws + WS_WOUT))
#define W1T ((bf16_t*)(ws + WS_W1))
#define W2T ((bf16_t*)(ws + WS_W2))
#define STAT ((float*)(ws + WS_STAT))
#define H ((bf16_t*)(ws + WS_H))
#define ATMP ((bf16_t*)(ws + WS_ATMP))
#define BTMP ((bf16_t*)(ws + WS_BTMP))
#define Y ((bf16_t*)(ws + WS_Y))
#define MERGED ((bf16_t*)(ws + WS_MERGED))
#define Z ((bf16_t*)(ws + WS_Z))
#define U ((bf16_t*)(ws + WS_Z))
#define PROJ ((bf16_t*)(ws + WS_PROJ))
#define NRMQ ((unsigned*)(ws + WS_NRM))
#define NRMK ((unsigned*)(ws + WS_NRM) + 1024)

    {
        FRESH_LANE();
        LAS float* scr = (LAS float*)(ldsl + wave * 16384);
        constexpr int I_IN = (DM / 64) * (INW / 32), I_BR = (512 / 64) * (DM / 32), I_OUT = (DM / 64) * (DM / 32), I_1 = (DM / 64) * (DFF / 32), I_2 = (DFF / 64) * (DM / 32);
        constexpr int NITEMS = 2 * I_IN + 8 * I_BR + 2 * I_OUT + 2 * I_1 + 2 * I_2;
        for (int it = gw; it < NITEMS; it += NGW) {
            int r = it;
            if (r < 2 * I_IN) { const int l = r / I_IN; transpose_item(w_in + (size_t)l * DM * INW, DM, INW, WinT + (size_t)l * INW * DM, scr, r % I_IN, lane); continue; } r -= 2 * I_IN;
            if (r < 8 * I_BR) { const int ln = r / I_BR; transpose_item(w_branch + (size_t)ln * 512 * DM, 512, DM, WbrT + (size_t)ln * DM * 512, scr, r % I_BR, lane); continue; } r -= 8 * I_BR;
            if (r < 2 * I_OUT) { const int l = r / I_OUT; transpose_item(w_out + (size_t)l * DM * DM, DM, DM, WoutT + (size_t)l * DM * DM, scr, r % I_OUT, lane); continue; } r -= 2 * I_OUT;
            if (r < 2 * I_1) { const int l = r / I_1; transpose_item(w_ff1 + (size_t)l * DM * DFF, DM, DFF, W1T + (size_t)l * DFF * DM, scr, r % I_1, lane); continue; } r -= 2 * I_1;
            { const int l = r / I_2; transpose_item(w_ff2 + (size_t)l * DFF * DM, DFF, DM, W2T + (size_t)l * DM * DFF, scr, r % I_2, lane); }
        }
        for (int m = gw; m < TG; m += NGW) rms_row_bf16(x_in + (size_t)m * DM, norm_mix, H + (size_t)m * DM, lane);
    }
    grid.sync();

    for (int l = 0; l < DEPTH; ++l) {
        const float lam_init = 0.8f - 0.6f * __expf(-0.3f * (float)l);
        float lam;
        { FRESH_LANE(); const float* lp = diff_lambda + l * 256; const float a = lp[lane] * lp[64 + lane], b = lp[128 + lane] * lp[192 + lane]; lam = expf(wave_sum(a)) - expf(wave_sum(b)) + lam_init; lam = __uint_as_float(__builtin_amdgcn_readfirstlane(__float_as_uint(lam))); }
        const float out_scale = 1.f - lam_init;
        { FRESH_LANE(); LAS float* tab = (LAS float*)(ldsl + TAB_OFF); for (int i = tid; i < 8 * 465; i += 512) tab[i] = na_rpb[l * 8 * 465 + i] * LOG2E; }
        __syncthreads();
        for (int grp = 0; grp < NGRP; ++grp) {
            const size_t tok0 = (size_t)grp * TG;
            const float* xsrc = (l == 0) ? x_in : xout;
            {
                pg8::Gemm g{H, WinT + (size_t)l * INW * DM, DM, DM, DM, 1 << 30, 0}; pg8::StaticOrder S; S.init(TG, INW, G, bx);
                if (bx == 0) { for (int i = tid0; i < 1024 + 16; i += 512) NRMQ[i] = 0u; }
                pg8::Epi<0> E{PROJ, nullptr, nullptr, b_gate + l * 4096, INW};
                pg8::gemm_phase(ldsl, g, S, E);
            }
            xcd_barrier(xbar);
            {
                FRESH_LANE();
                const float inv = exp2f(-(float)(lane & 15) * 0.8304820237218406f);
                const float gq = qk_norm[l * 128 + lane], gk = qk_norm[l * 128 + 64 + lane];
                const int per = (TG + NGW - 1) / NGW;
                float mq = 0.f, mk = 0.f; int cu = -1;
                for (int i = 0; i < per; ++i) {
                    const int m = gw * per + i; if (m >= TG) break;
                    if ((m >> 8) != cu) { if (cu >= 0 && (lane & 7) == 0) { atomicMax(NRMQ + cu * 8 + (lane >> 3), __float_as_uint(mq)); atomicMax(NRMK + (cu >> 5) * 8 + (lane >> 3), __float_as_uint(mk)); } cu = m >> 8; mq = 0.f; mk = 0.f; }
                    const int s = (int)((tok0 + m) % SEQ); const float pos = (float)((lane < 32) ? (s >> 6) : (s & 63));
                    float sn, cs; sincos_red(pos * inv, sn, cs);
                    { const bf16_t* ar = PROJ + (size_t)m * INW; const u32x4 qv = *(const u32x4*)(ar + COL_AQ + lane * 8), kv = *(const u32x4*)(ar + COL_AK + lane * 8);
                      float nq = 0.f, nk = 0.f;
#pragma unroll
                      for (int e = 0; e < 4; ++e) { nq += bflo(qv[e]) * bflo(qv[e]) + bfhi(qv[e]) * bfhi(qv[e]); nk += bflo(kv[e]) * bflo(kv[e]) + bfhi(kv[e]) * bfhi(kv[e]); }
                      nq += __shfl_xor(nq, 1); nk += __shfl_xor(nk, 1); nq += __shfl_xor(nq, 2); nk += __shfl_xor(nk, 2); nq += __shfl_xor(nq, 4); nk += __shfl_xor(nk, 4);
                      mq = fmaxf(mq, sqrtf(nq)); mk = fmaxf(mk, sqrtf(nk)); }
                    bf16_t* row = PROJ + (size_t)m * INW + COL_DQ;
#pragma unroll
                    for (int hd = 0; hd < 10; ++hd) {
                        const float v = __uint_as_float((unsigned)row[hd * 64 + lane] << 16);
                        const float rn = rsqrtf(wave_sum(v * v) * (1.f / 64.f) + EPS);
                        const float y = v * rn * (hd < 8 ? gq : gk);
                        const float p = __shfl_xor(y, 16);
                        float o = ((lane >> 4) & 1) ? (y * cs + p * sn) : (y * cs - p * sn);
                        if (hd < 8) o *= C2;
                        row[hd * 64 + lane] = (bf16_t)f2bf(o);
                    }
                }
                if (cu >= 0 && (lane & 7) == 0) { atomicMax(NRMQ + cu * 8 + (lane >> 3), __float_as_uint(mq)); atomicMax(NRMK + (cu >> 5) * 8 + (lane >> 3), __float_as_uint(mk)); }
            }
            xcd_barrier(xbar);
            {
                using namespace attn_body;
                char* shm = (char*)lds;
                {
                    unsigned* qctr = (unsigned*)(ws + WS_BAR) + 3584 + (l * NGRP + grp) * 8;
                    volatile LAS unsigned* slot = (volatile LAS unsigned*)(ldsl + MISC_OFF + 32);
                    const int myx = (G % 8 == 0) ? (vcu / (G / 8)) : 0;
                    for (int qq = 0; qq < 8; ++qq) {
                        const int sx = (myx + qq) & 7;
                        for (;;) {
                            if (tid0 == 0) *slot = atomicAdd(qctr + sx, 1u);
                            __syncthreads();
                            const int j = (int)*slot;
                            __syncthreads();
                            if (j >= 128) break;
                            const int qb = j & 31; AttnArgs a{}; a.qs = INW; a.ks = INW; a.NT = 128; a.tlo = 0; a.thi = 127;
                            if (j >= 32 && j < 96) { const int ds = 2 * sx + ((j - 32) >> 5), bb = ds >> 3, h = ds & 7; const size_t tb = (size_t)bb * SEQ;
                                a.Q = (const bf16*)(PROJ + (tb + qb * 256) * INW + COL_DQ + h * 64); a.K = (const bf16*)(PROJ + tb * INW + COL_DK + (h >> 2) * 64);
                                a.V = (const bf16*)(PROJ + tb * INW + COL_DV + (h >> 2) * 64); a.O = (bf16*)(Y + (tb + qb * 256) * 2048 + 1536 + h * 64); a.os = 2048;
                                attn_unit<MD, 8>(a, shm);
                            } else { const int bb = sx >> 2, hh = ((j < 32) ? 2 : 0) + ((sx >> 1) & 1), comp = sx & 1; const size_t tb = (size_t)bb * SEQ;
                                a.Q = (const bf16*)(PROJ + (tb + qb * 256) * INW + COL_AQ + hh * 128 + comp * 64); a.K = (const bf16*)(PROJ + tb * INW + COL_AK + hh * 128 + comp * 64);
                                a.V = (const bf16*)(PROJ + tb * INW + COL_AV + hh * 128); a.O = (bf16*)(ATMP + (tb + qb * 256) * 1024 + (hh * 2 + comp) * 128); a.os = 1024;
                                a.s2 = exp2f(-2.f * (float)(hh + 1)) * LOG2E;
                                const float Bs = __uint_as_float(NRMQ[(bb * 32 + qb) * 8 + hh * 2 + comp]) * __uint_as_float(NRMK[bb * 8 + hh * 2 + comp]) * 1.02f + 0.25f;
                                const float dlim = fminf((150.f + 2.f * Bs) / a.s2, 1.0e6f), q0f = (float)(qb * 256);
                                int tlo = max(0, (int)floorf((q0f - 63.f - dlim) * (1.f / 64.f))), thi = min(127, (int)ceilf((q0f + 255.f + dlim) * (1.f / 64.f)));
                                if (((thi - tlo + 1) & 1) != 0) { if (tlo > 0) --tlo; else ++thi; }
                                tlo = __builtin_amdgcn_readfirstlane(tlo); thi = __builtin_amdgcn_readfirstlane(thi);
                                a.K += (size_t)tlo * 64 * INW; a.V += (size_t)tlo * 64 * INW; a.q0 = qb * 256 - 64 * tlo; a.NT = thi - tlo + 1;
                                attn_unit128<8>(a, shm);
                            }
                        }
                    }
                }
                for (int u = vcu; u < GB * 24 * 32; u += G) {
                    const int sg = u >> 5, blk = u & 31, bb = sg / 24, k = sg % 24, gp = k >> 3, h = k & 7, dsh = 2 * gp, dil = 1 << dsh;
                    const int nblk = 32 >> dsh, res = blk / nblk, i0 = (blk % nblk) * 256, L = SEQ >> dsh;
                    const long tq = (long)bb * SEQ + res + (long)i0 * dil, tk = (long)bb * SEQ + res + (long)(i0 - 64) * dil;
                    AttnArgs a{}; a.qs = dil * INW; a.ks = dil * INW; a.os = dil * 1536; a.NT = 6; a.tlo = (i0 == 0) ? 1 : 0; a.thi = (i0 + 256 == L) ? 4 : 5;
                    const int cq = COL_B + gp * 1536 + h * 64;
                    a.Q = (const bf16*)(PROJ + tq * INW + cq); a.K = (const bf16*)(PROJ + tk * INW + cq + 512); a.V = (const bf16*)(PROJ + tk * INW + cq + 1024);
                    a.O = (bf16*)(BTMP + tq * 1536 + gp * 512 + h * 64);
                    a.s2 = exp2f(-(float)(h + 1)) * (float)dil * LOG2E; a.stat = STAT + (tq * 24 + gp * 8 + h) * 2; a.ss = dil * 48;
                    attn_unit<MB, 8>(a, shm);
                }
                for (int u = vcu; u < GB * 8 * 32; u += G) {
                    const int sg = u >> 5, qb = u & 31, bb = sg >> 3, h = sg & 7, r0 = 4 * qb, kb = min(max(r0 - 4, 0), 116); const size_t tb = (size_t)bb * SEQ;
                    AttnArgs a{}; a.qs = INW; a.ks = INW; a.os = 2048; a.NT = 12; a.tlo = 0; a.thi = 11; a.q0 = r0; a.kb = kb;
                    a.Q = (const bf16*)(PROJ + (tb + r0 * 64) * INW + COL_CQ + h * 64); a.K = (const bf16*)(PROJ + (tb + kb * 64) * INW + COL_CK + h * 64);
                    a.V = (const bf16*)(PROJ + (tb + kb * 64) * INW + COL_CV + h * 64); a.O = (bf16*)(Y + (tb + r0 * 64) * 2048 + 1024 + h * 64);
                    a.tab = (lds_fptr)((lds_cptr)shm + TAB_OFF) + h * 465;
                    attn_unit<MC, 8>(a, shm);
                }
            }
            xcd_barrier(xbar);
            {
                FRESH_LANE();
                const float g0 = diff_subln[l * 128 + 2 * lane], g1 = diff_subln[l * 128 + 2 * lane + 1];
                for (int m = gw; m < TG; m += NGW) {
                    const unsigned* at = (const unsigned*)(ATMP + (size_t)m * 1024); unsigned* yr = (unsigned*)(Y + (size_t)m * 2048);
#pragma unroll
                    for (int hh = 0; hh < 4; ++hh) {
                        const unsigned w0 = at[(hh * 2) * 64 + lane], w1 = at[(hh * 2 + 1) * 64 + lane];
                        const float d0 = bflo(w0) - lam * bflo(w1), d1 = bfhi(w0) - lam * bfhi(w1);
                        const float rn = rsqrtf(wave_sum(d0 * d0 + d1 * d1) * (1.f / 128.f) + EPS) * out_scale;
                        yr[hh * 64 + lane] = pk2(d0 * rn * g0, d1 * rn * g1);
                    }
                    const int h = lane >> 3, d8 = (lane & 7) * 8;
                    const float* st = STAT + (size_t)m * 48 + h * 2;
                    const float m0 = st[0], l0 = st[1], m1 = st[16], l1 = st[17], m2 = st[32], l2 = st[33];
                    const float ms = fmaxf(m0, fmaxf(m1, m2));
                    const float w0 = l0 * exp2f(m0 - ms), w1 = l1 * exp2f(m1 - ms), w2 = l2 * exp2f(m2 - ms); const float inv = 1.f / (w0 + w1 + w2);
                    const bf16_t* bt = BTMP + (size_t)m * 1536 + h * 64 + d8;
                    const u32x4 a0 = *(const u32x4*)bt, a1 = *(const u32x4*)(bt + 512), a2 = *(const u32x4*)(bt + 1024);
                    u32x4 o;
#pragma unroll
                    for (int e = 0; e < 4; ++e) { const float lo = (w0 * bflo(a0[e]) + w1 * bflo(a1[e]) + w2 * bflo(a2[e])) * inv, hi = (w0 * bfhi(a0[e]) + w1 * bfhi(a1[e]) + w2 * bfhi(a2[e])) * inv; o[e] = pk2(lo, hi); }
                    *(u32x4*)(Y + (size_t)m * 2048 + 512 + h * 64 + d8) = o;
                }
            }
            xcd_barrier(xbar);
            {
                pg8::Gemm g{Y, WbrT + (size_t)l * 4096 * 512, 2048, 512, 512, 4, 512}; pg8::StaticOrder S; S.init(TG, 4096, G, bx);
                pg8::Epi<1> E{Z, nullptr, nullptr, nullptr, 4096};
                pg8::gemm_phase(ldsl, g, S, E);
            }
            xcd_barrier(xbar);
            { FRESH_LANE();
            for (int m = gw; m < TG; m += NGW) {
                const bf16_t* gr = PROJ + (size_t)m * INW + COL_GATE; const bf16_t* zr = Z + (size_t)m * 4096;
#pragma unroll
                for (int j = 0; j < 2; ++j) { const int c = lane * 8 + j * 512; float acc[8] = {0.f, 0.f, 0.f, 0.f, 0.f, 0.f, 0.f, 0.f};
#pragma unroll
                    for (int n = 0; n < 4; ++n) { const u32x4 gv = *(const u32x4*)(gr + n * 1024 + c), zv = *(const u32x4*)(zr + n * 1024 + c);
#pragma unroll
                        for (int e = 0; e < 4; ++e) { acc[2 * e] += bflo(gv[e]) * bflo(zv[e]); acc[2 * e + 1] += bfhi(gv[e]) * bfhi(zv[e]); } }
                    u32x4 o; o.x = pk2(acc[0], acc[1]); o.y = pk2(acc[2], acc[3]); o.z = pk2(acc[4], acc[5]); o.w = pk2(acc[6], acc[7]);
                    *(u32x4*)(MERGED + (size_t)m * DM + c) = o; }
            } }
            xcd_barrier(xbar);
            {
                pg8::Gemm g{MERGED, WoutT + (size_t)l * DM * DM, DM, DM, DM, 1 << 30, 0}; pg8::StaticOrder S; S.init(TG, DM, G, bx);
                pg8::Epi<3> E{nullptr, xout + tok0 * DM, xsrc + tok0 * DM, nullptr, DM};
                pg8::gemm_phase(ldsl, g, S, E);
            }
            xcd_barrier(xbar);
            { FRESH_LANE(); for (int m = gw; m < TG; m += NGW) rms_row_bf16(xout + (tok0 + m) * DM, norm_ffn + l * DM, H + (size_t)m * DM, lane); }
            xcd_barrier(xbar);
            {
                pg8::Gemm g{H, W1T + (size_t)l * DFF * DM, DM, DM, DM, 1 << 30, 0}; pg8::StaticOrder S; S.init(TG, DFF, G, bx);
                pg8::Epi<2> E{U, nullptr, nullptr, nullptr, DFF};
                pg8::gemm_phase(ldsl, g, S, E);
            }
            xcd_barrier(xbar);
            {
                pg8::Gemm g{U, W2T + (size_t)l * DM * DFF, DFF, DFF, DFF, 1 << 30, 0}; pg8::StaticOrder S; S.init(TG, DM, G, bx);
                pg8::Epi<3> E{nullptr, xout + tok0 * DM, xout + tok0 * DM, nullptr, DM};
                pg8::gemm_phase(ldsl, g, S, E);
            }
            {
                const int ng = grp + 1, nl = (ng == NGRP) ? l + 1 : l, ngrp = (ng == NGRP) ? 0 : ng;
                if (nl < DEPTH) {
                    if (nl != l) xcd_barrier(xbar);
                    FRESH_LANE(); const float* xs = (nl == 0) ? x_in : xout; const size_t nt0 = (size_t)ngrp * TG;
                    for (int m = gw; m < TG; m += NGW) rms_row_bf16(xs + (nt0 + m) * DM, norm_mix + nl * DM, H + (size_t)m * DM, lane);
                }
            }
            xcd_barrier(xbar);
        }
    }
    FRESH_LANE();
    for (int m = gw; m < NTOK; m += NGW) {
        f32x4* o = (f32x4*)(xout + (size_t)m * DM) + lane; const f32x4* g4 = (const f32x4*)norm_final + lane;
        f32x4 v[4]; float s = 0.f;
#pragma unroll
        for (int j = 0; j < 4; ++j) { v[j] = o[64 * j]; s += (v[j].x * v[j].x + v[j].y * v[j].y) + (v[j].z * v[j].z + v[j].w * v[j].w); }
        const float r = rsqrtf(wave_sum(s) * (1.f / DM) + EPS);
#pragma unroll
        for (int j = 0; j < 4; ++j) { const f32x4 g = g4[64 * j]; o[64 * j] = (f32x4){v[j].x * r * g.x, v[j].y * r * g.y, v[j].z * r * g.z, v[j].w * r * g.w}; }
    }
}

#undef ws
#undef x_in
#undef norm_mix
#undef w_in
#undef b_gate
#undef diff_lambda
#undef diff_subln
#undef na_rpb
#undef qk_norm
#undef w_branch
#undef w_out
#undef norm_ffn
#undef w_ff1
#undef w_ff2
#undef norm_final
#undef xout
#undef WinT
#undef WbrT
#undef WoutT
#undef W1T
#undef W2T
#undef STAT
#undef H
#undef ATMP
#undef BTMP
#undef Y
#undef MERGED
#undef Z
#undef U
#undef PROJ
#undef NRMQ
#undef NRMK

extern "C" void kernel_launch(void* const* d_in, const int* in_sizes, int n_in, void* d_out, int out_size, void* d_ws, size_t ws_size, hipStream_t stream) {
    static int grid_blocks = 0;
    if (!grid_blocks) {
        int dev = 0, cus = 0, per_cu = 0;
        (void)hipGetDevice(&dev);
        (void)hipDeviceGetAttribute(&cus, hipDeviceAttributeMultiprocessorCount, dev);
        (void)hipFuncSetAttribute((const void*)mk_fwd, hipFuncAttributeMaxDynamicSharedMemorySize, LDS_BYTES);
        (void)hipOccupancyMaxActiveBlocksPerMultiprocessor(&per_cu, (const void*)mk_fwd, 512, LDS_BYTES);
        if (per_cu < 1) per_cu = 1;
        grid_blocks = cus * per_cu;
        if (ws_size < WS_END || n_in != 14) { fprintf(stderr, "kernel_launch: workspace %zu < %zu or n_in %d != 14\n", ws_size, (size_t)WS_END, n_in); grid_blocks = -1; }
    }
    if (grid_blocks < 0) return;
    (void)hipMemsetAsync((char*)d_ws + WS_BAR, 0, 16384, stream);
    Args a{};
    for (int i = 0; i < 14; ++i) a.in[i] = (const float*)d_in[i];
    a.out = (float*)d_out; a.ws = (unsigned char*)d_ws;
    void* kargs[] = {&a};
    hipError_t e = hipLaunchCooperativeKernel((const void*)mk_fwd, dim3(grid_blocks), dim3(512), kargs, LDS_BYTES, stream);
    if (e != hipSuccess) fprintf(stderr, "cooperative launch failed: %s (grid %d)\n", hipGetErrorString(e), grid_blocks);
}
```

```cpp
#include <hip/hip_runtime.h>
#include <hip/hip_cooperative_groups.h>
#include <hip/hip_bf16.h>
#include <cstdio>
#include <cstdint>
#include <cmath>
namespace cg = cooperative_groups;

constexpr int BATCH = 8, SEQ = 8192, DM = 1024, NTOK = BATCH * SEQ, INW = 12544, DFF = 4096, DEPTH = 2;
constexpr int GB = 2, TG = GB * SEQ, NGRP = BATCH / GB;
constexpr float EPS = 1e-6f;
constexpr float LOG2E = 1.4426950408889634f;
constexpr float C2 = 0.125f * LOG2E;
constexpr int COL_AQ = 0, COL_AK = 512, COL_AV = 1024, COL_B = 1536, COL_CQ = 6144, COL_CK = 6656, COL_CV = 7168, COL_DQ = 7680, COL_DK = 8192, COL_DV = 8320, COL_GATE = 8448;
constexpr size_t MiB = 1u << 20;
constexpr size_t WS_WIN = 0, WS_WBR = 49 * MiB, WS_WOUT = 57 * MiB, WS_W1 = 61 * MiB, WS_W2 = 77 * MiB, WS_STAT = 93 * MiB, WS_H = 96 * MiB, WS_ATMP = 128 * MiB,
                 WS_BTMP = 160 * MiB, WS_Y = 208 * MiB, WS_MERGED = 272 * MiB, WS_Z = 304 * MiB, WS_PROJ = 432 * MiB, WS_NRM = 824 * MiB, WS_BAR = 824 * MiB + 512 * 1024, WS_SSQM = 825 * MiB, WS_SSQF = 826 * MiB, WS_XB = 827 * MiB, WS_END = 955 * MiB;
constexpr int LDS_BYTES = 151552, TAB_OFF = 131072, MISC_OFF = 147072, SSQ_OFF = 147456;

#define LAS __attribute__((address_space(3)))
typedef unsigned short bf16_t;
typedef short bf16x8 __attribute__((ext_vector_type(8)));
typedef float f32x4 __attribute__((ext_vector_type(4)));
typedef unsigned u32x4 __attribute__((ext_vector_type(4)));
typedef unsigned u32x2 __attribute__((ext_vector_type(2)));

__device__ __forceinline__ unsigned f2bf(float f) { unsigned u = __builtin_bit_cast(unsigned, f); return (u + 0x7fffu + ((u >> 16) & 1u)) >> 16; }
__device__ __forceinline__ unsigned pk2(float lo, float hi) { return f2bf(lo) | (f2bf(hi) << 16); }
__device__ __forceinline__ float bflo(unsigned w) { return __uint_as_float(w << 16); }
__device__ __forceinline__ float bfhi(unsigned w) { return __uint_as_float(w & 0xffff0000u); }
__device__ __forceinline__ float wave_sum(float v) {
#pragma unroll
    for (int o = 1; o < 64; o <<= 1) v += __shfl_xor(v, o);
    return v;
}

namespace pg8 {
constexpr int BM = 256, BK = 64, HALF = 128, HTB = HALF * BK * 2, STAGE_BYTES = 8 * HTB, NXCD = 8, WGM = 4;
__host__ __device__ __forceinline__ int lds_byte(int r, int c) { const int st = (r >> 4) * 2 + (c >> 5), rr = r & 15, cc = c & 31, ob = rr * 64 + cc * 2; return st * 1024 + (ob ^ (((ob >> 9) & 1) << 5)); }
__host__ __device__ __forceinline__ void stage_rc(int b, int& R, int& C) { const int st = b / 1024, sb = b % 1024, swz = sb ^ (((sb >> 9) & 1) << 5); R = (st >> 1) * 16 + swz / 64; C = (st & 1) * 32 + (swz % 64) / 2; }
__host__ __device__ __forceinline__ int perm32(int rho) { const int n = rho >> 4, i = rho & 15; return 8 * (i >> 2) + 4 * n + (i & 3); }

struct Unit { int pm, pn; };
struct Gemm { const bf16_t* A; const bf16_t* Bt; int lda, ldb, K, adiv, astride; };

struct StaticOrder {
    int nM, nN, nwg, G, c;
    __device__ void init(int M, int N, int G_, int c_) { nM = M / BM; nN = N / BM; nwg = nM * nN; G = G_; c = c_; }
    __device__ bool next(int i, Unit& u) const {
        const long L = (long)i * G + c; if (L >= nwg) return false;
        int wgid = (int)L; { const int q = nwg / NXCD, r = nwg % NXCD, xcd = wgid % NXCD, off = wgid / NXCD; wgid = (xcd < r ? xcd * (q + 1) : r * (q + 1) + (xcd - r) * q) + off; }
        const int nig = WGM * nN, gid = wgid / nig, fm = gid * WGM, gsz = (nM - fm) < WGM ? (nM - fm) : WGM;
        u.pm = fm + ((wgid % nig) % gsz); u.pn = (wgid % nig) / gsz; return true;
    }
};

__device__ __forceinline__ unsigned cvt_pk_bf16(float lo, float hi) { unsigned r; asm volatile("v_cvt_pk_bf16_f32 %0, %1, %2" : "=v"(r) : "v"(lo), "v"(hi)); return r; }

template <int MODE> struct Epi {
    bf16_t* O; float* Of; const float* base; const float* bias; int ldc;
    const float* ssq;
    bf16_t* XBo; float* SSQo; LAS float* lx;
    __device__ __forceinline__ void operator()(const f32x4 (&acc)[2][2][4][2], const Unit& u, int wr, int wc, int fr, int fq) const {
        const int row0 = u.pm * BM + wr * 64 + fr, col0 = u.pn * BM + wc * 32 + 8 * fq;
        int kind = 0; float sc = 1.f;
        if (MODE == 0) { const int pn = u.pn; if (pn >= 33) kind = 2; else if (pn < 2 || pn == 6 || pn == 7 || pn == 12 || pn == 13 || pn == 18 || pn == 19 || pn == 24 || pn == 25) sc = C2; }
        float rsv[2][4]; f32x4 bv[2][2];
#pragma unroll
        for (int ai = 0; ai < 2; ++ai)
#pragma unroll
            for (int m = 0; m < 4; ++m) { rsv[ai][m] = 1.f;
                if (MODE == 0 || MODE == 2) { const f32x4 q = *(const f32x4*)(ssq + (size_t)(row0 + ai * HALF + m * 16) * 4); rsv[ai][m] = rsqrtf(((q[0] + q[1]) + (q[2] + q[3])) * (1.f / 1024.f) + EPS); } }
#pragma unroll
        for (int bj = 0; bj < 2; ++bj)
#pragma unroll
            for (int n = 0; n < 2; ++n) { bv[bj][n] = (f32x4){0.f, 0.f, 0.f, 0.f}; if (MODE == 0) { if (kind == 2) bv[bj][n] = *(const f32x4*)(bias + col0 + bj * HALF - COL_GATE + 4 * n); } }
        f32x4 nb[2][2];
        if (MODE == 3) {
#pragma unroll
            for (int bj = 0; bj < 2; ++bj)
#pragma unroll
                for (int n = 0; n < 2; ++n) nb[bj][n] = *(const f32x4*)(base + (size_t)row0 * ldc + col0 + bj * HALF + 4 * n);
        }
#pragma unroll
        for (int ai = 0; ai < 2; ++ai)
#pragma unroll
            for (int m = 0; m < 4; ++m) { const size_t roff = (size_t)(row0 + ai * HALF + m * 16) * ldc; float psq = 0.f; const float rs = rsv[ai][m];
                f32x4 cb[2][2];
                if (MODE == 3) {
#pragma unroll
                    for (int bj = 0; bj < 2; ++bj)
#pragma unroll
                        for (int n = 0; n < 2; ++n) cb[bj][n] = nb[bj][n];
                    const int g1 = ai * 4 + m + 1;
                    if (g1 < 8) { const size_t r1 = (size_t)(row0 + (g1 >> 2) * HALF + (g1 & 3) * 16) * ldc;
#pragma unroll
                        for (int bj = 0; bj < 2; ++bj)
#pragma unroll
                            for (int n = 0; n < 2; ++n) nb[bj][n] = *(const f32x4*)(base + r1 + col0 + bj * HALF + 4 * n); }
                }
#pragma unroll
                for (int bj = 0; bj < 2; ++bj) { const int col = col0 + bj * HALF; f32x4 v0 = acc[ai][bj][m][0], v1 = acc[ai][bj][m][1];
                    if (MODE == 3) {
                        v0 = cb[bj][0] + v0; v1 = cb[bj][1] + v1;
                        *(f32x4*)(Of + roff + col) = v0; *(f32x4*)(Of + roff + col + 4) = v1;
                        psq += (v0[0] * v0[0] + v0[1] * v0[1]) + (v0[2] * v0[2] + v0[3] * v0[3]) + (v1[0] * v1[0] + v1[1] * v1[1]) + (v1[2] * v1[2] + v1[3] * v1[3]);
                        u32x4 w; w.x = cvt_pk_bf16(v0[0], v0[1]); w.y = cvt_pk_bf16(v0[2], v0[3]); w.z = cvt_pk_bf16(v1[0], v1[1]); w.w = cvt_pk_bf16(v1[2], v1[3]);
                        *(u32x4*)(XBo + roff + col) = w;
                    } else {
                        if (MODE == 0 || MODE == 2) { v0 = v0 * rs; v1 = v1 * rs; }
                        if (MODE == 0) {
                            if (kind == 2) {
#pragma unroll
                                for (int e = 0; e < 4; ++e) { v0[e] = 1.f / (1.f + __expf(-(v0[e] + bv[bj][0][e]))); v1[e] = 1.f / (1.f + __expf(-(v1[e] + bv[bj][1][e]))); } }
                            else { v0 = v0 * sc; v1 = v1 * sc; }
                        }
                        if (MODE == 2) {
#pragma unroll
                            for (int e = 0; e < 4; ++e) { const float a = fmaxf(v0[e], 0.f), b = fmaxf(v1[e], 0.f); v0[e] = a * a; v1[e] = b * b; } }
                        u32x4 w; w.x = cvt_pk_bf16(v0[0], v0[1]); w.y = cvt_pk_bf16(v0[2], v0[3]); w.z = cvt_pk_bf16(v1[0], v1[1]); w.w = cvt_pk_bf16(v1[2], v1[3]);
                        *(u32x4*)(O + roff + col) = w;
                    } }
                if (MODE == 3) { psq += __shfl_xor(psq, 16); psq += __shfl_xor(psq, 32); if (fq == 0) lx[(ai * HALF + wr * 64 + m * 16 + fr) * 4 + wc] = psq; }
            }
        if (MODE == 3) {
            asm volatile("s_waitcnt lgkmcnt(0)" ::: "memory"); __builtin_amdgcn_s_barrier(); asm volatile("" ::: "memory");
            const int t = threadIdx.x;
            if (t < 256) { const f32x4 q = *(const LAS f32x4*)(lx + t * 4); SSQo[(size_t)(u.pm * BM + t) * 4 + u.pn] = (q[0] + q[1]) + (q[2] + q[3]); }
        }
    }
};

template <class EpiT>
__device__ __forceinline__ void gemm_phase(LAS unsigned char* lds, const Gemm g, const StaticOrder& S, const EpiT& E) {
    int tid_ = threadIdx.x; asm volatile("" : "+v"(tid_));
    const int tid = tid_, wid = __builtin_amdgcn_readfirstlane(tid >> 6), lane = tid & 63, wr = wid >> 2, wc = wid & 3, fr = lane & 15, fq = lane >> 4;
    const int K = g.K, nt = K / BK;
    unsigned voffA[2], voffB[2];
#pragma unroll
    for (int i = 0; i < 2; ++i) { int R, C; stage_rc(tid * 16 + i * 8192, R, C); const int Rb = (R & ~31) + perm32(R & 31);
        voffA[i] = (unsigned)(R * g.lda + C) * 2u; voffB[i] = (unsigned)(Rb * g.ldb + C) * 2u; }
    const size_t kstep = (size_t)(BK * 2);
    const size_t hA = (size_t)HALF * g.lda * 2, hB = (size_t)HALF * g.ldb * 2;
    const size_t tA = 2 * hA, tB = 2 * hB;
    const unsigned ldsw = (unsigned)wid * 1024u;
    const int aoff = lds_byte(wr * 64 + fr, fq * 8), boff = lds_byte(wc * 32 + fr, fq * 8);
#define PG8_SA(b, h) (((b) * 2 + (h)) * HTB)
#define PG8_SB(b, h) ((4 + (b) * 2 + (h)) * HTB)
#define PG8_STAGE(bufoff, gbase, voff) do { _Pragma("unroll") for (int _i = 0; _i < 2; ++_i) \
        __builtin_amdgcn_global_load_lds((const unsigned*)((const char*)(gbase) + (voff)[_i]), (LAS unsigned*)(lds + (bufoff) + ldsw + _i * 8192), 16, 0, 0); } while (0)
#define PG8_LDA(dst, b, h) do { _Pragma("unroll") for (int m = 0; m < 4; ++m) _Pragma("unroll") for (int k = 0; k < 2; ++k) dst[m][k] = *(const LAS bf16x8*)(lds + PG8_SA(b, h) + aoff + m * 2048 + k * 1024); } while (0)
#define PG8_LDB(dst, b, h) do { _Pragma("unroll") for (int n = 0; n < 2; ++n) _Pragma("unroll") for (int k = 0; k < 2; ++k) dst[n][k] = *(const LAS bf16x8*)(lds + PG8_SB(b, h) + boff + n * 2048 + k * 1024); } while (0)
#define PG8_MMA(ai, bj, At, Bt) do { __builtin_amdgcn_s_setprio(1); _Pragma("unroll") for (int m = 0; m < 4; ++m) _Pragma("unroll") for (int n = 0; n < 2; ++n) _Pragma("unroll") for (int k = 0; k < 2; ++k) \
        acc[ai][bj][m][n] = __builtin_amdgcn_mfma_f32_16x16x32_bf16(Bt[n][k], At[m][k], acc[ai][bj][m][n], 0, 0, 0); __builtin_amdgcn_s_setprio(0); } while (0)
#define PG8_WAIT_V(n) asm volatile("s_waitcnt vmcnt(" #n ")" ::: "memory")
#define PG8_WAIT_L(n) asm volatile("s_waitcnt lgkmcnt(" #n ")" ::: "memory")
#define PG8_BAR __builtin_amdgcn_s_barrier()
#define PG8_SCHED __builtin_amdgcn_sched_barrier(0)
#define PG8_PA(u) ((const char*)g.A + (size_t)(u).pm * tA + (size_t)((u).pn / g.adiv) * (size_t)g.astride * 2)
#define PG8_PB(u) ((const char*)g.Bt + (size_t)(u).pn * tB)
    Unit cur, nxt; int ui = 0;
    if (!S.next(0, cur)) return;
    f32x4 acc[2][2][4][2];
#pragma unroll
    for (int a = 0; a < 2; ++a)
#pragma unroll
        for (int b = 0; b < 2; ++b)
#pragma unroll
            for (int m = 0; m < 4; ++m)
#pragma unroll
                for (int n = 0; n < 2; ++n) acc[a][b][m][n] = (f32x4){0.f, 0.f, 0.f, 0.f};
    bf16x8 At[4][2], B0[2][2], B1[2][2];
    const char* cA = PG8_PA(cur); const char* cB = PG8_PB(cur);
    PG8_STAGE(PG8_SB(0, 0), cB, voffB); PG8_STAGE(PG8_SB(0, 1), cB + hB, voffB); PG8_STAGE(PG8_SA(0, 0), cA, voffA); PG8_STAGE(PG8_SA(0, 1), cA + hA, voffA);
    if (wr == 1) PG8_BAR;
    PG8_WAIT_V(2); PG8_BAR;
    PG8_STAGE(PG8_SB(1, 0), cB + kstep, voffB); PG8_STAGE(PG8_SA(1, 0), cA + kstep, voffA); PG8_STAGE(PG8_SB(1, 1), cB + hB + kstep, voffB);
    PG8_WAIT_V(6); PG8_BAR;
    for (;;) {
        const bool has_next = S.next(ui + 1, nxt);
        const char* nA = has_next ? PG8_PA(nxt) : cA; const char* nB = has_next ? PG8_PB(nxt) : cB;
        for (int t = 0; t < nt; t += 2) {
            const bool last = (t == nt - 2);
            const char* a1 = cA + (size_t)(t + 1) * kstep;
            const char* a2 = last ? nA : cA + (size_t)(t + 2) * kstep; const char* b2 = last ? nB : cB + (size_t)(t + 2) * kstep;
            const char* a3 = a2 + kstep; const char* b3 = b2 + kstep;
            PG8_LDB(B0, 0, 0); PG8_LDB(B1, 0, 1); PG8_SCHED; PG8_LDA(At, 0, 0); PG8_STAGE(PG8_SA(1, 1), a1 + hA, voffA);
            PG8_WAIT_V(8); PG8_WAIT_L(0); PG8_BAR; PG8_MMA(0, 0, At, B0); PG8_MMA(0, 1, At, B1); PG8_BAR; PG8_SCHED;
            PG8_LDA(At, 0, 1); PG8_STAGE(PG8_SB(0, 0), b2, voffB); PG8_STAGE(PG8_SB(0, 1), b2 + hB, voffB); PG8_STAGE(PG8_SA(0, 0), a2, voffA);
            PG8_WAIT_V(8); PG8_WAIT_L(0); PG8_BAR; PG8_MMA(1, 0, At, B0); PG8_MMA(1, 1, At, B1); PG8_BAR; PG8_SCHED;
            PG8_LDB(B0, 1, 0); PG8_LDB(B1, 1, 1); PG8_SCHED; PG8_LDA(At, 1, 0); PG8_STAGE(PG8_SA(0, 1), a2 + hA, voffA);
            PG8_WAIT_V(8); PG8_WAIT_L(0); PG8_BAR; PG8_MMA(0, 0, At, B0); PG8_MMA(0, 1, At, B1); PG8_BAR; PG8_SCHED;
            PG8_LDA(At, 1, 1); PG8_STAGE(PG8_SB(1, 0), b3, voffB); PG8_STAGE(PG8_SB(1, 1), b3 + hB, voffB); PG8_STAGE(PG8_SA(1, 0), a3, voffA);
            PG8_WAIT_V(8); PG8_WAIT_L(0); PG8_BAR; PG8_MMA(1, 0, At, B0); PG8_MMA(1, 1, At, B1); PG8_BAR; PG8_SCHED;
        }
        if (wr == 0) PG8_BAR;
        E(acc, cur, wr, wc, fr, fq);
        if (!has_next) break;
#pragma unroll
        for (int a = 0; a < 2; ++a)
#pragma unroll
            for (int b = 0; b < 2; ++b)
#pragma unroll
                for (int m = 0; m < 4; ++m)
#pragma unroll
                    for (int n = 0; n < 2; ++n) acc[a][b][m][n] = (f32x4){0.f, 0.f, 0.f, 0.f};
        cur = nxt; cA = nA; cB = nB; ++ui;
        if (wr == 1) PG8_BAR;
    }
    PG8_WAIT_V(0);
    PG8_BAR;
#undef PG8_SA
#undef PG8_SB
#undef PG8_STAGE
#undef PG8_LDA
#undef PG8_LDB
#undef PG8_MMA
#undef PG8_WAIT_V
#undef PG8_WAIT_L
#undef PG8_BAR
#undef PG8_SCHED
#undef PG8_PA
#undef PG8_PB
}
}

namespace attn_body {
using bf16 = __hip_bfloat16;
using s16x4 = __attribute__((ext_vector_type(4))) short;
using f32x16 = __attribute__((ext_vector_type(16))) float;
constexpr int NW = 8, QBLK = 32, QB = QBLK * NW, KVBLK = 64;
constexpr int MA = 0, MB = 1, MC = 2, MD = 3;
__device__ __forceinline__ int crow(int r, int hi) { return (r & 3) + 8 * (r >> 2) + 4 * hi; }
#define SBAR() __builtin_amdgcn_sched_barrier(0)
constexpr int NSLOT = 3, SLOTB = 8192;
constexpr int LDS_K = 0, LDS_V = NSLOT * SLOTB, LDS_WS = 2 * NSLOT * SLOTB, LDS_OST = LDS_WS + NW * 64 * 4, LDS_ATT = LDS_OST + NW * 4096;
typedef __attribute__((address_space(3))) const char* lds_cptr;
typedef __attribute__((address_space(3))) const float* lds_fptr;

struct AttnArgs {
    const bf16* Q; const bf16* K; const bf16* V; bf16* O;
    int qs, ks, os;
    int NT, tlo, thi;
    float s2;
    int q0;
    int kb;
    float* stat; int ss;
    lds_fptr tab;
};

__device__ __forceinline__ void glds16(const void* gsrc, unsigned lds_dst) { unsigned keep;
  asm volatile("s_mov_b32 %0, m0\n\ts_mov_b32 m0, %2\n\ts_nop 0\n\tglobal_load_lds_dwordx4 %1, off\n\ts_mov_b32 m0, %0" : "=&s"(keep) : "v"(gsrc), "s"(lds_dst) : "memory"); }
__device__ __forceinline__ float max3f(float a, float b, float c) { float r; asm("v_max3_f32 %0, %1, %2, %3" : "=v"(r) : "v"(a), "v"(b), "v"(c)); return r; }
__device__ __forceinline__ float max2f(float a, float b) { float r; asm("v_max_f32_e32 %0, %1, %2" : "=v"(r) : "v"(a), "v"(b)); return r; }
__device__ __forceinline__ float fadd_s(float a, float b) { float r; asm("v_add_f32_e32 %0, %1, %2" : "=v"(r) : "v"(a), "v"(b)); return r; }
__device__ __forceinline__ float fsub_s(float a, float b) { float r; asm("v_sub_f32_e32 %0, %1, %2" : "=v"(r) : "v"(a), "v"(b)); return r; }
typedef float f32x2_t __attribute__((ext_vector_type(2))); typedef __bf16 bf16x2_t __attribute__((ext_vector_type(2)));
__device__ __forceinline__ unsigned cvtpk_s(float lo, float hi) { f32x2_t v = {lo, hi}; bf16x2_t b = __builtin_convertvector(v, bf16x2_t); return __builtin_bit_cast(unsigned, b); }
#define WAIT_BAR(N) asm volatile("s_waitcnt vmcnt(" #N ") lgkmcnt(0)\n\ts_barrier" ::: "memory")

__device__ __forceinline__ void qkt(f32x16& p0, f32x16& p1, const char* Kslot, const bf16x8* qr, const f32x16& negm, int r32, int hi) {
  const char* kb = Kslot + hi * 1024 + r32 * 16;
  #pragma unroll
  for (int d0 = 0; d0 < 4; ++d0) {
    const bf16x8 b0 = *reinterpret_cast<const bf16x8*>(kb + d0 * 2048);
    const bf16x8 b1 = *reinterpret_cast<const bf16x8*>(kb + d0 * 2048 + 512);
    if (d0 == 0) { p0 = __builtin_amdgcn_mfma_f32_32x32x16_bf16(b0, qr[0], negm, 0, 0, 0); p1 = __builtin_amdgcn_mfma_f32_32x32x16_bf16(b1, qr[0], negm, 0, 0, 0); }
    else { p0 = __builtin_amdgcn_mfma_f32_32x32x16_bf16(b0, qr[d0], p0, 0, 0, 0); p1 = __builtin_amdgcn_mfma_f32_32x32x16_bf16(b1, qr[d0], p1, 0, 0, 0); } }
}
typedef short v4i16_t __attribute__((ext_vector_type(4)));
__device__ __forceinline__ void kload8(bf16x8* kf, lds_cptr kp) {
  kf[0] = *(const LAS bf16x8*)(kp);        kf[1] = *(const LAS bf16x8*)(kp + 512);
  kf[2] = *(const LAS bf16x8*)(kp + 2048); kf[3] = *(const LAS bf16x8*)(kp + 2560);
  kf[4] = *(const LAS bf16x8*)(kp + 4096); kf[5] = *(const LAS bf16x8*)(kp + 4608);
  kf[6] = *(const LAS bf16x8*)(kp + 6144); kf[7] = *(const LAS bf16x8*)(kp + 6656);
}
__device__ __forceinline__ void kload2(bf16x8* kf, lds_cptr kp, int j) { kf[2 * j] = *(const LAS bf16x8*)(kp + j * 2048); kf[2 * j + 1] = *(const LAS bf16x8*)(kp + j * 2048 + 512); }
__device__ __forceinline__ s16x4 vtr(lds_cptr p) { return __builtin_bit_cast(s16x4, __builtin_amdgcn_ds_read_tr16_b64_v4i16((LAS v4i16_t*)p)); }
__device__ __forceinline__ float rowmax(const f32x16& p0, const f32x16& p1) {
  float a = max3f(p0[0], p0[1], p1[0]), b = max3f(p0[2], p0[3], p1[1]); a = max3f(a, p1[2], p1[3]);
  #pragma unroll
  for (int r = 4; r < 16; r += 4) { a = max3f(a, p0[r], p0[r + 1]); b = max3f(b, p0[r + 2], p0[r + 3]); a = max3f(a, p1[r], p1[r + 1]); b = max3f(b, p1[r + 2], p1[r + 3]); }
  const float m = max2f(a, b);
  auto rr = __builtin_amdgcn_permlane32_swap(__float_as_uint(m), __float_as_uint(m), false, false);
  return max2f(__uint_as_float(rr[0]), __uint_as_float(rr[1]));
}
__device__ __forceinline__ void pv(f32x16* o, int vb, bf16x8 pa0, bf16x8 pa1, bf16x8 pa2, bf16x8 pa3) {
  #pragma unroll
  for (int d0 = 0; d0 < 2; ++d0) { s16x4 lo[4], hi[4];
    #pragma unroll
    for (int ks = 0; ks < 4; ++ks) {
      asm volatile("ds_read_b64_tr_b16 %0,%1 offset:%c2" : "=&v"(lo[ks]) : "v"(vb), "i"(d0 * 4096 + ks * 1024) : "memory");
      asm volatile("ds_read_b64_tr_b16 %0,%1 offset:%c2" : "=&v"(hi[ks]) : "v"(vb), "i"(d0 * 4096 + ks * 1024 + 512) : "memory"); }
    asm volatile("s_waitcnt lgkmcnt(0)" ::: "memory"); SBAR();
    #define PK(k) (bf16x8){lo[k][0], lo[k][1], lo[k][2], lo[k][3], hi[k][0], hi[k][1], hi[k][2], hi[k][3]}
    o[d0] = __builtin_amdgcn_mfma_f32_32x32x16_bf16(pa0, PK(0), o[d0], 0, 0, 0);
    o[d0] = __builtin_amdgcn_mfma_f32_32x32x16_bf16(pa1, PK(1), o[d0], 0, 0, 0);
    o[d0] = __builtin_amdgcn_mfma_f32_32x32x16_bf16(pa2, PK(2), o[d0], 0, 0, 0);
    o[d0] = __builtin_amdgcn_mfma_f32_32x32x16_bf16(pa3, PK(3), o[d0], 0, 0, 0);
    #undef PK
  }
}

template <int MODE> __device__ __forceinline__ void score_hook(f32x16& c0, f32x16& c1, int t, const AttnArgs& a, int qrel, int hi, int wid, int r32, float mh) {
  if constexpr (MODE == MA) {
    const int wlo = a.q0 + wid * QBLK, sd = (64 * t + 63 < wlo) ? 1 : ((64 * t > wlo + 31) ? -1 : 0);
    if (sd != 0) { const float sv = (float)sd * a.s2;
      #pragma unroll
      for (int r = 0; r < 16; ++r) { const float kf = (float)((r & 3) + 8 * (r >> 2)); c0[r] = fmaf(kf, sv, c0[r]); c1[r] = fmaf(kf + 32.f, sv, c1[r]); if ((r & 3) == 3) __builtin_amdgcn_sched_barrier(0); }
    } else {
      const float dq = (float)(a.q0 + qrel - 64 * t - 4 * hi), ns = -a.s2;
      #pragma unroll
      for (int r = 0; r < 16; ++r) { const float kf = (float)((r & 3) + 8 * (r >> 2)); c0[r] = fmaf(ns, fabsf(dq - kf), c0[r]); c1[r] = fmaf(ns, fabsf(dq - (kf + 32.f)), c1[r]); if ((r & 1) == 1) __builtin_amdgcn_sched_barrier(0); }
    }
  }
  if constexpr (MODE == MB) {
    const bool tv = (t >= a.tlo) && (t <= a.thi);
    const float dq = (float)(qrel + 64 - 64 * t - 4 * hi), ns = -a.s2;
    #pragma unroll
    for (int r = 0; r < 16; ++r) { const float kf = (float)((r & 3) + 8 * (r >> 2)); const float d0 = fabsf(dq - kf), d1 = fabsf(dq - (kf + 32.f));
      c0[r] = (tv && d0 <= 64.f) ? fmaf(ns, d0, c0[r] - mh) : -INFINITY; c1[r] = (tv && d1 <= 64.f) ? fmaf(ns, d1, c1[r] - mh) : -INFINITY;
      if ((r & 3) == 3) __builtin_amdgcn_sched_barrier(0); }
  }
  if constexpr (MODE == MC) {
    const int qrow = a.q0 + (wid >> 1), rs = min(max(qrow - 4, 0), 120), krow = a.kb + t;
    if (krow < rs || krow >= rs + 8) {
      #pragma unroll
      for (int r = 0; r < 16; ++r) { c0[r] = -INFINITY; c1[r] = -INFINITY; }
    } else {
      const int qc = (wid & 1) * 32 + r32, cs = min(max(qc - 8, 0), 48);
      const lds_fptr tp = a.tab + (krow - qrow + 7) * 31 + (15 - qc + 4 * hi);
      const int kd = 4 * hi - cs;
      #pragma unroll
      for (int r = 0; r < 16; ++r) { const int kc = (r & 3) + 8 * (r >> 2);
        const float b0 = tp[kc], b1 = tp[kc + 32];
        c0[r] = ((unsigned)(kd + kc) < 16u) ? c0[r] + (b0 - mh) : -INFINITY; c1[r] = ((unsigned)(kd + kc + 32) < 16u) ? c1[r] + (b1 - mh) : -INFINITY;
        if ((r & 3) == 3) __builtin_amdgcn_sched_barrier(0); }
    }
  }
}

template <int MODE, int THRL> __device__ __forceinline__ void attn_unit(const AttnArgs& A_, char* shm) {
  int tid_ = threadIdx.x; asm volatile("" : "+v"(tid_));
  const int tid = tid_, lane = tid & 63, r32 = lane & 31, hi = lane >> 5; const int wid = __builtin_amdgcn_readfirstlane(tid >> 6);
  const bf16* Qw = A_.Q + (wid * QBLK) * A_.qs;
  const unsigned lds0 = (unsigned)(uintptr_t)shm;
  float* wsf = (float*)(shm + LDS_WS) + wid * 64;
  const int ks = A_.ks;
  const bf16* ksrc = A_.K + (lane * ks + wid * 8);
  const bf16* vsrc = A_.V + ((16 * (wid & 3) + (lane >> 2)) * ks + (wid >> 2) * 32 + (lane & 3) * 8);
  const unsigned kdst = lds0 + LDS_K + wid * 1024, vdst = lds0 + LDS_V + wid * 1024;
  #define TT(t) ((MODE == MB) ? min(max((int)(t), A_.tlo), A_.thi) : (int)(t))
  #define DMA_K(t, slot) glds16(ksrc + TT(t) * KVBLK * ks, (unsigned)__builtin_amdgcn_readfirstlane(kdst + (slot)))
  #define DMA_V(t, slot) glds16(vsrc + TT(t) * KVBLK * ks, (unsigned)__builtin_amdgcn_readfirstlane(vdst + (slot)))
  const int vb0 = (int)(lds0 + LDS_V) + ((lane >> 4) & 1) * 32 + (lane & 3) * 8 + (4 * hi + ((lane & 15) >> 2)) * 64;
  const char* Kbase = shm + LDS_K; bf16x8 kf[8];
  const lds_cptr shm3 = (lds_cptr)shm; const lds_cptr kp0 = shm3 + LDS_K + hi * 1024 + r32 * 16; const lds_cptr vp0 = shm3 + LDS_V + ((lane >> 4) & 1) * 32 + (lane & 3) * 8 + (4 * hi + ((lane & 15) >> 2)) * 64;
  const int NT = A_.NT;
  DMA_K(0, 0); DMA_V(0, 0); DMA_K(1, SLOTB);
  bf16x8 qr[4];
  #pragma unroll
  for (int d0 = 0; d0 < 4; ++d0) qr[d0] = *reinterpret_cast<const bf16x8*>(&Qw[r32 * A_.qs + d0 * 16 + hi * 8]);
  float mhat = 0.f, l_reg = 0.f; f32x16 o[2]; o[0] = f32x16{}; o[1] = f32x16{}; f32x16 negm = f32x16{}; asm volatile("" : "+v"(negm));
  const int qrel = wid * QBLK + r32;
  constexpr bool NEGM = (MODE == MA || MODE == MD);
  #define CIN (NEGM ? negm : f32x16{})
  #define NEGM_SET(tn) do { float nb_ = -mhat; \
      if (MODE == MA) { const int wlo_ = A_.q0 + wid * QBLK, sd_ = (64 * (tn) + 63 < wlo_) ? 1 : ((64 * (tn) > wlo_ + 31) ? -1 : 0); \
        if (sd_ != 0) nb_ = fmaf(-(float)sd_ * A_.s2, (float)(A_.q0 + qrel - 64 * (tn) - 4 * hi), nb_); } \
      _Pragma("unroll") for (int r = 0; r < 16; ++r) negm[r] = nb_; asm volatile("" : "+v"(negm)); } while (0)
  #define CMASK(P0, P1, t) score_hook<MODE>(P0, P1, (t), A_, qrel, hi, wid, r32, mhat)
  bool resc = false;
  #define START(P0, P1) do { const float rm = rowmax(P0, P1); resc = false; \
    { const float dl = (MODE == MB || MODE == MC) ? fmaxf(rm, -2048.f) : rm; mhat = fadd_s(mhat, dl); \
      _Pragma("unroll") for (int r = 0; r < 16; ++r) { P0[r] = fsub_s(P0[r], dl); P1[r] = fsub_s(P1[r], dl); } \
      if (NEGM) { NEGM_SET(1); } } \
    _Pragma("unroll") for (int r = 0; r < 16; ++r) P0[r] = __builtin_amdgcn_exp2f(P0[r]); } while (0)
  #define RESC() do { if (resc) { asm volatile("s_waitcnt lgkmcnt(0)" ::: "memory"); \
      _Pragma("unroll") for (int d_ = 0; d_ < 2; ++d_) _Pragma("unroll") for (int r = 0; r < 16; ++r) o[d_][r] *= wsf[crow(r, hi)]; } } while (0)
  f32x16 pA0, pA1, pB0, pB1;
  int sl_prev = 0, sl_cur = 0, sl_next = SLOTB;
  #define ROT() do { sl_prev = sl_cur; sl_cur = sl_next; sl_next = (sl_next == (NSLOT - 1) * SLOTB) ? 0 : sl_next + SLOTB; } while (0)
  DMA_K(2, 2 * SLOTB);
  if (MODE == MA) { NEGM_SET(0); }
  WAIT_BAR(3);
  qkt(pA0, pA1, Kbase, qr, negm, r32, hi); asm volatile("s_nop 15\n\ts_nop 7" : "+v"(pA0), "+v"(pA1)); CMASK(pA0, pA1, 0);
  START(pA0, pA1);
  _Pragma("unroll") for (int r = 0; r < 16; ++r) pA1[r] = __builtin_amdgcn_exp2f(pA1[r]);
  WAIT_BAR(0);
  DMA_K(3, 0); DMA_V(1, SLOTB);
  ROT();
  kload8(kf, kp0 + sl_cur);
  WAIT_BAR(2);
  s16x4 vlo[8], vhi[8]; u32x4 pw0, pw1, pw2, pw3;
  #define PKW(P, B) cvtpk_s(P[B], P[B + 1])
  #define PAF(k) __builtin_bit_cast(bf16x8, pw##k)
  #define VFR(i) (bf16x8){vlo[i][0], vlo[i][1], vlo[i][2], vlo[i][3], vhi[i][0], vhi[i][1], vhi[i][2], vhi[i][3]}
  #define PIN(x) asm volatile("" : "+v"(x))
  #define MX3(a, b, c) __builtin_fmaxf(__builtin_fmaxf((a), (b)), (c))
  #define GAPA(MF, A0, A1, A2, A3, W0, W1, PW) do { MF; sacc += A0; sacc += A1; sacc += A2; sacc += A3; PIN(sacc); W0; W1; PIN(PW); SBAR(); } while (0)
  #define EX(v) __builtin_amdgcn_exp2f(v)
  #define GAPB(MF, X, B) do { MF; X[B] = EX(X[B]); X[B + 1] = EX(X[B + 1]); X[B + 2] = EX(X[B + 2]); X[B + 3] = EX(X[B + 3]); PIN(X); SBAR(); } while (0)
  #define VRD(i) do { vlo[i] = vtr(vp_ + (((i) >> 2) * 4096 + ((i) & 3) * 1024)); vhi[i] = vtr(vp_ + (((i) >> 2) * 4096 + ((i) & 3) * 1024 + 512)); } while (0)
  #define KRD(G, j) do { if (G) { kload2(kf, kp0 + sl_next, j); SBAR(); } } while (0)
  #define STEP(C0, C1, P0, P1, t, GK, GV, GL) do { SBAR(); \
    const lds_cptr vp_ = vp0 + sl_prev; \
    VRD(0); SBAR(); float sacc = (P0[0] + P0[1]); \
    GAPA(C0 = __builtin_amdgcn_mfma_f32_32x32x16_bf16(kf[0], qr[0], CIN, 0, 0, 0), P0[2], P0[3], P0[4], P0[5],     pw0[0] = PKW(P0, 0), pw0[1] = PKW(P0, 2), pw0); \
    VRD(4); SBAR(); GAPA(C1 = __builtin_amdgcn_mfma_f32_32x32x16_bf16(kf[1], qr[0], CIN, 0, 0, 0), P0[6], P0[7], P0[8], P0[9],     pw0[2] = PKW(P0, 4), pw0[3] = PKW(P0, 6), pw0); \
    VRD(1); SBAR(); GAPA(C0 = __builtin_amdgcn_mfma_f32_32x32x16_bf16(kf[2], qr[1], C0, 0, 0, 0),   P0[10], P0[11], P0[12], P0[13], pw1[0] = PKW(P0, 8), pw1[1] = PKW(P0, 10), pw1); \
    VRD(5); SBAR(); GAPA(C1 = __builtin_amdgcn_mfma_f32_32x32x16_bf16(kf[3], qr[1], C1, 0, 0, 0),   P0[14], P0[15], P1[0], P1[1],   pw1[2] = PKW(P0, 12), pw1[3] = PKW(P0, 14), pw1); \
    VRD(2); SBAR(); GAPA(C0 = __builtin_amdgcn_mfma_f32_32x32x16_bf16(kf[4], qr[2], C0, 0, 0, 0),   P1[2], P1[3], P1[4], P1[5],     pw2[0] = PKW(P1, 0), pw2[1] = PKW(P1, 2), pw2); \
    VRD(6); SBAR(); GAPA(C1 = __builtin_amdgcn_mfma_f32_32x32x16_bf16(kf[5], qr[2], C1, 0, 0, 0),   P1[6], P1[7], P1[8], P1[9],     pw2[2] = PKW(P1, 4), pw2[3] = PKW(P1, 6), pw2); \
    VRD(3); SBAR(); GAPA(C0 = __builtin_amdgcn_mfma_f32_32x32x16_bf16(kf[6], qr[3], C0, 0, 0, 0),   P1[10], P1[11], P1[12], P1[13], pw3[0] = PKW(P1, 8), pw3[1] = PKW(P1, 10), pw3); \
    VRD(7); SBAR(); GAPA(C1 = __builtin_amdgcn_mfma_f32_32x32x16_bf16(kf[7], qr[3], C1, 0, 0, 0),   P1[14], P1[15], 0.f, 0.f,       pw3[2] = PKW(P1, 12), pw3[3] = PKW(P1, 14), pw3); \
    l_reg += sacc; \
    if (GK) { DMA_K((t) + 3, sl_cur); } if (GV) { DMA_V((t) + 1, sl_next); } \
    CMASK(C0, C1, t); \
    { float a = MX3(C0[0], C0[1], C1[0]), b = MX3(C0[2], C0[3], C1[1]); a = MX3(a, C1[2], C1[3]); \
      _Pragma("unroll") for (int r = 4; r < 16; r += 4) { a = MX3(a, C0[r], C0[r + 1]); b = MX3(b, C0[r + 2], C0[r + 3]); a = MX3(a, C1[r], C1[r + 1]); b = MX3(b, C1[r + 2], C1[r + 3]); } \
      float rm = __builtin_fmaxf(a, b); { auto rr = __builtin_amdgcn_permlane32_swap(__float_as_uint(rm), __float_as_uint(rm), false, false); rm = __builtin_fmaxf(__uint_as_float(rr[0]), __uint_as_float(rr[1])); } \
      resc = false; \
      if (__builtin_expect(__any(rm > (float)THRL), 0)) { const float dl = __builtin_fmaxf(rm, 0.f); mhat += dl; \
        _Pragma("unroll") for (int r = 0; r < 16; ++r) { C0[r] -= dl; C1[r] -= dl; } \
        if (MODE == MD) { NEGM_SET(0); } \
        const float f = __builtin_amdgcn_exp2f(-dl); l_reg *= f; if (hi == 0) wsf[r32] = f; resc = true; } \
      if (MODE == MA) { NEGM_SET((t) + 1); } } \
    SBAR(); \
    GAPB(o[0] = __builtin_amdgcn_mfma_f32_32x32x16_bf16(PAF(0), VFR(0), o[0], 0, 0, 0), C0, 0); \
    GAPB(o[1] = __builtin_amdgcn_mfma_f32_32x32x16_bf16(PAF(0), VFR(4), o[1], 0, 0, 0), C0, 4); \
    KRD(GL, 0); GAPB(o[0] = __builtin_amdgcn_mfma_f32_32x32x16_bf16(PAF(1), VFR(1), o[0], 0, 0, 0), C0, 8); \
    KRD(GL, 1); GAPB(o[1] = __builtin_amdgcn_mfma_f32_32x32x16_bf16(PAF(1), VFR(5), o[1], 0, 0, 0), C0, 12); \
    KRD(GL, 2); GAPB(o[0] = __builtin_amdgcn_mfma_f32_32x32x16_bf16(PAF(2), VFR(2), o[0], 0, 0, 0), C1, 0); \
    KRD(GL, 3); GAPB(o[1] = __builtin_amdgcn_mfma_f32_32x32x16_bf16(PAF(2), VFR(6), o[1], 0, 0, 0), C1, 4); \
    GAPB(o[0] = __builtin_amdgcn_mfma_f32_32x32x16_bf16(PAF(3), VFR(3), o[0], 0, 0, 0), C1, 8); \
    GAPB(o[1] = __builtin_amdgcn_mfma_f32_32x32x16_bf16(PAF(3), VFR(7), o[1], 0, 0, 0), C1, 12); \
    } while (0)
  int t = 1;
  for (; t + 5 < NT; t += 2) {
    STEP(pB0, pB1, pA0, pA1, t, true, true, true);     WAIT_BAR(2); RESC(); ROT();
    STEP(pA0, pA1, pB0, pB1, t + 1, true, true, true); WAIT_BAR(2); RESC(); ROT();
  }
  #define ENDW(tt) do { if ((tt) + 3 < NT) { WAIT_BAR(2); } else if ((tt) + 2 < NT) { WAIT_BAR(1); } else { WAIT_BAR(0); } } while (0)
  for (; t + 1 < NT; t += 2) {
    STEP(pB0, pB1, pA0, pA1, t, (t + 3 < NT), (t + 1 < NT), (t + 1 < NT));         ENDW(t);     RESC(); ROT();
    STEP(pA0, pA1, pB0, pB1, t + 1, (t + 4 < NT), (t + 2 < NT), (t + 2 < NT));     ENDW(t + 1); RESC(); ROT();
  }
  STEP(pB0, pB1, pA0, pA1, NT - 1, false, false, false); RESC();
  { float sacc = pB0[0] + pB0[1]; _Pragma("unroll") for (int r = 2; r < 16; ++r) sacc += pB0[r]; _Pragma("unroll") for (int r = 0; r < 16; ++r) sacc += pB1[r]; l_reg += sacc;
    pw0 = (u32x4){PKW(pB0, 0), PKW(pB0, 2), PKW(pB0, 4), PKW(pB0, 6)}; pw1 = (u32x4){PKW(pB0, 8), PKW(pB0, 10), PKW(pB0, 12), PKW(pB0, 14)}; pw2 = (u32x4){PKW(pB1, 0), PKW(pB1, 2), PKW(pB1, 4), PKW(pB1, 6)}; pw3 = (u32x4){PKW(pB1, 8), PKW(pB1, 10), PKW(pB1, 12), PKW(pB1, 14)};
    SBAR(); pv(o, vb0 + sl_cur, PAF(0), PAF(1), PAF(2), PAF(3)); }
  #undef PKW
  #undef PAF
  #undef VFR
  #undef PIN
  #undef MX3
  #undef GAPA
  #undef GAPB
  #undef EX
  #undef VRD
  #undef KRD
  #undef STEP
  #undef ENDW
  { auto rr = __builtin_amdgcn_permlane32_swap(__float_as_uint(l_reg), __float_as_uint(l_reg), false, false); l_reg = __uint_as_float(rr[0]) + __uint_as_float(rr[1]); }
  if (MODE == MB) { if (hi == 0) { float* sp = A_.stat + (wid * QBLK + r32) * A_.ss; sp[0] = mhat; sp[1] = l_reg; } }
  if (hi == 0) wsf[32 + r32] = l_reg; asm volatile("s_waitcnt lgkmcnt(0)" ::: "memory");
  float rli[16];
  #pragma unroll
  for (int r = 0; r < 16; ++r) rli[r] = __builtin_amdgcn_rcpf(wsf[32 + crow(r, hi)]);
  bf16* Ow = A_.O + (wid * QBLK) * A_.os;
  { bf16* stg = (bf16*)(shm + LDS_OST) + wid * 2048;
    #pragma unroll
    for (int r = 0; r < 16; ++r) { const int orow = crow(r, hi);
      #pragma unroll
      for (int d0 = 0; d0 < 2; ++d0) stg[orow * 64 + d0 * 32 + r32] = __float2bfloat16(o[d0][r] * rli[r]); }
    asm volatile("s_waitcnt lgkmcnt(0)" ::: "memory");
    #pragma unroll
    for (int i = 0; i < 4; ++i) { const int row = i * 8 + (lane >> 3), ch = lane & 7; const u32x4 v = *(const u32x4*)(stg + row * 64 + ch * 8); *(u32x4*)(Ow + row * A_.os + ch * 8) = v; } }
  asm volatile("s_waitcnt lgkmcnt(0)\n\ts_barrier" ::: "memory");
  #undef DMA_K
  #undef DMA_V
  #undef TT
  #undef CMASK
  #undef CIN
  #undef NEGM_SET
  #undef START
  #undef RESC
  #undef ROT
}

constexpr int L8_K = 0, L8_V = 3 * 8192, L8_WS = L8_V + 3 * 16384, L8_QO = L8_WS + 2048, L8_END = L8_QO + 8 * 4096;
template <int THRL> __device__ __forceinline__ void attn_unit128(const AttnArgs& A_, char* shm) {
  int tid_ = threadIdx.x; asm volatile("" : "+v"(tid_));
  const int tid = tid_, lane = tid & 63, r32 = lane & 31, hi = lane >> 5; const int wid = __builtin_amdgcn_readfirstlane(tid >> 6);
  const bf16* Qw = A_.Q + (wid * QBLK) * A_.qs;
  const unsigned lds0 = (unsigned)(uintptr_t)shm;
  float* wsf = (float*)(shm + L8_WS) + wid * 64;
  const int ks = A_.ks;
  const bf16* ksrc = A_.K + (lane * ks + wid * 8);
  const bf16* vsrc = A_.V + ((16 * (wid & 3) + (lane >> 2)) * ks + (wid >> 2) * 32 + (lane & 3) * 8);
  const unsigned kdst = lds0 + L8_K + wid * 1024, vdst = lds0 + L8_V + wid * 1024;
  #define DMA_K(t, slot) glds16(ksrc + (int)(t) * KVBLK * ks, (unsigned)__builtin_amdgcn_readfirstlane(kdst + (slot)))
  #define DMA_V(t, slot) do { glds16(vsrc + (int)(t) * KVBLK * ks, (unsigned)__builtin_amdgcn_readfirstlane(vdst + 2 * (slot))); \
                              glds16(vsrc + (int)(t) * KVBLK * ks + 64, (unsigned)__builtin_amdgcn_readfirstlane(vdst + 2 * (slot) + 8192)); } while (0)
  const int vb0 = (int)(lds0 + L8_V) + ((lane >> 4) & 1) * 32 + (lane & 3) * 8 + (4 * hi + ((lane & 15) >> 2)) * 64;
  const char* Kbase = shm + L8_K; bf16x8 kf[8];
  const lds_cptr shm3 = (lds_cptr)shm; const lds_cptr kp0 = shm3 + L8_K + hi * 1024 + r32 * 16; const lds_cptr vp0 = shm3 + L8_V + ((lane >> 4) & 1) * 32 + (lane & 3) * 8 + (4 * hi + ((lane & 15) >> 2)) * 64;
  const lds_cptr qst = shm3 + L8_QO + wid * 4096 + lane * 16;
  const int NT = A_.NT;
  DMA_K(0, 0); DMA_V(0, 0); DMA_K(1, SLOTB);
  { bf16x8 qr[4];
    #pragma unroll
    for (int d0 = 0; d0 < 4; ++d0) qr[d0] = *reinterpret_cast<const bf16x8*>(&Qw[r32 * A_.qs + d0 * 16 + hi * 8]);
    #pragma unroll
    for (int d0 = 0; d0 < 4; ++d0) *(LAS bf16x8*)(shm3 + L8_QO + wid * 4096 + lane * 16 + d0 * 1024) = qr[d0]; }
  #define QLD(d0) (*(const LAS bf16x8*)(qst + (d0) * 1024))
  float mhat = 0.f, l_reg = 0.f; f32x16 o[4]; o[0] = f32x16{}; o[1] = f32x16{}; o[2] = f32x16{}; o[3] = f32x16{};
  const int qrel = wid * QBLK + r32;
  #define NB(tn) ({ float nb_ = -mhat; const int wlo_ = A_.q0 + wid * QBLK, sd_ = (64 * (tn) + 63 < wlo_) ? 1 : ((64 * (tn) > wlo_ + 31) ? -1 : 0); \
      if (sd_ != 0) nb_ = fmaf(-(float)sd_ * A_.s2, (float)(A_.q0 + qrel - 64 * (tn) - 4 * hi), nb_); nb_; })
  #define CMASK(P0, P1, t) score_hook<MA>(P0, P1, (t), A_, qrel, hi, wid, r32, mhat)
  bool resc = false;
  #define RESC() do { if (resc) { asm volatile("s_waitcnt lgkmcnt(0)" ::: "memory"); \
      _Pragma("unroll") for (int d_ = 0; d_ < 4; ++d_) _Pragma("unroll") for (int r = 0; r < 16; ++r) o[d_][r] *= wsf[crow(r, hi)]; } } while (0)
  f32x16 pA0, pA1, pB0, pB1;
  int sl_prev = 0, sl_cur = 0, sl_next = SLOTB;
  #define ROT() do { sl_prev = sl_cur; sl_cur = sl_next; sl_next = (sl_next == (NSLOT - 1) * SLOTB) ? 0 : sl_next + SLOTB; } while (0)
  DMA_K(2, 2 * SLOTB);
  WAIT_BAR(4);
  { f32x16 cin; const float nb0 = NB(0);
    #pragma unroll
    for (int r = 0; r < 16; ++r) cin[r] = nb0;
    bf16x8 qr[4];
    #pragma unroll
    for (int d0 = 0; d0 < 4; ++d0) qr[d0] = QLD(d0);
    qkt(pA0, pA1, Kbase, qr, cin, r32, hi); }
  asm volatile("s_nop 15\n\ts_nop 7" : "+v"(pA0), "+v"(pA1)); CMASK(pA0, pA1, 0);
  { const float rm = rowmax(pA0, pA1); mhat = fadd_s(mhat, rm);
    #pragma unroll
    for (int r = 0; r < 16; ++r) { pA0[r] = fsub_s(pA0[r], rm); pA1[r] = fsub_s(pA1[r], rm); }
    #pragma unroll
    for (int r = 0; r < 16; ++r) pA0[r] = __builtin_amdgcn_exp2f(pA0[r]);
    #pragma unroll
    for (int r = 0; r < 16; ++r) pA1[r] = __builtin_amdgcn_exp2f(pA1[r]); }
  WAIT_BAR(0);
  DMA_K(3, 0); DMA_V(1, SLOTB);
  ROT();
  kload8(kf, kp0 + sl_cur);
  WAIT_BAR(3);
  u32x4 pw0, pw1, pw2, pw3;
  #define PKW(P, B) cvtpk_s(P[B], P[B + 1])
  #define PAF(k) __builtin_bit_cast(bf16x8, pw##k)
  #define VFR(i) (bf16x8){vlo[i][0], vlo[i][1], vlo[i][2], vlo[i][3], vhi[i][0], vhi[i][1], vhi[i][2], vhi[i][3]}
  #define WFR(i) (bf16x8){wlo[i][0], wlo[i][1], wlo[i][2], wlo[i][3], whi[i][0], whi[i][1], whi[i][2], whi[i][3]}
  #define PIN(x) asm volatile("" : "+v"(x))
  #define MX3(a, b, c) __builtin_fmaxf(__builtin_fmaxf((a), (b)), (c))
  #define GAPA(MF, A0, A1, A2, A3, W0, W1, PW) do { MF; sacc += A0; sacc += A1; sacc += A2; sacc += A3; PIN(sacc); W0; W1; PIN(PW); SBAR(); } while (0)
  #define EX(v) __builtin_amdgcn_exp2f(v)
  #define GAPB(MF, X, B) do { MF; X[B] = EX(X[B]); X[B + 1] = EX(X[B + 1]); PIN(X); SBAR(); } while (0)
  #define VRD(i) do { vlo[i] = vtr(vp_ + (((i) >> 2) * 4096 + ((i) & 3) * 1024)); vhi[i] = vtr(vp_ + (((i) >> 2) * 4096 + ((i) & 3) * 1024 + 512)); } while (0)
  #define VRD2(i) do { wlo[i] = vtr(vp_ + (8192 + ((i) >> 2) * 4096 + ((i) & 3) * 1024)); whi[i] = vtr(vp_ + (8192 + ((i) >> 2) * 4096 + ((i) & 3) * 1024 + 512)); SBAR(); } while (0)
  #define KRD(G, j) do { if (G) { kload2(kf, kp0 + sl_next, j); SBAR(); } } while (0)
  #define FOFF(j) (((((j) & 1) + 2 * ((j) >> 3)) * 4096) + ((((j) >> 1) & 3) * 1024))
  #define FRD(j) do { fl[j] = vtr(vp_ + FOFF(j)); fh[j] = vtr(vp_ + FOFF(j) + 512); SBAR(); } while (0)
  #define FFR(j) (bf16x8){fl[j][0], fl[j][1], fl[j][2], fl[j][3], fh[j][0], fh[j][1], fh[j][2], fh[j][3]}
  #define STEP(C0, C1, P0, P1, t, GK, GV, GL) do { SBAR(); \
    const lds_cptr vp_ = vp0 + 2 * sl_prev; s16x4 fl[16], fh[16]; \
    { const float nb_t = NB(t); _Pragma("unroll") for (int r = 0; r < 16; ++r) { C0[r] = nb_t; C1[r] = nb_t; } } \
    bf16x8 q0_ = QLD(0), q1_ = QLD(1); SBAR(); float sacc = (P0[0] + P0[1]); \
    GAPA(C0 = __builtin_amdgcn_mfma_f32_32x32x16_bf16(kf[0], q0_, C0, 0, 0, 0), P0[2], P0[3], P0[4], P0[5],     pw0[0] = PKW(P0, 0), pw0[1] = PKW(P0, 2), pw0); \
    GAPA(C1 = __builtin_amdgcn_mfma_f32_32x32x16_bf16(kf[1], q0_, C1, 0, 0, 0), P0[6], P0[7], P0[8], P0[9],     pw0[2] = PKW(P0, 4), pw0[3] = PKW(P0, 6), pw0); \
    q0_ = QLD(2); SBAR(); \
    GAPA(C0 = __builtin_amdgcn_mfma_f32_32x32x16_bf16(kf[2], q1_, C0, 0, 0, 0),   P0[10], P0[11], P0[12], P0[13], pw1[0] = PKW(P0, 8), pw1[1] = PKW(P0, 10), pw1); \
    GAPA(C1 = __builtin_amdgcn_mfma_f32_32x32x16_bf16(kf[3], q1_, C1, 0, 0, 0),   P0[14], P0[15], P1[0], P1[1],   pw1[2] = PKW(P0, 12), pw1[3] = PKW(P0, 14), pw1); \
    q1_ = QLD(3); SBAR(); \
    GAPA(C0 = __builtin_amdgcn_mfma_f32_32x32x16_bf16(kf[4], q0_, C0, 0, 0, 0),   P1[2], P1[3], P1[4], P1[5],     pw2[0] = PKW(P1, 0), pw2[1] = PKW(P1, 2), pw2); \
    GAPA(C1 = __builtin_amdgcn_mfma_f32_32x32x16_bf16(kf[5], q0_, C1, 0, 0, 0),   P1[6], P1[7], P1[8], P1[9],     pw2[2] = PKW(P1, 4), pw2[3] = PKW(P1, 6), pw2); \
    GAPA(C0 = __builtin_amdgcn_mfma_f32_32x32x16_bf16(kf[6], q1_, C0, 0, 0, 0),   P1[10], P1[11], P1[12], P1[13], pw3[0] = PKW(P1, 8), pw3[1] = PKW(P1, 10), pw3); \
    GAPA(C1 = __builtin_amdgcn_mfma_f32_32x32x16_bf16(kf[7], q1_, C1, 0, 0, 0),   P1[14], P1[15], 0.f, 0.f,       pw3[2] = PKW(P1, 12), pw3[3] = PKW(P1, 14), pw3); \
    l_reg += sacc; \
    if (GK) { DMA_K((t) + 3, sl_cur); } if (GV) { DMA_V((t) + 1, sl_next); } \
    FRD(0); FRD(1); FRD(2); \
    CMASK(C0, C1, t); \
    { float a = MX3(C0[0], C0[1], C1[0]), b = MX3(C0[2], C0[3], C1[1]); a = MX3(a, C1[2], C1[3]); \
      _Pragma("unroll") for (int r = 4; r < 16; r += 4) { a = MX3(a, C0[r], C0[r + 1]); b = MX3(b, C0[r + 2], C0[r + 3]); a = MX3(a, C1[r], C1[r + 1]); b = MX3(b, C1[r + 2], C1[r + 3]); } \
      float rm = __builtin_fmaxf(a, b); { auto rr = __builtin_amdgcn_permlane32_swap(__float_as_uint(rm), __float_as_uint(rm), false, false); rm = __builtin_fmaxf(__uint_as_float(rr[0]), __uint_as_float(rr[1])); } \
      resc = false; \
      if (__builtin_expect(__any(rm > (float)THRL), 0)) { const float dl = __builtin_fmaxf(rm, 0.f); mhat += dl; \
        _Pragma("unroll") for (int r = 0; r < 16; ++r) { C0[r] -= dl; C1[r] -= dl; } \
        const float f = __builtin_amdgcn_exp2f(-dl); l_reg *= f; if (hi == 0) wsf[r32] = f; resc = true; } } \
    SBAR(); \
    GAPB(o[0] = __builtin_amdgcn_mfma_f32_32x32x16_bf16(PAF(0), FFR(0), o[0], 0, 0, 0), C0, 0);   FRD(3); \
    GAPB(o[1] = __builtin_amdgcn_mfma_f32_32x32x16_bf16(PAF(0), FFR(1), o[1], 0, 0, 0), C0, 2);   FRD(4); \
    GAPB(o[0] = __builtin_amdgcn_mfma_f32_32x32x16_bf16(PAF(1), FFR(2), o[0], 0, 0, 0), C0, 4);   FRD(5); \
    GAPB(o[1] = __builtin_amdgcn_mfma_f32_32x32x16_bf16(PAF(1), FFR(3), o[1], 0, 0, 0), C0, 6);   FRD(6); \
    GAPB(o[0] = __builtin_amdgcn_mfma_f32_32x32x16_bf16(PAF(2), FFR(4), o[0], 0, 0, 0), C0, 8);   FRD(7); \
    GAPB(o[1] = __builtin_amdgcn_mfma_f32_32x32x16_bf16(PAF(2), FFR(5), o[1], 0, 0, 0), C0, 10);  FRD(8); \
    GAPB(o[0] = __builtin_amdgcn_mfma_f32_32x32x16_bf16(PAF(3), FFR(6), o[0], 0, 0, 0), C0, 12);  FRD(9); \
    GAPB(o[1] = __builtin_amdgcn_mfma_f32_32x32x16_bf16(PAF(3), FFR(7), o[1], 0, 0, 0), C0, 14);  FRD(10); \
    KRD(GL, 0); GAPB(o[2] = __builtin_amdgcn_mfma_f32_32x32x16_bf16(PAF(0), FFR(8), o[2], 0, 0, 0), C1, 0);   FRD(11); \
    KRD(GL, 1); GAPB(o[3] = __builtin_amdgcn_mfma_f32_32x32x16_bf16(PAF(0), FFR(9), o[3], 0, 0, 0), C1, 2);   FRD(12); \
    KRD(GL, 2); GAPB(o[2] = __builtin_amdgcn_mfma_f32_32x32x16_bf16(PAF(1), FFR(10), o[2], 0, 0, 0), C1, 4);  FRD(13); \
    KRD(GL, 3); GAPB(o[3] = __builtin_amdgcn_mfma_f32_32x32x16_bf16(PAF(1), FFR(11), o[3], 0, 0, 0), C1, 6);  FRD(14); \
    GAPB(o[2] = __builtin_amdgcn_mfma_f32_32x32x16_bf16(PAF(2), FFR(12), o[2], 0, 0, 0), C1, 8);  FRD(15); \
    GAPB(o[3] = __builtin_amdgcn_mfma_f32_32x32x16_bf16(PAF(2), FFR(13), o[3], 0, 0, 0), C1, 10); \
    GAPB(o[2] = __builtin_amdgcn_mfma_f32_32x32x16_bf16(PAF(3), FFR(14), o[2], 0, 0, 0), C1, 12); \
    GAPB(o[3] = __builtin_amdgcn_mfma_f32_32x32x16_bf16(PAF(3), FFR(15), o[3], 0, 0, 0), C1, 14); \
    } while (0)
  int t = 1;
  for (; t + 5 < NT; t += 2) {
    STEP(pB0, pB1, pA0, pA1, t, true, true, true);     WAIT_BAR(3); RESC(); ROT();
    STEP(pA0, pA1, pB0, pB1, t + 1, true, true, true); WAIT_BAR(3); RESC(); ROT();
  }
  #define ENDW(tt) do { if ((tt) + 3 < NT) { WAIT_BAR(3); } else if ((tt) + 2 < NT) { WAIT_BAR(2); } else { WAIT_BAR(0); } } while (0)
  for (; t + 1 < NT; t += 2) {
    STEP(pB0, pB1, pA0, pA1, t, (t + 3 < NT), (t + 1 < NT), (t + 1 < NT));         ENDW(t);     RESC(); ROT();
    STEP(pA0, pA1, pB0, pB1, t + 1, (t + 4 < NT), (t + 2 < NT), (t + 2 < NT));     ENDW(t + 1); RESC(); ROT();
  }
  STEP(pB0, pB1, pA0, pA1, NT - 1, false, false, false); RESC();
  { float sacc = pB0[0] + pB0[1]; _Pragma("unroll") for (int r = 2; r < 16; ++r) sacc += pB0[r]; _Pragma("unroll") for (int r = 0; r < 16; ++r) sacc += pB1[r]; l_reg += sacc;
    pw0 = (u32x4){PKW(pB0, 0), PKW(pB0, 2), PKW(pB0, 4), PKW(pB0, 6)}; pw1 = (u32x4){PKW(pB0, 8), PKW(pB0, 10), PKW(pB0, 12), PKW(pB0, 14)}; pw2 = (u32x4){PKW(pB1, 0), PKW(pB1, 2), PKW(pB1, 4), PKW(pB1, 6)}; pw3 = (u32x4){PKW(pB1, 8), PKW(pB1, 10), PKW(pB1, 12), PKW(pB1, 14)};
    SBAR(); pv(o, vb0 + 2 * sl_cur, PAF(0), PAF(1), PAF(2), PAF(3)); pv(o + 2, vb0 + 2 * sl_cur + 8192, PAF(0), PAF(1), PAF(2), PAF(3)); }
  #undef PKW
  #undef PAF
  #undef VFR
  #undef WFR
  #undef PIN
  #undef MX3
  #undef GAPA
  #undef GAPB
  #undef EX
  #undef VRD
  #undef FOFF
  #undef FRD
  #undef FFR
  #undef KRD
  #undef STEP
  #undef ENDW
  { auto rr = __builtin_amdgcn_permlane32_swap(__float_as_uint(l_reg), __float_as_uint(l_reg), false, false); l_reg = __uint_as_float(rr[0]) + __uint_as_float(rr[1]); }
  if (hi == 0) wsf[32 + r32] = l_reg; asm volatile("s_waitcnt lgkmcnt(0)" ::: "memory");
  float rli[16];
  #pragma unroll
  for (int r = 0; r < 16; ++r) rli[r] = __builtin_amdgcn_rcpf(wsf[32 + crow(r, hi)]);
  bf16* Ow = A_.O + (wid * QBLK) * A_.os;
  { bf16* stg = (bf16*)(shm + L8_QO) + wid * 2048;
    #pragma unroll
    for (int hv = 0; hv < 2; ++hv) {
      #pragma unroll
      for (int r = 0; r < 16; ++r) { const int orow = crow(r, hi);
        #pragma unroll
        for (int d0 = 0; d0 < 2; ++d0) stg[orow * 64 + d0 * 32 + r32] = __float2bfloat16(o[2 * hv + d0][r] * rli[r]); }
      asm volatile("s_waitcnt lgkmcnt(0)" ::: "memory");
      #pragma unroll
      for (int i = 0; i < 4; ++i) { const int row = i * 8 + (lane >> 3), ch = lane & 7; const u32x4 v = *(const u32x4*)(stg + row * 64 + ch * 8); *(u32x4*)(Ow + row * A_.os + hv * 64 + ch * 8) = v; }
      asm volatile("s_waitcnt lgkmcnt(0)" ::: "memory"); } }
  asm volatile("s_waitcnt lgkmcnt(0)\n\ts_barrier" ::: "memory");
  #undef DMA_K
  #undef DMA_V
  #undef QLD
  #undef NB
  #undef CMASK
  #undef RESC
  #undef ROT
}
#undef SBAR
#undef WAIT_BAR
}

__device__ __forceinline__ void transpose_item(const float* W, int K, int N, bf16_t* WT, LAS float* scr, int item, int lane, const float* gk = nullptr) {
    const int nblk = N / 32, kb = item / nblk, nb = item % nblk, k0 = 64 * kb, n0 = 32 * nb;
#pragma unroll 8
    for (int i = 0; i < 32; ++i) { const int kk = 2 * i + (lane >> 5); const float gg = gk ? gk[k0 + kk] : 1.f; scr[kk * 33 + (lane & 31)] = W[(size_t)(k0 + kk) * N + n0 + (lane & 31)] * gg; }
    asm volatile("s_waitcnt lgkmcnt(0)" ::: "memory");
    const int c = lane & 7;
#pragma unroll
    for (int j = 0; j < 4; ++j) { const int n = (lane >> 3) + 8 * j; const LAS float* s = scr + (8 * c) * 33 + n;
        u32x4 o; o.x = pk2(s[0 * 33], s[1 * 33]); o.y = pk2(s[2 * 33], s[3 * 33]); o.z = pk2(s[4 * 33], s[5 * 33]); o.w = pk2(s[6 * 33], s[7 * 33]);
        *(u32x4*)(WT + (size_t)(n0 + n) * K + k0 + 8 * c) = o; }
    asm volatile("s_waitcnt lgkmcnt(0)" ::: "memory");
}
__device__ __forceinline__ void rms_row_bf16(const float* xrow, const float* g, bf16_t* orow, int lane) {
    const f32x4* xr = (const f32x4*)xrow + lane; const f32x4* gr = (const f32x4*)g + lane;
    f32x4 v[4]; float s = 0.f;
#pragma unroll
    for (int j = 0; j < 4; ++j) { v[j] = xr[64 * j]; s += (v[j].x * v[j].x + v[j].y * v[j].y) + (v[j].z * v[j].z + v[j].w * v[j].w); }
    const float rs = rsqrtf(wave_sum(s) * (1.f / DM) + EPS);
    u32x2* o8 = (u32x2*)orow + lane;
#pragma unroll
    for (int j = 0; j < 4; ++j) { const f32x4 gg = gr[64 * j]; u32x2 w; w.x = pk2(v[j].x * rs * gg.x, v[j].y * rs * gg.y); w.y = pk2(v[j].z * rs * gg.z, v[j].w * rs * gg.w); o8[64 * j] = w; }
}
__device__ __forceinline__ void sincos_red(float a, float& s, float& c) {
    const float q = rintf(a * 0.636619772367581f); const int iq = (int)q;
    float r = fmaf(q, -1.5703125f, a); r = fmaf(q, -4.837512969970703125e-4f, r); r = fmaf(q, -7.54978995489188216e-8f, r);
    const float r2 = r * r;
    const float sp = r + r * r2 * (-1.6666654611e-1f + r2 * (8.3321608736e-3f + r2 * (-1.9515295891e-4f)));
    const float cp = 1.0f - 0.5f * r2 + r2 * r2 * (4.166664568298827e-2f + r2 * (-1.388731625493765e-3f + r2 * 2.443315711809948e-5f));
    const int k = iq & 3;
    s = (k == 0) ? sp : (k == 1) ? cp : (k == 2) ? -sp : -cp;
    c = (k == 0) ? cp : (k == 1) ? -sp : (k == 2) ? -cp : sp;
}

#define XB_TMO      128
#define XB_XCNT(j)  (256  + 64 * (j))
#define XB_XSUB(j)  (1280 + 64 * (j))
#define XB_XGEN(j)  (2304 + 64 * (j))
#define XB_TOP      3328
#define XB_TOPGEN   3392
#define XCD_BAR_WORDS 3456
#define XB_SPIN_CAP (1u << 18)

__device__ __forceinline__ unsigned xb_ld(unsigned* p)              { return __hip_atomic_load(p, __ATOMIC_RELAXED, __HIP_MEMORY_SCOPE_AGENT); }
__device__ __forceinline__ unsigned xb_add(unsigned* p, unsigned v) { return __hip_atomic_fetch_add(p, v, __ATOMIC_RELAXED, __HIP_MEMORY_SCOPE_AGENT); }
__device__ __forceinline__ unsigned xb_xcc_id() { return (unsigned)__builtin_amdgcn_s_getreg((3 << 11) | 20) & 0xFu; }
#define XB_SPIN(cond, bar) do { unsigned _sp = 0; while (cond) { __builtin_amdgcn_s_sleep(1); \
    if ((++_sp & 255u) == 0u) { if (xb_ld(&(bar)[XB_TMO])) break; if (_sp > XB_SPIN_CAP) { atomicAdd(&(bar)[XB_TMO], 1u); break; } } } } while (0)

struct XcdBarrier {
    unsigned* bar; unsigned x;
    volatile LAS unsigned* st;
};

__device__ __forceinline__ XcdBarrier xcd_barrier_post(unsigned* bar, volatile LAS unsigned* st) {
    XcdBarrier b; b.bar = bar; b.x = xb_xcc_id(); b.st = st;
    if (threadIdx.x == 0) (void)xb_add(&bar[XB_XCNT(b.x)], 1u);
    return b;
}
__device__ __forceinline__ void xcd_barrier_complete(unsigned* bar, unsigned x, unsigned& nloc, unsigned& nx) {
    const unsigned G = gridDim.x * gridDim.y * gridDim.z;
    unsigned sum, cnt, mine, sp = 0u;
    for (;;) {
        sum = 0u; cnt = 0u; mine = 0u;
#pragma unroll
        for (unsigned j = 0; j < 16; ++j) { const unsigned c = xb_ld(&bar[XB_XCNT(j)]); sum += c; cnt += (c > 0u) ? 1u : 0u; mine = (j == x) ? c : mine; }
        if (sum == G) break;
        __builtin_amdgcn_s_sleep(1);
        if ((++sp & 255u) == 0u) { if (xb_ld(&bar[XB_TMO])) break; if (sp > XB_SPIN_CAP) { atomicAdd(&bar[XB_TMO], 1u); break; } }
    }
    nloc = mine > 0u ? mine : 1u; nx = cnt > 0u ? cnt : 1u;
}

__device__ __forceinline__ void xcd_barrier(const XcdBarrier& b) {
    asm volatile("s_waitcnt vmcnt(0)" ::: "memory");
    __syncthreads();
    if (threadIdx.x == 0) {
        unsigned* bar = b.bar;
        __builtin_amdgcn_s_waitcnt(0);
        unsigned nloc = b.st[0], nx = b.st[1];
        if (nloc == 0u) { xcd_barrier_complete(bar, b.x, nloc, nx); b.st[0] = nloc; b.st[1] = nx; }
        const unsigned old = xb_add(&bar[XB_XSUB(b.x)], 1u);
        const unsigned gen = old / nloc;
        if (old + 1u == (gen + 1u) * nloc) {
            __builtin_amdgcn_fence(__ATOMIC_RELEASE, "agent");
            asm volatile("s_waitcnt vmcnt(0)" ::: "memory");
            const unsigned og = xb_add(&bar[XB_TOP], 1u);
            const unsigned tg = og / nx;
            if (og + 1u == (tg + 1u) * nx) xb_add(&bar[XB_TOPGEN], 1u);
            else XB_SPIN(xb_ld(&bar[XB_TOPGEN]) == tg, bar);
            __builtin_amdgcn_fence(__ATOMIC_ACQUIRE, "agent");
            xb_add(&bar[XB_XGEN(b.x)], 1u);
            asm volatile("s_waitcnt vmcnt(0)" ::: "memory");
        } else {
            XB_SPIN(xb_ld(&bar[XB_XGEN(b.x)]) == gen, bar);
            __builtin_amdgcn_fence(__ATOMIC_ACQUIRE, "agent");
            asm volatile("s_waitcnt vmcnt(0)" ::: "memory");
        }
    }
    __syncthreads();
}


struct Args { const float* in[14]; float* out; unsigned char* ws; };

__global__ void __launch_bounds__(512) mk_fwd(Args args) {
    extern __shared__ __attribute__((aligned(16))) unsigned char lds[];
    cg::grid_group grid = cg::this_grid();
    const int tid0 = threadIdx.x, wave = __builtin_amdgcn_readfirstlane(tid0 >> 6);
#define FRESH_LANE() int tid = tid0; asm volatile("" : "+v"(tid)); const int lane = tid & 63
    const int G = gridDim.x, bx = blockIdx.x;
    const int vcu = (G % 8 == 0) ? (bx % 8) * (G / 8) + bx / 8 : bx;
    const int gw = vcu * 8 + wave, NGW = G * 8;
    LAS unsigned char* ldsl = (LAS unsigned char*)lds;
    if (tid0 < 8) ((LAS unsigned*)(ldsl + MISC_OFF))[tid0] = 0u;
    __syncthreads();
    const XcdBarrier xbar = xcd_barrier_post((unsigned*)(args.ws + WS_BAR), (volatile LAS unsigned*)(ldsl + MISC_OFF));
#define ws (args.ws)
#define x_in (args.in[0])
#define norm_mix (args.in[1])
#define w_in (args.in[2])
#define b_gate (args.in[3])
#define diff_lambda (args.in[4])
#define diff_subln (args.in[5])
#define na_rpb (args.in[6])
#define qk_norm (args.in[7])
#define w_branch (args.in[8])
#define w_out (args.in[9])
#define norm_ffn (args.in[10])
#define w_ff1 (args.in[11])
#define w_ff2 (args.in[12])
#define norm_final (args.in[13])
#define xout (args.out)
#define WinT ((bf16_t*)(ws + WS_WIN))
#define WbrT ((bf16_t*)(ws + WS_WBR))
#define WoutT ((bf16_t*)(ws + WS_WOUT))
#define W1T ((bf16_t*)(ws + WS_W1))
#define W2T ((bf16_t*)(ws + WS_W2))
#define STAT ((float*)(ws + WS_STAT))
#define H ((bf16_t*)(ws + WS_H))
#define ATMP ((bf16_t*)(ws + WS_ATMP))
#define BTMP ((bf16_t*)(ws + WS_BTMP))
#define Y ((bf16_t*)(ws + WS_Y))
#define MERGED ((bf16_t*)(ws + WS_MERGED))
#define Z ((bf16_t*)(ws + WS_Z))
#define U ((bf16_t*)(ws + WS_Z))
#define PROJ ((bf16_t*)(ws + WS_PROJ))
#define XB ((bf16_t*)(ws + WS_XB))
#define SSQM ((float*)(ws + WS_SSQM))
#define SSQF ((float*)(ws + WS_SSQF))
#define NRMQ ((unsigned*)(ws + WS_NRM))
#define NRMK ((unsigned*)(ws + WS_NRM) + 1024)

    {
        FRESH_LANE();
        LAS float* scr = (LAS float*)(ldsl + wave * 16384);
        constexpr int I_IN = (DM / 64) * (INW / 32), I_BR = (512 / 64) * (DM / 32), I_OUT = (DM / 64) * (DM / 32), I_1 = (DM / 64) * (DFF / 32), I_2 = (DFF / 64) * (DM / 32);
        constexpr int NITEMS = 2 * I_IN + 8 * I_BR + 2 * I_OUT + 2 * I_1 + 2 * I_2;
        for (int it = gw; it < NITEMS; it += NGW) {
            int r = it;
            if (r < 2 * I_IN) { const int l = r / I_IN; transpose_item(w_in + (size_t)l * DM * INW, DM, INW, WinT + (size_t)l * INW * DM, scr, r % I_IN, lane, norm_mix + l * DM); continue; } r -= 2 * I_IN;
            if (r < 8 * I_BR) { const int ln = r / I_BR; transpose_item(w_branch + (size_t)ln * 512 * DM, 512, DM, WbrT + (size_t)ln * DM * 512, scr, r % I_BR, lane); continue; } r -= 8 * I_BR;
            if (r < 2 * I_OUT) { const int l = r / I_OUT; transpose_item(w_out + (size_t)l * DM * DM, DM, DM, WoutT + (size_t)l * DM * DM, scr, r % I_OUT, lane); continue; } r -= 2 * I_OUT;
            if (r < 2 * I_1) { const int l = r / I_1; transpose_item(w_ff1 + (size_t)l * DM * DFF, DM, DFF, W1T + (size_t)l * DFF * DM, scr, r % I_1, lane, norm_ffn + l * DM); continue; } r -= 2 * I_1;
            { const int l = r / I_2; transpose_item(w_ff2 + (size_t)l * DFF * DM, DFF, DM, W2T + (size_t)l * DM * DFF, scr, r % I_2, lane); }
        }
        for (int m = gw; m < NTOK; m += NGW) {
            const f32x4* xr = (const f32x4*)(x_in + (size_t)m * DM) + lane; u32x2* o8 = (u32x2*)(XB + (size_t)m * DM) + lane; float sq = 0.f;
#pragma unroll
            for (int j = 0; j < 4; ++j) { const f32x4 v = xr[64 * j]; sq += (v.x * v.x + v.y * v.y) + (v.z * v.z + v.w * v.w); u32x2 w; w.x = pk2(v.x, v.y); w.y = pk2(v.z, v.w); o8[64 * j] = w; }
            sq = wave_sum(sq);
            if (lane == 0) *(f32x4*)(SSQM + (size_t)m * 4) = (f32x4){sq, 0.f, 0.f, 0.f};
        }
    }
    grid.sync();

    for (int l = 0; l < DEPTH; ++l) {
        { FRESH_LANE(); LAS float* tab = (LAS float*)(ldsl + TAB_OFF); for (int i = tid; i < 8 * 465; i += 512) tab[i] = na_rpb[l * 8 * 465 + i] * LOG2E; }
        __syncthreads();
        for (int grp = 0; grp < NGRP; ++grp) {
            const size_t tok0 = (size_t)grp * TG;
            const float* xsrc = (l == 0) ? x_in : xout;
            {
                pg8::Gemm g{XB + tok0 * DM, WinT + (size_t)l * INW * DM, DM, DM, DM, 1 << 30, 0}; pg8::StaticOrder S; S.init(TG, INW, G, bx);
                if (bx == 0) { FRESH_LANE(); NRMQ[tid] = 0u; NRMQ[tid + 512] = 0u; if (tid < 16) NRMQ[1024 + tid] = 0u; (void)lane; }
                pg8::Epi<0> E{PROJ, nullptr, nullptr, b_gate + l * 4096, INW, SSQM + tok0 * 4, nullptr, nullptr, nullptr};
                pg8::gemm_phase(ldsl, g, S, E);
            }
            xcd_barrier(xbar);
            {
                FRESH_LANE();
                const float inv = exp2f(-(float)(lane & 15) * 0.8304820237218406f);
                const float gq = qk_norm[l * 128 + lane], gk = qk_norm[l * 128 + 64 + lane];
                const int per = (TG + NGW - 1) / NGW;
                float mq = 0.f, mk = 0.f; int cu = -1;
                for (int i = 0; i < per; ++i) {
                    const int m = gw * per + i; if (m >= TG) break;
                    if ((m >> 8) != cu) { if (cu >= 0 && (lane & 7) == 0) { atomicMax(NRMQ + cu * 8 + (lane >> 3), __float_as_uint(mq)); atomicMax(NRMK + (cu >> 5) * 8 + (lane >> 3), __float_as_uint(mk)); } cu = m >> 8; mq = 0.f; mk = 0.f; }
                    const int s = (int)((tok0 + m) % SEQ); const float pos = (float)((lane < 32) ? (s >> 6) : (s & 63));
                    float sn, cs; sincos_red(pos * inv, sn, cs);
                    { const bf16_t* ar = PROJ + (size_t)m * INW; const u32x4 qv = *(const u32x4*)(ar + COL_AQ + lane * 8), kv = *(const u32x4*)(ar + COL_AK + lane * 8);
                      float nq = 0.f, nk = 0.f;
#pragma unroll
                      for (int e = 0; e < 4; ++e) { nq += bflo(qv[e]) * bflo(qv[e]) + bfhi(qv[e]) * bfhi(qv[e]); nk += bflo(kv[e]) * bflo(kv[e]) + bfhi(kv[e]) * bfhi(kv[e]); }
                      nq += __shfl_xor(nq, 1); nk += __shfl_xor(nk, 1); nq += __shfl_xor(nq, 2); nk += __shfl_xor(nk, 2); nq += __shfl_xor(nq, 4); nk += __shfl_xor(nk, 4);
                      mq = fmaxf(mq, sqrtf(nq)); mk = fmaxf(mk, sqrtf(nk)); }
                    bf16_t* row = PROJ + (size_t)m * INW + COL_DQ;
#pragma unroll
                    for (int hd = 0; hd < 10; ++hd) {
                        const float v = __uint_as_float((unsigned)row[hd * 64 + lane] << 16);
                        const float rn = rsqrtf(wave_sum(v * v) * (1.f / 64.f) + EPS);
                        const float y = v * rn * (hd < 8 ? gq : gk);
                        const float p = __shfl_xor(y, 16);
                        float o = ((lane >> 4) & 1) ? (y * cs + p * sn) : (y * cs - p * sn);
                        if (hd < 8) o *= C2;
                        row[hd * 64 + lane] = (bf16_t)f2bf(o);
                    }
                }
                if (cu >= 0 && (lane & 7) == 0) { atomicMax(NRMQ + cu * 8 + (lane >> 3), __float_as_uint(mq)); atomicMax(NRMK + (cu >> 5) * 8 + (lane >> 3), __float_as_uint(mk)); }
            }
            xcd_barrier(xbar);
            {
                using namespace attn_body;
                char* shm = (char*)lds;
                {
                    unsigned* qctr = (unsigned*)(ws + WS_BAR) + 3584 + (l * NGRP + grp) * 8;
                    volatile LAS unsigned* slot = (volatile LAS unsigned*)(ldsl + MISC_OFF + 32);
                    const int myx = (G % 8 == 0) ? (vcu / (G / 8)) : 0;
                    for (int qq = 0; qq < 8; ++qq) {
                        const int sx = (myx + qq) & 7;
                        for (;;) {
                            if (tid0 == 0) *slot = atomicAdd(qctr + sx, 1u);
                            __syncthreads();
                            const int j = (int)*slot;
                            __syncthreads();
                            if (j >= 128) break;
                            const int qb = j & 31; AttnArgs a{}; a.qs = INW; a.ks = INW; a.NT = 128; a.tlo = 0; a.thi = 127;
                            if (j >= 32 && j < 96) { const int ds = 2 * sx + ((j - 32) >> 5), bb = ds >> 3, h = ds & 7; const size_t tb = (size_t)bb * SEQ;
                                a.Q = (const bf16*)(PROJ + (tb + qb * 256) * INW + COL_DQ + h * 64); a.K = (const bf16*)(PROJ + tb * INW + COL_DK + (h >> 2) * 64);
                                a.V = (const bf16*)(PROJ + tb * INW + COL_DV + (h >> 2) * 64); a.O = (bf16*)(Y + (tb + qb * 256) * 2048 + 1536 + h * 64); a.os = 2048;
                                attn_unit<MD, 8>(a, shm);
                            } else { const int bb = sx >> 2, hh = ((j < 32) ? 2 : 0) + ((sx >> 1) & 1), comp = sx & 1; const size_t tb = (size_t)bb * SEQ;
                                a.Q = (const bf16*)(PROJ + (tb + qb * 256) * INW + COL_AQ + hh * 128 + comp * 64); a.K = (const bf16*)(PROJ + tb * INW + COL_AK + hh * 128 + comp * 64);
                                a.V = (const bf16*)(PROJ + tb * INW + COL_AV + hh * 128); a.O = (bf16*)(ATMP + (tb + qb * 256) * 1024 + (hh * 2 + comp) * 128); a.os = 1024;
                                a.s2 = exp2f(-2.f * (float)(hh + 1)) * LOG2E;
                                const float Bs = __uint_as_float(NRMQ[(bb * 32 + qb) * 8 + hh * 2 + comp]) * __uint_as_float(NRMK[bb * 8 + hh * 2 + comp]) * 1.02f + 0.25f;
                                const float dlim = fminf((150.f + 2.f * Bs) / a.s2, 1.0e6f), q0f = (float)(qb * 256);
                                int tlo = max(0, (int)floorf((q0f - 63.f - dlim) * (1.f / 64.f))), thi = min(127, (int)ceilf((q0f + 255.f + dlim) * (1.f / 64.f)));
                                if (((thi - tlo + 1) & 1) != 0) { if (tlo > 0) --tlo; else ++thi; }
                                tlo = __builtin_amdgcn_readfirstlane(tlo); thi = __builtin_amdgcn_readfirstlane(thi);
                                a.K += (size_t)tlo * 64 * INW; a.V += (size_t)tlo * 64 * INW; a.q0 = qb * 256 - 64 * tlo; a.NT = thi - tlo + 1;
                                attn_unit128<8>(a, shm);
                            }
                        }
                    }
                }
                for (int u = vcu; u < GB * 24 * 32; u += G) {
                    const int sg = u >> 5, blk = u & 31, bb = sg / 24, k = sg % 24, gp = k >> 3, h = k & 7, dsh = 2 * gp, dil = 1 << dsh;
                    const int nblk = 32 >> dsh, res = blk / nblk, i0 = (blk % nblk) * 256, L = SEQ >> dsh;
                    const long tq = (long)bb * SEQ + res + (long)i0 * dil, tk = (long)bb * SEQ + res + (long)(i0 - 64) * dil;
                    AttnArgs a{}; a.qs = dil * INW; a.ks = dil * INW; a.os = dil * 1536; a.NT = 6; a.tlo = (i0 == 0) ? 1 : 0; a.thi = (i0 + 256 == L) ? 4 : 5;
                    const int cq = COL_B + gp * 1536 + h * 64;
                    a.Q = (const bf16*)(PROJ + tq * INW + cq); a.K = (const bf16*)(PROJ + tk * INW + cq + 512); a.V = (const bf16*)(PROJ + tk * INW + cq + 1024);
                    a.O = (bf16*)(BTMP + tq * 1536 + gp * 512 + h * 64);
                    a.s2 = exp2f(-(float)(h + 1)) * (float)dil * LOG2E; a.stat = STAT + (tq * 24 + gp * 8 + h) * 2; a.ss = dil * 48;
                    attn_unit<MB, 8>(a, shm);
                }
                for (int u = vcu; u < GB * 8 * 32; u += G) {
                    const int sg = u >> 5, qb = u & 31, bb = sg >> 3, h = sg & 7, r0 = 4 * qb, kb = min(max(r0 - 4, 0), 116); const size_t tb = (size_t)bb * SEQ;
                    AttnArgs a{}; a.qs = INW; a.ks = INW; a.os = 2048; a.NT = 12; a.tlo = 0; a.thi = 11; a.q0 = r0; a.kb = kb;
                    a.Q = (const bf16*)(PROJ + (tb + r0 * 64) * INW + COL_CQ + h * 64); a.K = (const bf16*)(PROJ + (tb + kb * 64) * INW + COL_CK + h * 64);
                    a.V = (const bf16*)(PROJ + (tb + kb * 64) * INW + COL_CV + h * 64); a.O = (bf16*)(Y + (tb + r0 * 64) * 2048 + 1024 + h * 64);
                    a.tab = (lds_fptr)((lds_cptr)shm + TAB_OFF) + h * 465;
                    attn_unit<MC, 8>(a, shm);
                }
            }
            xcd_barrier(xbar);
            {
                FRESH_LANE();
                int l_ = l; asm volatile("" : "+s"(l_));
                const float lam_init = (l_ == 0) ? 0.2f : (0.8f - 0.6f * 0.7408182206817179f);
                float lam;
                { const float* lp = diff_lambda + l * 256; const float a = lp[lane] * lp[64 + lane], b = lp[128 + lane] * lp[192 + lane]; lam = expf(wave_sum(a)) - expf(wave_sum(b)) + lam_init; lam = __uint_as_float(__builtin_amdgcn_readfirstlane(__float_as_uint(lam))); }
                const float out_scale = 1.f - lam_init;
                const float g0 = diff_subln[l * 128 + 2 * lane], g1 = diff_subln[l * 128 + 2 * lane + 1];
                for (int m = gw; m < TG; m += NGW) {
                    const unsigned* at = (const unsigned*)(ATMP + (size_t)m * 1024); unsigned* yr = (unsigned*)(Y + (size_t)m * 2048);
#pragma unroll
                    for (int hh = 0; hh < 4; ++hh) {
                        const unsigned w0 = at[(hh * 2) * 64 + lane], w1 = at[(hh * 2 + 1) * 64 + lane];
                        const float d0 = bflo(w0) - lam * bflo(w1), d1 = bfhi(w0) - lam * bfhi(w1);
                        const float rn = rsqrtf(wave_sum(d0 * d0 + d1 * d1) * (1.f / 128.f) + EPS) * out_scale;
                        yr[hh * 64 + lane] = pk2(d0 * rn * g0, d1 * rn * g1);
                    }
                    const int h = lane >> 3, d8 = (lane & 7) * 8;
                    const float* st = STAT + (size_t)m * 48 + h * 2;
                    const float m0 = st[0], l0 = st[1], m1 = st[16], l1 = st[17], m2 = st[32], l2 = st[33];
                    const float ms = fmaxf(m0, fmaxf(m1, m2));
                    const float w0 = l0 * exp2f(m0 - ms), w1 = l1 * exp2f(m1 - ms), w2 = l2 * exp2f(m2 - ms); const float inv = 1.f / (w0 + w1 + w2);
                    const bf16_t* bt = BTMP + (size_t)m * 1536 + h * 64 + d8;
                    const u32x4 a0 = *(const u32x4*)bt, a1 = *(const u32x4*)(bt + 512), a2 = *(const u32x4*)(bt + 1024);
                    u32x4 o;
#pragma unroll
                    for (int e = 0; e < 4; ++e) { const float lo = (w0 * bflo(a0[e]) + w1 * bflo(a1[e]) + w2 * bflo(a2[e])) * inv, hi = (w0 * bfhi(a0[e]) + w1 * bfhi(a1[e]) + w2 * bfhi(a2[e])) * inv; o[e] = pk2(lo, hi); }
                    *(u32x4*)(Y + (size_t)m * 2048 + 512 + h * 64 + d8) = o;
                }
            }
            xcd_barrier(xbar);
            {
                pg8::Gemm g{Y, WbrT + (size_t)l * 4096 * 512, 2048, 512, 512, 4, 512}; pg8::StaticOrder S; S.init(TG, 4096, G, bx);
                pg8::Epi<1> E{Z, nullptr, nullptr, nullptr, 4096, nullptr, nullptr, nullptr, nullptr};
                pg8::gemm_phase(ldsl, g, S, E);
            }
            xcd_barrier(xbar);
            { FRESH_LANE();
            for (int m = gw; m < TG; m += NGW) {
                const bf16_t* gr = PROJ + (size_t)m * INW + COL_GATE; const bf16_t* zr = Z + (size_t)m * 4096;
#pragma unroll
                for (int j = 0; j < 2; ++j) { const int c = lane * 8 + j * 512; float acc[8] = {0.f, 0.f, 0.f, 0.f, 0.f, 0.f, 0.f, 0.f};
#pragma unroll
                    for (int n = 0; n < 4; ++n) { const u32x4 gv = *(const u32x4*)(gr + n * 1024 + c), zv = *(const u32x4*)(zr + n * 1024 + c);
#pragma unroll
                        for (int e = 0; e < 4; ++e) { acc[2 * e] += bflo(gv[e]) * bflo(zv[e]); acc[2 * e + 1] += bfhi(gv[e]) * bfhi(zv[e]); } }
                    u32x4 o; o.x = pk2(acc[0], acc[1]); o.y = pk2(acc[2], acc[3]); o.z = pk2(acc[4], acc[5]); o.w = pk2(acc[6], acc[7]);
                    *(u32x4*)(MERGED + (size_t)m * DM + c) = o; }
            } }
            xcd_barrier(xbar);
            {
                pg8::Gemm g{MERGED, WoutT + (size_t)l * DM * DM, DM, DM, DM, 1 << 30, 0}; pg8::StaticOrder S; S.init(TG, DM, G, bx);
                pg8::Epi<3> E{nullptr, xout + tok0 * DM, xsrc + tok0 * DM, nullptr, DM, nullptr, H, SSQF, (LAS float*)(ldsl + SSQ_OFF)};
                pg8::gemm_phase(ldsl, g, S, E);
            }
            xcd_barrier(xbar);
            {
                pg8::Gemm g{H, W1T + (size_t)l * DFF * DM, DM, DM, DM, 1 << 30, 0}; pg8::StaticOrder S; S.init(TG, DFF, G, bx);
                pg8::Epi<2> E{U, nullptr, nullptr, nullptr, DFF, SSQF, nullptr, nullptr, nullptr};
                pg8::gemm_phase(ldsl, g, S, E);
            }
            xcd_barrier(xbar);
            {
                pg8::Gemm g{U, W2T + (size_t)l * DM * DFF, DFF, DFF, DFF, 1 << 30, 0}; pg8::StaticOrder S; S.init(TG, DM, G, bx);
                pg8::Epi<3> E{nullptr, xout + tok0 * DM, xout + tok0 * DM, nullptr, DM, nullptr, XB + tok0 * DM, SSQM + tok0 * 4, (LAS float*)(ldsl + SSQ_OFF)};
                pg8::gemm_phase(ldsl, g, S, E);
            }
            if (l == DEPTH - 1 && grp == NGRP - 1) xcd_barrier(xbar);
        }
    }
    FRESH_LANE();
    for (int m = gw; m < NTOK; m += NGW) {
        f32x4* o = (f32x4*)(xout + (size_t)m * DM) + lane; const f32x4* g4 = (const f32x4*)norm_final + lane;
        f32x4 v[4]; float s = 0.f;
#pragma unroll
        for (int j = 0; j < 4; ++j) { v[j] = o[64 * j]; s += (v[j].x * v[j].x + v[j].y * v[j].y) + (v[j].z * v[j].z + v[j].w * v[j].w); }
        const float r = rsqrtf(wave_sum(s) * (1.f / DM) + EPS);
#pragma unroll
        for (int j = 0; j < 4; ++j) { const f32x4 g = g4[64 * j]; o[64 * j] = (f32x4){v[j].x * r * g.x, v[j].y * r * g.y, v[j].z * r * g.z, v[j].w * r * g.w}; }
    }
}

#undef ws
#undef x_in
#undef norm_mix
#undef w_in
#undef b_gate
#undef diff_lambda
#undef diff_subln
#undef na_rpb
#undef qk_norm
#undef w_branch
#undef w_out
#undef norm_ffn
#undef w_ff1
#undef w_ff2
#undef norm_final
#undef xout
#undef WinT
#undef WbrT
#undef WoutT
#undef W1T
#undef W2T
#undef STAT
#undef H
#undef ATMP
#undef BTMP
#undef Y
#undef MERGED
#undef Z
#undef U
#undef PROJ
#undef NRMQ
#undef XB
#undef SSQM
#undef SSQF
#undef NRMK

extern "C" void kernel_launch(void* const* d_in, const int* in_sizes, int n_in, void* d_out, int out_size, void* d_ws, size_t ws_size, hipStream_t stream) {
    static int grid_blocks = 0;
    if (!grid_blocks) {
        int dev = 0, cus = 0, per_cu = 0;
        (void)hipGetDevice(&dev);
        (void)hipDeviceGetAttribute(&cus, hipDeviceAttributeMultiprocessorCount, dev);
        (void)hipFuncSetAttribute((const void*)mk_fwd, hipFuncAttributeMaxDynamicSharedMemorySize, LDS_BYTES);
        (void)hipOccupancyMaxActiveBlocksPerMultiprocessor(&per_cu, (const void*)mk_fwd, 512, LDS_BYTES);
        if (per_cu < 1) per_cu = 1;
        grid_blocks = cus * per_cu;
        if (ws_size < WS_END || n_in != 14) { fprintf(stderr, "kernel_launch: workspace %zu < %zu or n_in %d != 14\n", ws_size, (size_t)WS_END, n_in); grid_blocks = -1; }
    }
    if (grid_blocks < 0) return;
    (void)hipMemsetAsync((char*)d_ws + WS_BAR, 0, 16384, stream);
    Args a{};
    for (int i = 0; i < 14; ++i) a.in[i] = (const float*)d_in[i];
    a.out = (float*)d_out; a.ws = (unsigned char*)d_ws;
    void* kargs[] = {&a};
    hipError_t e = hipLaunchCooperativeKernel((const void*)mk_fwd, dim3(grid_blocks), dim3(512), kargs, LDS_BYTES, stream);
    if (e != hipSuccess) fprintf(stderr, "cooperative launch failed: %s (grid %d)\n", hipGetErrorString(e), grid_blocks);
}
```

```cpp
#include <hip/hip_runtime.h>
#include <hip/hip_cooperative_groups.h>
#include <hip/hip_bf16.h>
#include <cstdio>
#include <cstdint>
#include <cmath>
namespace cg = cooperative_groups;

constexpr int BATCH = 8, SEQ = 8192, DM = 1024, NTOK = BATCH * SEQ, INW = 12544, DFF = 4096, DEPTH = 2;
constexpr int GB = 2, TG = GB * SEQ, NGRP = BATCH / GB;
constexpr float EPS = 1e-6f;
constexpr float LOG2E = 1.4426950408889634f;
constexpr float C2 = 0.125f * LOG2E;
constexpr int COL_AQ = 0, COL_AK = 512, COL_AV = 1024, COL_B = 1536, COL_CQ = 6144, COL_CK = 6656, COL_CV = 7168, COL_DQ = 7680, COL_DK = 8192, COL_DV = 8320, COL_GATE = 8448;
constexpr size_t MiB = 1u << 20;
constexpr size_t WS_WIN = 0, WS_WBR = 49 * MiB, WS_WOUT = 57 * MiB, WS_W1 = 61 * MiB, WS_W2 = 77 * MiB, WS_STAT = 93 * MiB, WS_H = 96 * MiB, WS_ATMP = 128 * MiB,
                 WS_BTMP = 160 * MiB, WS_Y = 208 * MiB, WS_MERGED = 272 * MiB, WS_Z = 304 * MiB, WS_PROJ = 432 * MiB, WS_NRM = 824 * MiB, WS_BAR = 824 * MiB + 512 * 1024, WS_SSQM = 825 * MiB, WS_SSQF = 826 * MiB, WS_XB = 827 * MiB, WS_END = 955 * MiB;
constexpr int LDS_BYTES = 151552, TAB_OFF = 131072, MISC_OFF = 147072, SSQ_OFF = 147456;

#define LAS __attribute__((address_space(3)))
typedef unsigned short bf16_t;
typedef short bf16x8 __attribute__((ext_vector_type(8)));
typedef float f32x4 __attribute__((ext_vector_type(4)));
typedef unsigned u32x4 __attribute__((ext_vector_type(4)));
typedef unsigned u32x2 __attribute__((ext_vector_type(2)));

__device__ __forceinline__ unsigned f2bf(float f) { unsigned u = __builtin_bit_cast(unsigned, f); return (u + 0x7fffu + ((u >> 16) & 1u)) >> 16; }
__device__ __forceinline__ unsigned pk2(float lo, float hi) { return f2bf(lo) | (f2bf(hi) << 16); }
__device__ __forceinline__ float bflo(unsigned w) { return __uint_as_float(w << 16); }
__device__ __forceinline__ float bfhi(unsigned w) { return __uint_as_float(w & 0xffff0000u); }
__device__ __forceinline__ float wave_sum(float v) {
#pragma unroll
    for (int o = 1; o < 64; o <<= 1) v += __shfl_xor(v, o);
    return v;
}

namespace pg8 {
constexpr int BM = 256, BK = 64, HALF = 128, HTB = HALF * BK * 2, STAGE_BYTES = 8 * HTB, NXCD = 8, WGM = 4;
__host__ __device__ __forceinline__ int lds_byte(int r, int c) { const int st = (r >> 4) * 2 + (c >> 5), rr = r & 15, cc = c & 31, ob = rr * 64 + cc * 2; return st * 1024 + (ob ^ (((ob >> 9) & 1) << 5)); }
__host__ __device__ __forceinline__ void stage_rc(int b, int& R, int& C) { const int st = b / 1024, sb = b % 1024, swz = sb ^ (((sb >> 9) & 1) << 5); R = (st >> 1) * 16 + swz / 64; C = (st & 1) * 32 + (swz % 64) / 2; }
__host__ __device__ __forceinline__ int perm32(int rho) { const int n = rho >> 4, i = rho & 15; return 8 * (i >> 2) + 4 * n + (i & 3); }

struct Unit { int pm, pn; };
struct Gemm { const bf16_t* A; const bf16_t* Bt; int lda, ldb, K, adiv, astride; };

struct StaticOrder {
    int nM, nN, nwg, G, c;
    __device__ void init(int M, int N, int G_, int c_) { nM = M / BM; nN = N / BM; nwg = nM * nN; G = G_; c = c_; }
    __device__ bool next(int i, Unit& u) const {
        const long L = (long)i * G + c; if (L >= nwg) return false;
        int wgid = (int)L; { const int q = nwg / NXCD, r = nwg % NXCD, xcd = wgid % NXCD, off = wgid / NXCD; wgid = (xcd < r ? xcd * (q + 1) : r * (q + 1) + (xcd - r) * q) + off; }
        const int nig = WGM * nN, gid = wgid / nig, fm = gid * WGM, gsz = (nM - fm) < WGM ? (nM - fm) : WGM;
        u.pm = fm + ((wgid % nig) % gsz); u.pn = (wgid % nig) / gsz; return true;
    }
};

__device__ __forceinline__ unsigned cvt_pk_bf16(float lo, float hi) { unsigned r; asm volatile("v_cvt_pk_bf16_f32 %0, %1, %2" : "=v"(r) : "v"(lo), "v"(hi)); return r; }

template <int MODE> struct Epi {
    bf16_t* O; float* Of; const float* base; const float* bias; int ldc;
    const float* ssq;
    bf16_t* XBo; float* SSQo; LAS float* lx;
    __device__ __forceinline__ void operator()(const f32x4 (&acc)[2][2][4][2], const Unit& u, int wr, int wc, int fr, int fq) const {
        const int row0 = u.pm * BM + wr * 64 + fr, col0 = u.pn * BM + wc * 32 + 8 * fq;
        int kind = 0; float sc = 1.f;
        if (MODE == 0) { const int pn = u.pn; if (pn >= 33) kind = 2; else if (pn < 2 || pn == 6 || pn == 7 || pn == 12 || pn == 13 || pn == 18 || pn == 19 || pn == 24 || pn == 25) sc = C2; }
        float rsv[2][4]; f32x4 bv[2][2];
#pragma unroll
        for (int ai = 0; ai < 2; ++ai)
#pragma unroll
            for (int m = 0; m < 4; ++m) { rsv[ai][m] = 1.f;
                if (MODE == 0 || MODE == 2) { const f32x4 q = *(const f32x4*)(ssq + (size_t)(row0 + ai * HALF + m * 16) * 4); rsv[ai][m] = rsqrtf(((q[0] + q[1]) + (q[2] + q[3])) * (1.f / 1024.f) + EPS); } }
#pragma unroll
        for (int bj = 0; bj < 2; ++bj)
#pragma unroll
            for (int n = 0; n < 2; ++n) { bv[bj][n] = (f32x4){0.f, 0.f, 0.f, 0.f}; if (MODE == 0) { if (kind == 2) bv[bj][n] = *(const f32x4*)(bias + col0 + bj * HALF - COL_GATE + 4 * n); } }
        f32x4 nb[2][2];
        if (MODE == 3) {
#pragma unroll
            for (int bj = 0; bj < 2; ++bj)
#pragma unroll
                for (int n = 0; n < 2; ++n) nb[bj][n] = *(const f32x4*)(base + (size_t)row0 * ldc + col0 + bj * HALF + 4 * n);
        }
#pragma unroll
        for (int ai = 0; ai < 2; ++ai)
#pragma unroll
            for (int m = 0; m < 4; ++m) { const size_t roff = (size_t)(row0 + ai * HALF + m * 16) * ldc; float psq = 0.f; const float rs = rsv[ai][m];
                f32x4 cb[2][2];
                if (MODE == 3) {
#pragma unroll
                    for (int bj = 0; bj < 2; ++bj)
#pragma unroll
                        for (int n = 0; n < 2; ++n) cb[bj][n] = nb[bj][n];
                    const int g1 = ai * 4 + m + 1;
                    if (g1 < 8) { const size_t r1 = (size_t)(row0 + (g1 >> 2) * HALF + (g1 & 3) * 16) * ldc;
#pragma unroll
                        for (int bj = 0; bj < 2; ++bj)
#pragma unroll
                            for (int n = 0; n < 2; ++n) nb[bj][n] = *(const f32x4*)(base + r1 + col0 + bj * HALF + 4 * n); }
                }
#pragma unroll
                for (int bj = 0; bj < 2; ++bj) { const int col = col0 + bj * HALF; f32x4 v0 = acc[ai][bj][m][0], v1 = acc[ai][bj][m][1];
                    if (MODE == 3) {
                        v0 = cb[bj][0] + v0; v1 = cb[bj][1] + v1;
                        *(f32x4*)(Of + roff + col) = v0; *(f32x4*)(Of + roff + col + 4) = v1;
                        psq += (v0[0] * v0[0] + v0[1] * v0[1]) + (v0[2] * v0[2] + v0[3] * v0[3]) + (v1[0] * v1[0] + v1[1] * v1[1]) + (v1[2] * v1[2] + v1[3] * v1[3]);
                        u32x4 w; w.x = cvt_pk_bf16(v0[0], v0[1]); w.y = cvt_pk_bf16(v0[2], v0[3]); w.z = cvt_pk_bf16(v1[0], v1[1]); w.w = cvt_pk_bf16(v1[2], v1[3]);
                        *(u32x4*)(XBo + roff + col) = w;
                    } else {
                        if (MODE == 0 || MODE == 2) { v0 = v0 * rs; v1 = v1 * rs; }
                        if (MODE == 0) {
                            if (kind == 2) {
#pragma unroll
                                for (int e = 0; e < 4; ++e) { v0[e] = 1.f / (1.f + __expf(-(v0[e] + bv[bj][0][e]))); v1[e] = 1.f / (1.f + __expf(-(v1[e] + bv[bj][1][e]))); } }
                            else { v0 = v0 * sc; v1 = v1 * sc; }
                        }
                        if (MODE == 2) {
#pragma unroll
                            for (int e = 0; e < 4; ++e) { const float a = fmaxf(v0[e], 0.f), b = fmaxf(v1[e], 0.f); v0[e] = a * a; v1[e] = b * b; } }
                        u32x4 w; w.x = cvt_pk_bf16(v0[0], v0[1]); w.y = cvt_pk_bf16(v0[2], v0[3]); w.z = cvt_pk_bf16(v1[0], v1[1]); w.w = cvt_pk_bf16(v1[2], v1[3]);
                        *(u32x4*)(O + roff + col) = w;
                    } }
                if (MODE == 3) { psq += __shfl_xor(psq, 16); psq += __shfl_xor(psq, 32); if (fq == 0) lx[(ai * HALF + wr * 64 + m * 16 + fr) * 4 + wc] = psq; }
            }
        if (MODE == 3) {
            asm volatile("s_waitcnt lgkmcnt(0)" ::: "memory"); __builtin_amdgcn_s_barrier(); asm volatile("" ::: "memory");
            const int t = threadIdx.x;
            if (t < 256) { const f32x4 q = *(const LAS f32x4*)(lx + t * 4); SSQo[(size_t)(u.pm * BM + t) * 4 + u.pn] = (q[0] + q[1]) + (q[2] + q[3]); }
        }
    }
};

template <class EpiT>
__device__ __forceinline__ void gemm_phase(LAS unsigned char* lds, const Gemm g, const StaticOrder& S, const EpiT& E) {
    int tid_ = threadIdx.x; asm volatile("" : "+v"(tid_));
    const int tid = tid_, wid = __builtin_amdgcn_readfirstlane(tid >> 6), lane = tid & 63, wr = wid >> 2, wc = wid & 3, fr = lane & 15, fq = lane >> 4;
    const int K = g.K, nt = K / BK;
    unsigned voffA[2], voffB[2];
#pragma unroll
    for (int i = 0; i < 2; ++i) { int R, C; stage_rc(tid * 16 + i * 8192, R, C); const int Rb = (R & ~31) + perm32(R & 31);
        voffA[i] = (unsigned)(R * g.lda + C) * 2u; voffB[i] = (unsigned)(Rb * g.ldb + C) * 2u; }
    const size_t kstep = (size_t)(BK * 2);
    const size_t hA = (size_t)HALF * g.lda * 2, hB = (size_t)HALF * g.ldb * 2;
    const size_t tA = 2 * hA, tB = 2 * hB;
    const unsigned ldsw = (unsigned)wid * 1024u;
    const int aoff = lds_byte(wr * 64 + fr, fq * 8), boff = lds_byte(wc * 32 + fr, fq * 8);
#define PG8_SA(b, h) (((b) * 2 + (h)) * HTB)
#define PG8_SB(b, h) ((4 + (b) * 2 + (h)) * HTB)
#define PG8_STAGE(bufoff, gbase, voff) do { _Pragma("unroll") for (int _i = 0; _i < 2; ++_i) \
        __builtin_amdgcn_global_load_lds((const unsigned*)((const char*)(gbase) + (voff)[_i]), (LAS unsigned*)(lds + (bufoff) + ldsw + _i * 8192), 16, 0, 0); } while (0)
#define PG8_LDA(dst, b, h) do { _Pragma("unroll") for (int m = 0; m < 4; ++m) _Pragma("unroll") for (int k = 0; k < 2; ++k) dst[m][k] = *(const LAS bf16x8*)(lds + PG8_SA(b, h) + aoff + m * 2048 + k * 1024); } while (0)
#define PG8_LDB(dst, b, h) do { _Pragma("unroll") for (int n = 0; n < 2; ++n) _Pragma("unroll") for (int k = 0; k < 2; ++k) dst[n][k] = *(const LAS bf16x8*)(lds + PG8_SB(b, h) + boff + n * 2048 + k * 1024); } while (0)
#define PG8_MMA(ai, bj, At, Bt) do { __builtin_amdgcn_s_setprio(1); _Pragma("unroll") for (int m = 0; m < 4; ++m) _Pragma("unroll") for (int n = 0; n < 2; ++n) _Pragma("unroll") for (int k = 0; k < 2; ++k) \
        acc[ai][bj][m][n] = __builtin_amdgcn_mfma_f32_16x16x32_bf16(Bt[n][k], At[m][k], acc[ai][bj][m][n], 0, 0, 0); __builtin_amdgcn_s_setprio(0); } while (0)
#define PG8_WAIT_V(n) asm volatile("s_waitcnt vmcnt(" #n ")" ::: "memory")
#define PG8_WAIT_L(n) asm volatile("s_waitcnt lgkmcnt(" #n ")" ::: "memory")
#define PG8_BAR __builtin_amdgcn_s_barrier()
#define PG8_SCHED __builtin_amdgcn_sched_barrier(0)
#define PG8_PA(u) ((const char*)g.A + (size_t)(u).pm * tA + (size_t)((u).pn / g.adiv) * (size_t)g.astride * 2)
#define PG8_PB(u) ((const char*)g.Bt + (size_t)(u).pn * tB)
    Unit cur, nxt; int ui = 0;
    if (!S.next(0, cur)) return;
    f32x4 acc[2][2][4][2];
#pragma unroll
    for (int a = 0; a < 2; ++a)
#pragma unroll
        for (int b = 0; b < 2; ++b)
#pragma unroll
            for (int m = 0; m < 4; ++m)
#pragma unroll
                for (int n = 0; n < 2; ++n) acc[a][b][m][n] = (f32x4){0.f, 0.f, 0.f, 0.f};
    bf16x8 At[4][2], B0[2][2], B1[2][2];
    const char* cA = PG8_PA(cur); const char* cB = PG8_PB(cur);
    PG8_STAGE(PG8_SB(0, 0), cB, voffB); PG8_STAGE(PG8_SB(0, 1), cB + hB, voffB); PG8_STAGE(PG8_SA(0, 0), cA, voffA); PG8_STAGE(PG8_SA(0, 1), cA + hA, voffA);
    if (wr == 1) PG8_BAR;
    PG8_WAIT_V(2); PG8_BAR;
    PG8_STAGE(PG8_SB(1, 0), cB + kstep, voffB); PG8_STAGE(PG8_SA(1, 0), cA + kstep, voffA); PG8_STAGE(PG8_SB(1, 1), cB + hB + kstep, voffB);
    PG8_WAIT_V(6); PG8_BAR;
    for (;;) {
        const bool has_next = S.next(ui + 1, nxt);
        const char* nA = has_next ? PG8_PA(nxt) : cA; const char* nB = has_next ? PG8_PB(nxt) : cB;
        for (int t = 0; t < nt; t += 2) {
            const bool last = (t == nt - 2);
            const char* a1 = cA + (size_t)(t + 1) * kstep;
            const char* a2 = last ? nA : cA + (size_t)(t + 2) * kstep; const char* b2 = last ? nB : cB + (size_t)(t + 2) * kstep;
            const char* a3 = a2 + kstep; const char* b3 = b2 + kstep;
            PG8_LDB(B0, 0, 0); PG8_LDB(B1, 0, 1); PG8_SCHED; PG8_LDA(At, 0, 0); PG8_STAGE(PG8_SA(1, 1), a1 + hA, voffA);
            PG8_WAIT_V(8); PG8_WAIT_L(0); PG8_BAR; PG8_MMA(0, 0, At, B0); PG8_MMA(0, 1, At, B1); PG8_BAR; PG8_SCHED;
            PG8_LDA(At, 0, 1); PG8_STAGE(PG8_SB(0, 0), b2, voffB); PG8_STAGE(PG8_SB(0, 1), b2 + hB, voffB); PG8_STAGE(PG8_SA(0, 0), a2, voffA);
            PG8_WAIT_V(8); PG8_WAIT_L(0); PG8_BAR; PG8_MMA(1, 0, At, B0); PG8_MMA(1, 1, At, B1); PG8_BAR; PG8_SCHED;
            PG8_LDB(B0, 1, 0); PG8_LDB(B1, 1, 1); PG8_SCHED; PG8_LDA(At, 1, 0); PG8_STAGE(PG8_SA(0, 1), a2 + hA, voffA);
            PG8_WAIT_V(8); PG8_WAIT_L(0); PG8_BAR; PG8_MMA(0, 0, At, B0); PG8_MMA(0, 1, At, B1); PG8_BAR; PG8_SCHED;
            PG8_LDA(At, 1, 1); PG8_STAGE(PG8_SB(1, 0), b3, voffB); PG8_STAGE(PG8_SB(1, 1), b3 + hB, voffB); PG8_STAGE(PG8_SA(1, 0), a3, voffA);
            PG8_WAIT_V(8); PG8_WAIT_L(0); PG8_BAR; PG8_MMA(1, 0, At, B0); PG8_MMA(1, 1, At, B1); PG8_BAR; PG8_SCHED;
        }
        if (wr == 0) PG8_BAR;
        E(acc, cur, wr, wc, fr, fq);
        if (!has_next) break;
#pragma unroll
        for (int a = 0; a < 2; ++a)
#pragma unroll
            for (int b = 0; b < 2; ++b)
#pragma unroll
                for (int m = 0; m < 4; ++m)
#pragma unroll
                    for (int n = 0; n < 2; ++n) acc[a][b][m][n] = (f32x4){0.f, 0.f, 0.f, 0.f};
        cur = nxt; cA = nA; cB = nB; ++ui;
        if (wr == 1) PG8_BAR;
    }
    PG8_WAIT_V(0);
    PG8_BAR;
#undef PG8_SA
#undef PG8_SB
#undef PG8_STAGE
#undef PG8_LDA
#undef PG8_LDB
#undef PG8_MMA
#undef PG8_WAIT_V
#undef PG8_WAIT_L
#undef PG8_BAR
#undef PG8_SCHED
#undef PG8_PA
#undef PG8_PB
}
}

namespace attn_body {
using bf16 = __hip_bfloat16;
using s16x4 = __attribute__((ext_vector_type(4))) short;
using f32x16 = __attribute__((ext_vector_type(16))) float;
constexpr int NW = 8, QBLK = 32, QB = QBLK * NW, KVBLK = 64;
constexpr int MA = 0, MB = 1, MC = 2, MD = 3;
__device__ __forceinline__ int crow(int r, int hi) { return (r & 3) + 8 * (r >> 2) + 4 * hi; }
#define SBAR() __builtin_amdgcn_sched_barrier(0)
constexpr int NSLOT = 3, SLOTB = 8192;
constexpr int LDS_K = 0, LDS_V = NSLOT * SLOTB, LDS_WS = 2 * NSLOT * SLOTB, LDS_OST = LDS_WS + NW * 64 * 4, LDS_ATT = LDS_OST + NW * 4096;
typedef __attribute__((address_space(3))) const char* lds_cptr;
typedef __attribute__((address_space(3))) const float* lds_fptr;

struct AttnArgs {
    const bf16* Q; const bf16* K; const bf16* V; bf16* O;
    int qs, ks, os;
    int NT, tlo, thi;
    float s2;
    int q0;
    int kb;
    float* stat; int ss;
    lds_fptr tab;
};

__device__ __forceinline__ void glds16(const void* gsrc, unsigned lds_dst) { unsigned keep;
  asm volatile("s_mov_b32 %0, m0\n\ts_mov_b32 m0, %2\n\ts_nop 0\n\tglobal_load_lds_dwordx4 %1, off\n\ts_mov_b32 m0, %0" : "=&s"(keep) : "v"(gsrc), "s"(lds_dst) : "memory"); }
__device__ __forceinline__ float max3f(float a, float b, float c) { float r; asm("v_max3_f32 %0, %1, %2, %3" : "=v"(r) : "v"(a), "v"(b), "v"(c)); return r; }
__device__ __forceinline__ float max2f(float a, float b) { float r; asm("v_max_f32_e32 %0, %1, %2" : "=v"(r) : "v"(a), "v"(b)); return r; }
__device__ __forceinline__ float fadd_s(float a, float b) { float r; asm("v_add_f32_e32 %0, %1, %2" : "=v"(r) : "v"(a), "v"(b)); return r; }
__device__ __forceinline__ float fsub_s(float a, float b) { float r; asm("v_sub_f32_e32 %0, %1, %2" : "=v"(r) : "v"(a), "v"(b)); return r; }
typedef float f32x2_t __attribute__((ext_vector_type(2))); typedef __bf16 bf16x2_t __attribute__((ext_vector_type(2)));
__device__ __forceinline__ unsigned cvtpk_s(float lo, float hi) { f32x2_t v = {lo, hi}; bf16x2_t b = __builtin_convertvector(v, bf16x2_t); return __builtin_bit_cast(unsigned, b); }
#define WAIT_BAR(N) asm volatile("s_waitcnt vmcnt(" #N ") lgkmcnt(0)\n\ts_barrier" ::: "memory")

__device__ __forceinline__ void qkt(f32x16& p0, f32x16& p1, const char* Kslot, const bf16x8* qr, const f32x16& negm, int r32, int hi) {
  const char* kb = Kslot + hi * 1024 + r32 * 16;
  #pragma unroll
  for (int d0 = 0; d0 < 4; ++d0) {
    const bf16x8 b0 = *reinterpret_cast<const bf16x8*>(kb + d0 * 2048);
    const bf16x8 b1 = *reinterpret_cast<const bf16x8*>(kb + d0 * 2048 + 512);
    if (d0 == 0) { p0 = __builtin_amdgcn_mfma_f32_32x32x16_bf16(b0, qr[0], negm, 0, 0, 0); p1 = __builtin_amdgcn_mfma_f32_32x32x16_bf16(b1, qr[0], negm, 0, 0, 0); }
    else { p0 = __builtin_amdgcn_mfma_f32_32x32x16_bf16(b0, qr[d0], p0, 0, 0, 0); p1 = __builtin_amdgcn_mfma_f32_32x32x16_bf16(b1, qr[d0], p1, 0, 0, 0); } }
}
typedef short v4i16_t __attribute__((ext_vector_type(4)));
__device__ __forceinline__ void kload8(bf16x8* kf, lds_cptr kp) {
  kf[0] = *(const LAS bf16x8*)(kp);        kf[1] = *(const LAS bf16x8*)(kp + 512);
  kf[2] = *(const LAS bf16x8*)(kp + 2048); kf[3] = *(const LAS bf16x8*)(kp + 2560);
  kf[4] = *(const LAS bf16x8*)(kp + 4096); kf[5] = *(const LAS bf16x8*)(kp + 4608);
  kf[6] = *(const LAS bf16x8*)(kp + 6144); kf[7] = *(const LAS bf16x8*)(kp + 6656);
}
__device__ __forceinline__ void kload2(bf16x8* kf, lds_cptr kp, int j) { kf[2 * j] = *(const LAS bf16x8*)(kp + j * 2048); kf[2 * j + 1] = *(const LAS bf16x8*)(kp + j * 2048 + 512); }
__device__ __forceinline__ s16x4 vtr(lds_cptr p) { return __builtin_bit_cast(s16x4, __builtin_amdgcn_ds_read_tr16_b64_v4i16((LAS v4i16_t*)p)); }
__device__ __forceinline__ float rowmax(const f32x16& p0, const f32x16& p1) {
  float a = max3f(p0[0], p0[1], p1[0]), b = max3f(p0[2], p0[3], p1[1]); a = max3f(a, p1[2], p1[3]);
  #pragma unroll
  for (int r = 4; r < 16; r += 4) { a = max3f(a, p0[r], p0[r + 1]); b = max3f(b, p0[r + 2], p0[r + 3]); a = max3f(a, p1[r], p1[r + 1]); b = max3f(b, p1[r + 2], p1[r + 3]); }
  const float m = max2f(a, b);
  auto rr = __builtin_amdgcn_permlane32_swap(__float_as_uint(m), __float_as_uint(m), false, false);
  return max2f(__uint_as_float(rr[0]), __uint_as_float(rr[1]));
}
__device__ __forceinline__ void pv(f32x16* o, int vb, bf16x8 pa0, bf16x8 pa1, bf16x8 pa2, bf16x8 pa3) {
  #pragma unroll
  for (int d0 = 0; d0 < 2; ++d0) { s16x4 lo[4], hi[4];
    #pragma unroll
    for (int ks = 0; ks < 4; ++ks) {
      asm volatile("ds_read_b64_tr_b16 %0,%1 offset:%c2" : "=&v"(lo[ks]) : "v"(vb), "i"(d0 * 4096 + ks * 1024) : "memory");
      asm volatile("ds_read_b64_tr_b16 %0,%1 offset:%c2" : "=&v"(hi[ks]) : "v"(vb), "i"(d0 * 4096 + ks * 1024 + 512) : "memory"); }
    asm volatile("s_waitcnt lgkmcnt(0)" ::: "memory"); SBAR();
    #define PK(k) (bf16x8){lo[k][0], lo[k][1], lo[k][2], lo[k][3], hi[k][0], hi[k][1], hi[k][2], hi[k][3]}
    o[d0] = __builtin_amdgcn_mfma_f32_32x32x16_bf16(pa0, PK(0), o[d0], 0, 0, 0);
    o[d0] = __builtin_amdgcn_mfma_f32_32x32x16_bf16(pa1, PK(1), o[d0], 0, 0, 0);
    o[d0] = __builtin_amdgcn_mfma_f32_32x32x16_bf16(pa2, PK(2), o[d0], 0, 0, 0);
    o[d0] = __builtin_amdgcn_mfma_f32_32x32x16_bf16(pa3, PK(3), o[d0], 0, 0, 0);
    #undef PK
  }
}

template <int MODE> __device__ __forceinline__ void score_hook(f32x16& c0, f32x16& c1, int t, const AttnArgs& a, int qrel, int hi, int wid, int r32, float mh) {
  if constexpr (MODE == MA) {
    const int wlo = a.q0 + wid * QBLK, sd = (64 * t + 63 < wlo) ? 1 : ((64 * t > wlo + 31) ? -1 : 0);
    if (sd != 0) { const float sv = (float)sd * a.s2;
      #pragma unroll
      for (int r = 0; r < 16; ++r) { const float kf = (float)((r & 3) + 8 * (r >> 2)); c0[r] = fmaf(kf, sv, c0[r]); c1[r] = fmaf(kf + 32.f, sv, c1[r]); if ((r & 3) == 3) __builtin_amdgcn_sched_barrier(0); }
    } else {
      const float dq = (float)(a.q0 + qrel - 64 * t - 4 * hi), ns = -a.s2;
      #pragma unroll
      for (int r = 0; r < 16; ++r) { const float kf = (float)((r & 3) + 8 * (r >> 2)); c0[r] = fmaf(ns, fabsf(dq - kf), c0[r]); c1[r] = fmaf(ns, fabsf(dq - (kf + 32.f)), c1[r]); if ((r & 1) == 1) __builtin_amdgcn_sched_barrier(0); }
    }
  }
  if constexpr (MODE == MB) {
    const bool tv = (t >= a.tlo) && (t <= a.thi);
    const float dq = (float)(qrel + 64 - 64 * t - 4 * hi), ns = -a.s2;
    #pragma unroll
    for (int r = 0; r < 16; ++r) { const float kf = (float)((r & 3) + 8 * (r >> 2)); const float d0 = fabsf(dq - kf), d1 = fabsf(dq - (kf + 32.f));
      c0[r] = (tv && d0 <= 64.f) ? fmaf(ns, d0, c0[r] - mh) : -INFINITY; c1[r] = (tv && d1 <= 64.f) ? fmaf(ns, d1, c1[r] - mh) : -INFINITY;
      if ((r & 3) == 3) __builtin_amdgcn_sched_barrier(0); }
  }
  if constexpr (MODE == MC) {
    const int qrow = a.q0 + (wid >> 1), rs = min(max(qrow - 4, 0), 120), krow = a.kb + t;
    if (krow < rs || krow >= rs + 8) {
      #pragma unroll
      for (int r = 0; r < 16; ++r) { c0[r] = -INFINITY; c1[r] = -INFINITY; }
    } else {
      const int qc = (wid & 1) * 32 + r32, cs = min(max(qc - 8, 0), 48);
      const lds_fptr tp = a.tab + (krow - qrow + 7) * 31 + (15 - qc + 4 * hi);
      const int kd = 4 * hi - cs;
      #pragma unroll
      for (int r = 0; r < 16; ++r) { const int kc = (r & 3) + 8 * (r >> 2);
        const float b0 = tp[kc], b1 = tp[kc + 32];
        c0[r] = ((unsigned)(kd + kc) < 16u) ? c0[r] + (b0 - mh) : -INFINITY; c1[r] = ((unsigned)(kd + kc + 32) < 16u) ? c1[r] + (b1 - mh) : -INFINITY;
        if ((r & 3) == 3) __builtin_amdgcn_sched_barrier(0); }
    }
  }
}

template <int MODE, int THRL> __device__ __forceinline__ void attn_unit(const AttnArgs& A_, char* shm) {
  int tid_ = threadIdx.x; asm volatile("" : "+v"(tid_));
  const int tid = tid_, lane = tid & 63, r32 = lane & 31, hi = lane >> 5; const int wid = __builtin_amdgcn_readfirstlane(tid >> 6);
  const bf16* Qw = A_.Q + (wid * QBLK) * A_.qs;
  const unsigned lds0 = (unsigned)(uintptr_t)shm;
  float* wsf = (float*)(shm + LDS_WS) + wid * 64;
  const int ks = A_.ks;
  const bf16* ksrc = A_.K + (lane * ks + wid * 8);
  const bf16* vsrc = A_.V + ((16 * (wid & 3) + (lane >> 2)) * ks + (wid >> 2) * 32 + (lane & 3) * 8);
  const unsigned kdst = lds0 + LDS_K + wid * 1024, vdst = lds0 + LDS_V + wid * 1024;
  #define TT(t) ((MODE == MB) ? min(max((int)(t), A_.tlo), A_.thi) : (int)(t))
  #define DMA_K(t, slot) glds16(ksrc + TT(t) * KVBLK * ks, (unsigned)__builtin_amdgcn_readfirstlane(kdst + (slot)))
  #define DMA_V(t, slot) glds16(vsrc + TT(t) * KVBLK * ks, (unsigned)__builtin_amdgcn_readfirstlane(vdst + (slot)))
  const int vb0 = (int)(lds0 + LDS_V) + ((lane >> 4) & 1) * 32 + (lane & 3) * 8 + (4 * hi + ((lane & 15) >> 2)) * 64;
  const char* Kbase = shm + LDS_K; bf16x8 kf[8];
  const lds_cptr shm3 = (lds_cptr)shm; const lds_cptr kp0 = shm3 + LDS_K + hi * 1024 + r32 * 16; const lds_cptr vp0 = shm3 + LDS_V + ((lane >> 4) & 1) * 32 + (lane & 3) * 8 + (4 * hi + ((lane & 15) >> 2)) * 64;
  const int NT = A_.NT;
  DMA_K(0, 0); DMA_V(0, 0); DMA_K(1, SLOTB);
  bf16x8 qr[4];
  #pragma unroll
  for (int d0 = 0; d0 < 4; ++d0) qr[d0] = *reinterpret_cast<const bf16x8*>(&Qw[r32 * A_.qs + d0 * 16 + hi * 8]);
  float mhat = 0.f, l_reg = 0.f; f32x16 o[2]; o[0] = f32x16{}; o[1] = f32x16{}; f32x16 negm = f32x16{}; asm volatile("" : "+v"(negm));
  const int qrel = wid * QBLK + r32;
  constexpr bool NEGM = (MODE == MA || MODE == MD);
  #define CIN (NEGM ? negm : f32x16{})
  #define NEGM_SET(tn) do { float nb_ = -mhat; \
      if (MODE == MA) { const int wlo_ = A_.q0 + wid * QBLK, sd_ = (64 * (tn) + 63 < wlo_) ? 1 : ((64 * (tn) > wlo_ + 31) ? -1 : 0); \
        if (sd_ != 0) nb_ = fmaf(-(float)sd_ * A_.s2, (float)(A_.q0 + qrel - 64 * (tn) - 4 * hi), nb_); } \
      _Pragma("unroll") for (int r = 0; r < 16; ++r) negm[r] = nb_; asm volatile("" : "+v"(negm)); } while (0)
  #define CMASK(P0, P1, t) score_hook<MODE>(P0, P1, (t), A_, qrel, hi, wid, r32, mhat)
  bool resc = false;
  #define START(P0, P1) do { const float rm = rowmax(P0, P1); resc = false; \
    { const float dl = (MODE == MB || MODE == MC) ? fmaxf(rm, -2048.f) : rm; mhat = fadd_s(mhat, dl); \
      _Pragma("unroll") for (int r = 0; r < 16; ++r) { P0[r] = fsub_s(P0[r], dl); P1[r] = fsub_s(P1[r], dl); } \
      if (NEGM) { NEGM_SET(1); } } \
    _Pragma("unroll") for (int r = 0; r < 16; ++r) P0[r] = __builtin_amdgcn_exp2f(P0[r]); } while (0)
  #define RESC() do { if (resc) { asm volatile("s_waitcnt lgkmcnt(0)" ::: "memory"); \
      _Pragma("unroll") for (int d_ = 0; d_ < 2; ++d_) _Pragma("unroll") for (int r = 0; r < 16; ++r) o[d_][r] *= wsf[crow(r, hi)]; } } while (0)
  f32x16 pA0, pA1, pB0, pB1;
  int sl_prev = 0, sl_cur = 0, sl_next = SLOTB;
  #define ROT() do { sl_prev = sl_cur; sl_cur = sl_next; sl_next = (sl_next == (NSLOT - 1) * SLOTB) ? 0 : sl_next + SLOTB; } while (0)
  DMA_K(2, 2 * SLOTB);
  if (MODE == MA) { NEGM_SET(0); }
  WAIT_BAR(3);
  qkt(pA0, pA1, Kbase, qr, negm, r32, hi); asm volatile("s_nop 15\n\ts_nop 7" : "+v"(pA0), "+v"(pA1)); CMASK(pA0, pA1, 0);
  START(pA0, pA1);
  _Pragma("unroll") for (int r = 0; r < 16; ++r) pA1[r] = __builtin_amdgcn_exp2f(pA1[r]);
  WAIT_BAR(0);
  DMA_K(3, 0); DMA_V(1, SLOTB);
  ROT();
  kload8(kf, kp0 + sl_cur);
  WAIT_BAR(2);
  s16x4 vlo[8], vhi[8]; u32x4 pw0, pw1, pw2, pw3;
  #define PKW(P, B) cvtpk_s(P[B], P[B + 1])
  #define PAF(k) __builtin_bit_cast(bf16x8, pw##k)
  #define VFR(i) (bf16x8){vlo[i][0], vlo[i][1], vlo[i][2], vlo[i][3], vhi[i][0], vhi[i][1], vhi[i][2], vhi[i][3]}
  #define PIN(x) asm volatile("" : "+v"(x))
  #define MX3(a, b, c) __builtin_fmaxf(__builtin_fmaxf((a), (b)), (c))
  #define GAPA(MF, A0, A1, A2, A3, W0, W1, PW) do { MF; sacc += A0; sacc += A1; sacc += A2; sacc += A3; PIN(sacc); W0; W1; PIN(PW); SBAR(); } while (0)
  #define EX(v) __builtin_amdgcn_exp2f(v)
  #define GAPB(MF, X, B) do { MF; X[B] = EX(X[B]); X[B + 1] = EX(X[B + 1]); X[B + 2] = EX(X[B + 2]); X[B + 3] = EX(X[B + 3]); PIN(X); SBAR(); } while (0)
  #define VRD(i) do { vlo[i] = vtr(vp_ + (((i) >> 2) * 4096 + ((i) & 3) * 1024)); vhi[i] = vtr(vp_ + (((i) >> 2) * 4096 + ((i) & 3) * 1024 + 512)); } while (0)
  #define KRD(G, j) do { if (G) { kload2(kf, kp0 + sl_next, j); SBAR(); } } while (0)
  #define STEP(C0, C1, P0, P1, t, GK, GV, GL) do { SBAR(); \
    const lds_cptr vp_ = vp0 + sl_prev; \
    VRD(0); SBAR(); float sacc = (P0[0] + P0[1]); \
    GAPA(C0 = __builtin_amdgcn_mfma_f32_32x32x16_bf16(kf[0], qr[0], CIN, 0, 0, 0), P0[2], P0[3], P0[4], P0[5],     pw0[0] = PKW(P0, 0), pw0[1] = PKW(P0, 2), pw0); \
    VRD(4); SBAR(); GAPA(C1 = __builtin_amdgcn_mfma_f32_32x32x16_bf16(kf[1], qr[0], CIN, 0, 0, 0), P0[6], P0[7], P0[8], P0[9],     pw0[2] = PKW(P0, 4), pw0[3] = PKW(P0, 6), pw0); \
    VRD(1); SBAR(); GAPA(C0 = __builtin_amdgcn_mfma_f32_32x32x16_bf16(kf[2], qr[1], C0, 0, 0, 0),   P0[10], P0[11], P0[12], P0[13], pw1[0] = PKW(P0, 8), pw1[1] = PKW(P0, 10), pw1); \
    VRD(5); SBAR(); GAPA(C1 = __builtin_amdgcn_mfma_f32_32x32x16_bf16(kf[3], qr[1], C1, 0, 0, 0),   P0[14], P0[15], P1[0], P1[1],   pw1[2] = PKW(P0, 12), pw1[3] = PKW(P0, 14), pw1); \
    VRD(2); SBAR(); GAPA(C0 = __builtin_amdgcn_mfma_f32_32x32x16_bf16(kf[4], qr[2], C0, 0, 0, 0),   P1[2], P1[3], P1[4], P1[5],     pw2[0] = PKW(P1, 0), pw2[1] = PKW(P1, 2), pw2); \
    VRD(6); SBAR(); GAPA(C1 = __builtin_amdgcn_mfma_f32_32x32x16_bf16(kf[5], qr[2], C1, 0, 0, 0),   P1[6], P1[7], P1[8], P1[9],     pw2[2] = PKW(P1, 4), pw2[3] = PKW(P1, 6), pw2); \
    VRD(3); SBAR(); GAPA(C0 = __builtin_amdgcn_mfma_f32_32x32x16_bf16(kf[6], qr[3], C0, 0, 0, 0),   P1[10], P1[11], P1[12], P1[13], pw3[0] = PKW(P1, 8), pw3[1] = PKW(P1, 10), pw3); \
    VRD(7); SBAR(); GAPA(C1 = __builtin_amdgcn_mfma_f32_32x32x16_bf16(kf[7], qr[3], C1, 0, 0, 0),   P1[14], P1[15], 0.f, 0.f,       pw3[2] = PKW(P1, 12), pw3[3] = PKW(P1, 14), pw3); \
    l_reg += sacc; \
    if (GK) { DMA_K((t) + 3, sl_cur); } if (GV) { DMA_V((t) + 1, sl_next); } \
    CMASK(C0, C1, t); \
    { float a = MX3(C0[0], C0[1], C1[0]), b = MX3(C0[2], C0[3], C1[1]); a = MX3(a, C1[2], C1[3]); \
      _Pragma("unroll") for (int r = 4; r < 16; r += 4) { a = MX3(a, C0[r], C0[r + 1]); b = MX3(b, C0[r + 2], C0[r + 3]); a = MX3(a, C1[r], C1[r + 1]); b = MX3(b, C1[r + 2], C1[r + 3]); } \
      float rm = __builtin_fmaxf(a, b); { auto rr = __builtin_amdgcn_permlane32_swap(__float_as_uint(rm), __float_as_uint(rm), false, false); rm = __builtin_fmaxf(__uint_as_float(rr[0]), __uint_as_float(rr[1])); } \
      resc = false; \
      if (__builtin_expect(__any(rm > (float)THRL), 0)) { const float dl = __builtin_fmaxf(rm, 0.f); mhat += dl; \
        _Pragma("unroll") for (int r = 0; r < 16; ++r) { C0[r] -= dl; C1[r] -= dl; } \
        if (MODE == MD) { NEGM_SET(0); } \
        const float f = __builtin_amdgcn_exp2f(-dl); l_reg *= f; if (hi == 0) wsf[r32] = f; resc = true; } \
      if (MODE == MA) { NEGM_SET((t) + 1); } } \
    SBAR(); \
    GAPB(o[0] = __builtin_amdgcn_mfma_f32_32x32x16_bf16(PAF(0), VFR(0), o[0], 0, 0, 0), C0, 0); \
    GAPB(o[1] = __builtin_amdgcn_mfma_f32_32x32x16_bf16(PAF(0), VFR(4), o[1], 0, 0, 0), C0, 4); \
    KRD(GL, 0); GAPB(o[0] = __builtin_amdgcn_mfma_f32_32x32x16_bf16(PAF(1), VFR(1), o[0], 0, 0, 0), C0, 8); \
    KRD(GL, 1); GAPB(o[1] = __builtin_amdgcn_mfma_f32_32x32x16_bf16(PAF(1), VFR(5), o[1], 0, 0, 0), C0, 12); \
    KRD(GL, 2); GAPB(o[0] = __builtin_amdgcn_mfma_f32_32x32x16_bf16(PAF(2), VFR(2), o[0], 0, 0, 0), C1, 0); \
    KRD(GL, 3); GAPB(o[1] = __builtin_amdgcn_mfma_f32_32x32x16_bf16(PAF(2), VFR(6), o[1], 0, 0, 0), C1, 4); \
    GAPB(o[0] = __builtin_amdgcn_mfma_f32_32x32x16_bf16(PAF(3), VFR(3), o[0], 0, 0, 0), C1, 8); \
    GAPB(o[1] = __builtin_amdgcn_mfma_f32_32x32x16_bf16(PAF(3), VFR(7), o[1], 0, 0, 0), C1, 12); \
    } while (0)
  int t = 1;
  for (; t + 5 < NT; t += 2) {
    STEP(pB0, pB1, pA0, pA1, t, true, true, true);     WAIT_BAR(2); RESC(); ROT();
    STEP(pA0, pA1, pB0, pB1, t + 1, true, true, true); WAIT_BAR(2); RESC(); ROT();
  }
  #define ENDW(tt) do { if ((tt) + 3 < NT) { WAIT_BAR(2); } else if ((tt) + 2 < NT) { WAIT_BAR(1); } else { WAIT_BAR(0); } } while (0)
  for (; t + 1 < NT; t += 2) {
    STEP(pB0, pB1, pA0, pA1, t, (t + 3 < NT), (t + 1 < NT), (t + 1 < NT));         ENDW(t);     RESC(); ROT();
    STEP(pA0, pA1, pB0, pB1, t + 1, (t + 4 < NT), (t + 2 < NT), (t + 2 < NT));     ENDW(t + 1); RESC(); ROT();
  }
  STEP(pB0, pB1, pA0, pA1, NT - 1, false, false, false); RESC();
  { float sacc = pB0[0] + pB0[1]; _Pragma("unroll") for (int r = 2; r < 16; ++r) sacc += pB0[r]; _Pragma("unroll") for (int r = 0; r < 16; ++r) sacc += pB1[r]; l_reg += sacc;
    pw0 = (u32x4){PKW(pB0, 0), PKW(pB0, 2), PKW(pB0, 4), PKW(pB0, 6)}; pw1 = (u32x4){PKW(pB0, 8), PKW(pB0, 10), PKW(pB0, 12), PKW(pB0, 14)}; pw2 = (u32x4){PKW(pB1, 0), PKW(pB1, 2), PKW(pB1, 4), PKW(pB1, 6)}; pw3 = (u32x4){PKW(pB1, 8), PKW(pB1, 10), PKW(pB1, 12), PKW(pB1, 14)};
    SBAR(); pv(o, vb0 + sl_cur, PAF(0), PAF(1), PAF(2), PAF(3)); }
  #undef PKW
  #undef PAF
  #undef VFR
  #undef PIN
  #undef MX3
  #undef GAPA
  #undef GAPB
  #undef EX
  #undef VRD
  #undef KRD
  #undef STEP
  #undef ENDW
  { auto rr = __builtin_amdgcn_permlane32_swap(__float_as_uint(l_reg), __float_as_uint(l_reg), false, false); l_reg = __uint_as_float(rr[0]) + __uint_as_float(rr[1]); }
  if (MODE == MB) { if (hi == 0) { float* sp = A_.stat + (wid * QBLK + r32) * A_.ss; sp[0] = mhat; sp[1] = l_reg; } }
  if (hi == 0) wsf[32 + r32] = l_reg; asm volatile("s_waitcnt lgkmcnt(0)" ::: "memory");
  float rli[16];
  #pragma unroll
  for (int r = 0; r < 16; ++r) rli[r] = __builtin_amdgcn_rcpf(wsf[32 + crow(r, hi)]);
  bf16* Ow = A_.O + (wid * QBLK) * A_.os;
  { bf16* stg = (bf16*)(shm + LDS_OST) + wid * 2048;
    #pragma unroll
    for (int r = 0; r < 16; ++r) { const int orow = crow(r, hi);
      #pragma unroll
      for (int d0 = 0; d0 < 2; ++d0) stg[orow * 64 + d0 * 32 + r32] = __float2bfloat16(o[d0][r] * rli[r]); }
    asm volatile("s_waitcnt lgkmcnt(0)" ::: "memory");
    #pragma unroll
    for (int i = 0; i < 4; ++i) { const int row = i * 8 + (lane >> 3), ch = lane & 7; const u32x4 v = *(const u32x4*)(stg + row * 64 + ch * 8); *(u32x4*)(Ow + row * A_.os + ch * 8) = v; } }
  asm volatile("s_waitcnt lgkmcnt(0)\n\ts_barrier" ::: "memory");
  #undef DMA_K
  #undef DMA_V
  #undef TT
  #undef CMASK
  #undef CIN
  #undef NEGM_SET
  #undef START
  #undef RESC
  #undef ROT
}

constexpr int L8_K = 0, L8_V = 3 * 8192, L8_WS = L8_V + 3 * 16384, L8_QO = L8_WS + 2048, L8_END = L8_QO + 8 * 4096;
template <int THRL> __device__ __forceinline__ void attn_unit128(const AttnArgs& A_, char* shm) {
  int tid_ = threadIdx.x; asm volatile("" : "+v"(tid_));
  const int tid = tid_, lane = tid & 63, r32 = lane & 31, hi = lane >> 5; const int wid = __builtin_amdgcn_readfirstlane(tid >> 6);
  const bf16* Qw = A_.Q + (wid * QBLK) * A_.qs;
  const unsigned lds0 = (unsigned)(uintptr_t)shm;
  float* wsf = (float*)(shm + L8_WS) + wid * 64;
  const int ks = A_.ks;
  const bf16* ksrc = A_.K + (lane * ks + wid * 8);
  const bf16* vsrc = A_.V + ((16 * (wid & 3) + (lane >> 2)) * ks + (wid >> 2) * 32 + (lane & 3) * 8);
  const unsigned kdst = lds0 + L8_K + wid * 1024, vdst = lds0 + L8_V + wid * 1024;
  #define DMA_K(t, slot) glds16(ksrc + (int)(t) * KVBLK * ks, (unsigned)__builtin_amdgcn_readfirstlane(kdst + (slot)))
  #define DMA_V(t, slot) do { glds16(vsrc + (int)(t) * KVBLK * ks, (unsigned)__builtin_amdgcn_readfirstlane(vdst + 2 * (slot))); \
                              glds16(vsrc + (int)(t) * KVBLK * ks + 64, (unsigned)__builtin_amdgcn_readfirstlane(vdst + 2 * (slot) + 8192)); } while (0)
  const int vb0 = (int)(lds0 + L8_V) + ((lane >> 4) & 1) * 32 + (lane & 3) * 8 + (4 * hi + ((lane & 15) >> 2)) * 64;
  const char* Kbase = shm + L8_K; bf16x8 kf[8];
  const lds_cptr shm3 = (lds_cptr)shm; const lds_cptr kp0 = shm3 + L8_K + hi * 1024 + r32 * 16; const lds_cptr vp0 = shm3 + L8_V + ((lane >> 4) & 1) * 32 + (lane & 3) * 8 + (4 * hi + ((lane & 15) >> 2)) * 64;
  const lds_cptr qst = shm3 + L8_QO + wid * 4096 + lane * 16;
  const int NT = A_.NT;
  DMA_K(0, 0); DMA_V(0, 0); DMA_K(1, SLOTB);
  { bf16x8 qr[4];
    #pragma unroll
    for (int d0 = 0; d0 < 4; ++d0) qr[d0] = *reinterpret_cast<const bf16x8*>(&Qw[r32 * A_.qs + d0 * 16 + hi * 8]);
    #pragma unroll
    for (int d0 = 0; d0 < 4; ++d0) *(LAS bf16x8*)(shm3 + L8_QO + wid * 4096 + lane * 16 + d0 * 1024) = qr[d0]; }
  #define QLD(d0) (*(const LAS bf16x8*)(qst + (d0) * 1024))
  float mhat = 0.f, l_reg = 0.f; f32x16 o[4]; o[0] = f32x16{}; o[1] = f32x16{}; o[2] = f32x16{}; o[3] = f32x16{};
  const int qrel = wid * QBLK + r32;
  #define NB(tn) ({ float nb_ = -mhat; const int wlo_ = A_.q0 + wid * QBLK, sd_ = (64 * (tn) + 63 < wlo_) ? 1 : ((64 * (tn) > wlo_ + 31) ? -1 : 0); \
      if (sd_ != 0) nb_ = fmaf(-(float)sd_ * A_.s2, (float)(A_.q0 + qrel - 64 * (tn) - 4 * hi), nb_); nb_; })
  #define CMASK(P0, P1, t) score_hook<MA>(P0, P1, (t), A_, qrel, hi, wid, r32, mhat)
  bool resc = false;
  #define RESC() do { if (resc) { asm volatile("s_waitcnt lgkmcnt(0)" ::: "memory"); \
      _Pragma("unroll") for (int d_ = 0; d_ < 4; ++d_) _Pragma("unroll") for (int r = 0; r < 16; ++r) o[d_][r] *= wsf[crow(r, hi)]; } } while (0)
  f32x16 pA0, pA1, pB0, pB1;
  int sl_prev = 0, sl_cur = 0, sl_next = SLOTB;
  #define ROT() do { sl_prev = sl_cur; sl_cur = sl_next; sl_next = (sl_next == (NSLOT - 1) * SLOTB) ? 0 : sl_next + SLOTB; } while (0)
  DMA_K(2, 2 * SLOTB);
  WAIT_BAR(4);
  { f32x16 cin; const float nb0 = NB(0);
    #pragma unroll
    for (int r = 0; r < 16; ++r) cin[r] = nb0;
    bf16x8 qr[4];
    #pragma unroll
    for (int d0 = 0; d0 < 4; ++d0) qr[d0] = QLD(d0);
    qkt(pA0, pA1, Kbase, qr, cin, r32, hi); }
  asm volatile("s_nop 15\n\ts_nop 7" : "+v"(pA0), "+v"(pA1)); CMASK(pA0, pA1, 0);
  { const float rm = rowmax(pA0, pA1); mhat = fadd_s(mhat, rm);
    #pragma unroll
    for (int r = 0; r < 16; ++r) { pA0[r] = fsub_s(pA0[r], rm); pA1[r] = fsub_s(pA1[r], rm); }
    #pragma unroll
    for (int r = 0; r < 16; ++r) pA0[r] = __builtin_amdgcn_exp2f(pA0[r]);
    #pragma unroll
    for (int r = 0; r < 16; ++r) pA1[r] = __builtin_amdgcn_exp2f(pA1[r]); }
  WAIT_BAR(0);
  DMA_K(3, 0); DMA_V(1, SLOTB);
  ROT();
  kload8(kf, kp0 + sl_cur);
  WAIT_BAR(3);
  u32x4 pw0, pw1, pw2, pw3;
  #define PKW(P, B) cvtpk_s(P[B], P[B + 1])
  #define PAF(k) __builtin_bit_cast(bf16x8, pw##k)
  #define VFR(i) (bf16x8){vlo[i][0], vlo[i][1], vlo[i][2], vlo[i][3], vhi[i][0], vhi[i][1], vhi[i][2], vhi[i][3]}
  #define WFR(i) (bf16x8){wlo[i][0], wlo[i][1], wlo[i][2], wlo[i][3], whi[i][0], whi[i][1], whi[i][2], whi[i][3]}
  #define PIN(x) asm volatile("" : "+v"(x))
  #define MX3(a, b, c) __builtin_fmaxf(__builtin_fmaxf((a), (b)), (c))
  #define GAPA(MF, A0, A1, A2, A3, W0, W1, PW) do { MF; sacc += A0; sacc += A1; sacc += A2; sacc += A3; PIN(sacc); W0; W1; PIN(PW); SBAR(); } while (0)
  #define EX(v) __builtin_amdgcn_exp2f(v)
  #define GAPB(MF, X, B) do { MF; X[B] = EX(X[B]); X[B + 1] = EX(X[B + 1]); PIN(X); SBAR(); } while (0)
  #define VRD(i) do { vlo[i] = vtr(vp_ + (((i) >> 2) * 4096 + ((i) & 3) * 1024)); vhi[i] = vtr(vp_ + (((i) >> 2) * 4096 + ((i) & 3) * 1024 + 512)); } while (0)
  #define VRD2(i) do { wlo[i] = vtr(vp_ + (8192 + ((i) >> 2) * 4096 + ((i) & 3) * 1024)); whi[i] = vtr(vp_ + (8192 + ((i) >> 2) * 4096 + ((i) & 3) * 1024 + 512)); SBAR(); } while (0)
  #define KRD(G, j) do { if (G) { kload2(kf, kp0 + sl_next, j); SBAR(); } } while (0)
  #define FOFF(j) (((((j) & 1) + 2 * ((j) >> 3)) * 4096) + ((((j) >> 1) & 3) * 1024))
  #define FRD(j) do { fl[j] = vtr(vp_ + FOFF(j)); fh[j] = vtr(vp_ + FOFF(j) + 512); SBAR(); } while (0)
  #define FFR(j) (bf16x8){fl[j][0], fl[j][1], fl[j][2], fl[j][3], fh[j][0], fh[j][1], fh[j][2], fh[j][3]}
  #define STEP(C0, C1, P0, P1, t, GK, GV, GL) do { SBAR(); \
    const lds_cptr vp_ = vp0 + 2 * sl_prev; s16x4 fl[16], fh[16]; \
    { const float nb_t = NB(t); _Pragma("unroll") for (int r = 0; r < 16; ++r) { C0[r] = nb_t; C1[r] = nb_t; } } \
    bf16x8 q0_ = QLD(0), q1_ = QLD(1); SBAR(); float sacc = (P0[0] + P0[1]); \
    GAPA(C0 = __builtin_amdgcn_mfma_f32_32x32x16_bf16(kf[0], q0_, C0, 0, 0, 0), P0[2], P0[3], P0[4], P0[5],     pw0[0] = PKW(P0, 0), pw0[1] = PKW(P0, 2), pw0); \
    GAPA(C1 = __builtin_amdgcn_mfma_f32_32x32x16_bf16(kf[1], q0_, C1, 0, 0, 0), P0[6], P0[7], P0[8], P0[9],     pw0[2] = PKW(P0, 4), pw0[3] = PKW(P0, 6), pw0); \
    q0_ = QLD(2); SBAR(); \
    GAPA(C0 = __builtin_amdgcn_mfma_f32_32x32x16_bf16(kf[2], q1_, C0, 0, 0, 0),   P0[10], P0[11], P0[12], P0[13], pw1[0] = PKW(P0, 8), pw1[1] = PKW(P0, 10), pw1); \
    GAPA(C1 = __builtin_amdgcn_mfma_f32_32x32x16_bf16(kf[3], q1_, C1, 0, 0, 0),   P0[14], P0[15], P1[0], P1[1],   pw1[2] = PKW(P0, 12), pw1[3] = PKW(P0, 14), pw1); \
    q1_ = QLD(3); SBAR(); \
    GAPA(C0 = __builtin_amdgcn_mfma_f32_32x32x16_bf16(kf[4], q0_, C0, 0, 0, 0),   P1[2], P1[3], P1[4], P1[5],     pw2[0] = PKW(P1, 0), pw2[1] = PKW(P1, 2), pw2); \
    GAPA(C1 = __builtin_amdgcn_mfma_f32_32x32x16_bf16(kf[5], q0_, C1, 0, 0, 0),   P1[6], P1[7], P1[8], P1[9],     pw2[2] = PKW(P1, 4), pw2[3] = PKW(P1, 6), pw2); \
    GAPA(C0 = __builtin_amdgcn_mfma_f32_32x32x16_bf16(kf[6], q1_, C0, 0, 0, 0),   P1[10], P1[11], P1[12], P1[13], pw3[0] = PKW(P1, 8), pw3[1] = PKW(P1, 10), pw3); \
    GAPA(C1 = __builtin_amdgcn_mfma_f32_32x32x16_bf16(kf[7], q1_, C1, 0, 0, 0),   P1[14], P1[15], 0.f, 0.f,       pw3[2] = PKW(P1, 12), pw3[3] = PKW(P1, 14), pw3); \
    l_reg += sacc; \
    if (GK) { DMA_K((t) + 3, sl_cur); } if (GV) { DMA_V((t) + 1, sl_next); } \
    FRD(0); FRD(1); FRD(2); \
    CMASK(C0, C1, t); \
    { float a = MX3(C0[0], C0[1], C1[0]), b = MX3(C0[2], C0[3], C1[1]); a = MX3(a, C1[2], C1[3]); \
      _Pragma("unroll") for (int r = 4; r < 16; r += 4) { a = MX3(a, C0[r], C0[r + 1]); b = MX3(b, C0[r + 2], C0[r + 3]); a = MX3(a, C1[r], C1[r + 1]); b = MX3(b, C1[r + 2], C1[r + 3]); } \
      float rm = __builtin_fmaxf(a, b); { auto rr = __builtin_amdgcn_permlane32_swap(__float_as_uint(rm), __float_as_uint(rm), false, false); rm = __builtin_fmaxf(__uint_as_float(rr[0]), __uint_as_float(rr[1])); } \
      resc = false; \
      if (__builtin_expect(__any(rm > (float)THRL), 0)) { const float dl = __builtin_fmaxf(rm, 0.f); mhat += dl; \
        _Pragma("unroll") for (int r = 0; r < 16; ++r) { C0[r] -= dl; C1[r] -= dl; } \
        const float f = __builtin_amdgcn_exp2f(-dl); l_reg *= f; if (hi == 0) wsf[r32] = f; resc = true; } } \
    SBAR(); \
    GAPB(o[0] = __builtin_amdgcn_mfma_f32_32x32x16_bf16(PAF(0), FFR(0), o[0], 0, 0, 0), C0, 0);   FRD(3); \
    GAPB(o[1] = __builtin_amdgcn_mfma_f32_32x32x16_bf16(PAF(0), FFR(1), o[1], 0, 0, 0), C0, 2);   FRD(4); \
    GAPB(o[0] = __builtin_amdgcn_mfma_f32_32x32x16_bf16(PAF(1), FFR(2), o[0], 0, 0, 0), C0, 4);   FRD(5); \
    GAPB(o[1] = __builtin_amdgcn_mfma_f32_32x32x16_bf16(PAF(1), FFR(3), o[1], 0, 0, 0), C0, 6);   FRD(6); \
    GAPB(o[0] = __builtin_amdgcn_mfma_f32_32x32x16_bf16(PAF(2), FFR(4), o[0], 0, 0, 0), C0, 8);   FRD(7); \
    GAPB(o[1] = __builtin_amdgcn_mfma_f32_32x32x16_bf16(PAF(2), FFR(5), o[1], 0, 0, 0), C0, 10);  FRD(8); \
    GAPB(o[0] = __builtin_amdgcn_mfma_f32_32x32x16_bf16(PAF(3), FFR(6), o[0], 0, 0, 0), C0, 12);  FRD(9); \
    GAPB(o[1] = __builtin_amdgcn_mfma_f32_32x32x16_bf16(PAF(3), FFR(7), o[1], 0, 0, 0), C0, 14);  FRD(10); \
    KRD(GL, 0); GAPB(o[2] = __builtin_amdgcn_mfma_f32_32x32x16_bf16(PAF(0), FFR(8), o[2], 0, 0, 0), C1, 0);   FRD(11); \
    KRD(GL, 1); GAPB(o[3] = __builtin_amdgcn_mfma_f32_32x32x16_bf16(PAF(0), FFR(9), o[3], 0, 0, 0), C1, 2);   FRD(12); \
    KRD(GL, 2); GAPB(o[2] = __builtin_amdgcn_mfma_f32_32x32x16_bf16(PAF(1), FFR(10), o[2], 0, 0, 0), C1, 4);  FRD(13); \
    KRD(GL, 3); GAPB(o[3] = __builtin_amdgcn_mfma_f32_32x32x16_bf16(PAF(1), FFR(11), o[3], 0, 0, 0), C1, 6);  FRD(14); \
    GAPB(o[2] = __builtin_amdgcn_mfma_f32_32x32x16_bf16(PAF(2), FFR(12), o[2], 0, 0, 0), C1, 8);  FRD(15); \
    GAPB(o[3] = __builtin_amdgcn_mfma_f32_32x32x16_bf16(PAF(2), FFR(13), o[3], 0, 0, 0), C1, 10); \
    GAPB(o[2] = __builtin_amdgcn_mfma_f32_32x32x16_bf16(PAF(3), FFR(14), o[2], 0, 0, 0), C1, 12); \
    GAPB(o[3] = __builtin_amdgcn_mfma_f32_32x32x16_bf16(PAF(3), FFR(15), o[3], 0, 0, 0), C1, 14); \
    } while (0)
  int t = 1;
  for (; t + 5 < NT; t += 2) {
    STEP(pB0, pB1, pA0, pA1, t, true, true, true);     WAIT_BAR(3); RESC(); ROT();
    STEP(pA0, pA1, pB0, pB1, t + 1, true, true, true); WAIT_BAR(3); RESC(); ROT();
  }
  #define ENDW(tt) do { if ((tt) + 3 < NT) { WAIT_BAR(3); } else if ((tt) + 2 < NT) { WAIT_BAR(2); } else { WAIT_BAR(0); } } while (0)
  for (; t + 1 < NT; t += 2) {
    STEP(pB0, pB1, pA0, pA1, t, (t + 3 < NT), (t + 1 < NT), (t + 1 < NT));         ENDW(t);     RESC(); ROT();
    STEP(pA0, pA1, pB0, pB1, t + 1, (t + 4 < NT), (t + 2 < NT), (t + 2 < NT));     ENDW(t + 1); RESC(); ROT();
  }
  STEP(pB0, pB1, pA0, pA1, NT - 1, false, false, false); RESC();
  { float sacc = pB0[0] + pB0[1]; _Pragma("unroll") for (int r = 2; r < 16; ++r) sacc += pB0[r]; _Pragma("unroll") for (int r = 0; r < 16; ++r) sacc += pB1[r]; l_reg += sacc;
    pw0 = (u32x4){PKW(pB0, 0), PKW(pB0, 2), PKW(pB0, 4), PKW(pB0, 6)}; pw1 = (u32x4){PKW(pB0, 8), PKW(pB0, 10), PKW(pB0, 12), PKW(pB0, 14)}; pw2 = (u32x4){PKW(pB1, 0), PKW(pB1, 2), PKW(pB1, 4), PKW(pB1, 6)}; pw3 = (u32x4){PKW(pB1, 8), PKW(pB1, 10), PKW(pB1, 12), PKW(pB1, 14)};
    SBAR(); pv(o, vb0 + 2 * sl_cur, PAF(0), PAF(1), PAF(2), PAF(3)); pv(o + 2, vb0 + 2 * sl_cur + 8192, PAF(0), PAF(1), PAF(2), PAF(3)); }
  #undef PKW
  #undef PAF
  #undef VFR
  #undef WFR
  #undef PIN
  #undef MX3
  #undef GAPA
  #undef GAPB
  #undef EX
  #undef VRD
  #undef FOFF
  #undef FRD
  #undef FFR
  #undef KRD
  #undef STEP
  #undef ENDW
  { auto rr = __builtin_amdgcn_permlane32_swap(__float_as_uint(l_reg), __float_as_uint(l_reg), false, false); l_reg = __uint_as_float(rr[0]) + __uint_as_float(rr[1]); }
  if (hi == 0) wsf[32 + r32] = l_reg; asm volatile("s_waitcnt lgkmcnt(0)" ::: "memory");
  float rli[16];
  #pragma unroll
  for (int r = 0; r < 16; ++r) rli[r] = __builtin_amdgcn_rcpf(wsf[32 + crow(r, hi)]);
  bf16* Ow = A_.O + (wid * QBLK) * A_.os;
  { bf16* stg = (bf16*)(shm + L8_QO) + wid * 2048;
    #pragma unroll
    for (int hv = 0; hv < 2; ++hv) {
      #pragma unroll
      for (int r = 0; r < 16; ++r) { const int orow = crow(r, hi);
        #pragma unroll
        for (int d0 = 0; d0 < 2; ++d0) stg[orow * 64 + d0 * 32 + r32] = __float2bfloat16(o[2 * hv + d0][r] * rli[r]); }
      asm volatile("s_waitcnt lgkmcnt(0)" ::: "memory");
      #pragma unroll
      for (int i = 0; i < 4; ++i) { const int row = i * 8 + (lane >> 3), ch = lane & 7; const u32x4 v = *(const u32x4*)(stg + row * 64 + ch * 8); *(u32x4*)(Ow + row * A_.os + hv * 64 + ch * 8) = v; }
      asm volatile("s_waitcnt lgkmcnt(0)" ::: "memory"); } }
  asm volatile("s_waitcnt lgkmcnt(0)\n\ts_barrier" ::: "memory");
  #undef DMA_K
  #undef DMA_V
  #undef QLD
  #undef NB
  #undef CMASK
  #undef RESC
  #undef ROT
}
#undef SBAR
#undef WAIT_BAR
}

__device__ __forceinline__ void transpose_item(const float* W, int K, int N, bf16_t* WT, LAS float* scr, int item, int lane, const float* gk = nullptr) {
    const int nblk = N / 32, kb = item / nblk, nb = item % nblk, k0 = 64 * kb, n0 = 32 * nb;
#pragma unroll 8
    for (int i = 0; i < 32; ++i) { const int kk = 2 * i + (lane >> 5); const float gg = gk ? gk[k0 + kk] : 1.f; scr[kk * 33 + (lane & 31)] = W[(size_t)(k0 + kk) * N + n0 + (lane & 31)] * gg; }
    asm volatile("s_waitcnt lgkmcnt(0)" ::: "memory");
    const int c = lane & 7;
#pragma unroll
    for (int j = 0; j < 4; ++j) { const int n = (lane >> 3) + 8 * j; const LAS float* s = scr + (8 * c) * 33 + n;
        u32x4 o; o.x = pk2(s[0 * 33], s[1 * 33]); o.y = pk2(s[2 * 33], s[3 * 33]); o.z = pk2(s[4 * 33], s[5 * 33]); o.w = pk2(s[6 * 33], s[7 * 33]);
        *(u32x4*)(WT + (size_t)(n0 + n) * K + k0 + 8 * c) = o; }
    asm volatile("s_waitcnt lgkmcnt(0)" ::: "memory");
}
__device__ __forceinline__ void rms_row_bf16(const float* xrow, const float* g, bf16_t* orow, int lane) {
    const f32x4* xr = (const f32x4*)xrow + lane; const f32x4* gr = (const f32x4*)g + lane;
    f32x4 v[4]; float s = 0.f;
#pragma unroll
    for (int j = 0; j < 4; ++j) { v[j] = xr[64 * j]; s += (v[j].x * v[j].x + v[j].y * v[j].y) + (v[j].z * v[j].z + v[j].w * v[j].w); }
    const float rs = rsqrtf(wave_sum(s) * (1.f / DM) + EPS);
    u32x2* o8 = (u32x2*)orow + lane;
#pragma unroll
    for (int j = 0; j < 4; ++j) { const f32x4 gg = gr[64 * j]; u32x2 w; w.x = pk2(v[j].x * rs * gg.x, v[j].y * rs * gg.y); w.y = pk2(v[j].z * rs * gg.z, v[j].w * rs * gg.w); o8[64 * j] = w; }
}
__device__ __forceinline__ void sincos_red(float a, float& s, float& c) {
    const float q = rintf(a * 0.636619772367581f); const int iq = (int)q;
    float r = fmaf(q, -1.5703125f, a); r = fmaf(q, -4.837512969970703125e-4f, r); r = fmaf(q, -7.54978995489188216e-8f, r);
    const float r2 = r * r;
    const float sp = r + r * r2 * (-1.6666654611e-1f + r2 * (8.3321608736e-3f + r2 * (-1.9515295891e-4f)));
    const float cp = 1.0f - 0.5f * r2 + r2 * r2 * (4.166664568298827e-2f + r2 * (-1.388731625493765e-3f + r2 * 2.443315711809948e-5f));
    const int k = iq & 3;
    s = (k == 0) ? sp : (k == 1) ? cp : (k == 2) ? -sp : -cp;
    c = (k == 0) ? cp : (k == 1) ? -sp : (k == 2) ? -cp : sp;
}

#define XB_TMO      128
#define XB_XCNT(j)  (256  + 64 * (j))
#define XB_XSUB(j)  (1280 + 64 * (j))
#define XB_XGEN(j)  (2304 + 64 * (j))
#define XB_TOP      3328
#define XB_TOPGEN   3392
#define XCD_BAR_WORDS 3456
#define XB_SPIN_CAP (1u << 18)

__device__ __forceinline__ unsigned xb_ld(unsigned* p)              { return __hip_atomic_load(p, __ATOMIC_RELAXED, __HIP_MEMORY_SCOPE_AGENT); }
__device__ __forceinline__ unsigned xb_add(unsigned* p, unsigned v) { return __hip_atomic_fetch_add(p, v, __ATOMIC_RELAXED, __HIP_MEMORY_SCOPE_AGENT); }
__device__ __forceinline__ unsigned xb_xcc_id() { return (unsigned)__builtin_amdgcn_s_getreg((3 << 11) | 20) & 0xFu; }
#define XB_SPIN(cond, bar) do { unsigned _sp = 0; while (cond) { __builtin_amdgcn_s_sleep(1); \
    if ((++_sp & 255u) == 0u) { if (xb_ld(&(bar)[XB_TMO])) break; if (_sp > XB_SPIN_CAP) { atomicAdd(&(bar)[XB_TMO], 1u); break; } } } } while (0)

struct XcdBarrier {
    unsigned* bar; unsigned x;
    volatile LAS unsigned* st;
};

__device__ __forceinline__ XcdBarrier xcd_barrier_post(unsigned* bar, volatile LAS unsigned* st) {
    XcdBarrier b; b.bar = bar; b.x = xb_xcc_id(); b.st = st;
    if (threadIdx.x == 0) (void)xb_add(&bar[XB_XCNT(b.x)], 1u);
    return b;
}
__device__ __forceinline__ void xcd_barrier_complete(unsigned* bar, unsigned x, unsigned& nloc, unsigned& nx) {
    const unsigned G = gridDim.x * gridDim.y * gridDim.z;
    unsigned sum, cnt, mine, sp = 0u;
    for (;;) {
        sum = 0u; cnt = 0u; mine = 0u;
#pragma unroll
        for (unsigned j = 0; j < 16; ++j) { const unsigned c = xb_ld(&bar[XB_XCNT(j)]); sum += c; cnt += (c > 0u) ? 1u : 0u; mine = (j == x) ? c : mine; }
        if (sum == G) break;
        __builtin_amdgcn_s_sleep(1);
        if ((++sp & 255u) == 0u) { if (xb_ld(&bar[XB_TMO])) break; if (sp > XB_SPIN_CAP) { atomicAdd(&bar[XB_TMO], 1u); break; } }
    }
    nloc = mine > 0u ? mine : 1u; nx = cnt > 0u ? cnt : 1u;
}

__device__ __forceinline__ void xcd_barrier(const XcdBarrier& b) {
    asm volatile("s_waitcnt vmcnt(0)" ::: "memory");
    __syncthreads();
    if (threadIdx.x == 0) {
        unsigned* bar = b.bar;
        __builtin_amdgcn_s_waitcnt(0);
        unsigned nloc = b.st[0], nx = b.st[1];
        if (nloc == 0u) { xcd_barrier_complete(bar, b.x, nloc, nx); b.st[0] = nloc; b.st[1] = nx; }
        const unsigned old = xb_add(&bar[XB_XSUB(b.x)], 1u);
        const unsigned gen = old / nloc;
        if (old + 1u == (gen + 1u) * nloc) {
            __builtin_amdgcn_fence(__ATOMIC_RELEASE, "agent");
            asm volatile("s_waitcnt vmcnt(0)" ::: "memory");
            const unsigned og = xb_add(&bar[XB_TOP], 1u);
            const unsigned tg = og / nx;
            if (og + 1u == (tg + 1u) * nx) xb_add(&bar[XB_TOPGEN], 1u);
            else XB_SPIN(xb_ld(&bar[XB_TOPGEN]) == tg, bar);
            __builtin_amdgcn_fence(__ATOMIC_ACQUIRE, "agent");
            xb_add(&bar[XB_XGEN(b.x)], 1u);
            asm volatile("s_waitcnt vmcnt(0)" ::: "memory");
        } else {
            XB_SPIN(xb_ld(&bar[XB_XGEN(b.x)]) == gen, bar);
            __builtin_amdgcn_fence(__ATOMIC_ACQUIRE, "agent");
            asm volatile("s_waitcnt vmcnt(0)" ::: "memory");
        }
    }
    __syncthreads();
}


struct Args { const float* in[14]; float* out; unsigned char* ws; };

__global__ void __launch_bounds__(512) mk_fwd(Args args) {
    extern __shared__ __attribute__((aligned(16))) unsigned char lds[];
    cg::grid_group grid = cg::this_grid();
    const int tid0 = threadIdx.x, wave = __builtin_amdgcn_readfirstlane(tid0 >> 6);
#define FRESH_LANE() int tid = tid0; asm volatile("" : "+v"(tid)); const int lane = tid & 63
    const int G = gridDim.x, bx = blockIdx.x;
    const int vcu = (G % 8 == 0) ? (bx % 8) * (G / 8) + bx / 8 : bx;
    const int gw = vcu * 8 + wave, NGW = G * 8;
    LAS unsigned char* ldsl = (LAS unsigned char*)lds;
    if (tid0 < 8) ((LAS unsigned*)(ldsl + MISC_OFF))[tid0] = 0u;
    __syncthreads();
    const XcdBarrier xbar = xcd_barrier_post((unsigned*)(args.ws + WS_BAR), (volatile LAS unsigned*)(ldsl + MISC_OFF));
#define ws (args.ws)
#define x_in (args.in[0])
#define norm_mix (args.in[1])
#define w_in (args.in[2])
#define b_gate (args.in[3])
#define diff_lambda (args.in[4])
#define diff_subln (args.in[5])
#define na_rpb (args.in[6])
#define qk_norm (args.in[7])
#define w_branch (args.in[8])
#define w_out (args.in[9])
#define norm_ffn (args.in[10])
#define w_ff1 (args.in[11])
#define w_ff2 (args.in[12])
#define norm_final (args.in[13])
#define xout (args.out)
#define WinT ((bf16_t*)(ws + WS_WIN))
#define WbrT ((bf16_t*)(ws + WS_WBR))
#define WoutT ((bf16_t*)(ws + WS_WOUT))
#define W1T ((bf16_t*)(ws + WS_W1))
#define W2T ((bf16_t*)(ws + WS_W2))
#define STAT ((float*)(ws + WS_STAT))
#define H ((bf16_t*)(ws + WS_H))
#define ATMP ((bf16_t*)(ws + WS_ATMP))
#define BTMP ((bf16_t*)(ws + WS_BTMP))
#define Y ((bf16_t*)(ws + WS_Y))
#define MERGED ((bf16_t*)(ws + WS_MERGED))
#define Z ((bf16_t*)(ws + WS_Z))
#define U ((bf16_t*)(ws + WS_Z))
#define PROJ ((bf16_t*)(ws + WS_PROJ))
#define XB ((bf16_t*)(ws + WS_XB))
#define SSQM ((float*)(ws + WS_SSQM))
#define SSQF ((float*)(ws + WS_SSQF))
#define NRMQ ((unsigned*)(ws + WS_NRM))
#define NRMK ((unsigned*)(ws + WS_NRM) + 1024)

    {
        FRESH_LANE();
        LAS float* scr = (LAS float*)(ldsl + wave * 16384);
        constexpr int I_IN = (DM / 64) * (INW / 32), I_BR = (512 / 64) * (DM / 32), I_OUT = (DM / 64) * (DM / 32), I_1 = (DM / 64) * (DFF / 32), I_2 = (DFF / 64) * (DM / 32);
        constexpr int NITEMS = 2 * I_IN + 8 * I_BR + 2 * I_OUT + 2 * I_1 + 2 * I_2;
        for (int it = gw; it < NITEMS; it += NGW) {
            int r = it;
            if (r < 2 * I_IN) { const int l = r / I_IN; transpose_item(w_in + (size_t)l * DM * INW, DM, INW, WinT + (size_t)l * INW * DM, scr, r % I_IN, lane, norm_mix + l * DM); continue; } r -= 2 * I_IN;
            if (r < 8 * I_BR) { const int ln = r / I_BR; transpose_item(w_branch + (size_t)ln * 512 * DM, 512, DM, WbrT + (size_t)ln * DM * 512, scr, r % I_BR, lane); continue; } r -= 8 * I_BR;
            if (r < 2 * I_OUT) { const int l = r / I_OUT; transpose_item(w_out + (size_t)l * DM * DM, DM, DM, WoutT + (size_t)l * DM * DM, scr, r % I_OUT, lane); continue; } r -= 2 * I_OUT;
            if (r < 2 * I_1) { const int l = r / I_1; transpose_item(w_ff1 + (size_t)l * DM * DFF, DM, DFF, W1T + (size_t)l * DFF * DM, scr, r % I_1, lane, norm_ffn + l * DM); continue; } r -= 2 * I_1;
            { const int l = r / I_2; transpose_item(w_ff2 + (size_t)l * DFF * DM, DFF, DM, W2T + (size_t)l * DM * DFF, scr, r % I_2, lane); }
        }
        for (int m = gw; m < NTOK; m += NGW) {
            const f32x4* xr = (const f32x4*)(x_in + (size_t)m * DM) + lane; u32x2* o8 = (u32x2*)(XB + (size_t)m * DM) + lane; float sq = 0.f;
#pragma unroll
            for (int j = 0; j < 4; ++j) { const f32x4 v = xr[64 * j]; sq += (v.x * v.x + v.y * v.y) + (v.z * v.z + v.w * v.w); u32x2 w; w.x = pk2(v.x, v.y); w.y = pk2(v.z, v.w); o8[64 * j] = w; }
            sq = wave_sum(sq);
            if (lane == 0) *(f32x4*)(SSQM + (size_t)m * 4) = (f32x4){sq, 0.f, 0.f, 0.f};
        }
    }
    grid.sync();

    for (int l = 0; l < DEPTH; ++l) {
        { FRESH_LANE(); LAS float* tab = (LAS float*)(ldsl + TAB_OFF); for (int i = tid; i < 8 * 465; i += 512) tab[i] = na_rpb[l * 8 * 465 + i] * LOG2E; }
        __syncthreads();
        for (int grp = 0; grp < NGRP; ++grp) {
            const size_t tok0 = (size_t)grp * TG;
            const float* xsrc = (l == 0) ? x_in : xout;
            {
                pg8::Gemm g{XB + tok0 * DM, WinT + (size_t)l * INW * DM, DM, DM, DM, 1 << 30, 0}; pg8::StaticOrder S; S.init(TG, INW, G, bx);
                if (bx == 0) { FRESH_LANE(); NRMQ[tid] = 0u; NRMQ[tid + 512] = 0u; if (tid < 16) NRMQ[1024 + tid] = 0u; (void)lane; }
                pg8::Epi<0> E{PROJ, nullptr, nullptr, b_gate + l * 4096, INW, SSQM + tok0 * 4, nullptr, nullptr, nullptr};
                pg8::gemm_phase(ldsl, g, S, E);
            }
            xcd_barrier(xbar);
            {
                FRESH_LANE();
                const float inv = exp2f(-(float)(lane & 15) * 0.8304820237218406f);
                const float gq = qk_norm[l * 128 + lane], gk = qk_norm[l * 128 + 64 + lane];
                const int per = (TG + NGW - 1) / NGW;
                float mq = 0.f, mk = 0.f; int cu = -1;
                u32x4 qv, kv, qvn = {}, kvn = {}; unsigned short rw[10], rwn[10] = {};
#define P3_LOAD(QV, KV, RW, mm) do { const bf16_t* ar_ = PROJ + (size_t)(mm) * INW; QV = *(const u32x4*)(ar_ + COL_AQ + lane * 8); KV = *(const u32x4*)(ar_ + COL_AK + lane * 8); \
                    _Pragma("unroll") for (int hd = 0; hd < 10; ++hd) RW[hd] = ar_[COL_DQ + hd * 64 + lane]; } while (0)
                if (gw * per < TG) P3_LOAD(qv, kv, rw, gw * per);
                for (int i = 0; i < per; ++i) {
                    const int m = gw * per + i; if (m >= TG) break;
                    if (i + 1 < per && m + 1 < TG) P3_LOAD(qvn, kvn, rwn, m + 1);
                    if ((m >> 8) != cu) { if (cu >= 0 && (lane & 7) == 0) { atomicMax(NRMQ + cu * 8 + (lane >> 3), __float_as_uint(mq)); atomicMax(NRMK + (cu >> 5) * 8 + (lane >> 3), __float_as_uint(mk)); } cu = m >> 8; mq = 0.f; mk = 0.f; }
                    const int s = (int)((tok0 + m) % SEQ); const float pos = (float)((lane < 32) ? (s >> 6) : (s & 63));
                    float sn, cs; sincos_red(pos * inv, sn, cs);
                    { float nq = 0.f, nk = 0.f;
#pragma unroll
                      for (int e = 0; e < 4; ++e) { nq += bflo(qv[e]) * bflo(qv[e]) + bfhi(qv[e]) * bfhi(qv[e]); nk += bflo(kv[e]) * bflo(kv[e]) + bfhi(kv[e]) * bfhi(kv[e]); }
                      nq += __shfl_xor(nq, 1); nk += __shfl_xor(nk, 1); nq += __shfl_xor(nq, 2); nk += __shfl_xor(nk, 2); nq += __shfl_xor(nq, 4); nk += __shfl_xor(nk, 4);
                      mq = fmaxf(mq, sqrtf(nq)); mk = fmaxf(mk, sqrtf(nk)); }
                    bf16_t* row = PROJ + (size_t)m * INW + COL_DQ;
#pragma unroll
                    for (int hd = 0; hd < 10; ++hd) {
                        const float v = __uint_as_float((unsigned)rw[hd] << 16);
                        const float rn = rsqrtf(wave_sum(v * v) * (1.f / 64.f) + EPS);
                        const float y = v * rn * (hd < 8 ? gq : gk);
                        const float p = __shfl_xor(y, 16);
                        float o = ((lane >> 4) & 1) ? (y * cs + p * sn) : (y * cs - p * sn);
                        if (hd < 8) o *= C2;
                        row[hd * 64 + lane] = (bf16_t)f2bf(o);
                    }
                    qv = qvn; kv = kvn;
#pragma unroll
                    for (int hd = 0; hd < 10; ++hd) rw[hd] = rwn[hd];
                }
#undef P3_LOAD
                if (cu >= 0 && (lane & 7) == 0) { atomicMax(NRMQ + cu * 8 + (lane >> 3), __float_as_uint(mq)); atomicMax(NRMK + (cu >> 5) * 8 + (lane >> 3), __float_as_uint(mk)); }
            }
            xcd_barrier(xbar);
            {
                using namespace attn_body;
                char* shm = (char*)lds;
                {
                    unsigned* qctr = (unsigned*)(ws + WS_BAR) + 3584 + (l * NGRP + grp) * 8;
                    volatile LAS unsigned* slot = (volatile LAS unsigned*)(ldsl + MISC_OFF + 32);
                    const int myx = (G % 8 == 0) ? (vcu / (G / 8)) : 0;
                    for (int qq = 0; qq < 8; ++qq) {
                        const int sx = (myx + qq) & 7;
                        for (;;) {
                            if (tid0 == 0) *slot = atomicAdd(qctr + sx, 1u);
                            __syncthreads();
                            const int j = (int)*slot;
                            __syncthreads();
                            if (j >= 128) break;
                            const int qb = j & 31; AttnArgs a{}; a.qs = INW; a.ks = INW; a.NT = 128; a.tlo = 0; a.thi = 127;
                            if (j >= 32 && j < 96) { const int ds = 2 * sx + ((j - 32) >> 5), bb = ds >> 3, h = ds & 7; const size_t tb = (size_t)bb * SEQ;
                                a.Q = (const bf16*)(PROJ + (tb + qb * 256) * INW + COL_DQ + h * 64); a.K = (const bf16*)(PROJ + tb * INW + COL_DK + (h >> 2) * 64);
                                a.V = (const bf16*)(PROJ + tb * INW + COL_DV + (h >> 2) * 64); a.O = (bf16*)(Y + (tb + qb * 256) * 2048 + 1536 + h * 64); a.os = 2048;
                                attn_unit<MD, 8>(a, shm);
                            } else { const int bb = sx >> 2, hh = ((j < 32) ? 2 : 0) + ((sx >> 1) & 1), comp = sx & 1; const size_t tb = (size_t)bb * SEQ;
                                a.Q = (const bf16*)(PROJ + (tb + qb * 256) * INW + COL_AQ + hh * 128 + comp * 64); a.K = (const bf16*)(PROJ + tb * INW + COL_AK + hh * 128 + comp * 64);
                                a.V = (const bf16*)(PROJ + tb * INW + COL_AV + hh * 128); a.O = (bf16*)(ATMP + (tb + qb * 256) * 1024 + (hh * 2 + comp) * 128); a.os = 1024;
                                a.s2 = exp2f(-2.f * (float)(hh + 1)) * LOG2E;
                                const float Bs = __uint_as_float(NRMQ[(bb * 32 + qb) * 8 + hh * 2 + comp]) * __uint_as_float(NRMK[bb * 8 + hh * 2 + comp]) * 1.02f + 0.25f;
                                const float dlim = fminf((150.f + 2.f * Bs) / a.s2, 1.0e6f), q0f = (float)(qb * 256);
                                int tlo = max(0, (int)floorf((q0f - 63.f - dlim) * (1.f / 64.f))), thi = min(127, (int)ceilf((q0f + 255.f + dlim) * (1.f / 64.f)));
                                if (((thi - tlo + 1) & 1) != 0) { if (tlo > 0) --tlo; else ++thi; }
                                tlo = __builtin_amdgcn_readfirstlane(tlo); thi = __builtin_amdgcn_readfirstlane(thi);
                                a.K += (size_t)tlo * 64 * INW; a.V += (size_t)tlo * 64 * INW; a.q0 = qb * 256 - 64 * tlo; a.NT = thi - tlo + 1;
                                attn_unit128<8>(a, shm);
                            }
                        }
                    }
                }
                for (int u = vcu; u < GB * 24 * 32; u += G) {
                    const int sg = u >> 5, blk = u & 31, bb = sg / 24, k = sg % 24, gp = k >> 3, h = k & 7, dsh = 2 * gp, dil = 1 << dsh;
                    const int nblk = 32 >> dsh, res = blk / nblk, i0 = (blk % nblk) * 256, L = SEQ >> dsh;
                    const long tq = (long)bb * SEQ + res + (long)i0 * dil, tk = (long)bb * SEQ + res + (long)(i0 - 64) * dil;
                    AttnArgs a{}; a.qs = dil * INW; a.ks = dil * INW; a.os = dil * 1536; a.NT = 6; a.tlo = (i0 == 0) ? 1 : 0; a.thi = (i0 + 256 == L) ? 4 : 5;
                    const int cq = COL_B + gp * 1536 + h * 64;
                    a.Q = (const bf16*)(PROJ + tq * INW + cq); a.K = (const bf16*)(PROJ + tk * INW + cq + 512); a.V = (const bf16*)(PROJ + tk * INW + cq + 1024);
                    a.O = (bf16*)(BTMP + tq * 1536 + gp * 512 + h * 64);
                    a.s2 = exp2f(-(float)(h + 1)) * (float)dil * LOG2E; a.stat = STAT + (tq * 24 + gp * 8 + h) * 2; a.ss = dil * 48;
                    attn_unit<MB, 8>(a, shm);
                }
                for (int u = vcu; u < GB * 8 * 32; u += G) {
                    const int sg = u >> 5, qb = u & 31, bb = sg >> 3, h = sg & 7, r0 = 4 * qb, kb = min(max(r0 - 4, 0), 116); const size_t tb = (size_t)bb * SEQ;
                    AttnArgs a{}; a.qs = INW; a.ks = INW; a.os = 2048; a.NT = 12; a.tlo = 0; a.thi = 11; a.q0 = r0; a.kb = kb;
                    a.Q = (const bf16*)(PROJ + (tb + r0 * 64) * INW + COL_CQ + h * 64); a.K = (const bf16*)(PROJ + (tb + kb * 64) * INW + COL_CK + h * 64);
                    a.V = (const bf16*)(PROJ + (tb + kb * 64) * INW + COL_CV + h * 64); a.O = (bf16*)(Y + (tb + r0 * 64) * 2048 + 1024 + h * 64);
                    a.tab = (lds_fptr)((lds_cptr)shm + TAB_OFF) + h * 465;
                    attn_unit<MC, 8>(a, shm);
                }
            }
            xcd_barrier(xbar);
            {
                FRESH_LANE();
                int l_ = l; asm volatile("" : "+s"(l_));
                const float lam_init = (l_ == 0) ? 0.2f : (0.8f - 0.6f * 0.7408182206817179f);
                float lam;
                { const float* lp = diff_lambda + l * 256; const float a = lp[lane] * lp[64 + lane], b = lp[128 + lane] * lp[192 + lane]; lam = expf(wave_sum(a)) - expf(wave_sum(b)) + lam_init; lam = __uint_as_float(__builtin_amdgcn_readfirstlane(__float_as_uint(lam))); }
                const float out_scale = 1.f - lam_init;
                const float g0 = diff_subln[l * 128 + 2 * lane], g1 = diff_subln[l * 128 + 2 * lane + 1];
                const int h = lane >> 3, d8 = (lane & 7) * 8;
                unsigned aw[8]; u32x4 bw[3]; float sv[6];
#define P5_LOAD(AW, BW, SV, mm) do { const unsigned* at_ = (const unsigned*)(ATMP + (size_t)(mm) * 1024); _Pragma("unroll") for (int q = 0; q < 8; ++q) AW[q] = at_[q * 64 + lane]; \
                    const bf16_t* bt_ = BTMP + (size_t)(mm) * 1536 + h * 64 + d8; _Pragma("unroll") for (int g = 0; g < 3; ++g) BW[g] = *(const u32x4*)(bt_ + g * 512); \
                    const float* st_ = STAT + (size_t)(mm) * 48 + h * 2; _Pragma("unroll") for (int g = 0; g < 3; ++g) { SV[2 * g] = st_[16 * g]; SV[2 * g + 1] = st_[16 * g + 1]; } } while (0)
                for (int m = gw; m < TG; m += NGW) {
                    P5_LOAD(aw, bw, sv, m);
                    unsigned* yr = (unsigned*)(Y + (size_t)m * 2048);
#pragma unroll
                    for (int hh = 0; hh < 4; ++hh) {
                        const unsigned w0 = aw[hh * 2], w1 = aw[hh * 2 + 1];
                        const float d0 = bflo(w0) - lam * bflo(w1), d1 = bfhi(w0) - lam * bfhi(w1);
                        const float rn = rsqrtf(wave_sum(d0 * d0 + d1 * d1) * (1.f / 128.f) + EPS) * out_scale;
                        yr[hh * 64 + lane] = pk2(d0 * rn * g0, d1 * rn * g1);
                    }
                    const float m0 = sv[0], l0 = sv[1], m1 = sv[2], l1 = sv[3], m2 = sv[4], l2 = sv[5];
                    const float ms = fmaxf(m0, fmaxf(m1, m2));
                    const float w0 = l0 * exp2f(m0 - ms), w1 = l1 * exp2f(m1 - ms), w2 = l2 * exp2f(m2 - ms); const float inv = 1.f / (w0 + w1 + w2);
                    const u32x4 a0 = bw[0], a1 = bw[1], a2 = bw[2];
                    u32x4 o;
#pragma unroll
                    for (int e = 0; e < 4; ++e) { const float lo = (w0 * bflo(a0[e]) + w1 * bflo(a1[e]) + w2 * bflo(a2[e])) * inv, hi = (w0 * bfhi(a0[e]) + w1 * bfhi(a1[e]) + w2 * bfhi(a2[e])) * inv; o[e] = pk2(lo, hi); }
                    *(u32x4*)(Y + (size_t)m * 2048 + 512 + h * 64 + d8) = o;
                }
#undef P5_LOAD
            }
            xcd_barrier(xbar);
            {
                pg8::Gemm g{Y, WbrT + (size_t)l * 4096 * 512, 2048, 512, 512, 4, 512}; pg8::StaticOrder S; S.init(TG, 4096, G, bx);
                pg8::Epi<1> E{Z, nullptr, nullptr, nullptr, 4096, nullptr, nullptr, nullptr, nullptr};
                pg8::gemm_phase(ldsl, g, S, E);
            }
            xcd_barrier(xbar);
            { FRESH_LANE();
            u32x4 gv[2][4], zv[2][4];
#define P7_LOAD(GV, ZV, mm) do { const bf16_t* gr_ = PROJ + (size_t)(mm) * INW + COL_GATE + lane * 8; const bf16_t* zr_ = Z + (size_t)(mm) * 4096 + lane * 8; \
                _Pragma("unroll") for (int jj = 0; jj < 2; ++jj) _Pragma("unroll") for (int n = 0; n < 4; ++n) { GV[jj][n] = *(const u32x4*)(gr_ + n * 1024 + jj * 512); ZV[jj][n] = *(const u32x4*)(zr_ + n * 1024 + jj * 512); } } while (0)
            for (int m = gw; m < TG; m += NGW) {
                P7_LOAD(gv, zv, m);
#pragma unroll
                for (int j = 0; j < 2; ++j) { const int c = lane * 8 + j * 512; float acc[8] = {0.f, 0.f, 0.f, 0.f, 0.f, 0.f, 0.f, 0.f};
#pragma unroll
                    for (int n = 0; n < 4; ++n) {
#pragma unroll
                        for (int e = 0; e < 4; ++e) { acc[2 * e] += bflo(gv[j][n][e]) * bflo(zv[j][n][e]); acc[2 * e + 1] += bfhi(gv[j][n][e]) * bfhi(zv[j][n][e]); } }
                    u32x4 o; o.x = pk2(acc[0], acc[1]); o.y = pk2(acc[2], acc[3]); o.z = pk2(acc[4], acc[5]); o.w = pk2(acc[6], acc[7]);
                    *(u32x4*)(MERGED + (size_t)m * DM + c) = o; }
#undef P7_LOAD
            } }
            xcd_barrier(xbar);
            {
                pg8::Gemm g{MERGED, WoutT + (size_t)l * DM * DM, DM, DM, DM, 1 << 30, 0}; pg8::StaticOrder S; S.init(TG, DM, G, bx);
                pg8::Epi<3> E{nullptr, xout + tok0 * DM, xsrc + tok0 * DM, nullptr, DM, nullptr, H, SSQF, (LAS float*)(ldsl + SSQ_OFF)};
                pg8::gemm_phase(ldsl, g, S, E);
            }
            xcd_barrier(xbar);
            {
                pg8::Gemm g{H, W1T + (size_t)l * DFF * DM, DM, DM, DM, 1 << 30, 0}; pg8::StaticOrder S; S.init(TG, DFF, G, bx);
                pg8::Epi<2> E{U, nullptr, nullptr, nullptr, DFF, SSQF, nullptr, nullptr, nullptr};
                pg8::gemm_phase(ldsl, g, S, E);
            }
            xcd_barrier(xbar);
            {
                pg8::Gemm g{U, W2T + (size_t)l * DM * DFF, DFF, DFF, DFF, 1 << 30, 0}; pg8::StaticOrder S; S.init(TG, DM, G, bx);
                pg8::Epi<3> E{nullptr, xout + tok0 * DM, xout + tok0 * DM, nullptr, DM, nullptr, XB + tok0 * DM, SSQM + tok0 * 4, (LAS float*)(ldsl + SSQ_OFF)};
                pg8::gemm_phase(ldsl, g, S, E);
            }
            if (l == DEPTH - 1 && grp == NGRP - 1) xcd_barrier(xbar);
        }
    }
    FRESH_LANE();
    for (int m = gw; m < NTOK; m += NGW) {
        f32x4* o = (f32x4*)(xout + (size_t)m * DM) + lane; const f32x4* g4 = (const f32x4*)norm_final + lane;
        f32x4 v[4]; float s = 0.f;
#pragma unroll
        for (int j = 0; j < 4; ++j) { v[j] = o[64 * j]; s += (v[j].x * v[j].x + v[j].y * v[j].y) + (v[j].z * v[j].z + v[j].w * v[j].w); }
        const float r = rsqrtf(wave_sum(s) * (1.f / DM) + EPS);
#pragma unroll
        for (int j = 0; j < 4; ++j) { const f32x4 g = g4[64 * j]; o[64 * j] = (f32x4){v[j].x * r * g.x, v[j].y * r * g.y, v[j].z * r * g.z, v[j].w * r * g.w}; }
    }
}

#undef ws
#undef x_in
#undef norm_mix
#undef w_in
#undef b_gate
#undef diff_lambda
#undef diff_subln
#undef na_rpb
#undef qk_norm
#undef w_branch
#undef w_out
#undef norm_ffn
#undef w_ff1
#undef w_ff2
#undef norm_final
#undef xout
#undef WinT
#undef WbrT
#undef WoutT
#undef W1T
#undef W2T
#undef STAT
#undef H
#undef ATMP
#undef BTMP
#undef Y
#undef MERGED
#undef Z
#undef U
#undef PROJ
#undef NRMQ
#undef XB
#undef SSQM
#undef SSQF
#undef NRMK

extern "C" void kernel_launch(void* const* d_in, const int* in_sizes, int n_in, void* d_out, int out_size, void* d_ws, size_t ws_size, hipStream_t stream) {
    static int grid_blocks = 0;
    if (!grid_blocks) {
        int dev = 0, cus = 0, per_cu = 0;
        (void)hipGetDevice(&dev);
        (void)hipDeviceGetAttribute(&cus, hipDeviceAttributeMultiprocessorCount, dev);
        (void)hipFuncSetAttribute((const void*)mk_fwd, hipFuncAttributeMaxDynamicSharedMemorySize, LDS_BYTES);
        (void)hipOccupancyMaxActiveBlocksPerMultiprocessor(&per_cu, (const void*)mk_fwd, 512, LDS_BYTES);
        if (per_cu < 1) per_cu = 1;
        grid_blocks = cus * per_cu;
        if (ws_size < WS_END || n_in != 14) { fprintf(stderr, "kernel_launch: workspace %zu < %zu or n_in %d != 14\n", ws_size, (size_t)WS_END, n_in); grid_blocks = -1; }
    }
    if (grid_blocks < 0) return;
    (void)hipMemsetAsync((char*)d_ws + WS_BAR, 0, 16384, stream);
    Args a{};
    for (int i = 0; i < 14; ++i) a.in[i] = (const float*)d_in[i];
    a.out = (float*)d_out; a.ws = (unsigned char*)d_ws;
    void* kargs[] = {&a};
    hipError_t e = hipLaunchCooperativeKernel((const void*)mk_fwd, dim3(grid_blocks), dim3(512), kargs, LDS_BYTES, stream);
    if (e != hipSuccess) fprintf(stderr, "cooperative launch failed: %s (grid %d)\n", hipGetErrorString(e), grid_blocks);
}
```

```cpp
#include <hip/hip_runtime.h>
#include <hip/hip_cooperative_groups.h>
#include <hip/hip_bf16.h>
#include <cstdio>
#include <cstdint>
#include <cmath>
namespace cg = cooperative_groups;

constexpr int BATCH = 8, SEQ = 8192, DM = 1024, NTOK = BATCH * SEQ, INW = 12544, DFF = 4096, DEPTH = 2;
constexpr int GB = 2, TG = GB * SEQ, NGRP = BATCH / GB;
constexpr float EPS = 1e-6f;
constexpr float LOG2E = 1.4426950408889634f;
constexpr float C2 = 0.125f * LOG2E;
constexpr int COL_AQ = 0, COL_AK = 512, COL_AV = 1024, COL_B = 1536, COL_CQ = 6144, COL_CK = 6656, COL_CV = 7168, COL_DQ = 7680, COL_DK = 8192, COL_DV = 8320, COL_GATE = 8448;
constexpr size_t MiB = 1u << 20;
constexpr size_t WS_WIN = 0, WS_WBR = 49 * MiB, WS_WOUT = 57 * MiB, WS_W1 = 61 * MiB, WS_W2 = 77 * MiB, WS_STAT = 93 * MiB, WS_H = 96 * MiB, WS_ATMP = 128 * MiB,
                 WS_BTMP = 160 * MiB, WS_Y = 208 * MiB, WS_MERGED = 272 * MiB, WS_Z = 304 * MiB, WS_PROJ = 432 * MiB, WS_NRM = 824 * MiB, WS_BAR = 824 * MiB + 512 * 1024, WS_SSQM = 825 * MiB, WS_SSQF = 826 * MiB, WS_XB = 827 * MiB, WS_END = 955 * MiB;
constexpr int LDS_BYTES = 151552, TAB_OFF = 131072, MISC_OFF = 147072, SSQ_OFF = 147456;

#define LAS __attribute__((address_space(3)))
typedef unsigned short bf16_t;
typedef short bf16x8 __attribute__((ext_vector_type(8)));
typedef float f32x4 __attribute__((ext_vector_type(4)));
typedef unsigned u32x4 __attribute__((ext_vector_type(4)));
typedef unsigned u32x2 __attribute__((ext_vector_type(2)));

__device__ __forceinline__ unsigned f2bf(float f) { unsigned u = __builtin_bit_cast(unsigned, f); return (u + 0x7fffu + ((u >> 16) & 1u)) >> 16; }
__device__ __forceinline__ unsigned pk2(float lo, float hi) { return f2bf(lo) | (f2bf(hi) << 16); }
__device__ __forceinline__ float bflo(unsigned w) { return __uint_as_float(w << 16); }
__device__ __forceinline__ float bfhi(unsigned w) { return __uint_as_float(w & 0xffff0000u); }
__device__ __forceinline__ float wave_sum(float v) {
#pragma unroll
    for (int o = 1; o < 64; o <<= 1) v += __shfl_xor(v, o);
    return v;
}

namespace pg8 {
constexpr int BM = 256, BK = 64, HALF = 128, HTB = HALF * BK * 2, STAGE_BYTES = 8 * HTB, NXCD = 8, WGM = 4;
__host__ __device__ __forceinline__ int lds_byte(int r, int c) { const int st = (r >> 4) * 2 + (c >> 5), rr = r & 15, cc = c & 31, ob = rr * 64 + cc * 2; return st * 1024 + (ob ^ (((ob >> 9) & 1) << 5)); }
__host__ __device__ __forceinline__ void stage_rc(int b, int& R, int& C) { const int st = b / 1024, sb = b % 1024, swz = sb ^ (((sb >> 9) & 1) << 5); R = (st >> 1) * 16 + swz / 64; C = (st & 1) * 32 + (swz % 64) / 2; }
__host__ __device__ __forceinline__ int perm32(int rho) { const int n = rho >> 4, i = rho & 15; return 8 * (i >> 2) + 4 * n + (i & 3); }

struct Unit { int pm, pn; };
struct Gemm { const bf16_t* A; const bf16_t* Bt; int lda, ldb, K, adiv, astride; };

struct StaticOrder {
    int nM, nN, nwg, G, c;
    __device__ void init(int M, int N, int G_, int c_) { nM = M / BM; nN = N / BM; nwg = nM * nN; G = G_; c = c_; }
    __device__ bool next(int i, Unit& u) const {
        const long L = (long)i * G + c; if (L >= nwg) return false;
        int wgid = (int)L; { const int q = nwg / NXCD, r = nwg % NXCD, xcd = wgid % NXCD, off = wgid / NXCD; wgid = (xcd < r ? xcd * (q + 1) : r * (q + 1) + (xcd - r) * q) + off; }
        const int nig = WGM * nN, gid = wgid / nig, fm = gid * WGM, gsz = (nM - fm) < WGM ? (nM - fm) : WGM;
        u.pm = fm + ((wgid % nig) % gsz); u.pn = (wgid % nig) / gsz; return true;
    }
};

__device__ __forceinline__ unsigned cvt_pk_bf16(float lo, float hi) { unsigned r; asm volatile("v_cvt_pk_bf16_f32 %0, %1, %2" : "=v"(r) : "v"(lo), "v"(hi)); return r; }

template <int MODE> struct Epi {
    bf16_t* O; float* Of; const float* base; const float* bias; int ldc;
    const float* ssq;
    bf16_t* XBo; float* SSQo; LAS float* lx;
    __device__ __forceinline__ void operator()(const f32x4 (&acc)[2][2][4][2], const Unit& u, int wr, int wc, int fr, int fq) const {
        const int row0 = u.pm * BM + wr * 64 + fr, col0 = u.pn * BM + wc * 32 + 8 * fq;
        int kind = 0; float sc = 1.f;
        if (MODE == 0) { const int pn = u.pn; if (pn >= 33) kind = 2; else if (pn < 2 || pn == 6 || pn == 7 || pn == 12 || pn == 13 || pn == 18 || pn == 19 || pn == 24 || pn == 25) sc = C2; }
        float rsv[2][4]; f32x4 bv[2][2];
#pragma unroll
        for (int ai = 0; ai < 2; ++ai)
#pragma unroll
            for (int m = 0; m < 4; ++m) { rsv[ai][m] = 1.f;
                if (MODE == 0 || MODE == 2) { const f32x4 q = *(const f32x4*)(ssq + (size_t)(row0 + ai * HALF + m * 16) * 4); rsv[ai][m] = rsqrtf(((q[0] + q[1]) + (q[2] + q[3])) * (1.f / 1024.f) + EPS); } }
#pragma unroll
        for (int bj = 0; bj < 2; ++bj)
#pragma unroll
            for (int n = 0; n < 2; ++n) { bv[bj][n] = (f32x4){0.f, 0.f, 0.f, 0.f}; if (MODE == 0) { if (kind == 2) bv[bj][n] = *(const f32x4*)(bias + col0 + bj * HALF - COL_GATE + 4 * n); } }
        f32x4 nb[2][2];
        if (MODE == 3) {
#pragma unroll
            for (int bj = 0; bj < 2; ++bj)
#pragma unroll
                for (int n = 0; n < 2; ++n) nb[bj][n] = *(const f32x4*)(base + (size_t)row0 * ldc + col0 + bj * HALF + 4 * n);
        }
#pragma unroll
        for (int ai = 0; ai < 2; ++ai)
#pragma unroll
            for (int m = 0; m < 4; ++m) { const size_t roff = (size_t)(row0 + ai * HALF + m * 16) * ldc; float psq = 0.f; const float rs = rsv[ai][m];
                f32x4 cb[2][2];
                if (MODE == 3) {
#pragma unroll
                    for (int bj = 0; bj < 2; ++bj)
#pragma unroll
                        for (int n = 0; n < 2; ++n) cb[bj][n] = nb[bj][n];
                    const int g1 = ai * 4 + m + 1;
                    if (g1 < 8) { const size_t r1 = (size_t)(row0 + (g1 >> 2) * HALF + (g1 & 3) * 16) * ldc;
#pragma unroll
                        for (int bj = 0; bj < 2; ++bj)
#pragma unroll
                            for (int n = 0; n < 2; ++n) nb[bj][n] = *(const f32x4*)(base + r1 + col0 + bj * HALF + 4 * n); }
                }
#pragma unroll
                for (int bj = 0; bj < 2; ++bj) { const int col = col0 + bj * HALF; f32x4 v0 = acc[ai][bj][m][0], v1 = acc[ai][bj][m][1];
                    if (MODE == 3) {
                        v0 = cb[bj][0] + v0; v1 = cb[bj][1] + v1;
                        *(f32x4*)(Of + roff + col) = v0; *(f32x4*)(Of + roff + col + 4) = v1;
                        psq += (v0[0] * v0[0] + v0[1] * v0[1]) + (v0[2] * v0[2] + v0[3] * v0[3]) + (v1[0] * v1[0] + v1[1] * v1[1]) + (v1[2] * v1[2] + v1[3] * v1[3]);
                        u32x4 w; w.x = cvt_pk_bf16(v0[0], v0[1]); w.y = cvt_pk_bf16(v0[2], v0[3]); w.z = cvt_pk_bf16(v1[0], v1[1]); w.w = cvt_pk_bf16(v1[2], v1[3]);
                        *(u32x4*)(XBo + roff + col) = w;
                    } else {
                        if (MODE == 0 || MODE == 2) { v0 = v0 * rs; v1 = v1 * rs; }
                        if (MODE == 0) {
                            if (kind == 2) {
#pragma unroll
                                for (int e = 0; e < 4; ++e) { v0[e] = 1.f / (1.f + __expf(-(v0[e] + bv[bj][0][e]))); v1[e] = 1.f / (1.f + __expf(-(v1[e] + bv[bj][1][e]))); } }
                            else { v0 = v0 * sc; v1 = v1 * sc; }
                        }
                        if (MODE == 2) {
#pragma unroll
                            for (int e = 0; e < 4; ++e) { const float a = fmaxf(v0[e], 0.f), b = fmaxf(v1[e], 0.f); v0[e] = a * a; v1[e] = b * b; } }
                        u32x4 w; w.x = cvt_pk_bf16(v0[0], v0[1]); w.y = cvt_pk_bf16(v0[2], v0[3]); w.z = cvt_pk_bf16(v1[0], v1[1]); w.w = cvt_pk_bf16(v1[2], v1[3]);
                        *(u32x4*)(O + roff + col) = w;
                    } }
                if (MODE == 3) { psq += __shfl_xor(psq, 16); psq += __shfl_xor(psq, 32); if (fq == 0) lx[(ai * HALF + wr * 64 + m * 16 + fr) * 4 + wc] = psq; }
            }
        if (MODE == 3) {
            asm volatile("s_waitcnt lgkmcnt(0)" ::: "memory"); __builtin_amdgcn_s_barrier(); asm volatile("" ::: "memory");
            const int t = threadIdx.x;
            if (t < 256) { const f32x4 q = *(const LAS f32x4*)(lx + t * 4); SSQo[(size_t)(u.pm * BM + t) * 4 + u.pn] = (q[0] + q[1]) + (q[2] + q[3]); }
        }
    }
};

template <class EpiT>
__device__ __forceinline__ void gemm_phase(LAS unsigned char* lds, const Gemm g, const StaticOrder& S, const EpiT& E) {
    int tid_ = threadIdx.x; asm volatile("" : "+v"(tid_));
    const int tid = tid_, wid = __builtin_amdgcn_readfirstlane(tid >> 6), lane = tid & 63, wr = wid >> 2, wc = wid & 3, fr = lane & 15, fq = lane >> 4;
    const int K = g.K, nt = K / BK;
    unsigned voffA[2], voffB[2];
#pragma unroll
    for (int i = 0; i < 2; ++i) { int R, C; stage_rc(tid * 16 + i * 8192, R, C); const int Rb = (R & ~31) + perm32(R & 31);
        voffA[i] = (unsigned)(R * g.lda + C) * 2u; voffB[i] = (unsigned)(Rb * g.ldb + C) * 2u; }
    const size_t kstep = (size_t)(BK * 2);
    const size_t hA = (size_t)HALF * g.lda * 2, hB = (size_t)HALF * g.ldb * 2;
    const size_t tA = 2 * hA, tB = 2 * hB;
    const unsigned ldsw = (unsigned)wid * 1024u;
    const int aoff = lds_byte(wr * 64 + fr, fq * 8), boff = lds_byte(wc * 32 + fr, fq * 8);
#define PG8_SA(b, h) (((b) * 2 + (h)) * HTB)
#define PG8_SB(b, h) ((4 + (b) * 2 + (h)) * HTB)
#define PG8_STAGE(bufoff, gbase, voff) do { _Pragma("unroll") for (int _i = 0; _i < 2; ++_i) \
        __builtin_amdgcn_global_load_lds((const unsigned*)((const char*)(gbase) + (voff)[_i]), (LAS unsigned*)(lds + (bufoff) + ldsw + _i * 8192), 16, 0, 0); } while (0)
#define PG8_LDA(dst, b, h) do { _Pragma("unroll") for (int m = 0; m < 4; ++m) _Pragma("unroll") for (int k = 0; k < 2; ++k) dst[m][k] = *(const LAS bf16x8*)(lds + PG8_SA(b, h) + aoff + m * 2048 + k * 1024); } while (0)
#define PG8_LDB(dst, b, h) do { _Pragma("unroll") for (int n = 0; n < 2; ++n) _Pragma("unroll") for (int k = 0; k < 2; ++k) dst[n][k] = *(const LAS bf16x8*)(lds + PG8_SB(b, h) + boff + n * 2048 + k * 1024); } while (0)
#define PG8_MMA(ai, bj, At, Bt) do { __builtin_amdgcn_s_setprio(1); _Pragma("unroll") for (int m = 0; m < 4; ++m) _Pragma("unroll") for (int n = 0; n < 2; ++n) _Pragma("unroll") for (int k = 0; k < 2; ++k) \
        acc[ai][bj][m][n] = __builtin_amdgcn_mfma_f32_16x16x32_bf16(Bt[n][k], At[m][k], acc[ai][bj][m][n], 0, 0, 0); __builtin_amdgcn_s_setprio(0); } while (0)
#define PG8_WAIT_V(n) asm volatile("s_waitcnt vmcnt(" #n ")" ::: "memory")
#define PG8_WAIT_L(n) asm volatile("s_waitcnt lgkmcnt(" #n ")" ::: "memory")
#define PG8_BAR __builtin_amdgcn_s_barrier()
#define PG8_SCHED __builtin_amdgcn_sched_barrier(0)
#define PG8_PA(u) ((const char*)g.A + (size_t)(u).pm * tA + (size_t)((u).pn / g.adiv) * (size_t)g.astride * 2)
#define PG8_PB(u) ((const char*)g.Bt + (size_t)(u).pn * tB)
    Unit cur, nxt; int ui = 0;
    if (!S.next(0, cur)) return;
    f32x4 acc[2][2][4][2];
#pragma unroll
    for (int a = 0; a < 2; ++a)
#pragma unroll
        for (int b = 0; b < 2; ++b)
#pragma unroll
            for (int m = 0; m < 4; ++m)
#pragma unroll
                for (int n = 0; n < 2; ++n) acc[a][b][m][n] = (f32x4){0.f, 0.f, 0.f, 0.f};
    bf16x8 At[4][2], B0[2][2], B1[2][2];
    const char* cA = PG8_PA(cur); const char* cB = PG8_PB(cur);
    PG8_STAGE(PG8_SB(0, 0), cB, voffB); PG8_STAGE(PG8_SB(0, 1), cB + hB, voffB); PG8_STAGE(PG8_SA(0, 0), cA, voffA); PG8_STAGE(PG8_SA(0, 1), cA + hA, voffA);
    if (wr == 1) PG8_BAR;
    PG8_WAIT_V(2); PG8_BAR;
    PG8_STAGE(PG8_SB(1, 0), cB + kstep, voffB); PG8_STAGE(PG8_SA(1, 0), cA + kstep, voffA); PG8_STAGE(PG8_SB(1, 1), cB + hB + kstep, voffB);
    PG8_WAIT_V(6); PG8_BAR;
    for (;;) {
        const bool has_next = S.next(ui + 1, nxt);
        const char* nA = has_next ? PG8_PA(nxt) : cA; const char* nB = has_next ? PG8_PB(nxt) : cB;
        for (int t = 0; t < nt; t += 2) {
            const bool last = (t == nt - 2);
            const char* a1 = cA + (size_t)(t + 1) * kstep;
            const char* a2 = last ? nA : cA + (size_t)(t + 2) * kstep; const char* b2 = last ? nB : cB + (size_t)(t + 2) * kstep;
            const char* a3 = a2 + kstep; const char* b3 = b2 + kstep;
            PG8_LDB(B0, 0, 0); PG8_LDB(B1, 0, 1); PG8_SCHED; PG8_LDA(At, 0, 0); PG8_STAGE(PG8_SA(1, 1), a1 + hA, voffA);
            PG8_WAIT_V(8); PG8_WAIT_L(0); PG8_BAR; PG8_MMA(0, 0, At, B0); PG8_MMA(0, 1, At, B1); PG8_BAR; PG8_SCHED;
            PG8_LDA(At, 0, 1); PG8_STAGE(PG8_SB(0, 0), b2, voffB); PG8_STAGE(PG8_SB(0, 1), b2 + hB, voffB); PG8_STAGE(PG8_SA(0, 0), a2, voffA);
            PG8_WAIT_V(8); PG8_WAIT_L(0); PG8_BAR; PG8_MMA(1, 0, At, B0); PG8_MMA(1, 1, At, B1); PG8_BAR; PG8_SCHED;
            PG8_LDB(B0, 1, 0); PG8_LDB(B1, 1, 1); PG8_SCHED; PG8_LDA(At, 1, 0); PG8_STAGE(PG8_SA(0, 1), a2 + hA, voffA);
            PG8_WAIT_V(8); PG8_WAIT_L(0); PG8_BAR; PG8_MMA(0, 0, At, B0); PG8_MMA(0, 1, At, B1); PG8_BAR; PG8_SCHED;
            PG8_LDA(At, 1, 1); PG8_STAGE(PG8_SB(1, 0), b3, voffB); PG8_STAGE(PG8_SB(1, 1), b3 + hB, voffB); PG8_STAGE(PG8_SA(1, 0), a3, voffA);
            PG8_WAIT_V(8); PG8_WAIT_L(0); PG8_BAR; PG8_MMA(1, 0, At, B0); PG8_MMA(1, 1, At, B1); PG8_BAR; PG8_SCHED;
        }
        if (wr == 0) PG8_BAR;
        E(acc, cur, wr, wc, fr, fq);
        if (!has_next) break;
#pragma unroll
        for (int a = 0; a < 2; ++a)
#pragma unroll
            for (int b = 0; b < 2; ++b)
#pragma unroll
                for (int m = 0; m < 4; ++m)
#pragma unroll
                    for (int n = 0; n < 2; ++n) acc[a][b][m][n] = (f32x4){0.f, 0.f, 0.f, 0.f};
        cur = nxt; cA = nA; cB = nB; ++ui;
        if (wr == 1) PG8_BAR;
    }
    PG8_WAIT_V(0);
    PG8_BAR;
#undef PG8_SA
#undef PG8_SB
#undef PG8_STAGE
#undef PG8_LDA
#undef PG8_LDB
#undef PG8_MMA
#undef PG8_WAIT_V
#undef PG8_WAIT_L
#undef PG8_BAR
#undef PG8_SCHED
#undef PG8_PA
#undef PG8_PB
}
}

namespace attn_body {
using bf16 = __hip_bfloat16;
using s16x4 = __attribute__((ext_vector_type(4))) short;
using f32x16 = __attribute__((ext_vector_type(16))) float;
constexpr int NW = 8, QBLK = 32, QB = QBLK * NW, KVBLK = 64;
constexpr int MA = 0, MB = 1, MC = 2, MD = 3;
__device__ __forceinline__ int crow(int r, int hi) { return (r & 3) + 8 * (r >> 2) + 4 * hi; }
#define SBAR() __builtin_amdgcn_sched_barrier(0)
constexpr int NSLOT = 3, SLOTB = 8192;
constexpr int LDS_K = 0, LDS_V = NSLOT * SLOTB, LDS_WS = 2 * NSLOT * SLOTB, LDS_OST = LDS_WS + NW * 64 * 4, LDS_ATT = LDS_OST + NW * 4096;
typedef __attribute__((address_space(3))) const char* lds_cptr;
typedef __attribute__((address_space(3))) const float* lds_fptr;

struct AttnArgs {
    const bf16* Q; const bf16* K; const bf16* V; bf16* O;
    int qs, ks, os;
    int NT, tlo, thi;
    float s2;
    int q0;
    int kb;
    float* stat; int ss;
    lds_fptr tab;
};

__device__ __forceinline__ void glds16(const void* gsrc, unsigned lds_dst) { unsigned keep;
  asm volatile("s_mov_b32 %0, m0\n\ts_mov_b32 m0, %2\n\ts_nop 0\n\tglobal_load_lds_dwordx4 %1, off\n\ts_mov_b32 m0, %0" : "=&s"(keep) : "v"(gsrc), "s"(lds_dst) : "memory"); }
__device__ __forceinline__ float max3f(float a, float b, float c) { float r; asm("v_max3_f32 %0, %1, %2, %3" : "=v"(r) : "v"(a), "v"(b), "v"(c)); return r; }
__device__ __forceinline__ float max2f(float a, float b) { float r; asm("v_max_f32_e32 %0, %1, %2" : "=v"(r) : "v"(a), "v"(b)); return r; }
__device__ __forceinline__ float fadd_s(float a, float b) { float r; asm("v_add_f32_e32 %0, %1, %2" : "=v"(r) : "v"(a), "v"(b)); return r; }
__device__ __forceinline__ float fsub_s(float a, float b) { float r; asm("v_sub_f32_e32 %0, %1, %2" : "=v"(r) : "v"(a), "v"(b)); return r; }
typedef float f32x2_t __attribute__((ext_vector_type(2))); typedef __bf16 bf16x2_t __attribute__((ext_vector_type(2)));
__device__ __forceinline__ unsigned cvtpk_s(float lo, float hi) { f32x2_t v = {lo, hi}; bf16x2_t b = __builtin_convertvector(v, bf16x2_t); return __builtin_bit_cast(unsigned, b); }
#define WAIT_BAR(N) asm volatile("s_waitcnt vmcnt(" #N ") lgkmcnt(0)\n\ts_barrier" ::: "memory")

__device__ __forceinline__ void qkt(f32x16& p0, f32x16& p1, const char* Kslot, const bf16x8* qr, const f32x16& negm, int r32, int hi) {
  const char* kb = Kslot + hi * 1024 + r32 * 16;
  #pragma unroll
  for (int d0 = 0; d0 < 4; ++d0) {
    const bf16x8 b0 = *reinterpret_cast<const bf16x8*>(kb + d0 * 2048);
    const bf16x8 b1 = *reinterpret_cast<const bf16x8*>(kb + d0 * 2048 + 512);
    if (d0 == 0) { p0 = __builtin_amdgcn_mfma_f32_32x32x16_bf16(b0, qr[0], negm, 0, 0, 0); p1 = __builtin_amdgcn_mfma_f32_32x32x16_bf16(b1, qr[0], negm, 0, 0, 0); }
    else { p0 = __builtin_amdgcn_mfma_f32_32x32x16_bf16(b0, qr[d0], p0, 0, 0, 0); p1 = __builtin_amdgcn_mfma_f32_32x32x16_bf16(b1, qr[d0], p1, 0, 0, 0); } }
}
typedef short v4i16_t __attribute__((ext_vector_type(4)));
__device__ __forceinline__ void kload8(bf16x8* kf, lds_cptr kp) {
  kf[0] = *(const LAS bf16x8*)(kp);        kf[1] = *(const LAS bf16x8*)(kp + 512);
  kf[2] = *(const LAS bf16x8*)(kp + 2048); kf[3] = *(const LAS bf16x8*)(kp + 2560);
  kf[4] = *(const LAS bf16x8*)(kp + 4096); kf[5] = *(const LAS bf16x8*)(kp + 4608);
  kf[6] = *(const LAS bf16x8*)(kp + 6144); kf[7] = *(const LAS bf16x8*)(kp + 6656);
}
__device__ __forceinline__ void kload2(bf16x8* kf, lds_cptr kp, int j) { kf[2 * j] = *(const LAS bf16x8*)(kp + j * 2048); kf[2 * j + 1] = *(const LAS bf16x8*)(kp + j * 2048 + 512); }
__device__ __forceinline__ s16x4 vtr(lds_cptr p) { return __builtin_bit_cast(s16x4, __builtin_amdgcn_ds_read_tr16_b64_v4i16((LAS v4i16_t*)p)); }
__device__ __forceinline__ float rowmax(const f32x16& p0, const f32x16& p1) {
  float a = max3f(p0[0], p0[1], p1[0]), b = max3f(p0[2], p0[3], p1[1]); a = max3f(a, p1[2], p1[3]);
  #pragma unroll
  for (int r = 4; r < 16; r += 4) { a = max3f(a, p0[r], p0[r + 1]); b = max3f(b, p0[r + 2], p0[r + 3]); a = max3f(a, p1[r], p1[r + 1]); b = max3f(b, p1[r + 2], p1[r + 3]); }
  const float m = max2f(a, b);
  auto rr = __builtin_amdgcn_permlane32_swap(__float_as_uint(m), __float_as_uint(m), false, false);
  return max2f(__uint_as_float(rr[0]), __uint_as_float(rr[1]));
}
__device__ __forceinline__ void pv(f32x16* o, int vb, bf16x8 pa0, bf16x8 pa1, bf16x8 pa2, bf16x8 pa3) {
  #pragma unroll
  for (int d0 = 0; d0 < 2; ++d0) { s16x4 lo[4], hi[4];
    #pragma unroll
    for (int ks = 0; ks < 4; ++ks) {
      asm volatile("ds_read_b64_tr_b16 %0,%1 offset:%c2" : "=&v"(lo[ks]) : "v"(vb), "i"(d0 * 4096 + ks * 1024) : "memory");
      asm volatile("ds_read_b64_tr_b16 %0,%1 offset:%c2" : "=&v"(hi[ks]) : "v"(vb), "i"(d0 * 4096 + ks * 1024 + 512) : "memory"); }
    asm volatile("s_waitcnt lgkmcnt(0)" ::: "memory"); SBAR();
    #define PK(k) (bf16x8){lo[k][0], lo[k][1], lo[k][2], lo[k][3], hi[k][0], hi[k][1], hi[k][2], hi[k][3]}
    o[d0] = __builtin_amdgcn_mfma_f32_32x32x16_bf16(pa0, PK(0), o[d0], 0, 0, 0);
    o[d0] = __builtin_amdgcn_mfma_f32_32x32x16_bf16(pa1, PK(1), o[d0], 0, 0, 0);
    o[d0] = __builtin_amdgcn_mfma_f32_32x32x16_bf16(pa2, PK(2), o[d0], 0, 0, 0);
    o[d0] = __builtin_amdgcn_mfma_f32_32x32x16_bf16(pa3, PK(3), o[d0], 0, 0, 0);
    #undef PK
  }
}

template <int MODE> __device__ __forceinline__ void score_hook(f32x16& c0, f32x16& c1, int t, const AttnArgs& a, int qrel, int hi, int wid, int r32, float mh) {
  if constexpr (MODE == MA) {
    const int wlo = a.q0 + wid * QBLK, sd = (64 * t + 63 < wlo) ? 1 : ((64 * t > wlo + 31) ? -1 : 0);
    if (sd != 0) { const float sv = (float)sd * a.s2;
      #pragma unroll
      for (int r = 0; r < 16; ++r) { const float kf = (float)((r & 3) + 8 * (r >> 2)); c0[r] = fmaf(kf, sv, c0[r]); c1[r] = fmaf(kf + 32.f, sv, c1[r]); if ((r & 3) == 3) __builtin_amdgcn_sched_barrier(0); }
    } else {
      const float dq = (float)(a.q0 + qrel - 64 * t - 4 * hi), ns = -a.s2;
      #pragma unroll
      for (int r = 0; r < 16; ++r) { const float kf = (float)((r & 3) + 8 * (r >> 2)); c0[r] = fmaf(ns, fabsf(dq - kf), c0[r]); c1[r] = fmaf(ns, fabsf(dq - (kf + 32.f)), c1[r]); if ((r & 1) == 1) __builtin_amdgcn_sched_barrier(0); }
    }
  }
  if constexpr (MODE == MB) {
    const bool tv = (t >= a.tlo) && (t <= a.thi);
    const float dq = (float)(qrel + 64 - 64 * t - 4 * hi), ns = -a.s2;
    #pragma unroll
    for (int r = 0; r < 16; ++r) { const float kf = (float)((r & 3) + 8 * (r >> 2)); const float d0 = fabsf(dq - kf), d1 = fabsf(dq - (kf + 32.f));
      c0[r] = (tv && d0 <= 64.f) ? fmaf(ns, d0, c0[r] - mh) : -INFINITY; c1[r] = (tv && d1 <= 64.f) ? fmaf(ns, d1, c1[r] - mh) : -INFINITY;
      if ((r & 3) == 3) __builtin_amdgcn_sched_barrier(0); }
  }
  if constexpr (MODE == MC) {
    const int qrow = a.q0 + (wid >> 1), rs = min(max(qrow - 4, 0), 120), krow = a.kb + t;
    if (krow < rs || krow >= rs + 8) {
      #pragma unroll
      for (int r = 0; r < 16; ++r) { c0[r] = -INFINITY; c1[r] = -INFINITY; }
    } else {
      const int qc = (wid & 1) * 32 + r32, cs = min(max(qc - 8, 0), 48);
      const lds_fptr tp = a.tab + (krow - qrow + 7) * 31 + (15 - qc + 4 * hi);
      const int kd = 4 * hi - cs;
      #pragma unroll
      for (int r = 0; r < 16; ++r) { const int kc = (r & 3) + 8 * (r >> 2);
        const float b0 = tp[kc], b1 = tp[kc + 32];
        c0[r] = ((unsigned)(kd + kc) < 16u) ? c0[r] + (b0 - mh) : -INFINITY; c1[r] = ((unsigned)(kd + kc + 32) < 16u) ? c1[r] + (b1 - mh) : -INFINITY;
        if ((r & 3) == 3) __builtin_amdgcn_sched_barrier(0); }
    }
  }
}

template <int MODE, int THRL> __device__ __forceinline__ void attn_unit(const AttnArgs& A_, char* shm) {
  int tid_ = threadIdx.x; asm volatile("" : "+v"(tid_));
  const int tid = tid_, lane = tid & 63, r32 = lane & 31, hi = lane >> 5; const int wid = __builtin_amdgcn_readfirstlane(tid >> 6);
  const bf16* Qw = A_.Q + (wid * QBLK) * A_.qs;
  const unsigned lds0 = (unsigned)(uintptr_t)shm;
  float* wsf = (float*)(shm + LDS_WS) + wid * 64;
  const int ks = A_.ks;
  const bf16* ksrc = A_.K + (lane * ks + wid * 8);
  const bf16* vsrc = A_.V + ((16 * (wid & 3) + (lane >> 2)) * ks + (wid >> 2) * 32 + (lane & 3) * 8);
  const unsigned kdst = lds0 + LDS_K + wid * 1024, vdst = lds0 + LDS_V + wid * 1024;
  #define TT(t) ((MODE == MB) ? min(max((int)(t), A_.tlo), A_.thi) : (int)(t))
  #define DMA_K(t, slot) glds16(ksrc + TT(t) * KVBLK * ks, (unsigned)__builtin_amdgcn_readfirstlane(kdst + (slot)))
  #define DMA_V(t, slot) glds16(vsrc + TT(t) * KVBLK * ks, (unsigned)__builtin_amdgcn_readfirstlane(vdst + (slot)))
  const int vb0 = (int)(lds0 + LDS_V) + ((lane >> 4) & 1) * 32 + (lane & 3) * 8 + (4 * hi + ((lane & 15) >> 2)) * 64;
  const char* Kbase = shm + LDS_K; bf16x8 kf[8];
  const lds_cptr shm3 = (lds_cptr)shm; const lds_cptr kp0 = shm3 + LDS_K + hi * 1024 + r32 * 16; const lds_cptr vp0 = shm3 + LDS_V + ((lane >> 4) & 1) * 32 + (lane & 3) * 8 + (4 * hi + ((lane & 15) >> 2)) * 64;
  const int NT = A_.NT;
  DMA_K(0, 0); DMA_V(0, 0); DMA_K(1, SLOTB);
  bf16x8 qr[4];
  #pragma unroll
  for (int d0 = 0; d0 < 4; ++d0) qr[d0] = *reinterpret_cast<const bf16x8*>(&Qw[r32 * A_.qs + d0 * 16 + hi * 8]);
  float mhat = 0.f, l_reg = 0.f; f32x16 o[2]; o[0] = f32x16{}; o[1] = f32x16{}; f32x16 negm = f32x16{}; asm volatile("" : "+v"(negm));
  const int qrel = wid * QBLK + r32;
  constexpr bool NEGM = (MODE == MA || MODE == MD);
  #define CIN (NEGM ? negm : f32x16{})
  #define NEGM_SET(tn) do { float nb_ = -mhat; \
      if (MODE == MA) { const int wlo_ = A_.q0 + wid * QBLK, sd_ = (64 * (tn) + 63 < wlo_) ? 1 : ((64 * (tn) > wlo_ + 31) ? -1 : 0); \
        if (sd_ != 0) nb_ = fmaf(-(float)sd_ * A_.s2, (float)(A_.q0 + qrel - 64 * (tn) - 4 * hi), nb_); } \
      _Pragma("unroll") for (int r = 0; r < 16; ++r) negm[r] = nb_; asm volatile("" : "+v"(negm)); } while (0)
  #define CMASK(P0, P1, t) score_hook<MODE>(P0, P1, (t), A_, qrel, hi, wid, r32, mhat)
  bool resc = false;
  #define START(P0, P1) do { const float rm = rowmax(P0, P1); resc = false; \
    { const float dl = (MODE == MB || MODE == MC) ? fmaxf(rm, -2048.f) : rm; mhat = fadd_s(mhat, dl); \
      _Pragma("unroll") for (int r = 0; r < 16; ++r) { P0[r] = fsub_s(P0[r], dl); P1[r] = fsub_s(P1[r], dl); } \
      if (NEGM) { NEGM_SET(1); } } \
    _Pragma("unroll") for (int r = 0; r < 16; ++r) P0[r] = __builtin_amdgcn_exp2f(P0[r]); } while (0)
  #define RESC() do { if (resc) { asm volatile("s_waitcnt lgkmcnt(0)" ::: "memory"); \
      _Pragma("unroll") for (int d_ = 0; d_ < 2; ++d_) _Pragma("unroll") for (int r = 0; r < 16; ++r) o[d_][r] *= wsf[crow(r, hi)]; } } while (0)
  f32x16 pA0, pA1, pB0, pB1;
  int sl_prev = 0, sl_cur = 0, sl_next = SLOTB;
  #define ROT() do { sl_prev = sl_cur; sl_cur = sl_next; sl_next = (sl_next == (NSLOT - 1) * SLOTB) ? 0 : sl_next + SLOTB; } while (0)
  DMA_K(2, 2 * SLOTB);
  if (MODE == MA) { NEGM_SET(0); }
  WAIT_BAR(3);
  qkt(pA0, pA1, Kbase, qr, negm, r32, hi); asm volatile("s_nop 15\n\ts_nop 7" : "+v"(pA0), "+v"(pA1)); CMASK(pA0, pA1, 0);
  START(pA0, pA1);
  _Pragma("unroll") for (int r = 0; r < 16; ++r) pA1[r] = __builtin_amdgcn_exp2f(pA1[r]);
  WAIT_BAR(0);
  DMA_K(3, 0); DMA_V(1, SLOTB);
  ROT();
  kload8(kf, kp0 + sl_cur);
  WAIT_BAR(2);
  s16x4 vlo[8], vhi[8]; u32x4 pw0, pw1, pw2, pw3;
  #define PKW(P, B) cvtpk_s(P[B], P[B + 1])
  #define PAF(k) __builtin_bit_cast(bf16x8, pw##k)
  #define VFR(i) (bf16x8){vlo[i][0], vlo[i][1], vlo[i][2], vlo[i][3], vhi[i][0], vhi[i][1], vhi[i][2], vhi[i][3]}
  #define PIN(x) asm volatile("" : "+v"(x))
  #define MX3(a, b, c) __builtin_fmaxf(__builtin_fmaxf((a), (b)), (c))
  #define GAPA(MF, A0, A1, A2, A3, W0, W1, PW) do { MF; sacc += A0; sacc += A1; sacc += A2; sacc += A3; PIN(sacc); W0; W1; PIN(PW); SBAR(); } while (0)
  #define EX(v) __builtin_amdgcn_exp2f(v)
  #define GAPB(MF, X, B) do { MF; X[B] = EX(X[B]); X[B + 1] = EX(X[B + 1]); X[B + 2] = EX(X[B + 2]); X[B + 3] = EX(X[B + 3]); PIN(X); SBAR(); } while (0)
  #define VRD(i) do { vlo[i] = vtr(vp_ + (((i) >> 2) * 4096 + ((i) & 3) * 1024)); vhi[i] = vtr(vp_ + (((i) >> 2) * 4096 + ((i) & 3) * 1024 + 512)); } while (0)
  #define KRD(G, j) do { if (G) { kload2(kf, kp0 + sl_next, j); SBAR(); } } while (0)
  #define STEP(C0, C1, P0, P1, t, GK, GV, GL) do { SBAR(); \
    const lds_cptr vp_ = vp0 + sl_prev; \
    VRD(0); SBAR(); float sacc = (P0[0] + P0[1]); \
    GAPA(C0 = __builtin_amdgcn_mfma_f32_32x32x16_bf16(kf[0], qr[0], CIN, 0, 0, 0), P0[2], P0[3], P0[4], P0[5],     pw0[0] = PKW(P0, 0), pw0[1] = PKW(P0, 2), pw0); \
    VRD(4); SBAR(); GAPA(C1 = __builtin_amdgcn_mfma_f32_32x32x16_bf16(kf[1], qr[0], CIN, 0, 0, 0), P0[6], P0[7], P0[8], P0[9],     pw0[2] = PKW(P0, 4), pw0[3] = PKW(P0, 6), pw0); \
    VRD(1); SBAR(); GAPA(C0 = __builtin_amdgcn_mfma_f32_32x32x16_bf16(kf[2], qr[1], C0, 0, 0, 0),   P0[10], P0[11], P0[12], P0[13], pw1[0] = PKW(P0, 8), pw1[1] = PKW(P0, 10), pw1); \
    VRD(5); SBAR(); GAPA(C1 = __builtin_amdgcn_mfma_f32_32x32x16_bf16(kf[3], qr[1], C1, 0, 0, 0),   P0[14], P0[15], P1[0], P1[1],   pw1[2] = PKW(P0, 12), pw1[3] = PKW(P0, 14), pw1); \
    VRD(2); SBAR(); GAPA(C0 = __builtin_amdgcn_mfma_f32_32x32x16_bf16(kf[4], qr[2], C0, 0, 0, 0),   P1[2], P1[3], P1[4], P1[5],     pw2[0] = PKW(P1, 0), pw2[1] = PKW(P1, 2), pw2); \
    VRD(6); SBAR(); GAPA(C1 = __builtin_amdgcn_mfma_f32_32x32x16_bf16(kf[5], qr[2], C1, 0, 0, 0),   P1[6], P1[7], P1[8], P1[9],     pw2[2] = PKW(P1, 4), pw2[3] = PKW(P1, 6), pw2); \
    VRD(3); SBAR(); GAPA(C0 = __builtin_amdgcn_mfma_f32_32x32x16_bf16(kf[6], qr[3], C0, 0, 0, 0),   P1[10], P1[11], P1[12], P1[13], pw3[0] = PKW(P1, 8), pw3[1] = PKW(P1, 10), pw3); \
    VRD(7); SBAR(); GAPA(C1 = __builtin_amdgcn_mfma_f32_32x32x16_bf16(kf[7], qr[3], C1, 0, 0, 0),   P1[14], P1[15], 0.f, 0.f,       pw3[2] = PKW(P1, 12), pw3[3] = PKW(P1, 14), pw3); \
    l_reg += sacc; \
    if (GK) { DMA_K((t) + 3, sl_cur); } if (GV) { DMA_V((t) + 1, sl_next); } \
    CMASK(C0, C1, t); \
    { float a = MX3(C0[0], C0[1], C1[0]), b = MX3(C0[2], C0[3], C1[1]); a = MX3(a, C1[2], C1[3]); \
      _Pragma("unroll") for (int r = 4; r < 16; r += 4) { a = MX3(a, C0[r], C0[r + 1]); b = MX3(b, C0[r + 2], C0[r + 3]); a = MX3(a, C1[r], C1[r + 1]); b = MX3(b, C1[r + 2], C1[r + 3]); } \
      float rm = __builtin_fmaxf(a, b); { auto rr = __builtin_amdgcn_permlane32_swap(__float_as_uint(rm), __float_as_uint(rm), false, false); rm = __builtin_fmaxf(__uint_as_float(rr[0]), __uint_as_float(rr[1])); } \
      resc = false; \
      if (__builtin_expect(__any(rm > (float)THRL), 0)) { const float dl = __builtin_fmaxf(rm, 0.f); mhat += dl; \
        _Pragma("unroll") for (int r = 0; r < 16; ++r) { C0[r] -= dl; C1[r] -= dl; } \
        if (MODE == MD) { NEGM_SET(0); } \
        const float f = __builtin_amdgcn_exp2f(-dl); l_reg *= f; if (hi == 0) wsf[r32] = f; resc = true; } \
      if (MODE == MA) { NEGM_SET((t) + 1); } } \
    SBAR(); \
    GAPB(o[0] = __builtin_amdgcn_mfma_f32_32x32x16_bf16(PAF(0), VFR(0), o[0], 0, 0, 0), C0, 0); \
    GAPB(o[1] = __builtin_amdgcn_mfma_f32_32x32x16_bf16(PAF(0), VFR(4), o[1], 0, 0, 0), C0, 4); \
    KRD(GL, 0); GAPB(o[0] = __builtin_amdgcn_mfma_f32_32x32x16_bf16(PAF(1), VFR(1), o[0], 0, 0, 0), C0, 8); \
    KRD(GL, 1); GAPB(o[1] = __builtin_amdgcn_mfma_f32_32x32x16_bf16(PAF(1), VFR(5), o[1], 0, 0, 0), C0, 12); \
    KRD(GL, 2); GAPB(o[0] = __builtin_amdgcn_mfma_f32_32x32x16_bf16(PAF(2), VFR(2), o[0], 0, 0, 0), C1, 0); \
    KRD(GL, 3); GAPB(o[1] = __builtin_amdgcn_mfma_f32_32x32x16_bf16(PAF(2), VFR(6), o[1], 0, 0, 0), C1, 4); \
    GAPB(o[0] = __builtin_amdgcn_mfma_f32_32x32x16_bf16(PAF(3), VFR(3), o[0], 0, 0, 0), C1, 8); \
    GAPB(o[1] = __builtin_amdgcn_mfma_f32_32x32x16_bf16(PAF(3), VFR(7), o[1], 0, 0, 0), C1, 12); \
    } while (0)
  int t = 1;
  for (; t + 5 < NT; t += 2) {
    STEP(pB0, pB1, pA0, pA1, t, true, true, true);     WAIT_BAR(2); RESC(); ROT();
    STEP(pA0, pA1, pB0, pB1, t + 1, true, true, true); WAIT_BAR(2); RESC(); ROT();
  }
  #define ENDW(tt) do { if ((tt) + 3 < NT) { WAIT_BAR(2); } else if ((tt) + 2 < NT) { WAIT_BAR(1); } else { WAIT_BAR(0); } } while (0)
  for (; t + 1 < NT; t += 2) {
    STEP(pB0, pB1, pA0, pA1, t, (t + 3 < NT), (t + 1 < NT), (t + 1 < NT));         ENDW(t);     RESC(); ROT();
    STEP(pA0, pA1, pB0, pB1, t + 1, (t + 4 < NT), (t + 2 < NT), (t + 2 < NT));     ENDW(t + 1); RESC(); ROT();
  }
  STEP(pB0, pB1, pA0, pA1, NT - 1, false, false, false); RESC();
  { float sacc = pB0[0] + pB0[1]; _Pragma("unroll") for (int r = 2; r < 16; ++r) sacc += pB0[r]; _Pragma("unroll") for (int r = 0; r < 16; ++r) sacc += pB1[r]; l_reg += sacc;
    pw0 = (u32x4){PKW(pB0, 0), PKW(pB0, 2), PKW(pB0, 4), PKW(pB0, 6)}; pw1 = (u32x4){PKW(pB0, 8), PKW(pB0, 10), PKW(pB0, 12), PKW(pB0, 14)}; pw2 = (u32x4){PKW(pB1, 0), PKW(pB1, 2), PKW(pB1, 4), PKW(pB1, 6)}; pw3 = (u32x4){PKW(pB1, 8), PKW(pB1, 10), PKW(pB1, 12), PKW(pB1, 14)};
    SBAR(); pv(o, vb0 + sl_cur, PAF(0), PAF(1), PAF(2), PAF(3)); }
  #undef PKW
  #undef PAF
  #undef VFR
  #undef PIN
  #undef MX3
  #undef GAPA
  #undef GAPB
  #undef EX
  #undef VRD
  #undef KRD
  #undef STEP
  #undef ENDW
  { auto rr = __builtin_amdgcn_permlane32_swap(__float_as_uint(l_reg), __float_as_uint(l_reg), false, false); l_reg = __uint_as_float(rr[0]) + __uint_as_float(rr[1]); }
  if (MODE == MB) { if (hi == 0) { float* sp = A_.stat + (wid * QBLK + r32) * A_.ss; sp[0] = mhat; sp[1] = l_reg; } }
  if (hi == 0) wsf[32 + r32] = l_reg; asm volatile("s_waitcnt lgkmcnt(0)" ::: "memory");
  float rli[16];
  #pragma unroll
  for (int r = 0; r < 16; ++r) rli[r] = __builtin_amdgcn_rcpf(wsf[32 + crow(r, hi)]);
  bf16* Ow = A_.O + (wid * QBLK) * A_.os;
  { bf16* stg = (bf16*)(shm + LDS_OST) + wid * 2048;
    #pragma unroll
    for (int r = 0; r < 16; ++r) { const int orow = crow(r, hi);
      #pragma unroll
      for (int d0 = 0; d0 < 2; ++d0) stg[orow * 64 + d0 * 32 + r32] = __float2bfloat16(o[d0][r] * rli[r]); }
    asm volatile("s_waitcnt lgkmcnt(0)" ::: "memory");
    #pragma unroll
    for (int i = 0; i < 4; ++i) { const int row = i * 8 + (lane >> 3), ch = lane & 7; const u32x4 v = *(const u32x4*)(stg + row * 64 + ch * 8); *(u32x4*)(Ow + row * A_.os + ch * 8) = v; } }
  asm volatile("s_waitcnt lgkmcnt(0)\n\ts_barrier" ::: "memory");
  #undef DMA_K
  #undef DMA_V
  #undef TT
  #undef CMASK
  #undef CIN
  #undef NEGM_SET
  #undef START
  #undef RESC
  #undef ROT
}

constexpr int L8_K = 0, L8_V = 3 * 8192, L8_WS = L8_V + 3 * 16384, L8_QO = L8_WS + 2048, L8_END = L8_QO + 8 * 4096;
template <int THRL> __device__ __forceinline__ void attn_unit128(const AttnArgs& A_, char* shm) {
  int tid_ = threadIdx.x; asm volatile("" : "+v"(tid_));
  const int tid = tid_, lane = tid & 63, r32 = lane & 31, hi = lane >> 5; const int wid = __builtin_amdgcn_readfirstlane(tid >> 6);
  const bf16* Qw = A_.Q + (wid * QBLK) * A_.qs;
  const unsigned lds0 = (unsigned)(uintptr_t)shm;
  float* wsf = (float*)(shm + L8_WS) + wid * 64;
  const int ks = A_.ks;
  const bf16* ksrc = A_.K + (lane * ks + wid * 8);
  const bf16* vsrc = A_.V + ((16 * (wid & 3) + (lane >> 2)) * ks + (wid >> 2) * 32 + (lane & 3) * 8);
  const unsigned kdst = lds0 + L8_K + wid * 1024, vdst = lds0 + L8_V + wid * 1024;
  #define DMA_K(t, slot) glds16(ksrc + (int)(t) * KVBLK * ks, (unsigned)__builtin_amdgcn_readfirstlane(kdst + (slot)))
  #define DMA_V(t, slot) do { glds16(vsrc + (int)(t) * KVBLK * ks, (unsigned)__builtin_amdgcn_readfirstlane(vdst + 2 * (slot))); \
                              glds16(vsrc + (int)(t) * KVBLK * ks + 64, (unsigned)__builtin_amdgcn_readfirstlane(vdst + 2 * (slot) + 8192)); } while (0)
  const int vb0 = (int)(lds0 + L8_V) + ((lane >> 4) & 1) * 32 + (lane & 3) * 8 + (4 * hi + ((lane & 15) >> 2)) * 64;
  const char* Kbase = shm + L8_K; bf16x8 kf[8];
  const lds_cptr shm3 = (lds_cptr)shm; const lds_cptr kp0 = shm3 + L8_K + hi * 1024 + r32 * 16; const lds_cptr vp0 = shm3 + L8_V + ((lane >> 4) & 1) * 32 + (lane & 3) * 8 + (4 * hi + ((lane & 15) >> 2)) * 64;
  const lds_cptr qst = shm3 + L8_QO + wid * 4096 + lane * 16;
  const int NT = A_.NT;
  DMA_K(0, 0); DMA_V(0, 0); DMA_K(1, SLOTB);
  { bf16x8 qr[4];
    #pragma unroll
    for (int d0 = 0; d0 < 4; ++d0) qr[d0] = *reinterpret_cast<const bf16x8*>(&Qw[r32 * A_.qs + d0 * 16 + hi * 8]);
    #pragma unroll
    for (int d0 = 0; d0 < 4; ++d0) *(LAS bf16x8*)(shm3 + L8_QO + wid * 4096 + lane * 16 + d0 * 1024) = qr[d0]; }
  #define QLD(d0) (*(const LAS bf16x8*)(qst + (d0) * 1024))
  float mhat = 0.f, l_reg = 0.f; f32x16 o[4]; o[0] = f32x16{}; o[1] = f32x16{}; o[2] = f32x16{}; o[3] = f32x16{};
  const int qrel = wid * QBLK + r32;
  #define NB(tn) ({ float nb_ = -mhat; const int wlo_ = A_.q0 + wid * QBLK, sd_ = (64 * (tn) + 63 < wlo_) ? 1 : ((64 * (tn) > wlo_ + 31) ? -1 : 0); \
      if (sd_ != 0) nb_ = fmaf(-(float)sd_ * A_.s2, (float)(A_.q0 + qrel - 64 * (tn) - 4 * hi), nb_); nb_; })
  #define CMASK(P0, P1, t) score_hook<MA>(P0, P1, (t), A_, qrel, hi, wid, r32, mhat)
  bool resc = false;
  #define RESC() do { if (resc) { asm volatile("s_waitcnt lgkmcnt(0)" ::: "memory"); \
      _Pragma("unroll") for (int d_ = 0; d_ < 4; ++d_) _Pragma("unroll") for (int r = 0; r < 16; ++r) o[d_][r] *= wsf[crow(r, hi)]; } } while (0)
  f32x16 pA0, pA1, pB0, pB1;
  int sl_prev = 0, sl_cur = 0, sl_next = SLOTB;
  #define ROT() do { sl_prev = sl_cur; sl_cur = sl_next; sl_next = (sl_next == (NSLOT - 1) * SLOTB) ? 0 : sl_next + SLOTB; } while (0)
  DMA_K(2, 2 * SLOTB);
  WAIT_BAR(4);
  { f32x16 cin; const float nb0 = NB(0);
    #pragma unroll
    for (int r = 0; r < 16; ++r) cin[r] = nb0;
    bf16x8 qr[4];
    #pragma unroll
    for (int d0 = 0; d0 < 4; ++d0) qr[d0] = QLD(d0);
    qkt(pA0, pA1, Kbase, qr, cin, r32, hi); }
  asm volatile("s_nop 15\n\ts_nop 7" : "+v"(pA0), "+v"(pA1)); CMASK(pA0, pA1, 0);
  { const float rm = rowmax(pA0, pA1); mhat = fadd_s(mhat, rm);
    #pragma unroll
    for (int r = 0; r < 16; ++r) { pA0[r] = fsub_s(pA0[r], rm); pA1[r] = fsub_s(pA1[r], rm); }
    #pragma unroll
    for (int r = 0; r < 16; ++r) pA0[r] = __builtin_amdgcn_exp2f(pA0[r]);
    #pragma unroll
    for (int r = 0; r < 16; ++r) pA1[r] = __builtin_amdgcn_exp2f(pA1[r]); }
  WAIT_BAR(0);
  DMA_K(3, 0); DMA_V(1, SLOTB);
  ROT();
  kload8(kf, kp0 + sl_cur);
  WAIT_BAR(3);
  u32x4 pw0, pw1, pw2, pw3;
  #define PKW(P, B) cvtpk_s(P[B], P[B + 1])
  #define PAF(k) __builtin_bit_cast(bf16x8, pw##k)
  #define VFR(i) (bf16x8){vlo[i][0], vlo[i][1], vlo[i][2], vlo[i][3], vhi[i][0], vhi[i][1], vhi[i][2], vhi[i][3]}
  #define WFR(i) (bf16x8){wlo[i][0], wlo[i][1], wlo[i][2], wlo[i][3], whi[i][0], whi[i][1], whi[i][2], whi[i][3]}
  #define PIN(x) asm volatile("" : "+v"(x))
  #define MX3(a, b, c) __builtin_fmaxf(__builtin_fmaxf((a), (b)), (c))
  #define GAPA(MF, A0, A1, A2, A3, W0, W1, PW) do { MF; sacc += A0; sacc += A1; sacc += A2; sacc += A3; PIN(sacc); W0; W1; PIN(PW); SBAR(); } while (0)
  #define EX(v) __builtin_amdgcn_exp2f(v)
  #define GAPB(MF, X, B) do { MF; X[B] = EX(X[B]); X[B + 1] = EX(X[B + 1]); PIN(X); SBAR(); } while (0)
  #define VRD(i) do { vlo[i] = vtr(vp_ + (((i) >> 2) * 4096 + ((i) & 3) * 1024)); vhi[i] = vtr(vp_ + (((i) >> 2) * 4096 + ((i) & 3) * 1024 + 512)); } while (0)
  #define VRD2(i) do { wlo[i] = vtr(vp_ + (8192 + ((i) >> 2) * 4096 + ((i) & 3) * 1024)); whi[i] = vtr(vp_ + (8192 + ((i) >> 2) * 4096 + ((i) & 3) * 1024 + 512)); SBAR(); } while (0)
  #define KRD(G, j) do { if (G) { kload2(kf, kp0 + sl_next, j); SBAR(); } } while (0)
  #define FOFF(j) (((((j) & 1) + 2 * ((j) >> 3)) * 4096) + ((((j) >> 1) & 3) * 1024))
  #define FRD(j) do { fl[j] = vtr(vp_ + FOFF(j)); fh[j] = vtr(vp_ + FOFF(j) + 512); SBAR(); } while (0)
  #define FFR(j) (bf16x8){fl[j][0], fl[j][1], fl[j][2], fl[j][3], fh[j][0], fh[j][1], fh[j][2], fh[j][3]}
  #define STEP(C0, C1, P0, P1, t, GK, GV, GL) do { SBAR(); \
    const lds_cptr vp_ = vp0 + 2 * sl_prev; s16x4 fl[16], fh[16]; \
    { const float nb_t = NB(t); _Pragma("unroll") for (int r = 0; r < 16; ++r) { C0[r] = nb_t; C1[r] = nb_t; } } \
    bf16x8 q0_ = QLD(0), q1_ = QLD(1); SBAR(); float sacc = (P0[0] + P0[1]); \
    GAPA(C0 = __builtin_amdgcn_mfma_f32_32x32x16_bf16(kf[0], q0_, C0, 0, 0, 0), P0[2], P0[3], P0[4], P0[5],     pw0[0] = PKW(P0, 0), pw0[1] = PKW(P0, 2), pw0); \
    GAPA(C1 = __builtin_amdgcn_mfma_f32_32x32x16_bf16(kf[1], q0_, C1, 0, 0, 0), P0[6], P0[7], P0[8], P0[9],     pw0[2] = PKW(P0, 4), pw0[3] = PKW(P0, 6), pw0); \
    q0_ = QLD(2); SBAR(); \
    GAPA(C0 = __builtin_amdgcn_mfma_f32_32x32x16_bf16(kf[2], q1_, C0, 0, 0, 0),   P0[10], P0[11], P0[12], P0[13], pw1[0] = PKW(P0, 8), pw1[1] = PKW(P0, 10), pw1); \
    GAPA(C1 = __builtin_amdgcn_mfma_f32_32x32x16_bf16(kf[3], q1_, C1, 0, 0, 0),   P0[14], P0[15], P1[0], P1[1],   pw1[2] = PKW(P0, 12), pw1[3] = PKW(P0, 14), pw1); \
    q1_ = QLD(3); SBAR(); \
    GAPA(C0 = __builtin_amdgcn_mfma_f32_32x32x16_bf16(kf[4], q0_, C0, 0, 0, 0),   P1[2], P1[3], P1[4], P1[5],     pw2[0] = PKW(P1, 0), pw2[1] = PKW(P1, 2), pw2); \
    GAPA(C1 = __builtin_amdgcn_mfma_f32_32x32x16_bf16(kf[5], q0_, C1, 0, 0, 0),   P1[6], P1[7], P1[8], P1[9],     pw2[2] = PKW(P1, 4), pw2[3] = PKW(P1, 6), pw2); \
    GAPA(C0 = __builtin_amdgcn_mfma_f32_32x32x16_bf16(kf[6], q1_, C0, 0, 0, 0),   P1[10], P1[11], P1[12], P1[13], pw3[0] = PKW(P1, 8), pw3[1] = PKW(P1, 10), pw3); \
    GAPA(C1 = __builtin_amdgcn_mfma_f32_32x32x16_bf16(kf[7], q1_, C1, 0, 0, 0),   P1[14], P1[15], 0.f, 0.f,       pw3[2] = PKW(P1, 12), pw3[3] = PKW(P1, 14), pw3); \
    l_reg += sacc; \
    if (GK) { DMA_K((t) + 3, sl_cur); } if (GV) { DMA_V((t) + 1, sl_next); } \
    FRD(0); FRD(1); FRD(2); \
    CMASK(C0, C1, t); \
    { float a = MX3(C0[0], C0[1], C1[0]), b = MX3(C0[2], C0[3], C1[1]); a = MX3(a, C1[2], C1[3]); \
      _Pragma("unroll") for (int r = 4; r < 16; r += 4) { a = MX3(a, C0[r], C0[r + 1]); b = MX3(b, C0[r + 2], C0[r + 3]); a = MX3(a, C1[r], C1[r + 1]); b = MX3(b, C1[r + 2], C1[r + 3]); } \
      float rm = __builtin_fmaxf(a, b); { auto rr = __builtin_amdgcn_permlane32_swap(__float_as_uint(rm), __float_as_uint(rm), false, false); rm = __builtin_fmaxf(__uint_as_float(rr[0]), __uint_as_float(rr[1])); } \
      resc = false; \
      if (__builtin_expect(__any(rm > (float)THRL), 0)) { const float dl = __builtin_fmaxf(rm, 0.f); mhat += dl; \
        _Pragma("unroll") for (int r = 0; r < 16; ++r) { C0[r] -= dl; C1[r] -= dl; } \
        const float f = __builtin_amdgcn_exp2f(-dl); l_reg *= f; if (hi == 0) wsf[r32] = f; resc = true; } } \
    SBAR(); \
    GAPB(o[0] = __builtin_amdgcn_mfma_f32_32x32x16_bf16(PAF(0), FFR(0), o[0], 0, 0, 0), C0, 0);   FRD(3); \
    GAPB(o[1] = __builtin_amdgcn_mfma_f32_32x32x16_bf16(PAF(0), FFR(1), o[1], 0, 0, 0), C0, 2);   FRD(4); \
    GAPB(o[0] = __builtin_amdgcn_mfma_f32_32x32x16_bf16(PAF(1), FFR(2), o[0], 0, 0, 0), C0, 4);   FRD(5); \
    GAPB(o[1] = __builtin_amdgcn_mfma_f32_32x32x16_bf16(PAF(1), FFR(3), o[1], 0, 0, 0), C0, 6);   FRD(6); \
    GAPB(o[0] = __builtin_amdgcn_mfma_f32_32x32x16_bf16(PAF(2), FFR(4), o[0], 0, 0, 0), C0, 8);   FRD(7); \
    GAPB(o[1] = __builtin_amdgcn_mfma_f32_32x32x16_bf16(PAF(2), FFR(5), o[1], 0, 0, 0), C0, 10);  FRD(8); \
    GAPB(o[0] = __builtin_amdgcn_mfma_f32_32x32x16_bf16(PAF(3), FFR(6), o[0], 0, 0, 0), C0, 12);  FRD(9); \
    GAPB(o[1] = __builtin_amdgcn_mfma_f32_32x32x16_bf16(PAF(3), FFR(7), o[1], 0, 0, 0), C0, 14);  FRD(10); \
    KRD(GL, 0); GAPB(o[2] = __builtin_amdgcn_mfma_f32_32x32x16_bf16(PAF(0), FFR(8), o[2], 0, 0, 0), C1, 0);   FRD(11); \
    KRD(GL, 1); GAPB(o[3] = __builtin_amdgcn_mfma_f32_32x32x16_bf16(PAF(0), FFR(9), o[3], 0, 0, 0), C1, 2);   FRD(12); \
    KRD(GL, 2); GAPB(o[2] = __builtin_amdgcn_mfma_f32_32x32x16_bf16(PAF(1), FFR(10), o[2], 0, 0, 0), C1, 4);  FRD(13); \
    KRD(GL, 3); GAPB(o[3] = __builtin_amdgcn_mfma_f32_32x32x16_bf16(PAF(1), FFR(11), o[3], 0, 0, 0), C1, 6);  FRD(14); \
    GAPB(o[2] = __builtin_amdgcn_mfma_f32_32x32x16_bf16(PAF(2), FFR(12), o[2], 0, 0, 0), C1, 8);  FRD(15); \
    GAPB(o[3] = __builtin_amdgcn_mfma_f32_32x32x16_bf16(PAF(2), FFR(13), o[3], 0, 0, 0), C1, 10); \
    GAPB(o[2] = __builtin_amdgcn_mfma_f32_32x32x16_bf16(PAF(3), FFR(14), o[2], 0, 0, 0), C1, 12); \
    GAPB(o[3] = __builtin_amdgcn_mfma_f32_32x32x16_bf16(PAF(3), FFR(15), o[3], 0, 0, 0), C1, 14); \
    } while (0)
  int t = 1;
  for (; t + 5 < NT; t += 2) {
    STEP(pB0, pB1, pA0, pA1, t, true, true, true);     WAIT_BAR(3); RESC(); ROT();
    STEP(pA0, pA1, pB0, pB1, t + 1, true, true, true); WAIT_BAR(3); RESC(); ROT();
  }
  #define ENDW(tt) do { if ((tt) + 3 < NT) { WAIT_BAR(3); } else if ((tt) + 2 < NT) { WAIT_BAR(2); } else { WAIT_BAR(0); } } while (0)
  for (; t + 1 < NT; t += 2) {
    STEP(pB0, pB1, pA0, pA1, t, (t + 3 < NT), (t + 1 < NT), (t + 1 < NT));         ENDW(t);     RESC(); ROT();
    STEP(pA0, pA1, pB0, pB1, t + 1, (t + 4 < NT), (t + 2 < NT), (t + 2 < NT));     ENDW(t + 1); RESC(); ROT();
  }
  STEP(pB0, pB1, pA0, pA1, NT - 1, false, false, false); RESC();
  { float sacc = pB0[0] + pB0[1]; _Pragma("unroll") for (int r = 2; r < 16; ++r) sacc += pB0[r]; _Pragma("unroll") for (int r = 0; r < 16; ++r) sacc += pB1[r]; l_reg += sacc;
    pw0 = (u32x4){PKW(pB0, 0), PKW(pB0, 2), PKW(pB0, 4), PKW(pB0, 6)}; pw1 = (u32x4){PKW(pB0, 8), PKW(pB0, 10), PKW(pB0, 12), PKW(pB0, 14)}; pw2 = (u32x4){PKW(pB1, 0), PKW(pB1, 2), PKW(pB1, 4), PKW(pB1, 6)}; pw3 = (u32x4){PKW(pB1, 8), PKW(pB1, 10), PKW(pB1, 12), PKW(pB1, 14)};
    SBAR(); pv(o, vb0 + 2 * sl_cur, PAF(0), PAF(1), PAF(2), PAF(3)); pv(o + 2, vb0 + 2 * sl_cur + 8192, PAF(0), PAF(1), PAF(2), PAF(3)); }
  #undef PKW
  #undef PAF
  #undef VFR
  #undef WFR
  #undef PIN
  #undef MX3
  #undef GAPA
  #undef GAPB
  #undef EX
  #undef VRD
  #undef FOFF
  #undef FRD
  #undef FFR
  #undef KRD
  #undef STEP
  #undef ENDW
  { auto rr = __builtin_amdgcn_permlane32_swap(__float_as_uint(l_reg), __float_as_uint(l_reg), false, false); l_reg = __uint_as_float(rr[0]) + __uint_as_float(rr[1]); }
  if (hi == 0) wsf[32 + r32] = l_reg; asm volatile("s_waitcnt lgkmcnt(0)" ::: "memory");
  float rli[16];
  #pragma unroll
  for (int r = 0; r < 16; ++r) rli[r] = __builtin_amdgcn_rcpf(wsf[32 + crow(r, hi)]);
  bf16* Ow = A_.O + (wid * QBLK) * A_.os;
  { bf16* stg = (bf16*)(shm + L8_QO) + wid * 2048;
    #pragma unroll
    for (int hv = 0; hv < 2; ++hv) {
      #pragma unroll
      for (int r = 0; r < 16; ++r) { const int orow = crow(r, hi);
        #pragma unroll
        for (int d0 = 0; d0 < 2; ++d0) stg[orow * 64 + d0 * 32 + r32] = __float2bfloat16(o[2 * hv + d0][r] * rli[r]); }
      asm volatile("s_waitcnt lgkmcnt(0)" ::: "memory");
      #pragma unroll
      for (int i = 0; i < 4; ++i) { const int row = i * 8 + (lane >> 3), ch = lane & 7; const u32x4 v = *(const u32x4*)(stg + row * 64 + ch * 8); *(u32x4*)(Ow + row * A_.os + hv * 64 + ch * 8) = v; }
      asm volatile("s_waitcnt lgkmcnt(0)" ::: "memory"); } }
  asm volatile("s_waitcnt lgkmcnt(0)\n\ts_barrier" ::: "memory");
  #undef DMA_K
  #undef DMA_V
  #undef QLD
  #undef NB
  #undef CMASK
  #undef RESC
  #undef ROT
}
#undef SBAR
#undef WAIT_BAR
}

__device__ __forceinline__ void transpose_item(const float* W, int K, int N, bf16_t* WT, LAS float* scr, int item, int lane, const float* gk = nullptr) {
    const int nblk = N / 32, kb = item / nblk, nb = item % nblk, k0 = 64 * kb, n0 = 32 * nb;
#pragma unroll 8
    for (int i = 0; i < 32; ++i) { const int kk = 2 * i + (lane >> 5); const float gg = gk ? gk[k0 + kk] : 1.f; scr[kk * 33 + (lane & 31)] = W[(size_t)(k0 + kk) * N + n0 + (lane & 31)] * gg; }
    asm volatile("s_waitcnt lgkmcnt(0)" ::: "memory");
    const int c = lane & 7;
#pragma unroll
    for (int j = 0; j < 4; ++j) { const int n = (lane >> 3) + 8 * j; const LAS float* s = scr + (8 * c) * 33 + n;
        u32x4 o; o.x = pk2(s[0 * 33], s[1 * 33]); o.y = pk2(s[2 * 33], s[3 * 33]); o.z = pk2(s[4 * 33], s[5 * 33]); o.w = pk2(s[6 * 33], s[7 * 33]);
        *(u32x4*)(WT + (size_t)(n0 + n) * K + k0 + 8 * c) = o; }
    asm volatile("s_waitcnt lgkmcnt(0)" ::: "memory");
}
__device__ __forceinline__ void rms_row_bf16(const float* xrow, const float* g, bf16_t* orow, int lane) {
    const f32x4* xr = (const f32x4*)xrow + lane; const f32x4* gr = (const f32x4*)g + lane;
    f32x4 v[4]; float s = 0.f;
#pragma unroll
    for (int j = 0; j < 4; ++j) { v[j] = xr[64 * j]; s += (v[j].x * v[j].x + v[j].y * v[j].y) + (v[j].z * v[j].z + v[j].w * v[j].w); }
    const float rs = rsqrtf(wave_sum(s) * (1.f / DM) + EPS);
    u32x2* o8 = (u32x2*)orow + lane;
#pragma unroll
    for (int j = 0; j < 4; ++j) { const f32x4 gg = gr[64 * j]; u32x2 w; w.x = pk2(v[j].x * rs * gg.x, v[j].y * rs * gg.y); w.y = pk2(v[j].z * rs * gg.z, v[j].w * rs * gg.w); o8[64 * j] = w; }
}
__device__ __forceinline__ void sincos_red(float a, float& s, float& c) {
    const float q = rintf(a * 0.636619772367581f); const int iq = (int)q;
    float r = fmaf(q, -1.5703125f, a); r = fmaf(q, -4.837512969970703125e-4f, r); r = fmaf(q, -7.54978995489188216e-8f, r);
    const float r2 = r * r;
    const float sp = r + r * r2 * (-1.6666654611e-1f + r2 * (8.3321608736e-3f + r2 * (-1.9515295891e-4f)));
    const float cp = 1.0f - 0.5f * r2 + r2 * r2 * (4.166664568298827e-2f + r2 * (-1.388731625493765e-3f + r2 * 2.443315711809948e-5f));
    const int k = iq & 3;
    s = (k == 0) ? sp : (k == 1) ? cp : (k == 2) ? -sp : -cp;
    c = (k == 0) ? cp : (k == 1) ? -sp : (k == 2) ? -cp : sp;
}

#define XB_TMO      128
#define XB_XCNT(j)  (256  + 64 * (j))
#define XB_XSUB(j)  (1280 + 64 * (j))
#define XB_XGEN(j)  (2304 + 64 * (j))
#define XB_TOP      3328
#define XB_TOPGEN   3392
#define XCD_BAR_WORDS 3456
#define XB_SPIN_CAP (1u << 18)

__device__ __forceinline__ unsigned xb_ld(unsigned* p)              { return __hip_atomic_load(p, __ATOMIC_RELAXED, __HIP_MEMORY_SCOPE_AGENT); }
__device__ __forceinline__ unsigned xb_add(unsigned* p, unsigned v) { return __hip_atomic_fetch_add(p, v, __ATOMIC_RELAXED, __HIP_MEMORY_SCOPE_AGENT); }
__device__ __forceinline__ unsigned xb_xcc_id() { return (unsigned)__builtin_amdgcn_s_getreg((3 << 11) | 20) & 0xFu; }
#define XB_SPIN(cond, bar) do { unsigned _sp = 0; while (cond) { __builtin_amdgcn_s_sleep(1); \
    if ((++_sp & 255u) == 0u) { if (xb_ld(&(bar)[XB_TMO])) break; if (_sp > XB_SPIN_CAP) { atomicAdd(&(bar)[XB_TMO], 1u); break; } } } } while (0)

struct XcdBarrier {
    unsigned* bar; unsigned x;
    volatile LAS unsigned* st;
};

__device__ __forceinline__ XcdBarrier xcd_barrier_post(unsigned* bar, volatile LAS unsigned* st) {
    XcdBarrier b; b.bar = bar; b.x = xb_xcc_id(); b.st = st;
    if (threadIdx.x == 0) (void)xb_add(&bar[XB_XCNT(b.x)], 1u);
    return b;
}
__device__ __forceinline__ void xcd_barrier_complete(unsigned* bar, unsigned x, unsigned& nloc, unsigned& nx) {
    const unsigned G = gridDim.x * gridDim.y * gridDim.z;
    unsigned sum, cnt, mine, sp = 0u;
    for (;;) {
        sum = 0u; cnt = 0u; mine = 0u;
#pragma unroll
        for (unsigned j = 0; j < 16; ++j) { const unsigned c = xb_ld(&bar[XB_XCNT(j)]); sum += c; cnt += (c > 0u) ? 1u : 0u; mine = (j == x) ? c : mine; }
        if (sum == G) break;
        __builtin_amdgcn_s_sleep(1);
        if ((++sp & 255u) == 0u) { if (xb_ld(&bar[XB_TMO])) break; if (sp > XB_SPIN_CAP) { atomicAdd(&bar[XB_TMO], 1u); break; } }
    }
    nloc = mine > 0u ? mine : 1u; nx = cnt > 0u ? cnt : 1u;
}

__device__ __forceinline__ void xcd_barrier(const XcdBarrier& b) {
    asm volatile("s_waitcnt vmcnt(0)" ::: "memory");
    __syncthreads();
    if (threadIdx.x == 0) {
        unsigned* bar = b.bar;
        __builtin_amdgcn_s_waitcnt(0);
        unsigned nloc = b.st[0], nx = b.st[1];
        if (nloc == 0u) { xcd_barrier_complete(bar, b.x, nloc, nx); b.st[0] = nloc; b.st[1] = nx; }
        const unsigned old = xb_add(&bar[XB_XSUB(b.x)], 1u);
        const unsigned gen = old / nloc;
        if (old + 1u == (gen + 1u) * nloc) {
            __builtin_amdgcn_fence(__ATOMIC_RELEASE, "agent");
            asm volatile("s_waitcnt vmcnt(0)" ::: "memory");
            const unsigned og = xb_add(&bar[XB_TOP], 1u);
            const unsigned tg = og / nx;
            if (og + 1u == (tg + 1u) * nx) xb_add(&bar[XB_TOPGEN], 1u);
            else XB_SPIN(xb_ld(&bar[XB_TOPGEN]) == tg, bar);
            __builtin_amdgcn_fence(__ATOMIC_ACQUIRE, "agent");
            xb_add(&bar[XB_XGEN(b.x)], 1u);
            asm volatile("s_waitcnt vmcnt(0)" ::: "memory");
        } else {
            XB_SPIN(xb_ld(&bar[XB_XGEN(b.x)]) == gen, bar);
            __builtin_amdgcn_fence(__ATOMIC_ACQUIRE, "agent");
            asm volatile("s_waitcnt vmcnt(0)" ::: "memory");
        }
    }
    __syncthreads();
}


struct Args { const float* in[14]; float* out; unsigned char* ws; };

__global__ void __launch_bounds__(512) mk_fwd(Args args) {
    extern __shared__ __attribute__((aligned(16))) unsigned char lds[];
    cg::grid_group grid = cg::this_grid();
    const int tid0 = threadIdx.x, wave = __builtin_amdgcn_readfirstlane(tid0 >> 6);
#define FRESH_LANE() int tid = tid0; asm volatile("" : "+v"(tid)); const int lane = tid & 63
    const int G = gridDim.x, bx = blockIdx.x;
    const int vcu = (G % 8 == 0) ? (bx % 8) * (G / 8) + bx / 8 : bx;
    const int gw = vcu * 8 + wave, NGW = G * 8;
    LAS unsigned char* ldsl = (LAS unsigned char*)lds;
    if (tid0 < 8) ((LAS unsigned*)(ldsl + MISC_OFF))[tid0] = 0u;
    __syncthreads();
    const XcdBarrier xbar = xcd_barrier_post((unsigned*)(args.ws + WS_BAR), (volatile LAS unsigned*)(ldsl + MISC_OFF));
#define ws (args.ws)
#define x_in (args.in[0])
#define norm_mix (args.in[1])
#define w_in (args.in[2])
#define b_gate (args.in[3])
#define diff_lambda (args.in[4])
#define diff_subln (args.in[5])
#define na_rpb (args.in[6])
#define qk_norm (args.in[7])
#define w_branch (args.in[8])
#define w_out (args.in[9])
#define norm_ffn (args.in[10])
#define w_ff1 (args.in[11])
#define w_ff2 (args.in[12])
#define norm_final (args.in[13])
#define xout (args.out)
#define WinT ((bf16_t*)(ws + WS_WIN))
#define WbrT ((bf16_t*)(ws + WS_WBR))
#define WoutT ((bf16_t*)(ws + WS_WOUT))
#define W1T ((bf16_t*)(ws + WS_W1))
#define W2T ((bf16_t*)(ws + WS_W2))
#define STAT ((float*)(ws + WS_STAT))
#define H ((bf16_t*)(ws + WS_H))
#define ATMP ((bf16_t*)(ws + WS_ATMP))
#define BTMP ((bf16_t*)(ws + WS_BTMP))
#define Y ((bf16_t*)(ws + WS_Y))
#define MERGED ((bf16_t*)(ws + WS_MERGED))
#define Z ((bf16_t*)(ws + WS_Z))
#define U ((bf16_t*)(ws + WS_Z))
#define PROJ ((bf16_t*)(ws + WS_PROJ))
#define XB ((bf16_t*)(ws + WS_XB))
#define SSQM ((float*)(ws + WS_SSQM))
#define SSQF ((float*)(ws + WS_SSQF))
#define NRMQ ((unsigned*)(ws + WS_NRM))
#define NRMK ((unsigned*)(ws + WS_NRM) + 1024)

    {
        FRESH_LANE();
        LAS float* scr = (LAS float*)(ldsl + wave * 16384);
        constexpr int I_IN = (DM / 64) * (INW / 32), I_BR = (512 / 64) * (DM / 32), I_OUT = (DM / 64) * (DM / 32), I_1 = (DM / 64) * (DFF / 32), I_2 = (DFF / 64) * (DM / 32);
        constexpr int NITEMS = 2 * I_IN + 8 * I_BR + 2 * I_OUT + 2 * I_1 + 2 * I_2;
        for (int it = gw; it < NITEMS; it += NGW) {
            int r = it;
            if (r < 2 * I_IN) { const int l = r / I_IN; transpose_item(w_in + (size_t)l * DM * INW, DM, INW, WinT + (size_t)l * INW * DM, scr, r % I_IN, lane, norm_mix + l * DM); continue; } r -= 2 * I_IN;
            if (r < 8 * I_BR) { const int ln = r / I_BR; transpose_item(w_branch + (size_t)ln * 512 * DM, 512, DM, WbrT + (size_t)ln * DM * 512, scr, r % I_BR, lane); continue; } r -= 8 * I_BR;
            if (r < 2 * I_OUT) { const int l = r / I_OUT; transpose_item(w_out + (size_t)l * DM * DM, DM, DM, WoutT + (size_t)l * DM * DM, scr, r % I_OUT, lane); continue; } r -= 2 * I_OUT;
            if (r < 2 * I_1) { const int l = r / I_1; transpose_item(w_ff1 + (size_t)l * DM * DFF, DM, DFF, W1T + (size_t)l * DFF * DM, scr, r % I_1, lane, norm_ffn + l * DM); continue; } r -= 2 * I_1;
            { const int l = r / I_2; transpose_item(w_ff2 + (size_t)l * DFF * DM, DFF, DM, W2T + (size_t)l * DM * DFF, scr, r % I_2, lane); }
        }
        for (int m = gw; m < NTOK; m += NGW) {
            const f32x4* xr = (const f32x4*)(x_in + (size_t)m * DM) + lane; u32x2* o8 = (u32x2*)(XB + (size_t)m * DM) + lane; float sq = 0.f;
#pragma unroll
            for (int j = 0; j < 4; ++j) { const f32x4 v = xr[64 * j]; sq += (v.x * v.x + v.y * v.y) + (v.z * v.z + v.w * v.w); u32x2 w; w.x = pk2(v.x, v.y); w.y = pk2(v.z, v.w); o8[64 * j] = w; }
            sq = wave_sum(sq);
            if (lane == 0) *(f32x4*)(SSQM + (size_t)m * 4) = (f32x4){sq, 0.f, 0.f, 0.f};
        }
    }
    grid.sync();

    for (int l = 0; l < DEPTH; ++l) {
        { FRESH_LANE(); LAS float* tab = (LAS float*)(ldsl + TAB_OFF); for (int i = tid; i < 8 * 465; i += 512) tab[i] = na_rpb[l * 8 * 465 + i] * LOG2E; }
        __syncthreads();
        for (int grp = 0; grp < NGRP; ++grp) {
            const size_t tok0 = (size_t)grp * TG;
            const float* xsrc = (l == 0) ? x_in : xout;
            {
                pg8::Gemm g{XB + tok0 * DM, WinT + (size_t)l * INW * DM, DM, DM, DM, 1 << 30, 0}; pg8::StaticOrder S; S.init(TG, INW, G, bx);
                if (bx == 0) { FRESH_LANE(); NRMQ[tid] = 0u; NRMQ[tid + 512] = 0u; if (tid < 16) NRMQ[1024 + tid] = 0u; (void)lane; }
                pg8::Epi<0> E{PROJ, nullptr, nullptr, b_gate + l * 4096, INW, SSQM + tok0 * 4, nullptr, nullptr, nullptr};
                pg8::gemm_phase(ldsl, g, S, E);
            }
            xcd_barrier(xbar);
            {
                FRESH_LANE();
                const float inv = exp2f(-(float)(lane & 15) * 0.8304820237218406f);
                const float gq = qk_norm[l * 128 + lane], gk = qk_norm[l * 128 + 64 + lane];
                const int per = (TG + NGW - 1) / NGW;
                float mq = 0.f, mk = 0.f; int cu = -1;
                u32x4 qv, kv, qvn = {}, kvn = {}; unsigned short rw[10], rwn[10] = {};
#define P3_LOAD(QV, KV, RW, mm) do { const bf16_t* ar_ = PROJ + (size_t)(mm) * INW; QV = *(const u32x4*)(ar_ + COL_AQ + lane * 8); KV = *(const u32x4*)(ar_ + COL_AK + lane * 8); \
                    _Pragma("unroll") for (int hd = 0; hd < 10; ++hd) RW[hd] = ar_[COL_DQ + hd * 64 + lane]; } while (0)
                if (gw * per < TG) P3_LOAD(qv, kv, rw, gw * per);
                for (int i = 0; i < per; ++i) {
                    const int m = gw * per + i; if (m >= TG) break;
                    if (i + 1 < per && m + 1 < TG) P3_LOAD(qvn, kvn, rwn, m + 1);
                    if ((m >> 8) != cu) { if (cu >= 0 && (lane & 7) == 0) { atomicMax(NRMQ + cu * 8 + (lane >> 3), __float_as_uint(mq)); atomicMax(NRMK + (cu >> 5) * 8 + (lane >> 3), __float_as_uint(mk)); } cu = m >> 8; mq = 0.f; mk = 0.f; }
                    const int s = (int)((tok0 + m) % SEQ); const float pos = (float)((lane < 32) ? (s >> 6) : (s & 63));
                    float sn, cs; sincos_red(pos * inv, sn, cs);
                    { float nq = 0.f, nk = 0.f;
#pragma unroll
                      for (int e = 0; e < 4; ++e) { nq += bflo(qv[e]) * bflo(qv[e]) + bfhi(qv[e]) * bfhi(qv[e]); nk += bflo(kv[e]) * bflo(kv[e]) + bfhi(kv[e]) * bfhi(kv[e]); }
                      nq += __shfl_xor(nq, 1); nk += __shfl_xor(nk, 1); nq += __shfl_xor(nq, 2); nk += __shfl_xor(nk, 2); nq += __shfl_xor(nq, 4); nk += __shfl_xor(nk, 4);
                      mq = fmaxf(mq, sqrtf(nq)); mk = fmaxf(mk, sqrtf(nk)); }
                    bf16_t* row = PROJ + (size_t)m * INW + COL_DQ;
#pragma unroll
                    for (int hd = 0; hd < 10; ++hd) {
                        const float v = __uint_as_float((unsigned)rw[hd] << 16);
                        const float rn = rsqrtf(wave_sum(v * v) * (1.f / 64.f) + EPS);
                        const float y = v * rn * (hd < 8 ? gq : gk);
                        const float p = __shfl_xor(y, 16);
                        float o = ((lane >> 4) & 1) ? (y * cs + p * sn) : (y * cs - p * sn);
                        if (hd < 8) o *= C2;
                        row[hd * 64 + lane] = (bf16_t)f2bf(o);
                    }
                    qv = qvn; kv = kvn;
#pragma unroll
                    for (int hd = 0; hd < 10; ++hd) rw[hd] = rwn[hd];
                }
#undef P3_LOAD
                if (cu >= 0 && (lane & 7) == 0) { atomicMax(NRMQ + cu * 8 + (lane >> 3), __float_as_uint(mq)); atomicMax(NRMK + (cu >> 5) * 8 + (lane >> 3), __float_as_uint(mk)); }
            }
            xcd_barrier(xbar);
            {
                using namespace attn_body;
                char* shm = (char*)lds;
                {
                    unsigned* qctr = (unsigned*)(ws + WS_BAR) + 3584 + (l * NGRP + grp) * 8;
                    volatile LAS unsigned* slot = (volatile LAS unsigned*)(ldsl + MISC_OFF + 32);
                    const int myx = (G % 8 == 0) ? (vcu / (G / 8)) : 0;
                    int qq = 0;
                    for (;;) {
                        if (tid0 == 0) { int fj = -1, fx = 0;
                            for (; qq < 8; ++qq) { const int x_ = (myx + qq) & 7; const int j_ = (int)atomicAdd(qctr + x_, 1u); if (j_ < 288) { fj = j_; fx = x_; break; } }
                            slot[0] = (unsigned)fj; slot[1] = (unsigned)fx; }
                        __syncthreads();
                        const int j = (int)slot[0], sx = (int)slot[1];
                        __syncthreads();
                        if (j < 0) break;
                        if (j < 128) {
                            AttnArgs a{}; a.qs = INW; a.ks = INW; a.NT = 128; a.tlo = 0; a.thi = 127;
                            if (j >= 32 && j < 96) { const int qb = j & 31, ds = 2 * sx + ((j - 32) >> 5), bb = ds >> 3, h = ds & 7; const size_t tb = (size_t)bb * SEQ;
                                a.Q = (const bf16*)(PROJ + (tb + qb * 256) * INW + COL_DQ + h * 64); a.K = (const bf16*)(PROJ + tb * INW + COL_DK + (h >> 2) * 64);
                                a.V = (const bf16*)(PROJ + tb * INW + COL_DV + (h >> 2) * 64); a.O = (bf16*)(Y + (tb + qb * 256) * 2048 + 1536 + h * 64); a.os = 2048;
                                attn_unit<MD, 8>(a, shm);
                            } else {
                                int bb, hh, comp, qb;
                                if (j < 32) { bb = sx >> 2; hh = 2 + ((sx >> 1) & 1); comp = sx & 1; qb = j; }
                                else { const int s1 = sx >> 1; bb = s1 >> 1; comp = s1 & 1; hh = (j < 112) ? 1 : 0; qb = (sx & 1) * 16 + ((j - 96) & 15); }
                                const size_t tb = (size_t)bb * SEQ;
                                a.Q = (const bf16*)(PROJ + (tb + qb * 256) * INW + COL_AQ + hh * 128 + comp * 64); a.K = (const bf16*)(PROJ + tb * INW + COL_AK + hh * 128 + comp * 64);
                                a.V = (const bf16*)(PROJ + tb * INW + COL_AV + hh * 128); a.O = (bf16*)(ATMP + (tb + qb * 256) * 1024 + (hh * 2 + comp) * 128); a.os = 1024;
                                a.s2 = exp2f(-2.f * (float)(hh + 1)) * LOG2E;
                                const float Bs = __uint_as_float(NRMQ[(bb * 32 + qb) * 8 + hh * 2 + comp]) * __uint_as_float(NRMK[bb * 8 + hh * 2 + comp]) * 1.02f + 0.25f;
                                const float dlim = fminf((150.f + 2.f * Bs) / a.s2, 1.0e6f), q0f = (float)(qb * 256);
                                int tlo = max(0, (int)floorf((q0f - 63.f - dlim) * (1.f / 64.f))), thi = min(127, (int)ceilf((q0f + 255.f + dlim) * (1.f / 64.f)));
                                if (((thi - tlo + 1) & 1) != 0) { if (tlo > 0) --tlo; else ++thi; }
                                tlo = __builtin_amdgcn_readfirstlane(tlo); thi = __builtin_amdgcn_readfirstlane(thi);
                                a.K += (size_t)tlo * 64 * INW; a.V += (size_t)tlo * 64 * INW; a.q0 = qb * 256 - 64 * tlo; a.NT = thi - tlo + 1;
                                attn_unit128<8>(a, shm);
                            }
                        } else if (j < 192) {
                            const int cs = 2 * sx + ((j - 128) >> 5), qb = (j - 128) & 31, bb = cs >> 3, h = cs & 7, r0 = 4 * qb, kb = min(max(r0 - 4, 0), 116); const size_t tb = (size_t)bb * SEQ;
                            AttnArgs a{}; a.qs = INW; a.ks = INW; a.os = 2048; a.NT = 12; a.tlo = 0; a.thi = 11; a.q0 = r0; a.kb = kb;
                            a.Q = (const bf16*)(PROJ + (tb + r0 * 64) * INW + COL_CQ + h * 64); a.K = (const bf16*)(PROJ + (tb + kb * 64) * INW + COL_CK + h * 64);
                            a.V = (const bf16*)(PROJ + (tb + kb * 64) * INW + COL_CV + h * 64); a.O = (bf16*)(Y + (tb + r0 * 64) * 2048 + 1024 + h * 64);
                            a.tab = (lds_fptr)((lds_cptr)shm + TAB_OFF) + h * 465;
                            attn_unit<MC, 8>(a, shm);
                        } else {
                            const int p = j - 192, sg = 6 * sx + (p >> 4);
                            for (int e = 0; e < 2; ++e) {
                                const int blk = 2 * (p & 15) + e, bb = sg / 24, k = sg % 24, gp = k >> 3, h = k & 7, dsh = 2 * gp, dil = 1 << dsh;
                                const int nblk = 32 >> dsh, res = blk / nblk, i0 = (blk % nblk) * 256, L = SEQ >> dsh;
                                const long tq = (long)bb * SEQ + res + (long)i0 * dil, tk = (long)bb * SEQ + res + (long)(i0 - 64) * dil;
                                AttnArgs a{}; a.qs = dil * INW; a.ks = dil * INW; a.os = dil * 1536; a.NT = 6; a.tlo = (i0 == 0) ? 1 : 0; a.thi = (i0 + 256 == L) ? 4 : 5;
                                const int cq = COL_B + gp * 1536 + h * 64;
                                a.Q = (const bf16*)(PROJ + tq * INW + cq); a.K = (const bf16*)(PROJ + tk * INW + cq + 512); a.V = (const bf16*)(PROJ + tk * INW + cq + 1024);
                                a.O = (bf16*)(BTMP + tq * 1536 + gp * 512 + h * 64);
                                a.s2 = exp2f(-(float)(h + 1)) * (float)dil * LOG2E; a.stat = STAT + (tq * 24 + gp * 8 + h) * 2; a.ss = dil * 48;
                                attn_unit<MB, 8>(a, shm);
                            }
                        }
                    }
                }
            }
            xcd_barrier(xbar);
            {
                FRESH_LANE();
                int l_ = l; asm volatile("" : "+s"(l_));
                const float lam_init = (l_ == 0) ? 0.2f : (0.8f - 0.6f * 0.7408182206817179f);
                float lam;
                { const float* lp = diff_lambda + l * 256; const float a = lp[lane] * lp[64 + lane], b = lp[128 + lane] * lp[192 + lane]; lam = expf(wave_sum(a)) - expf(wave_sum(b)) + lam_init; lam = __uint_as_float(__builtin_amdgcn_readfirstlane(__float_as_uint(lam))); }
                const float out_scale = 1.f - lam_init;
                const float g0 = diff_subln[l * 128 + 2 * lane], g1 = diff_subln[l * 128 + 2 * lane + 1];
                const int h = lane >> 3, d8 = (lane & 7) * 8;
                unsigned aw[8]; u32x4 bw[3]; float sv[6];
#define P5_LOAD(AW, BW, SV, mm) do { const unsigned* at_ = (const unsigned*)(ATMP + (size_t)(mm) * 1024); _Pragma("unroll") for (int q = 0; q < 8; ++q) AW[q] = at_[q * 64 + lane]; \
                    const bf16_t* bt_ = BTMP + (size_t)(mm) * 1536 + h * 64 + d8; _Pragma("unroll") for (int g = 0; g < 3; ++g) BW[g] = *(const u32x4*)(bt_ + g * 512); \
                    const float* st_ = STAT + (size_t)(mm) * 48 + h * 2; _Pragma("unroll") for (int g = 0; g < 3; ++g) { SV[2 * g] = st_[16 * g]; SV[2 * g + 1] = st_[16 * g + 1]; } } while (0)
                for (int m = gw; m < TG; m += NGW) {
                    P5_LOAD(aw, bw, sv, m);
                    unsigned* yr = (unsigned*)(Y + (size_t)m * 2048);
#pragma unroll
                    for (int hh = 0; hh < 4; ++hh) {
                        const unsigned w0 = aw[hh * 2], w1 = aw[hh * 2 + 1];
                        const float d0 = bflo(w0) - lam * bflo(w1), d1 = bfhi(w0) - lam * bfhi(w1);
                        const float rn = rsqrtf(wave_sum(d0 * d0 + d1 * d1) * (1.f / 128.f) + EPS) * out_scale;
                        yr[hh * 64 + lane] = pk2(d0 * rn * g0, d1 * rn * g1);
                    }
                    const float m0 = sv[0], l0 = sv[1], m1 = sv[2], l1 = sv[3], m2 = sv[4], l2 = sv[5];
                    const float ms = fmaxf(m0, fmaxf(m1, m2));
                    const float w0 = l0 * exp2f(m0 - ms), w1 = l1 * exp2f(m1 - ms), w2 = l2 * exp2f(m2 - ms); const float inv = 1.f / (w0 + w1 + w2);
                    const u32x4 a0 = bw[0], a1 = bw[1], a2 = bw[2];
                    u32x4 o;
#pragma unroll
                    for (int e = 0; e < 4; ++e) { const float lo = (w0 * bflo(a0[e]) + w1 * bflo(a1[e]) + w2 * bflo(a2[e])) * inv, hi = (w0 * bfhi(a0[e]) + w1 * bfhi(a1[e]) + w2 * bfhi(a2[e])) * inv; o[e] = pk2(lo, hi); }
                    *(u32x4*)(Y + (size_t)m * 2048 + 512 + h * 64 + d8) = o;
                }
#undef P5_LOAD
            }
            xcd_barrier(xbar);
            {
                pg8::Gemm g{Y, WbrT + (size_t)l * 4096 * 512, 2048, 512, 512, 4, 512}; pg8::StaticOrder S; S.init(TG, 4096, G, bx);
                pg8::Epi<1> E{Z, nullptr, nullptr, nullptr, 4096, nullptr, nullptr, nullptr, nullptr};
                pg8::gemm_phase(ldsl, g, S, E);
            }
            xcd_barrier(xbar);
            { FRESH_LANE();
            u32x4 gv[2][4], zv[2][4];
#define P7_LOAD(GV, ZV, mm) do { const bf16_t* gr_ = PROJ + (size_t)(mm) * INW + COL_GATE + lane * 8; const bf16_t* zr_ = Z + (size_t)(mm) * 4096 + lane * 8; \
                _Pragma("unroll") for (int jj = 0; jj < 2; ++jj) _Pragma("unroll") for (int n = 0; n < 4; ++n) { GV[jj][n] = *(const u32x4*)(gr_ + n * 1024 + jj * 512); ZV[jj][n] = *(const u32x4*)(zr_ + n * 1024 + jj * 512); } } while (0)
            for (int m = gw; m < TG; m += NGW) {
                P7_LOAD(gv, zv, m);
#pragma unroll
                for (int j = 0; j < 2; ++j) { const int c = lane * 8 + j * 512; float acc[8] = {0.f, 0.f, 0.f, 0.f, 0.f, 0.f, 0.f, 0.f};
#pragma unroll
                    for (int n = 0; n < 4; ++n) {
#pragma unroll
                        for (int e = 0; e < 4; ++e) { acc[2 * e] += bflo(gv[j][n][e]) * bflo(zv[j][n][e]); acc[2 * e + 1] += bfhi(gv[j][n][e]) * bfhi(zv[j][n][e]); } }
                    u32x4 o; o.x = pk2(acc[0], acc[1]); o.y = pk2(acc[2], acc[3]); o.z = pk2(acc[4], acc[5]); o.w = pk2(acc[6], acc[7]);
                    *(u32x4*)(MERGED + (size_t)m * DM + c) = o; }
#undef P7_LOAD
            } }
            xcd_barrier(xbar);
            {
                pg8::Gemm g{MERGED, WoutT + (size_t)l * DM * DM, DM, DM, DM, 1 << 30, 0}; pg8::StaticOrder S; S.init(TG, DM, G, bx);
                pg8::Epi<3> E{nullptr, xout + tok0 * DM, xsrc + tok0 * DM, nullptr, DM, nullptr, H, SSQF, (LAS float*)(ldsl + SSQ_OFF)};
                pg8::gemm_phase(ldsl, g, S, E);
            }
            xcd_barrier(xbar);
            {
                pg8::Gemm g{H, W1T + (size_t)l * DFF * DM, DM, DM, DM, 1 << 30, 0}; pg8::StaticOrder S; S.init(TG, DFF, G, bx);
                pg8::Epi<2> E{U, nullptr, nullptr, nullptr, DFF, SSQF, nullptr, nullptr, nullptr};
                pg8::gemm_phase(ldsl, g, S, E);
            }
            xcd_barrier(xbar);
            {
                pg8::Gemm g{U, W2T + (size_t)l * DM * DFF, DFF, DFF, DFF, 1 << 30, 0}; pg8::StaticOrder S; S.init(TG, DM, G, bx);
                pg8::Epi<3> E{nullptr, xout + tok0 * DM, xout + tok0 * DM, nullptr, DM, nullptr, XB + tok0 * DM, SSQM + tok0 * 4, (LAS float*)(ldsl + SSQ_OFF)};
                pg8::gemm_phase(ldsl, g, S, E);
            }
            if (l == DEPTH - 1 && grp == NGRP - 1) xcd_barrier(xbar);
        }
    }
    FRESH_LANE();
    for (int m = gw; m < NTOK; m += NGW) {
        f32x4* o = (f32x4*)(xout + (size_t)m * DM) + lane; const f32x4* g4 = (const f32x4*)norm_final + lane;
        f32x4 v[4]; float s = 0.f;
#pragma unroll
        for (int j = 0; j < 4; ++j) { v[j] = o[64 * j]; s += (v[j].x * v[j].x + v[j].y * v[j].y) + (v[j].z * v[j].z + v[j].w * v[j].w); }
        const float r = rsqrtf(wave_sum(s) * (1.f / DM) + EPS);
#pragma unroll
        for (int j = 0; j < 4; ++j) { const f32x4 g = g4[64 * j]; o[64 * j] = (f32x4){v[j].x * r * g.x, v[j].y * r * g.y, v[j].z * r * g.z, v[j].w * r * g.w}; }
    }
}

#undef ws
#undef x_in
#undef norm_mix
#undef w_in
#undef b_gate
#undef diff_lambda
#undef diff_subln
#undef na_rpb
#undef qk_norm
#undef w_branch
#undef w_out
#undef norm_ffn
#undef w_ff1
#undef w_ff2
#undef norm_final
#undef xout
#undef WinT
#undef WbrT
#undef WoutT
#undef W1T
#undef W2T
#undef STAT
#undef H
#undef ATMP
#undef BTMP
#undef Y
#undef MERGED
#undef Z
#undef U
#undef PROJ
#undef NRMQ
#undef XB
#undef SSQM
#undef SSQF
#undef NRMK

extern "C" void kernel_launch(void* const* d_in, const int* in_sizes, int n_in, void* d_out, int out_size, void* d_ws, size_t ws_size, hipStream_t stream) {
    static int grid_blocks = 0;
    if (!grid_blocks) {
        int dev = 0, cus = 0, per_cu = 0;
        (void)hipGetDevice(&dev);
        (void)hipDeviceGetAttribute(&cus, hipDeviceAttributeMultiprocessorCount, dev);
        (void)hipFuncSetAttribute((const void*)mk_fwd, hipFuncAttributeMaxDynamicSharedMemorySize, LDS_BYTES);
        (void)hipOccupancyMaxActiveBlocksPerMultiprocessor(&per_cu, (const void*)mk_fwd, 512, LDS_BYTES);
        if (per_cu < 1) per_cu = 1;
        grid_blocks = cus * per_cu;
        if (ws_size < WS_END || n_in != 14) { fprintf(stderr, "kernel_launch: workspace %zu < %zu or n_in %d != 14\n", ws_size, (size_t)WS_END, n_in); grid_blocks = -1; }
    }
    if (grid_blocks < 0) return;
    (void)hipMemsetAsync((char*)d_ws + WS_BAR, 0, 16384, stream);
    Args a{};
    for (int i = 0; i < 14; ++i) a.in[i] = (const float*)d_in[i];
    a.out = (float*)d_out; a.ws = (unsigned char*)d_ws;
    void* kargs[] = {&a};
    hipError_t e = hipLaunchCooperativeKernel((const void*)mk_fwd, dim3(grid_blocks), dim3(512), kargs, LDS_BYTES, stream);
    if (e != hipSuccess) fprintf(stderr, "cooperative launch failed: %s (grid %d)\n", hipGetErrorString(e), grid_blocks);
}
```

```cpp
#include <hip/hip_runtime.h>
#include <hip/hip_cooperative_groups.h>
#include <hip/hip_bf16.h>
#include <cstdio>
#include <cstdint>
#include <cmath>
namespace cg = cooperative_groups;

constexpr int BATCH = 8, SEQ = 8192, DM = 1024, NTOK = BATCH * SEQ, INW = 12544, DFF = 4096, DEPTH = 2;
constexpr int GB = 2, TG = GB * SEQ, NGRP = BATCH / GB;
constexpr float EPS = 1e-6f;
constexpr float LOG2E = 1.4426950408889634f;
constexpr float C2 = 0.125f * LOG2E;
constexpr int COL_AQ = 0, COL_AK = 512, COL_AV = 1024, COL_B = 1536, COL_CQ = 6144, COL_CK = 6656, COL_CV = 7168, COL_DQ = 7680, COL_DK = 8192, COL_DV = 8320, COL_GATE = 8448;
constexpr size_t MiB = 1u << 20;
constexpr size_t WS_WIN = 0, WS_WBR = 49 * MiB, WS_WOUT = 57 * MiB, WS_W1 = 61 * MiB, WS_W2 = 77 * MiB, WS_STAT = 93 * MiB, WS_H = 96 * MiB, WS_ATMP = 128 * MiB,
                 WS_BTMP = 160 * MiB, WS_Y = 208 * MiB, WS_MERGED = 272 * MiB, WS_Z = 304 * MiB, WS_PROJ = 432 * MiB, WS_NRM = 824 * MiB, WS_BAR = 824 * MiB + 512 * 1024, WS_SSQM = 825 * MiB, WS_SSQF = 826 * MiB, WS_XB = 827 * MiB, WS_END = 955 * MiB;
constexpr int LDS_BYTES = 151552, TAB_OFF = 131072, MISC_OFF = 147072, SSQ_OFF = 147456;

#define LAS __attribute__((address_space(3)))
typedef unsigned short bf16_t;
typedef short bf16x8 __attribute__((ext_vector_type(8)));
typedef float f32x4 __attribute__((ext_vector_type(4)));
typedef unsigned u32x4 __attribute__((ext_vector_type(4)));
typedef unsigned u32x2 __attribute__((ext_vector_type(2)));

__device__ __forceinline__ unsigned f2bf(float f) { unsigned u = __builtin_bit_cast(unsigned, f); return (u + 0x7fffu + ((u >> 16) & 1u)) >> 16; }
__device__ __forceinline__ unsigned pk2(float lo, float hi) { return f2bf(lo) | (f2bf(hi) << 16); }
__device__ __forceinline__ float bflo(unsigned w) { return __uint_as_float(w << 16); }
__device__ __forceinline__ float bfhi(unsigned w) { return __uint_as_float(w & 0xffff0000u); }
__device__ __forceinline__ float wave_sum(float v) {
#pragma unroll
    for (int o = 1; o < 64; o <<= 1) v += __shfl_xor(v, o);
    return v;
}

namespace pg8 {
constexpr int BM = 256, BK = 64, HALF = 128, HTB = HALF * BK * 2, STAGE_BYTES = 8 * HTB, NXCD = 8, WGM = 4;
__host__ __device__ __forceinline__ int lds_byte(int r, int c) { const int st = (r >> 4) * 2 + (c >> 5), rr = r & 15, cc = c & 31, ob = rr * 64 + cc * 2; return st * 1024 + (ob ^ (((ob >> 9) & 1) << 5)); }
__host__ __device__ __forceinline__ void stage_rc(int b, int& R, int& C) { const int st = b / 1024, sb = b % 1024, swz = sb ^ (((sb >> 9) & 1) << 5); R = (st >> 1) * 16 + swz / 64; C = (st & 1) * 32 + (swz % 64) / 2; }
__host__ __device__ __forceinline__ int perm32(int rho) { const int n = rho >> 4, i = rho & 15; return 8 * (i >> 2) + 4 * n + (i & 3); }

struct Unit { int pm, pn; };
struct Gemm { const bf16_t* A; const bf16_t* Bt; int lda, ldb, K, adiv, astride; };

struct StaticOrder {
    int nM, nN, nwg, G, c;
    __device__ void init(int M, int N, int G_, int c_) { nM = M / BM; nN = N / BM; nwg = nM * nN; G = G_; c = c_; }
    __device__ bool next(int i, Unit& u) const {
        const long L = (long)i * G + c; if (L >= nwg) return false;
        int wgid = (int)L; { const int q = nwg / NXCD, r = nwg % NXCD, xcd = wgid % NXCD, off = wgid / NXCD; wgid = (xcd < r ? xcd * (q + 1) : r * (q + 1) + (xcd - r) * q) + off; }
        const int nig = WGM * nN, gid = wgid / nig, fm = gid * WGM, gsz = (nM - fm) < WGM ? (nM - fm) : WGM;
        u.pm = fm + ((wgid % nig) % gsz); u.pn = (wgid % nig) / gsz; return true;
    }
};

__device__ __forceinline__ unsigned cvt_pk_bf16(float lo, float hi) { unsigned r; asm volatile("v_cvt_pk_bf16_f32 %0, %1, %2" : "=v"(r) : "v"(lo), "v"(hi)); return r; }

template <int MODE> struct Epi {
    bf16_t* O; float* Of; const float* base; const float* bias; int ldc;
    const float* ssq;
    bf16_t* XBo; float* SSQo; LAS float* lx;
    __device__ __forceinline__ void operator()(const f32x4 (&acc)[2][2][4][2], const Unit& u, int wr, int wc, int fr, int fq) const {
        const int row0 = u.pm * BM + wr * 64 + fr, col0 = u.pn * BM + wc * 32 + 8 * fq;
        int kind = 0; float sc = 1.f;
        if (MODE == 0) { const int pn = u.pn; if (pn >= 33) kind = 2; else if (pn < 2 || pn == 6 || pn == 7 || pn == 12 || pn == 13 || pn == 18 || pn == 19 || pn == 24 || pn == 25) sc = C2; }
        float rsv[2][4]; f32x4 bv[2][2];
#pragma unroll
        for (int ai = 0; ai < 2; ++ai)
#pragma unroll
            for (int m = 0; m < 4; ++m) { rsv[ai][m] = 1.f;
                if (MODE == 0 || MODE == 2) { const f32x4 q = *(const f32x4*)(ssq + (size_t)(row0 + ai * HALF + m * 16) * 4); rsv[ai][m] = rsqrtf(((q[0] + q[1]) + (q[2] + q[3])) * (1.f / 1024.f) + EPS); } }
#pragma unroll
        for (int bj = 0; bj < 2; ++bj)
#pragma unroll
            for (int n = 0; n < 2; ++n) { bv[bj][n] = (f32x4){0.f, 0.f, 0.f, 0.f}; if (MODE == 0) { if (kind == 2) bv[bj][n] = *(const f32x4*)(bias + col0 + bj * HALF - COL_GATE + 4 * n); } }
        f32x4 nb[2][2];
        if (MODE == 3) {
#pragma unroll
            for (int bj = 0; bj < 2; ++bj)
#pragma unroll
                for (int n = 0; n < 2; ++n) nb[bj][n] = *(const f32x4*)(base + (size_t)row0 * ldc + col0 + bj * HALF + 4 * n);
        }
#pragma unroll
        for (int ai = 0; ai < 2; ++ai)
#pragma unroll
            for (int m = 0; m < 4; ++m) { const size_t roff = (size_t)(row0 + ai * HALF + m * 16) * ldc; float psq = 0.f; const float rs = rsv[ai][m];
                f32x4 cb[2][2];
                if (MODE == 3) {
#pragma unroll
                    for (int bj = 0; bj < 2; ++bj)
#pragma unroll
                        for (int n = 0; n < 2; ++n) cb[bj][n] = nb[bj][n];
                    const int g1 = ai * 4 + m + 1;
                    if (g1 < 8) { const size_t r1 = (size_t)(row0 + (g1 >> 2) * HALF + (g1 & 3) * 16) * ldc;
#pragma unroll
                        for (int bj = 0; bj < 2; ++bj)
#pragma unroll
                            for (int n = 0; n < 2; ++n) nb[bj][n] = *(const f32x4*)(base + r1 + col0 + bj * HALF + 4 * n); }
                }
#pragma unroll
                for (int bj = 0; bj < 2; ++bj) { const int col = col0 + bj * HALF; f32x4 v0 = acc[ai][bj][m][0], v1 = acc[ai][bj][m][1];
                    if (MODE == 3) {
                        v0 = cb[bj][0] + v0; v1 = cb[bj][1] + v1;
                        *(f32x4*)(Of + roff + col) = v0; *(f32x4*)(Of + roff + col + 4) = v1;
                        psq += (v0[0] * v0[0] + v0[1] * v0[1]) + (v0[2] * v0[2] + v0[3] * v0[3]) + (v1[0] * v1[0] + v1[1] * v1[1]) + (v1[2] * v1[2] + v1[3] * v1[3]);
                        u32x4 w; w.x = cvt_pk_bf16(v0[0], v0[1]); w.y = cvt_pk_bf16(v0[2], v0[3]); w.z = cvt_pk_bf16(v1[0], v1[1]); w.w = cvt_pk_bf16(v1[2], v1[3]);
                        *(u32x4*)(XBo + roff + col) = w;
                    } else {
                        if (MODE == 0 || MODE == 2) { v0 = v0 * rs; v1 = v1 * rs; }
                        if (MODE == 0) {
                            if (kind == 2) {
#pragma unroll
                                for (int e = 0; e < 4; ++e) { v0[e] = 1.f / (1.f + __expf(-(v0[e] + bv[bj][0][e]))); v1[e] = 1.f / (1.f + __expf(-(v1[e] + bv[bj][1][e]))); } }
                            else { v0 = v0 * sc; v1 = v1 * sc; }
                        }
                        if (MODE == 2) {
#pragma unroll
                            for (int e = 0; e < 4; ++e) { const float a = fmaxf(v0[e], 0.f), b = fmaxf(v1[e], 0.f); v0[e] = a * a; v1[e] = b * b; } }
                        u32x4 w; w.x = cvt_pk_bf16(v0[0], v0[1]); w.y = cvt_pk_bf16(v0[2], v0[3]); w.z = cvt_pk_bf16(v1[0], v1[1]); w.w = cvt_pk_bf16(v1[2], v1[3]);
                        *(u32x4*)(O + roff + col) = w;
                    } }
                if (MODE == 3) { psq += __shfl_xor(psq, 16); psq += __shfl_xor(psq, 32); if (fq == 0) lx[(ai * HALF + wr * 64 + m * 16 + fr) * 4 + wc] = psq; }
            }
        if (MODE == 3) {
            asm volatile("s_waitcnt lgkmcnt(0)" ::: "memory"); __builtin_amdgcn_s_barrier(); asm volatile("" ::: "memory");
            const int t = threadIdx.x;
            if (t < 256) { const f32x4 q = *(const LAS f32x4*)(lx + t * 4); SSQo[(size_t)(u.pm * BM + t) * 4 + u.pn] = (q[0] + q[1]) + (q[2] + q[3]); }
        }
    }
};

template <class EpiT>
__device__ __forceinline__ void gemm_phase(LAS unsigned char* lds, const Gemm g, const StaticOrder& S, const EpiT& E) {
    int tid_ = threadIdx.x; asm volatile("" : "+v"(tid_));
    const int tid = tid_, wid = __builtin_amdgcn_readfirstlane(tid >> 6), lane = tid & 63, wr = wid >> 2, wc = wid & 3, fr = lane & 15, fq = lane >> 4;
    const int K = g.K, nt = K / BK;
    unsigned voffA[2], voffB[2];
#pragma unroll
    for (int i = 0; i < 2; ++i) { int R, C; stage_rc(tid * 16 + i * 8192, R, C); const int Rb = (R & ~31) + perm32(R & 31);
        voffA[i] = (unsigned)(R * g.lda + C) * 2u; voffB[i] = (unsigned)(Rb * g.ldb + C) * 2u; }
    const size_t kstep = (size_t)(BK * 2);
    const size_t hA = (size_t)HALF * g.lda * 2, hB = (size_t)HALF * g.ldb * 2;
    const size_t tA = 2 * hA, tB = 2 * hB;
    const unsigned ldsw = (unsigned)wid * 1024u;
    const int aoff = lds_byte(wr * 64 + fr, fq * 8), boff = lds_byte(wc * 32 + fr, fq * 8);
#define PG8_SA(b, h) (((b) * 2 + (h)) * HTB)
#define PG8_SB(b, h) ((4 + (b) * 2 + (h)) * HTB)
#define PG8_STAGE(bufoff, gbase, voff) do { _Pragma("unroll") for (int _i = 0; _i < 2; ++_i) \
        __builtin_amdgcn_global_load_lds((const unsigned*)((const char*)(gbase) + (voff)[_i]), (LAS unsigned*)(lds + (bufoff) + ldsw + _i * 8192), 16, 0, 0); } while (0)
#define PG8_LDA(dst, b, h) do { _Pragma("unroll") for (int m = 0; m < 4; ++m) _Pragma("unroll") for (int k = 0; k < 2; ++k) dst[m][k] = *(const LAS bf16x8*)(lds + PG8_SA(b, h) + aoff + m * 2048 + k * 1024); } while (0)
#define PG8_LDB(dst, b, h) do { _Pragma("unroll") for (int n = 0; n < 2; ++n) _Pragma("unroll") for (int k = 0; k < 2; ++k) dst[n][k] = *(const LAS bf16x8*)(lds + PG8_SB(b, h) + boff + n * 2048 + k * 1024); } while (0)
#define PG8_MMA(ai, bj, At, Bt) do { __builtin_amdgcn_s_setprio(1); _Pragma("unroll") for (int m = 0; m < 4; ++m) _Pragma("unroll") for (int n = 0; n < 2; ++n) _Pragma("unroll") for (int k = 0; k < 2; ++k) \
        acc[ai][bj][m][n] = __builtin_amdgcn_mfma_f32_16x16x32_bf16(Bt[n][k], At[m][k], acc[ai][bj][m][n], 0, 0, 0); __builtin_amdgcn_s_setprio(0); } while (0)
#define PG8_WAIT_V(n) asm volatile("s_waitcnt vmcnt(" #n ")" ::: "memory")
#define PG8_WAIT_L(n) asm volatile("s_waitcnt lgkmcnt(" #n ")" ::: "memory")
#define PG8_BAR __builtin_amdgcn_s_barrier()
#define PG8_SCHED __builtin_amdgcn_sched_barrier(0)
#define PG8_PA(u) ((const char*)g.A + (size_t)(u).pm * tA + (size_t)((u).pn / g.adiv) * (size_t)g.astride * 2)
#define PG8_PB(u) ((const char*)g.Bt + (size_t)(u).pn * tB)
    Unit cur, nxt; int ui = 0;
    if (!S.next(0, cur)) return;
    f32x4 acc[2][2][4][2];
#pragma unroll
    for (int a = 0; a < 2; ++a)
#pragma unroll
        for (int b = 0; b < 2; ++b)
#pragma unroll
            for (int m = 0; m < 4; ++m)
#pragma unroll
                for (int n = 0; n < 2; ++n) acc[a][b][m][n] = (f32x4){0.f, 0.f, 0.f, 0.f};
    bf16x8 At[4][2], B0[2][2], B1[2][2];
    const char* cA = PG8_PA(cur); const char* cB = PG8_PB(cur);
    PG8_STAGE(PG8_SB(0, 0), cB, voffB); PG8_STAGE(PG8_SB(0, 1), cB + hB, voffB); PG8_STAGE(PG8_SA(0, 0), cA, voffA); PG8_STAGE(PG8_SA(0, 1), cA + hA, voffA);
    if (wr == 1) PG8_BAR;
    PG8_WAIT_V(2); PG8_BAR;
    PG8_STAGE(PG8_SB(1, 0), cB + kstep, voffB); PG8_STAGE(PG8_SA(1, 0), cA + kstep, voffA); PG8_STAGE(PG8_SB(1, 1), cB + hB + kstep, voffB);
    PG8_WAIT_V(6); PG8_BAR;
    for (;;) {
        const bool has_next = S.next(ui + 1, nxt);
        const char* nA = has_next ? PG8_PA(nxt) : cA; const char* nB = has_next ? PG8_PB(nxt) : cB;
        for (int t = 0; t < nt; t += 2) {
            const bool last = (t == nt - 2);
            const char* a1 = cA + (size_t)(t + 1) * kstep;
            const char* a2 = last ? nA : cA + (size_t)(t + 2) * kstep; const char* b2 = last ? nB : cB + (size_t)(t + 2) * kstep;
            const char* a3 = a2 + kstep; const char* b3 = b2 + kstep;
            PG8_LDB(B0, 0, 0); PG8_LDB(B1, 0, 1); PG8_SCHED; PG8_LDA(At, 0, 0); PG8_STAGE(PG8_SA(1, 1), a1 + hA, voffA);
            PG8_WAIT_V(8); PG8_WAIT_L(0); PG8_BAR; PG8_MMA(0, 0, At, B0); PG8_MMA(0, 1, At, B1); PG8_BAR; PG8_SCHED;
            PG8_LDA(At, 0, 1); PG8_STAGE(PG8_SB(0, 0), b2, voffB); PG8_STAGE(PG8_SB(0, 1), b2 + hB, voffB); PG8_STAGE(PG8_SA(0, 0), a2, voffA);
            PG8_WAIT_V(8); PG8_WAIT_L(0); PG8_BAR; PG8_MMA(1, 0, At, B0); PG8_MMA(1, 1, At, B1); PG8_BAR; PG8_SCHED;
            PG8_LDB(B0, 1, 0); PG8_LDB(B1, 1, 1); PG8_SCHED; PG8_LDA(At, 1, 0); PG8_STAGE(PG8_SA(0, 1), a2 + hA, voffA);
            PG8_WAIT_V(8); PG8_WAIT_L(0); PG8_BAR; PG8_MMA(0, 0, At, B0); PG8_MMA(0, 1, At, B1); PG8_BAR; PG8_SCHED;
            PG8_LDA(At, 1, 1); PG8_STAGE(PG8_SB(1, 0), b3, voffB); PG8_STAGE(PG8_SB(1, 1), b3 + hB, voffB); PG8_STAGE(PG8_SA(1, 0), a3, voffA);
            PG8_WAIT_V(8); PG8_WAIT_L(0); PG8_BAR; PG8_MMA(1, 0, At, B0); PG8_MMA(1, 1, At, B1); PG8_BAR; PG8_SCHED;
        }
        if (wr == 0) PG8_BAR;
        E(acc, cur, wr, wc, fr, fq);
        if (!has_next) break;
#pragma unroll
        for (int a = 0; a < 2; ++a)
#pragma unroll
            for (int b = 0; b < 2; ++b)
#pragma unroll
                for (int m = 0; m < 4; ++m)
#pragma unroll
                    for (int n = 0; n < 2; ++n) acc[a][b][m][n] = (f32x4){0.f, 0.f, 0.f, 0.f};
        cur = nxt; cA = nA; cB = nB; ++ui;
        if (wr == 1) PG8_BAR;
    }
    PG8_WAIT_V(0);
    PG8_BAR;
#undef PG8_SA
#undef PG8_SB
#undef PG8_STAGE
#undef PG8_LDA
#undef PG8_LDB
#undef PG8_MMA
#undef PG8_WAIT_V
#undef PG8_WAIT_L
#undef PG8_BAR
#undef PG8_SCHED
#undef PG8_PA
#undef PG8_PB
}
}

namespace attn_body {
using bf16 = __hip_bfloat16;
using s16x4 = __attribute__((ext_vector_type(4))) short;
using f32x16 = __attribute__((ext_vector_type(16))) float;
constexpr int NW = 8, QBLK = 32, QB = QBLK * NW, KVBLK = 64;
constexpr int MA = 0, MB = 1, MC = 2, MD = 3;
__device__ __forceinline__ int crow(int r, int hi) { return (r & 3) + 8 * (r >> 2) + 4 * hi; }
#define SBAR() __builtin_amdgcn_sched_barrier(0)
constexpr int NSLOT = 3, SLOTB = 8192;
constexpr int LDS_K = 0, LDS_V = NSLOT * SLOTB, LDS_WS = 2 * NSLOT * SLOTB, LDS_OST = LDS_WS + NW * 64 * 4, LDS_ATT = LDS_OST + NW * 4096;
typedef __attribute__((address_space(3))) const char* lds_cptr;
typedef __attribute__((address_space(3))) const float* lds_fptr;

struct AttnArgs {
    const bf16* Q; const bf16* K; const bf16* V; bf16* O;
    int qs, ks, os;
    int NT, tlo, thi;
    float s2;
    int q0;
    int kb;
    float* stat; int ss;
    lds_fptr tab;
};

__device__ __forceinline__ void glds16(const void* gsrc, unsigned lds_dst) { unsigned keep;
  asm volatile("s_mov_b32 %0, m0\n\ts_mov_b32 m0, %2\n\ts_nop 0\n\tglobal_load_lds_dwordx4 %1, off\n\ts_mov_b32 m0, %0" : "=&s"(keep) : "v"(gsrc), "s"(lds_dst) : "memory"); }
__device__ __forceinline__ float max3f(float a, float b, float c) { float r; asm("v_max3_f32 %0, %1, %2, %3" : "=v"(r) : "v"(a), "v"(b), "v"(c)); return r; }
__device__ __forceinline__ float max2f(float a, float b) { float r; asm("v_max_f32_e32 %0, %1, %2" : "=v"(r) : "v"(a), "v"(b)); return r; }
__device__ __forceinline__ float fadd_s(float a, float b) { float r; asm("v_add_f32_e32 %0, %1, %2" : "=v"(r) : "v"(a), "v"(b)); return r; }
__device__ __forceinline__ float fsub_s(float a, float b) { float r; asm("v_sub_f32_e32 %0, %1, %2" : "=v"(r) : "v"(a), "v"(b)); return r; }
typedef float f32x2_t __attribute__((ext_vector_type(2))); typedef __bf16 bf16x2_t __attribute__((ext_vector_type(2)));
__device__ __forceinline__ unsigned cvtpk_s(float lo, float hi) { f32x2_t v = {lo, hi}; bf16x2_t b = __builtin_convertvector(v, bf16x2_t); return __builtin_bit_cast(unsigned, b); }
#define WAIT_BAR(N) asm volatile("s_waitcnt vmcnt(" #N ") lgkmcnt(0)\n\ts_barrier" ::: "memory")

__device__ __forceinline__ void qkt(f32x16& p0, f32x16& p1, const char* Kslot, const bf16x8* qr, const f32x16& negm, int r32, int hi) {
  const char* kb = Kslot + hi * 1024 + r32 * 16;
  #pragma unroll
  for (int d0 = 0; d0 < 4; ++d0) {
    const bf16x8 b0 = *reinterpret_cast<const bf16x8*>(kb + d0 * 2048);
    const bf16x8 b1 = *reinterpret_cast<const bf16x8*>(kb + d0 * 2048 + 512);
    if (d0 == 0) { p0 = __builtin_amdgcn_mfma_f32_32x32x16_bf16(b0, qr[0], negm, 0, 0, 0); p1 = __builtin_amdgcn_mfma_f32_32x32x16_bf16(b1, qr[0], negm, 0, 0, 0); }
    else { p0 = __builtin_amdgcn_mfma_f32_32x32x16_bf16(b0, qr[d0], p0, 0, 0, 0); p1 = __builtin_amdgcn_mfma_f32_32x32x16_bf16(b1, qr[d0], p1, 0, 0, 0); } }
}
typedef short v4i16_t __attribute__((ext_vector_type(4)));
__device__ __forceinline__ void kload8(bf16x8* kf, lds_cptr kp) {
  kf[0] = *(const LAS bf16x8*)(kp);        kf[1] = *(const LAS bf16x8*)(kp + 512);
  kf[2] = *(const LAS bf16x8*)(kp + 2048); kf[3] = *(const LAS bf16x8*)(kp + 2560);
  kf[4] = *(const LAS bf16x8*)(kp + 4096); kf[5] = *(const LAS bf16x8*)(kp + 4608);
  kf[6] = *(const LAS bf16x8*)(kp + 6144); kf[7] = *(const LAS bf16x8*)(kp + 6656);
}
__device__ __forceinline__ void kload2(bf16x8* kf, lds_cptr kp, int j) { kf[2 * j] = *(const LAS bf16x8*)(kp + j * 2048); kf[2 * j + 1] = *(const LAS bf16x8*)(kp + j * 2048 + 512); }
__device__ __forceinline__ s16x4 vtr(lds_cptr p) { return __builtin_bit_cast(s16x4, __builtin_amdgcn_ds_read_tr16_b64_v4i16((LAS v4i16_t*)p)); }
__device__ __forceinline__ float rowmax(const f32x16& p0, const f32x16& p1) {
  float a = max3f(p0[0], p0[1], p1[0]), b = max3f(p0[2], p0[3], p1[1]); a = max3f(a, p1[2], p1[3]);
  #pragma unroll
  for (int r = 4; r < 16; r += 4) { a = max3f(a, p0[r], p0[r + 1]); b = max3f(b, p0[r + 2], p0[r + 3]); a = max3f(a, p1[r], p1[r + 1]); b = max3f(b, p1[r + 2], p1[r + 3]); }
  const float m = max2f(a, b);
  auto rr = __builtin_amdgcn_permlane32_swap(__float_as_uint(m), __float_as_uint(m), false, false);
  return max2f(__uint_as_float(rr[0]), __uint_as_float(rr[1]));
}
__device__ __forceinline__ void pv(f32x16* o, int vb, bf16x8 pa0, bf16x8 pa1, bf16x8 pa2, bf16x8 pa3) {
  #pragma unroll
  for (int d0 = 0; d0 < 2; ++d0) { s16x4 lo[4], hi[4];
    #pragma unroll
    for (int ks = 0; ks < 4; ++ks) {
      asm volatile("ds_read_b64_tr_b16 %0,%1 offset:%c2" : "=&v"(lo[ks]) : "v"(vb), "i"(d0 * 4096 + ks * 1024) : "memory");
      asm volatile("ds_read_b64_tr_b16 %0,%1 offset:%c2" : "=&v"(hi[ks]) : "v"(vb), "i"(d0 * 4096 + ks * 1024 + 512) : "memory"); }
    asm volatile("s_waitcnt lgkmcnt(0)" ::: "memory"); SBAR();
    #define PK(k) (bf16x8){lo[k][0], lo[k][1], lo[k][2], lo[k][3], hi[k][0], hi[k][1], hi[k][2], hi[k][3]}
    o[d0] = __builtin_amdgcn_mfma_f32_32x32x16_bf16(pa0, PK(0), o[d0], 0, 0, 0);
    o[d0] = __builtin_amdgcn_mfma_f32_32x32x16_bf16(pa1, PK(1), o[d0], 0, 0, 0);
    o[d0] = __builtin_amdgcn_mfma_f32_32x32x16_bf16(pa2, PK(2), o[d0], 0, 0, 0);
    o[d0] = __builtin_amdgcn_mfma_f32_32x32x16_bf16(pa3, PK(3), o[d0], 0, 0, 0);
    #undef PK
  }
}

template <int MODE> __device__ __forceinline__ void score_hook(f32x16& c0, f32x16& c1, int t, const AttnArgs& a, int qrel, int hi, int wid, int r32, float mh) {
  if constexpr (MODE == MA) {
    const int wlo = a.q0 + wid * QBLK, sd = (64 * t + 63 < wlo) ? 1 : ((64 * t > wlo + 31) ? -1 : 0);
    if (sd != 0) { const float sv = (float)sd * a.s2;
      #pragma unroll
      for (int r = 0; r < 16; ++r) { const float kf = (float)((r & 3) + 8 * (r >> 2)); c0[r] = fmaf(kf, sv, c0[r]); c1[r] = fmaf(kf + 32.f, sv, c1[r]); if ((r & 3) == 3) __builtin_amdgcn_sched_barrier(0); }
    } else {
      const float dq = (float)(a.q0 + qrel - 64 * t - 4 * hi), ns = -a.s2;
      #pragma unroll
      for (int r = 0; r < 16; ++r) { const float kf = (float)((r & 3) + 8 * (r >> 2)); c0[r] = fmaf(ns, fabsf(dq - kf), c0[r]); c1[r] = fmaf(ns, fabsf(dq - (kf + 32.f)), c1[r]); if ((r & 1) == 1) __builtin_amdgcn_sched_barrier(0); }
    }
  }
  if constexpr (MODE == MB) {
    const bool tv = (t >= a.tlo) && (t <= a.thi);
    const float dq = (float)(qrel + 64 - 64 * t - 4 * hi), ns = -a.s2;
    #pragma unroll
    for (int r = 0; r < 16; ++r) { const float kf = (float)((r & 3) + 8 * (r >> 2)); const float d0 = fabsf(dq - kf), d1 = fabsf(dq - (kf + 32.f));
      c0[r] = (tv && d0 <= 64.f) ? fmaf(ns, d0, c0[r] - mh) : -INFINITY; c1[r] = (tv && d1 <= 64.f) ? fmaf(ns, d1, c1[r] - mh) : -INFINITY;
      if ((r & 3) == 3) __builtin_amdgcn_sched_barrier(0); }
  }
  if constexpr (MODE == MC) {
    const int qrow = a.q0 + (wid >> 1), rs = min(max(qrow - 4, 0), 120), krow = a.kb + t;
    if (krow < rs || krow >= rs + 8) {
      #pragma unroll
      for (int r = 0; r < 16; ++r) { c0[r] = -INFINITY; c1[r] = -INFINITY; }
    } else {
      const int qc = (wid & 1) * 32 + r32, cs = min(max(qc - 8, 0), 48);
      const lds_fptr tp = a.tab + (krow - qrow + 7) * 31 + (15 - qc + 4 * hi);
      const int kd = 4 * hi - cs;
      #pragma unroll
      for (int r = 0; r < 16; ++r) { const int kc = (r & 3) + 8 * (r >> 2);
        const float b0 = tp[kc], b1 = tp[kc + 32];
        c0[r] = ((unsigned)(kd + kc) < 16u) ? c0[r] + (b0 - mh) : -INFINITY; c1[r] = ((unsigned)(kd + kc + 32) < 16u) ? c1[r] + (b1 - mh) : -INFINITY;
        if ((r & 3) == 3) __builtin_amdgcn_sched_barrier(0); }
    }
  }
}

template <int MODE, int THRL> __device__ __forceinline__ void attn_unit(const AttnArgs& A_, char* shm) {
  int tid_ = threadIdx.x; asm volatile("" : "+v"(tid_));
  const int tid = tid_, lane = tid & 63, r32 = lane & 31, hi = lane >> 5; const int wid = __builtin_amdgcn_readfirstlane(tid >> 6);
  const bf16* Qw = A_.Q + (wid * QBLK) * A_.qs;
  const unsigned lds0 = (unsigned)(uintptr_t)shm;
  float* wsf = (float*)(shm + LDS_WS) + wid * 64;
  const int ks = A_.ks;
  const bf16* ksrc = A_.K + (lane * ks + wid * 8);
  const bf16* vsrc = A_.V + ((16 * (wid & 3) + (lane >> 2)) * ks + (wid >> 2) * 32 + (lane & 3) * 8);
  const unsigned kdst = lds0 + LDS_K + wid * 1024, vdst = lds0 + LDS_V + wid * 1024;
  #define TT(t) ((MODE == MB) ? min(max((int)(t), A_.tlo), A_.thi) : (int)(t))
  #define DMA_K(t, slot) glds16(ksrc + TT(t) * KVBLK * ks, (unsigned)__builtin_amdgcn_readfirstlane(kdst + (slot)))
  #define DMA_V(t, slot) glds16(vsrc + TT(t) * KVBLK * ks, (unsigned)__builtin_amdgcn_readfirstlane(vdst + (slot)))
  const int vb0 = (int)(lds0 + LDS_V) + ((lane >> 4) & 1) * 32 + (lane & 3) * 8 + (4 * hi + ((lane & 15) >> 2)) * 64;
  const char* Kbase = shm + LDS_K; bf16x8 kf[8];
  const lds_cptr shm3 = (lds_cptr)shm; const lds_cptr kp0 = shm3 + LDS_K + hi * 1024 + r32 * 16; const lds_cptr vp0 = shm3 + LDS_V + ((lane >> 4) & 1) * 32 + (lane & 3) * 8 + (4 * hi + ((lane & 15) >> 2)) * 64;
  const int NT = A_.NT;
  DMA_K(0, 0); DMA_V(0, 0); DMA_K(1, SLOTB);
  bf16x8 qr[4];
  #pragma unroll
  for (int d0 = 0; d0 < 4; ++d0) qr[d0] = *reinterpret_cast<const bf16x8*>(&Qw[r32 * A_.qs + d0 * 16 + hi * 8]);
  float mhat = 0.f, l_reg = 0.f; f32x16 o[2]; o[0] = f32x16{}; o[1] = f32x16{}; f32x16 negm = f32x16{}; asm volatile("" : "+v"(negm));
  const int qrel = wid * QBLK + r32;
  constexpr bool NEGM = (MODE == MA || MODE == MD);
  #define CIN (NEGM ? negm : f32x16{})
  #define NEGM_SET(tn) do { float nb_ = -mhat; \
      if (MODE == MA) { const int wlo_ = A_.q0 + wid * QBLK, sd_ = (64 * (tn) + 63 < wlo_) ? 1 : ((64 * (tn) > wlo_ + 31) ? -1 : 0); \
        if (sd_ != 0) nb_ = fmaf(-(float)sd_ * A_.s2, (float)(A_.q0 + qrel - 64 * (tn) - 4 * hi), nb_); } \
      _Pragma("unroll") for (int r = 0; r < 16; ++r) negm[r] = nb_; asm volatile("" : "+v"(negm)); } while (0)
  #define CMASK(P0, P1, t) score_hook<MODE>(P0, P1, (t), A_, qrel, hi, wid, r32, mhat)
  bool resc = false;
  #define START(P0, P1) do { const float rm = rowmax(P0, P1); resc = false; \
    { const float dl = (MODE == MB || MODE == MC) ? fmaxf(rm, -2048.f) : rm; mhat = fadd_s(mhat, dl); \
      _Pragma("unroll") for (int r = 0; r < 16; ++r) { P0[r] = fsub_s(P0[r], dl); P1[r] = fsub_s(P1[r], dl); } \
      if (NEGM) { NEGM_SET(1); } } \
    _Pragma("unroll") for (int r = 0; r < 16; ++r) P0[r] = __builtin_amdgcn_exp2f(P0[r]); } while (0)
  #define RESC() do { if (resc) { asm volatile("s_waitcnt lgkmcnt(0)" ::: "memory"); \
      _Pragma("unroll") for (int d_ = 0; d_ < 2; ++d_) _Pragma("unroll") for (int r = 0; r < 16; ++r) o[d_][r] *= wsf[crow(r, hi)]; } } while (0)
  f32x16 pA0, pA1, pB0, pB1;
  int sl_prev = 0, sl_cur = 0, sl_next = SLOTB;
  #define ROT() do { sl_prev = sl_cur; sl_cur = sl_next; sl_next = (sl_next == (NSLOT - 1) * SLOTB) ? 0 : sl_next + SLOTB; } while (0)
  DMA_K(2, 2 * SLOTB);
  if (MODE == MA) { NEGM_SET(0); }
  WAIT_BAR(3);
  qkt(pA0, pA1, Kbase, qr, negm, r32, hi); asm volatile("s_nop 15\n\ts_nop 7" : "+v"(pA0), "+v"(pA1)); CMASK(pA0, pA1, 0);
  START(pA0, pA1);
  _Pragma("unroll") for (int r = 0; r < 16; ++r) pA1[r] = __builtin_amdgcn_exp2f(pA1[r]);
  WAIT_BAR(0);
  DMA_K(3, 0); DMA_V(1, SLOTB);
  ROT();
  kload8(kf, kp0 + sl_cur);
  WAIT_BAR(2);
  s16x4 vlo[8], vhi[8]; u32x4 pw0, pw1, pw2, pw3;
  #define PKW(P, B) cvtpk_s(P[B], P[B + 1])
  #define PAF(k) __builtin_bit_cast(bf16x8, pw##k)
  #define VFR(i) (bf16x8){vlo[i][0], vlo[i][1], vlo[i][2], vlo[i][3], vhi[i][0], vhi[i][1], vhi[i][2], vhi[i][3]}
  #define PIN(x) asm volatile("" : "+v"(x))
  #define MX3(a, b, c) __builtin_fmaxf(__builtin_fmaxf((a), (b)), (c))
  #define GAPA(MF, A0, A1, A2, A3, W0, W1, PW) do { MF; sacc += A0; sacc += A1; sacc += A2; sacc += A3; PIN(sacc); W0; W1; PIN(PW); SBAR(); } while (0)
  #define EX(v) __builtin_amdgcn_exp2f(v)
  #define GAPB(MF, X, B) do { MF; X[B] = EX(X[B]); X[B + 1] = EX(X[B + 1]); X[B + 2] = EX(X[B + 2]); X[B + 3] = EX(X[B + 3]); PIN(X); SBAR(); } while (0)
  #define VRD(i) do { vlo[i] = vtr(vp_ + (((i) >> 2) * 4096 + ((i) & 3) * 1024)); vhi[i] = vtr(vp_ + (((i) >> 2) * 4096 + ((i) & 3) * 1024 + 512)); } while (0)
  #define KRD(G, j) do { if (G) { kload2(kf, kp0 + sl_next, j); SBAR(); } } while (0)
  #define STEP(C0, C1, P0, P1, t, GK, GV, GL) do { SBAR(); \
    const lds_cptr vp_ = vp0 + sl_prev; \
    VRD(0); SBAR(); float sacc = (P0[0] + P0[1]); \
    GAPA(C0 = __builtin_amdgcn_mfma_f32_32x32x16_bf16(kf[0], qr[0], CIN, 0, 0, 0), P0[2], P0[3], P0[4], P0[5],     pw0[0] = PKW(P0, 0), pw0[1] = PKW(P0, 2), pw0); \
    VRD(4); SBAR(); GAPA(C1 = __builtin_amdgcn_mfma_f32_32x32x16_bf16(kf[1], qr[0], CIN, 0, 0, 0), P0[6], P0[7], P0[8], P0[9],     pw0[2] = PKW(P0, 4), pw0[3] = PKW(P0, 6), pw0); \
    VRD(1); SBAR(); GAPA(C0 = __builtin_amdgcn_mfma_f32_32x32x16_bf16(kf[2], qr[1], C0, 0, 0, 0),   P0[10], P0[11], P0[12], P0[13], pw1[0] = PKW(P0, 8), pw1[1] = PKW(P0, 10), pw1); \
    VRD(5); SBAR(); GAPA(C1 = __builtin_amdgcn_mfma_f32_32x32x16_bf16(kf[3], qr[1], C1, 0, 0, 0),   P0[14], P0[15], P1[0], P1[1],   pw1[2] = PKW(P0, 12), pw1[3] = PKW(P0, 14), pw1); \
    VRD(2); SBAR(); GAPA(C0 = __builtin_amdgcn_mfma_f32_32x32x16_bf16(kf[4], qr[2], C0, 0, 0, 0),   P1[2], P1[3], P1[4], P1[5],     pw2[0] = PKW(P1, 0), pw2[1] = PKW(P1, 2), pw2); \
    VRD(6); SBAR(); GAPA(C1 = __builtin_amdgcn_mfma_f32_32x32x16_bf16(kf[5], qr[2], C1, 0, 0, 0),   P1[6], P1[7], P1[8], P1[9],     pw2[2] = PKW(P1, 4), pw2[3] = PKW(P1, 6), pw2); \
    VRD(3); SBAR(); GAPA(C0 = __builtin_amdgcn_mfma_f32_32x32x16_bf16(kf[6], qr[3], C0, 0, 0, 0),   P1[10], P1[11], P1[12], P1[13], pw3[0] = PKW(P1, 8), pw3[1] = PKW(P1, 10), pw3); \
    VRD(7); SBAR(); GAPA(C1 = __builtin_amdgcn_mfma_f32_32x32x16_bf16(kf[7], qr[3], C1, 0, 0, 0),   P1[14], P1[15], 0.f, 0.f,       pw3[2] = PKW(P1, 12), pw3[3] = PKW(P1, 14), pw3); \
    l_reg += sacc; \
    if (GK) { DMA_K((t) + 3, sl_cur); } if (GV) { DMA_V((t) + 1, sl_next); } \
    CMASK(C0, C1, t); \
    { float a = MX3(C0[0], C0[1], C1[0]), b = MX3(C0[2], C0[3], C1[1]); a = MX3(a, C1[2], C1[3]); \
      _Pragma("unroll") for (int r = 4; r < 16; r += 4) { a = MX3(a, C0[r], C0[r + 1]); b = MX3(b, C0[r + 2], C0[r + 3]); a = MX3(a, C1[r], C1[r + 1]); b = MX3(b, C1[r + 2], C1[r + 3]); } \
      float rm = __builtin_fmaxf(a, b); { auto rr = __builtin_amdgcn_permlane32_swap(__float_as_uint(rm), __float_as_uint(rm), false, false); rm = __builtin_fmaxf(__uint_as_float(rr[0]), __uint_as_float(rr[1])); } \
      resc = false; \
      if (__builtin_expect(__any(rm > (float)THRL), 0)) { const float dl = __builtin_fmaxf(rm, 0.f); mhat += dl; \
        _Pragma("unroll") for (int r = 0; r < 16; ++r) { C0[r] -= dl; C1[r] -= dl; } \
        if (MODE == MD) { NEGM_SET(0); } \
        const float f = __builtin_amdgcn_exp2f(-dl); l_reg *= f; if (hi == 0) wsf[r32] = f; resc = true; } \
      if (MODE == MA) { NEGM_SET((t) + 1); } } \
    SBAR(); \
    GAPB(o[0] = __builtin_amdgcn_mfma_f32_32x32x16_bf16(PAF(0), VFR(0), o[0], 0, 0, 0), C0, 0); \
    GAPB(o[1] = __builtin_amdgcn_mfma_f32_32x32x16_bf16(PAF(0), VFR(4), o[1], 0, 0, 0), C0, 4); \
    KRD(GL, 0); GAPB(o[0] = __builtin_amdgcn_mfma_f32_32x32x16_bf16(PAF(1), VFR(1), o[0], 0, 0, 0), C0, 8); \
    KRD(GL, 1); GAPB(o[1] = __builtin_amdgcn_mfma_f32_32x32x16_bf16(PAF(1), VFR(5), o[1], 0, 0, 0), C0, 12); \
    KRD(GL, 2); GAPB(o[0] = __builtin_amdgcn_mfma_f32_32x32x16_bf16(PAF(2), VFR(2), o[0], 0, 0, 0), C1, 0); \
    KRD(GL, 3); GAPB(o[1] = __builtin_amdgcn_mfma_f32_32x32x16_bf16(PAF(2), VFR(6), o[1], 0, 0, 0), C1, 4); \
    GAPB(o[0] = __builtin_amdgcn_mfma_f32_32x32x16_bf16(PAF(3), VFR(3), o[0], 0, 0, 0), C1, 8); \
    GAPB(o[1] = __builtin_amdgcn_mfma_f32_32x32x16_bf16(PAF(3), VFR(7), o[1], 0, 0, 0), C1, 12); \
    } while (0)
  int t = 1;
  for (; t + 5 < NT; t += 2) {
    STEP(pB0, pB1, pA0, pA1, t, true, true, true);     WAIT_BAR(2); RESC(); ROT();
    STEP(pA0, pA1, pB0, pB1, t + 1, true, true, true); WAIT_BAR(2); RESC(); ROT();
  }
  #define ENDW(tt) do { if ((tt) + 3 < NT) { WAIT_BAR(2); } else if ((tt) + 2 < NT) { WAIT_BAR(1); } else { WAIT_BAR(0); } } while (0)
  for (; t + 1 < NT; t += 2) {
    STEP(pB0, pB1, pA0, pA1, t, (t + 3 < NT), (t + 1 < NT), (t + 1 < NT));         ENDW(t);     RESC(); ROT();
    STEP(pA0, pA1, pB0, pB1, t + 1, (t + 4 < NT), (t + 2 < NT), (t + 2 < NT));     ENDW(t + 1); RESC(); ROT();
  }
  STEP(pB0, pB1, pA0, pA1, NT - 1, false, false, false); RESC();
  { float sacc = pB0[0] + pB0[1]; _Pragma("unroll") for (int r = 2; r < 16; ++r) sacc += pB0[r]; _Pragma("unroll") for (int r = 0; r < 16; ++r) sacc += pB1[r]; l_reg += sacc;
    pw0 = (u32x4){PKW(pB0, 0), PKW(pB0, 2), PKW(pB0, 4), PKW(pB0, 6)}; pw1 = (u32x4){PKW(pB0, 8), PKW(pB0, 10), PKW(pB0, 12), PKW(pB0, 14)}; pw2 = (u32x4){PKW(pB1, 0), PKW(pB1, 2), PKW(pB1, 4), PKW(pB1, 6)}; pw3 = (u32x4){PKW(pB1, 8), PKW(pB1, 10), PKW(pB1, 12), PKW(pB1, 14)};
    SBAR(); pv(o, vb0 + sl_cur, PAF(0), PAF(1), PAF(2), PAF(3)); }
  #undef PKW
  #undef PAF
  #undef VFR
  #undef PIN
  #undef MX3
  #undef GAPA
  #undef GAPB
  #undef EX
  #undef VRD
  #undef KRD
  #undef STEP
  #undef ENDW
  { auto rr = __builtin_amdgcn_permlane32_swap(__float_as_uint(l_reg), __float_as_uint(l_reg), false, false); l_reg = __uint_as_float(rr[0]) + __uint_as_float(rr[1]); }
  if (MODE == MB) { if (hi == 0) { float* sp = A_.stat + (wid * QBLK + r32) * A_.ss; sp[0] = mhat; sp[1] = l_reg; } }
  if (hi == 0) wsf[32 + r32] = l_reg; asm volatile("s_waitcnt lgkmcnt(0)" ::: "memory");
  float rli[16];
  #pragma unroll
  for (int r = 0; r < 16; ++r) rli[r] = __builtin_amdgcn_rcpf(wsf[32 + crow(r, hi)]);
  bf16* Ow = A_.O + (wid * QBLK) * A_.os;
  { bf16* stg = (bf16*)(shm + LDS_OST) + wid * 2048;
    #pragma unroll
    for (int r = 0; r < 16; ++r) { const int orow = crow(r, hi);
      #pragma unroll
      for (int d0 = 0; d0 < 2; ++d0) stg[orow * 64 + d0 * 32 + r32] = __float2bfloat16(o[d0][r] * rli[r]); }
    asm volatile("s_waitcnt lgkmcnt(0)" ::: "memory");
    #pragma unroll
    for (int i = 0; i < 4; ++i) { const int row = i * 8 + (lane >> 3), ch = lane & 7; const u32x4 v = *(const u32x4*)(stg + row * 64 + ch * 8); *(u32x4*)(Ow + row * A_.os + ch * 8) = v; } }
  asm volatile("s_waitcnt lgkmcnt(0)\n\ts_barrier" ::: "memory");
  #undef DMA_K
  #undef DMA_V
  #undef TT
  #undef CMASK
  #undef CIN
  #undef NEGM_SET
  #undef START
  #undef RESC
  #undef ROT
}

constexpr int L8_K = 0, L8_V = 3 * 8192, L8_WS = L8_V + 3 * 16384, L8_QO = L8_WS + 2048, L8_END = L8_QO + 8 * 4096;
template <int THRL> __device__ __forceinline__ void attn_unit128(const AttnArgs& A_, char* shm) {
  int tid_ = threadIdx.x; asm volatile("" : "+v"(tid_));
  const int tid = tid_, lane = tid & 63, r32 = lane & 31, hi = lane >> 5; const int wid = __builtin_amdgcn_readfirstlane(tid >> 6);
  const bf16* Qw = A_.Q + (wid * QBLK) * A_.qs;
  const unsigned lds0 = (unsigned)(uintptr_t)shm;
  float* wsf = (float*)(shm + L8_WS) + wid * 64;
  const int ks = A_.ks;
  const bf16* ksrc = A_.K + (lane * ks + wid * 8);
  const bf16* vsrc = A_.V + ((16 * (wid & 3) + (lane >> 2)) * ks + (wid >> 2) * 32 + (lane & 3) * 8);
  const unsigned kdst = lds0 + L8_K + wid * 1024, vdst = lds0 + L8_V + wid * 1024;
  #define DMA_K(t, slot) glds16(ksrc + (int)(t) * KVBLK * ks, (unsigned)__builtin_amdgcn_readfirstlane(kdst + (slot)))
  #define DMA_V(t, slot) do { glds16(vsrc + (int)(t) * KVBLK * ks, (unsigned)__builtin_amdgcn_readfirstlane(vdst + 2 * (slot))); \
                              glds16(vsrc + (int)(t) * KVBLK * ks + 64, (unsigned)__builtin_amdgcn_readfirstlane(vdst + 2 * (slot) + 8192)); } while (0)
  const int vb0 = (int)(lds0 + L8_V) + ((lane >> 4) & 1) * 32 + (lane & 3) * 8 + (4 * hi + ((lane & 15) >> 2)) * 64;
  const char* Kbase = shm + L8_K; bf16x8 kf[8];
  const lds_cptr shm3 = (lds_cptr)shm; const lds_cptr kp0 = shm3 + L8_K + hi * 1024 + r32 * 16; const lds_cptr vp0 = shm3 + L8_V + ((lane >> 4) & 1) * 32 + (lane & 3) * 8 + (4 * hi + ((lane & 15) >> 2)) * 64;
  const lds_cptr qst = shm3 + L8_QO + wid * 4096 + lane * 16;
  const int NT = A_.NT;
  DMA_K(0, 0); DMA_V(0, 0); DMA_K(1, SLOTB);
  { bf16x8 qr[4];
    #pragma unroll
    for (int d0 = 0; d0 < 4; ++d0) qr[d0] = *reinterpret_cast<const bf16x8*>(&Qw[r32 * A_.qs + d0 * 16 + hi * 8]);
    #pragma unroll
    for (int d0 = 0; d0 < 4; ++d0) *(LAS bf16x8*)(shm3 + L8_QO + wid * 4096 + lane * 16 + d0 * 1024) = qr[d0]; }
  #define QLD(d0) (*(const LAS bf16x8*)(qst + (d0) * 1024))
  float mhat = 0.f, l_reg = 0.f; f32x16 o[4]; o[0] = f32x16{}; o[1] = f32x16{}; o[2] = f32x16{}; o[3] = f32x16{};
  const int qrel = wid * QBLK + r32;
  #define NB(tn) ({ float nb_ = -mhat; const int wlo_ = A_.q0 + wid * QBLK, sd_ = (64 * (tn) + 63 < wlo_) ? 1 : ((64 * (tn) > wlo_ + 31) ? -1 : 0); \
      if (sd_ != 0) nb_ = fmaf(-(float)sd_ * A_.s2, (float)(A_.q0 + qrel - 64 * (tn) - 4 * hi), nb_); nb_; })
  #define CMASK(P0, P1, t) score_hook<MA>(P0, P1, (t), A_, qrel, hi, wid, r32, mhat)
  bool resc = false;
  #define RESC() do { if (resc) { asm volatile("s_waitcnt lgkmcnt(0)" ::: "memory"); \
      _Pragma("unroll") for (int d_ = 0; d_ < 4; ++d_) _Pragma("unroll") for (int r = 0; r < 16; ++r) o[d_][r] *= wsf[crow(r, hi)]; } } while (0)
  f32x16 pA0, pA1, pB0, pB1;
  int sl_prev = 0, sl_cur = 0, sl_next = SLOTB;
  #define ROT() do { sl_prev = sl_cur; sl_cur = sl_next; sl_next = (sl_next == (NSLOT - 1) * SLOTB) ? 0 : sl_next + SLOTB; } while (0)
  DMA_K(2, 2 * SLOTB);
  WAIT_BAR(4);
  { f32x16 cin; const float nb0 = NB(0);
    #pragma unroll
    for (int r = 0; r < 16; ++r) cin[r] = nb0;
    bf16x8 qr[4];
    #pragma unroll
    for (int d0 = 0; d0 < 4; ++d0) qr[d0] = QLD(d0);
    qkt(pA0, pA1, Kbase, qr, cin, r32, hi); }
  asm volatile("s_nop 15\n\ts_nop 7" : "+v"(pA0), "+v"(pA1)); CMASK(pA0, pA1, 0);
  { const float rm = rowmax(pA0, pA1); mhat = fadd_s(mhat, rm);
    #pragma unroll
    for (int r = 0; r < 16; ++r) { pA0[r] = fsub_s(pA0[r], rm); pA1[r] = fsub_s(pA1[r], rm); }
    #pragma unroll
    for (int r = 0; r < 16; ++r) pA0[r] = __builtin_amdgcn_exp2f(pA0[r]);
    #pragma unroll
    for (int r = 0; r < 16; ++r) pA1[r] = __builtin_amdgcn_exp2f(pA1[r]); }
  WAIT_BAR(0);
  DMA_K(3, 0); DMA_V(1, SLOTB);
  ROT();
  kload8(kf, kp0 + sl_cur);
  WAIT_BAR(3);
  u32x4 pw0, pw1, pw2, pw3;
  #define PKW(P, B) cvtpk_s(P[B], P[B + 1])
  #define PAF(k) __builtin_bit_cast(bf16x8, pw##k)
  #define VFR(i) (bf16x8){vlo[i][0], vlo[i][1], vlo[i][2], vlo[i][3], vhi[i][0], vhi[i][1], vhi[i][2], vhi[i][3]}
  #define WFR(i) (bf16x8){wlo[i][0], wlo[i][1], wlo[i][2], wlo[i][3], whi[i][0], whi[i][1], whi[i][2], whi[i][3]}
  #define PIN(x) asm volatile("" : "+v"(x))
  #define MX3(a, b, c) __builtin_fmaxf(__builtin_fmaxf((a), (b)), (c))
  #define GAPA(MF, A0, A1, A2, A3, W0, W1, PW) do { MF; sacc += A0; sacc += A1; sacc += A2; sacc += A3; PIN(sacc); W0; W1; PIN(PW); SBAR(); } while (0)
  #define EX(v) __builtin_amdgcn_exp2f(v)
  #define GAPB(MF, X, B) do { MF; X[B] = EX(X[B]); X[B + 1] = EX(X[B + 1]); PIN(X); SBAR(); } while (0)
  #define VRD(i) do { vlo[i] = vtr(vp_ + (((i) >> 2) * 4096 + ((i) & 3) * 1024)); vhi[i] = vtr(vp_ + (((i) >> 2) * 4096 + ((i) & 3) * 1024 + 512)); } while (0)
  #define VRD2(i) do { wlo[i] = vtr(vp_ + (8192 + ((i) >> 2) * 4096 + ((i) & 3) * 1024)); whi[i] = vtr(vp_ + (8192 + ((i) >> 2) * 4096 + ((i) & 3) * 1024 + 512)); SBAR(); } while (0)
  #define KRD(G, j) do { if (G) { kload2(kf, kp0 + sl_next, j); SBAR(); } } while (0)
  #define FOFF(j) (((((j) & 1) + 2 * ((j) >> 3)) * 4096) + ((((j) >> 1) & 3) * 1024))
  #define FRD(j) do { fl[j] = vtr(vp_ + FOFF(j)); fh[j] = vtr(vp_ + FOFF(j) + 512); SBAR(); } while (0)
  #define FFR(j) (bf16x8){fl[j][0], fl[j][1], fl[j][2], fl[j][3], fh[j][0], fh[j][1], fh[j][2], fh[j][3]}
  #define STEP(C0, C1, P0, P1, t, GK, GV, GL) do { SBAR(); \
    const lds_cptr vp_ = vp0 + 2 * sl_prev; s16x4 fl[16], fh[16]; \
    { const float nb_t = NB(t); _Pragma("unroll") for (int r = 0; r < 16; ++r) { C0[r] = nb_t; C1[r] = nb_t; } } \
    bf16x8 q0_ = QLD(0), q1_ = QLD(1); SBAR(); float sacc = (P0[0] + P0[1]); \
    GAPA(C0 = __builtin_amdgcn_mfma_f32_32x32x16_bf16(kf[0], q0_, C0, 0, 0, 0), P0[2], P0[3], P0[4], P0[5],     pw0[0] = PKW(P0, 0), pw0[1] = PKW(P0, 2), pw0); \
    GAPA(C1 = __builtin_amdgcn_mfma_f32_32x32x16_bf16(kf[1], q0_, C1, 0, 0, 0), P0[6], P0[7], P0[8], P0[9],     pw0[2] = PKW(P0, 4), pw0[3] = PKW(P0, 6), pw0); \
    q0_ = QLD(2); SBAR(); \
    GAPA(C0 = __builtin_amdgcn_mfma_f32_32x32x16_bf16(kf[2], q1_, C0, 0, 0, 0),   P0[10], P0[11], P0[12], P0[13], pw1[0] = PKW(P0, 8), pw1[1] = PKW(P0, 10), pw1); \
    GAPA(C1 = __builtin_amdgcn_mfma_f32_32x32x16_bf16(kf[3], q1_, C1, 0, 0, 0),   P0[14], P0[15], P1[0], P1[1],   pw1[2] = PKW(P0, 12), pw1[3] = PKW(P0, 14), pw1); \
    q1_ = QLD(3); SBAR(); \
    GAPA(C0 = __builtin_amdgcn_mfma_f32_32x32x16_bf16(kf[4], q0_, C0, 0, 0, 0),   P1[2], P1[3], P1[4], P1[5],     pw2[0] = PKW(P1, 0), pw2[1] = PKW(P1, 2), pw2); \
    GAPA(C1 = __builtin_amdgcn_mfma_f32_32x32x16_bf16(kf[5], q0_, C1, 0, 0, 0),   P1[6], P1[7], P1[8], P1[9],     pw2[2] = PKW(P1, 4), pw2[3] = PKW(P1, 6), pw2); \
    GAPA(C0 = __builtin_amdgcn_mfma_f32_32x32x16_bf16(kf[6], q1_, C0, 0, 0, 0),   P1[10], P1[11], P1[12], P1[13], pw3[0] = PKW(P1, 8), pw3[1] = PKW(P1, 10), pw3); \
    GAPA(C1 = __builtin_amdgcn_mfma_f32_32x32x16_bf16(kf[7], q1_, C1, 0, 0, 0),   P1[14], P1[15], 0.f, 0.f,       pw3[2] = PKW(P1, 12), pw3[3] = PKW(P1, 14), pw3); \
    l_reg += sacc; \
    if (GK) { DMA_K((t) + 3, sl_cur); } if (GV) { DMA_V((t) + 1, sl_next); } \
    FRD(0); FRD(1); FRD(2); \
    CMASK(C0, C1, t); \
    { float a = MX3(C0[0], C0[1], C1[0]), b = MX3(C0[2], C0[3], C1[1]); a = MX3(a, C1[2], C1[3]); \
      _Pragma("unroll") for (int r = 4; r < 16; r += 4) { a = MX3(a, C0[r], C0[r + 1]); b = MX3(b, C0[r + 2], C0[r + 3]); a = MX3(a, C1[r], C1[r + 1]); b = MX3(b, C1[r + 2], C1[r + 3]); } \
      float rm = __builtin_fmaxf(a, b); { auto rr = __builtin_amdgcn_permlane32_swap(__float_as_uint(rm), __float_as_uint(rm), false, false); rm = __builtin_fmaxf(__uint_as_float(rr[0]), __uint_as_float(rr[1])); } \
      resc = false; \
      if (__builtin_expect(__any(rm > (float)THRL), 0)) { const float dl = __builtin_fmaxf(rm, 0.f); mhat += dl; \
        _Pragma("unroll") for (int r = 0; r < 16; ++r) { C0[r] -= dl; C1[r] -= dl; } \
        const float f = __builtin_amdgcn_exp2f(-dl); l_reg *= f; if (hi == 0) wsf[r32] = f; resc = true; } } \
    SBAR(); \
    GAPB(o[0] = __builtin_amdgcn_mfma_f32_32x32x16_bf16(PAF(0), FFR(0), o[0], 0, 0, 0), C0, 0);   FRD(3); \
    GAPB(o[1] = __builtin_amdgcn_mfma_f32_32x32x16_bf16(PAF(0), FFR(1), o[1], 0, 0, 0), C0, 2);   FRD(4); \
    GAPB(o[0] = __builtin_amdgcn_mfma_f32_32x32x16_bf16(PAF(1), FFR(2), o[0], 0, 0, 0), C0, 4);   FRD(5); \
    GAPB(o[1] = __builtin_amdgcn_mfma_f32_32x32x16_bf16(PAF(1), FFR(3), o[1], 0, 0, 0), C0, 6);   FRD(6); \
    GAPB(o[0] = __builtin_amdgcn_mfma_f32_32x32x16_bf16(PAF(2), FFR(4), o[0], 0, 0, 0), C0, 8);   FRD(7); \
    GAPB(o[1] = __builtin_amdgcn_mfma_f32_32x32x16_bf16(PAF(2), FFR(5), o[1], 0, 0, 0), C0, 10);  FRD(8); \
    GAPB(o[0] = __builtin_amdgcn_mfma_f32_32x32x16_bf16(PAF(3), FFR(6), o[0], 0, 0, 0), C0, 12);  FRD(9); \
    GAPB(o[1] = __builtin_amdgcn_mfma_f32_32x32x16_bf16(PAF(3), FFR(7), o[1], 0, 0, 0), C0, 14);  FRD(10); \
    KRD(GL, 0); GAPB(o[2] = __builtin_amdgcn_mfma_f32_32x32x16_bf16(PAF(0), FFR(8), o[2], 0, 0, 0), C1, 0);   FRD(11); \
    KRD(GL, 1); GAPB(o[3] = __builtin_amdgcn_mfma_f32_32x32x16_bf16(PAF(0), FFR(9), o[3], 0, 0, 0), C1, 2);   FRD(12); \
    KRD(GL, 2); GAPB(o[2] = __builtin_amdgcn_mfma_f32_32x32x16_bf16(PAF(1), FFR(10), o[2], 0, 0, 0), C1, 4);  FRD(13); \
    KRD(GL, 3); GAPB(o[3] = __builtin_amdgcn_mfma_f32_32x32x16_bf16(PAF(1), FFR(11), o[3], 0, 0, 0), C1, 6);  FRD(14); \
    GAPB(o[2] = __builtin_amdgcn_mfma_f32_32x32x16_bf16(PAF(2), FFR(12), o[2], 0, 0, 0), C1, 8);  FRD(15); \
    GAPB(o[3] = __builtin_amdgcn_mfma_f32_32x32x16_bf16(PAF(2), FFR(13), o[3], 0, 0, 0), C1, 10); \
    GAPB(o[2] = __builtin_amdgcn_mfma_f32_32x32x16_bf16(PAF(3), FFR(14), o[2], 0, 0, 0), C1, 12); \
    GAPB(o[3] = __builtin_amdgcn_mfma_f32_32x32x16_bf16(PAF(3), FFR(15), o[3], 0, 0, 0), C1, 14); \
    } while (0)
  int t = 1;
  for (; t + 5 < NT; t += 2) {
    STEP(pB0, pB1, pA0, pA1, t, true, true, true);     WAIT_BAR(3); RESC(); ROT();
    STEP(pA0, pA1, pB0, pB1, t + 1, true, true, true); WAIT_BAR(3); RESC(); ROT();
  }
  #define ENDW(tt) do { if ((tt) + 3 < NT) { WAIT_BAR(3); } else if ((tt) + 2 < NT) { WAIT_BAR(2); } else { WAIT_BAR(0); } } while (0)
  for (; t + 1 < NT; t += 2) {
    STEP(pB0, pB1, pA0, pA1, t, (t + 3 < NT), (t + 1 < NT), (t + 1 < NT));         ENDW(t);     RESC(); ROT();
    STEP(pA0, pA1, pB0, pB1, t + 1, (t + 4 < NT), (t + 2 < NT), (t + 2 < NT));     ENDW(t + 1); RESC(); ROT();
  }
  STEP(pB0, pB1, pA0, pA1, NT - 1, false, false, false); RESC();
  { float sacc = pB0[0] + pB0[1]; _Pragma("unroll") for (int r = 2; r < 16; ++r) sacc += pB0[r]; _Pragma("unroll") for (int r = 0; r < 16; ++r) sacc += pB1[r]; l_reg += sacc;
    pw0 = (u32x4){PKW(pB0, 0), PKW(pB0, 2), PKW(pB0, 4), PKW(pB0, 6)}; pw1 = (u32x4){PKW(pB0, 8), PKW(pB0, 10), PKW(pB0, 12), PKW(pB0, 14)}; pw2 = (u32x4){PKW(pB1, 0), PKW(pB1, 2), PKW(pB1, 4), PKW(pB1, 6)}; pw3 = (u32x4){PKW(pB1, 8), PKW(pB1, 10), PKW(pB1, 12), PKW(pB1, 14)};
    SBAR(); pv(o, vb0 + 2 * sl_cur, PAF(0), PAF(1), PAF(2), PAF(3)); pv(o + 2, vb0 + 2 * sl_cur + 8192, PAF(0), PAF(1), PAF(2), PAF(3)); }
  #undef PKW
  #undef PAF
  #undef VFR
  #undef WFR
  #undef PIN
  #undef MX3
  #undef GAPA
  #undef GAPB
  #undef EX
  #undef VRD
  #undef FOFF
  #undef FRD
  #undef FFR
  #undef KRD
  #undef STEP
  #undef ENDW
  { auto rr = __builtin_amdgcn_permlane32_swap(__float_as_uint(l_reg), __float_as_uint(l_reg), false, false); l_reg = __uint_as_float(rr[0]) + __uint_as_float(rr[1]); }
  if (hi == 0) wsf[32 + r32] = l_reg; asm volatile("s_waitcnt lgkmcnt(0)" ::: "memory");
  float rli[16];
  #pragma unroll
  for (int r = 0; r < 16; ++r) rli[r] = __builtin_amdgcn_rcpf(wsf[32 + crow(r, hi)]);
  bf16* Ow = A_.O + (wid * QBLK) * A_.os;
  { bf16* stg = (bf16*)(shm + L8_QO) + wid * 2048;
    #pragma unroll
    for (int hv = 0; hv < 2; ++hv) {
      #pragma unroll
      for (int r = 0; r < 16; ++r) { const int orow = crow(r, hi);
        #pragma unroll
        for (int d0 = 0; d0 < 2; ++d0) stg[orow * 64 + d0 * 32 + r32] = __float2bfloat16(o[2 * hv + d0][r] * rli[r]); }
      asm volatile("s_waitcnt lgkmcnt(0)" ::: "memory");
      #pragma unroll
      for (int i = 0; i < 4; ++i) { const int row = i * 8 + (lane >> 3), ch = lane & 7; const u32x4 v = *(const u32x4*)(stg + row * 64 + ch * 8); *(u32x4*)(Ow + row * A_.os + hv * 64 + ch * 8) = v; }
      asm volatile("s_waitcnt lgkmcnt(0)" ::: "memory"); } }
  asm volatile("s_waitcnt lgkmcnt(0)\n\ts_barrier" ::: "memory");
  #undef DMA_K
  #undef DMA_V
  #undef QLD
  #undef NB
  #undef CMASK
  #undef RESC
  #undef ROT
}
#undef SBAR
#undef WAIT_BAR
}

__device__ __forceinline__ void transpose_item(const float* W, int K, int N, bf16_t* WT, LAS float* scr, int item, int lane, const float* gk = nullptr) {
    const int nblk = N / 32, kb = item / nblk, nb = item % nblk, k0 = 64 * kb, n0 = 32 * nb;
#pragma unroll 8
    for (int i = 0; i < 32; ++i) { const int kk = 2 * i + (lane >> 5); const float gg = gk ? gk[k0 + kk] : 1.f; scr[kk * 33 + (lane & 31)] = W[(size_t)(k0 + kk) * N + n0 + (lane & 31)] * gg; }
    asm volatile("s_waitcnt lgkmcnt(0)" ::: "memory");
    const int c = lane & 7;
#pragma unroll
    for (int j = 0; j < 4; ++j) { const int n = (lane >> 3) + 8 * j; const LAS float* s = scr + (8 * c) * 33 + n;
        u32x4 o; o.x = pk2(s[0 * 33], s[1 * 33]); o.y = pk2(s[2 * 33], s[3 * 33]); o.z = pk2(s[4 * 33], s[5 * 33]); o.w = pk2(s[6 * 33], s[7 * 33]);
        *(u32x4*)(WT + (size_t)(n0 + n) * K + k0 + 8 * c) = o; }
    asm volatile("s_waitcnt lgkmcnt(0)" ::: "memory");
}
__device__ __forceinline__ void rms_row_bf16(const float* xrow, const float* g, bf16_t* orow, int lane) {
    const f32x4* xr = (const f32x4*)xrow + lane; const f32x4* gr = (const f32x4*)g + lane;
    f32x4 v[4]; float s = 0.f;
#pragma unroll
    for (int j = 0; j < 4; ++j) { v[j] = xr[64 * j]; s += (v[j].x * v[j].x + v[j].y * v[j].y) + (v[j].z * v[j].z + v[j].w * v[j].w); }
    const float rs = rsqrtf(wave_sum(s) * (1.f / DM) + EPS);
    u32x2* o8 = (u32x2*)orow + lane;
#pragma unroll
    for (int j = 0; j < 4; ++j) { const f32x4 gg = gr[64 * j]; u32x2 w; w.x = pk2(v[j].x * rs * gg.x, v[j].y * rs * gg.y); w.y = pk2(v[j].z * rs * gg.z, v[j].w * rs * gg.w); o8[64 * j] = w; }
}
__device__ __forceinline__ void sincos_red(float a, float& s, float& c) {
    const float q = rintf(a * 0.636619772367581f); const int iq = (int)q;
    float r = fmaf(q, -1.5703125f, a); r = fmaf(q, -4.837512969970703125e-4f, r); r = fmaf(q, -7.54978995489188216e-8f, r);
    const float r2 = r * r;
    const float sp = r + r * r2 * (-1.6666654611e-1f + r2 * (8.3321608736e-3f + r2 * (-1.9515295891e-4f)));
    const float cp = 1.0f - 0.5f * r2 + r2 * r2 * (4.166664568298827e-2f + r2 * (-1.388731625493765e-3f + r2 * 2.443315711809948e-5f));
    const int k = iq & 3;
    s = (k == 0) ? sp : (k == 1) ? cp : (k == 2) ? -sp : -cp;
    c = (k == 0) ? cp : (k == 1) ? -sp : (k == 2) ? -cp : sp;
}

#define XB_TMO      128
#define XB_XCNT(j)  (256  + 64 * (j))
#define XB_XSUB(j)  (1280 + 64 * (j))
#define XB_XGEN(j)  (2304 + 64 * (j))
#define XB_TOP      3328
#define XB_TOPGEN   3392
#define XCD_BAR_WORDS 3456
#define XB_SPIN_CAP (1u << 18)

__device__ __forceinline__ unsigned xb_ld(unsigned* p)              { return __hip_atomic_load(p, __ATOMIC_RELAXED, __HIP_MEMORY_SCOPE_AGENT); }
__device__ __forceinline__ unsigned xb_add(unsigned* p, unsigned v) { return __hip_atomic_fetch_add(p, v, __ATOMIC_RELAXED, __HIP_MEMORY_SCOPE_AGENT); }
__device__ __forceinline__ unsigned xb_xcc_id() { return (unsigned)__builtin_amdgcn_s_getreg((3 << 11) | 20) & 0xFu; }
#define XB_SPIN(cond, bar) do { unsigned _sp = 0; while (cond) { __builtin_amdgcn_s_sleep(1); \
    if ((++_sp & 255u) == 0u) { if (xb_ld(&(bar)[XB_TMO])) break; if (_sp > XB_SPIN_CAP) { atomicAdd(&(bar)[XB_TMO], 1u); break; } } } } while (0)

struct XcdBarrier {
    unsigned* bar; unsigned x;
    volatile LAS unsigned* st;
};

__device__ __forceinline__ XcdBarrier xcd_barrier_post(unsigned* bar, volatile LAS unsigned* st) {
    XcdBarrier b; b.bar = bar; b.x = xb_xcc_id(); b.st = st;
    if (threadIdx.x == 0) (void)xb_add(&bar[XB_XCNT(b.x)], 1u);
    return b;
}
__device__ __forceinline__ void xcd_barrier_complete(unsigned* bar, unsigned x, unsigned& nloc, unsigned& nx) {
    const unsigned G = gridDim.x * gridDim.y * gridDim.z;
    unsigned sum, cnt, mine, sp = 0u;
    for (;;) {
        sum = 0u; cnt = 0u; mine = 0u;
#pragma unroll
        for (unsigned j = 0; j < 16; ++j) { const unsigned c = xb_ld(&bar[XB_XCNT(j)]); sum += c; cnt += (c > 0u) ? 1u : 0u; mine = (j == x) ? c : mine; }
        if (sum == G) break;
        __builtin_amdgcn_s_sleep(1);
        if ((++sp & 255u) == 0u) { if (xb_ld(&bar[XB_TMO])) break; if (sp > XB_SPIN_CAP) { atomicAdd(&bar[XB_TMO], 1u); break; } }
    }
    nloc = mine > 0u ? mine : 1u; nx = cnt > 0u ? cnt : 1u;
}

__device__ __forceinline__ void xcd_barrier(const XcdBarrier& b) {
    asm volatile("s_waitcnt vmcnt(0)" ::: "memory");
    __syncthreads();
    if (threadIdx.x == 0) {
        unsigned* bar = b.bar;
        __builtin_amdgcn_s_waitcnt(0);
        unsigned nloc = b.st[0], nx = b.st[1];
        if (nloc == 0u) { xcd_barrier_complete(bar, b.x, nloc, nx); b.st[0] = nloc; b.st[1] = nx; }
        const unsigned old = xb_add(&bar[XB_XSUB(b.x)], 1u);
        const unsigned gen = old / nloc;
        if (old + 1u == (gen + 1u) * nloc) {
            __builtin_amdgcn_fence(__ATOMIC_RELEASE, "agent");
            asm volatile("s_waitcnt vmcnt(0)" ::: "memory");
            const unsigned og = xb_add(&bar[XB_TOP], 1u);
            const unsigned tg = og / nx;
            if (og + 1u == (tg + 1u) * nx) xb_add(&bar[XB_TOPGEN], 1u);
            else XB_SPIN(xb_ld(&bar[XB_TOPGEN]) == tg, bar);
            __builtin_amdgcn_fence(__ATOMIC_ACQUIRE, "agent");
            xb_add(&bar[XB_XGEN(b.x)], 1u);
            asm volatile("s_waitcnt vmcnt(0)" ::: "memory");
        } else {
            XB_SPIN(xb_ld(&bar[XB_XGEN(b.x)]) == gen, bar);
            __builtin_amdgcn_fence(__ATOMIC_ACQUIRE, "agent");
            asm volatile("s_waitcnt vmcnt(0)" ::: "memory");
        }
    }
    __syncthreads();
}


struct Args { const float* in[14]; float* out; unsigned char* ws; };

__global__ void __launch_bounds__(512) mk_fwd(Args args) {
    extern __shared__ __attribute__((aligned(16))) unsigned char lds[];
    cg::grid_group grid = cg::this_grid();
    const int tid0 = threadIdx.x, wave = __builtin_amdgcn_readfirstlane(tid0 >> 6);
#define FRESH_LANE() int tid = tid0; asm volatile("" : "+v"(tid)); const int lane = tid & 63
    const int G = gridDim.x, bx = blockIdx.x;
    const int vcu = (G % 8 == 0) ? (bx % 8) * (G / 8) + bx / 8 : bx;
    const int gw = vcu * 8 + wave, NGW = G * 8;
    LAS unsigned char* ldsl = (LAS unsigned char*)lds;
    if (tid0 < 8) ((LAS unsigned*)(ldsl + MISC_OFF))[tid0] = 0u;
    __syncthreads();
    const XcdBarrier xbar = xcd_barrier_post((unsigned*)(args.ws + WS_BAR), (volatile LAS unsigned*)(ldsl + MISC_OFF));
#define ws (args.ws)
#define x_in (args.in[0])
#define norm_mix (args.in[1])
#define w_in (args.in[2])
#define b_gate (args.in[3])
#define diff_lambda (args.in[4])
#define diff_subln (args.in[5])
#define na_rpb (args.in[6])
#define qk_norm (args.in[7])
#define w_branch (args.in[8])
#define w_out (args.in[9])
#define norm_ffn (args.in[10])
#define w_ff1 (args.in[11])
#define w_ff2 (args.in[12])
#define norm_final (args.in[13])
#define xout (args.out)
#define WinT ((bf16_t*)(ws + WS_WIN))
#define WbrT ((bf16_t*)(ws + WS_WBR))
#define WoutT ((bf16_t*)(ws + WS_WOUT))
#define W1T ((bf16_t*)(ws + WS_W1))
#define W2T ((bf16_t*)(ws + WS_W2))
#define STAT ((float*)(ws + WS_STAT))
#define H ((bf16_t*)(ws + WS_H))
#define ATMP ((bf16_t*)(ws + WS_ATMP))
#define BTMP ((bf16_t*)(ws + WS_BTMP))
#define Y ((bf16_t*)(ws + WS_Y))
#define MERGED ((bf16_t*)(ws + WS_MERGED))
#define Z ((bf16_t*)(ws + WS_Z))
#define U ((bf16_t*)(ws + WS_Z))
#define PROJ ((bf16_t*)(ws + WS_PROJ))
#define XB ((bf16_t*)(ws + WS_XB))
#define SSQM ((float*)(ws + WS_SSQM))
#define SSQF ((float*)(ws + WS_SSQF))
#define NRMQ ((unsigned*)(ws + WS_NRM))
#define NRMK ((unsigned*)(ws + WS_NRM) + 1024)

    {
        FRESH_LANE();
        LAS float* scr = (LAS float*)(ldsl + wave * 16384);
        constexpr int I_IN = (DM / 64) * (INW / 32), I_BR = (512 / 64) * (DM / 32), I_OUT = (DM / 64) * (DM / 32), I_1 = (DM / 64) * (DFF / 32), I_2 = (DFF / 64) * (DM / 32);
        constexpr int NITEMS = 2 * I_IN + 8 * I_BR + 2 * I_OUT + 2 * I_1 + 2 * I_2;
        for (int it = gw; it < NITEMS; it += NGW) {
            int r = it;
            if (r < 2 * I_IN) { const int l = r / I_IN; transpose_item(w_in + (size_t)l * DM * INW, DM, INW, WinT + (size_t)l * INW * DM, scr, r % I_IN, lane, norm_mix + l * DM); continue; } r -= 2 * I_IN;
            if (r < 8 * I_BR) { const int ln = r / I_BR; transpose_item(w_branch + (size_t)ln * 512 * DM, 512, DM, WbrT + (size_t)ln * DM * 512, scr, r % I_BR, lane); continue; } r -= 8 * I_BR;
            if (r < 2 * I_OUT) { const int l = r / I_OUT; transpose_item(w_out + (size_t)l * DM * DM, DM, DM, WoutT + (size_t)l * DM * DM, scr, r % I_OUT, lane); continue; } r -= 2 * I_OUT;
            if (r < 2 * I_1) { const int l = r / I_1; transpose_item(w_ff1 + (size_t)l * DM * DFF, DM, DFF, W1T + (size_t)l * DFF * DM, scr, r % I_1, lane, norm_ffn + l * DM); continue; } r -= 2 * I_1;
            { const int l = r / I_2; transpose_item(w_ff2 + (size_t)l * DFF * DM, DFF, DM, W2T + (size_t)l * DM * DFF, scr, r % I_2, lane); }
        }
        {
            f32x4 v[4], vn[4] = {};
            if (gw < NTOK) { const f32x4* xr = (const f32x4*)(x_in + (size_t)gw * DM) + lane;
#pragma unroll
                for (int j = 0; j < 4; ++j) v[j] = xr[64 * j]; }
            for (int m = gw; m < NTOK; m += NGW) {
                if (m + NGW < NTOK) { const f32x4* xr = (const f32x4*)(x_in + (size_t)(m + NGW) * DM) + lane;
#pragma unroll
                    for (int j = 0; j < 4; ++j) vn[j] = xr[64 * j]; }
                u32x2* o8 = (u32x2*)(XB + (size_t)m * DM) + lane; float sq = 0.f;
#pragma unroll
                for (int j = 0; j < 4; ++j) { sq += (v[j].x * v[j].x + v[j].y * v[j].y) + (v[j].z * v[j].z + v[j].w * v[j].w); u32x2 w; w.x = pk2(v[j].x, v[j].y); w.y = pk2(v[j].z, v[j].w); o8[64 * j] = w; }
                sq = wave_sum(sq);
                if (lane == 0) *(f32x4*)(SSQM + (size_t)m * 4) = (f32x4){sq, 0.f, 0.f, 0.f};
#pragma unroll
                for (int j = 0; j < 4; ++j) v[j] = vn[j];
            }
        }
    }
    grid.sync();

    for (int l = 0; l < DEPTH; ++l) {
        { FRESH_LANE(); LAS float* tab = (LAS float*)(ldsl + TAB_OFF); for (int i = tid; i < 8 * 465; i += 512) tab[i] = na_rpb[l * 8 * 465 + i] * LOG2E; }
        __syncthreads();
        for (int grp = 0; grp < NGRP; ++grp) {
            const size_t tok0 = (size_t)grp * TG;
            const float* xsrc = (l == 0) ? x_in : xout;
            {
                pg8::Gemm g{XB + tok0 * DM, WinT + (size_t)l * INW * DM, DM, DM, DM, 1 << 30, 0}; pg8::StaticOrder S; S.init(TG, INW, G, bx);
                if (bx == 0) { FRESH_LANE(); NRMQ[tid] = 0u; NRMQ[tid + 512] = 0u; if (tid < 16) NRMQ[1024 + tid] = 0u; (void)lane; }
                pg8::Epi<0> E{PROJ, nullptr, nullptr, b_gate + l * 4096, INW, SSQM + tok0 * 4, nullptr, nullptr, nullptr};
                pg8::gemm_phase(ldsl, g, S, E);
            }
            xcd_barrier(xbar);
            {
                FRESH_LANE();
                const float inv = exp2f(-(float)(lane & 15) * 0.8304820237218406f);
                const float gq = qk_norm[l * 128 + lane], gk = qk_norm[l * 128 + 64 + lane];
                const int per = (TG + NGW - 1) / NGW;
                float mq = 0.f, mk = 0.f; int cu = -1;
                u32x4 qv, kv, qvn = {}, kvn = {}; unsigned short rw[10], rwn[10] = {};
#define P3_LOAD(QV, KV, RW, mm) do { const bf16_t* ar_ = PROJ + (size_t)(mm) * INW; QV = *(const u32x4*)(ar_ + COL_AQ + lane * 8); KV = *(const u32x4*)(ar_ + COL_AK + lane * 8); \
                    _Pragma("unroll") for (int hd = 0; hd < 10; ++hd) RW[hd] = ar_[COL_DQ + hd * 64 + lane]; } while (0)
                if (gw * per < TG) P3_LOAD(qv, kv, rw, gw * per);
                for (int i = 0; i < per; ++i) {
                    const int m = gw * per + i; if (m >= TG) break;
                    if (i + 1 < per && m + 1 < TG) P3_LOAD(qvn, kvn, rwn, m + 1);
                    if ((m >> 8) != cu) { if (cu >= 0 && (lane & 7) == 0) { atomicMax(NRMQ + cu * 8 + (lane >> 3), __float_as_uint(mq)); atomicMax(NRMK + (cu >> 5) * 8 + (lane >> 3), __float_as_uint(mk)); } cu = m >> 8; mq = 0.f; mk = 0.f; }
                    const int s = (int)((tok0 + m) % SEQ); const float pos = (float)((lane < 32) ? (s >> 6) : (s & 63));
                    float sn, cs; sincos_red(pos * inv, sn, cs);
                    { float nq = 0.f, nk = 0.f;
#pragma unroll
                      for (int e = 0; e < 4; ++e) { nq += bflo(qv[e]) * bflo(qv[e]) + bfhi(qv[e]) * bfhi(qv[e]); nk += bflo(kv[e]) * bflo(kv[e]) + bfhi(kv[e]) * bfhi(kv[e]); }
                      nq += __shfl_xor(nq, 1); nk += __shfl_xor(nk, 1); nq += __shfl_xor(nq, 2); nk += __shfl_xor(nk, 2); nq += __shfl_xor(nq, 4); nk += __shfl_xor(nk, 4);
                      mq = fmaxf(mq, sqrtf(nq)); mk = fmaxf(mk, sqrtf(nk)); }
                    bf16_t* row = PROJ + (size_t)m * INW + COL_DQ;
#pragma unroll
                    for (int hd = 0; hd < 10; ++hd) {
                        const float v = __uint_as_float((unsigned)rw[hd] << 16);
                        const float rn = rsqrtf(wave_sum(v * v) * (1.f / 64.f) + EPS);
                        const float y = v * rn * (hd < 8 ? gq : gk);
                        const float p = __shfl_xor(y, 16);
                        float o = ((lane >> 4) & 1) ? (y * cs + p * sn) : (y * cs - p * sn);
                        if (hd < 8) o *= C2;
                        row[hd * 64 + lane] = (bf16_t)f2bf(o);
                    }
                    qv = qvn; kv = kvn;
#pragma unroll
                    for (int hd = 0; hd < 10; ++hd) rw[hd] = rwn[hd];
                }
#undef P3_LOAD
                if (cu >= 0 && (lane & 7) == 0) { atomicMax(NRMQ + cu * 8 + (lane >> 3), __float_as_uint(mq)); atomicMax(NRMK + (cu >> 5) * 8 + (lane >> 3), __float_as_uint(mk)); }
            }
            xcd_barrier(xbar);
            {
                using namespace attn_body;
                char* shm = (char*)lds;
                {
                    unsigned* qctr = (unsigned*)(ws + WS_BAR) + 3584 + (l * NGRP + grp) * 8;
                    volatile LAS unsigned* slot = (volatile LAS unsigned*)(ldsl + MISC_OFF + 32);
                    const int myx = (G % 8 == 0) ? (vcu / (G / 8)) : 0;
                    int qq = 0;
                    for (;;) {
                        if (tid0 == 0) { int fj = -1, fx = 0;
                            for (; qq < 8; ++qq) { const int x_ = (myx + qq) & 7; const int j_ = (int)atomicAdd(qctr + x_, 1u); if (j_ < 288) { fj = j_; fx = x_; break; } }
                            slot[0] = (unsigned)fj; slot[1] = (unsigned)fx; }
                        __syncthreads();
                        const int j = (int)slot[0], sx = (int)slot[1];
                        __syncthreads();
                        if (j < 0) break;
                        if (j < 128) {
                            AttnArgs a{}; a.qs = INW; a.ks = INW; a.NT = 128; a.tlo = 0; a.thi = 127;
                            if (j >= 32 && j < 96) { const int qb = j & 31, ds = 2 * sx + ((j - 32) >> 5), bb = ds >> 3, h = ds & 7; const size_t tb = (size_t)bb * SEQ;
                                a.Q = (const bf16*)(PROJ + (tb + qb * 256) * INW + COL_DQ + h * 64); a.K = (const bf16*)(PROJ + tb * INW + COL_DK + (h >> 2) * 64);
                                a.V = (const bf16*)(PROJ + tb * INW + COL_DV + (h >> 2) * 64); a.O = (bf16*)(Y + (tb + qb * 256) * 2048 + 1536 + h * 64); a.os = 2048;
                                attn_unit<MD, 8>(a, shm);
                            } else {
                                int bb, hh, comp, qb;
                                if (j < 32) { bb = sx >> 2; hh = 2 + ((sx >> 1) & 1); comp = sx & 1; qb = j; }
                                else { const int s1 = sx >> 1; bb = s1 >> 1; comp = s1 & 1; hh = (j < 112) ? 1 : 0; qb = (sx & 1) * 16 + ((j - 96) & 15); }
                                const size_t tb = (size_t)bb * SEQ;
                                a.Q = (const bf16*)(PROJ + (tb + qb * 256) * INW + COL_AQ + hh * 128 + comp * 64); a.K = (const bf16*)(PROJ + tb * INW + COL_AK + hh * 128 + comp * 64);
                                a.V = (const bf16*)(PROJ + tb * INW + COL_AV + hh * 128); a.O = (bf16*)(ATMP + (tb + qb * 256) * 1024 + (hh * 2 + comp) * 128); a.os = 1024;
                                a.s2 = exp2f(-2.f * (float)(hh + 1)) * LOG2E;
                                const float Bs = __uint_as_float(NRMQ[(bb * 32 + qb) * 8 + hh * 2 + comp]) * __uint_as_float(NRMK[bb * 8 + hh * 2 + comp]) * 1.02f + 0.25f;
                                const float dlim = fminf((150.f + 2.f * Bs) / a.s2, 1.0e6f), q0f = (float)(qb * 256);
                                int tlo = max(0, (int)floorf((q0f - 63.f - dlim) * (1.f / 64.f))), thi = min(127, (int)ceilf((q0f + 255.f + dlim) * (1.f / 64.f)));
                                if (((thi - tlo + 1) & 1) != 0) { if (tlo > 0) --tlo; else ++thi; }
                                tlo = __builtin_amdgcn_readfirstlane(tlo); thi = __builtin_amdgcn_readfirstlane(thi);
                                a.K += (size_t)tlo * 64 * INW; a.V += (size_t)tlo * 64 * INW; a.q0 = qb * 256 - 64 * tlo; a.NT = thi - tlo + 1;
                                attn_unit128<8>(a, shm);
                            }
                        } else if (j < 192) {
                            const int cs = 2 * sx + ((j - 128) >> 5), qb = (j - 128) & 31, bb = cs >> 3, h = cs & 7, r0 = 4 * qb, kb = min(max(r0 - 4, 0), 116); const size_t tb = (size_t)bb * SEQ;
                            AttnArgs a{}; a.qs = INW; a.ks = INW; a.os = 2048; a.NT = 12; a.tlo = 0; a.thi = 11; a.q0 = r0; a.kb = kb;
                            a.Q = (const bf16*)(PROJ + (tb + r0 * 64) * INW + COL_CQ + h * 64); a.K = (const bf16*)(PROJ + (tb + kb * 64) * INW + COL_CK + h * 64);
                            a.V = (const bf16*)(PROJ + (tb + kb * 64) * INW + COL_CV + h * 64); a.O = (bf16*)(Y + (tb + r0 * 64) * 2048 + 1024 + h * 64);
                            a.tab = (lds_fptr)((lds_cptr)shm + TAB_OFF) + h * 465;
                            attn_unit<MC, 8>(a, shm);
                        } else {
                            const int p = j - 192, sg = 6 * sx + (p >> 4);
                            for (int e = 0; e < 2; ++e) {
                                const int blk = 2 * (p & 15) + e, bb = sg / 24, k = sg % 24, gp = k >> 3, h = k & 7, dsh = 2 * gp, dil = 1 << dsh;
                                const int nblk = 32 >> dsh, res = blk / nblk, i0 = (blk % nblk) * 256, L = SEQ >> dsh;
                                const long tq = (long)bb * SEQ + res + (long)i0 * dil, tk = (long)bb * SEQ + res + (long)(i0 - 64) * dil;
                                AttnArgs a{}; a.qs = dil * INW; a.ks = dil * INW; a.os = dil * 1536; a.NT = 6; a.tlo = (i0 == 0) ? 1 : 0; a.thi = (i0 + 256 == L) ? 4 : 5;
                                const int cq = COL_B + gp * 1536 + h * 64;
                                a.Q = (const bf16*)(PROJ + tq * INW + cq); a.K = (const bf16*)(PROJ + tk * INW + cq + 512); a.V = (const bf16*)(PROJ + tk * INW + cq + 1024);
                                a.O = (bf16*)(BTMP + tq * 1536 + gp * 512 + h * 64);
                                a.s2 = exp2f(-(float)(h + 1)) * (float)dil * LOG2E; a.stat = STAT + (tq * 24 + gp * 8 + h) * 2; a.ss = dil * 48;
                                attn_unit<MB, 8>(a, shm);
                            }
                        }
                    }
                }
            }
            xcd_barrier(xbar);
            {
                FRESH_LANE();
                int l_ = l; asm volatile("" : "+s"(l_));
                const float lam_init = (l_ == 0) ? 0.2f : (0.8f - 0.6f * 0.7408182206817179f);
                float lam;
                { const float* lp = diff_lambda + l * 256; const float a = lp[lane] * lp[64 + lane], b = lp[128 + lane] * lp[192 + lane]; lam = expf(wave_sum(a)) - expf(wave_sum(b)) + lam_init; lam = __uint_as_float(__builtin_amdgcn_readfirstlane(__float_as_uint(lam))); }
                const float out_scale = 1.f - lam_init;
                const float g0 = diff_subln[l * 128 + 2 * lane], g1 = diff_subln[l * 128 + 2 * lane + 1];
                const int h = lane >> 3, d8 = (lane & 7) * 8;
                unsigned aw[8]; u32x4 bw[3]; float sv[6];
#define P5_LOAD(AW, BW, SV, mm) do { const unsigned* at_ = (const unsigned*)(ATMP + (size_t)(mm) * 1024); _Pragma("unroll") for (int q = 0; q < 8; ++q) AW[q] = at_[q * 64 + lane]; \
                    const bf16_t* bt_ = BTMP + (size_t)(mm) * 1536 + h * 64 + d8; _Pragma("unroll") for (int g = 0; g < 3; ++g) BW[g] = *(const u32x4*)(bt_ + g * 512); \
                    const float* st_ = STAT + (size_t)(mm) * 48 + h * 2; _Pragma("unroll") for (int g = 0; g < 3; ++g) { SV[2 * g] = st_[16 * g]; SV[2 * g + 1] = st_[16 * g + 1]; } } while (0)
                for (int m = gw; m < TG; m += NGW) {
                    P5_LOAD(aw, bw, sv, m);
                    unsigned* yr = (unsigned*)(Y + (size_t)m * 2048);
#pragma unroll
                    for (int hh = 0; hh < 4; ++hh) {
                        const unsigned w0 = aw[hh * 2], w1 = aw[hh * 2 + 1];
                        const float d0 = bflo(w0) - lam * bflo(w1), d1 = bfhi(w0) - lam * bfhi(w1);
                        const float rn = rsqrtf(wave_sum(d0 * d0 + d1 * d1) * (1.f / 128.f) + EPS) * out_scale;
                        yr[hh * 64 + lane] = pk2(d0 * rn * g0, d1 * rn * g1);
                    }
                    const float m0 = sv[0], l0 = sv[1], m1 = sv[2], l1 = sv[3], m2 = sv[4], l2 = sv[5];
                    const float ms = fmaxf(m0, fmaxf(m1, m2));
                    const float w0 = l0 * exp2f(m0 - ms), w1 = l1 * exp2f(m1 - ms), w2 = l2 * exp2f(m2 - ms); const float inv = 1.f / (w0 + w1 + w2);
                    const u32x4 a0 = bw[0], a1 = bw[1], a2 = bw[2];
                    u32x4 o;
#pragma unroll
                    for (int e = 0; e < 4; ++e) { const float lo = (w0 * bflo(a0[e]) + w1 * bflo(a1[e]) + w2 * bflo(a2[e])) * inv, hi = (w0 * bfhi(a0[e]) + w1 * bfhi(a1[e]) + w2 * bfhi(a2[e])) * inv; o[e] = pk2(lo, hi); }
                    *(u32x4*)(Y + (size_t)m * 2048 + 512 + h * 64 + d8) = o;
                }
#undef P5_LOAD
            }
            xcd_barrier(xbar);
            {
                pg8::Gemm g{Y, WbrT + (size_t)l * 4096 * 512, 2048, 512, 512, 4, 512}; pg8::StaticOrder S; S.init(TG, 4096, G, bx);
                pg8::Epi<1> E{Z, nullptr, nullptr, nullptr, 4096, nullptr, nullptr, nullptr, nullptr};
                pg8::gemm_phase(ldsl, g, S, E);
            }
            xcd_barrier(xbar);
            { FRESH_LANE();
            u32x4 gv[2][4], zv[2][4];
#define P7_LOAD(GV, ZV, mm) do { const bf16_t* gr_ = PROJ + (size_t)(mm) * INW + COL_GATE + lane * 8; const bf16_t* zr_ = Z + (size_t)(mm) * 4096 + lane * 8; \
                _Pragma("unroll") for (int jj = 0; jj < 2; ++jj) _Pragma("unroll") for (int n = 0; n < 4; ++n) { GV[jj][n] = *(const u32x4*)(gr_ + n * 1024 + jj * 512); ZV[jj][n] = *(const u32x4*)(zr_ + n * 1024 + jj * 512); } } while (0)
            for (int m = gw; m < TG; m += NGW) {
                P7_LOAD(gv, zv, m);
#pragma unroll
                for (int j = 0; j < 2; ++j) { const int c = lane * 8 + j * 512; float acc[8] = {0.f, 0.f, 0.f, 0.f, 0.f, 0.f, 0.f, 0.f};
#pragma unroll
                    for (int n = 0; n < 4; ++n) {
#pragma unroll
                        for (int e = 0; e < 4; ++e) { acc[2 * e] += bflo(gv[j][n][e]) * bflo(zv[j][n][e]); acc[2 * e + 1] += bfhi(gv[j][n][e]) * bfhi(zv[j][n][e]); } }
                    u32x4 o; o.x = pk2(acc[0], acc[1]); o.y = pk2(acc[2], acc[3]); o.z = pk2(acc[4], acc[5]); o.w = pk2(acc[6], acc[7]);
                    *(u32x4*)(MERGED + (size_t)m * DM + c) = o; }
#undef P7_LOAD
            } }
            xcd_barrier(xbar);
            {
                pg8::Gemm g{MERGED, WoutT + (size_t)l * DM * DM, DM, DM, DM, 1 << 30, 0}; pg8::StaticOrder S; S.init(TG, DM, G, bx);
                pg8::Epi<3> E{nullptr, xout + tok0 * DM, xsrc + tok0 * DM, nullptr, DM, nullptr, H, SSQF, (LAS float*)(ldsl + SSQ_OFF)};
                pg8::gemm_phase(ldsl, g, S, E);
            }
            xcd_barrier(xbar);
            {
                pg8::Gemm g{H, W1T + (size_t)l * DFF * DM, DM, DM, DM, 1 << 30, 0}; pg8::StaticOrder S; S.init(TG, DFF, G, bx);
                pg8::Epi<2> E{U, nullptr, nullptr, nullptr, DFF, SSQF, nullptr, nullptr, nullptr};
                pg8::gemm_phase(ldsl, g, S, E);
            }
            xcd_barrier(xbar);
            {
                pg8::Gemm g{U, W2T + (size_t)l * DM * DFF, DFF, DFF, DFF, 1 << 30, 0}; pg8::StaticOrder S; S.init(TG, DM, G, bx);
                pg8::Epi<3> E{nullptr, xout + tok0 * DM, xout + tok0 * DM, nullptr, DM, nullptr, XB + tok0 * DM, SSQM + tok0 * 4, (LAS float*)(ldsl + SSQ_OFF)};
                pg8::gemm_phase(ldsl, g, S, E);
            }
            if (l == DEPTH - 1 && grp == NGRP - 1) xcd_barrier(xbar);
        }
    }
    {
        FRESH_LANE();
        const f32x4* g4 = (const f32x4*)norm_final + lane; f32x4 gg[4];
#pragma unroll
        for (int j = 0; j < 4; ++j) gg[j] = g4[64 * j];
        f32x4 v[4], vn[4] = {};
        if (gw < NTOK) { const f32x4* o = (const f32x4*)(xout + (size_t)gw * DM) + lane;
#pragma unroll
            for (int j = 0; j < 4; ++j) v[j] = o[64 * j]; }
        for (int m = gw; m < NTOK; m += NGW) {
            if (m + NGW < NTOK) { const f32x4* on = (const f32x4*)(xout + (size_t)(m + NGW) * DM) + lane;
#pragma unroll
                for (int j = 0; j < 4; ++j) vn[j] = on[64 * j]; }
            f32x4* o = (f32x4*)(xout + (size_t)m * DM) + lane; float sq = 0.f;
#pragma unroll
            for (int j = 0; j < 4; ++j) sq += (v[j].x * v[j].x + v[j].y * v[j].y) + (v[j].z * v[j].z + v[j].w * v[j].w);
            const float r = rsqrtf(wave_sum(sq) * (1.f / DM) + EPS);
#pragma unroll
            for (int j = 0; j < 4; ++j) o[64 * j] = (f32x4){v[j].x * r * gg[j].x, v[j].y * r * gg[j].y, v[j].z * r * gg[j].z, v[j].w * r * gg[j].w};
#pragma unroll
            for (int j = 0; j < 4; ++j) v[j] = vn[j];
        }
    }
}

#undef ws
#undef x_in
#undef norm_mix
#undef w_in
#undef b_gate
#undef diff_lambda
#undef diff_subln
#undef na_rpb
#undef qk_norm
#undef w_branch
#undef w_out
#undef norm_ffn
#undef w_ff1
#undef w_ff2
#undef norm_final
#undef xout
#undef WinT
#undef WbrT
#undef WoutT
#undef W1T
#undef W2T
#undef STAT
#undef H
#undef ATMP
#undef BTMP
#undef Y
#undef MERGED
#undef Z
#undef U
#undef PROJ
#undef NRMQ
#undef XB
#undef SSQM
#undef SSQF
#undef NRMK

extern "C" void kernel_launch(void* const* d_in, const int* in_sizes, int n_in, void* d_out, int out_size, void* d_ws, size_t ws_size, hipStream_t stream) {
    static int grid_blocks = 0;
    if (!grid_blocks) {
        int dev = 0, cus = 0, per_cu = 0;
        (void)hipGetDevice(&dev);
        (void)hipDeviceGetAttribute(&cus, hipDeviceAttributeMultiprocessorCount, dev);
        (void)hipFuncSetAttribute((const void*)mk_fwd, hipFuncAttributeMaxDynamicSharedMemorySize, LDS_BYTES);
        (void)hipOccupancyMaxActiveBlocksPerMultiprocessor(&per_cu, (const void*)mk_fwd, 512, LDS_BYTES);
        if (per_cu < 1) per_cu = 1;
        grid_blocks = cus * per_cu;
        if (ws_size < WS_END || n_in != 14) { fprintf(stderr, "kernel_launch: workspace %zu < %zu or n_in %d != 14\n", ws_size, (size_t)WS_END, n_in); grid_blocks = -1; }
    }
    if (grid_blocks < 0) return;
    (void)hipMemsetAsync((char*)d_ws + WS_BAR, 0, 16384, stream);
    Args a{};
    for (int i = 0; i < 14; ++i) a.in[i] = (const float*)d_in[i];
    a.out = (float*)d_out; a.ws = (unsigned char*)d_ws;
    void* kargs[] = {&a};
    hipError_t e = hipLaunchCooperativeKernel((const void*)mk_fwd, dim3(grid_blocks), dim3(512), kargs, LDS_BYTES, stream);
    if (e != hipSuccess) fprintf(stderr, "cooperative launch failed: %s (grid %d)\n", hipGetErrorString(e), grid_blocks);
}
```

```cpp
#include <hip/hip_runtime.h>
#include <hip/hip_cooperative_groups.h>
#include <hip/hip_bf16.h>
#include <cstdio>
#include <cstdint>
#include <cmath>
namespace cg = cooperative_groups;

constexpr int BATCH = 8, SEQ = 8192, DM = 1024, NTOK = BATCH * SEQ, INW = 12544, DFF = 4096, DEPTH = 2;
constexpr int GB = 2, TG = GB * SEQ, NGRP = BATCH / GB;
constexpr float EPS = 1e-6f;
constexpr float LOG2E = 1.4426950408889634f;
constexpr float C2 = 0.125f * LOG2E;
constexpr int COL_AQ = 0, COL_AK = 512, COL_AV = 1024, COL_B = 1536, COL_CQ = 6144, COL_CK = 6656, COL_CV = 7168, COL_DQ = 7680, COL_DK = 8192, COL_DV = 8320, COL_GATE = 8448;
constexpr size_t MiB = 1u << 20;
constexpr size_t WS_WIN = 0, WS_WBR = 49 * MiB, WS_WOUT = 57 * MiB, WS_W1 = 61 * MiB, WS_W2 = 77 * MiB, WS_STAT = 93 * MiB, WS_H = 96 * MiB, WS_ATMP = 128 * MiB,
                 WS_BTMP = 160 * MiB, WS_Y = 208 * MiB, WS_MERGED = 272 * MiB, WS_Z = 304 * MiB, WS_PROJ = 432 * MiB, WS_NRM = 824 * MiB, WS_BAR = 824 * MiB + 512 * 1024, WS_SSQM = 825 * MiB, WS_SSQF = 826 * MiB, WS_XB = 827 * MiB, WS_END = 955 * MiB;
constexpr int LDS_BYTES = 151552, TAB_OFF = 131072, MISC_OFF = 147072, SSQ_OFF = 147456;

#define LAS __attribute__((address_space(3)))
typedef unsigned short bf16_t;
typedef short bf16x8 __attribute__((ext_vector_type(8)));
typedef float f32x4 __attribute__((ext_vector_type(4)));
typedef unsigned u32x4 __attribute__((ext_vector_type(4)));
typedef unsigned u32x2 __attribute__((ext_vector_type(2)));

__device__ __forceinline__ unsigned f2bf(float f) { unsigned u = __builtin_bit_cast(unsigned, f); return (u + 0x7fffu + ((u >> 16) & 1u)) >> 16; }
__device__ __forceinline__ unsigned pk2(float lo, float hi) { return f2bf(lo) | (f2bf(hi) << 16); }
__device__ __forceinline__ float bflo(unsigned w) { return __uint_as_float(w << 16); }
__device__ __forceinline__ float bfhi(unsigned w) { return __uint_as_float(w & 0xffff0000u); }
__device__ __forceinline__ float wave_sum(float v) {
#pragma unroll
    for (int o = 1; o < 64; o <<= 1) v += __shfl_xor(v, o);
    return v;
}

namespace pg8 {
constexpr int BM = 256, BK = 64, HALF = 128, HTB = HALF * BK * 2, STAGE_BYTES = 8 * HTB, NXCD = 8, WGM = 4;
__host__ __device__ __forceinline__ int lds_byte(int r, int c) { const int st = (r >> 4) * 2 + (c >> 5), rr = r & 15, cc = c & 31, ob = rr * 64 + cc * 2; return st * 1024 + (ob ^ (((ob >> 9) & 1) << 5)); }
__host__ __device__ __forceinline__ void stage_rc(int b, int& R, int& C) { const int st = b / 1024, sb = b % 1024, swz = sb ^ (((sb >> 9) & 1) << 5); R = (st >> 1) * 16 + swz / 64; C = (st & 1) * 32 + (swz % 64) / 2; }
__host__ __device__ __forceinline__ int perm32(int rho) { const int n = rho >> 4, i = rho & 15; return 8 * (i >> 2) + 4 * n + (i & 3); }

struct Unit { int pm, pn; };
struct Gemm { const bf16_t* A; const bf16_t* Bt; int lda, ldb, K, adiv, astride; };

struct StaticOrder {
    int nM, nN, nwg, G, c;
    __device__ void init(int M, int N, int G_, int c_) { nM = M / BM; nN = N / BM; nwg = nM * nN; G = G_; c = c_; }
    __device__ bool next(int i, Unit& u) const {
        const long L = (long)i * G + c; if (L >= nwg) return false;
        int wgid = (int)L; { const int q = nwg / NXCD, r = nwg % NXCD, xcd = wgid % NXCD, off = wgid / NXCD; wgid = (xcd < r ? xcd * (q + 1) : r * (q + 1) + (xcd - r) * q) + off; }
        const int nig = WGM * nN, gid = wgid / nig, fm = gid * WGM, gsz = (nM - fm) < WGM ? (nM - fm) : WGM;
        u.pm = fm + ((wgid % nig) % gsz); u.pn = (wgid % nig) / gsz; return true;
    }
};

__device__ __forceinline__ unsigned cvt_pk_bf16(float lo, float hi) { unsigned r; asm volatile("v_cvt_pk_bf16_f32 %0, %1, %2" : "=v"(r) : "v"(lo), "v"(hi)); return r; }

template <int MODE> struct Epi {
    bf16_t* O; float* Of; const float* base; const float* bias; int ldc;
    const float* ssq;
    bf16_t* XBo; float* SSQo; LAS float* lx;
    __device__ __forceinline__ void operator()(const f32x4 (&acc)[2][2][4][2], const Unit& u, int wr, int wc, int fr, int fq) const {
        const int row0 = u.pm * BM + wr * 64 + fr, col0 = u.pn * BM + wc * 32 + 8 * fq;
        int kind = 0; float sc = 1.f;
        if (MODE == 0) { const int pn = u.pn; if (pn >= 33) kind = 2; else if (pn < 2 || pn == 6 || pn == 7 || pn == 12 || pn == 13 || pn == 18 || pn == 19 || pn == 24 || pn == 25) sc = C2; }
        float rsv[2][4]; f32x4 bv[2][2];
#pragma unroll
        for (int ai = 0; ai < 2; ++ai)
#pragma unroll
            for (int m = 0; m < 4; ++m) { rsv[ai][m] = 1.f;
                if (MODE == 0 || MODE == 2) { const f32x4 q = *(const f32x4*)(ssq + (size_t)(row0 + ai * HALF + m * 16) * 4); rsv[ai][m] = rsqrtf(((q[0] + q[1]) + (q[2] + q[3])) * (1.f / 1024.f) + EPS); } }
#pragma unroll
        for (int bj = 0; bj < 2; ++bj)
#pragma unroll
            for (int n = 0; n < 2; ++n) { bv[bj][n] = (f32x4){0.f, 0.f, 0.f, 0.f}; if (MODE == 0) { if (kind == 2) bv[bj][n] = *(const f32x4*)(bias + col0 + bj * HALF - COL_GATE + 4 * n); } }
        f32x4 nb[2][2];
        if (MODE == 3) {
#pragma unroll
            for (int bj = 0; bj < 2; ++bj)
#pragma unroll
                for (int n = 0; n < 2; ++n) nb[bj][n] = *(const f32x4*)(base + (size_t)row0 * ldc + col0 + bj * HALF + 4 * n);
        }
#pragma unroll
        for (int ai = 0; ai < 2; ++ai)
#pragma unroll
            for (int m = 0; m < 4; ++m) { const size_t roff = (size_t)(row0 + ai * HALF + m * 16) * ldc; float psq = 0.f; const float rs = rsv[ai][m];
                f32x4 cb[2][2];
                if (MODE == 3) {
#pragma unroll
                    for (int bj = 0; bj < 2; ++bj)
#pragma unroll
                        for (int n = 0; n < 2; ++n) cb[bj][n] = nb[bj][n];
                    const int g1 = ai * 4 + m + 1;
                    if (g1 < 8) { const size_t r1 = (size_t)(row0 + (g1 >> 2) * HALF + (g1 & 3) * 16) * ldc;
#pragma unroll
                        for (int bj = 0; bj < 2; ++bj)
#pragma unroll
                            for (int n = 0; n < 2; ++n) nb[bj][n] = *(const f32x4*)(base + r1 + col0 + bj * HALF + 4 * n); }
                }
#pragma unroll
                for (int bj = 0; bj < 2; ++bj) { const int col = col0 + bj * HALF; f32x4 v0 = acc[ai][bj][m][0], v1 = acc[ai][bj][m][1];
                    if (MODE == 3) {
                        v0 = cb[bj][0] + v0; v1 = cb[bj][1] + v1;
                        *(f32x4*)(Of + roff + col) = v0; *(f32x4*)(Of + roff + col + 4) = v1;
                        psq += (v0[0] * v0[0] + v0[1] * v0[1]) + (v0[2] * v0[2] + v0[3] * v0[3]) + (v1[0] * v1[0] + v1[1] * v1[1]) + (v1[2] * v1[2] + v1[3] * v1[3]);
                        u32x4 w; w.x = cvt_pk_bf16(v0[0], v0[1]); w.y = cvt_pk_bf16(v0[2], v0[3]); w.z = cvt_pk_bf16(v1[0], v1[1]); w.w = cvt_pk_bf16(v1[2], v1[3]);
                        *(u32x4*)(XBo + roff + col) = w;
                    } else {
                        if (MODE == 0 || MODE == 2) { v0 = v0 * rs; v1 = v1 * rs; }
                        if (MODE == 0) {
                            if (kind == 2) {
#pragma unroll
                                for (int e = 0; e < 4; ++e) { v0[e] = 1.f / (1.f + __expf(-(v0[e] + bv[bj][0][e]))); v1[e] = 1.f / (1.f + __expf(-(v1[e] + bv[bj][1][e]))); } }
                            else { v0 = v0 * sc; v1 = v1 * sc; }
                        }
                        if (MODE == 2) {
#pragma unroll
                            for (int e = 0; e < 4; ++e) { const float a = fmaxf(v0[e], 0.f), b = fmaxf(v1[e], 0.f); v0[e] = a * a; v1[e] = b * b; } }
                        u32x4 w; w.x = cvt_pk_bf16(v0[0], v0[1]); w.y = cvt_pk_bf16(v0[2], v0[3]); w.z = cvt_pk_bf16(v1[0], v1[1]); w.w = cvt_pk_bf16(v1[2], v1[3]);
                        *(u32x4*)(O + roff + col) = w;
                    } }
                if (MODE == 3) { psq += __shfl_xor(psq, 16); psq += __shfl_xor(psq, 32); if (fq == 0) lx[(ai * HALF + wr * 64 + m * 16 + fr) * 4 + wc] = psq; }
            }
        if (MODE == 3) {
            asm volatile("s_waitcnt lgkmcnt(0)" ::: "memory"); __builtin_amdgcn_s_barrier(); asm volatile("" ::: "memory");
            const int t = threadIdx.x;
            if (t < 256) { const f32x4 q = *(const LAS f32x4*)(lx + t * 4); SSQo[(size_t)(u.pm * BM + t) * 4 + u.pn] = (q[0] + q[1]) + (q[2] + q[3]); }
        }
    }
};

template <class EpiT>
__device__ __forceinline__ void gemm_phase(LAS unsigned char* lds, const Gemm g, const StaticOrder& S, const EpiT& E) {
    int tid_ = threadIdx.x; asm volatile("" : "+v"(tid_));
    const int tid = tid_, wid = __builtin_amdgcn_readfirstlane(tid >> 6), lane = tid & 63, wr = wid >> 2, wc = wid & 3, fr = lane & 15, fq = lane >> 4;
    const int K = g.K, nt = K / BK;
    unsigned voffA[2], voffB[2];
#pragma unroll
    for (int i = 0; i < 2; ++i) { int R, C; stage_rc(tid * 16 + i * 8192, R, C); const int Rb = (R & ~31) + perm32(R & 31);
        voffA[i] = (unsigned)(R * g.lda + C) * 2u; voffB[i] = (unsigned)(Rb * g.ldb + C) * 2u; }
    const size_t kstep = (size_t)(BK * 2);
    const size_t hA = (size_t)HALF * g.lda * 2, hB = (size_t)HALF * g.ldb * 2;
    const size_t tA = 2 * hA, tB = 2 * hB;
    const unsigned ldsw = (unsigned)wid * 1024u;
    const int aoff = lds_byte(wr * 64 + fr, fq * 8), boff = lds_byte(wc * 32 + fr, fq * 8);
#define PG8_SA(b, h) (((b) * 2 + (h)) * HTB)
#define PG8_SB(b, h) ((4 + (b) * 2 + (h)) * HTB)
#define PG8_STAGE(bufoff, gbase, voff) do { _Pragma("unroll") for (int _i = 0; _i < 2; ++_i) \
        __builtin_amdgcn_global_load_lds((const unsigned*)((const char*)(gbase) + (voff)[_i]), (LAS unsigned*)(lds + (bufoff) + ldsw + _i * 8192), 16, 0, 0); } while (0)
#define PG8_LDA(dst, b, h) do { _Pragma("unroll") for (int m = 0; m < 4; ++m) _Pragma("unroll") for (int k = 0; k < 2; ++k) dst[m][k] = *(const LAS bf16x8*)(lds + PG8_SA(b, h) + aoff + m * 2048 + k * 1024); } while (0)
#define PG8_LDB(dst, b, h) do { _Pragma("unroll") for (int n = 0; n < 2; ++n) _Pragma("unroll") for (int k = 0; k < 2; ++k) dst[n][k] = *(const LAS bf16x8*)(lds + PG8_SB(b, h) + boff + n * 2048 + k * 1024); } while (0)
#define PG8_MMA(ai, bj, At, Bt) do { __builtin_amdgcn_s_setprio(1); _Pragma("unroll") for (int m = 0; m < 4; ++m) _Pragma("unroll") for (int n = 0; n < 2; ++n) _Pragma("unroll") for (int k = 0; k < 2; ++k) \
        acc[ai][bj][m][n] = __builtin_amdgcn_mfma_f32_16x16x32_bf16(Bt[n][k], At[m][k], acc[ai][bj][m][n], 0, 0, 0); __builtin_amdgcn_s_setprio(0); } while (0)
#define PG8_WAIT_V(n) asm volatile("s_waitcnt vmcnt(" #n ")" ::: "memory")
#define PG8_WAIT_L(n) asm volatile("s_waitcnt lgkmcnt(" #n ")" ::: "memory")
#define PG8_BAR __builtin_amdgcn_s_barrier()
#define PG8_SCHED __builtin_amdgcn_sched_barrier(0)
#define PG8_PA(u) ((const char*)g.A + (size_t)(u).pm * tA + (size_t)((u).pn / g.adiv) * (size_t)g.astride * 2)
#define PG8_PB(u) ((const char*)g.Bt + (size_t)(u).pn * tB)
    Unit cur, nxt; int ui = 0;
    if (!S.next(0, cur)) return;
    f32x4 acc[2][2][4][2];
#pragma unroll
    for (int a = 0; a < 2; ++a)
#pragma unroll
        for (int b = 0; b < 2; ++b)
#pragma unroll
            for (int m = 0; m < 4; ++m)
#pragma unroll
                for (int n = 0; n < 2; ++n) acc[a][b][m][n] = (f32x4){0.f, 0.f, 0.f, 0.f};
    bf16x8 At[4][2], B0[2][2], B1[2][2];
    const char* cA = PG8_PA(cur); const char* cB = PG8_PB(cur);
    PG8_STAGE(PG8_SB(0, 0), cB, voffB); PG8_STAGE(PG8_SB(0, 1), cB + hB, voffB); PG8_STAGE(PG8_SA(0, 0), cA, voffA); PG8_STAGE(PG8_SA(0, 1), cA + hA, voffA);
    if (wr == 1) PG8_BAR;
    PG8_WAIT_V(2); PG8_BAR;
    PG8_STAGE(PG8_SB(1, 0), cB + kstep, voffB); PG8_STAGE(PG8_SA(1, 0), cA + kstep, voffA); PG8_STAGE(PG8_SB(1, 1), cB + hB + kstep, voffB);
    PG8_WAIT_V(6); PG8_BAR;
    for (;;) {
        const bool has_next = S.next(ui + 1, nxt);
        const char* nA = has_next ? PG8_PA(nxt) : cA; const char* nB = has_next ? PG8_PB(nxt) : cB;
        for (int t = 0; t < nt; t += 2) {
            const bool last = (t == nt - 2);
            const char* a1 = cA + (size_t)(t + 1) * kstep;
            const char* a2 = last ? nA : cA + (size_t)(t + 2) * kstep; const char* b2 = last ? nB : cB + (size_t)(t + 2) * kstep;
            const char* a3 = a2 + kstep; const char* b3 = b2 + kstep;
            PG8_LDB(B0, 0, 0); PG8_LDB(B1, 0, 1); PG8_SCHED; PG8_LDA(At, 0, 0); PG8_STAGE(PG8_SA(1, 1), a1 + hA, voffA);
            PG8_WAIT_V(8); PG8_WAIT_L(0); PG8_BAR; PG8_MMA(0, 0, At, B0); PG8_MMA(0, 1, At, B1); PG8_BAR; PG8_SCHED;
            PG8_LDA(At, 0, 1); PG8_STAGE(PG8_SB(0, 0), b2, voffB); PG8_STAGE(PG8_SB(0, 1), b2 + hB, voffB); PG8_STAGE(PG8_SA(0, 0), a2, voffA);
            PG8_WAIT_V(8); PG8_WAIT_L(0); PG8_BAR; PG8_MMA(1, 0, At, B0); PG8_MMA(1, 1, At, B1); PG8_BAR; PG8_SCHED;
            PG8_LDB(B0, 1, 0); PG8_LDB(B1, 1, 1); PG8_SCHED; PG8_LDA(At, 1, 0); PG8_STAGE(PG8_SA(0, 1), a2 + hA, voffA);
            PG8_WAIT_V(8); PG8_WAIT_L(0); PG8_BAR; PG8_MMA(0, 0, At, B0); PG8_MMA(0, 1, At, B1); PG8_BAR; PG8_SCHED;
            PG8_LDA(At, 1, 1); PG8_STAGE(PG8_SB(1, 0), b3, voffB); PG8_STAGE(PG8_SB(1, 1), b3 + hB, voffB); PG8_STAGE(PG8_SA(1, 0), a3, voffA);
            PG8_WAIT_V(8); PG8_WAIT_L(0); PG8_BAR; PG8_MMA(1, 0, At, B0); PG8_MMA(1, 1, At, B1); PG8_BAR; PG8_SCHED;
        }
        if (wr == 0) PG8_BAR;
        E(acc, cur, wr, wc, fr, fq);
        if (!has_next) break;
#pragma unroll
        for (int a = 0; a < 2; ++a)
#pragma unroll
            for (int b = 0; b < 2; ++b)
#pragma unroll
                for (int m = 0; m < 4; ++m)
#pragma unroll
                    for (int n = 0; n < 2; ++n) acc[a][b][m][n] = (f32x4){0.f, 0.f, 0.f, 0.f};
        cur = nxt; cA = nA; cB = nB; ++ui;
        if (wr == 1) PG8_BAR;
    }
    PG8_WAIT_V(0);
    PG8_BAR;
#undef PG8_SA
#undef PG8_SB
#undef PG8_STAGE
#undef PG8_LDA
#undef PG8_LDB
#undef PG8_MMA
#undef PG8_WAIT_V
#undef PG8_WAIT_L
#undef PG8_BAR
#undef PG8_SCHED
#undef PG8_PA
#undef PG8_PB
}
}

namespace attn_body {
using bf16 = __hip_bfloat16;
using s16x4 = __attribute__((ext_vector_type(4))) short;
using f32x16 = __attribute__((ext_vector_type(16))) float;
constexpr int NW = 8, QBLK = 32, QB = QBLK * NW, KVBLK = 64;
constexpr int MA = 0, MB = 1, MC = 2, MD = 3;
__device__ __forceinline__ int crow(int r, int hi) { return (r & 3) + 8 * (r >> 2) + 4 * hi; }
#define SBAR() __builtin_amdgcn_sched_barrier(0)
constexpr int NSLOT = 3, SLOTB = 8192;
constexpr int LDS_K = 0, LDS_V = NSLOT * SLOTB, LDS_WS = 2 * NSLOT * SLOTB, LDS_OST = LDS_WS + NW * 64 * 4, LDS_ATT = LDS_OST + NW * 4096;
typedef __attribute__((address_space(3))) const char* lds_cptr;
typedef __attribute__((address_space(3))) const float* lds_fptr;

struct AttnArgs {
    const bf16* Q; const bf16* K; const bf16* V; bf16* O;
    int qs, ks, os;
    int NT, tlo, thi;
    float s2;
    int q0;
    int kb;
    float* stat; int ss;
    lds_fptr tab;
};

__device__ __forceinline__ void glds16(const void* gsrc, unsigned lds_dst) { unsigned keep;
  asm volatile("s_mov_b32 %0, m0\n\ts_mov_b32 m0, %2\n\ts_nop 0\n\tglobal_load_lds_dwordx4 %1, off\n\ts_mov_b32 m0, %0" : "=&s"(keep) : "v"(gsrc), "s"(lds_dst) : "memory"); }
__device__ __forceinline__ float max3f(float a, float b, float c) { float r; asm("v_max3_f32 %0, %1, %2, %3" : "=v"(r) : "v"(a), "v"(b), "v"(c)); return r; }
__device__ __forceinline__ float max2f(float a, float b) { float r; asm("v_max_f32_e32 %0, %1, %2" : "=v"(r) : "v"(a), "v"(b)); return r; }
__device__ __forceinline__ float fadd_s(float a, float b) { float r; asm("v_add_f32_e32 %0, %1, %2" : "=v"(r) : "v"(a), "v"(b)); return r; }
__device__ __forceinline__ float fsub_s(float a, float b) { float r; asm("v_sub_f32_e32 %0, %1, %2" : "=v"(r) : "v"(a), "v"(b)); return r; }
typedef float f32x2_t __attribute__((ext_vector_type(2))); typedef __bf16 bf16x2_t __attribute__((ext_vector_type(2)));
__device__ __forceinline__ unsigned cvtpk_s(float lo, float hi) { f32x2_t v = {lo, hi}; bf16x2_t b = __builtin_convertvector(v, bf16x2_t); return __builtin_bit_cast(unsigned, b); }
#define WAIT_BAR(N) asm volatile("s_waitcnt vmcnt(" #N ") lgkmcnt(0)\n\ts_barrier" ::: "memory")

__device__ __forceinline__ void qkt(f32x16& p0, f32x16& p1, const char* Kslot, const bf16x8* qr, const f32x16& negm, int r32, int hi) {
  const char* kb = Kslot + hi * 1024 + r32 * 16;
  #pragma unroll
  for (int d0 = 0; d0 < 4; ++d0) {
    const bf16x8 b0 = *reinterpret_cast<const bf16x8*>(kb + d0 * 2048);
    const bf16x8 b1 = *reinterpret_cast<const bf16x8*>(kb + d0 * 2048 + 512);
    if (d0 == 0) { p0 = __builtin_amdgcn_mfma_f32_32x32x16_bf16(b0, qr[0], negm, 0, 0, 0); p1 = __builtin_amdgcn_mfma_f32_32x32x16_bf16(b1, qr[0], negm, 0, 0, 0); }
    else { p0 = __builtin_amdgcn_mfma_f32_32x32x16_bf16(b0, qr[d0], p0, 0, 0, 0); p1 = __builtin_amdgcn_mfma_f32_32x32x16_bf16(b1, qr[d0], p1, 0, 0, 0); } }
}
typedef short v4i16_t __attribute__((ext_vector_type(4)));
__device__ __forceinline__ void kload8(bf16x8* kf, lds_cptr kp) {
  kf[0] = *(const LAS bf16x8*)(kp);        kf[1] = *(const LAS bf16x8*)(kp + 512);
  kf[2] = *(const LAS bf16x8*)(kp + 2048); kf[3] = *(const LAS bf16x8*)(kp + 2560);
  kf[4] = *(const LAS bf16x8*)(kp + 4096); kf[5] = *(const LAS bf16x8*)(kp + 4608);
  kf[6] = *(const LAS bf16x8*)(kp + 6144); kf[7] = *(const LAS bf16x8*)(kp + 6656);
}
__device__ __forceinline__ void kload2(bf16x8* kf, lds_cptr kp, int j) { kf[2 * j] = *(const LAS bf16x8*)(kp + j * 2048); kf[2 * j + 1] = *(const LAS bf16x8*)(kp + j * 2048 + 512); }
__device__ __forceinline__ s16x4 vtr(lds_cptr p) { return __builtin_bit_cast(s16x4, __builtin_amdgcn_ds_read_tr16_b64_v4i16((LAS v4i16_t*)p)); }
__device__ __forceinline__ float rowmax(const f32x16& p0, const f32x16& p1) {
  float a = max3f(p0[0], p0[1], p1[0]), b = max3f(p0[2], p0[3], p1[1]); a = max3f(a, p1[2], p1[3]);
  #pragma unroll
  for (int r = 4; r < 16; r += 4) { a = max3f(a, p0[r], p0[r + 1]); b = max3f(b, p0[r + 2], p0[r + 3]); a = max3f(a, p1[r], p1[r + 1]); b = max3f(b, p1[r + 2], p1[r + 3]); }
  const float m = max2f(a, b);
  auto rr = __builtin_amdgcn_permlane32_swap(__float_as_uint(m), __float_as_uint(m), false, false);
  return max2f(__uint_as_float(rr[0]), __uint_as_float(rr[1]));
}
__device__ __forceinline__ void pv(f32x16* o, int vb, bf16x8 pa0, bf16x8 pa1, bf16x8 pa2, bf16x8 pa3) {
  #pragma unroll
  for (int d0 = 0; d0 < 2; ++d0) { s16x4 lo[4], hi[4];
    #pragma unroll
    for (int ks = 0; ks < 4; ++ks) {
      asm volatile("ds_read_b64_tr_b16 %0,%1 offset:%c2" : "=&v"(lo[ks]) : "v"(vb), "i"(d0 * 4096 + ks * 1024) : "memory");
      asm volatile("ds_read_b64_tr_b16 %0,%1 offset:%c2" : "=&v"(hi[ks]) : "v"(vb), "i"(d0 * 4096 + ks * 1024 + 512) : "memory"); }
    asm volatile("s_waitcnt lgkmcnt(0)" ::: "memory"); SBAR();
    #define PK(k) (bf16x8){lo[k][0], lo[k][1], lo[k][2], lo[k][3], hi[k][0], hi[k][1], hi[k][2], hi[k][3]}
    o[d0] = __builtin_amdgcn_mfma_f32_32x32x16_bf16(pa0, PK(0), o[d0], 0, 0, 0);
    o[d0] = __builtin_amdgcn_mfma_f32_32x32x16_bf16(pa1, PK(1), o[d0], 0, 0, 0);
    o[d0] = __builtin_amdgcn_mfma_f32_32x32x16_bf16(pa2, PK(2), o[d0], 0, 0, 0);
    o[d0] = __builtin_amdgcn_mfma_f32_32x32x16_bf16(pa3, PK(3), o[d0], 0, 0, 0);
    #undef PK
  }
}

template <int MODE> __device__ __forceinline__ void score_hook(f32x16& c0, f32x16& c1, int t, const AttnArgs& a, int qrel, int hi, int wid, int r32, float mh) {
  if constexpr (MODE == MA) {
    const int wlo = a.q0 + wid * QBLK, sd = (64 * t + 63 < wlo) ? 1 : ((64 * t > wlo + 31) ? -1 : 0);
    if (sd != 0) { const float sv = (float)sd * a.s2;
      #pragma unroll
      for (int r = 0; r < 16; ++r) { const float kf = (float)((r & 3) + 8 * (r >> 2)); c0[r] = fmaf(kf, sv, c0[r]); c1[r] = fmaf(kf + 32.f, sv, c1[r]); if ((r & 3) == 3) __builtin_amdgcn_sched_barrier(0); }
    } else {
      const float dq = (float)(a.q0 + qrel - 64 * t - 4 * hi), ns = -a.s2;
      #pragma unroll
      for (int r = 0; r < 16; ++r) { const float kf = (float)((r & 3) + 8 * (r >> 2)); c0[r] = fmaf(ns, fabsf(dq - kf), c0[r]); c1[r] = fmaf(ns, fabsf(dq - (kf + 32.f)), c1[r]); if ((r & 1) == 1) __builtin_amdgcn_sched_barrier(0); }
    }
  }
  if constexpr (MODE == MB) {
    const bool tv = (t >= a.tlo) && (t <= a.thi);
    const float dq = (float)(qrel + 64 - 64 * t - 4 * hi), ns = -a.s2;
    #pragma unroll
    for (int r = 0; r < 16; ++r) { const float kf = (float)((r & 3) + 8 * (r >> 2)); const float d0 = fabsf(dq - kf), d1 = fabsf(dq - (kf + 32.f));
      c0[r] = (tv && d0 <= 64.f) ? fmaf(ns, d0, c0[r] - mh) : -INFINITY; c1[r] = (tv && d1 <= 64.f) ? fmaf(ns, d1, c1[r] - mh) : -INFINITY;
      if ((r & 3) == 3) __builtin_amdgcn_sched_barrier(0); }
  }
  if constexpr (MODE == MC) {
    const int qrow = a.q0 + (wid >> 1), rs = min(max(qrow - 4, 0), 120), krow = a.kb + t;
    if (krow < rs || krow >= rs + 8) {
      #pragma unroll
      for (int r = 0; r < 16; ++r) { c0[r] = -INFINITY; c1[r] = -INFINITY; }
    } else {
      const int qc = (wid & 1) * 32 + r32, cs = min(max(qc - 8, 0), 48);
      const lds_fptr tp = a.tab + (krow - qrow + 7) * 31 + (15 - qc + 4 * hi);
      const int kd = 4 * hi - cs;
      #pragma unroll
      for (int r = 0; r < 16; ++r) { const int kc = (r & 3) + 8 * (r >> 2);
        const float b0 = tp[kc], b1 = tp[kc + 32];
        c0[r] = ((unsigned)(kd + kc) < 16u) ? c0[r] + (b0 - mh) : -INFINITY; c1[r] = ((unsigned)(kd + kc + 32) < 16u) ? c1[r] + (b1 - mh) : -INFINITY;
        if ((r & 3) == 3) __builtin_amdgcn_sched_barrier(0); }
    }
  }
}

template <int MODE, int THRL> __device__ __forceinline__ void attn_unit(const AttnArgs& A_, char* shm) {
  int tid_ = threadIdx.x; asm volatile("" : "+v"(tid_));
  const int tid = tid_, lane = tid & 63, r32 = lane & 31, hi = lane >> 5; const int wid = __builtin_amdgcn_readfirstlane(tid >> 6);
  const bf16* Qw = A_.Q + (wid * QBLK) * A_.qs;
  const unsigned lds0 = (unsigned)(uintptr_t)shm;
  float* wsf = (float*)(shm + LDS_WS) + wid * 64;
  const int ks = A_.ks;
  const bf16* ksrc = A_.K + (lane * ks + wid * 8);
  const bf16* vsrc = A_.V + ((16 * (wid & 3) + (lane >> 2)) * ks + (wid >> 2) * 32 + (lane & 3) * 8);
  const unsigned kdst = lds0 + LDS_K + wid * 1024, vdst = lds0 + LDS_V + wid * 1024;
  #define TT(t) ((MODE == MB) ? min(max((int)(t), A_.tlo), A_.thi) : (int)(t))
  #define DMA_K(t, slot) glds16(ksrc + TT(t) * KVBLK * ks, (unsigned)__builtin_amdgcn_readfirstlane(kdst + (slot)))
  #define DMA_V(t, slot) glds16(vsrc + TT(t) * KVBLK * ks, (unsigned)__builtin_amdgcn_readfirstlane(vdst + (slot)))
  const int vb0 = (int)(lds0 + LDS_V) + ((lane >> 4) & 1) * 32 + (lane & 3) * 8 + (4 * hi + ((lane & 15) >> 2)) * 64;
  const char* Kbase = shm + LDS_K; bf16x8 kf[8];
  const lds_cptr shm3 = (lds_cptr)shm; const lds_cptr kp0 = shm3 + LDS_K + hi * 1024 + r32 * 16; const lds_cptr vp0 = shm3 + LDS_V + ((lane >> 4) & 1) * 32 + (lane & 3) * 8 + (4 * hi + ((lane & 15) >> 2)) * 64;
  const int NT = A_.NT;
  DMA_K(0, 0); DMA_V(0, 0); DMA_K(1, SLOTB);
  bf16x8 qr[4];
  #pragma unroll
  for (int d0 = 0; d0 < 4; ++d0) qr[d0] = *reinterpret_cast<const bf16x8*>(&Qw[r32 * A_.qs + d0 * 16 + hi * 8]);
  float mhat = 0.f, l_reg = 0.f; f32x16 o[2]; o[0] = f32x16{}; o[1] = f32x16{}; f32x16 negm = f32x16{}; asm volatile("" : "+v"(negm));
  const int qrel = wid * QBLK + r32;
  constexpr bool NEGM = (MODE == MA || MODE == MD);
  #define CIN (NEGM ? negm : f32x16{})
  #define NEGM_SET(tn) do { float nb_ = -mhat; \
      if (MODE == MA) { const int wlo_ = A_.q0 + wid * QBLK, sd_ = (64 * (tn) + 63 < wlo_) ? 1 : ((64 * (tn) > wlo_ + 31) ? -1 : 0); \
        if (sd_ != 0) nb_ = fmaf(-(float)sd_ * A_.s2, (float)(A_.q0 + qrel - 64 * (tn) - 4 * hi), nb_); } \
      _Pragma("unroll") for (int r = 0; r < 16; ++r) negm[r] = nb_; asm volatile("" : "+v"(negm)); } while (0)
  #define CMASK(P0, P1, t) score_hook<MODE>(P0, P1, (t), A_, qrel, hi, wid, r32, mhat)
  bool resc = false;
  #define START(P0, P1) do { const float rm = rowmax(P0, P1); resc = false; \
    { const float dl = (MODE == MB || MODE == MC) ? fmaxf(rm, -2048.f) : rm; mhat = fadd_s(mhat, dl); \
      _Pragma("unroll") for (int r = 0; r < 16; ++r) { P0[r] = fsub_s(P0[r], dl); P1[r] = fsub_s(P1[r], dl); } \
      if (NEGM) { NEGM_SET(1); } } \
    _Pragma("unroll") for (int r = 0; r < 16; ++r) P0[r] = __builtin_amdgcn_exp2f(P0[r]); } while (0)
  #define RESC() do { if (resc) { asm volatile("s_waitcnt lgkmcnt(0)" ::: "memory"); \
      _Pragma("unroll") for (int d_ = 0; d_ < 2; ++d_) _Pragma("unroll") for (int r = 0; r < 16; ++r) o[d_][r] *= wsf[crow(r, hi)]; } } while (0)
  f32x16 pA0, pA1, pB0, pB1;
  int sl_prev = 0, sl_cur = 0, sl_next = SLOTB;
  #define ROT() do { sl_prev = sl_cur; sl_cur = sl_next; sl_next = (sl_next == (NSLOT - 1) * SLOTB) ? 0 : sl_next + SLOTB; } while (0)
  DMA_K(2, 2 * SLOTB);
  if (MODE == MA) { NEGM_SET(0); }
  WAIT_BAR(3);
  qkt(pA0, pA1, Kbase, qr, negm, r32, hi); asm volatile("s_nop 15\n\ts_nop 7" : "+v"(pA0), "+v"(pA1)); CMASK(pA0, pA1, 0);
  START(pA0, pA1);
  _Pragma("unroll") for (int r = 0; r < 16; ++r) pA1[r] = __builtin_amdgcn_exp2f(pA1[r]);
  WAIT_BAR(0);
  DMA_K(3, 0); DMA_V(1, SLOTB);
  ROT();
  kload8(kf, kp0 + sl_cur);
  WAIT_BAR(2);
  s16x4 vlo[8], vhi[8]; u32x4 pw0, pw1, pw2, pw3;
  #define PKW(P, B) cvtpk_s(P[B], P[B + 1])
  #define PAF(k) __builtin_bit_cast(bf16x8, pw##k)
  #define VFR(i) (bf16x8){vlo[i][0], vlo[i][1], vlo[i][2], vlo[i][3], vhi[i][0], vhi[i][1], vhi[i][2], vhi[i][3]}
  #define PIN(x) asm volatile("" : "+v"(x))
  #define MX3(a, b, c) __builtin_fmaxf(__builtin_fmaxf((a), (b)), (c))
  #define GAPA(MF, A0, A1, A2, A3, W0, W1, PW) do { MF; sacc += A0; sacc += A1; sacc += A2; sacc += A3; PIN(sacc); W0; W1; PIN(PW); SBAR(); } while (0)
  #define EX(v) __builtin_amdgcn_exp2f(v)
  #define GAPB(MF, X, B) do { MF; X[B] = EX(X[B]); X[B + 1] = EX(X[B + 1]); X[B + 2] = EX(X[B + 2]); X[B + 3] = EX(X[B + 3]); PIN(X); SBAR(); } while (0)
  #define VRD(i) do { vlo[i] = vtr(vp_ + (((i) >> 2) * 4096 + ((i) & 3) * 1024)); vhi[i] = vtr(vp_ + (((i) >> 2) * 4096 + ((i) & 3) * 1024 + 512)); } while (0)
  #define KRD(G, j) do { if (G) { kload2(kf, kp0 + sl_next, j); SBAR(); } } while (0)
  #define STEP(C0, C1, P0, P1, t, GK, GV, GL) do { SBAR(); \
    const lds_cptr vp_ = vp0 + sl_prev; \
    VRD(0); SBAR(); float sacc = (P0[0] + P0[1]); \
    GAPA(C0 = __builtin_amdgcn_mfma_f32_32x32x16_bf16(kf[0], qr[0], CIN, 0, 0, 0), P0[2], P0[3], P0[4], P0[5],     pw0[0] = PKW(P0, 0), pw0[1] = PKW(P0, 2), pw0); \
    VRD(4); SBAR(); GAPA(C1 = __builtin_amdgcn_mfma_f32_32x32x16_bf16(kf[1], qr[0], CIN, 0, 0, 0), P0[6], P0[7], P0[8], P0[9],     pw0[2] = PKW(P0, 4), pw0[3] = PKW(P0, 6), pw0); \
    VRD(1); SBAR(); GAPA(C0 = __builtin_amdgcn_mfma_f32_32x32x16_bf16(kf[2], qr[1], C0, 0, 0, 0),   P0[10], P0[11], P0[12], P0[13], pw1[0] = PKW(P0, 8), pw1[1] = PKW(P0, 10), pw1); \
    VRD(5); SBAR(); GAPA(C1 = __builtin_amdgcn_mfma_f32_32x32x16_bf16(kf[3], qr[1], C1, 0, 0, 0),   P0[14], P0[15], P1[0], P1[1],   pw1[2] = PKW(P0, 12), pw1[3] = PKW(P0, 14), pw1); \
    VRD(2); SBAR(); GAPA(C0 = __builtin_amdgcn_mfma_f32_32x32x16_bf16(kf[4], qr[2], C0, 0, 0, 0),   P1[2], P1[3], P1[4], P1[5],     pw2[0] = PKW(P1, 0), pw2[1] = PKW(P1, 2), pw2); \
    VRD(6); SBAR(); GAPA(C1 = __builtin_amdgcn_mfma_f32_32x32x16_bf16(kf[5], qr[2], C1, 0, 0, 0),   P1[6], P1[7], P1[8], P1[9],     pw2[2] = PKW(P1, 4), pw2[3] = PKW(P1, 6), pw2); \
    VRD(3); SBAR(); GAPA(C0 = __builtin_amdgcn_mfma_f32_32x32x16_bf16(kf[6], qr[3], C0, 0, 0, 0),   P1[10], P1[11], P1[12], P1[13], pw3[0] = PKW(P1, 8), pw3[1] = PKW(P1, 10), pw3); \
    VRD(7); SBAR(); GAPA(C1 = __builtin_amdgcn_mfma_f32_32x32x16_bf16(kf[7], qr[3], C1, 0, 0, 0),   P1[14], P1[15], 0.f, 0.f,       pw3[2] = PKW(P1, 12), pw3[3] = PKW(P1, 14), pw3); \
    l_reg += sacc; \
    if (GK) { DMA_K((t) + 3, sl_cur); } if (GV) { DMA_V((t) + 1, sl_next); } \
    CMASK(C0, C1, t); \
    { float a = MX3(C0[0], C0[1], C1[0]), b = MX3(C0[2], C0[3], C1[1]); a = MX3(a, C1[2], C1[3]); \
      _Pragma("unroll") for (int r = 4; r < 16; r += 4) { a = MX3(a, C0[r], C0[r + 1]); b = MX3(b, C0[r + 2], C0[r + 3]); a = MX3(a, C1[r], C1[r + 1]); b = MX3(b, C1[r + 2], C1[r + 3]); } \
      float rm = __builtin_fmaxf(a, b); { auto rr = __builtin_amdgcn_permlane32_swap(__float_as_uint(rm), __float_as_uint(rm), false, false); rm = __builtin_fmaxf(__uint_as_float(rr[0]), __uint_as_float(rr[1])); } \
      resc = false; \
      if (__builtin_expect(__any(rm > (float)THRL), 0)) { const float dl = __builtin_fmaxf(rm, 0.f); mhat += dl; \
        _Pragma("unroll") for (int r = 0; r < 16; ++r) { C0[r] -= dl; C1[r] -= dl; } \
        if (MODE == MD) { NEGM_SET(0); } \
        const float f = __builtin_amdgcn_exp2f(-dl); l_reg *= f; if (hi == 0) wsf[r32] = f; resc = true; } \
      if (MODE == MA) { NEGM_SET((t) + 1); } } \
    SBAR(); \
    GAPB(o[0] = __builtin_amdgcn_mfma_f32_32x32x16_bf16(PAF(0), VFR(0), o[0], 0, 0, 0), C0, 0); \
    GAPB(o[1] = __builtin_amdgcn_mfma_f32_32x32x16_bf16(PAF(0), VFR(4), o[1], 0, 0, 0), C0, 4); \
    KRD(GL, 0); GAPB(o[0] = __builtin_amdgcn_mfma_f32_32x32x16_bf16(PAF(1), VFR(1), o[0], 0, 0, 0), C0, 8); \
    KRD(GL, 1); GAPB(o[1] = __builtin_amdgcn_mfma_f32_32x32x16_bf16(PAF(1), VFR(5), o[1], 0, 0, 0), C0, 12); \
    KRD(GL, 2); GAPB(o[0] = __builtin_amdgcn_mfma_f32_32x32x16_bf16(PAF(2), VFR(2), o[0], 0, 0, 0), C1, 0); \
    KRD(GL, 3); GAPB(o[1] = __builtin_amdgcn_mfma_f32_32x32x16_bf16(PAF(2), VFR(6), o[1], 0, 0, 0), C1, 4); \
    GAPB(o[0] = __builtin_amdgcn_mfma_f32_32x32x16_bf16(PAF(3), VFR(3), o[0], 0, 0, 0), C1, 8); \
    GAPB(o[1] = __builtin_amdgcn_mfma_f32_32x32x16_bf16(PAF(3), VFR(7), o[1], 0, 0, 0), C1, 12); \
    } while (0)
  int t = 1;
  for (; t + 5 < NT; t += 2) {
    STEP(pB0, pB1, pA0, pA1, t, true, true, true);     WAIT_BAR(2); RESC(); ROT();
    STEP(pA0, pA1, pB0, pB1, t + 1, true, true, true); WAIT_BAR(2); RESC(); ROT();
  }
  #define ENDW(tt) do { if ((tt) + 3 < NT) { WAIT_BAR(2); } else if ((tt) + 2 < NT) { WAIT_BAR(1); } else { WAIT_BAR(0); } } while (0)
  for (; t + 1 < NT; t += 2) {
    STEP(pB0, pB1, pA0, pA1, t, (t + 3 < NT), (t + 1 < NT), (t + 1 < NT));         ENDW(t);     RESC(); ROT();
    STEP(pA0, pA1, pB0, pB1, t + 1, (t + 4 < NT), (t + 2 < NT), (t + 2 < NT));     ENDW(t + 1); RESC(); ROT();
  }
  STEP(pB0, pB1, pA0, pA1, NT - 1, false, false, false); RESC();
  { float sacc = pB0[0] + pB0[1]; _Pragma("unroll") for (int r = 2; r < 16; ++r) sacc += pB0[r]; _Pragma("unroll") for (int r = 0; r < 16; ++r) sacc += pB1[r]; l_reg += sacc;
    pw0 = (u32x4){PKW(pB0, 0), PKW(pB0, 2), PKW(pB0, 4), PKW(pB0, 6)}; pw1 = (u32x4){PKW(pB0, 8), PKW(pB0, 10), PKW(pB0, 12), PKW(pB0, 14)}; pw2 = (u32x4){PKW(pB1, 0), PKW(pB1, 2), PKW(pB1, 4), PKW(pB1, 6)}; pw3 = (u32x4){PKW(pB1, 8), PKW(pB1, 10), PKW(pB1, 12), PKW(pB1, 14)};
    SBAR(); pv(o, vb0 + sl_cur, PAF(0), PAF(1), PAF(2), PAF(3)); }
  #undef PKW
  #undef PAF
  #undef VFR
  #undef PIN
  #undef MX3
  #undef GAPA
  #undef GAPB
  #undef EX
  #undef VRD
  #undef KRD
  #undef STEP
  #undef ENDW
  { auto rr = __builtin_amdgcn_permlane32_swap(__float_as_uint(l_reg), __float_as_uint(l_reg), false, false); l_reg = __uint_as_float(rr[0]) + __uint_as_float(rr[1]); }
  if (MODE == MB) { if (hi == 0) { float* sp = A_.stat + (wid * QBLK + r32) * A_.ss; sp[0] = mhat; sp[1] = l_reg; } }
  if (hi == 0) wsf[32 + r32] = l_reg; asm volatile("s_waitcnt lgkmcnt(0)" ::: "memory");
  float rli[16];
  #pragma unroll
  for (int r = 0; r < 16; ++r) rli[r] = __builtin_amdgcn_rcpf(wsf[32 + crow(r, hi)]);
  bf16* Ow = A_.O + (wid * QBLK) * A_.os;
  { bf16* stg = (bf16*)(shm + LDS_OST) + wid * 2048;
    #pragma unroll
    for (int r = 0; r < 16; ++r) { const int orow = crow(r, hi);
      #pragma unroll
      for (int d0 = 0; d0 < 2; ++d0) stg[orow * 64 + d0 * 32 + r32] = __float2bfloat16(o[d0][r] * rli[r]); }
    asm volatile("s_waitcnt lgkmcnt(0)" ::: "memory");
    #pragma unroll
    for (int i = 0; i < 4; ++i) { const int row = i * 8 + (lane >> 3), ch = lane & 7; const u32x4 v = *(const u32x4*)(stg + row * 64 + ch * 8); *(u32x4*)(Ow + row * A_.os + ch * 8) = v; } }
  asm volatile("s_waitcnt lgkmcnt(0)\n\ts_barrier" ::: "memory");
  #undef DMA_K
  #undef DMA_V
  #undef TT
  #undef CMASK
  #undef CIN
  #undef NEGM_SET
  #undef START
  #undef RESC
  #undef ROT
}

constexpr int L8_K = 0, L8_V = 3 * 8192, L8_WS = L8_V + 3 * 16384, L8_QO = L8_WS + 2048, L8_END = L8_QO + 8 * 4096;
template <int THRL> __device__ __forceinline__ void attn_unit128(const AttnArgs& A_, char* shm) {
  int tid_ = threadIdx.x; asm volatile("" : "+v"(tid_));
  const int tid = tid_, lane = tid & 63, r32 = lane & 31, hi = lane >> 5; const int wid = __builtin_amdgcn_readfirstlane(tid >> 6);
  const bf16* Qw = A_.Q + (wid * QBLK) * A_.qs;
  const unsigned lds0 = (unsigned)(uintptr_t)shm;
  float* wsf = (float*)(shm + L8_WS) + wid * 64;
  const int ks = A_.ks;
  const bf16* ksrc = A_.K + (lane * ks + wid * 8);
  const bf16* vsrc = A_.V + ((16 * (wid & 3) + (lane >> 2)) * ks + (wid >> 2) * 32 + (lane & 3) * 8);
  const unsigned kdst = lds0 + L8_K + wid * 1024, vdst = lds0 + L8_V + wid * 1024;
  #define DMA_K(t, slot) glds16(ksrc + (int)(t) * KVBLK * ks, (unsigned)__builtin_amdgcn_readfirstlane(kdst + (slot)))
  #define DMA_V(t, slot) do { glds16(vsrc + (int)(t) * KVBLK * ks, (unsigned)__builtin_amdgcn_readfirstlane(vdst + 2 * (slot))); \
                              glds16(vsrc + (int)(t) * KVBLK * ks + 64, (unsigned)__builtin_amdgcn_readfirstlane(vdst + 2 * (slot) + 8192)); } while (0)
  const int vb0 = (int)(lds0 + L8_V) + ((lane >> 4) & 1) * 32 + (lane & 3) * 8 + (4 * hi + ((lane & 15) >> 2)) * 64;
  const char* Kbase = shm + L8_K; bf16x8 kf[8];
  const lds_cptr shm3 = (lds_cptr)shm; const lds_cptr kp0 = shm3 + L8_K + hi * 1024 + r32 * 16; const lds_cptr vp0 = shm3 + L8_V + ((lane >> 4) & 1) * 32 + (lane & 3) * 8 + (4 * hi + ((lane & 15) >> 2)) * 64;
  const lds_cptr qst = shm3 + L8_QO + wid * 4096 + lane * 16;
  const int NT = A_.NT;
  DMA_K(0, 0); DMA_V(0, 0); DMA_K(1, SLOTB);
  { bf16x8 qr[4];
    #pragma unroll
    for (int d0 = 0; d0 < 4; ++d0) qr[d0] = *reinterpret_cast<const bf16x8*>(&Qw[r32 * A_.qs + d0 * 16 + hi * 8]);
    #pragma unroll
    for (int d0 = 0; d0 < 4; ++d0) *(LAS bf16x8*)(shm3 + L8_QO + wid * 4096 + lane * 16 + d0 * 1024) = qr[d0]; }
  #define QLD(d0) (*(const LAS bf16x8*)(qst + (d0) * 1024))
  float mhat = 0.f, l_reg = 0.f; f32x16 o[4]; o[0] = f32x16{}; o[1] = f32x16{}; o[2] = f32x16{}; o[3] = f32x16{};
  const int qrel = wid * QBLK + r32;
  #define NB(tn) ({ float nb_ = -mhat; const int wlo_ = A_.q0 + wid * QBLK, sd_ = (64 * (tn) + 63 < wlo_) ? 1 : ((64 * (tn) > wlo_ + 31) ? -1 : 0); \
      if (sd_ != 0) nb_ = fmaf(-(float)sd_ * A_.s2, (float)(A_.q0 + qrel - 64 * (tn) - 4 * hi), nb_); nb_; })
  #define CMASK(P0, P1, t) score_hook<MA>(P0, P1, (t), A_, qrel, hi, wid, r32, mhat)
  bool resc = false;
  #define RESC() do { if (resc) { asm volatile("s_waitcnt lgkmcnt(0)" ::: "memory"); \
      _Pragma("unroll") for (int d_ = 0; d_ < 4; ++d_) _Pragma("unroll") for (int r = 0; r < 16; ++r) o[d_][r] *= wsf[crow(r, hi)]; } } while (0)
  f32x16 pA0, pA1, pB0, pB1;
  int sl_prev = 0, sl_cur = 0, sl_next = SLOTB;
  #define ROT() do { sl_prev = sl_cur; sl_cur = sl_next; sl_next = (sl_next == (NSLOT - 1) * SLOTB) ? 0 : sl_next + SLOTB; } while (0)
  DMA_K(2, 2 * SLOTB);
  WAIT_BAR(4);
  { f32x16 cin; const float nb0 = NB(0);
    #pragma unroll
    for (int r = 0; r < 16; ++r) cin[r] = nb0;
    bf16x8 qr[4];
    #pragma unroll
    for (int d0 = 0; d0 < 4; ++d0) qr[d0] = QLD(d0);
    qkt(pA0, pA1, Kbase, qr, cin, r32, hi); }
  asm volatile("s_nop 15\n\ts_nop 7" : "+v"(pA0), "+v"(pA1)); CMASK(pA0, pA1, 0);
  { const float rm = rowmax(pA0, pA1); mhat = fadd_s(mhat, rm);
    #pragma unroll
    for (int r = 0; r < 16; ++r) { pA0[r] = fsub_s(pA0[r], rm); pA1[r] = fsub_s(pA1[r], rm); }
    #pragma unroll
    for (int r = 0; r < 16; ++r) pA0[r] = __builtin_amdgcn_exp2f(pA0[r]);
    #pragma unroll
    for (int r = 0; r < 16; ++r) pA1[r] = __builtin_amdgcn_exp2f(pA1[r]); }
  WAIT_BAR(0);
  DMA_K(3, 0); DMA_V(1, SLOTB);
  ROT();
  kload8(kf, kp0 + sl_cur);
  WAIT_BAR(3);
  u32x4 pw0, pw1, pw2, pw3;
  #define PKW(P, B) cvtpk_s(P[B], P[B + 1])
  #define PAF(k) __builtin_bit_cast(bf16x8, pw##k)
  #define VFR(i) (bf16x8){vlo[i][0], vlo[i][1], vlo[i][2], vlo[i][3], vhi[i][0], vhi[i][1], vhi[i][2], vhi[i][3]}
  #define WFR(i) (bf16x8){wlo[i][0], wlo[i][1], wlo[i][2], wlo[i][3], whi[i][0], whi[i][1], whi[i][2], whi[i][3]}
  #define PIN(x) asm volatile("" : "+v"(x))
  #define MX3(a, b, c) __builtin_fmaxf(__builtin_fmaxf((a), (b)), (c))
  #define GAPA(MF, A0, A1, A2, A3, W0, W1, PW) do { MF; sacc += A0; sacc += A1; sacc += A2; sacc += A3; PIN(sacc); W0; W1; PIN(PW); SBAR(); } while (0)
  #define EX(v) __builtin_amdgcn_exp2f(v)
  #define GAPB(MF, X, B) do { MF; X[B] = EX(X[B]); X[B + 1] = EX(X[B + 1]); PIN(X); SBAR(); } while (0)
  #define VRD(i) do { vlo[i] = vtr(vp_ + (((i) >> 2) * 4096 + ((i) & 3) * 1024)); vhi[i] = vtr(vp_ + (((i) >> 2) * 4096 + ((i) & 3) * 1024 + 512)); } while (0)
  #define VRD2(i) do { wlo[i] = vtr(vp_ + (8192 + ((i) >> 2) * 4096 + ((i) & 3) * 1024)); whi[i] = vtr(vp_ + (8192 + ((i) >> 2) * 4096 + ((i) & 3) * 1024 + 512)); SBAR(); } while (0)
  #define KRD(G, j) do { if (G) { kload2(kf, kp0 + sl_next, j); SBAR(); } } while (0)
  #define FOFF(j) (((((j) & 1) + 2 * ((j) >> 3)) * 4096) + ((((j) >> 1) & 3) * 1024))
  #define FRD(j) do { fl[j] = vtr(vp_ + FOFF(j)); fh[j] = vtr(vp_ + FOFF(j) + 512); SBAR(); } while (0)
  #define FFR(j) (bf16x8){fl[j][0], fl[j][1], fl[j][2], fl[j][3], fh[j][0], fh[j][1], fh[j][2], fh[j][3]}
  #define STEP(C0, C1, P0, P1, t, GK, GV, GL) do { SBAR(); \
    const lds_cptr vp_ = vp0 + 2 * sl_prev; s16x4 fl[16], fh[16]; \
    { const float nb_t = NB(t); _Pragma("unroll") for (int r = 0; r < 16; ++r) { C0[r] = nb_t; C1[r] = nb_t; } } \
    bf16x8 q0_ = QLD(0), q1_ = QLD(1); SBAR(); float sacc = (P0[0] + P0[1]); \
    GAPA(C0 = __builtin_amdgcn_mfma_f32_32x32x16_bf16(kf[0], q0_, C0, 0, 0, 0), P0[2], P0[3], P0[4], P0[5],     pw0[0] = PKW(P0, 0), pw0[1] = PKW(P0, 2), pw0); \
    GAPA(C1 = __builtin_amdgcn_mfma_f32_32x32x16_bf16(kf[1], q0_, C1, 0, 0, 0), P0[6], P0[7], P0[8], P0[9],     pw0[2] = PKW(P0, 4), pw0[3] = PKW(P0, 6), pw0); \
    q0_ = QLD(2); SBAR(); \
    GAPA(C0 = __builtin_amdgcn_mfma_f32_32x32x16_bf16(kf[2], q1_, C0, 0, 0, 0),   P0[10], P0[11], P0[12], P0[13], pw1[0] = PKW(P0, 8), pw1[1] = PKW(P0, 10), pw1); \
    GAPA(C1 = __builtin_amdgcn_mfma_f32_32x32x16_bf16(kf[3], q1_, C1, 0, 0, 0),   P0[14], P0[15], P1[0], P1[1],   pw1[2] = PKW(P0, 12), pw1[3] = PKW(P0, 14), pw1); \
    q1_ = QLD(3); SBAR(); \
    GAPA(C0 = __builtin_amdgcn_mfma_f32_32x32x16_bf16(kf[4], q0_, C0, 0, 0, 0),   P1[2], P1[3], P1[4], P1[5],     pw2[0] = PKW(P1, 0), pw2[1] = PKW(P1, 2), pw2); \
    GAPA(C1 = __builtin_amdgcn_mfma_f32_32x32x16_bf16(kf[5], q0_, C1, 0, 0, 0),   P1[6], P1[7], P1[8], P1[9],     pw2[2] = PKW(P1, 4), pw2[3] = PKW(P1, 6), pw2); \
    GAPA(C0 = __builtin_amdgcn_mfma_f32_32x32x16_bf16(kf[6], q1_, C0, 0, 0, 0),   P1[10], P1[11], P1[12], P1[13], pw3[0] = PKW(P1, 8), pw3[1] = PKW(P1, 10), pw3); \
    GAPA(C1 = __builtin_amdgcn_mfma_f32_32x32x16_bf16(kf[7], q1_, C1, 0, 0, 0),   P1[14], P1[15], 0.f, 0.f,       pw3[2] = PKW(P1, 12), pw3[3] = PKW(P1, 14), pw3); \
    l_reg += sacc; \
    if (GK) { DMA_K((t) + 3, sl_cur); } if (GV) { DMA_V((t) + 1, sl_next); } \
    FRD(0); FRD(1); FRD(2); \
    CMASK(C0, C1, t); \
    { float a = MX3(C0[0], C0[1], C1[0]), b = MX3(C0[2], C0[3], C1[1]); a = MX3(a, C1[2], C1[3]); \
      _Pragma("unroll") for (int r = 4; r < 16; r += 4) { a = MX3(a, C0[r], C0[r + 1]); b = MX3(b, C0[r + 2], C0[r + 3]); a = MX3(a, C1[r], C1[r + 1]); b = MX3(b, C1[r + 2], C1[r + 3]); } \
      float rm = __builtin_fmaxf(a, b); { auto rr = __builtin_amdgcn_permlane32_swap(__float_as_uint(rm), __float_as_uint(rm), false, false); rm = __builtin_fmaxf(__uint_as_float(rr[0]), __uint_as_float(rr[1])); } \
      resc = false; \
      if (__builtin_expect(__any(rm > (float)THRL), 0)) { const float dl = __builtin_fmaxf(rm, 0.f); mhat += dl; \
        _Pragma("unroll") for (int r = 0; r < 16; ++r) { C0[r] -= dl; C1[r] -= dl; } \
        const float f = __builtin_amdgcn_exp2f(-dl); l_reg *= f; if (hi == 0) wsf[r32] = f; resc = true; } } \
    SBAR(); \
    GAPB(o[0] = __builtin_amdgcn_mfma_f32_32x32x16_bf16(PAF(0), FFR(0), o[0], 0, 0, 0), C0, 0);   FRD(3); \
    GAPB(o[1] = __builtin_amdgcn_mfma_f32_32x32x16_bf16(PAF(0), FFR(1), o[1], 0, 0, 0), C0, 2);   FRD(4); \
    GAPB(o[0] = __builtin_amdgcn_mfma_f32_32x32x16_bf16(PAF(1), FFR(2), o[0], 0, 0, 0), C0, 4);   FRD(5); \
    GAPB(o[1] = __builtin_amdgcn_mfma_f32_32x32x16_bf16(PAF(1), FFR(3), o[1], 0, 0, 0), C0, 6);   FRD(6); \
    GAPB(o[0] = __builtin_amdgcn_mfma_f32_32x32x16_bf16(PAF(2), FFR(4), o[0], 0, 0, 0), C0, 8);   FRD(7); \
    GAPB(o[1] = __builtin_amdgcn_mfma_f32_32x32x16_bf16(PAF(2), FFR(5), o[1], 0, 0, 0), C0, 10);  FRD(8); \
    GAPB(o[0] = __builtin_amdgcn_mfma_f32_32x32x16_bf16(PAF(3), FFR(6), o[0], 0, 0, 0), C0, 12);  FRD(9); \
    GAPB(o[1] = __builtin_amdgcn_mfma_f32_32x32x16_bf16(PAF(3), FFR(7), o[1], 0, 0, 0), C0, 14);  FRD(10); \
    KRD(GL, 0); GAPB(o[2] = __builtin_amdgcn_mfma_f32_32x32x16_bf16(PAF(0), FFR(8), o[2], 0, 0, 0), C1, 0);   FRD(11); \
    KRD(GL, 1); GAPB(o[3] = __builtin_amdgcn_mfma_f32_32x32x16_bf16(PAF(0), FFR(9), o[3], 0, 0, 0), C1, 2);   FRD(12); \
    KRD(GL, 2); GAPB(o[2] = __builtin_amdgcn_mfma_f32_32x32x16_bf16(PAF(1), FFR(10), o[2], 0, 0, 0), C1, 4);  FRD(13); \
    KRD(GL, 3); GAPB(o[3] = __builtin_amdgcn_mfma_f32_32x32x16_bf16(PAF(1), FFR(11), o[3], 0, 0, 0), C1, 6);  FRD(14); \
    GAPB(o[2] = __builtin_amdgcn_mfma_f32_32x32x16_bf16(PAF(2), FFR(12), o[2], 0, 0, 0), C1, 8);  FRD(15); \
    GAPB(o[3] = __builtin_amdgcn_mfma_f32_32x32x16_bf16(PAF(2), FFR(13), o[3], 0, 0, 0), C1, 10); \
    GAPB(o[2] = __builtin_amdgcn_mfma_f32_32x32x16_bf16(PAF(3), FFR(14), o[2], 0, 0, 0), C1, 12); \
    GAPB(o[3] = __builtin_amdgcn_mfma_f32_32x32x16_bf16(PAF(3), FFR(15), o[3], 0, 0, 0), C1, 14); \
    } while (0)
  int t = 1;
  for (; t + 5 < NT; t += 2) {
    STEP(pB0, pB1, pA0, pA1, t, true, true, true);     WAIT_BAR(3); RESC(); ROT();
    STEP(pA0, pA1, pB0, pB1, t + 1, true, true, true); WAIT_BAR(3); RESC(); ROT();
  }
  #define ENDW(tt) do { if ((tt) + 3 < NT) { WAIT_BAR(3); } else if ((tt) + 2 < NT) { WAIT_BAR(2); } else { WAIT_BAR(0); } } while (0)
  for (; t + 1 < NT; t += 2) {
    STEP(pB0, pB1, pA0, pA1, t, (t + 3 < NT), (t + 1 < NT), (t + 1 < NT));         ENDW(t);     RESC(); ROT();
    STEP(pA0, pA1, pB0, pB1, t + 1, (t + 4 < NT), (t + 2 < NT), (t + 2 < NT));     ENDW(t + 1); RESC(); ROT();
  }
  STEP(pB0, pB1, pA0, pA1, NT - 1, false, false, false); RESC();
  { float sacc = pB0[0] + pB0[1]; _Pragma("unroll") for (int r = 2; r < 16; ++r) sacc += pB0[r]; _Pragma("unroll") for (int r = 0; r < 16; ++r) sacc += pB1[r]; l_reg += sacc;
    pw0 = (u32x4){PKW(pB0, 0), PKW(pB0, 2), PKW(pB0, 4), PKW(pB0, 6)}; pw1 = (u32x4){PKW(pB0, 8), PKW(pB0, 10), PKW(pB0, 12), PKW(pB0, 14)}; pw2 = (u32x4){PKW(pB1, 0), PKW(pB1, 2), PKW(pB1, 4), PKW(pB1, 6)}; pw3 = (u32x4){PKW(pB1, 8), PKW(pB1, 10), PKW(pB1, 12), PKW(pB1, 14)};
    SBAR(); pv(o, vb0 + 2 * sl_cur, PAF(0), PAF(1), PAF(2), PAF(3)); pv(o + 2, vb0 + 2 * sl_cur + 8192, PAF(0), PAF(1), PAF(2), PAF(3)); }
  #undef PKW
  #undef PAF
  #undef VFR
  #undef WFR
  #undef PIN
  #undef MX3
  #undef GAPA
  #undef GAPB
  #undef EX
  #undef VRD
  #undef FOFF
  #undef FRD
  #undef FFR
  #undef KRD
  #undef STEP
  #undef ENDW
  { auto rr = __builtin_amdgcn_permlane32_swap(__float_as_uint(l_reg), __float_as_uint(l_reg), false, false); l_reg = __uint_as_float(rr[0]) + __uint_as_float(rr[1]); }
  if (hi == 0) wsf[32 + r32] = l_reg; asm volatile("s_waitcnt lgkmcnt(0)" ::: "memory");
  float rli[16];
  #pragma unroll
  for (int r = 0; r < 16; ++r) rli[r] = __builtin_amdgcn_rcpf(wsf[32 + crow(r, hi)]);
  bf16* Ow = A_.O + (wid * QBLK) * A_.os;
  { bf16* stg = (bf16*)(shm + L8_QO) + wid * 2048;
    #pragma unroll
    for (int hv = 0; hv < 2; ++hv) {
      #pragma unroll
      for (int r = 0; r < 16; ++r) { const int orow = crow(r, hi);
        #pragma unroll
        for (int d0 = 0; d0 < 2; ++d0) stg[orow * 64 + d0 * 32 + r32] = __float2bfloat16(o[2 * hv + d0][r] * rli[r]); }
      asm volatile("s_waitcnt lgkmcnt(0)" ::: "memory");
      #pragma unroll
      for (int i = 0; i < 4; ++i) { const int row = i * 8 + (lane >> 3), ch = lane & 7; const u32x4 v = *(const u32x4*)(stg + row * 64 + ch * 8); *(u32x4*)(Ow + row * A_.os + hv * 64 + ch * 8) = v; }
      asm volatile("s_waitcnt lgkmcnt(0)" ::: "memory"); } }
  asm volatile("s_waitcnt lgkmcnt(0)\n\ts_barrier" ::: "memory");
  #undef DMA_K
  #undef DMA_V
  #undef QLD
  #undef NB
  #undef CMASK
  #undef RESC
  #undef ROT
}
#undef SBAR
#undef WAIT_BAR
}

__device__ __forceinline__ void transpose_item(const float* W, int K, int N, bf16_t* WT, LAS float* scr, int item, int lane, const float* gk = nullptr) {
    const int nblk = N / 32, kb = item / nblk, nb = item % nblk, k0 = 64 * kb, n0 = 32 * nb;
#pragma unroll 8
    for (int i = 0; i < 32; ++i) { const int kk = 2 * i + (lane >> 5); const float gg = gk ? gk[k0 + kk] : 1.f; scr[kk * 33 + (lane & 31)] = W[(size_t)(k0 + kk) * N + n0 + (lane & 31)] * gg; }
    asm volatile("s_waitcnt lgkmcnt(0)" ::: "memory");
    const int c = lane & 7;
#pragma unroll
    for (int j = 0; j < 4; ++j) { const int n = (lane >> 3) + 8 * j; const LAS float* s = scr + (8 * c) * 33 + n;
        u32x4 o; o.x = pk2(s[0 * 33], s[1 * 33]); o.y = pk2(s[2 * 33], s[3 * 33]); o.z = pk2(s[4 * 33], s[5 * 33]); o.w = pk2(s[6 * 33], s[7 * 33]);
        *(u32x4*)(WT + (size_t)(n0 + n) * K + k0 + 8 * c) = o; }
    asm volatile("s_waitcnt lgkmcnt(0)" ::: "memory");
}
__device__ __forceinline__ void rms_row_bf16(const float* xrow, const float* g, bf16_t* orow, int lane) {
    const f32x4* xr = (const f32x4*)xrow + lane; const f32x4* gr = (const f32x4*)g + lane;
    f32x4 v[4]; float s = 0.f;
#pragma unroll
    for (int j = 0; j < 4; ++j) { v[j] = xr[64 * j]; s += (v[j].x * v[j].x + v[j].y * v[j].y) + (v[j].z * v[j].z + v[j].w * v[j].w); }
    const float rs = rsqrtf(wave_sum(s) * (1.f / DM) + EPS);
    u32x2* o8 = (u32x2*)orow + lane;
#pragma unroll
    for (int j = 0; j < 4; ++j) { const f32x4 gg = gr[64 * j]; u32x2 w; w.x = pk2(v[j].x * rs * gg.x, v[j].y * rs * gg.y); w.y = pk2(v[j].z * rs * gg.z, v[j].w * rs * gg.w); o8[64 * j] = w; }
}
__device__ __forceinline__ void sincos_red(float a, float& s, float& c) {
    const float q = rintf(a * 0.636619772367581f); const int iq = (int)q;
    float r = fmaf(q, -1.5703125f, a); r = fmaf(q, -4.837512969970703125e-4f, r); r = fmaf(q, -7.54978995489188216e-8f, r);
    const float r2 = r * r;
    const float sp = r + r * r2 * (-1.6666654611e-1f + r2 * (8.3321608736e-3f + r2 * (-1.9515295891e-4f)));
    const float cp = 1.0f - 0.5f * r2 + r2 * r2 * (4.166664568298827e-2f + r2 * (-1.388731625493765e-3f + r2 * 2.443315711809948e-5f));
    const int k = iq & 3;
    s = (k == 0) ? sp : (k == 1) ? cp : (k == 2) ? -sp : -cp;
    c = (k == 0) ? cp : (k == 1) ? -sp : (k == 2) ? -cp : sp;
}

#define XB_TMO      128
#define XB_XCNT(j)  (256  + 64 * (j))
#define XB_XSUB(j)  (1280 + 64 * (j))
#define XB_XGEN(j)  (2304 + 64 * (j))
#define XB_TOP      3328
#define XB_TOPGEN   3392
#define XCD_BAR_WORDS 3456
#define XB_SPIN_CAP (1u << 18)

__device__ __forceinline__ unsigned xb_ld(unsigned* p)              { return __hip_atomic_load(p, __ATOMIC_RELAXED, __HIP_MEMORY_SCOPE_AGENT); }
__device__ __forceinline__ unsigned xb_add(unsigned* p, unsigned v) { return __hip_atomic_fetch_add(p, v, __ATOMIC_RELAXED, __HIP_MEMORY_SCOPE_AGENT); }
__device__ __forceinline__ unsigned xb_xcc_id() { return (unsigned)__builtin_amdgcn_s_getreg((3 << 11) | 20) & 0xFu; }
#define XB_SPIN(cond, bar) do { unsigned _sp = 0; while (cond) { __builtin_amdgcn_s_sleep(1); \
    if ((++_sp & 255u) == 0u) { if (xb_ld(&(bar)[XB_TMO])) break; if (_sp > XB_SPIN_CAP) { atomicAdd(&(bar)[XB_TMO], 1u); break; } } } } while (0)

struct XcdBarrier {
    unsigned* bar; unsigned x;
    volatile LAS unsigned* st;
};

__device__ __forceinline__ XcdBarrier xcd_barrier_post(unsigned* bar, volatile LAS unsigned* st) {
    XcdBarrier b; b.bar = bar; b.x = xb_xcc_id(); b.st = st;
    if (threadIdx.x == 0) (void)xb_add(&bar[XB_XCNT(b.x)], 1u);
    return b;
}
__device__ __forceinline__ void xcd_barrier_complete(unsigned* bar, unsigned x, unsigned& nloc, unsigned& nx) {
    const unsigned G = gridDim.x * gridDim.y * gridDim.z;
    unsigned sum, cnt, mine, sp = 0u;
    for (;;) {
        sum = 0u; cnt = 0u; mine = 0u;
#pragma unroll
        for (unsigned j = 0; j < 16; ++j) { const unsigned c = xb_ld(&bar[XB_XCNT(j)]); sum += c; cnt += (c > 0u) ? 1u : 0u; mine = (j == x) ? c : mine; }
        if (sum == G) break;
        __builtin_amdgcn_s_sleep(1);
        if ((++sp & 255u) == 0u) { if (xb_ld(&bar[XB_TMO])) break; if (sp > XB_SPIN_CAP) { atomicAdd(&bar[XB_TMO], 1u); break; } }
    }
    nloc = mine > 0u ? mine : 1u; nx = cnt > 0u ? cnt : 1u;
}

__device__ __forceinline__ void xcd_barrier(const XcdBarrier& b) {
    asm volatile("s_waitcnt vmcnt(0)" ::: "memory");
    __syncthreads();
    if (threadIdx.x == 0) {
        unsigned* bar = b.bar;
        __builtin_amdgcn_s_waitcnt(0);
        unsigned nloc = b.st[0], nx = b.st[1];
        if (nloc == 0u) { xcd_barrier_complete(bar, b.x, nloc, nx); b.st[0] = nloc; b.st[1] = nx; }
        const unsigned old = xb_add(&bar[XB_XSUB(b.x)], 1u);
        const unsigned gen = old / nloc;
        if (old + 1u == (gen + 1u) * nloc) {
            __builtin_amdgcn_fence(__ATOMIC_RELEASE, "agent");
            asm volatile("s_waitcnt vmcnt(0)" ::: "memory");
            const unsigned og = xb_add(&bar[XB_TOP], 1u);
            const unsigned tg = og / nx;
            if (og + 1u == (tg + 1u) * nx) xb_add(&bar[XB_TOPGEN], 1u);
            else XB_SPIN(xb_ld(&bar[XB_TOPGEN]) == tg, bar);
            __builtin_amdgcn_fence(__ATOMIC_ACQUIRE, "agent");
            xb_add(&bar[XB_XGEN(b.x)], 1u);
            asm volatile("s_waitcnt vmcnt(0)" ::: "memory");
        } else {
            XB_SPIN(xb_ld(&bar[XB_XGEN(b.x)]) == gen, bar);
            __builtin_amdgcn_fence(__ATOMIC_ACQUIRE, "agent");
            asm volatile("s_waitcnt vmcnt(0)" ::: "memory");
        }
    }
    __syncthreads();
}


struct Args { const float* in[14]; float* out; unsigned char* ws; };

__global__ void __launch_bounds__(512) mk_fwd(Args args) {
    extern __shared__ __attribute__((aligned(16))) unsigned char lds[];
    cg::grid_group grid = cg::this_grid();
    const int tid0 = threadIdx.x, wave = __builtin_amdgcn_readfirstlane(tid0 >> 6);
#define FRESH_LANE() int tid = tid0; asm volatile("" : "+v"(tid)); const int lane = tid & 63
    const int G = gridDim.x, bx = blockIdx.x;
    const int vcu = (G % 8 == 0) ? (bx % 8) * (G / 8) + bx / 8 : bx;
    const int gw = vcu * 8 + wave, NGW = G * 8;
    LAS unsigned char* ldsl = (LAS unsigned char*)lds;
    if (tid0 < 8) ((LAS unsigned*)(ldsl + MISC_OFF))[tid0] = 0u;
    __syncthreads();
    const XcdBarrier xbar = xcd_barrier_post((unsigned*)(args.ws + WS_BAR), (volatile LAS unsigned*)(ldsl + MISC_OFF));
#define ws (args.ws)
#define x_in (args.in[0])
#define norm_mix (args.in[1])
#define w_in (args.in[2])
#define b_gate (args.in[3])
#define diff_lambda (args.in[4])
#define diff_subln (args.in[5])
#define na_rpb (args.in[6])
#define qk_norm (args.in[7])
#define w_branch (args.in[8])
#define w_out (args.in[9])
#define norm_ffn (args.in[10])
#define w_ff1 (args.in[11])
#define w_ff2 (args.in[12])
#define norm_final (args.in[13])
#define xout (args.out)
#define WinT ((bf16_t*)(ws + WS_WIN))
#define WbrT ((bf16_t*)(ws + WS_WBR))
#define WoutT ((bf16_t*)(ws + WS_WOUT))
#define W1T ((bf16_t*)(ws + WS_W1))
#define W2T ((bf16_t*)(ws + WS_W2))
#define STAT ((float*)(ws + WS_STAT))
#define H ((bf16_t*)(ws + WS_H))
#define ATMP ((bf16_t*)(ws + WS_ATMP))
#define BTMP ((bf16_t*)(ws + WS_BTMP))
#define Y ((bf16_t*)(ws + WS_Y))
#define MERGED ((bf16_t*)(ws + WS_MERGED))
#define Z ((bf16_t*)(ws + WS_Z))
#define U ((bf16_t*)(ws + WS_Z))
#define PROJ ((bf16_t*)(ws + WS_PROJ))
#define XB ((bf16_t*)(ws + WS_XB))
#define SSQM ((float*)(ws + WS_SSQM))
#define SSQF ((float*)(ws + WS_SSQF))
#define NRMQ ((unsigned*)(ws + WS_NRM))
#define NRMK ((unsigned*)(ws + WS_NRM) + 1024)

    {
        FRESH_LANE();
        LAS float* scr = (LAS float*)(ldsl + wave * 16384);
        constexpr int I_IN = (DM / 64) * (INW / 32), I_BR = (512 / 64) * (DM / 32), I_OUT = (DM / 64) * (DM / 32), I_1 = (DM / 64) * (DFF / 32), I_2 = (DFF / 64) * (DM / 32);
        constexpr int NITEMS = 2 * I_IN + 8 * I_BR + 2 * I_OUT + 2 * I_1 + 2 * I_2;
        for (int it = gw; it < NITEMS; it += NGW) {
            int r = it;
            if (r < 2 * I_IN) { const int l = r / I_IN; transpose_item(w_in + (size_t)l * DM * INW, DM, INW, WinT + (size_t)l * INW * DM, scr, r % I_IN, lane, norm_mix + l * DM); continue; } r -= 2 * I_IN;
            if (r < 8 * I_BR) { const int ln = r / I_BR; transpose_item(w_branch + (size_t)ln * 512 * DM, 512, DM, WbrT + (size_t)ln * DM * 512, scr, r % I_BR, lane); continue; } r -= 8 * I_BR;
            if (r < 2 * I_OUT) { const int l = r / I_OUT; transpose_item(w_out + (size_t)l * DM * DM, DM, DM, WoutT + (size_t)l * DM * DM, scr, r % I_OUT, lane); continue; } r -= 2 * I_OUT;
            if (r < 2 * I_1) { const int l = r / I_1; transpose_item(w_ff1 + (size_t)l * DM * DFF, DM, DFF, W1T + (size_t)l * DFF * DM, scr, r % I_1, lane, norm_ffn + l * DM); continue; } r -= 2 * I_1;
            { const int l = r / I_2; transpose_item(w_ff2 + (size_t)l * DFF * DM, DFF, DM, W2T + (size_t)l * DM * DFF, scr, r % I_2, lane); }
        }
        {
            f32x4 v[4], vn[4] = {};
            if (gw < NTOK) { const f32x4* xr = (const f32x4*)(x_in + (size_t)gw * DM) + lane;
#pragma unroll
                for (int j = 0; j < 4; ++j) v[j] = xr[64 * j]; }
            for (int m = gw; m < NTOK; m += NGW) {
                if (m + NGW < NTOK) { const f32x4* xr = (const f32x4*)(x_in + (size_t)(m + NGW) * DM) + lane;
#pragma unroll
                    for (int j = 0; j < 4; ++j) vn[j] = xr[64 * j]; }
                u32x2* o8 = (u32x2*)(XB + (size_t)m * DM) + lane; float sq = 0.f;
#pragma unroll
                for (int j = 0; j < 4; ++j) { sq += (v[j].x * v[j].x + v[j].y * v[j].y) + (v[j].z * v[j].z + v[j].w * v[j].w); u32x2 w; w.x = pk2(v[j].x, v[j].y); w.y = pk2(v[j].z, v[j].w); o8[64 * j] = w; }
                sq = wave_sum(sq);
                if (lane == 0) *(f32x4*)(SSQM + (size_t)m * 4) = (f32x4){sq, 0.f, 0.f, 0.f};
#pragma unroll
                for (int j = 0; j < 4; ++j) v[j] = vn[j];
            }
        }
    }
    grid.sync();

    for (int l = 0; l < DEPTH; ++l) {
        { FRESH_LANE(); LAS float* tab = (LAS float*)(ldsl + TAB_OFF); for (int i = tid; i < 8 * 465; i += 512) tab[i] = na_rpb[l * 8 * 465 + i] * LOG2E; }
        __syncthreads();
        for (int grp = 0; grp < NGRP; ++grp) {
            const size_t tok0 = (size_t)grp * TG;
            const float* xsrc = (l == 0) ? x_in : xout;
            {
                pg8::Gemm g{XB + tok0 * DM, WinT + (size_t)l * INW * DM, DM, DM, DM, 1 << 30, 0}; pg8::StaticOrder S; S.init(TG, INW, G, bx);
                if (bx == 0) { FRESH_LANE(); NRMQ[tid] = 0u; NRMQ[tid + 512] = 0u; if (tid < 16) NRMQ[1024 + tid] = 0u; (void)lane; }
                pg8::Epi<0> E{PROJ, nullptr, nullptr, b_gate + l * 4096, INW, SSQM + tok0 * 4, nullptr, nullptr, nullptr};
                pg8::gemm_phase(ldsl, g, S, E);
            }
            xcd_barrier(xbar);
            {
                FRESH_LANE();
                const float inv = exp2f(-(float)(lane & 15) * 0.8304820237218406f);
                const float gq = qk_norm[l * 128 + lane], gk = qk_norm[l * 128 + 64 + lane];
                const int per = (TG + NGW - 1) / NGW;
                float mq = 0.f, mk = 0.f; int cu = -1;
                u32x4 qv, kv, qvn = {}, kvn = {}; unsigned short rw[10], rwn[10] = {};
#define P3_LOAD(QV, KV, RW, mm) do { const bf16_t* ar_ = PROJ + (size_t)(mm) * INW; QV = *(const u32x4*)(ar_ + COL_AQ + lane * 8); KV = *(const u32x4*)(ar_ + COL_AK + lane * 8); \
                    _Pragma("unroll") for (int hd = 0; hd < 10; ++hd) RW[hd] = ar_[COL_DQ + hd * 64 + lane]; } while (0)
                if (gw * per < TG) P3_LOAD(qv, kv, rw, gw * per);
                for (int i = 0; i < per; ++i) {
                    const int m = gw * per + i; if (m >= TG) break;
                    if (i + 1 < per && m + 1 < TG) P3_LOAD(qvn, kvn, rwn, m + 1);
                    if ((m >> 8) != cu) { if (cu >= 0 && (lane & 7) == 0) { atomicMax(NRMQ + cu * 8 + (lane >> 3), __float_as_uint(mq)); atomicMax(NRMK + (cu >> 5) * 8 + (lane >> 3), __float_as_uint(mk)); } cu = m >> 8; mq = 0.f; mk = 0.f; }
                    const int s = (int)((tok0 + m) % SEQ); const float pos = (float)((lane < 32) ? (s >> 6) : (s & 63));
                    float sn, cs; sincos_red(pos * inv, sn, cs);
                    { float nq = 0.f, nk = 0.f;
#pragma unroll
                      for (int e = 0; e < 4; ++e) { nq += bflo(qv[e]) * bflo(qv[e]) + bfhi(qv[e]) * bfhi(qv[e]); nk += bflo(kv[e]) * bflo(kv[e]) + bfhi(kv[e]) * bfhi(kv[e]); }
                      nq += __shfl_xor(nq, 1); nk += __shfl_xor(nk, 1); nq += __shfl_xor(nq, 2); nk += __shfl_xor(nk, 2); nq += __shfl_xor(nq, 4); nk += __shfl_xor(nk, 4);
                      mq = fmaxf(mq, sqrtf(nq)); mk = fmaxf(mk, sqrtf(nk)); }
                    bf16_t* row = PROJ + (size_t)m * INW + COL_DQ;
#pragma unroll
                    for (int hd = 0; hd < 10; ++hd) {
                        const float v = __uint_as_float((unsigned)rw[hd] << 16);
                        const float rn = rsqrtf(wave_sum(v * v) * (1.f / 64.f) + EPS);
                        const float y = v * rn * (hd < 8 ? gq : gk);
                        const float p = __shfl_xor(y, 16);
                        float o = ((lane >> 4) & 1) ? (y * cs + p * sn) : (y * cs - p * sn);
                        if (hd < 8) o *= C2;
                        row[hd * 64 + lane] = (bf16_t)f2bf(o);
                    }
                    qv = qvn; kv = kvn;
#pragma unroll
                    for (int hd = 0; hd < 10; ++hd) rw[hd] = rwn[hd];
                }
#undef P3_LOAD
                if (cu >= 0 && (lane & 7) == 0) { atomicMax(NRMQ + cu * 8 + (lane >> 3), __float_as_uint(mq)); atomicMax(NRMK + (cu >> 5) * 8 + (lane >> 3), __float_as_uint(mk)); }
            }
            xcd_barrier(xbar);
            {
                using namespace attn_body;
                char* shm = (char*)lds;
                {
                    unsigned* qctr = (unsigned*)(ws + WS_BAR) + 3584 + (l * NGRP + grp) * 8;
                    volatile LAS unsigned* slot = (volatile LAS unsigned*)(ldsl + MISC_OFF + 32);
                    const int myx = (G % 8 == 0) ? (vcu / (G / 8)) : 0;
                    int qq = 0;
                    for (;;) {
                        if (tid0 == 0) { int fj = -1, fx = 0;
                            for (; qq < 8; ++qq) { const int x_ = (myx + qq) & 7; const int j_ = (int)atomicAdd(qctr + x_, 1u); if (j_ < 288) { fj = j_; fx = x_; break; } }
                            slot[0] = (unsigned)fj; slot[1] = (unsigned)fx; }
                        __syncthreads();
                        const int j = (int)slot[0], sx = (int)slot[1];
                        __syncthreads();
                        if (j < 0) break;
                        if (j < 128) {
                            AttnArgs a{}; a.qs = INW; a.ks = INW; a.NT = 128; a.tlo = 0; a.thi = 127;
                            if (j >= 32 && j < 96) { const int qb = j & 31, ds = 2 * sx + ((j - 32) >> 5), bb = ds >> 3, h = ds & 7; const size_t tb = (size_t)bb * SEQ;
                                a.Q = (const bf16*)(PROJ + (tb + qb * 256) * INW + COL_DQ + h * 64); a.K = (const bf16*)(PROJ + tb * INW + COL_DK + (h >> 2) * 64);
                                a.V = (const bf16*)(PROJ + tb * INW + COL_DV + (h >> 2) * 64); a.O = (bf16*)(Y + (tb + qb * 256) * 2048 + 1536 + h * 64); a.os = 2048;
                                attn_unit<MD, 16>(a, shm);
                            } else {
                                int bb, hh, comp, qb;
                                if (j < 32) { bb = sx >> 2; hh = 2 + ((sx >> 1) & 1); comp = sx & 1; qb = j; }
                                else { const int s1 = sx >> 1; bb = s1 >> 1; comp = s1 & 1; hh = (j < 112) ? 1 : 0; qb = (sx & 1) * 16 + ((j - 96) & 15); }
                                const size_t tb = (size_t)bb * SEQ;
                                a.Q = (const bf16*)(PROJ + (tb + qb * 256) * INW + COL_AQ + hh * 128 + comp * 64); a.K = (const bf16*)(PROJ + tb * INW + COL_AK + hh * 128 + comp * 64);
                                a.V = (const bf16*)(PROJ + tb * INW + COL_AV + hh * 128); a.O = (bf16*)(ATMP + (tb + qb * 256) * 1024 + (hh * 2 + comp) * 128); a.os = 1024;
                                a.s2 = exp2f(-2.f * (float)(hh + 1)) * LOG2E;
                                const float Bs = __uint_as_float(NRMQ[(bb * 32 + qb) * 8 + hh * 2 + comp]) * __uint_as_float(NRMK[bb * 8 + hh * 2 + comp]) * 1.02f + 0.25f;
                                const float dlim = fminf((150.f + 2.f * Bs) / a.s2, 1.0e6f), q0f = (float)(qb * 256);
                                int tlo = max(0, (int)floorf((q0f - 63.f - dlim) * (1.f / 64.f))), thi = min(127, (int)ceilf((q0f + 255.f + dlim) * (1.f / 64.f)));
                                if (((thi - tlo + 1) & 1) != 0) { if (tlo > 0) --tlo; else ++thi; }
                                tlo = __builtin_amdgcn_readfirstlane(tlo); thi = __builtin_amdgcn_readfirstlane(thi);
                                a.K += (size_t)tlo * 64 * INW; a.V += (size_t)tlo * 64 * INW; a.q0 = qb * 256 - 64 * tlo; a.NT = thi - tlo + 1;
                                attn_unit128<16>(a, shm);
                            }
                        } else if (j < 192) {
                            const int cs = 2 * sx + ((j - 128) >> 5), qb = (j - 128) & 31, bb = cs >> 3, h = cs & 7, r0 = 4 * qb, kb = min(max(r0 - 4, 0), 116); const size_t tb = (size_t)bb * SEQ;
                            AttnArgs a{}; a.qs = INW; a.ks = INW; a.os = 2048; a.NT = 12; a.tlo = 0; a.thi = 11; a.q0 = r0; a.kb = kb;
                            a.Q = (const bf16*)(PROJ + (tb + r0 * 64) * INW + COL_CQ + h * 64); a.K = (const bf16*)(PROJ + (tb + kb * 64) * INW + COL_CK + h * 64);
                            a.V = (const bf16*)(PROJ + (tb + kb * 64) * INW + COL_CV + h * 64); a.O = (bf16*)(Y + (tb + r0 * 64) * 2048 + 1024 + h * 64);
                            a.tab = (lds_fptr)((lds_cptr)shm + TAB_OFF) + h * 465;
                            attn_unit<MC, 8>(a, shm);
                        } else {
                            const int p = j - 192, sg = 6 * sx + (p >> 4);
                            for (int e = 0; e < 2; ++e) {
                                const int blk = 2 * (p & 15) + e, bb = sg / 24, k = sg % 24, gp = k >> 3, h = k & 7, dsh = 2 * gp, dil = 1 << dsh;
                                const int nblk = 32 >> dsh, res = blk / nblk, i0 = (blk % nblk) * 256, L = SEQ >> dsh;
                                const long tq = (long)bb * SEQ + res + (long)i0 * dil, tk = (long)bb * SEQ + res + (long)(i0 - 64) * dil;
                                AttnArgs a{}; a.qs = dil * INW; a.ks = dil * INW; a.os = dil * 1536; a.NT = 6; a.tlo = (i0 == 0) ? 1 : 0; a.thi = (i0 + 256 == L) ? 4 : 5;
                                const int cq = COL_B + gp * 1536 + h * 64;
                                a.Q = (const bf16*)(PROJ + tq * INW + cq); a.K = (const bf16*)(PROJ + tk * INW + cq + 512); a.V = (const bf16*)(PROJ + tk * INW + cq + 1024);
                                a.O = (bf16*)(BTMP + tq * 1536 + gp * 512 + h * 64);
                                a.s2 = exp2f(-(float)(h + 1)) * (float)dil * LOG2E; a.stat = STAT + (tq * 24 + gp * 8 + h) * 2; a.ss = dil * 48;
                                attn_unit<MB, 8>(a, shm);
                            }
                        }
                    }
                }
            }
            xcd_barrier(xbar);
            {
                FRESH_LANE();
                int l_ = l; asm volatile("" : "+s"(l_));
                const float lam_init = (l_ == 0) ? 0.2f : (0.8f - 0.6f * 0.7408182206817179f);
                float lam;
                { const float* lp = diff_lambda + l * 256; const float a = lp[lane] * lp[64 + lane], b = lp[128 + lane] * lp[192 + lane]; lam = expf(wave_sum(a)) - expf(wave_sum(b)) + lam_init; lam = __uint_as_float(__builtin_amdgcn_readfirstlane(__float_as_uint(lam))); }
                const float out_scale = 1.f - lam_init;
                const float g0 = diff_subln[l * 128 + 2 * lane], g1 = diff_subln[l * 128 + 2 * lane + 1];
                const int h = lane >> 3, d8 = (lane & 7) * 8;
                unsigned aw[8]; u32x4 bw[3]; float sv[6];
#define P5_LOAD(AW, BW, SV, mm) do { const unsigned* at_ = (const unsigned*)(ATMP + (size_t)(mm) * 1024); _Pragma("unroll") for (int q = 0; q < 8; ++q) AW[q] = at_[q * 64 + lane]; \
                    const bf16_t* bt_ = BTMP + (size_t)(mm) * 1536 + h * 64 + d8; _Pragma("unroll") for (int g = 0; g < 3; ++g) BW[g] = *(const u32x4*)(bt_ + g * 512); \
                    const float* st_ = STAT + (size_t)(mm) * 48 + h * 2; _Pragma("unroll") for (int g = 0; g < 3; ++g) { SV[2 * g] = st_[16 * g]; SV[2 * g + 1] = st_[16 * g + 1]; } } while (0)
                for (int m = gw; m < TG; m += NGW) {
                    P5_LOAD(aw, bw, sv, m);
                    unsigned* yr = (unsigned*)(Y + (size_t)m * 2048);
#pragma unroll
                    for (int hh = 0; hh < 4; ++hh) {
                        const unsigned w0 = aw[hh * 2], w1 = aw[hh * 2 + 1];
                        const float d0 = bflo(w0) - lam * bflo(w1), d1 = bfhi(w0) - lam * bfhi(w1);
                        const float rn = rsqrtf(wave_sum(d0 * d0 + d1 * d1) * (1.f / 128.f) + EPS) * out_scale;
                        yr[hh * 64 + lane] = pk2(d0 * rn * g0, d1 * rn * g1);
                    }
                    const float m0 = sv[0], l0 = sv[1], m1 = sv[2], l1 = sv[3], m2 = sv[4], l2 = sv[5];
                    const float ms = fmaxf(m0, fmaxf(m1, m2));
                    const float w0 = l0 * exp2f(m0 - ms), w1 = l1 * exp2f(m1 - ms), w2 = l2 * exp2f(m2 - ms); const float inv = 1.f / (w0 + w1 + w2);
                    const u32x4 a0 = bw[0], a1 = bw[1], a2 = bw[2];
                    u32x4 o;
#pragma unroll
                    for (int e = 0; e < 4; ++e) { const float lo = (w0 * bflo(a0[e]) + w1 * bflo(a1[e]) + w2 * bflo(a2[e])) * inv, hi = (w0 * bfhi(a0[e]) + w1 * bfhi(a1[e]) + w2 * bfhi(a2[e])) * inv; o[e] = pk2(lo, hi); }
                    *(u32x4*)(Y + (size_t)m * 2048 + 512 + h * 64 + d8) = o;
                }
#undef P5_LOAD
            }
            xcd_barrier(xbar);
            {
                pg8::Gemm g{Y, WbrT + (size_t)l * 4096 * 512, 2048, 512, 512, 4, 512}; pg8::StaticOrder S; S.init(TG, 4096, G, bx);
                pg8::Epi<1> E{Z, nullptr, nullptr, nullptr, 4096, nullptr, nullptr, nullptr, nullptr};
                pg8::gemm_phase(ldsl, g, S, E);
            }
            xcd_barrier(xbar);
            { FRESH_LANE();
            u32x4 gv[2][4], zv[2][4];
#define P7_LOAD(GV, ZV, mm) do { const bf16_t* gr_ = PROJ + (size_t)(mm) * INW + COL_GATE + lane * 8; const bf16_t* zr_ = Z + (size_t)(mm) * 4096 + lane * 8; \
                _Pragma("unroll") for (int jj = 0; jj < 2; ++jj) _Pragma("unroll") for (int n = 0; n < 4; ++n) { GV[jj][n] = *(const u32x4*)(gr_ + n * 1024 + jj * 512); ZV[jj][n] = *(const u32x4*)(zr_ + n * 1024 + jj * 512); } } while (0)
            for (int m = gw; m < TG; m += NGW) {
                P7_LOAD(gv, zv, m);
#pragma unroll
                for (int j = 0; j < 2; ++j) { const int c = lane * 8 + j * 512; float acc[8] = {0.f, 0.f, 0.f, 0.f, 0.f, 0.f, 0.f, 0.f};
#pragma unroll
                    for (int n = 0; n < 4; ++n) {
#pragma unroll
                        for (int e = 0; e < 4; ++e) { acc[2 * e] += bflo(gv[j][n][e]) * bflo(zv[j][n][e]); acc[2 * e + 1] += bfhi(gv[j][n][e]) * bfhi(zv[j][n][e]); } }
                    u32x4 o; o.x = pk2(acc[0], acc[1]); o.y = pk2(acc[2], acc[3]); o.z = pk2(acc[4], acc[5]); o.w = pk2(acc[6], acc[7]);
                    *(u32x4*)(MERGED + (size_t)m * DM + c) = o; }
#undef P7_LOAD
            } }
            xcd_barrier(xbar);
            {
                pg8::Gemm g{MERGED, WoutT + (size_t)l * DM * DM, DM, DM, DM, 1 << 30, 0}; pg8::StaticOrder S; S.init(TG, DM, G, bx);
                pg8::Epi<3> E{nullptr, xout + tok0 * DM, xsrc + tok0 * DM, nullptr, DM, nullptr, H, SSQF, (LAS float*)(ldsl + SSQ_OFF)};
                pg8::gemm_phase(ldsl, g, S, E);
            }
            xcd_barrier(xbar);
            {
                pg8::Gemm g{H, W1T + (size_t)l * DFF * DM, DM, DM, DM, 1 << 30, 0}; pg8::StaticOrder S; S.init(TG, DFF, G, bx);
                pg8::Epi<2> E{U, nullptr, nullptr, nullptr, DFF, SSQF, nullptr, nullptr, nullptr};
                pg8::gemm_phase(ldsl, g, S, E);
            }
            xcd_barrier(xbar);
            {
                pg8::Gemm g{U, W2T + (size_t)l * DM * DFF, DFF, DFF, DFF, 1 << 30, 0}; pg8::StaticOrder S; S.init(TG, DM, G, bx);
                pg8::Epi<3> E{nullptr, xout + tok0 * DM, xout + tok0 * DM, nullptr, DM, nullptr, XB + tok0 * DM, SSQM + tok0 * 4, (LAS float*)(ldsl + SSQ_OFF)};
                pg8::gemm_phase(ldsl, g, S, E);
            }
            if (l == DEPTH - 1 && grp == NGRP - 1) xcd_barrier(xbar);
        }
    }
    {
        FRESH_LANE();
        const f32x4* g4 = (const f32x4*)norm_final + lane; f32x4 gg[4];
#pragma unroll
        for (int j = 0; j < 4; ++j) gg[j] = g4[64 * j];
        f32x4 v[4], vn[4] = {};
        if (gw < NTOK) { const f32x4* o = (const f32x4*)(xout + (size_t)gw * DM) + lane;
#pragma unroll
            for (int j = 0; j < 4; ++j) v[j] = o[64 * j]; }
        for (int m = gw; m < NTOK; m += NGW) {
            if (m + NGW < NTOK) { const f32x4* on = (const f32x4*)(xout + (size_t)(m + NGW) * DM) + lane;
#pragma unroll
                for (int j = 0; j < 4; ++j) vn[j] = on[64 * j]; }
            f32x4* o = (f32x4*)(xout + (size_t)m * DM) + lane; float sq = 0.f;
#pragma unroll
            for (int j = 0; j < 4; ++j) sq += (v[j].x * v[j].x + v[j].y * v[j].y) + (v[j].z * v[j].z + v[j].w * v[j].w);
            const float r = rsqrtf(wave_sum(sq) * (1.f / DM) + EPS);
#pragma unroll
            for (int j = 0; j < 4; ++j) o[64 * j] = (f32x4){v[j].x * r * gg[j].x, v[j].y * r * gg[j].y, v[j].z * r * gg[j].z, v[j].w * r * gg[j].w};
#pragma unroll
            for (int j = 0; j < 4; ++j) v[j] = vn[j];
        }
    }
}

#undef ws
#undef x_in
#undef norm_mix
#undef w_in
#undef b_gate
#undef diff_lambda
#undef diff_subln
#undef na_rpb
#undef qk_norm
#undef w_branch
#undef w_out
#undef norm_ffn
#undef w_ff1
#undef w_ff2
#undef norm_final
#undef xout
#undef WinT
#undef WbrT
#undef WoutT
#undef W1T
#undef W2T
#undef STAT
#undef H
#undef ATMP
#undef BTMP
#undef Y
#undef MERGED
#undef Z
#undef U
#undef PROJ
#undef NRMQ
#undef XB
#undef SSQM
#undef SSQF
#undef NRMK

extern "C" void kernel_launch(void* const* d_in, const int* in_sizes, int n_in, void* d_out, int out_size, void* d_ws, size_t ws_size, hipStream_t stream) {
    static int grid_blocks = 0;
    if (!grid_blocks) {
        int dev = 0, cus = 0, per_cu = 0;
        (void)hipGetDevice(&dev);
        (void)hipDeviceGetAttribute(&cus, hipDeviceAttributeMultiprocessorCount, dev);
        (void)hipFuncSetAttribute((const void*)mk_fwd, hipFuncAttributeMaxDynamicSharedMemorySize, LDS_BYTES);
        (void)hipOccupancyMaxActiveBlocksPerMultiprocessor(&per_cu, (const void*)mk_fwd, 512, LDS_BYTES);
        if (per_cu < 1) per_cu = 1;
        grid_blocks = cus * per_cu;
        if (ws_size < WS_END || n_in != 14) { fprintf(stderr, "kernel_launch: workspace %zu < %zu or n_in %d != 14\n", ws_size, (size_t)WS_END, n_in); grid_blocks = -1; }
    }
    if (grid_blocks < 0) return;
    (void)hipMemsetAsync((char*)d_ws + WS_BAR, 0, 16384, stream);
    Args a{};
    for (int i = 0; i < 14; ++i) a.in[i] = (const float*)d_in[i];
    a.out = (float*)d_out; a.ws = (unsigned char*)d_ws;
    void* kargs[] = {&a};
    hipError_t e = hipLaunchCooperativeKernel((const void*)mk_fwd, dim3(grid_blocks), dim3(512), kargs, LDS_BYTES, stream);
    if (e != hipSuccess) fprintf(stderr, "cooperative launch failed: %s (grid %d)\n", hipGetErrorString(e), grid_blocks);
}
```

```cpp
#include <hip/hip_runtime.h>
#include <hip/hip_cooperative_groups.h>
#include <hip/hip_bf16.h>
#include <cstdio>
#include <cstdint>
#include <cmath>
namespace cg = cooperative_groups;

constexpr int BATCH = 8, SEQ = 8192, DM = 1024, NTOK = BATCH * SEQ, INW = 12544, DFF = 4096, DEPTH = 2;
constexpr int GB = 2, TG = GB * SEQ, NGRP = BATCH / GB;
constexpr float EPS = 1e-6f;
constexpr float LOG2E = 1.4426950408889634f;
constexpr float C2 = 0.125f * LOG2E;
constexpr int COL_AQ = 0, COL_AK = 512, COL_AV = 1024, COL_B = 1536, COL_CQ = 6144, COL_CK = 6656, COL_CV = 7168, COL_DQ = 7680, COL_DK = 8192, COL_DV = 8320, COL_GATE = 8448;
constexpr size_t MiB = 1u << 20;
constexpr size_t WS_WIN = 0, WS_WBR = 49 * MiB, WS_WOUT = 57 * MiB, WS_W1 = 61 * MiB, WS_W2 = 77 * MiB, WS_STAT = 93 * MiB, WS_H = 96 * MiB, WS_ATMP = 128 * MiB,
                 WS_BTMP = 160 * MiB, WS_Y = 208 * MiB, WS_MERGED = 272 * MiB, WS_Z = 304 * MiB, WS_PROJ = 432 * MiB, WS_NRM = 824 * MiB, WS_BAR = 824 * MiB + 512 * 1024, WS_SSQM = 825 * MiB, WS_SSQF = 826 * MiB, WS_XB = 827 * MiB, WS_END = 955 * MiB;
constexpr int LDS_BYTES = 151552, TAB_OFF = 131072, MISC_OFF = 147072, SSQ_OFF = 147456;

#define LAS __attribute__((address_space(3)))
typedef unsigned short bf16_t;
typedef short bf16x8 __attribute__((ext_vector_type(8)));
typedef float f32x4 __attribute__((ext_vector_type(4)));
typedef unsigned u32x4 __attribute__((ext_vector_type(4)));
typedef unsigned u32x2 __attribute__((ext_vector_type(2)));

__device__ __forceinline__ unsigned f2bf(float f) { unsigned u = __builtin_bit_cast(unsigned, f); return (u + 0x7fffu + ((u >> 16) & 1u)) >> 16; }
__device__ __forceinline__ unsigned pk2(float lo, float hi) { return f2bf(lo) | (f2bf(hi) << 16); }
__device__ __forceinline__ float bflo(unsigned w) { return __uint_as_float(w << 16); }
__device__ __forceinline__ float bfhi(unsigned w) { return __uint_as_float(w & 0xffff0000u); }
__device__ __forceinline__ float wave_sum(float v) {
#pragma unroll
    for (int o = 1; o < 64; o <<= 1) v += __shfl_xor(v, o);
    return v;
}

namespace pg8 {
constexpr int BM = 256, BK = 64, HALF = 128, HTB = HALF * BK * 2, STAGE_BYTES = 8 * HTB, NXCD = 8, WGM = 4;
__host__ __device__ __forceinline__ int lds_byte(int r, int c) { const int st = (r >> 4) * 2 + (c >> 5), rr = r & 15, cc = c & 31, ob = rr * 64 + cc * 2; return st * 1024 + (ob ^ (((ob >> 9) & 1) << 5)); }
__host__ __device__ __forceinline__ void stage_rc(int b, int& R, int& C) { const int st = b / 1024, sb = b % 1024, swz = sb ^ (((sb >> 9) & 1) << 5); R = (st >> 1) * 16 + swz / 64; C = (st & 1) * 32 + (swz % 64) / 2; }
__host__ __device__ __forceinline__ int perm32(int rho) { const int n = rho >> 4, i = rho & 15; return 8 * (i >> 2) + 4 * n + (i & 3); }

struct Unit { int pm, pn; };
struct Gemm { const bf16_t* A; const bf16_t* Bt; int lda, ldb, K, adiv, astride; };

struct StaticOrder {
    int nM, nN, nwg, G, c;
    __device__ void init(int M, int N, int G_, int c_) { nM = M / BM; nN = N / BM; nwg = nM * nN; G = G_; c = c_; }
    __device__ bool next(int i, Unit& u) const {
        const long L = (long)i * G + c; if (L >= nwg) return false;
        int wgid = (int)L; { const int q = nwg / NXCD, r = nwg % NXCD, xcd = wgid % NXCD, off = wgid / NXCD; wgid = (xcd < r ? xcd * (q + 1) : r * (q + 1) + (xcd - r) * q) + off; }
        const int nig = WGM * nN, gid = wgid / nig, fm = gid * WGM, gsz = (nM - fm) < WGM ? (nM - fm) : WGM;
        u.pm = fm + ((wgid % nig) % gsz); u.pn = (wgid % nig) / gsz; return true;
    }
};

__device__ __forceinline__ unsigned cvt_pk_bf16(float lo, float hi) { unsigned r; asm volatile("v_cvt_pk_bf16_f32 %0, %1, %2" : "=v"(r) : "v"(lo), "v"(hi)); return r; }

template <int MODE> struct Epi {
    bf16_t* O; float* Of; const float* base; const float* bias; int ldc;
    const float* ssq;
    bf16_t* XBo; float* SSQo; LAS float* lx;
    __device__ __forceinline__ void operator()(const f32x4 (&acc)[2][2][4][2], const Unit& u, int wr, int wc, int fr, int fq) const {
        const int row0 = u.pm * BM + wr * 64 + fr, col0 = u.pn * BM + wc * 32 + 8 * fq;
        int kind = 0; float sc = 1.f;
        if (MODE == 0) { const int pn = u.pn; if (pn >= 33) kind = 2; else if (pn < 2 || pn == 6 || pn == 7 || pn == 12 || pn == 13 || pn == 18 || pn == 19 || pn == 24 || pn == 25) sc = C2; }
        float rsv[2][4]; f32x4 bv[2][2];
#pragma unroll
        for (int ai = 0; ai < 2; ++ai)
#pragma unroll
            for (int m = 0; m < 4; ++m) { rsv[ai][m] = 1.f;
                if (MODE == 0 || MODE == 2) { const f32x4 q = *(const f32x4*)(ssq + (size_t)(row0 + ai * HALF + m * 16) * 4); rsv[ai][m] = rsqrtf(((q[0] + q[1]) + (q[2] + q[3])) * (1.f / 1024.f) + EPS); } }
#pragma unroll
        for (int bj = 0; bj < 2; ++bj)
#pragma unroll
            for (int n = 0; n < 2; ++n) { bv[bj][n] = (f32x4){0.f, 0.f, 0.f, 0.f}; if (MODE == 0) { if (kind == 2) bv[bj][n] = *(const f32x4*)(bias + col0 + bj * HALF - COL_GATE + 4 * n); } }
        f32x4 nb[2][2];
        if (MODE == 3) {
#pragma unroll
            for (int bj = 0; bj < 2; ++bj)
#pragma unroll
                for (int n = 0; n < 2; ++n) nb[bj][n] = *(const f32x4*)(base + (size_t)row0 * ldc + col0 + bj * HALF + 4 * n);
        }
#pragma unroll
        for (int ai = 0; ai < 2; ++ai)
#pragma unroll
            for (int m = 0; m < 4; ++m) { const size_t roff = (size_t)(row0 + ai * HALF + m * 16) * ldc; float psq = 0.f; const float rs = rsv[ai][m];
                f32x4 cb[2][2];
                if (MODE == 3) {
#pragma unroll
                    for (int bj = 0; bj < 2; ++bj)
#pragma unroll
                        for (int n = 0; n < 2; ++n) cb[bj][n] = nb[bj][n];
                    const int g1 = ai * 4 + m + 1;
                    if (g1 < 8) { const size_t r1 = (size_t)(row0 + (g1 >> 2) * HALF + (g1 & 3) * 16) * ldc;
#pragma unroll
                        for (int bj = 0; bj < 2; ++bj)
#pragma unroll
                            for (int n = 0; n < 2; ++n) nb[bj][n] = *(const f32x4*)(base + r1 + col0 + bj * HALF + 4 * n); }
                }
#pragma unroll
                for (int bj = 0; bj < 2; ++bj) { const int col = col0 + bj * HALF; f32x4 v0 = acc[ai][bj][m][0], v1 = acc[ai][bj][m][1];
                    if (MODE == 3) {
                        v0 = cb[bj][0] + v0; v1 = cb[bj][1] + v1;
                        *(f32x4*)(Of + roff + col) = v0; *(f32x4*)(Of + roff + col + 4) = v1;
                        psq += (v0[0] * v0[0] + v0[1] * v0[1]) + (v0[2] * v0[2] + v0[3] * v0[3]) + (v1[0] * v1[0] + v1[1] * v1[1]) + (v1[2] * v1[2] + v1[3] * v1[3]);
                        u32x4 w; w.x = cvt_pk_bf16(v0[0], v0[1]); w.y = cvt_pk_bf16(v0[2], v0[3]); w.z = cvt_pk_bf16(v1[0], v1[1]); w.w = cvt_pk_bf16(v1[2], v1[3]);
                        *(u32x4*)(XBo + roff + col) = w;
                    } else {
                        if (MODE == 0 || MODE == 2) { v0 = v0 * rs; v1 = v1 * rs; }
                        if (MODE == 0) {
                            if (kind == 2) {
#pragma unroll
                                for (int e = 0; e < 4; ++e) { v0[e] = 1.f / (1.f + __expf(-(v0[e] + bv[bj][0][e]))); v1[e] = 1.f / (1.f + __expf(-(v1[e] + bv[bj][1][e]))); } }
                            else { v0 = v0 * sc; v1 = v1 * sc; }
                        }
                        if (MODE == 2) {
#pragma unroll
                            for (int e = 0; e < 4; ++e) { const float a = fmaxf(v0[e], 0.f), b = fmaxf(v1[e], 0.f); v0[e] = a * a; v1[e] = b * b; } }
                        u32x4 w; w.x = cvt_pk_bf16(v0[0], v0[1]); w.y = cvt_pk_bf16(v0[2], v0[3]); w.z = cvt_pk_bf16(v1[0], v1[1]); w.w = cvt_pk_bf16(v1[2], v1[3]);
                        *(u32x4*)(O + roff + col) = w;
                    } }
                if (MODE == 3) { psq += __shfl_xor(psq, 16); psq += __shfl_xor(psq, 32); if (fq == 0) lx[(ai * HALF + wr * 64 + m * 16 + fr) * 4 + wc] = psq; }
            }
        if (MODE == 3) {
            asm volatile("s_waitcnt lgkmcnt(0)" ::: "memory"); __builtin_amdgcn_s_barrier(); asm volatile("" ::: "memory");
            const int t = threadIdx.x;
            if (t < 256) { const f32x4 q = *(const LAS f32x4*)(lx + t * 4); SSQo[(size_t)(u.pm * BM + t) * 4 + u.pn] = (q[0] + q[1]) + (q[2] + q[3]); }
        }
    }
};

template <class EpiT>
__device__ __forceinline__ void gemm_phase(LAS unsigned char* lds, const Gemm g, const StaticOrder& S, const EpiT& E) {
    int tid_ = threadIdx.x; asm volatile("" : "+v"(tid_));
    const int tid = tid_, wid = __builtin_amdgcn_readfirstlane(tid >> 6), lane = tid & 63, wr = wid >> 2, wc = wid & 3, fr = lane & 15, fq = lane >> 4;
    const int K = g.K, nt = K / BK;
    unsigned voffA[2], voffB[2];
#pragma unroll
    for (int i = 0; i < 2; ++i) { int R, C; stage_rc(tid * 16 + i * 8192, R, C); const int Rb = (R & ~31) + perm32(R & 31);
        voffA[i] = (unsigned)(R * g.lda + C) * 2u; voffB[i] = (unsigned)(Rb * g.ldb + C) * 2u; }
    const size_t kstep = (size_t)(BK * 2);
    const size_t hA = (size_t)HALF * g.lda * 2, hB = (size_t)HALF * g.ldb * 2;
    const size_t tA = 2 * hA, tB = 2 * hB;
    const unsigned ldsw = (unsigned)wid * 1024u;
    const int aoff = lds_byte(wr * 64 + fr, fq * 8), boff = lds_byte(wc * 32 + fr, fq * 8);
#define PG8_SA(b, h) (((b) * 2 + (h)) * HTB)
#define PG8_SB(b, h) ((4 + (b) * 2 + (h)) * HTB)
#define PG8_STAGE(bufoff, gbase, voff) do { _Pragma("unroll") for (int _i = 0; _i < 2; ++_i) \
        __builtin_amdgcn_global_load_lds((const unsigned*)((const char*)(gbase) + (voff)[_i]), (LAS unsigned*)(lds + (bufoff) + ldsw + _i * 8192), 16, 0, 0); } while (0)
#define PG8_LDA(dst, b, h) do { _Pragma("unroll") for (int m = 0; m < 4; ++m) _Pragma("unroll") for (int k = 0; k < 2; ++k) dst[m][k] = *(const LAS bf16x8*)(lds + PG8_SA(b, h) + aoff + m * 2048 + k * 1024); } while (0)
#define PG8_LDB(dst, b, h) do { _Pragma("unroll") for (int n = 0; n < 2; ++n) _Pragma("unroll") for (int k = 0; k < 2; ++k) dst[n][k] = *(const LAS bf16x8*)(lds + PG8_SB(b, h) + boff + n * 2048 + k * 1024); } while (0)
#define PG8_MMA(ai, bj, At, Bt) do { __builtin_amdgcn_s_setprio(1); _Pragma("unroll") for (int m = 0; m < 4; ++m) _Pragma("unroll") for (int n = 0; n < 2; ++n) _Pragma("unroll") for (int k = 0; k < 2; ++k) \
        acc[ai][bj][m][n] = __builtin_amdgcn_mfma_f32_16x16x32_bf16(Bt[n][k], At[m][k], acc[ai][bj][m][n], 0, 0, 0); __builtin_amdgcn_s_setprio(0); } while (0)
#define PG8_WAIT_V(n) asm volatile("s_waitcnt vmcnt(" #n ")" ::: "memory")
#define PG8_WAIT_L(n) asm volatile("s_waitcnt lgkmcnt(" #n ")" ::: "memory")
#define PG8_BAR __builtin_amdgcn_s_barrier()
#define PG8_SCHED __builtin_amdgcn_sched_barrier(0)
#define PG8_PA(u) ((const char*)g.A + (size_t)(u).pm * tA + (size_t)((u).pn / g.adiv) * (size_t)g.astride * 2)
#define PG8_PB(u) ((const char*)g.Bt + (size_t)(u).pn * tB)
    Unit cur, nxt; int ui = 0;
    if (!S.next(0, cur)) return;
    f32x4 acc[2][2][4][2];
#pragma unroll
    for (int a = 0; a < 2; ++a)
#pragma unroll
        for (int b = 0; b < 2; ++b)
#pragma unroll
            for (int m = 0; m < 4; ++m)
#pragma unroll
                for (int n = 0; n < 2; ++n) acc[a][b][m][n] = (f32x4){0.f, 0.f, 0.f, 0.f};
    bf16x8 At[4][2], B0[2][2], B1[2][2];
    const char* cA = PG8_PA(cur); const char* cB = PG8_PB(cur);
    PG8_STAGE(PG8_SB(0, 0), cB, voffB); PG8_STAGE(PG8_SB(0, 1), cB + hB, voffB); PG8_STAGE(PG8_SA(0, 0), cA, voffA); PG8_STAGE(PG8_SA(0, 1), cA + hA, voffA);
    if (wr == 1) PG8_BAR;
    PG8_WAIT_V(2); PG8_BAR;
    PG8_STAGE(PG8_SB(1, 0), cB + kstep, voffB); PG8_STAGE(PG8_SA(1, 0), cA + kstep, voffA); PG8_STAGE(PG8_SB(1, 1), cB + hB + kstep, voffB);
    PG8_WAIT_V(6); PG8_BAR;
    for (;;) {
        const bool has_next = S.next(ui + 1, nxt);
        const char* nA = has_next ? PG8_PA(nxt) : cA; const char* nB = has_next ? PG8_PB(nxt) : cB;
        for (int t = 0; t < nt; t += 2) {
            const bool last = (t == nt - 2);
            const char* a1 = cA + (size_t)(t + 1) * kstep;
            const char* a2 = last ? nA : cA + (size_t)(t + 2) * kstep; const char* b2 = last ? nB : cB + (size_t)(t + 2) * kstep;
            const char* a3 = a2 + kstep; const char* b3 = b2 + kstep;
            PG8_LDB(B0, 0, 0); PG8_LDB(B1, 0, 1); PG8_SCHED; PG8_LDA(At, 0, 0); PG8_STAGE(PG8_SA(1, 1), a1 + hA, voffA);
            PG8_WAIT_V(8); PG8_WAIT_L(0); PG8_BAR; PG8_MMA(0, 0, At, B0); PG8_MMA(0, 1, At, B1); PG8_BAR; PG8_SCHED;
            PG8_LDA(At, 0, 1); PG8_STAGE(PG8_SB(0, 0), b2, voffB); PG8_STAGE(PG8_SB(0, 1), b2 + hB, voffB); PG8_STAGE(PG8_SA(0, 0), a2, voffA);
            PG8_WAIT_V(8); PG8_WAIT_L(0); PG8_BAR; PG8_MMA(1, 0, At, B0); PG8_MMA(1, 1, At, B1); PG8_BAR; PG8_SCHED;
            PG8_LDB(B0, 1, 0); PG8_LDB(B1, 1, 1); PG8_SCHED; PG8_LDA(At, 1, 0); PG8_STAGE(PG8_SA(0, 1), a2 + hA, voffA);
            PG8_WAIT_V(8); PG8_WAIT_L(0); PG8_BAR; PG8_MMA(0, 0, At, B0); PG8_MMA(0, 1, At, B1); PG8_BAR; PG8_SCHED;
            PG8_LDA(At, 1, 1); PG8_STAGE(PG8_SB(1, 0), b3, voffB); PG8_STAGE(PG8_SB(1, 1), b3 + hB, voffB); PG8_STAGE(PG8_SA(1, 0), a3, voffA);
            PG8_WAIT_V(8); PG8_WAIT_L(0); PG8_BAR; PG8_MMA(1, 0, At, B0); PG8_MMA(1, 1, At, B1); PG8_BAR; PG8_SCHED;
        }
        if (wr == 0) PG8_BAR;
        E(acc, cur, wr, wc, fr, fq);
        if (!has_next) break;
#pragma unroll
        for (int a = 0; a < 2; ++a)
#pragma unroll
            for (int b = 0; b < 2; ++b)
#pragma unroll
                for (int m = 0; m < 4; ++m)
#pragma unroll
                    for (int n = 0; n < 2; ++n) acc[a][b][m][n] = (f32x4){0.f, 0.f, 0.f, 0.f};
        cur = nxt; cA = nA; cB = nB; ++ui;
        if (wr == 1) PG8_BAR;
    }
    PG8_WAIT_V(0);
    PG8_BAR;
#undef PG8_SA
#undef PG8_SB
#undef PG8_STAGE
#undef PG8_LDA
#undef PG8_LDB
#undef PG8_MMA
#undef PG8_WAIT_V
#undef PG8_WAIT_L
#undef PG8_BAR
#undef PG8_SCHED
#undef PG8_PA
#undef PG8_PB
}
}

namespace attn_body {
using bf16 = __hip_bfloat16;
using s16x4 = __attribute__((ext_vector_type(4))) short;
using f32x16 = __attribute__((ext_vector_type(16))) float;
constexpr int NW = 8, QBLK = 32, QB = QBLK * NW, KVBLK = 64;
constexpr int MA = 0, MB = 1, MC = 2, MD = 3;
__device__ __forceinline__ int crow(int r, int hi) { return (r & 3) + 8 * (r >> 2) + 4 * hi; }
#define SBAR() __builtin_amdgcn_sched_barrier(0)
constexpr int NSLOT = 3, SLOTB = 8192;
constexpr int LDS_K = 0, LDS_V = NSLOT * SLOTB, LDS_WS = 2 * NSLOT * SLOTB, LDS_OST = LDS_WS + NW * 64 * 4, LDS_ATT = LDS_OST + NW * 4096;
typedef __attribute__((address_space(3))) const char* lds_cptr;
typedef __attribute__((address_space(3))) const float* lds_fptr;

struct AttnArgs {
    const bf16* Q; const bf16* K; const bf16* V; bf16* O;
    int qs, ks, os;
    int NT, tlo, thi;
    float s2;
    int q0;
    int kb;
    float* stat; int ss;
    lds_fptr tab;
};

__device__ __forceinline__ void glds16(const void* gsrc, unsigned lds_dst) { unsigned keep;
  asm volatile("s_mov_b32 %0, m0\n\ts_mov_b32 m0, %2\n\ts_nop 0\n\tglobal_load_lds_dwordx4 %1, off\n\ts_mov_b32 m0, %0" : "=&s"(keep) : "v"(gsrc), "s"(lds_dst) : "memory"); }
__device__ __forceinline__ float max3f(float a, float b, float c) { float r; asm("v_max3_f32 %0, %1, %2, %3" : "=v"(r) : "v"(a), "v"(b), "v"(c)); return r; }
__device__ __forceinline__ float max2f(float a, float b) { float r; asm("v_max_f32_e32 %0, %1, %2" : "=v"(r) : "v"(a), "v"(b)); return r; }
__device__ __forceinline__ float fadd_s(float a, float b) { float r; asm("v_add_f32_e32 %0, %1, %2" : "=v"(r) : "v"(a), "v"(b)); return r; }
__device__ __forceinline__ float fsub_s(float a, float b) { float r; asm("v_sub_f32_e32 %0, %1, %2" : "=v"(r) : "v"(a), "v"(b)); return r; }
typedef float f32x2_t __attribute__((ext_vector_type(2))); typedef __bf16 bf16x2_t __attribute__((ext_vector_type(2)));
__device__ __forceinline__ unsigned cvtpk_s(float lo, float hi) { f32x2_t v = {lo, hi}; bf16x2_t b = __builtin_convertvector(v, bf16x2_t); return __builtin_bit_cast(unsigned, b); }
#define WAIT_BAR(N) asm volatile("s_waitcnt vmcnt(" #N ") lgkmcnt(0)\n\ts_barrier" ::: "memory")

__device__ __forceinline__ void qkt(f32x16& p0, f32x16& p1, const char* Kslot, const bf16x8* qr, const f32x16& negm, int r32, int hi) {
  const char* kb = Kslot + hi * 1024 + r32 * 16;
  #pragma unroll
  for (int d0 = 0; d0 < 4; ++d0) {
    const bf16x8 b0 = *reinterpret_cast<const bf16x8*>(kb + d0 * 2048);
    const bf16x8 b1 = *reinterpret_cast<const bf16x8*>(kb + d0 * 2048 + 512);
    if (d0 == 0) { p0 = __builtin_amdgcn_mfma_f32_32x32x16_bf16(b0, qr[0], negm, 0, 0, 0); p1 = __builtin_amdgcn_mfma_f32_32x32x16_bf16(b1, qr[0], negm, 0, 0, 0); }
    else { p0 = __builtin_amdgcn_mfma_f32_32x32x16_bf16(b0, qr[d0], p0, 0, 0, 0); p1 = __builtin_amdgcn_mfma_f32_32x32x16_bf16(b1, qr[d0], p1, 0, 0, 0); } }
}
typedef short v4i16_t __attribute__((ext_vector_type(4)));
__device__ __forceinline__ void kload8(bf16x8* kf, lds_cptr kp) {
  kf[0] = *(const LAS bf16x8*)(kp);        kf[1] = *(const LAS bf16x8*)(kp + 512);
  kf[2] = *(const LAS bf16x8*)(kp + 2048); kf[3] = *(const LAS bf16x8*)(kp + 2560);
  kf[4] = *(const LAS bf16x8*)(kp + 4096); kf[5] = *(const LAS bf16x8*)(kp + 4608);
  kf[6] = *(const LAS bf16x8*)(kp + 6144); kf[7] = *(const LAS bf16x8*)(kp + 6656);
}
__device__ __forceinline__ void kload2(bf16x8* kf, lds_cptr kp, int j) { kf[2 * j] = *(const LAS bf16x8*)(kp + j * 2048); kf[2 * j + 1] = *(const LAS bf16x8*)(kp + j * 2048 + 512); }
__device__ __forceinline__ s16x4 vtr(lds_cptr p) { return __builtin_bit_cast(s16x4, __builtin_amdgcn_ds_read_tr16_b64_v4i16((LAS v4i16_t*)p)); }
__device__ __forceinline__ float rowmax(const f32x16& p0, const f32x16& p1) {
  float a = max3f(p0[0], p0[1], p1[0]), b = max3f(p0[2], p0[3], p1[1]); a = max3f(a, p1[2], p1[3]);
  #pragma unroll
  for (int r = 4; r < 16; r += 4) { a = max3f(a, p0[r], p0[r + 1]); b = max3f(b, p0[r + 2], p0[r + 3]); a = max3f(a, p1[r], p1[r + 1]); b = max3f(b, p1[r + 2], p1[r + 3]); }
  const float m = max2f(a, b);
  auto rr = __builtin_amdgcn_permlane32_swap(__float_as_uint(m), __float_as_uint(m), false, false);
  return max2f(__uint_as_float(rr[0]), __uint_as_float(rr[1]));
}
__device__ __forceinline__ void pv(f32x16* o, int vb, bf16x8 pa0, bf16x8 pa1, bf16x8 pa2, bf16x8 pa3) {
  #pragma unroll
  for (int d0 = 0; d0 < 2; ++d0) { s16x4 lo[4], hi[4];
    #pragma unroll
    for (int ks = 0; ks < 4; ++ks) {
      asm volatile("ds_read_b64_tr_b16 %0,%1 offset:%c2" : "=&v"(lo[ks]) : "v"(vb), "i"(d0 * 4096 + ks * 1024) : "memory");
      asm volatile("ds_read_b64_tr_b16 %0,%1 offset:%c2" : "=&v"(hi[ks]) : "v"(vb), "i"(d0 * 4096 + ks * 1024 + 512) : "memory"); }
    asm volatile("s_waitcnt lgkmcnt(0)" ::: "memory"); SBAR();
    #define PK(k) (bf16x8){lo[k][0], lo[k][1], lo[k][2], lo[k][3], hi[k][0], hi[k][1], hi[k][2], hi[k][3]}
    o[d0] = __builtin_amdgcn_mfma_f32_32x32x16_bf16(pa0, PK(0), o[d0], 0, 0, 0);
    o[d0] = __builtin_amdgcn_mfma_f32_32x32x16_bf16(pa1, PK(1), o[d0], 0, 0, 0);
    o[d0] = __builtin_amdgcn_mfma_f32_32x32x16_bf16(pa2, PK(2), o[d0], 0, 0, 0);
    o[d0] = __builtin_amdgcn_mfma_f32_32x32x16_bf16(pa3, PK(3), o[d0], 0, 0, 0);
    #undef PK
  }
}

template <int MODE> __device__ __forceinline__ void score_hook(f32x16& c0, f32x16& c1, int t, const AttnArgs& a, int qrel, int hi, int wid, int r32, float mh) {
  if constexpr (MODE == MA) {
    const int wlo = a.q0 + wid * QBLK, sd = (64 * t + 63 < wlo) ? 1 : ((64 * t > wlo + 31) ? -1 : 0);
    if (sd != 0) { const float sv = (float)sd * a.s2;
      #pragma unroll
      for (int r = 0; r < 16; ++r) { const float kf = (float)((r & 3) + 8 * (r >> 2)); c0[r] = fmaf(kf, sv, c0[r]); c1[r] = fmaf(kf + 32.f, sv, c1[r]); if ((r & 3) == 3) __builtin_amdgcn_sched_barrier(0); }
    } else {
      const float dq = (float)(a.q0 + qrel - 64 * t - 4 * hi), ns = -a.s2;
      #pragma unroll
      for (int r = 0; r < 16; ++r) { const float kf = (float)((r & 3) + 8 * (r >> 2)); c0[r] = fmaf(ns, fabsf(dq - kf), c0[r]); c1[r] = fmaf(ns, fabsf(dq - (kf + 32.f)), c1[r]); if ((r & 1) == 1) __builtin_amdgcn_sched_barrier(0); }
    }
  }
  if constexpr (MODE == MB) {
    const bool tv = (t >= a.tlo) && (t <= a.thi);
    const float dq = (float)(qrel + 64 - 64 * t - 4 * hi), ns = -a.s2;
    #pragma unroll
    for (int r = 0; r < 16; ++r) { const float kf = (float)((r & 3) + 8 * (r >> 2)); const float d0 = fabsf(dq - kf), d1 = fabsf(dq - (kf + 32.f));
      c0[r] = (tv && d0 <= 64.f) ? fmaf(ns, d0, c0[r] - mh) : -INFINITY; c1[r] = (tv && d1 <= 64.f) ? fmaf(ns, d1, c1[r] - mh) : -INFINITY;
      if ((r & 3) == 3) __builtin_amdgcn_sched_barrier(0); }
  }
  if constexpr (MODE == MC) {
    const int qrow = a.q0 + (wid >> 1), rs = min(max(qrow - 4, 0), 120), krow = a.kb + t;
    if (krow < rs || krow >= rs + 8) {
      #pragma unroll
      for (int r = 0; r < 16; ++r) { c0[r] = -INFINITY; c1[r] = -INFINITY; }
    } else {
      const int qc = (wid & 1) * 32 + r32, cs = min(max(qc - 8, 0), 48);
      const lds_fptr tp = a.tab + (krow - qrow + 7) * 31 + (15 - qc + 4 * hi);
      const int kd = 4 * hi - cs;
      #pragma unroll
      for (int r = 0; r < 16; ++r) { const int kc = (r & 3) + 8 * (r >> 2);
        const float b0 = tp[kc], b1 = tp[kc + 32];
        c0[r] = ((unsigned)(kd + kc) < 16u) ? c0[r] + (b0 - mh) : -INFINITY; c1[r] = ((unsigned)(kd + kc + 32) < 16u) ? c1[r] + (b1 - mh) : -INFINITY;
        if ((r & 3) == 3) __builtin_amdgcn_sched_barrier(0); }
    }
  }
}

template <int MODE, int THRL> __device__ __forceinline__ void attn_unit(const AttnArgs& A_, char* shm) {
  int tid_ = threadIdx.x; asm volatile("" : "+v"(tid_));
  const int tid = tid_, lane = tid & 63, r32 = lane & 31, hi = lane >> 5; const int wid = __builtin_amdgcn_readfirstlane(tid >> 6);
  const bf16* Qw = A_.Q + (wid * QBLK) * A_.qs;
  const unsigned lds0 = (unsigned)(uintptr_t)shm;
  float* wsf = (float*)(shm + LDS_WS) + wid * 64;
  const int ks = A_.ks;
  const bf16* ksrc = A_.K + (lane * ks + wid * 8);
  const bf16* vsrc = A_.V + ((16 * (wid & 3) + (lane >> 2)) * ks + (wid >> 2) * 32 + (lane & 3) * 8);
  const unsigned kdst = lds0 + LDS_K + wid * 1024, vdst = lds0 + LDS_V + wid * 1024;
  #define TT(t) ((MODE == MB) ? min(max((int)(t), A_.tlo), A_.thi) : (int)(t))
  #define DMA_K(t, slot) glds16(ksrc + TT(t) * KVBLK * ks, (unsigned)__builtin_amdgcn_readfirstlane(kdst + (slot)))
  #define DMA_V(t, slot) glds16(vsrc + TT(t) * KVBLK * ks, (unsigned)__builtin_amdgcn_readfirstlane(vdst + (slot)))
  const int vb0 = (int)(lds0 + LDS_V) + ((lane >> 4) & 1) * 32 + (lane & 3) * 8 + (4 * hi + ((lane & 15) >> 2)) * 64;
  const char* Kbase = shm + LDS_K; bf16x8 kf[8];
  const lds_cptr shm3 = (lds_cptr)shm; const lds_cptr kp0 = shm3 + LDS_K + hi * 1024 + r32 * 16; const lds_cptr vp0 = shm3 + LDS_V + ((lane >> 4) & 1) * 32 + (lane & 3) * 8 + (4 * hi + ((lane & 15) >> 2)) * 64;
  const int NT = A_.NT;
  DMA_K(0, 0); DMA_V(0, 0); DMA_K(1, SLOTB);
  bf16x8 qr[4];
  #pragma unroll
  for (int d0 = 0; d0 < 4; ++d0) qr[d0] = *reinterpret_cast<const bf16x8*>(&Qw[r32 * A_.qs + d0 * 16 + hi * 8]);
  float mhat = 0.f, l_reg = 0.f; f32x16 o[2]; o[0] = f32x16{}; o[1] = f32x16{}; f32x16 negm = f32x16{}; asm volatile("" : "+v"(negm));
  const int qrel = wid * QBLK + r32;
  constexpr bool NEGM = (MODE == MA || MODE == MD);
  #define CIN (NEGM ? negm : f32x16{})
  #define NEGM_SET(tn) do { float nb_ = -mhat; \
      if (MODE == MA) { const int wlo_ = A_.q0 + wid * QBLK, sd_ = (64 * (tn) + 63 < wlo_) ? 1 : ((64 * (tn) > wlo_ + 31) ? -1 : 0); \
        if (sd_ != 0) nb_ = fmaf(-(float)sd_ * A_.s2, (float)(A_.q0 + qrel - 64 * (tn) - 4 * hi), nb_); } \
      _Pragma("unroll") for (int r = 0; r < 16; ++r) negm[r] = nb_; asm volatile("" : "+v"(negm)); } while (0)
  #define CMASK(P0, P1, t) score_hook<MODE>(P0, P1, (t), A_, qrel, hi, wid, r32, mhat)
  bool resc = false;
  #define START(P0, P1) do { const float rm = rowmax(P0, P1); resc = false; \
    { const float dl = (MODE == MB || MODE == MC) ? fmaxf(rm, -2048.f) : rm; mhat = fadd_s(mhat, dl); \
      _Pragma("unroll") for (int r = 0; r < 16; ++r) { P0[r] = fsub_s(P0[r], dl); P1[r] = fsub_s(P1[r], dl); } \
      if (NEGM) { NEGM_SET(1); } } \
    _Pragma("unroll") for (int r = 0; r < 16; ++r) P0[r] = __builtin_amdgcn_exp2f(P0[r]); } while (0)
  #define RESC() do { if (resc) { asm volatile("s_waitcnt lgkmcnt(0)" ::: "memory"); \
      _Pragma("unroll") for (int d_ = 0; d_ < 2; ++d_) _Pragma("unroll") for (int r = 0; r < 16; ++r) o[d_][r] *= wsf[crow(r, hi)]; } } while (0)
  f32x16 pA0, pA1, pB0, pB1;
  int sl_prev = 0, sl_cur = 0, sl_next = SLOTB;
  #define ROT() do { sl_prev = sl_cur; sl_cur = sl_next; sl_next = (sl_next == (NSLOT - 1) * SLOTB) ? 0 : sl_next + SLOTB; } while (0)
  DMA_K(2, 2 * SLOTB);
  if (MODE == MA) { NEGM_SET(0); }
  WAIT_BAR(3);
  qkt(pA0, pA1, Kbase, qr, negm, r32, hi); asm volatile("s_nop 15\n\ts_nop 7" : "+v"(pA0), "+v"(pA1)); CMASK(pA0, pA1, 0);
  START(pA0, pA1);
  _Pragma("unroll") for (int r = 0; r < 16; ++r) pA1[r] = __builtin_amdgcn_exp2f(pA1[r]);
  WAIT_BAR(0);
  DMA_K(3, 0); DMA_V(1, SLOTB);
  ROT();
  kload8(kf, kp0 + sl_cur);
  WAIT_BAR(2);
  s16x4 vlo[8], vhi[8]; u32x4 pw0, pw1, pw2, pw3;
  #define PKW(P, B) cvtpk_s(P[B], P[B + 1])
  #define PAF(k) __builtin_bit_cast(bf16x8, pw##k)
  #define VFR(i) (bf16x8){vlo[i][0], vlo[i][1], vlo[i][2], vlo[i][3], vhi[i][0], vhi[i][1], vhi[i][2], vhi[i][3]}
  #define PIN(x) asm volatile("" : "+v"(x))
  #define MX3(a, b, c) __builtin_fmaxf(__builtin_fmaxf((a), (b)), (c))
  #define GAPA(MF, A0, A1, A2, A3, W0, W1, PW) do { MF; sacc += A0; sacc += A1; sacc += A2; sacc += A3; PIN(sacc); W0; W1; PIN(PW); SBAR(); } while (0)
  #define EX(v) __builtin_amdgcn_exp2f(v)
  #define GAPB(MF, X, B) do { MF; X[B] = EX(X[B]); X[B + 1] = EX(X[B + 1]); X[B + 2] = EX(X[B + 2]); X[B + 3] = EX(X[B + 3]); PIN(X); SBAR(); } while (0)
  #define VRD(i) do { vlo[i] = vtr(vp_ + (((i) >> 2) * 4096 + ((i) & 3) * 1024)); vhi[i] = vtr(vp_ + (((i) >> 2) * 4096 + ((i) & 3) * 1024 + 512)); } while (0)
  #define KRD(G, j) do { if (G) { kload2(kf, kp0 + sl_next, j); SBAR(); } } while (0)
  #define STEP(C0, C1, P0, P1, t, GK, GV, GL) do { SBAR(); \
    const lds_cptr vp_ = vp0 + sl_prev; \
    VRD(0); SBAR(); float sacc = (P0[0] + P0[1]); \
    GAPA(C0 = __builtin_amdgcn_mfma_f32_32x32x16_bf16(kf[0], qr[0], CIN, 0, 0, 0), P0[2], P0[3], P0[4], P0[5],     pw0[0] = PKW(P0, 0), pw0[1] = PKW(P0, 2), pw0); \
    VRD(4); SBAR(); GAPA(C1 = __builtin_amdgcn_mfma_f32_32x32x16_bf16(kf[1], qr[0], CIN, 0, 0, 0), P0[6], P0[7], P0[8], P0[9],     pw0[2] = PKW(P0, 4), pw0[3] = PKW(P0, 6), pw0); \
    VRD(1); SBAR(); GAPA(C0 = __builtin_amdgcn_mfma_f32_32x32x16_bf16(kf[2], qr[1], C0, 0, 0, 0),   P0[10], P0[11], P0[12], P0[13], pw1[0] = PKW(P0, 8), pw1[1] = PKW(P0, 10), pw1); \
    VRD(5); SBAR(); GAPA(C1 = __builtin_amdgcn_mfma_f32_32x32x16_bf16(kf[3], qr[1], C1, 0, 0, 0),   P0[14], P0[15], P1[0], P1[1],   pw1[2] = PKW(P0, 12), pw1[3] = PKW(P0, 14), pw1); \
    VRD(2); SBAR(); GAPA(C0 = __builtin_amdgcn_mfma_f32_32x32x16_bf16(kf[4], qr[2], C0, 0, 0, 0),   P1[2], P1[3], P1[4], P1[5],     pw2[0] = PKW(P1, 0), pw2[1] = PKW(P1, 2), pw2); \
    VRD(6); SBAR(); GAPA(C1 = __builtin_amdgcn_mfma_f32_32x32x16_bf16(kf[5], qr[2], C1, 0, 0, 0),   P1[6], P1[7], P1[8], P1[9],     pw2[2] = PKW(P1, 4), pw2[3] = PKW(P1, 6), pw2); \
    VRD(3); SBAR(); GAPA(C0 = __builtin_amdgcn_mfma_f32_32x32x16_bf16(kf[6], qr[3], C0, 0, 0, 0),   P1[10], P1[11], P1[12], P1[13], pw3[0] = PKW(P1, 8), pw3[1] = PKW(P1, 10), pw3); \
    VRD(7); SBAR(); GAPA(C1 = __builtin_amdgcn_mfma_f32_32x32x16_bf16(kf[7], qr[3], C1, 0, 0, 0),   P1[14], P1[15], 0.f, 0.f,       pw3[2] = PKW(P1, 12), pw3[3] = PKW(P1, 14), pw3); \
    l_reg += sacc; \
    if (GK) { DMA_K((t) + 3, sl_cur); } if (GV) { DMA_V((t) + 1, sl_next); } \
    CMASK(C0, C1, t); \
    { float a = MX3(C0[0], C0[1], C1[0]), b = MX3(C0[2], C0[3], C1[1]); a = MX3(a, C1[2], C1[3]); \
      _Pragma("unroll") for (int r = 4; r < 16; r += 4) { a = MX3(a, C0[r], C0[r + 1]); b = MX3(b, C0[r + 2], C0[r + 3]); a = MX3(a, C1[r], C1[r + 1]); b = MX3(b, C1[r + 2], C1[r + 3]); } \
      float rm = __builtin_fmaxf(a, b); { auto rr = __builtin_amdgcn_permlane32_swap(__float_as_uint(rm), __float_as_uint(rm), false, false); rm = __builtin_fmaxf(__uint_as_float(rr[0]), __uint_as_float(rr[1])); } \
      resc = false; \
      if (__builtin_expect(__any(rm > (float)THRL), 0)) { const float dl = __builtin_fmaxf(rm, 0.f); mhat += dl; \
        _Pragma("unroll") for (int r = 0; r < 16; ++r) { C0[r] -= dl; C1[r] -= dl; } \
        if (MODE == MD) { NEGM_SET(0); } \
        const float f = __builtin_amdgcn_exp2f(-dl); l_reg *= f; if (hi == 0) wsf[r32] = f; resc = true; } \
      if (MODE == MA) { NEGM_SET((t) + 1); } } \
    SBAR(); \
    GAPB(o[0] = __builtin_amdgcn_mfma_f32_32x32x16_bf16(PAF(0), VFR(0), o[0], 0, 0, 0), C0, 0); \
    GAPB(o[1] = __builtin_amdgcn_mfma_f32_32x32x16_bf16(PAF(0), VFR(4), o[1], 0, 0, 0), C0, 4); \
    KRD(GL, 0); GAPB(o[0] = __builtin_amdgcn_mfma_f32_32x32x16_bf16(PAF(1), VFR(1), o[0], 0, 0, 0), C0, 8); \
    KRD(GL, 1); GAPB(o[1] = __builtin_amdgcn_mfma_f32_32x32x16_bf16(PAF(1), VFR(5), o[1], 0, 0, 0), C0, 12); \
    KRD(GL, 2); GAPB(o[0] = __builtin_amdgcn_mfma_f32_32x32x16_bf16(PAF(2), VFR(2), o[0], 0, 0, 0), C1, 0); \
    KRD(GL, 3); GAPB(o[1] = __builtin_amdgcn_mfma_f32_32x32x16_bf16(PAF(2), VFR(6), o[1], 0, 0, 0), C1, 4); \
    GAPB(o[0] = __builtin_amdgcn_mfma_f32_32x32x16_bf16(PAF(3), VFR(3), o[0], 0, 0, 0), C1, 8); \
    GAPB(o[1] = __builtin_amdgcn_mfma_f32_32x32x16_bf16(PAF(3), VFR(7), o[1], 0, 0, 0), C1, 12); \
    } while (0)
  int t = 1;
  for (; t + 5 < NT; t += 2) {
    STEP(pB0, pB1, pA0, pA1, t, true, true, true);     WAIT_BAR(2); RESC(); ROT();
    STEP(pA0, pA1, pB0, pB1, t + 1, true, true, true); WAIT_BAR(2); RESC(); ROT();
  }
  #define ENDW(tt) do { if ((tt) + 3 < NT) { WAIT_BAR(2); } else if ((tt) + 2 < NT) { WAIT_BAR(1); } else { WAIT_BAR(0); } } while (0)
  for (; t + 1 < NT; t += 2) {
    STEP(pB0, pB1, pA0, pA1, t, (t + 3 < NT), (t + 1 < NT), (t + 1 < NT));         ENDW(t);     RESC(); ROT();
    STEP(pA0, pA1, pB0, pB1, t + 1, (t + 4 < NT), (t + 2 < NT), (t + 2 < NT));     ENDW(t + 1); RESC(); ROT();
  }
  STEP(pB0, pB1, pA0, pA1, NT - 1, false, false, false); RESC();
  { float sacc = pB0[0] + pB0[1]; _Pragma("unroll") for (int r = 2; r < 16; ++r) sacc += pB0[r]; _Pragma("unroll") for (int r = 0; r < 16; ++r) sacc += pB1[r]; l_reg += sacc;
    pw0 = (u32x4){PKW(pB0, 0), PKW(pB0, 2), PKW(pB0, 4), PKW(pB0, 6)}; pw1 = (u32x4){PKW(pB0, 8), PKW(pB0, 10), PKW(pB0, 12), PKW(pB0, 14)}; pw2 = (u32x4){PKW(pB1, 0), PKW(pB1, 2), PKW(pB1, 4), PKW(pB1, 6)}; pw3 = (u32x4){PKW(pB1, 8), PKW(pB1, 10), PKW(pB1, 12), PKW(pB1, 14)};
    SBAR(); pv(o, vb0 + sl_cur, PAF(0), PAF(1), PAF(2), PAF(3)); }
  #undef PKW
  #undef PAF
  #undef VFR
  #undef PIN
  #undef MX3
  #undef GAPA
  #undef GAPB
  #undef EX
  #undef VRD
  #undef KRD
  #undef STEP
  #undef ENDW
  { auto rr = __builtin_amdgcn_permlane32_swap(__float_as_uint(l_reg), __float_as_uint(l_reg), false, false); l_reg = __uint_as_float(rr[0]) + __uint_as_float(rr[1]); }
  if (MODE == MB) { if (hi == 0) { float* sp = A_.stat + (wid * QBLK + r32) * A_.ss; sp[0] = mhat; sp[1] = l_reg; } }
  if (hi == 0) wsf[32 + r32] = l_reg; asm volatile("s_waitcnt lgkmcnt(0)" ::: "memory");
  float rli[16];
  #pragma unroll
  for (int r = 0; r < 16; ++r) rli[r] = __builtin_amdgcn_rcpf(wsf[32 + crow(r, hi)]);
  bf16* Ow = A_.O + (wid * QBLK) * A_.os;
  { bf16* stg = (bf16*)(shm + LDS_OST) + wid * 2048;
    #pragma unroll
    for (int r = 0; r < 16; ++r) { const int orow = crow(r, hi);
      #pragma unroll
      for (int d0 = 0; d0 < 2; ++d0) stg[orow * 64 + d0 * 32 + r32] = __float2bfloat16(o[d0][r] * rli[r]); }
    asm volatile("s_waitcnt lgkmcnt(0)" ::: "memory");
    #pragma unroll
    for (int i = 0; i < 4; ++i) { const int row = i * 8 + (lane >> 3), ch = lane & 7; const u32x4 v = *(const u32x4*)(stg + row * 64 + ch * 8); *(u32x4*)(Ow + row * A_.os + ch * 8) = v; } }
  asm volatile("s_waitcnt lgkmcnt(0)\n\ts_barrier" ::: "memory");
  #undef DMA_K
  #undef DMA_V
  #undef TT
  #undef CMASK
  #undef CIN
  #undef NEGM_SET
  #undef START
  #undef RESC
  #undef ROT
}

constexpr int L8_K = 0, L8_V = 3 * 8192, L8_WS = L8_V + 3 * 16384, L8_QO = L8_WS + 2048, L8_END = L8_QO + 8 * 4096;
template <int THRL> __device__ __forceinline__ void attn_unit128(const AttnArgs& A_, char* shm) {
  int tid_ = threadIdx.x; asm volatile("" : "+v"(tid_));
  const int tid = tid_, lane = tid & 63, r32 = lane & 31, hi = lane >> 5; const int wid = __builtin_amdgcn_readfirstlane(tid >> 6);
  const bf16* Qw = A_.Q + (wid * QBLK) * A_.qs;
  const unsigned lds0 = (unsigned)(uintptr_t)shm;
  float* wsf = (float*)(shm + L8_WS) + wid * 64;
  const int ks = A_.ks;
  const bf16* ksrc = A_.K + (lane * ks + wid * 8);
  const bf16* vsrc = A_.V + ((16 * (wid & 3) + (lane >> 2)) * ks + (wid >> 2) * 32 + (lane & 3) * 8);
  const unsigned kdst = lds0 + L8_K + wid * 1024, vdst = lds0 + L8_V + wid * 1024;
  #define DMA_K(t, slot) glds16(ksrc + (int)(t) * KVBLK * ks, (unsigned)__builtin_amdgcn_readfirstlane(kdst + (slot)))
  #define DMA_V(t, slot) do { glds16(vsrc + (int)(t) * KVBLK * ks, (unsigned)__builtin_amdgcn_readfirstlane(vdst + 2 * (slot))); \
                              glds16(vsrc + (int)(t) * KVBLK * ks + 64, (unsigned)__builtin_amdgcn_readfirstlane(vdst + 2 * (slot) + 8192)); } while (0)
  const int vb0 = (int)(lds0 + L8_V) + ((lane >> 4) & 1) * 32 + (lane & 3) * 8 + (4 * hi + ((lane & 15) >> 2)) * 64;
  const char* Kbase = shm + L8_K; bf16x8 kf[8];
  const lds_cptr shm3 = (lds_cptr)shm; const lds_cptr kp0 = shm3 + L8_K + hi * 1024 + r32 * 16; const lds_cptr vp0 = shm3 + L8_V + ((lane >> 4) & 1) * 32 + (lane & 3) * 8 + (4 * hi + ((lane & 15) >> 2)) * 64;
  const lds_cptr qst = shm3 + L8_QO + wid * 4096 + lane * 16;
  const int NT = A_.NT;
  DMA_K(0, 0); DMA_V(0, 0); DMA_K(1, SLOTB);
  { bf16x8 qr[4];
    #pragma unroll
    for (int d0 = 0; d0 < 4; ++d0) qr[d0] = *reinterpret_cast<const bf16x8*>(&Qw[r32 * A_.qs + d0 * 16 + hi * 8]);
    #pragma unroll
    for (int d0 = 0; d0 < 4; ++d0) *(LAS bf16x8*)(shm3 + L8_QO + wid * 4096 + lane * 16 + d0 * 1024) = qr[d0]; }
  #define QLD(d0) (*(const LAS bf16x8*)(qst + (d0) * 1024))
  float mhat = 0.f, l_reg = 0.f; f32x16 o[4]; o[0] = f32x16{}; o[1] = f32x16{}; o[2] = f32x16{}; o[3] = f32x16{};
  const int qrel = wid * QBLK + r32;
  #define NB(tn) ({ float nb_ = -mhat; const int wlo_ = A_.q0 + wid * QBLK, sd_ = (64 * (tn) + 63 < wlo_) ? 1 : ((64 * (tn) > wlo_ + 31) ? -1 : 0); \
      if (sd_ != 0) nb_ = fmaf(-(float)sd_ * A_.s2, (float)(A_.q0 + qrel - 64 * (tn) - 4 * hi), nb_); nb_; })
  #define CMASK(P0, P1, t) score_hook<MA>(P0, P1, (t), A_, qrel, hi, wid, r32, mhat)
  bool resc = false;
  #define RESC() do { if (resc) { asm volatile("s_waitcnt lgkmcnt(0)" ::: "memory"); \
      _Pragma("unroll") for (int d_ = 0; d_ < 4; ++d_) _Pragma("unroll") for (int r = 0; r < 16; ++r) o[d_][r] *= wsf[crow(r, hi)]; } } while (0)
  f32x16 pA0, pA1, pB0, pB1;
  int sl_prev = 0, sl_cur = 0, sl_next = SLOTB;
  #define ROT() do { sl_prev = sl_cur; sl_cur = sl_next; sl_next = (sl_next == (NSLOT - 1) * SLOTB) ? 0 : sl_next + SLOTB; } while (0)
  DMA_K(2, 2 * SLOTB);
  WAIT_BAR(4);
  { f32x16 cin; const float nb0 = NB(0);
    #pragma unroll
    for (int r = 0; r < 16; ++r) cin[r] = nb0;
    bf16x8 qr[4];
    #pragma unroll
    for (int d0 = 0; d0 < 4; ++d0) qr[d0] = QLD(d0);
    qkt(pA0, pA1, Kbase, qr, cin, r32, hi); }
  asm volatile("s_nop 15\n\ts_nop 7" : "+v"(pA0), "+v"(pA1)); CMASK(pA0, pA1, 0);
  { const float rm = rowmax(pA0, pA1); mhat = fadd_s(mhat, rm);
    #pragma unroll
    for (int r = 0; r < 16; ++r) { pA0[r] = fsub_s(pA0[r], rm); pA1[r] = fsub_s(pA1[r], rm); }
    #pragma unroll
    for (int r = 0; r < 16; ++r) pA0[r] = __builtin_amdgcn_exp2f(pA0[r]);
    #pragma unroll
    for (int r = 0; r < 16; ++r) pA1[r] = __builtin_amdgcn_exp2f(pA1[r]); }
  WAIT_BAR(0);
  DMA_K(3, 0); DMA_V(1, SLOTB);
  ROT();
  kload8(kf, kp0 + sl_cur);
  WAIT_BAR(3);
  u32x4 pw0, pw1, pw2, pw3;
  #define PKW(P, B) cvtpk_s(P[B], P[B + 1])
  #define PAF(k) __builtin_bit_cast(bf16x8, pw##k)
  #define PIN(x) asm volatile("" : "+v"(x))
  #define MX3(a, b, c) __builtin_fmaxf(__builtin_fmaxf((a), (b)), (c))
  #define GAPA(MF, A0, A1, A2, A3, W0, W1, PW) do { MF; sacc += A0; sacc += A1; sacc += A2; sacc += A3; PIN(sacc); W0; W1; PIN(PW); SBAR(); } while (0)
  #define EX(v) __builtin_amdgcn_exp2f(v)
  #define GAPB(MF, X, B) do { MF; X[B] = EX(X[B]); X[B + 1] = EX(X[B + 1]); PIN(X); SBAR(); } while (0)
  #define KRD(G, j) do { if (G) { kload2(kf, kp0 + sl_next, j); SBAR(); } } while (0)
  #define FOFF(j) (((((j) & 1) + 2 * ((j) >> 3)) * 4096) + ((((j) >> 1) & 3) * 1024))
  #define FRD(j) do { fl[j] = vtr(vp_ + FOFF(j)); fh[j] = vtr(vp_ + FOFF(j) + 512); SBAR(); } while (0)
  #define FFR(j) (bf16x8){fl[j][0], fl[j][1], fl[j][2], fl[j][3], fh[j][0], fh[j][1], fh[j][2], fh[j][3]}
  #define STEP(C0, C1, P0, P1, t, GK, GV, GL) do { SBAR(); \
    const lds_cptr vp_ = vp0 + 2 * sl_prev; s16x4 fl[16], fh[16]; \
    { const float nb_t = NB(t); _Pragma("unroll") for (int r = 0; r < 16; ++r) { C0[r] = nb_t; C1[r] = nb_t; } } \
    bf16x8 q0_ = QLD(0), q1_ = QLD(1); SBAR(); float sacc = (P0[0] + P0[1]); \
    GAPA(C0 = __builtin_amdgcn_mfma_f32_32x32x16_bf16(kf[0], q0_, C0, 0, 0, 0), P0[2], P0[3], P0[4], P0[5],     pw0[0] = PKW(P0, 0), pw0[1] = PKW(P0, 2), pw0); \
    GAPA(C1 = __builtin_amdgcn_mfma_f32_32x32x16_bf16(kf[1], q0_, C1, 0, 0, 0), P0[6], P0[7], P0[8], P0[9],     pw0[2] = PKW(P0, 4), pw0[3] = PKW(P0, 6), pw0); \
    q0_ = QLD(2); SBAR(); \
    GAPA(C0 = __builtin_amdgcn_mfma_f32_32x32x16_bf16(kf[2], q1_, C0, 0, 0, 0),   P0[10], P0[11], P0[12], P0[13], pw1[0] = PKW(P0, 8), pw1[1] = PKW(P0, 10), pw1); \
    GAPA(C1 = __builtin_amdgcn_mfma_f32_32x32x16_bf16(kf[3], q1_, C1, 0, 0, 0),   P0[14], P0[15], P1[0], P1[1],   pw1[2] = PKW(P0, 12), pw1[3] = PKW(P0, 14), pw1); \
    q1_ = QLD(3); SBAR(); \
    GAPA(C0 = __builtin_amdgcn_mfma_f32_32x32x16_bf16(kf[4], q0_, C0, 0, 0, 0),   P1[2], P1[3], P1[4], P1[5],     pw2[0] = PKW(P1, 0), pw2[1] = PKW(P1, 2), pw2); \
    GAPA(C1 = __builtin_amdgcn_mfma_f32_32x32x16_bf16(kf[5], q0_, C1, 0, 0, 0),   P1[6], P1[7], P1[8], P1[9],     pw2[2] = PKW(P1, 4), pw2[3] = PKW(P1, 6), pw2); \
    GAPA(C0 = __builtin_amdgcn_mfma_f32_32x32x16_bf16(kf[6], q1_, C0, 0, 0, 0),   P1[10], P1[11], P1[12], P1[13], pw3[0] = PKW(P1, 8), pw3[1] = PKW(P1, 10), pw3); \
    GAPA(C1 = __builtin_amdgcn_mfma_f32_32x32x16_bf16(kf[7], q1_, C1, 0, 0, 0),   P1[14], P1[15], 0.f, 0.f,       pw3[2] = PKW(P1, 12), pw3[3] = PKW(P1, 14), pw3); \
    l_reg += sacc; \
    if (GK) { DMA_K((t) + 3, sl_cur); } if (GV) { DMA_V((t) + 1, sl_next); } \
    FRD(0); FRD(1); FRD(2); \
    CMASK(C0, C1, t); \
    { float a = MX3(C0[0], C0[1], C1[0]), b = MX3(C0[2], C0[3], C1[1]); a = MX3(a, C1[2], C1[3]); \
      _Pragma("unroll") for (int r = 4; r < 16; r += 4) { a = MX3(a, C0[r], C0[r + 1]); b = MX3(b, C0[r + 2], C0[r + 3]); a = MX3(a, C1[r], C1[r + 1]); b = MX3(b, C1[r + 2], C1[r + 3]); } \
      float rm = __builtin_fmaxf(a, b); { auto rr = __builtin_amdgcn_permlane32_swap(__float_as_uint(rm), __float_as_uint(rm), false, false); rm = __builtin_fmaxf(__uint_as_float(rr[0]), __uint_as_float(rr[1])); } \
      resc = false; \
      if (__builtin_expect(__any(rm > (float)THRL), 0)) { const float dl = __builtin_fmaxf(rm, 0.f); mhat += dl; \
        _Pragma("unroll") for (int r = 0; r < 16; ++r) { C0[r] -= dl; C1[r] -= dl; } \
        const float f = __builtin_amdgcn_exp2f(-dl); l_reg *= f; if (hi == 0) wsf[r32] = f; resc = true; } } \
    SBAR(); \
    GAPB(o[0] = __builtin_amdgcn_mfma_f32_32x32x16_bf16(PAF(0), FFR(0), o[0], 0, 0, 0), C0, 0);   FRD(3); \
    GAPB(o[1] = __builtin_amdgcn_mfma_f32_32x32x16_bf16(PAF(0), FFR(1), o[1], 0, 0, 0), C0, 2);   FRD(4); \
    GAPB(o[0] = __builtin_amdgcn_mfma_f32_32x32x16_bf16(PAF(1), FFR(2), o[0], 0, 0, 0), C0, 4);   FRD(5); \
    GAPB(o[1] = __builtin_amdgcn_mfma_f32_32x32x16_bf16(PAF(1), FFR(3), o[1], 0, 0, 0), C0, 6);   FRD(6); \
    GAPB(o[0] = __builtin_amdgcn_mfma_f32_32x32x16_bf16(PAF(2), FFR(4), o[0], 0, 0, 0), C0, 8);   FRD(7); \
    GAPB(o[1] = __builtin_amdgcn_mfma_f32_32x32x16_bf16(PAF(2), FFR(5), o[1], 0, 0, 0), C0, 10);  FRD(8); \
    GAPB(o[0] = __builtin_amdgcn_mfma_f32_32x32x16_bf16(PAF(3), FFR(6), o[0], 0, 0, 0), C0, 12);  FRD(9); \
    GAPB(o[1] = __builtin_amdgcn_mfma_f32_32x32x16_bf16(PAF(3), FFR(7), o[1], 0, 0, 0), C0, 14);  FRD(10); \
    KRD(GL, 0); GAPB(o[2] = __builtin_amdgcn_mfma_f32_32x32x16_bf16(PAF(0), FFR(8), o[2], 0, 0, 0), C1, 0);   FRD(11); \
    KRD(GL, 1); GAPB(o[3] = __builtin_amdgcn_mfma_f32_32x32x16_bf16(PAF(0), FFR(9), o[3], 0, 0, 0), C1, 2);   FRD(12); \
    KRD(GL, 2); GAPB(o[2] = __builtin_amdgcn_mfma_f32_32x32x16_bf16(PAF(1), FFR(10), o[2], 0, 0, 0), C1, 4);  FRD(13); \
    KRD(GL, 3); GAPB(o[3] = __builtin_amdgcn_mfma_f32_32x32x16_bf16(PAF(1), FFR(11), o[3], 0, 0, 0), C1, 6);  FRD(14); \
    GAPB(o[2] = __builtin_amdgcn_mfma_f32_32x32x16_bf16(PAF(2), FFR(12), o[2], 0, 0, 0), C1, 8);  FRD(15); \
    GAPB(o[3] = __builtin_amdgcn_mfma_f32_32x32x16_bf16(PAF(2), FFR(13), o[3], 0, 0, 0), C1, 10); \
    GAPB(o[2] = __builtin_amdgcn_mfma_f32_32x32x16_bf16(PAF(3), FFR(14), o[2], 0, 0, 0), C1, 12); \
    GAPB(o[3] = __builtin_amdgcn_mfma_f32_32x32x16_bf16(PAF(3), FFR(15), o[3], 0, 0, 0), C1, 14); \
    } while (0)
  int t = 1;
  for (; t + 5 < NT; t += 2) {
    STEP(pB0, pB1, pA0, pA1, t, true, true, true);     WAIT_BAR(3); RESC(); ROT();
    STEP(pA0, pA1, pB0, pB1, t + 1, true, true, true); WAIT_BAR(3); RESC(); ROT();
  }
  #define ENDW(tt) do { if ((tt) + 3 < NT) { WAIT_BAR(3); } else if ((tt) + 2 < NT) { WAIT_BAR(2); } else { WAIT_BAR(0); } } while (0)
  for (; t + 1 < NT; t += 2) {
    STEP(pB0, pB1, pA0, pA1, t, (t + 3 < NT), (t + 1 < NT), (t + 1 < NT));         ENDW(t);     RESC(); ROT();
    STEP(pA0, pA1, pB0, pB1, t + 1, (t + 4 < NT), (t + 2 < NT), (t + 2 < NT));     ENDW(t + 1); RESC(); ROT();
  }
  STEP(pB0, pB1, pA0, pA1, NT - 1, false, false, false); RESC();
  { float sacc = pB0[0] + pB0[1]; _Pragma("unroll") for (int r = 2; r < 16; ++r) sacc += pB0[r]; _Pragma("unroll") for (int r = 0; r < 16; ++r) sacc += pB1[r]; l_reg += sacc;
    pw0 = (u32x4){PKW(pB0, 0), PKW(pB0, 2), PKW(pB0, 4), PKW(pB0, 6)}; pw1 = (u32x4){PKW(pB0, 8), PKW(pB0, 10), PKW(pB0, 12), PKW(pB0, 14)}; pw2 = (u32x4){PKW(pB1, 0), PKW(pB1, 2), PKW(pB1, 4), PKW(pB1, 6)}; pw3 = (u32x4){PKW(pB1, 8), PKW(pB1, 10), PKW(pB1, 12), PKW(pB1, 14)};
    SBAR(); pv(o, vb0 + 2 * sl_cur, PAF(0), PAF(1), PAF(2), PAF(3)); pv(o + 2, vb0 + 2 * sl_cur + 8192, PAF(0), PAF(1), PAF(2), PAF(3)); }
  #undef PKW
  #undef PAF
  #undef PIN
  #undef MX3
  #undef GAPA
  #undef GAPB
  #undef EX
  #undef FOFF
  #undef FRD
  #undef FFR
  #undef KRD
  #undef STEP
  #undef ENDW
  { auto rr = __builtin_amdgcn_permlane32_swap(__float_as_uint(l_reg), __float_as_uint(l_reg), false, false); l_reg = __uint_as_float(rr[0]) + __uint_as_float(rr[1]); }
  if (hi == 0) wsf[32 + r32] = l_reg; asm volatile("s_waitcnt lgkmcnt(0)" ::: "memory");
  float rli[16];
  #pragma unroll
  for (int r = 0; r < 16; ++r) rli[r] = __builtin_amdgcn_rcpf(wsf[32 + crow(r, hi)]);
  bf16* Ow = A_.O + (wid * QBLK) * A_.os;
  { bf16* stg = (bf16*)(shm + L8_QO) + wid * 2048;
    #pragma unroll
    for (int hv = 0; hv < 2; ++hv) {
      #pragma unroll
      for (int r = 0; r < 16; ++r) { const int orow = crow(r, hi);
        #pragma unroll
        for (int d0 = 0; d0 < 2; ++d0) stg[orow * 64 + d0 * 32 + r32] = __float2bfloat16(o[2 * hv + d0][r] * rli[r]); }
      asm volatile("s_waitcnt lgkmcnt(0)" ::: "memory");
      #pragma unroll
      for (int i = 0; i < 4; ++i) { const int row = i * 8 + (lane >> 3), ch = lane & 7; const u32x4 v = *(const u32x4*)(stg + row * 64 + ch * 8); *(u32x4*)(Ow + row * A_.os + hv * 64 + ch * 8) = v; }
      asm volatile("s_waitcnt lgkmcnt(0)" ::: "memory"); } }
  asm volatile("s_waitcnt lgkmcnt(0)\n\ts_barrier" ::: "memory");
  #undef DMA_K
  #undef DMA_V
  #undef QLD
  #undef NB
  #undef CMASK
  #undef RESC
  #undef ROT
}
#undef SBAR
#undef WAIT_BAR
}

__device__ __forceinline__ void transpose_item(const float* W, int K, int N, bf16_t* WT, LAS float* scr, int item, int lane, const float* gk = nullptr) {
    const int nblk = N / 32, kb = item / nblk, nb = item % nblk, k0 = 64 * kb, n0 = 32 * nb;
#pragma unroll 8
    for (int i = 0; i < 32; ++i) { const int kk = 2 * i + (lane >> 5); const float gg = gk ? gk[k0 + kk] : 1.f; scr[kk * 33 + (lane & 31)] = W[(size_t)(k0 + kk) * N + n0 + (lane & 31)] * gg; }
    asm volatile("s_waitcnt lgkmcnt(0)" ::: "memory");
    const int c = lane & 7;
#pragma unroll
    for (int j = 0; j < 4; ++j) { const int n = (lane >> 3) + 8 * j; const LAS float* s = scr + (8 * c) * 33 + n;
        u32x4 o; o.x = pk2(s[0 * 33], s[1 * 33]); o.y = pk2(s[2 * 33], s[3 * 33]); o.z = pk2(s[4 * 33], s[5 * 33]); o.w = pk2(s[6 * 33], s[7 * 33]);
        *(u32x4*)(WT + (size_t)(n0 + n) * K + k0 + 8 * c) = o; }
    asm volatile("s_waitcnt lgkmcnt(0)" ::: "memory");
}
__device__ __forceinline__ void rms_row_bf16(const float* xrow, const float* g, bf16_t* orow, int lane) {
    const f32x4* xr = (const f32x4*)xrow + lane; const f32x4* gr = (const f32x4*)g + lane;
    f32x4 v[4]; float s = 0.f;
#pragma unroll
    for (int j = 0; j < 4; ++j) { v[j] = xr[64 * j]; s += (v[j].x * v[j].x + v[j].y * v[j].y) + (v[j].z * v[j].z + v[j].w * v[j].w); }
    const float rs = rsqrtf(wave_sum(s) * (1.f / DM) + EPS);
    u32x2* o8 = (u32x2*)orow + lane;
#pragma unroll
    for (int j = 0; j < 4; ++j) { const f32x4 gg = gr[64 * j]; u32x2 w; w.x = pk2(v[j].x * rs * gg.x, v[j].y * rs * gg.y); w.y = pk2(v[j].z * rs * gg.z, v[j].w * rs * gg.w); o8[64 * j] = w; }
}
__device__ __forceinline__ void sincos_red(float a, float& s, float& c) {
    const float q = rintf(a * 0.636619772367581f); const int iq = (int)q;
    float r = fmaf(q, -1.5703125f, a); r = fmaf(q, -4.837512969970703125e-4f, r); r = fmaf(q, -7.54978995489188216e-8f, r);
    const float r2 = r * r;
    const float sp = r + r * r2 * (-1.6666654611e-1f + r2 * (8.3321608736e-3f + r2 * (-1.9515295891e-4f)));
    const float cp = 1.0f - 0.5f * r2 + r2 * r2 * (4.166664568298827e-2f + r2 * (-1.388731625493765e-3f + r2 * 2.443315711809948e-5f));
    const int k = iq & 3;
    s = (k == 0) ? sp : (k == 1) ? cp : (k == 2) ? -sp : -cp;
    c = (k == 0) ? cp : (k == 1) ? -sp : (k == 2) ? -cp : sp;
}

#define XB_TMO      128
#define XB_XCNT(j)  (256  + 64 * (j))
#define XB_XSUB(j)  (1280 + 64 * (j))
#define XB_XGEN(j)  (2304 + 64 * (j))
#define XB_TOP      3328
#define XB_TOPGEN   3392
#define XCD_BAR_WORDS 3456
#define XB_SPIN_CAP (1u << 18)

__device__ __forceinline__ unsigned xb_ld(unsigned* p)              { return __hip_atomic_load(p, __ATOMIC_RELAXED, __HIP_MEMORY_SCOPE_AGENT); }
__device__ __forceinline__ unsigned xb_add(unsigned* p, unsigned v) { return __hip_atomic_fetch_add(p, v, __ATOMIC_RELAXED, __HIP_MEMORY_SCOPE_AGENT); }
__device__ __forceinline__ unsigned xb_xcc_id() { return (unsigned)__builtin_amdgcn_s_getreg((3 << 11) | 20) & 0xFu; }
#define XB_SPIN(cond, bar) do { unsigned _sp = 0; while (cond) { __builtin_amdgcn_s_sleep(1); \
    if ((++_sp & 255u) == 0u) { if (xb_ld(&(bar)[XB_TMO])) break; if (_sp > XB_SPIN_CAP) { atomicAdd(&(bar)[XB_TMO], 1u); break; } } } } while (0)

struct XcdBarrier {
    unsigned* bar; unsigned x;
    volatile LAS unsigned* st;
};

__device__ __forceinline__ XcdBarrier xcd_barrier_post(unsigned* bar, volatile LAS unsigned* st) {
    XcdBarrier b; b.bar = bar; b.x = xb_xcc_id(); b.st = st;
    if (threadIdx.x == 0) (void)xb_add(&bar[XB_XCNT(b.x)], 1u);
    return b;
}
__device__ __forceinline__ void xcd_barrier_complete(unsigned* bar, unsigned x, unsigned& nloc, unsigned& nx) {
    const unsigned G = gridDim.x * gridDim.y * gridDim.z;
    unsigned sum, cnt, mine, sp = 0u;
    for (;;) {
        sum = 0u; cnt = 0u; mine = 0u;
#pragma unroll
        for (unsigned j = 0; j < 16; ++j) { const unsigned c = xb_ld(&bar[XB_XCNT(j)]); sum += c; cnt += (c > 0u) ? 1u : 0u; mine = (j == x) ? c : mine; }
        if (sum == G) break;
        __builtin_amdgcn_s_sleep(1);
        if ((++sp & 255u) == 0u) { if (xb_ld(&bar[XB_TMO])) break; if (sp > XB_SPIN_CAP) { atomicAdd(&bar[XB_TMO], 1u); break; } }
    }
    nloc = mine > 0u ? mine : 1u; nx = cnt > 0u ? cnt : 1u;
}

__device__ __forceinline__ void xcd_barrier(const XcdBarrier& b) {
    asm volatile("s_waitcnt vmcnt(0)" ::: "memory");
    __syncthreads();
    if (threadIdx.x == 0) {
        unsigned* bar = b.bar;
        __builtin_amdgcn_s_waitcnt(0);
        unsigned nloc = b.st[0], nx = b.st[1];
        if (nloc == 0u) { xcd_barrier_complete(bar, b.x, nloc, nx); b.st[0] = nloc; b.st[1] = nx; }
        const unsigned old = xb_add(&bar[XB_XSUB(b.x)], 1u);
        const unsigned gen = old / nloc;
        if (old + 1u == (gen + 1u) * nloc) {
            __builtin_amdgcn_fence(__ATOMIC_RELEASE, "agent");
            asm volatile("s_waitcnt vmcnt(0)" ::: "memory");
            const unsigned og = xb_add(&bar[XB_TOP], 1u);
            const unsigned tg = og / nx;
            if (og + 1u == (tg + 1u) * nx) xb_add(&bar[XB_TOPGEN], 1u);
            else XB_SPIN(xb_ld(&bar[XB_TOPGEN]) == tg, bar);
            __builtin_amdgcn_fence(__ATOMIC_ACQUIRE, "agent");
            xb_add(&bar[XB_XGEN(b.x)], 1u);
            asm volatile("s_waitcnt vmcnt(0)" ::: "memory");
        } else {
            XB_SPIN(xb_ld(&bar[XB_XGEN(b.x)]) == gen, bar);
            __builtin_amdgcn_fence(__ATOMIC_ACQUIRE, "agent");
            asm volatile("s_waitcnt vmcnt(0)" ::: "memory");
        }
    }
    __syncthreads();
}


struct Args { const float* in[14]; float* out; unsigned char* ws; };

__global__ void __launch_bounds__(512) mk_fwd(Args args) {
    extern __shared__ __attribute__((aligned(16))) unsigned char lds[];
    cg::grid_group grid = cg::this_grid();
    const int tid0 = threadIdx.x, wave = __builtin_amdgcn_readfirstlane(tid0 >> 6);
#define FRESH_LANE() int tid = tid0; asm volatile("" : "+v"(tid)); const int lane = tid & 63
    const int G = gridDim.x, bx = blockIdx.x;
    const int vcu = (G % 8 == 0) ? (bx % 8) * (G / 8) + bx / 8 : bx;
    const int gw = vcu * 8 + wave, NGW = G * 8;
    LAS unsigned char* ldsl = (LAS unsigned char*)lds;
    if (tid0 < 8) ((LAS unsigned*)(ldsl + MISC_OFF))[tid0] = 0u;
    __syncthreads();
    const XcdBarrier xbar = xcd_barrier_post((unsigned*)(args.ws + WS_BAR), (volatile LAS unsigned*)(ldsl + MISC_OFF));
#define ws (args.ws)
#define x_in (args.in[0])
#define norm_mix (args.in[1])
#define w_in (args.in[2])
#define b_gate (args.in[3])
#define diff_lambda (args.in[4])
#define diff_subln (args.in[5])
#define na_rpb (args.in[6])
#define qk_norm (args.in[7])
#define w_branch (args.in[8])
#define w_out (args.in[9])
#define norm_ffn (args.in[10])
#define w_ff1 (args.in[11])
#define w_ff2 (args.in[12])
#define norm_final (args.in[13])
#define xout (args.out)
#define WinT ((bf16_t*)(ws + WS_WIN))
#define WbrT ((bf16_t*)(ws + WS_WBR))
#define WoutT ((bf16_t*)(ws + WS_WOUT))
#define W1T ((bf16_t*)(ws + WS_W1))
#define W2T ((bf16_t*)(ws + WS_W2))
#define STAT ((float*)(ws + WS_STAT))
#define H ((bf16_t*)(ws + WS_H))
#define ATMP ((bf16_t*)(ws + WS_ATMP))
#define BTMP ((bf16_t*)(ws + WS_BTMP))
#define Y ((bf16_t*)(ws + WS_Y))
#define MERGED ((bf16_t*)(ws + WS_MERGED))
#define Z ((bf16_t*)(ws + WS_Z))
#define U ((bf16_t*)(ws + WS_Z))
#define PROJ ((bf16_t*)(ws + WS_PROJ))
#define XB ((bf16_t*)(ws + WS_XB))
#define SSQM ((float*)(ws + WS_SSQM))
#define SSQF ((float*)(ws + WS_SSQF))
#define NRMQ ((unsigned*)(ws + WS_NRM))
#define NRMK ((unsigned*)(ws + WS_NRM) + 1024)

    {
        FRESH_LANE();
        LAS float* scr = (LAS float*)(ldsl + wave * 16384);
        constexpr int I_IN = (DM / 64) * (INW / 32), I_BR = (512 / 64) * (DM / 32), I_OUT = (DM / 64) * (DM / 32), I_1 = (DM / 64) * (DFF / 32), I_2 = (DFF / 64) * (DM / 32);
        constexpr int NITEMS = 2 * I_IN + 8 * I_BR + 2 * I_OUT + 2 * I_1 + 2 * I_2;
        for (int it = gw; it < NITEMS; it += NGW) {
            int r = it;
            if (r < 2 * I_IN) { const int l = r / I_IN; transpose_item(w_in + (size_t)l * DM * INW, DM, INW, WinT + (size_t)l * INW * DM, scr, r % I_IN, lane, norm_mix + l * DM); continue; } r -= 2 * I_IN;
            if (r < 8 * I_BR) { const int ln = r / I_BR; transpose_item(w_branch + (size_t)ln * 512 * DM, 512, DM, WbrT + (size_t)ln * DM * 512, scr, r % I_BR, lane); continue; } r -= 8 * I_BR;
            if (r < 2 * I_OUT) { const int l = r / I_OUT; transpose_item(w_out + (size_t)l * DM * DM, DM, DM, WoutT + (size_t)l * DM * DM, scr, r % I_OUT, lane); continue; } r -= 2 * I_OUT;
            if (r < 2 * I_1) { const int l = r / I_1; transpose_item(w_ff1 + (size_t)l * DM * DFF, DM, DFF, W1T + (size_t)l * DFF * DM, scr, r % I_1, lane, norm_ffn + l * DM); continue; } r -= 2 * I_1;
            { const int l = r / I_2; transpose_item(w_ff2 + (size_t)l * DFF * DM, DFF, DM, W2T + (size_t)l * DM * DFF, scr, r % I_2, lane); }
        }
        {
            f32x4 v[4], vn[4] = {};
            if (gw < NTOK) { const f32x4* xr = (const f32x4*)(x_in + (size_t)gw * DM) + lane;
#pragma unroll
                for (int j = 0; j < 4; ++j) v[j] = xr[64 * j]; }
            for (int m = gw; m < NTOK; m += NGW) {
                if (m + NGW < NTOK) { const f32x4* xr = (const f32x4*)(x_in + (size_t)(m + NGW) * DM) + lane;
#pragma unroll
                    for (int j = 0; j < 4; ++j) vn[j] = xr[64 * j]; }
                u32x2* o8 = (u32x2*)(XB + (size_t)m * DM) + lane; float sq = 0.f;
#pragma unroll
                for (int j = 0; j < 4; ++j) { sq += (v[j].x * v[j].x + v[j].y * v[j].y) + (v[j].z * v[j].z + v[j].w * v[j].w); u32x2 w; w.x = pk2(v[j].x, v[j].y); w.y = pk2(v[j].z, v[j].w); o8[64 * j] = w; }
                sq = wave_sum(sq);
                if (lane == 0) *(f32x4*)(SSQM + (size_t)m * 4) = (f32x4){sq, 0.f, 0.f, 0.f};
#pragma unroll
                for (int j = 0; j < 4; ++j) v[j] = vn[j];
            }
        }
    }
    grid.sync();

    for (int l = 0; l < DEPTH; ++l) {
        { FRESH_LANE(); LAS float* tab = (LAS float*)(ldsl + TAB_OFF); for (int i = tid; i < 8 * 465; i += 512) tab[i] = na_rpb[l * 8 * 465 + i] * LOG2E; }
        __syncthreads();
        for (int grp = 0; grp < NGRP; ++grp) {
            const size_t tok0 = (size_t)grp * TG;
            const float* xsrc = (l == 0) ? x_in : xout;
            {
                pg8::Gemm g{XB + tok0 * DM, WinT + (size_t)l * INW * DM, DM, DM, DM, 1 << 30, 0}; pg8::StaticOrder S; S.init(TG, INW, G, bx);
                if (bx == 0) { FRESH_LANE(); NRMQ[tid] = 0u; NRMQ[tid + 512] = 0u; if (tid < 16) NRMQ[1024 + tid] = 0u; (void)lane; }
                pg8::Epi<0> E{PROJ, nullptr, nullptr, b_gate + l * 4096, INW, SSQM + tok0 * 4, nullptr, nullptr, nullptr};
                pg8::gemm_phase(ldsl, g, S, E);
            }
            xcd_barrier(xbar);
            {
                FRESH_LANE();
                const float inv = exp2f(-(float)(lane & 15) * 0.8304820237218406f);
                const float gq = qk_norm[l * 128 + lane], gk = qk_norm[l * 128 + 64 + lane];
                const int per = (TG + NGW - 1) / NGW;
                float mq = 0.f, mk = 0.f; int cu = -1;
                u32x4 qv, kv, qvn = {}, kvn = {}; unsigned short rw[10], rwn[10] = {};
#define P3_LOAD(QV, KV, RW, mm) do { const bf16_t* ar_ = PROJ + (size_t)(mm) * INW; QV = *(const u32x4*)(ar_ + COL_AQ + lane * 8); KV = *(const u32x4*)(ar_ + COL_AK + lane * 8); \
                    _Pragma("unroll") for (int hd = 0; hd < 10; ++hd) RW[hd] = ar_[COL_DQ + hd * 64 + lane]; } while (0)
                if (gw * per < TG) P3_LOAD(qv, kv, rw, gw * per);
                for (int i = 0; i < per; ++i) {
                    const int m = gw * per + i; if (m >= TG) break;
                    if (i + 1 < per && m + 1 < TG) P3_LOAD(qvn, kvn, rwn, m + 1);
                    if ((m >> 8) != cu) { if (cu >= 0 && (lane & 7) == 0) { atomicMax(NRMQ + cu * 8 + (lane >> 3), __float_as_uint(mq)); atomicMax(NRMK + (cu >> 5) * 8 + (lane >> 3), __float_as_uint(mk)); } cu = m >> 8; mq = 0.f; mk = 0.f; }
                    const int s = (int)((tok0 + m) % SEQ); const float pos = (float)((lane < 32) ? (s >> 6) : (s & 63));
                    float sn, cs; sincos_red(pos * inv, sn, cs);
                    { float nq = 0.f, nk = 0.f;
#pragma unroll
                      for (int e = 0; e < 4; ++e) { nq += bflo(qv[e]) * bflo(qv[e]) + bfhi(qv[e]) * bfhi(qv[e]); nk += bflo(kv[e]) * bflo(kv[e]) + bfhi(kv[e]) * bfhi(kv[e]); }
                      nq += __shfl_xor(nq, 1); nk += __shfl_xor(nk, 1); nq += __shfl_xor(nq, 2); nk += __shfl_xor(nk, 2); nq += __shfl_xor(nq, 4); nk += __shfl_xor(nk, 4);
                      mq = fmaxf(mq, sqrtf(nq)); mk = fmaxf(mk, sqrtf(nk)); }
                    bf16_t* row = PROJ + (size_t)m * INW + COL_DQ;
#pragma unroll
                    for (int hd = 0; hd < 10; ++hd) {
                        const float v = __uint_as_float((unsigned)rw[hd] << 16);
                        const float rn = rsqrtf(wave_sum(v * v) * (1.f / 64.f) + EPS);
                        const float y = v * rn * (hd < 8 ? gq : gk);
                        const float p = __shfl_xor(y, 16);
                        float o = ((lane >> 4) & 1) ? (y * cs + p * sn) : (y * cs - p * sn);
                        if (hd < 8) o *= C2;
                        row[hd * 64 + lane] = (bf16_t)f2bf(o);
                    }
                    qv = qvn; kv = kvn;
#pragma unroll
                    for (int hd = 0; hd < 10; ++hd) rw[hd] = rwn[hd];
                }
#undef P3_LOAD
                if (cu >= 0 && (lane & 7) == 0) { atomicMax(NRMQ + cu * 8 + (lane >> 3), __float_as_uint(mq)); atomicMax(NRMK + (cu >> 5) * 8 + (lane >> 3), __float_as_uint(mk)); }
            }
            xcd_barrier(xbar);
            {
                using namespace attn_body;
                char* shm = (char*)lds;
                {
                    unsigned* qctr = (unsigned*)(ws + WS_BAR) + 3584 + (l * NGRP + grp) * 8;
                    volatile LAS unsigned* slot = (volatile LAS unsigned*)(ldsl + MISC_OFF + 32);
                    const int myx = (G % 8 == 0) ? (vcu / (G / 8)) : 0;
                    int qq = 0;
                    for (;;) {
                        if (tid0 == 0) { int fj = -1, fx = 0;
                            for (; qq < 8; ++qq) { const int x_ = (myx + qq) & 7; const int j_ = (int)atomicAdd(qctr + x_, 1u); if (j_ < 288) { fj = j_; fx = x_; break; } }
                            slot[0] = (unsigned)fj; slot[1] = (unsigned)fx; }
                        __syncthreads();
                        const int j = (int)slot[0], sx = (int)slot[1];
                        __syncthreads();
                        if (j < 0) break;
                        if (j < 128) {
                            AttnArgs a{}; a.qs = INW; a.ks = INW; a.NT = 128; a.tlo = 0; a.thi = 127;
                            if (j >= 32 && j < 96) { const int qb = j & 31, ds = 2 * sx + ((j - 32) >> 5), bb = ds >> 3, h = ds & 7; const size_t tb = (size_t)bb * SEQ;
                                a.Q = (const bf16*)(PROJ + (tb + qb * 256) * INW + COL_DQ + h * 64); a.K = (const bf16*)(PROJ + tb * INW + COL_DK + (h >> 2) * 64);
                                a.V = (const bf16*)(PROJ + tb * INW + COL_DV + (h >> 2) * 64); a.O = (bf16*)(Y + (tb + qb * 256) * 2048 + 1536 + h * 64); a.os = 2048;
                                attn_unit<MD, 16>(a, shm);
                            } else {
                                int bb, hh, comp, qb;
                                if (j < 32) { bb = sx >> 2; hh = 2 + ((sx >> 1) & 1); comp = sx & 1; qb = j; }
                                else { const int s1 = sx >> 1; bb = s1 >> 1; comp = s1 & 1; hh = (j < 112) ? 1 : 0; qb = (sx & 1) * 16 + ((j - 96) & 15); }
                                const size_t tb = (size_t)bb * SEQ;
                                a.Q = (const bf16*)(PROJ + (tb + qb * 256) * INW + COL_AQ + hh * 128 + comp * 64); a.K = (const bf16*)(PROJ + tb * INW + COL_AK + hh * 128 + comp * 64);
                                a.V = (const bf16*)(PROJ + tb * INW + COL_AV + hh * 128); a.O = (bf16*)(ATMP + (tb + qb * 256) * 1024 + (hh * 2 + comp) * 128); a.os = 1024;
                                a.s2 = exp2f(-2.f * (float)(hh + 1)) * LOG2E;
                                const float Bs = __uint_as_float(NRMQ[(bb * 32 + qb) * 8 + hh * 2 + comp]) * __uint_as_float(NRMK[bb * 8 + hh * 2 + comp]) * 1.02f + 0.25f;
                                const float dlim = fminf((150.f + 2.f * Bs) / a.s2, 1.0e6f), q0f = (float)(qb * 256);
                                int tlo = max(0, (int)floorf((q0f - 63.f - dlim) * (1.f / 64.f))), thi = min(127, (int)ceilf((q0f + 255.f + dlim) * (1.f / 64.f)));
                                if (((thi - tlo + 1) & 1) != 0) { if (tlo > 0) --tlo; else ++thi; }
                                tlo = __builtin_amdgcn_readfirstlane(tlo); thi = __builtin_amdgcn_readfirstlane(thi);
                                a.K += (size_t)tlo * 64 * INW; a.V += (size_t)tlo * 64 * INW; a.q0 = qb * 256 - 64 * tlo; a.NT = thi - tlo + 1;
                                attn_unit128<16>(a, shm);
                            }
                        } else if (j < 192) {
                            const int cs = 2 * sx + ((j - 128) >> 5), qb = (j - 128) & 31, bb = cs >> 3, h = cs & 7, r0 = 4 * qb, kb = min(max(r0 - 4, 0), 116); const size_t tb = (size_t)bb * SEQ;
                            AttnArgs a{}; a.qs = INW; a.ks = INW; a.os = 2048; a.NT = 12; a.tlo = 0; a.thi = 11; a.q0 = r0; a.kb = kb;
                            a.Q = (const bf16*)(PROJ + (tb + r0 * 64) * INW + COL_CQ + h * 64); a.K = (const bf16*)(PROJ + (tb + kb * 64) * INW + COL_CK + h * 64);
                            a.V = (const bf16*)(PROJ + (tb + kb * 64) * INW + COL_CV + h * 64); a.O = (bf16*)(Y + (tb + r0 * 64) * 2048 + 1024 + h * 64);
                            a.tab = (lds_fptr)((lds_cptr)shm + TAB_OFF) + h * 465;
                            attn_unit<MC, 8>(a, shm);
                        } else {
                            const int p = j - 192, sg = 6 * sx + (p >> 4);
                            for (int e = 0; e < 2; ++e) {
                                const int blk = 2 * (p & 15) + e, bb = sg / 24, k = sg % 24, gp = k >> 3, h = k & 7, dsh = 2 * gp, dil = 1 << dsh;
                                const int nblk = 32 >> dsh, res = blk / nblk, i0 = (blk % nblk) * 256, L = SEQ >> dsh;
                                const long tq = (long)bb * SEQ + res + (long)i0 * dil, tk = (long)bb * SEQ + res + (long)(i0 - 64) * dil;
                                AttnArgs a{}; a.qs = dil * INW; a.ks = dil * INW; a.os = dil * 1536; a.NT = 6; a.tlo = (i0 == 0) ? 1 : 0; a.thi = (i0 + 256 == L) ? 4 : 5;
                                const int cq = COL_B + gp * 1536 + h * 64;
                                a.Q = (const bf16*)(PROJ + tq * INW + cq); a.K = (const bf16*)(PROJ + tk * INW + cq + 512); a.V = (const bf16*)(PROJ + tk * INW + cq + 1024);
                                a.O = (bf16*)(BTMP + tq * 1536 + gp * 512 + h * 64);
                                a.s2 = exp2f(-(float)(h + 1)) * (float)dil * LOG2E; a.stat = STAT + (tq * 24 + gp * 8 + h) * 2; a.ss = dil * 48;
                                attn_unit<MB, 8>(a, shm);
                            }
                        }
                    }
                }
            }
            xcd_barrier(xbar);
            {
                FRESH_LANE();
                int l_ = l; asm volatile("" : "+s"(l_));
                const float lam_init = (l_ == 0) ? 0.2f : (0.8f - 0.6f * 0.7408182206817179f);
                float lam;
                { const float* lp = diff_lambda + l * 256; const float a = lp[lane] * lp[64 + lane], b = lp[128 + lane] * lp[192 + lane]; lam = expf(wave_sum(a)) - expf(wave_sum(b)) + lam_init; lam = __uint_as_float(__builtin_amdgcn_readfirstlane(__float_as_uint(lam))); }
                const float out_scale = 1.f - lam_init;
                const float g0 = diff_subln[l * 128 + 2 * lane], g1 = diff_subln[l * 128 + 2 * lane + 1];
                const int h = lane >> 3, d8 = (lane & 7) * 8;
                unsigned aw[8]; u32x4 bw[3]; float sv[6];
#define P5_LOAD(AW, BW, SV, mm) do { const unsigned* at_ = (const unsigned*)(ATMP + (size_t)(mm) * 1024); _Pragma("unroll") for (int q = 0; q < 8; ++q) AW[q] = at_[q * 64 + lane]; \
                    const bf16_t* bt_ = BTMP + (size_t)(mm) * 1536 + h * 64 + d8; _Pragma("unroll") for (int g = 0; g < 3; ++g) BW[g] = *(const u32x4*)(bt_ + g * 512); \
                    const float* st_ = STAT + (size_t)(mm) * 48 + h * 2; _Pragma("unroll") for (int g = 0; g < 3; ++g) { SV[2 * g] = st_[16 * g]; SV[2 * g + 1] = st_[16 * g + 1]; } } while (0)
                for (int m = gw; m < TG; m += NGW) {
                    P5_LOAD(aw, bw, sv, m);
                    unsigned* yr = (unsigned*)(Y + (size_t)m * 2048);
#pragma unroll
                    for (int hh = 0; hh < 4; ++hh) {
                        const unsigned w0 = aw[hh * 2], w1 = aw[hh * 2 + 1];
                        const float d0 = bflo(w0) - lam * bflo(w1), d1 = bfhi(w0) - lam * bfhi(w1);
                        const float rn = rsqrtf(wave_sum(d0 * d0 + d1 * d1) * (1.f / 128.f) + EPS) * out_scale;
                        yr[hh * 64 + lane] = pk2(d0 * rn * g0, d1 * rn * g1);
                    }
                    const float m0 = sv[0], l0 = sv[1], m1 = sv[2], l1 = sv[3], m2 = sv[4], l2 = sv[5];
                    const float ms = fmaxf(m0, fmaxf(m1, m2));
                    const float w0 = l0 * exp2f(m0 - ms), w1 = l1 * exp2f(m1 - ms), w2 = l2 * exp2f(m2 - ms); const float inv = 1.f / (w0 + w1 + w2);
                    const u32x4 a0 = bw[0], a1 = bw[1], a2 = bw[2];
                    u32x4 o;
#pragma unroll
                    for (int e = 0; e < 4; ++e) { const float lo = (w0 * bflo(a0[e]) + w1 * bflo(a1[e]) + w2 * bflo(a2[e])) * inv, hi = (w0 * bfhi(a0[e]) + w1 * bfhi(a1[e]) + w2 * bfhi(a2[e])) * inv; o[e] = pk2(lo, hi); }
                    *(u32x4*)(Y + (size_t)m * 2048 + 512 + h * 64 + d8) = o;
                }
#undef P5_LOAD
            }
            xcd_barrier(xbar);
            {
                pg8::Gemm g{Y, WbrT + (size_t)l * 4096 * 512, 2048, 512, 512, 4, 512}; pg8::StaticOrder S; S.init(TG, 4096, G, bx);
                pg8::Epi<1> E{Z, nullptr, nullptr, nullptr, 4096, nullptr, nullptr, nullptr, nullptr};
                pg8::gemm_phase(ldsl, g, S, E);
            }
            xcd_barrier(xbar);
            { FRESH_LANE();
            u32x4 gv[2][4], zv[2][4];
#define P7_LOAD(GV, ZV, mm) do { const bf16_t* gr_ = PROJ + (size_t)(mm) * INW + COL_GATE + lane * 8; const bf16_t* zr_ = Z + (size_t)(mm) * 4096 + lane * 8; \
                _Pragma("unroll") for (int jj = 0; jj < 2; ++jj) _Pragma("unroll") for (int n = 0; n < 4; ++n) { GV[jj][n] = *(const u32x4*)(gr_ + n * 1024 + jj * 512); ZV[jj][n] = *(const u32x4*)(zr_ + n * 1024 + jj * 512); } } while (0)
            for (int m = gw; m < TG; m += NGW) {
                P7_LOAD(gv, zv, m);
#pragma unroll
                for (int j = 0; j < 2; ++j) { const int c = lane * 8 + j * 512; float acc[8] = {0.f, 0.f, 0.f, 0.f, 0.f, 0.f, 0.f, 0.f};
#pragma unroll
                    for (int n = 0; n < 4; ++n) {
#pragma unroll
                        for (int e = 0; e < 4; ++e) { acc[2 * e] += bflo(gv[j][n][e]) * bflo(zv[j][n][e]); acc[2 * e + 1] += bfhi(gv[j][n][e]) * bfhi(zv[j][n][e]); } }
                    u32x4 o; o.x = pk2(acc[0], acc[1]); o.y = pk2(acc[2], acc[3]); o.z = pk2(acc[4], acc[5]); o.w = pk2(acc[6], acc[7]);
                    *(u32x4*)(MERGED + (size_t)m * DM + c) = o; }
#undef P7_LOAD
            } }
            xcd_barrier(xbar);
            {
                pg8::Gemm g{MERGED, WoutT + (size_t)l * DM * DM, DM, DM, DM, 1 << 30, 0}; pg8::StaticOrder S; S.init(TG, DM, G, bx);
                pg8::Epi<3> E{nullptr, xout + tok0 * DM, xsrc + tok0 * DM, nullptr, DM, nullptr, H, SSQF, (LAS float*)(ldsl + SSQ_OFF)};
                pg8::gemm_phase(ldsl, g, S, E);
            }
            xcd_barrier(xbar);
            {
                pg8::Gemm g{H, W1T + (size_t)l * DFF * DM, DM, DM, DM, 1 << 30, 0}; pg8::StaticOrder S; S.init(TG, DFF, G, bx);
                pg8::Epi<2> E{U, nullptr, nullptr, nullptr, DFF, SSQF, nullptr, nullptr, nullptr};
                pg8::gemm_phase(ldsl, g, S, E);
            }
            xcd_barrier(xbar);
            {
                pg8::Gemm g{U, W2T + (size_t)l * DM * DFF, DFF, DFF, DFF, 1 << 30, 0}; pg8::StaticOrder S; S.init(TG, DM, G, bx);
                pg8::Epi<3> E{nullptr, xout + tok0 * DM, xout + tok0 * DM, nullptr, DM, nullptr, XB + tok0 * DM, SSQM + tok0 * 4, (LAS float*)(ldsl + SSQ_OFF)};
                pg8::gemm_phase(ldsl, g, S, E);
            }
            if (l == DEPTH - 1 && grp == NGRP - 1) xcd_barrier(xbar);
        }
    }
    {
        FRESH_LANE();
        const f32x4* g4 = (const f32x4*)norm_final + lane; f32x4 gg[4];
#pragma unroll
        for (int j = 0; j < 4; ++j) gg[j] = g4[64 * j];
        f32x4 v[4], vn[4] = {};
        if (gw < NTOK) { const f32x4* o = (const f32x4*)(xout + (size_t)gw * DM) + lane;
#pragma unroll
            for (int j = 0; j < 4; ++j) v[j] = o[64 * j]; }
        for (int m = gw; m < NTOK; m += NGW) {
            if (m + NGW < NTOK) { const f32x4* on = (const f32x4*)(xout + (size_t)(m + NGW) * DM) + lane;
#pragma unroll
                for (int j = 0; j < 4; ++j) vn[j] = on[64 * j]; }
            f32x4* o = (f32x4*)(xout + (size_t)m * DM) + lane; float sq = 0.f;
#pragma unroll
            for (int j = 0; j < 4; ++j) sq += (v[j].x * v[j].x + v[j].y * v[j].y) + (v[j].z * v[j].z + v[j].w * v[j].w);
            const float r = rsqrtf(wave_sum(sq) * (1.f / DM) + EPS);
#pragma unroll
            for (int j = 0; j < 4; ++j) o[64 * j] = (f32x4){v[j].x * r * gg[j].x, v[j].y * r * gg[j].y, v[j].z * r * gg[j].z, v[j].w * r * gg[j].w};
#pragma unroll
            for (int j = 0; j < 4; ++j) v[j] = vn[j];
        }
    }
}

#undef ws
#undef x_in
#undef norm_mix
#undef w_in
#undef b_gate
#undef diff_lambda
#undef diff_subln
#undef na_rpb
#undef qk_norm
#undef w_branch
#undef w_out
#undef norm_ffn
#undef w_ff1
#undef w_ff2
#undef norm_final
#undef xout
#undef WinT
#undef WbrT
#undef WoutT
#undef W1T
#undef W2T
#undef STAT
#undef H
#undef ATMP
#undef BTMP
#undef Y
#undef MERGED
#undef Z
#undef U
#undef PROJ
#undef NRMQ
#undef XB
#undef SSQM
#undef SSQF
#undef NRMK

extern "C" void kernel_launch(void* const* d_in, const int* in_sizes, int n_in, void* d_out, int out_size, void* d_ws, size_t ws_size, hipStream_t stream) {
    static int grid_blocks = 0;
    if (!grid_blocks) {
        int dev = 0, cus = 0, per_cu = 0;
        (void)hipGetDevice(&dev);
        (void)hipDeviceGetAttribute(&cus, hipDeviceAttributeMultiprocessorCount, dev);
        (void)hipFuncSetAttribute((const void*)mk_fwd, hipFuncAttributeMaxDynamicSharedMemorySize, LDS_BYTES);
        (void)hipOccupancyMaxActiveBlocksPerMultiprocessor(&per_cu, (const void*)mk_fwd, 512, LDS_BYTES);
        if (per_cu < 1) per_cu = 1;
        grid_blocks = cus * per_cu;
        if (ws_size < WS_END || n_in != 14) { fprintf(stderr, "kernel_launch: workspace %zu < %zu or n_in %d != 14\n", ws_size, (size_t)WS_END, n_in); grid_blocks = -1; }
    }
    if (grid_blocks < 0) return;
    (void)hipMemsetAsync((char*)d_ws + WS_BAR, 0, 16384, stream);
    Args a{};
    for (int i = 0; i < 14; ++i) a.in[i] = (const float*)d_in[i];
    a.out = (float*)d_out; a.ws = (unsigned char*)d_ws;
    void* kargs[] = {&a};
    hipError_t e = hipLaunchCooperativeKernel((const void*)mk_fwd, dim3(grid_blocks), dim3(512), kargs, LDS_BYTES, stream);
    if (e != hipSuccess) fprintf(stderr, "cooperative launch failed: %s (grid %d)\n", hipGetErrorString(e), grid_blocks);
}
```

```cpp
#include <hip/hip_runtime.h>
#include <hip/hip_cooperative_groups.h>
#include <hip/hip_bf16.h>
#include <cstdio>
#include <cstdint>
#include <cmath>
namespace cg = cooperative_groups;

constexpr int BATCH = 8, SEQ = 8192, DM = 1024, NTOK = BATCH * SEQ, INW = 12544, DFF = 4096, DEPTH = 2;
constexpr int GB = 2, TG = GB * SEQ, NGRP = BATCH / GB;
constexpr float EPS = 1e-6f;
constexpr float LOG2E = 1.4426950408889634f;
constexpr float C2 = 0.125f * LOG2E;
constexpr int COL_AQ = 0, COL_AK = 512, COL_AV = 1024, COL_B = 1536, COL_CQ = 6144, COL_CK = 6656, COL_CV = 7168, COL_DQ = 7680, COL_DK = 8192, COL_DV = 8320, COL_GATE = 8448;
constexpr size_t MiB = 1u << 20;
constexpr size_t WS_WIN = 0, WS_WBR = 49 * MiB, WS_WOUT = 57 * MiB, WS_W1 = 61 * MiB, WS_W2 = 77 * MiB, WS_STAT = 93 * MiB, WS_H = 96 * MiB, WS_ATMP = 128 * MiB,
                 WS_BTMP = 160 * MiB, WS_Y = 208 * MiB, WS_MERGED = 272 * MiB, WS_Z = 304 * MiB, WS_PROJ = 432 * MiB, WS_NRM = 824 * MiB, WS_BAR = 824 * MiB + 512 * 1024, WS_SSQM = 825 * MiB, WS_SSQF = 826 * MiB, WS_XB = 827 * MiB, WS_END = 955 * MiB;
constexpr int LDS_BYTES = 151552, TAB_OFF = 131072, MISC_OFF = 147072, SSQ_OFF = 147456;

#define LAS __attribute__((address_space(3)))
typedef unsigned short bf16_t;
typedef short bf16x8 __attribute__((ext_vector_type(8)));
typedef float f32x4 __attribute__((ext_vector_type(4)));
typedef unsigned u32x4 __attribute__((ext_vector_type(4)));
typedef unsigned u32x2 __attribute__((ext_vector_type(2)));

__device__ __forceinline__ unsigned f2bf(float f) { unsigned u = __builtin_bit_cast(unsigned, f); return (u + 0x7fffu + ((u >> 16) & 1u)) >> 16; }
__device__ __forceinline__ unsigned pk2(float lo, float hi) { return f2bf(lo) | (f2bf(hi) << 16); }
__device__ __forceinline__ float bflo(unsigned w) { return __uint_as_float(w << 16); }
__device__ __forceinline__ float bfhi(unsigned w) { return __uint_as_float(w & 0xffff0000u); }
__device__ __forceinline__ float wave_sum(float v) {
#pragma unroll
    for (int o = 1; o < 64; o <<= 1) v += __shfl_xor(v, o);
    return v;
}

namespace pg8 {
constexpr int BM = 256, BK = 64, HALF = 128, HTB = HALF * BK * 2, STAGE_BYTES = 8 * HTB, NXCD = 8, WGM = 4;
__host__ __device__ __forceinline__ int lds_byte(int r, int c) { const int st = (r >> 4) * 2 + (c >> 5), rr = r & 15, cc = c & 31, ob = rr * 64 + cc * 2; return st * 1024 + (ob ^ (((ob >> 9) & 1) << 5)); }
__host__ __device__ __forceinline__ void stage_rc(int b, int& R, int& C) { const int st = b / 1024, sb = b % 1024, swz = sb ^ (((sb >> 9) & 1) << 5); R = (st >> 1) * 16 + swz / 64; C = (st & 1) * 32 + (swz % 64) / 2; }
__host__ __device__ __forceinline__ int perm32(int rho) { const int n = rho >> 4, i = rho & 15; return 8 * (i >> 2) + 4 * n + (i & 3); }

struct Unit { int pm, pn; };
struct Gemm { const bf16_t* A; const bf16_t* Bt; int lda, ldb, K, adiv, astride; };

struct StaticOrder {
    int nM, nN, nwg, G, c;
    __device__ void init(int M, int N, int G_, int c_) { nM = M / BM; nN = N / BM; nwg = nM * nN; G = G_; c = c_; }
    __device__ bool next(int i, Unit& u) const {
        const long L = (long)i * G + c; if (L >= nwg) return false;
        int wgid = (int)L; { const int q = nwg / NXCD, r = nwg % NXCD, xcd = wgid % NXCD, off = wgid / NXCD; wgid = (xcd < r ? xcd * (q + 1) : r * (q + 1) + (xcd - r) * q) + off; }
        const int nig = WGM * nN, gid = wgid / nig, fm = gid * WGM, gsz = (nM - fm) < WGM ? (nM - fm) : WGM;
        u.pm = fm + ((wgid % nig) % gsz); u.pn = (wgid % nig) / gsz; return true;
    }
};

__device__ __forceinline__ unsigned cvt_pk_bf16(float lo, float hi) { unsigned r; asm volatile("v_cvt_pk_bf16_f32 %0, %1, %2" : "=v"(r) : "v"(lo), "v"(hi)); return r; }

template <int MODE> struct Epi {
    bf16_t* O; float* Of; const float* base; const float* bias; int ldc;
    const float* ssq;
    bf16_t* XBo; float* SSQo; LAS float* lx;
    __device__ __forceinline__ void operator()(const f32x4 (&acc)[2][2][4][2], const Unit& u, int wr, int wc, int fr, int fq) const {
        const int row0 = u.pm * BM + wr * 64 + fr, col0 = u.pn * BM + wc * 32 + 8 * fq;
        int kind = 0; float sc = 1.f;
        if (MODE == 0) { const int pn = u.pn; if (pn >= 33) kind = 2; else if (pn < 2 || pn == 6 || pn == 7 || pn == 12 || pn == 13 || pn == 18 || pn == 19 || pn == 24 || pn == 25) sc = C2; }
        float rsv[2][4]; f32x4 bv[2][2];
#pragma unroll
        for (int ai = 0; ai < 2; ++ai)
#pragma unroll
            for (int m = 0; m < 4; ++m) { rsv[ai][m] = 1.f;
                if (MODE == 0 || MODE == 2) { const f32x4 q = *(const f32x4*)(ssq + (size_t)(row0 + ai * HALF + m * 16) * 4); rsv[ai][m] = rsqrtf(((q[0] + q[1]) + (q[2] + q[3])) * (1.f / 1024.f) + EPS); } }
#pragma unroll
        for (int bj = 0; bj < 2; ++bj)
#pragma unroll
            for (int n = 0; n < 2; ++n) { bv[bj][n] = (f32x4){0.f, 0.f, 0.f, 0.f}; if (MODE == 0) { if (kind == 2) bv[bj][n] = *(const f32x4*)(bias + col0 + bj * HALF - COL_GATE + 4 * n); } }
        f32x4 nb[2][2];
        if (MODE == 3) {
#pragma unroll
            for (int bj = 0; bj < 2; ++bj)
#pragma unroll
                for (int n = 0; n < 2; ++n) nb[bj][n] = *(const f32x4*)(base + (size_t)row0 * ldc + col0 + bj * HALF + 4 * n);
        }
#pragma unroll
        for (int ai = 0; ai < 2; ++ai)
#pragma unroll
            for (int m = 0; m < 4; ++m) { const size_t roff = (size_t)(row0 + ai * HALF + m * 16) * ldc; float psq = 0.f; const float rs = rsv[ai][m];
                f32x4 cb[2][2];
                if (MODE == 3) {
#pragma unroll
                    for (int bj = 0; bj < 2; ++bj)
#pragma unroll
                        for (int n = 0; n < 2; ++n) cb[bj][n] = nb[bj][n];
                    const int g1 = ai * 4 + m + 1;
                    if (g1 < 8) { const size_t r1 = (size_t)(row0 + (g1 >> 2) * HALF + (g1 & 3) * 16) * ldc;
#pragma unroll
                        for (int bj = 0; bj < 2; ++bj)
#pragma unroll
                            for (int n = 0; n < 2; ++n) nb[bj][n] = *(const f32x4*)(base + r1 + col0 + bj * HALF + 4 * n); }
                }
#pragma unroll
                for (int bj = 0; bj < 2; ++bj) { const int col = col0 + bj * HALF; f32x4 v0 = acc[ai][bj][m][0], v1 = acc[ai][bj][m][1];
                    if (MODE == 3) {
                        v0 = cb[bj][0] + v0; v1 = cb[bj][1] + v1;
                        *(f32x4*)(Of + roff + col) = v0; *(f32x4*)(Of + roff + col + 4) = v1;
                        psq += (v0[0] * v0[0] + v0[1] * v0[1]) + (v0[2] * v0[2] + v0[3] * v0[3]) + (v1[0] * v1[0] + v1[1] * v1[1]) + (v1[2] * v1[2] + v1[3] * v1[3]);
                        u32x4 w; w.x = cvt_pk_bf16(v0[0], v0[1]); w.y = cvt_pk_bf16(v0[2], v0[3]); w.z = cvt_pk_bf16(v1[0], v1[1]); w.w = cvt_pk_bf16(v1[2], v1[3]);
                        *(u32x4*)(XBo + roff + col) = w;
                    } else {
                        if (MODE == 0 || MODE == 2) { v0 = v0 * rs; v1 = v1 * rs; }
                        if (MODE == 0) {
                            if (kind == 2) {
#pragma unroll
                                for (int e = 0; e < 4; ++e) { v0[e] = 1.f / (1.f + __expf(-(v0[e] + bv[bj][0][e]))); v1[e] = 1.f / (1.f + __expf(-(v1[e] + bv[bj][1][e]))); } }
                            else { v0 = v0 * sc; v1 = v1 * sc; }
                        }
                        if (MODE == 2) {
#pragma unroll
                            for (int e = 0; e < 4; ++e) { const float a = fmaxf(v0[e], 0.f), b = fmaxf(v1[e], 0.f); v0[e] = a * a; v1[e] = b * b; } }
                        u32x4 w; w.x = cvt_pk_bf16(v0[0], v0[1]); w.y = cvt_pk_bf16(v0[2], v0[3]); w.z = cvt_pk_bf16(v1[0], v1[1]); w.w = cvt_pk_bf16(v1[2], v1[3]);
                        *(u32x4*)(O + roff + col) = w;
                    } }
                if (MODE == 3) { psq += __shfl_xor(psq, 16); psq += __shfl_xor(psq, 32); if (fq == 0) lx[(ai * HALF + wr * 64 + m * 16 + fr) * 4 + wc] = psq; }
            }
        if (MODE == 3) {
            asm volatile("s_waitcnt lgkmcnt(0)" ::: "memory"); __builtin_amdgcn_s_barrier(); asm volatile("" ::: "memory");
            const int t = threadIdx.x;
            if (t < 256) { const f32x4 q = *(const LAS f32x4*)(lx + t * 4); SSQo[(size_t)(u.pm * BM + t) * 4 + u.pn] = (q[0] + q[1]) + (q[2] + q[3]); }
        }
    }
};

template <class EpiT>
__device__ __forceinline__ void gemm_phase(LAS unsigned char* lds, const Gemm g, const StaticOrder& S, const EpiT& E) {
    int tid_ = threadIdx.x; asm volatile("" : "+v"(tid_));
    const int tid = tid_, wid = __builtin_amdgcn_readfirstlane(tid >> 6), lane = tid & 63, wr = wid >> 2, wc = wid & 3, fr = lane & 15, fq = lane >> 4;
    const int K = g.K, nt = K / BK;
    unsigned voffA[2], voffB[2];
#pragma unroll
    for (int i = 0; i < 2; ++i) { int R, C; stage_rc(tid * 16 + i * 8192, R, C); const int Rb = (R & ~31) + perm32(R & 31);
        voffA[i] = (unsigned)(R * g.lda + C) * 2u; voffB[i] = (unsigned)(Rb * g.ldb + C) * 2u; }
    const size_t kstep = (size_t)(BK * 2);
    const size_t hA = (size_t)HALF * g.lda * 2, hB = (size_t)HALF * g.ldb * 2;
    const size_t tA = 2 * hA, tB = 2 * hB;
    const unsigned ldsw = (unsigned)wid * 1024u;
    const int aoff = lds_byte(wr * 64 + fr, fq * 8), boff = lds_byte(wc * 32 + fr, fq * 8);
#define PG8_SA(b, h) (((b) * 2 + (h)) * HTB)
#define PG8_SB(b, h) ((4 + (b) * 2 + (h)) * HTB)
#define PG8_STAGE(bufoff, gbase, voff) do { _Pragma("unroll") for (int _i = 0; _i < 2; ++_i) \
        __builtin_amdgcn_global_load_lds((const unsigned*)((const char*)(gbase) + (voff)[_i]), (LAS unsigned*)(lds + (bufoff) + ldsw + _i * 8192), 16, 0, 0); } while (0)
#define PG8_LDA(dst, b, h) do { _Pragma("unroll") for (int m = 0; m < 4; ++m) _Pragma("unroll") for (int k = 0; k < 2; ++k) dst[m][k] = *(const LAS bf16x8*)(lds + PG8_SA(b, h) + aoff + m * 2048 + k * 1024); } while (0)
#define PG8_LDB(dst, b, h) do { _Pragma("unroll") for (int n = 0; n < 2; ++n) _Pragma("unroll") for (int k = 0; k < 2; ++k) dst[n][k] = *(const LAS bf16x8*)(lds + PG8_SB(b, h) + boff + n * 2048 + k * 1024); } while (0)
#define PG8_MMA(ai, bj, At, Bt) do { __builtin_amdgcn_s_setprio(1); _Pragma("unroll") for (int m = 0; m < 4; ++m) _Pragma("unroll") for (int n = 0; n < 2; ++n) _Pragma("unroll") for (int k = 0; k < 2; ++k) \
        acc[ai][bj][m][n] = __builtin_amdgcn_mfma_f32_16x16x32_bf16(Bt[n][k], At[m][k], acc[ai][bj][m][n], 0, 0, 0); __builtin_amdgcn_s_setprio(0); } while (0)
#define PG8_WAIT_V(n) asm volatile("s_waitcnt vmcnt(" #n ")" ::: "memory")
#define PG8_WAIT_L(n) asm volatile("s_waitcnt lgkmcnt(" #n ")" ::: "memory")
#define PG8_BAR __builtin_amdgcn_s_barrier()
#define PG8_SCHED __builtin_amdgcn_sched_barrier(0)
#define PG8_PA(u) ((const char*)g.A + (size_t)(u).pm * tA + (size_t)((u).pn / g.adiv) * (size_t)g.astride * 2)
#define PG8_PB(u) ((const char*)g.Bt + (size_t)(u).pn * tB)
    Unit cur, nxt; int ui = 0;
    if (!S.next(0, cur)) return;
    f32x4 acc[2][2][4][2];
#pragma unroll
    for (int a = 0; a < 2; ++a)
#pragma unroll
        for (int b = 0; b < 2; ++b)
#pragma unroll
            for (int m = 0; m < 4; ++m)
#pragma unroll
                for (int n = 0; n < 2; ++n) acc[a][b][m][n] = (f32x4){0.f, 0.f, 0.f, 0.f};
    bf16x8 At[4][2], B0[2][2], B1[2][2];
    const char* cA = PG8_PA(cur); const char* cB = PG8_PB(cur);
    PG8_STAGE(PG8_SB(0, 0), cB, voffB); PG8_STAGE(PG8_SB(0, 1), cB + hB, voffB); PG8_STAGE(PG8_SA(0, 0), cA, voffA); PG8_STAGE(PG8_SA(0, 1), cA + hA, voffA);
    if (wr == 1) PG8_BAR;
    PG8_WAIT_V(2); PG8_BAR;
    PG8_STAGE(PG8_SB(1, 0), cB + kstep, voffB); PG8_STAGE(PG8_SA(1, 0), cA + kstep, voffA); PG8_STAGE(PG8_SB(1, 1), cB + hB + kstep, voffB);
    PG8_WAIT_V(6); PG8_BAR;
    for (;;) {
        const bool has_next = S.next(ui + 1, nxt);
        const char* nA = has_next ? PG8_PA(nxt) : cA; const char* nB = has_next ? PG8_PB(nxt) : cB;
        for (int t = 0; t < nt; t += 2) {
            const bool last = (t == nt - 2);
            const char* a1 = cA + (size_t)(t + 1) * kstep;
            const char* a2 = last ? nA : cA + (size_t)(t + 2) * kstep; const char* b2 = last ? nB : cB + (size_t)(t + 2) * kstep;
            const char* a3 = a2 + kstep; const char* b3 = b2 + kstep;
            PG8_LDB(B0, 0, 0); PG8_LDB(B1, 0, 1); PG8_SCHED; PG8_LDA(At, 0, 0); PG8_STAGE(PG8_SA(1, 1), a1 + hA, voffA);
            PG8_WAIT_V(8); PG8_WAIT_L(0); PG8_BAR; PG8_MMA(0, 0, At, B0); PG8_MMA(0, 1, At, B1); PG8_BAR; PG8_SCHED;
            PG8_LDA(At, 0, 1); PG8_STAGE(PG8_SB(0, 0), b2, voffB); PG8_STAGE(PG8_SB(0, 1), b2 + hB, voffB); PG8_STAGE(PG8_SA(0, 0), a2, voffA);
            PG8_WAIT_V(8); PG8_WAIT_L(0); PG8_BAR; PG8_MMA(1, 0, At, B0); PG8_MMA(1, 1, At, B1); PG8_BAR; PG8_SCHED;
            PG8_LDB(B0, 1, 0); PG8_LDB(B1, 1, 1); PG8_SCHED; PG8_LDA(At, 1, 0); PG8_STAGE(PG8_SA(0, 1), a2 + hA, voffA);
            PG8_WAIT_V(8); PG8_WAIT_L(0); PG8_BAR; PG8_MMA(0, 0, At, B0); PG8_MMA(0, 1, At, B1); PG8_BAR; PG8_SCHED;
            PG8_LDA(At, 1, 1); PG8_STAGE(PG8_SB(1, 0), b3, voffB); PG8_STAGE(PG8_SB(1, 1), b3 + hB, voffB); PG8_STAGE(PG8_SA(1, 0), a3, voffA);
            PG8_WAIT_V(8); PG8_WAIT_L(0); PG8_BAR; PG8_MMA(1, 0, At, B0); PG8_MMA(1, 1, At, B1); PG8_BAR; PG8_SCHED;
        }
        if (wr == 0) PG8_BAR;
        E(acc, cur, wr, wc, fr, fq);
        if (!has_next) break;
#pragma unroll
        for (int a = 0; a < 2; ++a)
#pragma unroll
            for (int b = 0; b < 2; ++b)
#pragma unroll
                for (int m = 0; m < 4; ++m)
#pragma unroll
                    for (int n = 0; n < 2; ++n) acc[a][b][m][n] = (f32x4){0.f, 0.f, 0.f, 0.f};
        cur = nxt; cA = nA; cB = nB; ++ui;
        if (wr == 1) PG8_BAR;
    }
    PG8_WAIT_V(0);
    PG8_BAR;
#undef PG8_SA
#undef PG8_SB
#undef PG8_STAGE
#undef PG8_LDA
#undef PG8_LDB
#undef PG8_MMA
#undef PG8_WAIT_V
#undef PG8_WAIT_L
#undef PG8_BAR
#undef PG8_SCHED
#undef PG8_PA
#undef PG8_PB
}
}

namespace attn_body {
using bf16 = __hip_bfloat16;
using s16x4 = __attribute__((ext_vector_type(4))) short;
using f32x16 = __attribute__((ext_vector_type(16))) float;
constexpr int NW = 8, QBLK = 32, QB = QBLK * NW, KVBLK = 64;
constexpr int MA = 0, MB = 1, MC = 2, MD = 3;
__device__ __forceinline__ int crow(int r, int hi) { return (r & 3) + 8 * (r >> 2) + 4 * hi; }
#define SBAR() __builtin_amdgcn_sched_barrier(0)
constexpr int NSLOT = 3, SLOTB = 8192;
constexpr int LDS_K = 0, LDS_V = NSLOT * SLOTB, LDS_WS = 2 * NSLOT * SLOTB, LDS_OST = LDS_WS + NW * 64 * 4, LDS_ATT = LDS_OST + NW * 4096;
typedef __attribute__((address_space(3))) const char* lds_cptr;
typedef __attribute__((address_space(3))) const float* lds_fptr;

struct AttnArgs {
    const bf16* Q; const bf16* K; const bf16* V; bf16* O;
    int qs, ks, os;
    int NT, tlo, thi;
    float s2;
    int q0;
    int kb;
    float* stat; int ss;
    lds_fptr tab;
};

__device__ __forceinline__ void glds16(const void* gsrc, unsigned lds_dst) { unsigned keep;
  asm volatile("s_mov_b32 %0, m0\n\ts_mov_b32 m0, %2\n\ts_nop 0\n\tglobal_load_lds_dwordx4 %1, off\n\ts_mov_b32 m0, %0" : "=&s"(keep) : "v"(gsrc), "s"(lds_dst) : "memory"); }
__device__ __forceinline__ float max3f(float a, float b, float c) { float r; asm("v_max3_f32 %0, %1, %2, %3" : "=v"(r) : "v"(a), "v"(b), "v"(c)); return r; }
__device__ __forceinline__ float max2f(float a, float b) { float r; asm("v_max_f32_e32 %0, %1, %2" : "=v"(r) : "v"(a), "v"(b)); return r; }
__device__ __forceinline__ float fadd_s(float a, float b) { float r; asm("v_add_f32_e32 %0, %1, %2" : "=v"(r) : "v"(a), "v"(b)); return r; }
__device__ __forceinline__ float fsub_s(float a, float b) { float r; asm("v_sub_f32_e32 %0, %1, %2" : "=v"(r) : "v"(a), "v"(b)); return r; }
typedef float f32x2_t __attribute__((ext_vector_type(2))); typedef __bf16 bf16x2_t __attribute__((ext_vector_type(2)));
__device__ __forceinline__ unsigned cvtpk_s(float lo, float hi) { f32x2_t v = {lo, hi}; bf16x2_t b = __builtin_convertvector(v, bf16x2_t); return __builtin_bit_cast(unsigned, b); }
#define WAIT_BAR(N) asm volatile("s_waitcnt vmcnt(" #N ") lgkmcnt(0)\n\ts_barrier" ::: "memory")

__device__ __forceinline__ void qkt(f32x16& p0, f32x16& p1, const char* Kslot, const bf16x8* qr, const f32x16& negm, int r32, int hi) {
  const char* kb = Kslot + hi * 1024 + r32 * 16;
  #pragma unroll
  for (int d0 = 0; d0 < 4; ++d0) {
    const bf16x8 b0 = *reinterpret_cast<const bf16x8*>(kb + d0 * 2048);
    const bf16x8 b1 = *reinterpret_cast<const bf16x8*>(kb + d0 * 2048 + 512);
    if (d0 == 0) { p0 = __builtin_amdgcn_mfma_f32_32x32x16_bf16(b0, qr[0], negm, 0, 0, 0); p1 = __builtin_amdgcn_mfma_f32_32x32x16_bf16(b1, qr[0], negm, 0, 0, 0); }
    else { p0 = __builtin_amdgcn_mfma_f32_32x32x16_bf16(b0, qr[d0], p0, 0, 0, 0); p1 = __builtin_amdgcn_mfma_f32_32x32x16_bf16(b1, qr[d0], p1, 0, 0, 0); } }
}
typedef short v4i16_t __attribute__((ext_vector_type(4)));
__device__ __forceinline__ void kload8(bf16x8* kf, lds_cptr kp) {
  kf[0] = *(const LAS bf16x8*)(kp);        kf[1] = *(const LAS bf16x8*)(kp + 512);
  kf[2] = *(const LAS bf16x8*)(kp + 2048); kf[3] = *(const LAS bf16x8*)(kp + 2560);
  kf[4] = *(const LAS bf16x8*)(kp + 4096); kf[5] = *(const LAS bf16x8*)(kp + 4608);
  kf[6] = *(const LAS bf16x8*)(kp + 6144); kf[7] = *(const LAS bf16x8*)(kp + 6656);
}
__device__ __forceinline__ void kload2(bf16x8* kf, lds_cptr kp, int j) { kf[2 * j] = *(const LAS bf16x8*)(kp + j * 2048); kf[2 * j + 1] = *(const LAS bf16x8*)(kp + j * 2048 + 512); }
__device__ __forceinline__ s16x4 vtr(lds_cptr p) { return __builtin_bit_cast(s16x4, __builtin_amdgcn_ds_read_tr16_b64_v4i16((LAS v4i16_t*)p)); }
__device__ __forceinline__ float rowmax(const f32x16& p0, const f32x16& p1) {
  float a = max3f(p0[0], p0[1], p1[0]), b = max3f(p0[2], p0[3], p1[1]); a = max3f(a, p1[2], p1[3]);
  #pragma unroll
  for (int r = 4; r < 16; r += 4) { a = max3f(a, p0[r], p0[r + 1]); b = max3f(b, p0[r + 2], p0[r + 3]); a = max3f(a, p1[r], p1[r + 1]); b = max3f(b, p1[r + 2], p1[r + 3]); }
  const float m = max2f(a, b);
  auto rr = __builtin_amdgcn_permlane32_swap(__float_as_uint(m), __float_as_uint(m), false, false);
  return max2f(__uint_as_float(rr[0]), __uint_as_float(rr[1]));
}
__device__ __forceinline__ void pv(f32x16* o, int vb, bf16x8 pa0, bf16x8 pa1, bf16x8 pa2, bf16x8 pa3) {
  #pragma unroll
  for (int d0 = 0; d0 < 2; ++d0) { s16x4 lo[4], hi[4];
    #pragma unroll
    for (int ks = 0; ks < 4; ++ks) {
      asm volatile("ds_read_b64_tr_b16 %0,%1 offset:%c2" : "=&v"(lo[ks]) : "v"(vb), "i"(d0 * 4096 + ks * 1024) : "memory");
      asm volatile("ds_read_b64_tr_b16 %0,%1 offset:%c2" : "=&v"(hi[ks]) : "v"(vb), "i"(d0 * 4096 + ks * 1024 + 512) : "memory"); }
    asm volatile("s_waitcnt lgkmcnt(0)" ::: "memory"); SBAR();
    #define PK(k) (bf16x8){lo[k][0], lo[k][1], lo[k][2], lo[k][3], hi[k][0], hi[k][1], hi[k][2], hi[k][3]}
    o[d0] = __builtin_amdgcn_mfma_f32_32x32x16_bf16(pa0, PK(0), o[d0], 0, 0, 0);
    o[d0] = __builtin_amdgcn_mfma_f32_32x32x16_bf16(pa1, PK(1), o[d0], 0, 0, 0);
    o[d0] = __builtin_amdgcn_mfma_f32_32x32x16_bf16(pa2, PK(2), o[d0], 0, 0, 0);
    o[d0] = __builtin_amdgcn_mfma_f32_32x32x16_bf16(pa3, PK(3), o[d0], 0, 0, 0);
    #undef PK
  }
}

__device__ __forceinline__ float opq(float x) { asm("" : "+v"(x)); return x; }
template <int MODE> __device__ __forceinline__ void score_hook(f32x16& c0, f32x16& c1, int t, const AttnArgs& a, int qrel, int hi, int wid, int r32, float mh) {
  if constexpr (MODE == MA) {
    const int wlo = a.q0 + wid * QBLK, sd = (64 * t + 63 < wlo) ? 1 : ((64 * t > wlo + 31) ? -1 : 0);
    if (sd != 0) { const float sv = (float)sd * a.s2;
      #pragma unroll
      for (int r = 0; r < 16; ++r) { const float kf = (float)((r & 3) + 8 * (r >> 2)); c0[r] = opq(fmaf(kf, sv, c0[r])); c1[r] = opq(fmaf(kf + 32.f, sv, c1[r])); if ((r & 3) == 3) __builtin_amdgcn_sched_barrier(0); }
    } else {
      const float dq = (float)(a.q0 + qrel - 64 * t - 4 * hi), ns = -a.s2;
      #pragma unroll
      for (int r = 0; r < 16; ++r) { const float kf = (float)((r & 3) + 8 * (r >> 2)); c0[r] = opq(fmaf(ns, fabsf(opq(dq - kf)), c0[r])); c1[r] = opq(fmaf(ns, fabsf(opq(dq - (kf + 32.f))), c1[r])); if ((r & 1) == 1) __builtin_amdgcn_sched_barrier(0); }
    }
  }
  if constexpr (MODE == MB) {
    const bool tv = (t >= a.tlo) && (t <= a.thi);
    const float dq = (float)(qrel + 64 - 64 * t - 4 * hi), ns = -a.s2;
    #pragma unroll
    for (int r = 0; r < 16; ++r) { const float kf = (float)((r & 3) + 8 * (r >> 2)); const float d0 = fabsf(opq(dq - kf)), d1 = fabsf(opq(dq - (kf + 32.f)));
      c0[r] = (tv && d0 <= 64.f) ? opq(fmaf(ns, d0, opq(c0[r] - mh))) : -INFINITY; c1[r] = (tv && d1 <= 64.f) ? opq(fmaf(ns, d1, opq(c1[r] - mh))) : -INFINITY;
      if ((r & 3) == 3) __builtin_amdgcn_sched_barrier(0); }
  }
  if constexpr (MODE == MC) {
    const int qrow = a.q0 + (wid >> 1), rs = min(max(qrow - 4, 0), 120), krow = a.kb + t;
    if (krow < rs || krow >= rs + 8) {
      #pragma unroll
      for (int r = 0; r < 16; ++r) { c0[r] = -INFINITY; c1[r] = -INFINITY; }
    } else {
      const int qc = (wid & 1) * 32 + r32, cs = min(max(qc - 8, 0), 48);
      const lds_fptr tp = a.tab + (krow - qrow + 7) * 31 + (15 - qc + 4 * hi);
      const int kd = 4 * hi - cs;
      #pragma unroll
      for (int r = 0; r < 16; ++r) { const int kc = (r & 3) + 8 * (r >> 2);
        const float b0 = tp[kc], b1 = tp[kc + 32];
        c0[r] = ((unsigned)(kd + kc) < 16u) ? opq(c0[r] + opq(b0 - mh)) : -INFINITY; c1[r] = ((unsigned)(kd + kc + 32) < 16u) ? opq(c1[r] + opq(b1 - mh)) : -INFINITY;
        if ((r & 3) == 3) __builtin_amdgcn_sched_barrier(0); }
    }
  }
}

template <int MODE, int THRL> __device__ __forceinline__ void attn_unit(const AttnArgs& A_, char* shm) {
  int tid_ = threadIdx.x; asm volatile("" : "+v"(tid_));
  const int tid = tid_, lane = tid & 63, r32 = lane & 31, hi = lane >> 5; const int wid = __builtin_amdgcn_readfirstlane(tid >> 6);
  const bf16* Qw = A_.Q + (wid * QBLK) * A_.qs;
  const unsigned lds0 = (unsigned)(uintptr_t)shm;
  float* wsf = (float*)(shm + LDS_WS) + wid * 64;
  const int ks = A_.ks;
  const bf16* ksrc = A_.K + (lane * ks + wid * 8);
  const bf16* vsrc = A_.V + ((16 * (wid & 3) + (lane >> 2)) * ks + (wid >> 2) * 32 + (lane & 3) * 8);
  const unsigned kdst = lds0 + LDS_K + wid * 1024, vdst = lds0 + LDS_V + wid * 1024;
  #define TT(t) ((MODE == MB) ? min(max((int)(t), A_.tlo), A_.thi) : (int)(t))
  #define DMA_K(t, slot) glds16(ksrc + TT(t) * KVBLK * ks, (unsigned)__builtin_amdgcn_readfirstlane(kdst + (slot)))
  #define DMA_V(t, slot) glds16(vsrc + TT(t) * KVBLK * ks, (unsigned)__builtin_amdgcn_readfirstlane(vdst + (slot)))
  const int vb0 = (int)(lds0 + LDS_V) + ((lane >> 4) & 1) * 32 + (lane & 3) * 8 + (4 * hi + ((lane & 15) >> 2)) * 64;
  const char* Kbase = shm + LDS_K; bf16x8 kf[8];
  const lds_cptr shm3 = (lds_cptr)shm; const lds_cptr kp0 = shm3 + LDS_K + hi * 1024 + r32 * 16; const lds_cptr vp0 = shm3 + LDS_V + ((lane >> 4) & 1) * 32 + (lane & 3) * 8 + (4 * hi + ((lane & 15) >> 2)) * 64;
  const int NT = A_.NT;
  DMA_K(0, 0); DMA_V(0, 0); DMA_K(1, SLOTB);
  bf16x8 qr[4];
  #pragma unroll
  for (int d0 = 0; d0 < 4; ++d0) qr[d0] = *reinterpret_cast<const bf16x8*>(&Qw[r32 * A_.qs + d0 * 16 + hi * 8]);
  float mhat = 0.f, l_reg = 0.f; f32x16 o[2]; o[0] = f32x16{}; o[1] = f32x16{}; f32x16 negm = f32x16{}; asm volatile("" : "+v"(negm));
  const int qrel = wid * QBLK + r32;
  constexpr bool NEGM = (MODE == MA || MODE == MD);
  #define CIN (NEGM ? negm : f32x16{})
  #define NEGM_SET(tn) do { float nb_ = -mhat; \
      if (MODE == MA) { const int wlo_ = A_.q0 + wid * QBLK, sd_ = (64 * (tn) + 63 < wlo_) ? 1 : ((64 * (tn) > wlo_ + 31) ? -1 : 0); \
        if (sd_ != 0) nb_ = fmaf(-(float)sd_ * A_.s2, (float)(A_.q0 + qrel - 64 * (tn) - 4 * hi), nb_); } \
      _Pragma("unroll") for (int r = 0; r < 16; ++r) negm[r] = nb_; asm volatile("" : "+v"(negm)); } while (0)
  #define CMASK(P0, P1, t) score_hook<MODE>(P0, P1, (t), A_, qrel, hi, wid, r32, mhat)
  bool resc = false;
  #define START(P0, P1) do { const float rm = rowmax(P0, P1); resc = false; \
    { const float dl = (MODE == MB || MODE == MC) ? fmaxf(rm, -2048.f) : rm; mhat = fadd_s(mhat, dl); \
      _Pragma("unroll") for (int r = 0; r < 16; ++r) { P0[r] = fsub_s(P0[r], dl); P1[r] = fsub_s(P1[r], dl); } \
      if (NEGM) { NEGM_SET(1); } } \
    _Pragma("unroll") for (int r = 0; r < 16; ++r) P0[r] = __builtin_amdgcn_exp2f(P0[r]); } while (0)
  #define RESC() do { if (resc) { asm volatile("s_waitcnt lgkmcnt(0)" ::: "memory"); \
      _Pragma("unroll") for (int d_ = 0; d_ < 2; ++d_) _Pragma("unroll") for (int r = 0; r < 16; ++r) o[d_][r] *= wsf[crow(r, hi)]; } } while (0)
  f32x16 pA0, pA1, pB0, pB1;
  int sl_prev = 0, sl_cur = 0, sl_next = SLOTB;
  #define ROT() do { sl_prev = sl_cur; sl_cur = sl_next; sl_next = (sl_next == (NSLOT - 1) * SLOTB) ? 0 : sl_next + SLOTB; } while (0)
  DMA_K(2, 2 * SLOTB);
  if (MODE == MA) { NEGM_SET(0); }
  WAIT_BAR(3);
  qkt(pA0, pA1, Kbase, qr, negm, r32, hi); asm volatile("s_nop 15\n\ts_nop 7" : "+v"(pA0), "+v"(pA1)); CMASK(pA0, pA1, 0);
  START(pA0, pA1);
  _Pragma("unroll") for (int r = 0; r < 16; ++r) pA1[r] = __builtin_amdgcn_exp2f(pA1[r]);
  WAIT_BAR(0);
  DMA_K(3, 0); DMA_V(1, SLOTB);
  ROT();
  kload8(kf, kp0 + sl_cur);
  WAIT_BAR(2);
  s16x4 vlo[8], vhi[8]; u32x4 pw0, pw1, pw2, pw3;
  #define PKW(P, B) cvtpk_s(P[B], P[B + 1])
  #define PAF(k) __builtin_bit_cast(bf16x8, pw##k)
  #define VFR(i) (bf16x8){vlo[i][0], vlo[i][1], vlo[i][2], vlo[i][3], vhi[i][0], vhi[i][1], vhi[i][2], vhi[i][3]}
  #define PIN(x) asm volatile("" : "+v"(x))
  #define MX3(a, b, c) __builtin_fmaxf(__builtin_fmaxf((a), (b)), (c))
  #define GAPA(MF, A0, A1, A2, A3, W0, W1, PW) do { MF; sacc += A0; sacc += A1; sacc += A2; sacc += A3; PIN(sacc); W0; W1; PIN(PW); SBAR(); } while (0)
  #define EX(v) __builtin_amdgcn_exp2f(v)
  #define GAPB(MF, X, B) do { MF; X[B] = EX(X[B]); X[B + 1] = EX(X[B + 1]); X[B + 2] = EX(X[B + 2]); X[B + 3] = EX(X[B + 3]); PIN(X); SBAR(); } while (0)
  #define VRD(i) do { vlo[i] = vtr(vp_ + (((i) >> 2) * 4096 + ((i) & 3) * 1024)); vhi[i] = vtr(vp_ + (((i) >> 2) * 4096 + ((i) & 3) * 1024 + 512)); } while (0)
  #define KRD(G, j) do { if (G) { kload2(kf, kp0 + sl_next, j); SBAR(); } } while (0)
  #define STEP(C0, C1, P0, P1, t, GK, GV, GL) do { SBAR(); \
    const lds_cptr vp_ = vp0 + sl_prev; \
    VRD(0); SBAR(); float sacc = (P0[0] + P0[1]); \
    GAPA(C0 = __builtin_amdgcn_mfma_f32_32x32x16_bf16(kf[0], qr[0], CIN, 0, 0, 0), P0[2], P0[3], P0[4], P0[5],     pw0[0] = PKW(P0, 0), pw0[1] = PKW(P0, 2), pw0); \
    VRD(4); SBAR(); GAPA(C1 = __builtin_amdgcn_mfma_f32_32x32x16_bf16(kf[1], qr[0], CIN, 0, 0, 0), P0[6], P0[7], P0[8], P0[9],     pw0[2] = PKW(P0, 4), pw0[3] = PKW(P0, 6), pw0); \
    VRD(1); SBAR(); GAPA(C0 = __builtin_amdgcn_mfma_f32_32x32x16_bf16(kf[2], qr[1], C0, 0, 0, 0),   P0[10], P0[11], P0[12], P0[13], pw1[0] = PKW(P0, 8), pw1[1] = PKW(P0, 10), pw1); \
    VRD(5); SBAR(); GAPA(C1 = __builtin_amdgcn_mfma_f32_32x32x16_bf16(kf[3], qr[1], C1, 0, 0, 0),   P0[14], P0[15], P1[0], P1[1],   pw1[2] = PKW(P0, 12), pw1[3] = PKW(P0, 14), pw1); \
    VRD(2); SBAR(); GAPA(C0 = __builtin_amdgcn_mfma_f32_32x32x16_bf16(kf[4], qr[2], C0, 0, 0, 0),   P1[2], P1[3], P1[4], P1[5],     pw2[0] = PKW(P1, 0), pw2[1] = PKW(P1, 2), pw2); \
    VRD(6); SBAR(); GAPA(C1 = __builtin_amdgcn_mfma_f32_32x32x16_bf16(kf[5], qr[2], C1, 0, 0, 0),   P1[6], P1[7], P1[8], P1[9],     pw2[2] = PKW(P1, 4), pw2[3] = PKW(P1, 6), pw2); \
    VRD(3); SBAR(); GAPA(C0 = __builtin_amdgcn_mfma_f32_32x32x16_bf16(kf[6], qr[3], C0, 0, 0, 0),   P1[10], P1[11], P1[12], P1[13], pw3[0] = PKW(P1, 8), pw3[1] = PKW(P1, 10), pw3); \
    VRD(7); SBAR(); GAPA(C1 = __builtin_amdgcn_mfma_f32_32x32x16_bf16(kf[7], qr[3], C1, 0, 0, 0),   P1[14], P1[15], 0.f, 0.f,       pw3[2] = PKW(P1, 12), pw3[3] = PKW(P1, 14), pw3); \
    l_reg += sacc; \
    if (GK) { DMA_K((t) + 3, sl_cur); } if (GV) { DMA_V((t) + 1, sl_next); } \
    CMASK(C0, C1, t); \
    { float a = MX3(C0[0], C0[1], C1[0]), b = MX3(C0[2], C0[3], C1[1]); a = MX3(a, C1[2], C1[3]); \
      _Pragma("unroll") for (int r = 4; r < 16; r += 4) { a = MX3(a, C0[r], C0[r + 1]); b = MX3(b, C0[r + 2], C0[r + 3]); a = MX3(a, C1[r], C1[r + 1]); b = MX3(b, C1[r + 2], C1[r + 3]); } \
      float rm = __builtin_fmaxf(a, b); { auto rr = __builtin_amdgcn_permlane32_swap(__float_as_uint(rm), __float_as_uint(rm), false, false); rm = __builtin_fmaxf(__uint_as_float(rr[0]), __uint_as_float(rr[1])); } \
      resc = false; \
      if (__builtin_expect(__any(rm > (float)THRL), 0)) { const float dl = __builtin_fmaxf(rm, 0.f); mhat += dl; \
        _Pragma("unroll") for (int r = 0; r < 16; ++r) { C0[r] -= dl; C1[r] -= dl; } \
        if (MODE == MD) { NEGM_SET(0); } \
        const float f = __builtin_amdgcn_exp2f(-dl); l_reg *= f; if (hi == 0) wsf[r32] = f; resc = true; } \
      if (MODE == MA) { NEGM_SET((t) + 1); } } \
    SBAR(); \
    GAPB(o[0] = __builtin_amdgcn_mfma_f32_32x32x16_bf16(PAF(0), VFR(0), o[0], 0, 0, 0), C0, 0); \
    GAPB(o[1] = __builtin_amdgcn_mfma_f32_32x32x16_bf16(PAF(0), VFR(4), o[1], 0, 0, 0), C0, 4); \
    KRD(GL, 0); GAPB(o[0] = __builtin_amdgcn_mfma_f32_32x32x16_bf16(PAF(1), VFR(1), o[0], 0, 0, 0), C0, 8); \
    KRD(GL, 1); GAPB(o[1] = __builtin_amdgcn_mfma_f32_32x32x16_bf16(PAF(1), VFR(5), o[1], 0, 0, 0), C0, 12); \
    KRD(GL, 2); GAPB(o[0] = __builtin_amdgcn_mfma_f32_32x32x16_bf16(PAF(2), VFR(2), o[0], 0, 0, 0), C1, 0); \
    KRD(GL, 3); GAPB(o[1] = __builtin_amdgcn_mfma_f32_32x32x16_bf16(PAF(2), VFR(6), o[1], 0, 0, 0), C1, 4); \
    GAPB(o[0] = __builtin_amdgcn_mfma_f32_32x32x16_bf16(PAF(3), VFR(3), o[0], 0, 0, 0), C1, 8); \
    GAPB(o[1] = __builtin_amdgcn_mfma_f32_32x32x16_bf16(PAF(3), VFR(7), o[1], 0, 0, 0), C1, 12); \
    } while (0)
  int t = 1;
  for (; t + 5 < NT; t += 2) {
    STEP(pB0, pB1, pA0, pA1, t, true, true, true);     WAIT_BAR(2); RESC(); ROT();
    STEP(pA0, pA1, pB0, pB1, t + 1, true, true, true); WAIT_BAR(2); RESC(); ROT();
  }
  #define ENDW(tt) do { if ((tt) + 3 < NT) { WAIT_BAR(2); } else if ((tt) + 2 < NT) { WAIT_BAR(1); } else { WAIT_BAR(0); } } while (0)
  for (; t + 1 < NT; t += 2) {
    STEP(pB0, pB1, pA0, pA1, t, (t + 3 < NT), (t + 1 < NT), (t + 1 < NT));         ENDW(t);     RESC(); ROT();
    STEP(pA0, pA1, pB0, pB1, t + 1, (t + 4 < NT), (t + 2 < NT), (t + 2 < NT));     ENDW(t + 1); RESC(); ROT();
  }
  STEP(pB0, pB1, pA0, pA1, NT - 1, false, false, false); RESC();
  { float sacc = pB0[0] + pB0[1]; _Pragma("unroll") for (int r = 2; r < 16; ++r) sacc += pB0[r]; _Pragma("unroll") for (int r = 0; r < 16; ++r) sacc += pB1[r]; l_reg += sacc;
    pw0 = (u32x4){PKW(pB0, 0), PKW(pB0, 2), PKW(pB0, 4), PKW(pB0, 6)}; pw1 = (u32x4){PKW(pB0, 8), PKW(pB0, 10), PKW(pB0, 12), PKW(pB0, 14)}; pw2 = (u32x4){PKW(pB1, 0), PKW(pB1, 2), PKW(pB1, 4), PKW(pB1, 6)}; pw3 = (u32x4){PKW(pB1, 8), PKW(pB1, 10), PKW(pB1, 12), PKW(pB1, 14)};
    SBAR(); pv(o, vb0 + sl_cur, PAF(0), PAF(1), PAF(2), PAF(3)); }
  #undef PKW
  #undef PAF
  #undef VFR
  #undef PIN
  #undef MX3
  #undef GAPA
  #undef GAPB
  #undef EX
  #undef VRD
  #undef KRD
  #undef STEP
  #undef ENDW
  { auto rr = __builtin_amdgcn_permlane32_swap(__float_as_uint(l_reg), __float_as_uint(l_reg), false, false); l_reg = __uint_as_float(rr[0]) + __uint_as_float(rr[1]); }
  if (MODE == MB) { if (hi == 0) { float* sp = A_.stat + (wid * QBLK + r32) * A_.ss; sp[0] = mhat; sp[1] = l_reg; } }
  if (hi == 0) wsf[32 + r32] = l_reg; asm volatile("s_waitcnt lgkmcnt(0)" ::: "memory");
  float rli[16];
  #pragma unroll
  for (int r = 0; r < 16; ++r) rli[r] = __builtin_amdgcn_rcpf(wsf[32 + crow(r, hi)]);
  bf16* Ow = A_.O + (wid * QBLK) * A_.os;
  { bf16* stg = (bf16*)(shm + LDS_OST) + wid * 2048;
    #pragma unroll
    for (int r = 0; r < 16; ++r) { const int orow = crow(r, hi);
      #pragma unroll
      for (int d0 = 0; d0 < 2; ++d0) stg[orow * 64 + d0 * 32 + r32] = __float2bfloat16(o[d0][r] * rli[r]); }
    asm volatile("s_waitcnt lgkmcnt(0)" ::: "memory");
    #pragma unroll
    for (int i = 0; i < 4; ++i) { const int row = i * 8 + (lane >> 3), ch = lane & 7; const u32x4 v = *(const u32x4*)(stg + row * 64 + ch * 8); *(u32x4*)(Ow + row * A_.os + ch * 8) = v; } }
  asm volatile("s_waitcnt lgkmcnt(0)\n\ts_barrier" ::: "memory");
  #undef DMA_K
  #undef DMA_V
  #undef TT
  #undef CMASK
  #undef CIN
  #undef NEGM_SET
  #undef START
  #undef RESC
  #undef ROT
}

constexpr int L8_K = 0, L8_V = 3 * 8192, L8_WS = L8_V + 3 * 16384, L8_QO = L8_WS + 2048, L8_END = L8_QO + 8 * 4096;
template <int THRL> __device__ __forceinline__ void attn_unit128(const AttnArgs& A_, char* shm) {
  int tid_ = threadIdx.x; asm volatile("" : "+v"(tid_));
  const int tid = tid_, lane = tid & 63, r32 = lane & 31, hi = lane >> 5; const int wid = __builtin_amdgcn_readfirstlane(tid >> 6);
  const bf16* Qw = A_.Q + (wid * QBLK) * A_.qs;
  const unsigned lds0 = (unsigned)(uintptr_t)shm;
  float* wsf = (float*)(shm + L8_WS) + wid * 64;
  const int ks = A_.ks;
  const bf16* ksrc = A_.K + (lane * ks + wid * 8);
  const bf16* vsrc = A_.V + ((16 * (wid & 3) + (lane >> 2)) * ks + (wid >> 2) * 32 + (lane & 3) * 8);
  const unsigned kdst = lds0 + L8_K + wid * 1024, vdst = lds0 + L8_V + wid * 1024;
  #define DMA_K(t, slot) glds16(ksrc + (int)(t) * KVBLK * ks, (unsigned)__builtin_amdgcn_readfirstlane(kdst + (slot)))
  #define DMA_V(t, slot) do { glds16(vsrc + (int)(t) * KVBLK * ks, (unsigned)__builtin_amdgcn_readfirstlane(vdst + 2 * (slot))); \
                              glds16(vsrc + (int)(t) * KVBLK * ks + 64, (unsigned)__builtin_amdgcn_readfirstlane(vdst + 2 * (slot) + 8192)); } while (0)
  const int vb0 = (int)(lds0 + L8_V) + ((lane >> 4) & 1) * 32 + (lane & 3) * 8 + (4 * hi + ((lane & 15) >> 2)) * 64;
  const char* Kbase = shm + L8_K; bf16x8 kf[8];
  const lds_cptr shm3 = (lds_cptr)shm; const lds_cptr kp0 = shm3 + L8_K + hi * 1024 + r32 * 16; const lds_cptr vp0 = shm3 + L8_V + ((lane >> 4) & 1) * 32 + (lane & 3) * 8 + (4 * hi + ((lane & 15) >> 2)) * 64;
  const lds_cptr qst = shm3 + L8_QO + wid * 4096 + lane * 16;
  const int NT = A_.NT;
  DMA_K(0, 0); DMA_V(0, 0); DMA_K(1, SLOTB);
  { bf16x8 qr[4];
    #pragma unroll
    for (int d0 = 0; d0 < 4; ++d0) qr[d0] = *reinterpret_cast<const bf16x8*>(&Qw[r32 * A_.qs + d0 * 16 + hi * 8]);
    #pragma unroll
    for (int d0 = 0; d0 < 4; ++d0) *(LAS bf16x8*)(shm3 + L8_QO + wid * 4096 + lane * 16 + d0 * 1024) = qr[d0]; }
  #define QLD(d0) (*(const LAS bf16x8*)(qst + (d0) * 1024))
  float mhat = 0.f, l_reg = 0.f; f32x16 o[4]; o[0] = f32x16{}; o[1] = f32x16{}; o[2] = f32x16{}; o[3] = f32x16{};
  const int qrel = wid * QBLK + r32;
  #define NB(tn) ({ float nb_ = -mhat; const int wlo_ = A_.q0 + wid * QBLK, sd_ = (64 * (tn) + 63 < wlo_) ? 1 : ((64 * (tn) > wlo_ + 31) ? -1 : 0); \
      if (sd_ != 0) nb_ = fmaf(-(float)sd_ * A_.s2, (float)(A_.q0 + qrel - 64 * (tn) - 4 * hi), nb_); nb_; })
  #define CMASK(P0, P1, t) score_hook<MA>(P0, P1, (t), A_, qrel, hi, wid, r32, mhat)
  bool resc = false;
  #define RESC() do { if (resc) { asm volatile("s_waitcnt lgkmcnt(0)" ::: "memory"); \
      _Pragma("unroll") for (int d_ = 0; d_ < 4; ++d_) _Pragma("unroll") for (int r = 0; r < 16; ++r) o[d_][r] *= wsf[crow(r, hi)]; } } while (0)
  f32x16 pA0, pA1, pB0, pB1;
  int sl_prev = 0, sl_cur = 0, sl_next = SLOTB;
  #define ROT() do { sl_prev = sl_cur; sl_cur = sl_next; sl_next = (sl_next == (NSLOT - 1) * SLOTB) ? 0 : sl_next + SLOTB; } while (0)
  DMA_K(2, 2 * SLOTB);
  WAIT_BAR(4);
  { f32x16 cin; const float nb0 = NB(0);
    #pragma unroll
    for (int r = 0; r < 16; ++r) cin[r] = nb0;
    bf16x8 qr[4];
    #pragma unroll
    for (int d0 = 0; d0 < 4; ++d0) qr[d0] = QLD(d0);
    qkt(pA0, pA1, Kbase, qr, cin, r32, hi); }
  asm volatile("s_nop 15\n\ts_nop 7" : "+v"(pA0), "+v"(pA1)); CMASK(pA0, pA1, 0);
  { const float rm = rowmax(pA0, pA1); mhat = fadd_s(mhat, rm);
    #pragma unroll
    for (int r = 0; r < 16; ++r) { pA0[r] = fsub_s(pA0[r], rm); pA1[r] = fsub_s(pA1[r], rm); }
    #pragma unroll
    for (int r = 0; r < 16; ++r) pA0[r] = __builtin_amdgcn_exp2f(pA0[r]);
    #pragma unroll
    for (int r = 0; r < 16; ++r) pA1[r] = __builtin_amdgcn_exp2f(pA1[r]); }
  WAIT_BAR(0);
  DMA_K(3, 0); DMA_V(1, SLOTB);
  ROT();
  kload8(kf, kp0 + sl_cur);
  WAIT_BAR(3);
  u32x4 pw0, pw1, pw2, pw3;
  #define PKW(P, B) cvtpk_s(P[B], P[B + 1])
  #define PAF(k) __builtin_bit_cast(bf16x8, pw##k)
  #define PIN(x) asm volatile("" : "+v"(x))
  #define MX3(a, b, c) __builtin_fmaxf(__builtin_fmaxf((a), (b)), (c))
  #define GAPA(MF, A0, A1, A2, A3, W0, W1, PW) do { MF; sacc += A0; sacc += A1; sacc += A2; sacc += A3; PIN(sacc); W0; W1; PIN(PW); SBAR(); } while (0)
  #define EX(v) __builtin_amdgcn_exp2f(v)
  #define GAPB(MF, X, B) do { MF; X[B] = EX(X[B]); X[B + 1] = EX(X[B + 1]); PIN(X); SBAR(); } while (0)
  #define KRD(G, j) do { if (G) { kload2(kf, kp0 + sl_next, j); SBAR(); } } while (0)
  #define FOFF(j) (((((j) & 1) + 2 * ((j) >> 3)) * 4096) + ((((j) >> 1) & 3) * 1024))
  #define FRD(j) do { fl[j] = vtr(vp_ + FOFF(j)); fh[j] = vtr(vp_ + FOFF(j) + 512); SBAR(); } while (0)
  #define FFR(j) (bf16x8){fl[j][0], fl[j][1], fl[j][2], fl[j][3], fh[j][0], fh[j][1], fh[j][2], fh[j][3]}
  #define STEP(C0, C1, P0, P1, t, GK, GV, GL) do { SBAR(); \
    const lds_cptr vp_ = vp0 + 2 * sl_prev; s16x4 fl[16], fh[16]; \
    { const float nb_t = NB(t); _Pragma("unroll") for (int r = 0; r < 16; ++r) { C0[r] = nb_t; C1[r] = nb_t; } } \
    bf16x8 q0_ = QLD(0), q1_ = QLD(1); SBAR(); float sacc = (P0[0] + P0[1]); \
    GAPA(C0 = __builtin_amdgcn_mfma_f32_32x32x16_bf16(kf[0], q0_, C0, 0, 0, 0), P0[2], P0[3], P0[4], P0[5],     pw0[0] = PKW(P0, 0), pw0[1] = PKW(P0, 2), pw0); \
    GAPA(C1 = __builtin_amdgcn_mfma_f32_32x32x16_bf16(kf[1], q0_, C1, 0, 0, 0), P0[6], P0[7], P0[8], P0[9],     pw0[2] = PKW(P0, 4), pw0[3] = PKW(P0, 6), pw0); \
    q0_ = QLD(2); SBAR(); \
    GAPA(C0 = __builtin_amdgcn_mfma_f32_32x32x16_bf16(kf[2], q1_, C0, 0, 0, 0),   P0[10], P0[11], P0[12], P0[13], pw1[0] = PKW(P0, 8), pw1[1] = PKW(P0, 10), pw1); \
    GAPA(C1 = __builtin_amdgcn_mfma_f32_32x32x16_bf16(kf[3], q1_, C1, 0, 0, 0),   P0[14], P0[15], P1[0], P1[1],   pw1[2] = PKW(P0, 12), pw1[3] = PKW(P0, 14), pw1); \
    q1_ = QLD(3); SBAR(); \
    GAPA(C0 = __builtin_amdgcn_mfma_f32_32x32x16_bf16(kf[4], q0_, C0, 0, 0, 0),   P1[2], P1[3], P1[4], P1[5],     pw2[0] = PKW(P1, 0), pw2[1] = PKW(P1, 2), pw2); \
    GAPA(C1 = __builtin_amdgcn_mfma_f32_32x32x16_bf16(kf[5], q0_, C1, 0, 0, 0),   P1[6], P1[7], P1[8], P1[9],     pw2[2] = PKW(P1, 4), pw2[3] = PKW(P1, 6), pw2); \
    GAPA(C0 = __builtin_amdgcn_mfma_f32_32x32x16_bf16(kf[6], q1_, C0, 0, 0, 0),   P1[10], P1[11], P1[12], P1[13], pw3[0] = PKW(P1, 8), pw3[1] = PKW(P1, 10), pw3); \
    GAPA(C1 = __builtin_amdgcn_mfma_f32_32x32x16_bf16(kf[7], q1_, C1, 0, 0, 0),   P1[14], P1[15], 0.f, 0.f,       pw3[2] = PKW(P1, 12), pw3[3] = PKW(P1, 14), pw3); \
    l_reg += sacc; \
    if (GK) { DMA_K((t) + 3, sl_cur); } if (GV) { DMA_V((t) + 1, sl_next); } \
    FRD(0); FRD(1); FRD(2); \
    CMASK(C0, C1, t); \
    { float a = MX3(C0[0], C0[1], C1[0]), b = MX3(C0[2], C0[3], C1[1]); a = MX3(a, C1[2], C1[3]); \
      _Pragma("unroll") for (int r = 4; r < 16; r += 4) { a = MX3(a, C0[r], C0[r + 1]); b = MX3(b, C0[r + 2], C0[r + 3]); a = MX3(a, C1[r], C1[r + 1]); b = MX3(b, C1[r + 2], C1[r + 3]); } \
      float rm = __builtin_fmaxf(a, b); { auto rr = __builtin_amdgcn_permlane32_swap(__float_as_uint(rm), __float_as_uint(rm), false, false); rm = __builtin_fmaxf(__uint_as_float(rr[0]), __uint_as_float(rr[1])); } \
      resc = false; \
      if (__builtin_expect(__any(rm > (float)THRL), 0)) { const float dl = __builtin_fmaxf(rm, 0.f); mhat += dl; \
        _Pragma("unroll") for (int r = 0; r < 16; ++r) { C0[r] -= dl; C1[r] -= dl; } \
        const float f = __builtin_amdgcn_exp2f(-dl); l_reg *= f; if (hi == 0) wsf[r32] = f; resc = true; } } \
    SBAR(); \
    GAPB(o[0] = __builtin_amdgcn_mfma_f32_32x32x16_bf16(PAF(0), FFR(0), o[0], 0, 0, 0), C0, 0);   FRD(3); \
    GAPB(o[1] = __builtin_amdgcn_mfma_f32_32x32x16_bf16(PAF(0), FFR(1), o[1], 0, 0, 0), C0, 2);   FRD(4); \
    GAPB(o[0] = __builtin_amdgcn_mfma_f32_32x32x16_bf16(PAF(1), FFR(2), o[0], 0, 0, 0), C0, 4);   FRD(5); \
    GAPB(o[1] = __builtin_amdgcn_mfma_f32_32x32x16_bf16(PAF(1), FFR(3), o[1], 0, 0, 0), C0, 6);   FRD(6); \
    GAPB(o[0] = __builtin_amdgcn_mfma_f32_32x32x16_bf16(PAF(2), FFR(4), o[0], 0, 0, 0), C0, 8);   FRD(7); \
    GAPB(o[1] = __builtin_amdgcn_mfma_f32_32x32x16_bf16(PAF(2), FFR(5), o[1], 0, 0, 0), C0, 10);  FRD(8); \
    GAPB(o[0] = __builtin_amdgcn_mfma_f32_32x32x16_bf16(PAF(3), FFR(6), o[0], 0, 0, 0), C0, 12);  FRD(9); \
    GAPB(o[1] = __builtin_amdgcn_mfma_f32_32x32x16_bf16(PAF(3), FFR(7), o[1], 0, 0, 0), C0, 14);  FRD(10); \
    KRD(GL, 0); GAPB(o[2] = __builtin_amdgcn_mfma_f32_32x32x16_bf16(PAF(0), FFR(8), o[2], 0, 0, 0), C1, 0);   FRD(11); \
    KRD(GL, 1); GAPB(o[3] = __builtin_amdgcn_mfma_f32_32x32x16_bf16(PAF(0), FFR(9), o[3], 0, 0, 0), C1, 2);   FRD(12); \
    KRD(GL, 2); GAPB(o[2] = __builtin_amdgcn_mfma_f32_32x32x16_bf16(PAF(1), FFR(10), o[2], 0, 0, 0), C1, 4);  FRD(13); \
    KRD(GL, 3); GAPB(o[3] = __builtin_amdgcn_mfma_f32_32x32x16_bf16(PAF(1), FFR(11), o[3], 0, 0, 0), C1, 6);  FRD(14); \
    GAPB(o[2] = __builtin_amdgcn_mfma_f32_32x32x16_bf16(PAF(2), FFR(12), o[2], 0, 0, 0), C1, 8);  FRD(15); \
    GAPB(o[3] = __builtin_amdgcn_mfma_f32_32x32x16_bf16(PAF(2), FFR(13), o[3], 0, 0, 0), C1, 10); \
    GAPB(o[2] = __builtin_amdgcn_mfma_f32_32x32x16_bf16(PAF(3), FFR(14), o[2], 0, 0, 0), C1, 12); \
    GAPB(o[3] = __builtin_amdgcn_mfma_f32_32x32x16_bf16(PAF(3), FFR(15), o[3], 0, 0, 0), C1, 14); \
    } while (0)
  int t = 1;
  for (; t + 5 < NT; t += 2) {
    STEP(pB0, pB1, pA0, pA1, t, true, true, true);     WAIT_BAR(3); RESC(); ROT();
    STEP(pA0, pA1, pB0, pB1, t + 1, true, true, true); WAIT_BAR(3); RESC(); ROT();
  }
  #define ENDW(tt) do { if ((tt) + 3 < NT) { WAIT_BAR(3); } else if ((tt) + 2 < NT) { WAIT_BAR(2); } else { WAIT_BAR(0); } } while (0)
  for (; t + 1 < NT; t += 2) {
    STEP(pB0, pB1, pA0, pA1, t, (t + 3 < NT), (t + 1 < NT), (t + 1 < NT));         ENDW(t);     RESC(); ROT();
    STEP(pA0, pA1, pB0, pB1, t + 1, (t + 4 < NT), (t + 2 < NT), (t + 2 < NT));     ENDW(t + 1); RESC(); ROT();
  }
  STEP(pB0, pB1, pA0, pA1, NT - 1, false, false, false); RESC();
  { float sacc = pB0[0] + pB0[1]; _Pragma("unroll") for (int r = 2; r < 16; ++r) sacc += pB0[r]; _Pragma("unroll") for (int r = 0; r < 16; ++r) sacc += pB1[r]; l_reg += sacc;
    pw0 = (u32x4){PKW(pB0, 0), PKW(pB0, 2), PKW(pB0, 4), PKW(pB0, 6)}; pw1 = (u32x4){PKW(pB0, 8), PKW(pB0, 10), PKW(pB0, 12), PKW(pB0, 14)}; pw2 = (u32x4){PKW(pB1, 0), PKW(pB1, 2), PKW(pB1, 4), PKW(pB1, 6)}; pw3 = (u32x4){PKW(pB1, 8), PKW(pB1, 10), PKW(pB1, 12), PKW(pB1, 14)};
    SBAR(); pv(o, vb0 + 2 * sl_cur, PAF(0), PAF(1), PAF(2), PAF(3)); pv(o + 2, vb0 + 2 * sl_cur + 8192, PAF(0), PAF(1), PAF(2), PAF(3)); }
  #undef PKW
  #undef PAF
  #undef PIN
  #undef MX3
  #undef GAPA
  #undef GAPB
  #undef EX
  #undef FOFF
  #undef FRD
  #undef FFR
  #undef KRD
  #undef STEP
  #undef ENDW
  { auto rr = __builtin_amdgcn_permlane32_swap(__float_as_uint(l_reg), __float_as_uint(l_reg), false, false); l_reg = __uint_as_float(rr[0]) + __uint_as_float(rr[1]); }
  if (hi == 0) wsf[32 + r32] = l_reg; asm volatile("s_waitcnt lgkmcnt(0)" ::: "memory");
  float rli[16];
  #pragma unroll
  for (int r = 0; r < 16; ++r) rli[r] = __builtin_amdgcn_rcpf(wsf[32 + crow(r, hi)]);
  bf16* Ow = A_.O + (wid * QBLK) * A_.os;
  { bf16* stg = (bf16*)(shm + L8_QO) + wid * 2048;
    #pragma unroll
    for (int hv = 0; hv < 2; ++hv) {
      #pragma unroll
      for (int r = 0; r < 16; ++r) { const int orow = crow(r, hi);
        #pragma unroll
        for (int d0 = 0; d0 < 2; ++d0) stg[orow * 64 + d0 * 32 + r32] = __float2bfloat16(o[2 * hv + d0][r] * rli[r]); }
      asm volatile("s_waitcnt lgkmcnt(0)" ::: "memory");
      #pragma unroll
      for (int i = 0; i < 4; ++i) { const int row = i * 8 + (lane >> 3), ch = lane & 7; const u32x4 v = *(const u32x4*)(stg + row * 64 + ch * 8); *(u32x4*)(Ow + row * A_.os + hv * 64 + ch * 8) = v; }
      asm volatile("s_waitcnt lgkmcnt(0)" ::: "memory"); } }
  asm volatile("s_waitcnt lgkmcnt(0)\n\ts_barrier" ::: "memory");
  #undef DMA_K
  #undef DMA_V
  #undef QLD
  #undef NB
  #undef CMASK
  #undef RESC
  #undef ROT
}
#undef SBAR
#undef WAIT_BAR
}

__device__ __forceinline__ void transpose_item(const float* W, int K, int N, bf16_t* WT, LAS float* scr, int item, int lane, const float* gk = nullptr) {
    const int nblk = N / 32, kb = item / nblk, nb = item % nblk, k0 = 64 * kb, n0 = 32 * nb;
#pragma unroll 8
    for (int i = 0; i < 32; ++i) { const int kk = 2 * i + (lane >> 5); const float gg = gk ? gk[k0 + kk] : 1.f; scr[kk * 33 + (lane & 31)] = W[(size_t)(k0 + kk) * N + n0 + (lane & 31)] * gg; }
    asm volatile("s_waitcnt lgkmcnt(0)" ::: "memory");
    const int c = lane & 7;
#pragma unroll
    for (int j = 0; j < 4; ++j) { const int n = (lane >> 3) + 8 * j; const LAS float* s = scr + (8 * c) * 33 + n;
        u32x4 o; o.x = pk2(s[0 * 33], s[1 * 33]); o.y = pk2(s[2 * 33], s[3 * 33]); o.z = pk2(s[4 * 33], s[5 * 33]); o.w = pk2(s[6 * 33], s[7 * 33]);
        *(u32x4*)(WT + (size_t)(n0 + n) * K + k0 + 8 * c) = o; }
    asm volatile("s_waitcnt lgkmcnt(0)" ::: "memory");
}
__device__ __forceinline__ void rms_row_bf16(const float* xrow, const float* g, bf16_t* orow, int lane) {
    const f32x4* xr = (const f32x4*)xrow + lane; const f32x4* gr = (const f32x4*)g + lane;
    f32x4 v[4]; float s = 0.f;
#pragma unroll
    for (int j = 0; j < 4; ++j) { v[j] = xr[64 * j]; s += (v[j].x * v[j].x + v[j].y * v[j].y) + (v[j].z * v[j].z + v[j].w * v[j].w); }
    const float rs = rsqrtf(wave_sum(s) * (1.f / DM) + EPS);
    u32x2* o8 = (u32x2*)orow + lane;
#pragma unroll
    for (int j = 0; j < 4; ++j) { const f32x4 gg = gr[64 * j]; u32x2 w; w.x = pk2(v[j].x * rs * gg.x, v[j].y * rs * gg.y); w.y = pk2(v[j].z * rs * gg.z, v[j].w * rs * gg.w); o8[64 * j] = w; }
}
__device__ __forceinline__ void sincos_red(float a, float& s, float& c) {
    const float q = rintf(a * 0.636619772367581f); const int iq = (int)q;
    float r = fmaf(q, -1.5703125f, a); r = fmaf(q, -4.837512969970703125e-4f, r); r = fmaf(q, -7.54978995489188216e-8f, r);
    const float r2 = r * r;
    const float sp = r + r * r2 * (-1.6666654611e-1f + r2 * (8.3321608736e-3f + r2 * (-1.9515295891e-4f)));
    const float cp = 1.0f - 0.5f * r2 + r2 * r2 * (4.166664568298827e-2f + r2 * (-1.388731625493765e-3f + r2 * 2.443315711809948e-5f));
    const int k = iq & 3;
    s = (k == 0) ? sp : (k == 1) ? cp : (k == 2) ? -sp : -cp;
    c = (k == 0) ? cp : (k == 1) ? -sp : (k == 2) ? -cp : sp;
}

#define XB_TMO      128
#define XB_XCNT(j)  (256  + 64 * (j))
#define XB_XSUB(j)  (1280 + 64 * (j))
#define XB_XGEN(j)  (2304 + 64 * (j))
#define XB_TOP      3328
#define XB_TOPGEN   3392
#define XCD_BAR_WORDS 3456
#define XB_SPIN_CAP (1u << 18)

__device__ __forceinline__ unsigned xb_ld(unsigned* p)              { return __hip_atomic_load(p, __ATOMIC_RELAXED, __HIP_MEMORY_SCOPE_AGENT); }
__device__ __forceinline__ unsigned xb_add(unsigned* p, unsigned v) { return __hip_atomic_fetch_add(p, v, __ATOMIC_RELAXED, __HIP_MEMORY_SCOPE_AGENT); }
__device__ __forceinline__ unsigned xb_xcc_id() { return (unsigned)__builtin_amdgcn_s_getreg((3 << 11) | 20) & 0xFu; }
#define XB_SPIN(cond, bar) do { unsigned _sp = 0; while (cond) { __builtin_amdgcn_s_sleep(1); \
    if ((++_sp & 255u) == 0u) { if (xb_ld(&(bar)[XB_TMO])) break; if (_sp > XB_SPIN_CAP) { atomicAdd(&(bar)[XB_TMO], 1u); break; } } } } while (0)

struct XcdBarrier {
    unsigned* bar; unsigned x;
    volatile LAS unsigned* st;
};

__device__ __forceinline__ XcdBarrier xcd_barrier_post(unsigned* bar, volatile LAS unsigned* st) {
    XcdBarrier b; b.bar = bar; b.x = xb_xcc_id(); b.st = st;
    if (threadIdx.x == 0) (void)xb_add(&bar[XB_XCNT(b.x)], 1u);
    return b;
}
__device__ __forceinline__ void xcd_barrier_complete(unsigned* bar, unsigned x, unsigned& nloc, unsigned& nx) {
    const unsigned G = gridDim.x * gridDim.y * gridDim.z;
    unsigned sum, cnt, mine, sp = 0u;
    for (;;) {
        sum = 0u; cnt = 0u; mine = 0u;
#pragma unroll
        for (unsigned j = 0; j < 16; ++j) { const unsigned c = xb_ld(&bar[XB_XCNT(j)]); sum += c; cnt += (c > 0u) ? 1u : 0u; mine = (j == x) ? c : mine; }
        if (sum == G) break;
        __builtin_amdgcn_s_sleep(1);
        if ((++sp & 255u) == 0u) { if (xb_ld(&bar[XB_TMO])) break; if (sp > XB_SPIN_CAP) { atomicAdd(&bar[XB_TMO], 1u); break; } }
    }
    nloc = mine > 0u ? mine : 1u; nx = cnt > 0u ? cnt : 1u;
}

__device__ __forceinline__ void xcd_barrier(const XcdBarrier& b) {
    asm volatile("s_waitcnt vmcnt(0)" ::: "memory");
    __syncthreads();
    if (threadIdx.x == 0) {
        unsigned* bar = b.bar;
        __builtin_amdgcn_s_waitcnt(0);
        unsigned nloc = b.st[0], nx = b.st[1];
        if (nloc == 0u) { xcd_barrier_complete(bar, b.x, nloc, nx); b.st[0] = nloc; b.st[1] = nx; }
        const unsigned old = xb_add(&bar[XB_XSUB(b.x)], 1u);
        const unsigned gen = old / nloc;
        if (old + 1u == (gen + 1u) * nloc) {
            __builtin_amdgcn_fence(__ATOMIC_RELEASE, "agent");
            asm volatile("s_waitcnt vmcnt(0)" ::: "memory");
            const unsigned og = xb_add(&bar[XB_TOP], 1u);
            const unsigned tg = og / nx;
            if (og + 1u == (tg + 1u) * nx) xb_add(&bar[XB_TOPGEN], 1u);
            else XB_SPIN(xb_ld(&bar[XB_TOPGEN]) == tg, bar);
            __builtin_amdgcn_fence(__ATOMIC_ACQUIRE, "agent");
            xb_add(&bar[XB_XGEN(b.x)], 1u);
            asm volatile("s_waitcnt vmcnt(0)" ::: "memory");
        } else {
            XB_SPIN(xb_ld(&bar[XB_XGEN(b.x)]) == gen, bar);
            __builtin_amdgcn_fence(__ATOMIC_ACQUIRE, "agent");
            asm volatile("s_waitcnt vmcnt(0)" ::: "memory");
        }
    }
    __syncthreads();
}


struct Args { const float* in[14]; float* out; unsigned char* ws; };

__global__ void __launch_bounds__(512) mk_fwd(Args args) {
    extern __shared__ __attribute__((aligned(16))) unsigned char lds[];
    cg::grid_group grid = cg::this_grid();
    const int tid0 = threadIdx.x, wave = __builtin_amdgcn_readfirstlane(tid0 >> 6);
#define FRESH_LANE() int tid = tid0; asm volatile("" : "+v"(tid)); const int lane = tid & 63
    const int G = gridDim.x, bx = blockIdx.x;
    const int vcu = (G % 8 == 0) ? (bx % 8) * (G / 8) + bx / 8 : bx;
    const int gw = vcu * 8 + wave, NGW = G * 8;
    LAS unsigned char* ldsl = (LAS unsigned char*)lds;
    if (tid0 < 8) ((LAS unsigned*)(ldsl + MISC_OFF))[tid0] = 0u;
    __syncthreads();
    const XcdBarrier xbar = xcd_barrier_post((unsigned*)(args.ws + WS_BAR), (volatile LAS unsigned*)(ldsl + MISC_OFF));
#define ws (args.ws)
#define x_in (args.in[0])
#define norm_mix (args.in[1])
#define w_in (args.in[2])
#define b_gate (args.in[3])
#define diff_lambda (args.in[4])
#define diff_subln (args.in[5])
#define na_rpb (args.in[6])
#define qk_norm (args.in[7])
#define w_branch (args.in[8])
#define w_out (args.in[9])
#define norm_ffn (args.in[10])
#define w_ff1 (args.in[11])
#define w_ff2 (args.in[12])
#define norm_final (args.in[13])
#define xout (args.out)
#define WinT ((bf16_t*)(ws + WS_WIN))
#define WbrT ((bf16_t*)(ws + WS_WBR))
#define WoutT ((bf16_t*)(ws + WS_WOUT))
#define W1T ((bf16_t*)(ws + WS_W1))
#define W2T ((bf16_t*)(ws + WS_W2))
#define STAT ((float*)(ws + WS_STAT))
#define H ((bf16_t*)(ws + WS_H))
#define ATMP ((bf16_t*)(ws + WS_ATMP))
#define BTMP ((bf16_t*)(ws + WS_BTMP))
#define Y ((bf16_t*)(ws + WS_Y))
#define MERGED ((bf16_t*)(ws + WS_MERGED))
#define Z ((bf16_t*)(ws + WS_Z))
#define U ((bf16_t*)(ws + WS_Z))
#define PROJ ((bf16_t*)(ws + WS_PROJ))
#define XB ((bf16_t*)(ws + WS_XB))
#define SSQM ((float*)(ws + WS_SSQM))
#define SSQF ((float*)(ws + WS_SSQF))
#define NRMQ ((unsigned*)(ws + WS_NRM))
#define NRMK ((unsigned*)(ws + WS_NRM) + 1024)

    {
        FRESH_LANE();
        LAS float* scr = (LAS float*)(ldsl + wave * 16384);
        constexpr int I_IN = (DM / 64) * (INW / 32), I_BR = (512 / 64) * (DM / 32), I_OUT = (DM / 64) * (DM / 32), I_1 = (DM / 64) * (DFF / 32), I_2 = (DFF / 64) * (DM / 32);
        constexpr int NITEMS = 2 * I_IN + 8 * I_BR + 2 * I_OUT + 2 * I_1 + 2 * I_2;
        for (int it = gw; it < NITEMS; it += NGW) {
            int r = it;
            if (r < 2 * I_IN) { const int l = r / I_IN; transpose_item(w_in + (size_t)l * DM * INW, DM, INW, WinT + (size_t)l * INW * DM, scr, r % I_IN, lane, norm_mix + l * DM); continue; } r -= 2 * I_IN;
            if (r < 8 * I_BR) { const int ln = r / I_BR; transpose_item(w_branch + (size_t)ln * 512 * DM, 512, DM, WbrT + (size_t)ln * DM * 512, scr, r % I_BR, lane); continue; } r -= 8 * I_BR;
            if (r < 2 * I_OUT) { const int l = r / I_OUT; transpose_item(w_out + (size_t)l * DM * DM, DM, DM, WoutT + (size_t)l * DM * DM, scr, r % I_OUT, lane); continue; } r -= 2 * I_OUT;
            if (r < 2 * I_1) { const int l = r / I_1; transpose_item(w_ff1 + (size_t)l * DM * DFF, DM, DFF, W1T + (size_t)l * DFF * DM, scr, r % I_1, lane, norm_ffn + l * DM); continue; } r -= 2 * I_1;
            { const int l = r / I_2; transpose_item(w_ff2 + (size_t)l * DFF * DM, DFF, DM, W2T + (size_t)l * DM * DFF, scr, r % I_2, lane); }
        }
        {
            f32x4 v[4], vn[4] = {};
            if (gw < NTOK) { const f32x4* xr = (const f32x4*)(x_in + (size_t)gw * DM) + lane;
#pragma unroll
                for (int j = 0; j < 4; ++j) v[j] = xr[64 * j]; }
            for (int m = gw; m < NTOK; m += NGW) {
                if (m + NGW < NTOK) { const f32x4* xr = (const f32x4*)(x_in + (size_t)(m + NGW) * DM) + lane;
#pragma unroll
                    for (int j = 0; j < 4; ++j) vn[j] = xr[64 * j]; }
                u32x2* o8 = (u32x2*)(XB + (size_t)m * DM) + lane; float sq = 0.f;
#pragma unroll
                for (int j = 0; j < 4; ++j) { sq += (v[j].x * v[j].x + v[j].y * v[j].y) + (v[j].z * v[j].z + v[j].w * v[j].w); u32x2 w; w.x = pk2(v[j].x, v[j].y); w.y = pk2(v[j].z, v[j].w); o8[64 * j] = w; }
                sq = wave_sum(sq);
                if (lane == 0) *(f32x4*)(SSQM + (size_t)m * 4) = (f32x4){sq, 0.f, 0.f, 0.f};
#pragma unroll
                for (int j = 0; j < 4; ++j) v[j] = vn[j];
            }
        }
    }
    grid.sync();

    for (int l = 0; l < DEPTH; ++l) {
        { FRESH_LANE(); LAS float* tab = (LAS float*)(ldsl + TAB_OFF); for (int i = tid; i < 8 * 465; i += 512) tab[i] = na_rpb[l * 8 * 465 + i] * LOG2E; }
        __syncthreads();
        for (int grp = 0; grp < NGRP; ++grp) {
            const size_t tok0 = (size_t)grp * TG;
            const float* xsrc = (l == 0) ? x_in : xout;
            {
                pg8::Gemm g{XB + tok0 * DM, WinT + (size_t)l * INW * DM, DM, DM, DM, 1 << 30, 0}; pg8::StaticOrder S; S.init(TG, INW, G, bx);
                if (bx == 0) { FRESH_LANE(); NRMQ[tid] = 0u; NRMQ[tid + 512] = 0u; if (tid < 16) NRMQ[1024 + tid] = 0u; (void)lane; }
                pg8::Epi<0> E{PROJ, nullptr, nullptr, b_gate + l * 4096, INW, SSQM + tok0 * 4, nullptr, nullptr, nullptr};
                pg8::gemm_phase(ldsl, g, S, E);
            }
            xcd_barrier(xbar);
            {
                FRESH_LANE();
                const float inv = exp2f(-(float)(lane & 15) * 0.8304820237218406f);
                const float gq = qk_norm[l * 128 + lane], gk = qk_norm[l * 128 + 64 + lane];
                const int per = (TG + NGW - 1) / NGW;
                float mq = 0.f, mk = 0.f; int cu = -1;
                u32x4 qv, kv, qvn = {}, kvn = {}; unsigned short rw[10], rwn[10] = {};
#define P3_LOAD(QV, KV, RW, mm) do { const bf16_t* ar_ = PROJ + (size_t)(mm) * INW; QV = *(const u32x4*)(ar_ + COL_AQ + lane * 8); KV = *(const u32x4*)(ar_ + COL_AK + lane * 8); \
                    _Pragma("unroll") for (int hd = 0; hd < 10; ++hd) RW[hd] = ar_[COL_DQ + hd * 64 + lane]; } while (0)
                if (gw * per < TG) P3_LOAD(qv, kv, rw, gw * per);
                for (int i = 0; i < per; ++i) {
                    const int m = gw * per + i; if (m >= TG) break;
                    if (i + 1 < per && m + 1 < TG) P3_LOAD(qvn, kvn, rwn, m + 1);
                    if ((m >> 8) != cu) { if (cu >= 0 && (lane & 7) == 0) { atomicMax(NRMQ + cu * 8 + (lane >> 3), __float_as_uint(mq)); atomicMax(NRMK + (cu >> 5) * 8 + (lane >> 3), __float_as_uint(mk)); } cu = m >> 8; mq = 0.f; mk = 0.f; }
                    const int s = (int)((tok0 + m) % SEQ); const float pos = (float)((lane < 32) ? (s >> 6) : (s & 63));
                    float sn, cs; sincos_red(pos * inv, sn, cs);
                    { float nq = 0.f, nk = 0.f;
#pragma unroll
                      for (int e = 0; e < 4; ++e) { nq += bflo(qv[e]) * bflo(qv[e]) + bfhi(qv[e]) * bfhi(qv[e]); nk += bflo(kv[e]) * bflo(kv[e]) + bfhi(kv[e]) * bfhi(kv[e]); }
                      nq += __shfl_xor(nq, 1); nk += __shfl_xor(nk, 1); nq += __shfl_xor(nq, 2); nk += __shfl_xor(nk, 2); nq += __shfl_xor(nq, 4); nk += __shfl_xor(nk, 4);
                      mq = fmaxf(mq, sqrtf(nq)); mk = fmaxf(mk, sqrtf(nk)); }
                    bf16_t* row = PROJ + (size_t)m * INW + COL_DQ;
#pragma unroll
                    for (int hd = 0; hd < 10; ++hd) {
                        const float v = __uint_as_float((unsigned)rw[hd] << 16);
                        const float rn = rsqrtf(wave_sum(v * v) * (1.f / 64.f) + EPS);
                        const float y = v * rn * (hd < 8 ? gq : gk);
                        const float p = __shfl_xor(y, 16);
                        float o = ((lane >> 4) & 1) ? (y * cs + p * sn) : (y * cs - p * sn);
                        if (hd < 8) o *= C2;
                        row[hd * 64 + lane] = (bf16_t)f2bf(o);
                    }
                    qv = qvn; kv = kvn;
#pragma unroll
                    for (int hd = 0; hd < 10; ++hd) rw[hd] = rwn[hd];
                }
#undef P3_LOAD
                if (cu >= 0 && (lane & 7) == 0) { atomicMax(NRMQ + cu * 8 + (lane >> 3), __float_as_uint(mq)); atomicMax(NRMK + (cu >> 5) * 8 + (lane >> 3), __float_as_uint(mk)); }
            }
            xcd_barrier(xbar);
            {
                using namespace attn_body;
                char* shm = (char*)lds;
                {
                    unsigned* qctr = (unsigned*)(ws + WS_BAR) + 3584 + (l * NGRP + grp) * 8;
                    volatile LAS unsigned* slot = (volatile LAS unsigned*)(ldsl + MISC_OFF + 32);
                    const int myx = (G % 8 == 0) ? (vcu / (G / 8)) : 0;
                    int qq = 0;
                    for (;;) {
                        if (tid0 == 0) { int fj = -1, fx = 0;
                            for (; qq < 8; ++qq) { const int x_ = (myx + qq) & 7; const int j_ = (int)atomicAdd(qctr + x_, 1u); if (j_ < 288) { fj = j_; fx = x_; break; } }
                            slot[0] = (unsigned)fj; slot[1] = (unsigned)fx; }
                        __syncthreads();
                        const int j = (int)slot[0], sx = (int)slot[1];
                        __syncthreads();
                        if (j < 0) break;
                        if (j < 128) {
                            AttnArgs a{}; a.qs = INW; a.ks = INW; a.NT = 128; a.tlo = 0; a.thi = 127;
                            if (j >= 32 && j < 96) { const int qb = j & 31, ds = 2 * sx + ((j - 32) >> 5), bb = ds >> 3, h = ds & 7; const size_t tb = (size_t)bb * SEQ;
                                a.Q = (const bf16*)(PROJ + (tb + qb * 256) * INW + COL_DQ + h * 64); a.K = (const bf16*)(PROJ + tb * INW + COL_DK + (h >> 2) * 64);
                                a.V = (const bf16*)(PROJ + tb * INW + COL_DV + (h >> 2) * 64); a.O = (bf16*)(Y + (tb + qb * 256) * 2048 + 1536 + h * 64); a.os = 2048;
                                attn_unit<MD, 16>(a, shm);
                            } else {
                                int bb, hh, comp, qb;
                                if (j < 32) { bb = sx >> 2; hh = 2 + ((sx >> 1) & 1); comp = sx & 1; qb = j; }
                                else { const int s1 = sx >> 1; bb = s1 >> 1; comp = s1 & 1; hh = (j < 112) ? 1 : 0; qb = (sx & 1) * 16 + ((j - 96) & 15); }
                                const size_t tb = (size_t)bb * SEQ;
                                a.Q = (const bf16*)(PROJ + (tb + qb * 256) * INW + COL_AQ + hh * 128 + comp * 64); a.K = (const bf16*)(PROJ + tb * INW + COL_AK + hh * 128 + comp * 64);
                                a.V = (const bf16*)(PROJ + tb * INW + COL_AV + hh * 128); a.O = (bf16*)(ATMP + (tb + qb * 256) * 1024 + (hh * 2 + comp) * 128); a.os = 1024;
                                a.s2 = exp2f(-2.f * (float)(hh + 1)) * LOG2E;
                                const float Bs = __uint_as_float(NRMQ[(bb * 32 + qb) * 8 + hh * 2 + comp]) * __uint_as_float(NRMK[bb * 8 + hh * 2 + comp]) * 1.02f + 0.25f;
                                const float dlim = fminf((150.f + 2.f * Bs) / a.s2, 1.0e6f), q0f = (float)(qb * 256);
                                int tlo = max(0, (int)floorf((q0f - 63.f - dlim) * (1.f / 64.f))), thi = min(127, (int)ceilf((q0f + 255.f + dlim) * (1.f / 64.f)));
                                if (((thi - tlo + 1) & 1) != 0) { if (tlo > 0) --tlo; else ++thi; }
                                tlo = __builtin_amdgcn_readfirstlane(tlo); thi = __builtin_amdgcn_readfirstlane(thi);
                                a.K += (size_t)tlo * 64 * INW; a.V += (size_t)tlo * 64 * INW; a.q0 = qb * 256 - 64 * tlo; a.NT = thi - tlo + 1;
                                attn_unit128<16>(a, shm);
                            }
                        } else if (j < 192) {
                            const int cs = 2 * sx + ((j - 128) >> 5), qb = (j - 128) & 31, bb = cs >> 3, h = cs & 7, r0 = 4 * qb, kb = min(max(r0 - 4, 0), 116); const size_t tb = (size_t)bb * SEQ;
                            AttnArgs a{}; a.qs = INW; a.ks = INW; a.os = 2048; a.NT = 12; a.tlo = 0; a.thi = 11; a.q0 = r0; a.kb = kb;
                            a.Q = (const bf16*)(PROJ + (tb + r0 * 64) * INW + COL_CQ + h * 64); a.K = (const bf16*)(PROJ + (tb + kb * 64) * INW + COL_CK + h * 64);
                            a.V = (const bf16*)(PROJ + (tb + kb * 64) * INW + COL_CV + h * 64); a.O = (bf16*)(Y + (tb + r0 * 64) * 2048 + 1024 + h * 64);
                            a.tab = (lds_fptr)((lds_cptr)shm + TAB_OFF) + h * 465;
                            attn_unit<MC, 8>(a, shm);
                        } else {
                            const int p = j - 192, sg = 6 * sx + (p >> 4);
                            for (int e = 0; e < 2; ++e) {
                                const int blk = 2 * (p & 15) + e, bb = sg / 24, k = sg % 24, gp = k >> 3, h = k & 7, dsh = 2 * gp, dil = 1 << dsh;
                                const int nblk = 32 >> dsh, res = blk / nblk, i0 = (blk % nblk) * 256, L = SEQ >> dsh;
                                const long tq = (long)bb * SEQ + res + (long)i0 * dil, tk = (long)bb * SEQ + res + (long)(i0 - 64) * dil;
                                AttnArgs a{}; a.qs = dil * INW; a.ks = dil * INW; a.os = dil * 1536; a.NT = 6; a.tlo = (i0 == 0) ? 1 : 0; a.thi = (i0 + 256 == L) ? 4 : 5;
                                const int cq = COL_B + gp * 1536 + h * 64;
                                a.Q = (const bf16*)(PROJ + tq * INW + cq); a.K = (const bf16*)(PROJ + tk * INW + cq + 512); a.V = (const bf16*)(PROJ + tk * INW + cq + 1024);
                                a.O = (bf16*)(BTMP + tq * 1536 + gp * 512 + h * 64);
                                a.s2 = exp2f(-(float)(h + 1)) * (float)dil * LOG2E; a.stat = STAT + (tq * 24 + gp * 8 + h) * 2; a.ss = dil * 48;
                                attn_unit<MB, 8>(a, shm);
                            }
                        }
                    }
                }
            }
            xcd_barrier(xbar);
            {
                FRESH_LANE();
                int l_ = l; asm volatile("" : "+s"(l_));
                const float lam_init = (l_ == 0) ? 0.2f : (0.8f - 0.6f * 0.7408182206817179f);
                float lam;
                { const float* lp = diff_lambda + l * 256; const float a = lp[lane] * lp[64 + lane], b = lp[128 + lane] * lp[192 + lane]; lam = expf(wave_sum(a)) - expf(wave_sum(b)) + lam_init; lam = __uint_as_float(__builtin_amdgcn_readfirstlane(__float_as_uint(lam))); }
                const float out_scale = 1.f - lam_init;
                const float g0 = diff_subln[l * 128 + 2 * lane], g1 = diff_subln[l * 128 + 2 * lane + 1];
                const int h = lane >> 3, d8 = (lane & 7) * 8;
                unsigned aw[8]; u32x4 bw[3]; float sv[6];
#define P5_LOAD(AW, BW, SV, mm) do { const unsigned* at_ = (const unsigned*)(ATMP + (size_t)(mm) * 1024); _Pragma("unroll") for (int q = 0; q < 8; ++q) AW[q] = at_[q * 64 + lane]; \
                    const bf16_t* bt_ = BTMP + (size_t)(mm) * 1536 + h * 64 + d8; _Pragma("unroll") for (int g = 0; g < 3; ++g) BW[g] = *(const u32x4*)(bt_ + g * 512); \
                    const float* st_ = STAT + (size_t)(mm) * 48 + h * 2; _Pragma("unroll") for (int g = 0; g < 3; ++g) { SV[2 * g] = st_[16 * g]; SV[2 * g + 1] = st_[16 * g + 1]; } } while (0)
                for (int m = gw; m < TG; m += NGW) {
                    P5_LOAD(aw, bw, sv, m);
                    unsigned* yr = (unsigned*)(Y + (size_t)m * 2048);
#pragma unroll
                    for (int hh = 0; hh < 4; ++hh) {
                        const unsigned w0 = aw[hh * 2], w1 = aw[hh * 2 + 1];
                        const float d0 = bflo(w0) - lam * bflo(w1), d1 = bfhi(w0) - lam * bfhi(w1);
                        const float rn = rsqrtf(wave_sum(d0 * d0 + d1 * d1) * (1.f / 128.f) + EPS) * out_scale;
                        yr[hh * 64 + lane] = pk2(d0 * rn * g0, d1 * rn * g1);
                    }
                    const float m0 = sv[0], l0 = sv[1], m1 = sv[2], l1 = sv[3], m2 = sv[4], l2 = sv[5];
                    const float ms = fmaxf(m0, fmaxf(m1, m2));
                    const float w0 = l0 * exp2f(m0 - ms), w1 = l1 * exp2f(m1 - ms), w2 = l2 * exp2f(m2 - ms); const float inv = 1.f / (w0 + w1 + w2);
                    const u32x4 a0 = bw[0], a1 = bw[1], a2 = bw[2];
                    u32x4 o;
#pragma unroll
                    for (int e = 0; e < 4; ++e) { const float lo = (w0 * bflo(a0[e]) + w1 * bflo(a1[e]) + w2 * bflo(a2[e])) * inv, hi = (w0 * bfhi(a0[e]) + w1 * bfhi(a1[e]) + w2 * bfhi(a2[e])) * inv; o[e] = pk2(lo, hi); }
                    *(u32x4*)(Y + (size_t)m * 2048 + 512 + h * 64 + d8) = o;
                }
#undef P5_LOAD
            }
            xcd_barrier(xbar);
            {
                pg8::Gemm g{Y, WbrT + (size_t)l * 4096 * 512, 2048, 512, 512, 4, 512}; pg8::StaticOrder S; S.init(TG, 4096, G, bx);
                pg8::Epi<1> E{Z, nullptr, nullptr, nullptr, 4096, nullptr, nullptr, nullptr, nullptr};
                pg8::gemm_phase(ldsl, g, S, E);
            }
            xcd_barrier(xbar);
            { FRESH_LANE();
            u32x4 gv[2][4], zv[2][4];
#define P7_LOAD(GV, ZV, mm) do { const bf16_t* gr_ = PROJ + (size_t)(mm) * INW + COL_GATE + lane * 8; const bf16_t* zr_ = Z + (size_t)(mm) * 4096 + lane * 8; \
                _Pragma("unroll") for (int jj = 0; jj < 2; ++jj) _Pragma("unroll") for (int n = 0; n < 4; ++n) { GV[jj][n] = *(const u32x4*)(gr_ + n * 1024 + jj * 512); ZV[jj][n] = *(const u32x4*)(zr_ + n * 1024 + jj * 512); } } while (0)
            for (int m = gw; m < TG; m += NGW) {
                P7_LOAD(gv, zv, m);
#pragma unroll
                for (int j = 0; j < 2; ++j) { const int c = lane * 8 + j * 512; float acc[8] = {0.f, 0.f, 0.f, 0.f, 0.f, 0.f, 0.f, 0.f};
#pragma unroll
                    for (int n = 0; n < 4; ++n) {
#pragma unroll
                        for (int e = 0; e < 4; ++e) { acc[2 * e] += bflo(gv[j][n][e]) * bflo(zv[j][n][e]); acc[2 * e + 1] += bfhi(gv[j][n][e]) * bfhi(zv[j][n][e]); } }
                    u32x4 o; o.x = pk2(acc[0], acc[1]); o.y = pk2(acc[2], acc[3]); o.z = pk2(acc[4], acc[5]); o.w = pk2(acc[6], acc[7]);
                    *(u32x4*)(MERGED + (size_t)m * DM + c) = o; }
#undef P7_LOAD
            } }
            xcd_barrier(xbar);
            {
                pg8::Gemm g{MERGED, WoutT + (size_t)l * DM * DM, DM, DM, DM, 1 << 30, 0}; pg8::StaticOrder S; S.init(TG, DM, G, bx);
                pg8::Epi<3> E{nullptr, xout + tok0 * DM, xsrc + tok0 * DM, nullptr, DM, nullptr, H, SSQF, (LAS float*)(ldsl + SSQ_OFF)};
                pg8::gemm_phase(ldsl, g, S, E);
            }
            xcd_barrier(xbar);
            {
                pg8::Gemm g{H, W1T + (size_t)l * DFF * DM, DM, DM, DM, 1 << 30, 0}; pg8::StaticOrder S; S.init(TG, DFF, G, bx);
                pg8::Epi<2> E{U, nullptr, nullptr, nullptr, DFF, SSQF, nullptr, nullptr, nullptr};
                pg8::gemm_phase(ldsl, g, S, E);
            }
            xcd_barrier(xbar);
            {
                pg8::Gemm g{U, W2T + (size_t)l * DM * DFF, DFF, DFF, DFF, 1 << 30, 0}; pg8::StaticOrder S; S.init(TG, DM, G, bx);
                pg8::Epi<3> E{nullptr, xout + tok0 * DM, xout + tok0 * DM, nullptr, DM, nullptr, XB + tok0 * DM, SSQM + tok0 * 4, (LAS float*)(ldsl + SSQ_OFF)};
                pg8::gemm_phase(ldsl, g, S, E);
            }
            if (l == DEPTH - 1 && grp == NGRP - 1) xcd_barrier(xbar);
        }
    }
    {
        FRESH_LANE();
        const f32x4* g4 = (const f32x4*)norm_final + lane; f32x4 gg[4];
#pragma unroll
        for (int j = 0; j < 4; ++j) gg[j] = g4[64 * j];
        f32x4 v[4], vn[4] = {};
        if (gw < NTOK) { const f32x4* o = (const f32x4*)(xout + (size_t)gw * DM) + lane;
#pragma unroll
            for (int j = 0; j < 4; ++j) v[j] = o[64 * j]; }
        for (int m = gw; m < NTOK; m += NGW) {
            if (m + NGW < NTOK) { const f32x4* on = (const f32x4*)(xout + (size_t)(m + NGW) * DM) + lane;
#pragma unroll
                for (int j = 0; j < 4; ++j) vn[j] = on[64 * j]; }
            f32x4* o = (f32x4*)(xout + (size_t)m * DM) + lane; float sq = 0.f;
#pragma unroll
            for (int j = 0; j < 4; ++j) sq += (v[j].x * v[j].x + v[j].y * v[j].y) + (v[j].z * v[j].z + v[j].w * v[j].w);
            const float r = rsqrtf(wave_sum(sq) * (1.f / DM) + EPS);
#pragma unroll
            for (int j = 0; j < 4; ++j) o[64 * j] = (f32x4){v[j].x * r * gg[j].x, v[j].y * r * gg[j].y, v[j].z * r * gg[j].z, v[j].w * r * gg[j].w};
#pragma unroll
            for (int j = 0; j < 4; ++j) v[j] = vn[j];
        }
    }
}

#undef ws
#undef x_in
#undef norm_mix
#undef w_in
#undef b_gate
#undef diff_lambda
#undef diff_subln
#undef na_rpb
#undef qk_norm
#undef w_branch
#undef w_out
#undef norm_ffn
#undef w_ff1
#undef w_ff2
#undef norm_final
#undef xout
#undef WinT
#undef WbrT
#undef WoutT
#undef W1T
#undef W2T
#undef STAT
#undef H
#undef ATMP
#undef BTMP
#undef Y
#undef MERGED
#undef Z
#undef U
#undef PROJ
#undef NRMQ
#undef XB
#undef SSQM
#undef SSQF
#undef NRMK

extern "C" void kernel_launch(void* const* d_in, const int* in_sizes, int n_in, void* d_out, int out_size, void* d_ws, size_t ws_size, hipStream_t stream) {
    static int grid_blocks = 0;
    if (!grid_blocks) {
        int dev = 0, cus = 0, per_cu = 0;
        (void)hipGetDevice(&dev);
        (void)hipDeviceGetAttribute(&cus, hipDeviceAttributeMultiprocessorCount, dev);
        (void)hipFuncSetAttribute((const void*)mk_fwd, hipFuncAttributeMaxDynamicSharedMemorySize, LDS_BYTES);
        (void)hipOccupancyMaxActiveBlocksPerMultiprocessor(&per_cu, (const void*)mk_fwd, 512, LDS_BYTES);
        if (per_cu < 1) per_cu = 1;
        grid_blocks = cus * per_cu;
        if (ws_size < WS_END || n_in != 14) { fprintf(stderr, "kernel_launch: workspace %zu < %zu or n_in %d != 14\n", ws_size, (size_t)WS_END, n_in); grid_blocks = -1; }
    }
    if (grid_blocks < 0) return;
    (void)hipMemsetAsync((char*)d_ws + WS_BAR, 0, 16384, stream);
    Args a{};
    for (int i = 0; i < 14; ++i) a.in[i] = (const float*)d_in[i];
    a.out = (float*)d_out; a.ws = (unsigned char*)d_ws;
    void* kargs[] = {&a};
    hipError_t e = hipLaunchCooperativeKernel((const void*)mk_fwd, dim3(grid_blocks), dim3(512), kargs, LDS_BYTES, stream);
    if (e != hipSuccess) fprintf(stderr, "cooperative launch failed: %s (grid %d)\n", hipGetErrorString(e), grid_blocks);
}
```

```cpp
#include <hip/hip_runtime.h>
#include <hip/hip_cooperative_groups.h>
#include <hip/hip_bf16.h>
#include <cstdio>
#include <cstdint>
#include <cmath>
namespace cg = cooperative_groups;

constexpr int BATCH = 8, SEQ = 8192, DM = 1024, NTOK = BATCH * SEQ, INW = 12544, DFF = 4096, DEPTH = 2;
constexpr int GB = 2, TG = GB * SEQ, NGRP = BATCH / GB;
constexpr float EPS = 1e-6f;
constexpr float LOG2E = 1.4426950408889634f;
constexpr float C2 = 0.125f * LOG2E;
constexpr int COL_AQ = 0, COL_AK = 512, COL_AV = 1024, COL_B = 1536, COL_CQ = 6144, COL_CK = 6656, COL_CV = 7168, COL_DQ = 7680, COL_DK = 8192, COL_DV = 8320, COL_GATE = 8448;
constexpr size_t MiB = 1u << 20;
constexpr size_t WS_WIN = 0, WS_WBR = 49 * MiB, WS_WOUT = 57 * MiB, WS_W1 = 61 * MiB, WS_W2 = 77 * MiB, WS_STAT = 93 * MiB, WS_H = 96 * MiB, WS_ATMP = 128 * MiB,
                 WS_BTMP = 160 * MiB, WS_Y = 208 * MiB, WS_MERGED = 272 * MiB, WS_Z = 304 * MiB, WS_PROJ = 432 * MiB, WS_NRM = 824 * MiB, WS_BAR = 824 * MiB + 512 * 1024, WS_SSQM = 825 * MiB, WS_SSQF = 826 * MiB, WS_XB = 827 * MiB, WS_END = 955 * MiB;
constexpr int LDS_BYTES = 151552, TAB_OFF = 131072, MISC_OFF = 147072, SSQ_OFF = 147456;

#define LAS __attribute__((address_space(3)))
typedef unsigned short bf16_t;
typedef short bf16x8 __attribute__((ext_vector_type(8)));
typedef float f32x4 __attribute__((ext_vector_type(4)));
typedef unsigned u32x4 __attribute__((ext_vector_type(4)));
typedef unsigned u32x2 __attribute__((ext_vector_type(2)));

__device__ __forceinline__ unsigned f2bf(float f) { unsigned u = __builtin_bit_cast(unsigned, f); return (u + 0x7fffu + ((u >> 16) & 1u)) >> 16; }
__device__ __forceinline__ unsigned pk2(float lo, float hi) { return f2bf(lo) | (f2bf(hi) << 16); }
__device__ __forceinline__ float bflo(unsigned w) { return __uint_as_float(w << 16); }
__device__ __forceinline__ float bfhi(unsigned w) { return __uint_as_float(w & 0xffff0000u); }
__device__ __forceinline__ float wave_sum(float v) {
#pragma unroll
    for (int o = 1; o < 64; o <<= 1) v += __shfl_xor(v, o);
    return v;
}

namespace pg8 {
constexpr int BM = 256, BK = 64, HALF = 128, HTB = HALF * BK * 2, STAGE_BYTES = 8 * HTB, NXCD = 8, WGM = 4;
__host__ __device__ __forceinline__ int lds_byte(int r, int c) { const int st = (r >> 4) * 2 + (c >> 5), rr = r & 15, cc = c & 31, ob = rr * 64 + cc * 2; return st * 1024 + (ob ^ (((ob >> 9) & 1) << 5)); }
__host__ __device__ __forceinline__ void stage_rc(int b, int& R, int& C) { const int st = b / 1024, sb = b % 1024, swz = sb ^ (((sb >> 9) & 1) << 5); R = (st >> 1) * 16 + swz / 64; C = (st & 1) * 32 + (swz % 64) / 2; }
__host__ __device__ __forceinline__ int perm32(int rho) { const int n = rho >> 4, i = rho & 15; return 8 * (i >> 2) + 4 * n + (i & 3); }

struct Unit { int pm, pn; };
struct Gemm { const bf16_t* A; const bf16_t* Bt; int lda, ldb, K, adiv, astride; };

struct StaticOrder {
    int nM, nN, nwg, G, c;
    __device__ void init(int M, int N, int G_, int c_) { nM = M / BM; nN = N / BM; nwg = nM * nN; G = G_; c = c_; }
    __device__ bool next(int i, Unit& u) const {
        const long L = (long)i * G + c; if (L >= nwg) return false;
        int wgid = (int)L; { const int q = nwg / NXCD, r = nwg % NXCD, xcd = wgid % NXCD, off = wgid / NXCD; wgid = (xcd < r ? xcd * (q + 1) : r * (q + 1) + (xcd - r) * q) + off; }
        const int nig = WGM * nN, gid = wgid / nig, fm = gid * WGM, gsz = (nM - fm) < WGM ? (nM - fm) : WGM;
        u.pm = fm + ((wgid % nig) % gsz); u.pn = (wgid % nig) / gsz; return true;
    }
};

__device__ __forceinline__ unsigned cvt_pk_bf16(float lo, float hi) { unsigned r; asm volatile("v_cvt_pk_bf16_f32 %0, %1, %2" : "=v"(r) : "v"(lo), "v"(hi)); return r; }

template <int MODE> struct Epi {
    bf16_t* O; float* Of; const float* base; const float* bias; int ldc;
    const float* ssq;
    bf16_t* XBo; float* SSQo; LAS float* lx;
    __device__ __forceinline__ void operator()(const f32x4 (&acc)[2][2][4][2], const Unit& u, int wr, int wc, int fr, int fq) const {
        const int row0 = u.pm * BM + wr * 64 + fr, col0 = u.pn * BM + wc * 32 + 8 * fq;
        int kind = 0; float sc = 1.f;
        if (MODE == 0) { const int pn = u.pn; if (pn >= 33) kind = 2; else if (pn < 2 || pn == 6 || pn == 7 || pn == 12 || pn == 13 || pn == 18 || pn == 19 || pn == 24 || pn == 25) sc = C2; }
        float rsv[2][4]; f32x4 bv[2][2];
#pragma unroll
        for (int ai = 0; ai < 2; ++ai)
#pragma unroll
            for (int m = 0; m < 4; ++m) { rsv[ai][m] = 1.f;
                if (MODE == 0 || MODE == 2) { const f32x4 q = *(const f32x4*)(ssq + (size_t)(row0 + ai * HALF + m * 16) * 4); rsv[ai][m] = rsqrtf(((q[0] + q[1]) + (q[2] + q[3])) * (1.f / 1024.f) + EPS); } }
#pragma unroll
        for (int bj = 0; bj < 2; ++bj)
#pragma unroll
            for (int n = 0; n < 2; ++n) { bv[bj][n] = (f32x4){0.f, 0.f, 0.f, 0.f}; if (MODE == 0) { if (kind == 2) bv[bj][n] = *(const f32x4*)(bias + col0 + bj * HALF - COL_GATE + 4 * n); } }
        f32x4 nb[2][2];
        if (MODE == 3) {
#pragma unroll
            for (int bj = 0; bj < 2; ++bj)
#pragma unroll
                for (int n = 0; n < 2; ++n) nb[bj][n] = *(const f32x4*)(base + (size_t)row0 * ldc + col0 + bj * HALF + 4 * n);
        }
#pragma unroll
        for (int ai = 0; ai < 2; ++ai)
#pragma unroll
            for (int m = 0; m < 4; ++m) { const size_t roff = (size_t)(row0 + ai * HALF + m * 16) * ldc; float psq = 0.f; const float rs = rsv[ai][m];
                f32x4 cb[2][2];
                if (MODE == 3) {
#pragma unroll
                    for (int bj = 0; bj < 2; ++bj)
#pragma unroll
                        for (int n = 0; n < 2; ++n) cb[bj][n] = nb[bj][n];
                    const int g1 = ai * 4 + m + 1;
                    if (g1 < 8) { const size_t r1 = (size_t)(row0 + (g1 >> 2) * HALF + (g1 & 3) * 16) * ldc;
#pragma unroll
                        for (int bj = 0; bj < 2; ++bj)
#pragma unroll
                            for (int n = 0; n < 2; ++n) nb[bj][n] = *(const f32x4*)(base + r1 + col0 + bj * HALF + 4 * n); }
                }
#pragma unroll
                for (int bj = 0; bj < 2; ++bj) { const int col = col0 + bj * HALF; f32x4 v0 = acc[ai][bj][m][0], v1 = acc[ai][bj][m][1];
                    if (MODE == 3) {
                        v0 = cb[bj][0] + v0; v1 = cb[bj][1] + v1;
                        *(f32x4*)(Of + roff + col) = v0; *(f32x4*)(Of + roff + col + 4) = v1;
                        psq += (v0[0] * v0[0] + v0[1] * v0[1]) + (v0[2] * v0[2] + v0[3] * v0[3]) + (v1[0] * v1[0] + v1[1] * v1[1]) + (v1[2] * v1[2] + v1[3] * v1[3]);
                        u32x4 w; w.x = cvt_pk_bf16(v0[0], v0[1]); w.y = cvt_pk_bf16(v0[2], v0[3]); w.z = cvt_pk_bf16(v1[0], v1[1]); w.w = cvt_pk_bf16(v1[2], v1[3]);
                        *(u32x4*)(XBo + roff + col) = w;
                    } else {
                        if (MODE == 0 || MODE == 2) { v0 = v0 * rs; v1 = v1 * rs; }
                        if (MODE == 0) {
                            if (kind == 2) {
#pragma unroll
                                for (int e = 0; e < 4; ++e) { v0[e] = 1.f / (1.f + __expf(-(v0[e] + bv[bj][0][e]))); v1[e] = 1.f / (1.f + __expf(-(v1[e] + bv[bj][1][e]))); } }
                            else { v0 = v0 * sc; v1 = v1 * sc; }
                        }
                        if (MODE == 2) {
#pragma unroll
                            for (int e = 0; e < 4; ++e) { const float a = fmaxf(v0[e], 0.f), b = fmaxf(v1[e], 0.f); v0[e] = a * a; v1[e] = b * b; } }
                        u32x4 w; w.x = cvt_pk_bf16(v0[0], v0[1]); w.y = cvt_pk_bf16(v0[2], v0[3]); w.z = cvt_pk_bf16(v1[0], v1[1]); w.w = cvt_pk_bf16(v1[2], v1[3]);
                        *(u32x4*)(O + roff + col) = w;
                    } }
                if (MODE == 3) { psq += __shfl_xor(psq, 16); psq += __shfl_xor(psq, 32); if (fq == 0) lx[(ai * HALF + wr * 64 + m * 16 + fr) * 4 + wc] = psq; }
            }
        if (MODE == 3) {
            asm volatile("s_waitcnt lgkmcnt(0)" ::: "memory"); __builtin_amdgcn_s_barrier(); asm volatile("" ::: "memory");
            const int t = threadIdx.x;
            if (t < 256) { const f32x4 q = *(const LAS f32x4*)(lx + t * 4); SSQo[(size_t)(u.pm * BM + t) * 4 + u.pn] = (q[0] + q[1]) + (q[2] + q[3]); }
        }
    }
};

template <class EpiT>
__device__ __forceinline__ void gemm_phase(LAS unsigned char* lds, const Gemm g, const StaticOrder& S, const EpiT& E) {
    int tid_ = threadIdx.x; asm volatile("" : "+v"(tid_));
    const int tid = tid_, wid = __builtin_amdgcn_readfirstlane(tid >> 6), lane = tid & 63, wr = wid >> 2, wc = wid & 3, fr = lane & 15, fq = lane >> 4;
    const int K = g.K, nt = K / BK;
    unsigned voffA[2], voffB[2];
#pragma unroll
    for (int i = 0; i < 2; ++i) { int R, C; stage_rc(tid * 16 + i * 8192, R, C); const int Rb = (R & ~31) + perm32(R & 31);
        voffA[i] = (unsigned)(R * g.lda + C) * 2u; voffB[i] = (unsigned)(Rb * g.ldb + C) * 2u; }
    const size_t kstep = (size_t)(BK * 2);
    const size_t hA = (size_t)HALF * g.lda * 2, hB = (size_t)HALF * g.ldb * 2;
    const size_t tA = 2 * hA, tB = 2 * hB;
    const unsigned ldsw = (unsigned)wid * 1024u;
    const int aoff = lds_byte(wr * 64 + fr, fq * 8), boff = lds_byte(wc * 32 + fr, fq * 8);
#define PG8_SA(b, h) (((b) * 2 + (h)) * HTB)
#define PG8_SB(b, h) ((4 + (b) * 2 + (h)) * HTB)
#define PG8_STAGE(bufoff, gbase, voff) do { _Pragma("unroll") for (int _i = 0; _i < 2; ++_i) \
        __builtin_amdgcn_global_load_lds((const unsigned*)((const char*)(gbase) + (voff)[_i]), (LAS unsigned*)(lds + (bufoff) + ldsw + _i * 8192), 16, 0, 0); } while (0)
#define PG8_LDA(dst, b, h) do { _Pragma("unroll") for (int m = 0; m < 4; ++m) _Pragma("unroll") for (int k = 0; k < 2; ++k) dst[m][k] = *(const LAS bf16x8*)(lds + PG8_SA(b, h) + aoff + m * 2048 + k * 1024); } while (0)
#define PG8_LDB(dst, b, h) do { _Pragma("unroll") for (int n = 0; n < 2; ++n) _Pragma("unroll") for (int k = 0; k < 2; ++k) dst[n][k] = *(const LAS bf16x8*)(lds + PG8_SB(b, h) + boff + n * 2048 + k * 1024); } while (0)
#define PG8_MMA(ai, bj, At, Bt) do { __builtin_amdgcn_s_setprio(1); _Pragma("unroll") for (int m = 0; m < 4; ++m) _Pragma("unroll") for (int n = 0; n < 2; ++n) _Pragma("unroll") for (int k = 0; k < 2; ++k) \
        acc[ai][bj][m][n] = __builtin_amdgcn_mfma_f32_16x16x32_bf16(Bt[n][k], At[m][k], acc[ai][bj][m][n], 0, 0, 0); __builtin_amdgcn_s_setprio(0); } while (0)
#define PG8_WAIT_V(n) asm volatile("s_waitcnt vmcnt(" #n ")" ::: "memory")
#define PG8_WAIT_L(n) asm volatile("s_waitcnt lgkmcnt(" #n ")" ::: "memory")
#define PG8_BAR __builtin_amdgcn_s_barrier()
#define PG8_SCHED __builtin_amdgcn_sched_barrier(0)
#define PG8_PA(u) ((const char*)g.A + (size_t)(u).pm * tA + (size_t)((u).pn / g.adiv) * (size_t)g.astride * 2)
#define PG8_PB(u) ((const char*)g.Bt + (size_t)(u).pn * tB)
    Unit cur, nxt; int ui = 0;
    if (!S.next(0, cur)) return;
    f32x4 acc[2][2][4][2];
#pragma unroll
    for (int a = 0; a < 2; ++a)
#pragma unroll
        for (int b = 0; b < 2; ++b)
#pragma unroll
            for (int m = 0; m < 4; ++m)
#pragma unroll
                for (int n = 0; n < 2; ++n) acc[a][b][m][n] = (f32x4){0.f, 0.f, 0.f, 0.f};
    bf16x8 At[4][2], B0[2][2], B1[2][2];
    const char* cA = PG8_PA(cur); const char* cB = PG8_PB(cur);
    PG8_STAGE(PG8_SB(0, 0), cB, voffB); PG8_STAGE(PG8_SB(0, 1), cB + hB, voffB); PG8_STAGE(PG8_SA(0, 0), cA, voffA); PG8_STAGE(PG8_SA(0, 1), cA + hA, voffA);
    if (wr == 1) PG8_BAR;
    PG8_WAIT_V(2); PG8_BAR;
    PG8_STAGE(PG8_SB(1, 0), cB + kstep, voffB); PG8_STAGE(PG8_SA(1, 0), cA + kstep, voffA); PG8_STAGE(PG8_SB(1, 1), cB + hB + kstep, voffB);
    PG8_WAIT_V(6); PG8_BAR;
    for (;;) {
        const bool has_next = S.next(ui + 1, nxt);
        const char* nA = has_next ? PG8_PA(nxt) : cA; const char* nB = has_next ? PG8_PB(nxt) : cB;
        for (int t = 0; t < nt; t += 2) {
            const bool last = (t == nt - 2);
            const char* a1 = cA + (size_t)(t + 1) * kstep;
            const char* a2 = last ? nA : cA + (size_t)(t + 2) * kstep; const char* b2 = last ? nB : cB + (size_t)(t + 2) * kstep;
            const char* a3 = a2 + kstep; const char* b3 = b2 + kstep;
            PG8_LDB(B0, 0, 0); PG8_LDB(B1, 0, 1); PG8_SCHED; PG8_LDA(At, 0, 0); PG8_STAGE(PG8_SA(1, 1), a1 + hA, voffA);
            PG8_WAIT_V(8); PG8_WAIT_L(0); PG8_BAR; PG8_MMA(0, 0, At, B0); PG8_MMA(0, 1, At, B1); PG8_BAR; PG8_SCHED;
            PG8_LDA(At, 0, 1); PG8_STAGE(PG8_SB(0, 0), b2, voffB); PG8_STAGE(PG8_SB(0, 1), b2 + hB, voffB); PG8_STAGE(PG8_SA(0, 0), a2, voffA);
            PG8_WAIT_V(8); PG8_WAIT_L(0); PG8_BAR; PG8_MMA(1, 0, At, B0); PG8_MMA(1, 1, At, B1); PG8_BAR; PG8_SCHED;
            PG8_LDB(B0, 1, 0); PG8_LDB(B1, 1, 1); PG8_SCHED; PG8_LDA(At, 1, 0); PG8_STAGE(PG8_SA(0, 1), a2 + hA, voffA);
            PG8_WAIT_V(8); PG8_WAIT_L(0); PG8_BAR; PG8_MMA(0, 0, At, B0); PG8_MMA(0, 1, At, B1); PG8_BAR; PG8_SCHED;
            PG8_LDA(At, 1, 1); PG8_STAGE(PG8_SB(1, 0), b3, voffB); PG8_STAGE(PG8_SB(1, 1), b3 + hB, voffB); PG8_STAGE(PG8_SA(1, 0), a3, voffA);
            PG8_WAIT_V(8); PG8_WAIT_L(0); PG8_BAR; PG8_MMA(1, 0, At, B0); PG8_MMA(1, 1, At, B1); PG8_BAR; PG8_SCHED;
        }
        if (wr == 0) PG8_BAR;
        E(acc, cur, wr, wc, fr, fq);
        if (!has_next) break;
#pragma unroll
        for (int a = 0; a < 2; ++a)
#pragma unroll
            for (int b = 0; b < 2; ++b)
#pragma unroll
                for (int m = 0; m < 4; ++m)
#pragma unroll
                    for (int n = 0; n < 2; ++n) acc[a][b][m][n] = (f32x4){0.f, 0.f, 0.f, 0.f};
        cur = nxt; cA = nA; cB = nB; ++ui;
        if (wr == 1) PG8_BAR;
    }
    PG8_WAIT_V(0);
    PG8_BAR;
#undef PG8_SA
#undef PG8_SB
#undef PG8_STAGE
#undef PG8_LDA
#undef PG8_LDB
#undef PG8_MMA
#undef PG8_WAIT_V
#undef PG8_WAIT_L
#undef PG8_BAR
#undef PG8_SCHED
#undef PG8_PA
#undef PG8_PB
}
}

namespace attn_body {
using bf16 = __hip_bfloat16;
using s16x4 = __attribute__((ext_vector_type(4))) short;
using f32x16 = __attribute__((ext_vector_type(16))) float;
constexpr int NW = 8, QBLK = 32, QB = QBLK * NW, KVBLK = 64;
constexpr int MA = 0, MB = 1, MC = 2, MD = 3;
__device__ __forceinline__ int crow(int r, int hi) { return (r & 3) + 8 * (r >> 2) + 4 * hi; }
#define SBAR() __builtin_amdgcn_sched_barrier(0)
constexpr int NSLOT = 3, SLOTB = 8192;
constexpr int LDS_K = 0, LDS_V = NSLOT * SLOTB, LDS_WS = 2 * NSLOT * SLOTB, LDS_OST = LDS_WS + NW * 64 * 4, LDS_ATT = LDS_OST + NW * 4096;
typedef __attribute__((address_space(3))) const char* lds_cptr;
typedef __attribute__((address_space(3))) const float* lds_fptr;

struct AttnArgs {
    const bf16* Q; const bf16* K; const bf16* V; bf16* O;
    int qs, ks, os;
    int NT, tlo, thi;
    float s2;
    int q0;
    int kb;
    float* stat; int ss;
    lds_fptr tab;
};

__device__ __forceinline__ void glds16(const void* gsrc, unsigned lds_dst) { unsigned keep;
  asm volatile("s_mov_b32 %0, m0\n\ts_mov_b32 m0, %2\n\ts_nop 0\n\tglobal_load_lds_dwordx4 %1, off\n\ts_mov_b32 m0, %0" : "=&s"(keep) : "v"(gsrc), "s"(lds_dst) : "memory"); }
__device__ __forceinline__ float max3f(float a, float b, float c) { float r; asm("v_max3_f32 %0, %1, %2, %3" : "=v"(r) : "v"(a), "v"(b), "v"(c)); return r; }
__device__ __forceinline__ float max2f(float a, float b) { float r; asm("v_max_f32_e32 %0, %1, %2" : "=v"(r) : "v"(a), "v"(b)); return r; }
__device__ __forceinline__ float fadd_s(float a, float b) { float r; asm("v_add_f32_e32 %0, %1, %2" : "=v"(r) : "v"(a), "v"(b)); return r; }
__device__ __forceinline__ float fsub_s(float a, float b) { float r; asm("v_sub_f32_e32 %0, %1, %2" : "=v"(r) : "v"(a), "v"(b)); return r; }
typedef float f32x2_t __attribute__((ext_vector_type(2))); typedef __bf16 bf16x2_t __attribute__((ext_vector_type(2)));
__device__ __forceinline__ unsigned cvtpk_s(float lo, float hi) { f32x2_t v = {lo, hi}; bf16x2_t b = __builtin_convertvector(v, bf16x2_t); return __builtin_bit_cast(unsigned, b); }
#define WAIT_BAR(N) asm volatile("s_waitcnt vmcnt(" #N ") lgkmcnt(0)\n\ts_barrier" ::: "memory")

__device__ __forceinline__ void qkt(f32x16& p0, f32x16& p1, const char* Kslot, const bf16x8* qr, const f32x16& negm, int r32, int hi) {
  const char* kb = Kslot + hi * 1024 + r32 * 16;
  #pragma unroll
  for (int d0 = 0; d0 < 4; ++d0) {
    const bf16x8 b0 = *reinterpret_cast<const bf16x8*>(kb + d0 * 2048);
    const bf16x8 b1 = *reinterpret_cast<const bf16x8*>(kb + d0 * 2048 + 512);
    if (d0 == 0) { p0 = __builtin_amdgcn_mfma_f32_32x32x16_bf16(b0, qr[0], negm, 0, 0, 0); p1 = __builtin_amdgcn_mfma_f32_32x32x16_bf16(b1, qr[0], negm, 0, 0, 0); }
    else { p0 = __builtin_amdgcn_mfma_f32_32x32x16_bf16(b0, qr[d0], p0, 0, 0, 0); p1 = __builtin_amdgcn_mfma_f32_32x32x16_bf16(b1, qr[d0], p1, 0, 0, 0); } }
}
typedef short v4i16_t __attribute__((ext_vector_type(4)));
__device__ __forceinline__ void kload8(bf16x8* kf, lds_cptr kp) {
  kf[0] = *(const LAS bf16x8*)(kp);        kf[1] = *(const LAS bf16x8*)(kp + 512);
  kf[2] = *(const LAS bf16x8*)(kp + 2048); kf[3] = *(const LAS bf16x8*)(kp + 2560);
  kf[4] = *(const LAS bf16x8*)(kp + 4096); kf[5] = *(const LAS bf16x8*)(kp + 4608);
  kf[6] = *(const LAS bf16x8*)(kp + 6144); kf[7] = *(const LAS bf16x8*)(kp + 6656);
}
__device__ __forceinline__ void kload2(bf16x8* kf, lds_cptr kp, int j) { kf[2 * j] = *(const LAS bf16x8*)(kp + j * 2048); kf[2 * j + 1] = *(const LAS bf16x8*)(kp + j * 2048 + 512); }
__device__ __forceinline__ s16x4 vtr(lds_cptr p) { return __builtin_bit_cast(s16x4, __builtin_amdgcn_ds_read_tr16_b64_v4i16((LAS v4i16_t*)p)); }
__device__ __forceinline__ float rowmax(const f32x16& p0, const f32x16& p1) {
  float a = max3f(p0[0], p0[1], p1[0]), b = max3f(p0[2], p0[3], p1[1]); a = max3f(a, p1[2], p1[3]);
  #pragma unroll
  for (int r = 4; r < 16; r += 4) { a = max3f(a, p0[r], p0[r + 1]); b = max3f(b, p0[r + 2], p0[r + 3]); a = max3f(a, p1[r], p1[r + 1]); b = max3f(b, p1[r + 2], p1[r + 3]); }
  const float m = max2f(a, b);
  auto rr = __builtin_amdgcn_permlane32_swap(__float_as_uint(m), __float_as_uint(m), false, false);
  return max2f(__uint_as_float(rr[0]), __uint_as_float(rr[1]));
}
__device__ __forceinline__ void pv(f32x16* o, int vb, bf16x8 pa0, bf16x8 pa1, bf16x8 pa2, bf16x8 pa3) {
  #pragma unroll
  for (int d0 = 0; d0 < 2; ++d0) { s16x4 lo[4], hi[4];
    #pragma unroll
    for (int ks = 0; ks < 4; ++ks) {
      asm volatile("ds_read_b64_tr_b16 %0,%1 offset:%c2" : "=&v"(lo[ks]) : "v"(vb), "i"(d0 * 4096 + ks * 1024) : "memory");
      asm volatile("ds_read_b64_tr_b16 %0,%1 offset:%c2" : "=&v"(hi[ks]) : "v"(vb), "i"(d0 * 4096 + ks * 1024 + 512) : "memory"); }
    asm volatile("s_waitcnt lgkmcnt(0)" ::: "memory"); SBAR();
    #define PK(k) (bf16x8){lo[k][0], lo[k][1], lo[k][2], lo[k][3], hi[k][0], hi[k][1], hi[k][2], hi[k][3]}
    o[d0] = __builtin_amdgcn_mfma_f32_32x32x16_bf16(pa0, PK(0), o[d0], 0, 0, 0);
    o[d0] = __builtin_amdgcn_mfma_f32_32x32x16_bf16(pa1, PK(1), o[d0], 0, 0, 0);
    o[d0] = __builtin_amdgcn_mfma_f32_32x32x16_bf16(pa2, PK(2), o[d0], 0, 0, 0);
    o[d0] = __builtin_amdgcn_mfma_f32_32x32x16_bf16(pa3, PK(3), o[d0], 0, 0, 0);
    #undef PK
  }
}

__device__ __forceinline__ float opq(float x) { asm("" : "+v"(x)); return x; }
template <int MODE> __device__ __forceinline__ void score_hook(f32x16& c0, f32x16& c1, int t, const AttnArgs& a, int qrel, int hi, int wid, int r32, float mh) {
  if constexpr (MODE == MA) {
    const int wlo = a.q0 + wid * QBLK, sd = (64 * t + 63 < wlo) ? 1 : ((64 * t > wlo + 31) ? -1 : 0);
    if (sd != 0) { const float sv = (float)sd * a.s2;
      #pragma unroll
      for (int r = 0; r < 16; ++r) { const float kf = (float)((r & 3) + 8 * (r >> 2)); c0[r] = opq(fmaf(kf, sv, c0[r])); c1[r] = opq(fmaf(kf + 32.f, sv, c1[r])); if ((r & 3) == 3) __builtin_amdgcn_sched_barrier(0); }
    } else {
      const float dq = (float)(a.q0 + qrel - 64 * t - 4 * hi), ns = -a.s2;
      #pragma unroll
      for (int r = 0; r < 16; ++r) { const float kf = (float)((r & 3) + 8 * (r >> 2)); c0[r] = opq(fmaf(ns, fabsf(opq(dq - kf)), c0[r])); c1[r] = opq(fmaf(ns, fabsf(opq(dq - (kf + 32.f))), c1[r])); if ((r & 1) == 1) __builtin_amdgcn_sched_barrier(0); }
    }
  }
  if constexpr (MODE == MB) {
    const bool tv = (t >= a.tlo) && (t <= a.thi);
    const float dq = (float)(qrel + 64 - 64 * t - 4 * hi), ns = -a.s2;
    #pragma unroll
    for (int r = 0; r < 16; ++r) { const float kf = (float)((r & 3) + 8 * (r >> 2)); const float d0 = fabsf(opq(dq - kf)), d1 = fabsf(opq(dq - (kf + 32.f)));
      const float v0_ = opq(fmaf(ns, d0, opq(c0[r] - mh))), v1_ = opq(fmaf(ns, d1, opq(c1[r] - mh)));
      c0[r] = (tv && d0 <= 64.f) ? v0_ : -INFINITY; c1[r] = (tv && d1 <= 64.f) ? v1_ : -INFINITY;
      if ((r & 3) == 3) __builtin_amdgcn_sched_barrier(0); }
  }
  if constexpr (MODE == MC) {
    const int qrow = a.q0 + (wid >> 1), rs = min(max(qrow - 4, 0), 120), krow = a.kb + t;
    if (krow < rs || krow >= rs + 8) {
      #pragma unroll
      for (int r = 0; r < 16; ++r) { c0[r] = -INFINITY; c1[r] = -INFINITY; }
    } else {
      const int qc = (wid & 1) * 32 + r32, cs = min(max(qc - 8, 0), 48);
      const lds_fptr tp = a.tab + (krow - qrow + 7) * 31 + (15 - qc + 4 * hi);
      const int kd = 4 * hi - cs;
      #pragma unroll
      for (int r = 0; r < 16; ++r) { const int kc = (r & 3) + 8 * (r >> 2);
        const float b0 = tp[kc], b1 = tp[kc + 32];
        const float v0_ = opq(c0[r] + opq(b0 - mh)), v1_ = opq(c1[r] + opq(b1 - mh));
        c0[r] = ((unsigned)(kd + kc) < 16u) ? v0_ : -INFINITY; c1[r] = ((unsigned)(kd + kc + 32) < 16u) ? v1_ : -INFINITY;
        if ((r & 3) == 3) __builtin_amdgcn_sched_barrier(0); }
    }
  }
}

template <int MODE, int THRL> __device__ __forceinline__ void attn_unit(const AttnArgs& A_, char* shm) {
  int tid_ = threadIdx.x; asm volatile("" : "+v"(tid_));
  const int tid = tid_, lane = tid & 63, r32 = lane & 31, hi = lane >> 5; const int wid = __builtin_amdgcn_readfirstlane(tid >> 6);
  const bf16* Qw = A_.Q + (wid * QBLK) * A_.qs;
  const unsigned lds0 = (unsigned)(uintptr_t)shm;
  float* wsf = (float*)(shm + LDS_WS) + wid * 64;
  const int ks = A_.ks;
  const bf16* ksrc = A_.K + (lane * ks + wid * 8);
  const bf16* vsrc = A_.V + ((16 * (wid & 3) + (lane >> 2)) * ks + (wid >> 2) * 32 + (lane & 3) * 8);
  const unsigned kdst = lds0 + LDS_K + wid * 1024, vdst = lds0 + LDS_V + wid * 1024;
  #define TT(t) ((MODE == MB) ? min(max((int)(t), A_.tlo), A_.thi) : (int)(t))
  #define DMA_K(t, slot) glds16(ksrc + TT(t) * KVBLK * ks, (unsigned)__builtin_amdgcn_readfirstlane(kdst + (slot)))
  #define DMA_V(t, slot) glds16(vsrc + TT(t) * KVBLK * ks, (unsigned)__builtin_amdgcn_readfirstlane(vdst + (slot)))
  const int vb0 = (int)(lds0 + LDS_V) + ((lane >> 4) & 1) * 32 + (lane & 3) * 8 + (4 * hi + ((lane & 15) >> 2)) * 64;
  const char* Kbase = shm + LDS_K; bf16x8 kf[8];
  const lds_cptr shm3 = (lds_cptr)shm; const lds_cptr kp0 = shm3 + LDS_K + hi * 1024 + r32 * 16; const lds_cptr vp0 = shm3 + LDS_V + ((lane >> 4) & 1) * 32 + (lane & 3) * 8 + (4 * hi + ((lane & 15) >> 2)) * 64;
  const int NT = A_.NT;
  DMA_K(0, 0); DMA_V(0, 0); DMA_K(1, SLOTB);
  bf16x8 qr[4];
  #pragma unroll
  for (int d0 = 0; d0 < 4; ++d0) qr[d0] = *reinterpret_cast<const bf16x8*>(&Qw[r32 * A_.qs + d0 * 16 + hi * 8]);
  float mhat = 0.f, l_reg = 0.f; f32x16 o[2]; o[0] = f32x16{}; o[1] = f32x16{}; f32x16 negm = f32x16{}; asm volatile("" : "+v"(negm));
  const int qrel = wid * QBLK + r32;
  constexpr bool NEGM = (MODE == MA || MODE == MD);
  #define CIN (NEGM ? negm : f32x16{})
  #define NEGM_SET(tn) do { float nb_ = -mhat; \
      if (MODE == MA) { const int wlo_ = A_.q0 + wid * QBLK, sd_ = (64 * (tn) + 63 < wlo_) ? 1 : ((64 * (tn) > wlo_ + 31) ? -1 : 0); \
        if (sd_ != 0) nb_ = fmaf(-(float)sd_ * A_.s2, (float)(A_.q0 + qrel - 64 * (tn) - 4 * hi), nb_); } \
      _Pragma("unroll") for (int r = 0; r < 16; ++r) negm[r] = nb_; asm volatile("" : "+v"(negm)); } while (0)
  #define CMASK(P0, P1, t) score_hook<MODE>(P0, P1, (t), A_, qrel, hi, wid, r32, mhat)
  bool resc = false;
  #define START(P0, P1) do { const float rm = rowmax(P0, P1); resc = false; \
    { const float dl = (MODE == MB || MODE == MC) ? fmaxf(rm, -2048.f) : rm; mhat = fadd_s(mhat, dl); \
      _Pragma("unroll") for (int r = 0; r < 16; ++r) { P0[r] = fsub_s(P0[r], dl); P1[r] = fsub_s(P1[r], dl); } \
      if (NEGM) { NEGM_SET(1); } } \
    _Pragma("unroll") for (int r = 0; r < 16; ++r) P0[r] = __builtin_amdgcn_exp2f(P0[r]); } while (0)
  #define RESC() do { if (resc) { asm volatile("s_waitcnt lgkmcnt(0)" ::: "memory"); \
      _Pragma("unroll") for (int d_ = 0; d_ < 2; ++d_) _Pragma("unroll") for (int r = 0; r < 16; ++r) o[d_][r] *= wsf[crow(r, hi)]; } } while (0)
  f32x16 pA0, pA1, pB0, pB1;
  int sl_prev = 0, sl_cur = 0, sl_next = SLOTB;
  #define ROT() do { sl_prev = sl_cur; sl_cur = sl_next; sl_next = (sl_next == (NSLOT - 1) * SLOTB) ? 0 : sl_next + SLOTB; } while (0)
  DMA_K(2, 2 * SLOTB);
  if (MODE == MA) { NEGM_SET(0); }
  WAIT_BAR(3);
  qkt(pA0, pA1, Kbase, qr, negm, r32, hi); asm volatile("s_nop 15\n\ts_nop 7" : "+v"(pA0), "+v"(pA1)); CMASK(pA0, pA1, 0);
  START(pA0, pA1);
  _Pragma("unroll") for (int r = 0; r < 16; ++r) pA1[r] = __builtin_amdgcn_exp2f(pA1[r]);
  WAIT_BAR(0);
  DMA_K(3, 0); DMA_V(1, SLOTB);
  ROT();
  kload8(kf, kp0 + sl_cur);
  WAIT_BAR(2);
  s16x4 vlo[8], vhi[8]; u32x4 pw0, pw1, pw2, pw3;
  #define PKW(P, B) cvtpk_s(P[B], P[B + 1])
  #define PAF(k) __builtin_bit_cast(bf16x8, pw##k)
  #define VFR(i) (bf16x8){vlo[i][0], vlo[i][1], vlo[i][2], vlo[i][3], vhi[i][0], vhi[i][1], vhi[i][2], vhi[i][3]}
  #define PIN(x) asm volatile("" : "+v"(x))
  #define MX3(a, b, c) __builtin_fmaxf(__builtin_fmaxf((a), (b)), (c))
  #define GAPA(MF, A0, A1, A2, A3, W0, W1, PW) do { MF; sacc += A0; sacc += A1; sacc += A2; sacc += A3; PIN(sacc); W0; W1; PIN(PW); SBAR(); } while (0)
  #define EX(v) __builtin_amdgcn_exp2f(v)
  #define GAPB(MF, X, B) do { MF; X[B] = EX(X[B]); X[B + 1] = EX(X[B + 1]); X[B + 2] = EX(X[B + 2]); X[B + 3] = EX(X[B + 3]); PIN(X); SBAR(); } while (0)
  #define VRD(i) do { vlo[i] = vtr(vp_ + (((i) >> 2) * 4096 + ((i) & 3) * 1024)); vhi[i] = vtr(vp_ + (((i) >> 2) * 4096 + ((i) & 3) * 1024 + 512)); } while (0)
  #define KRD(G, j) do { if (G) { kload2(kf, kp0 + sl_next, j); SBAR(); } } while (0)
  #define STEP(C0, C1, P0, P1, t, GK, GV, GL) do { SBAR(); \
    const lds_cptr vp_ = vp0 + sl_prev; \
    VRD(0); SBAR(); float sacc = (P0[0] + P0[1]); \
    GAPA(C0 = __builtin_amdgcn_mfma_f32_32x32x16_bf16(kf[0], qr[0], CIN, 0, 0, 0), P0[2], P0[3], P0[4], P0[5],     pw0[0] = PKW(P0, 0), pw0[1] = PKW(P0, 2), pw0); \
    VRD(4); SBAR(); GAPA(C1 = __builtin_amdgcn_mfma_f32_32x32x16_bf16(kf[1], qr[0], CIN, 0, 0, 0), P0[6], P0[7], P0[8], P0[9],     pw0[2] = PKW(P0, 4), pw0[3] = PKW(P0, 6), pw0); \
    VRD(1); SBAR(); GAPA(C0 = __builtin_amdgcn_mfma_f32_32x32x16_bf16(kf[2], qr[1], C0, 0, 0, 0),   P0[10], P0[11], P0[12], P0[13], pw1[0] = PKW(P0, 8), pw1[1] = PKW(P0, 10), pw1); \
    VRD(5); SBAR(); GAPA(C1 = __builtin_amdgcn_mfma_f32_32x32x16_bf16(kf[3], qr[1], C1, 0, 0, 0),   P0[14], P0[15], P1[0], P1[1],   pw1[2] = PKW(P0, 12), pw1[3] = PKW(P0, 14), pw1); \
    VRD(2); SBAR(); GAPA(C0 = __builtin_amdgcn_mfma_f32_32x32x16_bf16(kf[4], qr[2], C0, 0, 0, 0),   P1[2], P1[3], P1[4], P1[5],     pw2[0] = PKW(P1, 0), pw2[1] = PKW(P1, 2), pw2); \
    VRD(6); SBAR(); GAPA(C1 = __builtin_amdgcn_mfma_f32_32x32x16_bf16(kf[5], qr[2], C1, 0, 0, 0),   P1[6], P1[7], P1[8], P1[9],     pw2[2] = PKW(P1, 4), pw2[3] = PKW(P1, 6), pw2); \
    VRD(3); SBAR(); GAPA(C0 = __builtin_amdgcn_mfma_f32_32x32x16_bf16(kf[6], qr[3], C0, 0, 0, 0),   P1[10], P1[11], P1[12], P1[13], pw3[0] = PKW(P1, 8), pw3[1] = PKW(P1, 10), pw3); \
    VRD(7); SBAR(); GAPA(C1 = __builtin_amdgcn_mfma_f32_32x32x16_bf16(kf[7], qr[3], C1, 0, 0, 0),   P1[14], P1[15], 0.f, 0.f,       pw3[2] = PKW(P1, 12), pw3[3] = PKW(P1, 14), pw3); \
    l_reg += sacc; \
    if (GK) { DMA_K((t) + 3, sl_cur); } if (GV) { DMA_V((t) + 1, sl_next); } \
    CMASK(C0, C1, t); \
    { float a = MX3(C0[0], C0[1], C1[0]), b = MX3(C0[2], C0[3], C1[1]); a = MX3(a, C1[2], C1[3]); \
      _Pragma("unroll") for (int r = 4; r < 16; r += 4) { a = MX3(a, C0[r], C0[r + 1]); b = MX3(b, C0[r + 2], C0[r + 3]); a = MX3(a, C1[r], C1[r + 1]); b = MX3(b, C1[r + 2], C1[r + 3]); } \
      float rm = __builtin_fmaxf(a, b); { auto rr = __builtin_amdgcn_permlane32_swap(__float_as_uint(rm), __float_as_uint(rm), false, false); rm = __builtin_fmaxf(__uint_as_float(rr[0]), __uint_as_float(rr[1])); } \
      resc = false; \
      if (__builtin_expect(__any(rm > (float)THRL), 0)) { const float dl = __builtin_fmaxf(rm, 0.f); mhat += dl; \
        _Pragma("unroll") for (int r = 0; r < 16; ++r) { C0[r] -= dl; C1[r] -= dl; } \
        if (MODE == MD) { NEGM_SET(0); } \
        const float f = __builtin_amdgcn_exp2f(-dl); l_reg *= f; if (hi == 0) wsf[r32] = f; resc = true; } \
      if (MODE == MA) { NEGM_SET((t) + 1); } } \
    SBAR(); \
    GAPB(o[0] = __builtin_amdgcn_mfma_f32_32x32x16_bf16(PAF(0), VFR(0), o[0], 0, 0, 0), C0, 0); \
    GAPB(o[1] = __builtin_amdgcn_mfma_f32_32x32x16_bf16(PAF(0), VFR(4), o[1], 0, 0, 0), C0, 4); \
    KRD(GL, 0); GAPB(o[0] = __builtin_amdgcn_mfma_f32_32x32x16_bf16(PAF(1), VFR(1), o[0], 0, 0, 0), C0, 8); \
    KRD(GL, 1); GAPB(o[1] = __builtin_amdgcn_mfma_f32_32x32x16_bf16(PAF(1), VFR(5), o[1], 0, 0, 0), C0, 12); \
    KRD(GL, 2); GAPB(o[0] = __builtin_amdgcn_mfma_f32_32x32x16_bf16(PAF(2), VFR(2), o[0], 0, 0, 0), C1, 0); \
    KRD(GL, 3); GAPB(o[1] = __builtin_amdgcn_mfma_f32_32x32x16_bf16(PAF(2), VFR(6), o[1], 0, 0, 0), C1, 4); \
    GAPB(o[0] = __builtin_amdgcn_mfma_f32_32x32x16_bf16(PAF(3), VFR(3), o[0], 0, 0, 0), C1, 8); \
    GAPB(o[1] = __builtin_amdgcn_mfma_f32_32x32x16_bf16(PAF(3), VFR(7), o[1], 0, 0, 0), C1, 12); \
    } while (0)
  int t = 1;
  for (; t + 5 < NT; t += 2) {
    STEP(pB0, pB1, pA0, pA1, t, true, true, true);     WAIT_BAR(2); RESC(); ROT();
    STEP(pA0, pA1, pB0, pB1, t + 1, true, true, true); WAIT_BAR(2); RESC(); ROT();
  }
  #define ENDW(tt) do { if ((tt) + 3 < NT) { WAIT_BAR(2); } else if ((tt) + 2 < NT) { WAIT_BAR(1); } else { WAIT_BAR(0); } } while (0)
  for (; t + 1 < NT; t += 2) {
    STEP(pB0, pB1, pA0, pA1, t, (t + 3 < NT), (t + 1 < NT), (t + 1 < NT));         ENDW(t);     RESC(); ROT();
    STEP(pA0, pA1, pB0, pB1, t + 1, (t + 4 < NT), (t + 2 < NT), (t + 2 < NT));     ENDW(t + 1); RESC(); ROT();
  }
  STEP(pB0, pB1, pA0, pA1, NT - 1, false, false, false); RESC();
  { float sacc = pB0[0] + pB0[1]; _Pragma("unroll") for (int r = 2; r < 16; ++r) sacc += pB0[r]; _Pragma("unroll") for (int r = 0; r < 16; ++r) sacc += pB1[r]; l_reg += sacc;
    pw0 = (u32x4){PKW(pB0, 0), PKW(pB0, 2), PKW(pB0, 4), PKW(pB0, 6)}; pw1 = (u32x4){PKW(pB0, 8), PKW(pB0, 10), PKW(pB0, 12), PKW(pB0, 14)}; pw2 = (u32x4){PKW(pB1, 0), PKW(pB1, 2), PKW(pB1, 4), PKW(pB1, 6)}; pw3 = (u32x4){PKW(pB1, 8), PKW(pB1, 10), PKW(pB1, 12), PKW(pB1, 14)};
    SBAR(); pv(o, vb0 + sl_cur, PAF(0), PAF(1), PAF(2), PAF(3)); }
  #undef PKW
  #undef PAF
  #undef VFR
  #undef PIN
  #undef MX3
  #undef GAPA
  #undef GAPB
  #undef EX
  #undef VRD
  #undef KRD
  #undef STEP
  #undef ENDW
  { auto rr = __builtin_amdgcn_permlane32_swap(__float_as_uint(l_reg), __float_as_uint(l_reg), false, false); l_reg = __uint_as_float(rr[0]) + __uint_as_float(rr[1]); }
  if (MODE == MB) { if (hi == 0) { float* sp = A_.stat + (wid * QBLK + r32) * A_.ss; sp[0] = mhat; sp[1] = l_reg; } }
  if (hi == 0) wsf[32 + r32] = l_reg; asm volatile("s_waitcnt lgkmcnt(0)" ::: "memory");
  float rli[16];
  #pragma unroll
  for (int r = 0; r < 16; ++r) rli[r] = __builtin_amdgcn_rcpf(wsf[32 + crow(r, hi)]);
  bf16* Ow = A_.O + (wid * QBLK) * A_.os;
  { bf16* stg = (bf16*)(shm + LDS_OST) + wid * 2048;
    #pragma unroll
    for (int r = 0; r < 16; ++r) { const int orow = crow(r, hi);
      #pragma unroll
      for (int d0 = 0; d0 < 2; ++d0) stg[orow * 64 + d0 * 32 + r32] = __float2bfloat16(o[d0][r] * rli[r]); }
    asm volatile("s_waitcnt lgkmcnt(0)" ::: "memory");
    #pragma unroll
    for (int i = 0; i < 4; ++i) { const int row = i * 8 + (lane >> 3), ch = lane & 7; const u32x4 v = *(const u32x4*)(stg + row * 64 + ch * 8); *(u32x4*)(Ow + row * A_.os + ch * 8) = v; } }
  asm volatile("s_waitcnt lgkmcnt(0)\n\ts_barrier" ::: "memory");
  #undef DMA_K
  #undef DMA_V
  #undef TT
  #undef CMASK
  #undef CIN
  #undef NEGM_SET
  #undef START
  #undef RESC
  #undef ROT
}

constexpr int L8_K = 0, L8_V = 3 * 8192, L8_WS = L8_V + 3 * 16384, L8_QO = L8_WS + 2048, L8_END = L8_QO + 8 * 4096;
template <int THRL> __device__ __forceinline__ void attn_unit128(const AttnArgs& A_, char* shm) {
  int tid_ = threadIdx.x; asm volatile("" : "+v"(tid_));
  const int tid = tid_, lane = tid & 63, r32 = lane & 31, hi = lane >> 5; const int wid = __builtin_amdgcn_readfirstlane(tid >> 6);
  const bf16* Qw = A_.Q + (wid * QBLK) * A_.qs;
  const unsigned lds0 = (unsigned)(uintptr_t)shm;
  float* wsf = (float*)(shm + L8_WS) + wid * 64;
  const int ks = A_.ks;
  const bf16* ksrc = A_.K + (lane * ks + wid * 8);
  const bf16* vsrc = A_.V + ((16 * (wid & 3) + (lane >> 2)) * ks + (wid >> 2) * 32 + (lane & 3) * 8);
  const unsigned kdst = lds0 + L8_K + wid * 1024, vdst = lds0 + L8_V + wid * 1024;
  #define DMA_K(t, slot) glds16(ksrc + (int)(t) * KVBLK * ks, (unsigned)__builtin_amdgcn_readfirstlane(kdst + (slot)))
  #define DMA_V(t, slot) do { glds16(vsrc + (int)(t) * KVBLK * ks, (unsigned)__builtin_amdgcn_readfirstlane(vdst + 2 * (slot))); \
                              glds16(vsrc + (int)(t) * KVBLK * ks + 64, (unsigned)__builtin_amdgcn_readfirstlane(vdst + 2 * (slot) + 8192)); } while (0)
  const int vb0 = (int)(lds0 + L8_V) + ((lane >> 4) & 1) * 32 + (lane & 3) * 8 + (4 * hi + ((lane & 15) >> 2)) * 64;
  const char* Kbase = shm + L8_K; bf16x8 kf[8];
  const lds_cptr shm3 = (lds_cptr)shm; const lds_cptr kp0 = shm3 + L8_K + hi * 1024 + r32 * 16; const lds_cptr vp0 = shm3 + L8_V + ((lane >> 4) & 1) * 32 + (lane & 3) * 8 + (4 * hi + ((lane & 15) >> 2)) * 64;
  const lds_cptr qst = shm3 + L8_QO + wid * 4096 + lane * 16;
  const int NT = A_.NT;
  DMA_K(0, 0); DMA_V(0, 0); DMA_K(1, SLOTB);
  { bf16x8 qr[4];
    #pragma unroll
    for (int d0 = 0; d0 < 4; ++d0) qr[d0] = *reinterpret_cast<const bf16x8*>(&Qw[r32 * A_.qs + d0 * 16 + hi * 8]);
    #pragma unroll
    for (int d0 = 0; d0 < 4; ++d0) *(LAS bf16x8*)(shm3 + L8_QO + wid * 4096 + lane * 16 + d0 * 1024) = qr[d0]; }
  #define QLD(d0) (*(const LAS bf16x8*)(qst + (d0) * 1024))
  float mhat = 0.f, l_reg = 0.f; f32x16 o[4]; o[0] = f32x16{}; o[1] = f32x16{}; o[2] = f32x16{}; o[3] = f32x16{};
  const int qrel = wid * QBLK + r32;
  #define NB(tn) ({ float nb_ = -mhat; const int wlo_ = A_.q0 + wid * QBLK, sd_ = (64 * (tn) + 63 < wlo_) ? 1 : ((64 * (tn) > wlo_ + 31) ? -1 : 0); \
      if (sd_ != 0) nb_ = fmaf(-(float)sd_ * A_.s2, (float)(A_.q0 + qrel - 64 * (tn) - 4 * hi), nb_); nb_; })
  #define CMASK(P0, P1, t) score_hook<MA>(P0, P1, (t), A_, qrel, hi, wid, r32, mhat)
  bool resc = false;
  #define RESC() do { if (resc) { asm volatile("s_waitcnt lgkmcnt(0)" ::: "memory"); \
      _Pragma("unroll") for (int d_ = 0; d_ < 4; ++d_) _Pragma("unroll") for (int r = 0; r < 16; ++r) o[d_][r] *= wsf[crow(r, hi)]; } } while (0)
  f32x16 pA0, pA1, pB0, pB1;
  int sl_prev = 0, sl_cur = 0, sl_next = SLOTB;
  #define ROT() do { sl_prev = sl_cur; sl_cur = sl_next; sl_next = (sl_next == (NSLOT - 1) * SLOTB) ? 0 : sl_next + SLOTB; } while (0)
  DMA_K(2, 2 * SLOTB);
  WAIT_BAR(4);
  { f32x16 cin; const float nb0 = NB(0);
    #pragma unroll
    for (int r = 0; r < 16; ++r) cin[r] = nb0;
    bf16x8 qr[4];
    #pragma unroll
    for (int d0 = 0; d0 < 4; ++d0) qr[d0] = QLD(d0);
    qkt(pA0, pA1, Kbase, qr, cin, r32, hi); }
  asm volatile("s_nop 15\n\ts_nop 7" : "+v"(pA0), "+v"(pA1)); CMASK(pA0, pA1, 0);
  { const float rm = rowmax(pA0, pA1); mhat = fadd_s(mhat, rm);
    #pragma unroll
    for (int r = 0; r < 16; ++r) { pA0[r] = fsub_s(pA0[r], rm); pA1[r] = fsub_s(pA1[r], rm); }
    #pragma unroll
    for (int r = 0; r < 16; ++r) pA0[r] = __builtin_amdgcn_exp2f(pA0[r]);
    #pragma unroll
    for (int r = 0; r < 16; ++r) pA1[r] = __builtin_amdgcn_exp2f(pA1[r]); }
  WAIT_BAR(0);
  DMA_K(3, 0); DMA_V(1, SLOTB);
  ROT();
  kload8(kf, kp0 + sl_cur);
  WAIT_BAR(3);
  u32x4 pw0, pw1, pw2, pw3;
  #define PKW(P, B) cvtpk_s(P[B], P[B + 1])
  #define PAF(k) __builtin_bit_cast(bf16x8, pw##k)
  #define PIN(x) asm volatile("" : "+v"(x))
  #define MX3(a, b, c) __builtin_fmaxf(__builtin_fmaxf((a), (b)), (c))
  #define GAPA(MF, A0, A1, A2, A3, W0, W1, PW) do { MF; sacc += A0; sacc += A1; sacc += A2; sacc += A3; PIN(sacc); W0; W1; PIN(PW); SBAR(); } while (0)
  #define EX(v) __builtin_amdgcn_exp2f(v)
  #define GAPB(MF, X, B) do { MF; X[B] = EX(X[B]); X[B + 1] = EX(X[B + 1]); PIN(X); SBAR(); } while (0)
  #define KRD(G, j) do { if (G) { kload2(kf, kp0 + sl_next, j); SBAR(); } } while (0)
  #define FOFF(j) (((((j) & 1) + 2 * ((j) >> 3)) * 4096) + ((((j) >> 1) & 3) * 1024))
  #define FRD(j) do { fl[j] = vtr(vp_ + FOFF(j)); fh[j] = vtr(vp_ + FOFF(j) + 512); SBAR(); } while (0)
  #define FFR(j) (bf16x8){fl[j][0], fl[j][1], fl[j][2], fl[j][3], fh[j][0], fh[j][1], fh[j][2], fh[j][3]}
  #define STEP(C0, C1, P0, P1, t, GK, GV, GL) do { SBAR(); \
    const lds_cptr vp_ = vp0 + 2 * sl_prev; s16x4 fl[16], fh[16]; \
    { const float nb_t = NB(t); _Pragma("unroll") for (int r = 0; r < 16; ++r) { C0[r] = nb_t; C1[r] = nb_t; } } \
    bf16x8 q0_ = QLD(0), q1_ = QLD(1); SBAR(); float sacc = (P0[0] + P0[1]); \
    GAPA(C0 = __builtin_amdgcn_mfma_f32_32x32x16_bf16(kf[0], q0_, C0, 0, 0, 0), P0[2], P0[3], P0[4], P0[5],     pw0[0] = PKW(P0, 0), pw0[1] = PKW(P0, 2), pw0); \
    GAPA(C1 = __builtin_amdgcn_mfma_f32_32x32x16_bf16(kf[1], q0_, C1, 0, 0, 0), P0[6], P0[7], P0[8], P0[9],     pw0[2] = PKW(P0, 4), pw0[3] = PKW(P0, 6), pw0); \
    q0_ = QLD(2); SBAR(); \
    GAPA(C0 = __builtin_amdgcn_mfma_f32_32x32x16_bf16(kf[2], q1_, C0, 0, 0, 0),   P0[10], P0[11], P0[12], P0[13], pw1[0] = PKW(P0, 8), pw1[1] = PKW(P0, 10), pw1); \
    GAPA(C1 = __builtin_amdgcn_mfma_f32_32x32x16_bf16(kf[3], q1_, C1, 0, 0, 0),   P0[14], P0[15], P1[0], P1[1],   pw1[2] = PKW(P0, 12), pw1[3] = PKW(P0, 14), pw1); \
    q1_ = QLD(3); SBAR(); \
    GAPA(C0 = __builtin_amdgcn_mfma_f32_32x32x16_bf16(kf[4], q0_, C0, 0, 0, 0),   P1[2], P1[3], P1[4], P1[5],     pw2[0] = PKW(P1, 0), pw2[1] = PKW(P1, 2), pw2); \
    GAPA(C1 = __builtin_amdgcn_mfma_f32_32x32x16_bf16(kf[5], q0_, C1, 0, 0, 0),   P1[6], P1[7], P1[8], P1[9],     pw2[2] = PKW(P1, 4), pw2[3] = PKW(P1, 6), pw2); \
    GAPA(C0 = __builtin_amdgcn_mfma_f32_32x32x16_bf16(kf[6], q1_, C0, 0, 0, 0),   P1[10], P1[11], P1[12], P1[13], pw3[0] = PKW(P1, 8), pw3[1] = PKW(P1, 10), pw3); \
    GAPA(C1 = __builtin_amdgcn_mfma_f32_32x32x16_bf16(kf[7], q1_, C1, 0, 0, 0),   P1[14], P1[15], 0.f, 0.f,       pw3[2] = PKW(P1, 12), pw3[3] = PKW(P1, 14), pw3); \
    l_reg += sacc; \
    if (GK) { DMA_K((t) + 3, sl_cur); } if (GV) { DMA_V((t) + 1, sl_next); } \
    FRD(0); FRD(1); FRD(2); \
    CMASK(C0, C1, t); \
    { float a = MX3(C0[0], C0[1], C1[0]), b = MX3(C0[2], C0[3], C1[1]); a = MX3(a, C1[2], C1[3]); \
      _Pragma("unroll") for (int r = 4; r < 16; r += 4) { a = MX3(a, C0[r], C0[r + 1]); b = MX3(b, C0[r + 2], C0[r + 3]); a = MX3(a, C1[r], C1[r + 1]); b = MX3(b, C1[r + 2], C1[r + 3]); } \
      float rm = __builtin_fmaxf(a, b); { auto rr = __builtin_amdgcn_permlane32_swap(__float_as_uint(rm), __float_as_uint(rm), false, false); rm = __builtin_fmaxf(__uint_as_float(rr[0]), __uint_as_float(rr[1])); } \
      resc = false; \
      if (__builtin_expect(__any(rm > (float)THRL), 0)) { const float dl = __builtin_fmaxf(rm, 0.f); mhat += dl; \
        _Pragma("unroll") for (int r = 0; r < 16; ++r) { C0[r] -= dl; C1[r] -= dl; } \
        const float f = __builtin_amdgcn_exp2f(-dl); l_reg *= f; if (hi == 0) wsf[r32] = f; resc = true; } } \
    SBAR(); \
    GAPB(o[0] = __builtin_amdgcn_mfma_f32_32x32x16_bf16(PAF(0), FFR(0), o[0], 0, 0, 0), C0, 0);   FRD(3); \
    GAPB(o[1] = __builtin_amdgcn_mfma_f32_32x32x16_bf16(PAF(0), FFR(1), o[1], 0, 0, 0), C0, 2);   FRD(4); \
    GAPB(o[0] = __builtin_amdgcn_mfma_f32_32x32x16_bf16(PAF(1), FFR(2), o[0], 0, 0, 0), C0, 4);   FRD(5); \
    GAPB(o[1] = __builtin_amdgcn_mfma_f32_32x32x16_bf16(PAF(1), FFR(3), o[1], 0, 0, 0), C0, 6);   FRD(6); \
    GAPB(o[0] = __builtin_amdgcn_mfma_f32_32x32x16_bf16(PAF(2), FFR(4), o[0], 0, 0, 0), C0, 8);   FRD(7); \
    GAPB(o[1] = __builtin_amdgcn_mfma_f32_32x32x16_bf16(PAF(2), FFR(5), o[1], 0, 0, 0), C0, 10);  FRD(8); \
    GAPB(o[0] = __builtin_amdgcn_mfma_f32_32x32x16_bf16(PAF(3), FFR(6), o[0], 0, 0, 0), C0, 12);  FRD(9); \
    GAPB(o[1] = __builtin_amdgcn_mfma_f32_32x32x16_bf16(PAF(3), FFR(7), o[1], 0, 0, 0), C0, 14);  FRD(10); \
    KRD(GL, 0); GAPB(o[2] = __builtin_amdgcn_mfma_f32_32x32x16_bf16(PAF(0), FFR(8), o[2], 0, 0, 0), C1, 0);   FRD(11); \
    KRD(GL, 1); GAPB(o[3] = __builtin_amdgcn_mfma_f32_32x32x16_bf16(PAF(0), FFR(9), o[3], 0, 0, 0), C1, 2);   FRD(12); \
    KRD(GL, 2); GAPB(o[2] = __builtin_amdgcn_mfma_f32_32x32x16_bf16(PAF(1), FFR(10), o[2], 0, 0, 0), C1, 4);  FRD(13); \
    KRD(GL, 3); GAPB(o[3] = __builtin_amdgcn_mfma_f32_32x32x16_bf16(PAF(1), FFR(11), o[3], 0, 0, 0), C1, 6);  FRD(14); \
    GAPB(o[2] = __builtin_amdgcn_mfma_f32_32x32x16_bf16(PAF(2), FFR(12), o[2], 0, 0, 0), C1, 8);  FRD(15); \
    GAPB(o[3] = __builtin_amdgcn_mfma_f32_32x32x16_bf16(PAF(2), FFR(13), o[3], 0, 0, 0), C1, 10); \
    GAPB(o[2] = __builtin_amdgcn_mfma_f32_32x32x16_bf16(PAF(3), FFR(14), o[2], 0, 0, 0), C1, 12); \
    GAPB(o[3] = __builtin_amdgcn_mfma_f32_32x32x16_bf16(PAF(3), FFR(15), o[3], 0, 0, 0), C1, 14); \
    } while (0)
  int t = 1;
  for (; t + 5 < NT; t += 2) {
    STEP(pB0, pB1, pA0, pA1, t, true, true, true);     WAIT_BAR(3); RESC(); ROT();
    STEP(pA0, pA1, pB0, pB1, t + 1, true, true, true); WAIT_BAR(3); RESC(); ROT();
  }
  #define ENDW(tt) do { if ((tt) + 3 < NT) { WAIT_BAR(3); } else if ((tt) + 2 < NT) { WAIT_BAR(2); } else { WAIT_BAR(0); } } while (0)
  for (; t + 1 < NT; t += 2) {
    STEP(pB0, pB1, pA0, pA1, t, (t + 3 < NT), (t + 1 < NT), (t + 1 < NT));         ENDW(t);     RESC(); ROT();
    STEP(pA0, pA1, pB0, pB1, t + 1, (t + 4 < NT), (t + 2 < NT), (t + 2 < NT));     ENDW(t + 1); RESC(); ROT();
  }
  STEP(pB0, pB1, pA0, pA1, NT - 1, false, false, false); RESC();
  { float sacc = pB0[0] + pB0[1]; _Pragma("unroll") for (int r = 2; r < 16; ++r) sacc += pB0[r]; _Pragma("unroll") for (int r = 0; r < 16; ++r) sacc += pB1[r]; l_reg += sacc;
    pw0 = (u32x4){PKW(pB0, 0), PKW(pB0, 2), PKW(pB0, 4), PKW(pB0, 6)}; pw1 = (u32x4){PKW(pB0, 8), PKW(pB0, 10), PKW(pB0, 12), PKW(pB0, 14)}; pw2 = (u32x4){PKW(pB1, 0), PKW(pB1, 2), PKW(pB1, 4), PKW(pB1, 6)}; pw3 = (u32x4){PKW(pB1, 8), PKW(pB1, 10), PKW(pB1, 12), PKW(pB1, 14)};
    SBAR(); pv(o, vb0 + 2 * sl_cur, PAF(0), PAF(1), PAF(2), PAF(3)); pv(o + 2, vb0 + 2 * sl_cur + 8192, PAF(0), PAF(1), PAF(2), PAF(3)); }
  #undef PKW
  #undef PAF
  #undef PIN
  #undef MX3
  #undef GAPA
  #undef GAPB
  #undef EX
  #undef FOFF
  #undef FRD
  #undef FFR
  #undef KRD
  #undef STEP
  #undef ENDW
  { auto rr = __builtin_amdgcn_permlane32_swap(__float_as_uint(l_reg), __float_as_uint(l_reg), false, false); l_reg = __uint_as_float(rr[0]) + __uint_as_float(rr[1]); }
  if (hi == 0) wsf[32 + r32] = l_reg; asm volatile("s_waitcnt lgkmcnt(0)" ::: "memory");
  float rli[16];
  #pragma unroll
  for (int r = 0; r < 16; ++r) rli[r] = __builtin_amdgcn_rcpf(wsf[32 + crow(r, hi)]);
  bf16* Ow = A_.O + (wid * QBLK) * A_.os;
  { bf16* stg = (bf16*)(shm + L8_QO) + wid * 2048;
    #pragma unroll
    for (int hv = 0; hv < 2; ++hv) {
      #pragma unroll
      for (int r = 0; r < 16; ++r) { const int orow = crow(r, hi);
        #pragma unroll
        for (int d0 = 0; d0 < 2; ++d0) stg[orow * 64 + d0 * 32 + r32] = __float2bfloat16(o[2 * hv + d0][r] * rli[r]); }
      asm volatile("s_waitcnt lgkmcnt(0)" ::: "memory");
      #pragma unroll
      for (int i = 0; i < 4; ++i) { const int row = i * 8 + (lane >> 3), ch = lane & 7; const u32x4 v = *(const u32x4*)(stg + row * 64 + ch * 8); *(u32x4*)(Ow + row * A_.os + hv * 64 + ch * 8) = v; }
      asm volatile("s_waitcnt lgkmcnt(0)" ::: "memory"); } }
  asm volatile("s_waitcnt lgkmcnt(0)\n\ts_barrier" ::: "memory");
  #undef DMA_K
  #undef DMA_V
  #undef QLD
  #undef NB
  #undef CMASK
  #undef RESC
  #undef ROT
}
#undef SBAR
#undef WAIT_BAR
}

__device__ __forceinline__ void transpose_item(const float* W, int K, int N, bf16_t* WT, LAS float* scr, int item, int lane, const float* gk = nullptr) {
    const int nblk = N / 32, kb = item / nblk, nb = item % nblk, k0 = 64 * kb, n0 = 32 * nb;
#pragma unroll 8
    for (int i = 0; i < 32; ++i) { const int kk = 2 * i + (lane >> 5); const float gg = gk ? gk[k0 + kk] : 1.f; scr[kk * 33 + (lane & 31)] = W[(size_t)(k0 + kk) * N + n0 + (lane & 31)] * gg; }
    asm volatile("s_waitcnt lgkmcnt(0)" ::: "memory");
    const int c = lane & 7;
#pragma unroll
    for (int j = 0; j < 4; ++j) { const int n = (lane >> 3) + 8 * j; const LAS float* s = scr + (8 * c) * 33 + n;
        u32x4 o; o.x = pk2(s[0 * 33], s[1 * 33]); o.y = pk2(s[2 * 33], s[3 * 33]); o.z = pk2(s[4 * 33], s[5 * 33]); o.w = pk2(s[6 * 33], s[7 * 33]);
        *(u32x4*)(WT + (size_t)(n0 + n) * K + k0 + 8 * c) = o; }
    asm volatile("s_waitcnt lgkmcnt(0)" ::: "memory");
}
__device__ __forceinline__ void rms_row_bf16(const float* xrow, const float* g, bf16_t* orow, int lane) {
    const f32x4* xr = (const f32x4*)xrow + lane; const f32x4* gr = (const f32x4*)g + lane;
    f32x4 v[4]; float s = 0.f;
#pragma unroll
    for (int j = 0; j < 4; ++j) { v[j] = xr[64 * j]; s += (v[j].x * v[j].x + v[j].y * v[j].y) + (v[j].z * v[j].z + v[j].w * v[j].w); }
    const float rs = rsqrtf(wave_sum(s) * (1.f / DM) + EPS);
    u32x2* o8 = (u32x2*)orow + lane;
#pragma unroll
    for (int j = 0; j < 4; ++j) { const f32x4 gg = gr[64 * j]; u32x2 w; w.x = pk2(v[j].x * rs * gg.x, v[j].y * rs * gg.y); w.y = pk2(v[j].z * rs * gg.z, v[j].w * rs * gg.w); o8[64 * j] = w; }
}
__device__ __forceinline__ void sincos_red(float a, float& s, float& c) {
    const float q = rintf(a * 0.636619772367581f); const int iq = (int)q;
    float r = fmaf(q, -1.5703125f, a); r = fmaf(q, -4.837512969970703125e-4f, r); r = fmaf(q, -7.54978995489188216e-8f, r);
    const float r2 = r * r;
    const float sp = r + r * r2 * (-1.6666654611e-1f + r2 * (8.3321608736e-3f + r2 * (-1.9515295891e-4f)));
    const float cp = 1.0f - 0.5f * r2 + r2 * r2 * (4.166664568298827e-2f + r2 * (-1.388731625493765e-3f + r2 * 2.443315711809948e-5f));
    const int k = iq & 3;
    s = (k == 0) ? sp : (k == 1) ? cp : (k == 2) ? -sp : -cp;
    c = (k == 0) ? cp : (k == 1) ? -sp : (k == 2) ? -cp : sp;
}

#define XB_TMO      128
#define XB_XCNT(j)  (256  + 64 * (j))
#define XB_XSUB(j)  (1280 + 64 * (j))
#define XB_XGEN(j)  (2304 + 64 * (j))
#define XB_TOP      3328
#define XB_TOPGEN   3392
#define XCD_BAR_WORDS 3456
#define XB_SPIN_CAP (1u << 18)

__device__ __forceinline__ unsigned xb_ld(unsigned* p)              { return __hip_atomic_load(p, __ATOMIC_RELAXED, __HIP_MEMORY_SCOPE_AGENT); }
__device__ __forceinline__ unsigned xb_add(unsigned* p, unsigned v) { return __hip_atomic_fetch_add(p, v, __ATOMIC_RELAXED, __HIP_MEMORY_SCOPE_AGENT); }
__device__ __forceinline__ unsigned xb_xcc_id() { return (unsigned)__builtin_amdgcn_s_getreg((3 << 11) | 20) & 0xFu; }
#define XB_SPIN(cond, bar) do { unsigned _sp = 0; while (cond) { __builtin_amdgcn_s_sleep(1); \
    if ((++_sp & 255u) == 0u) { if (xb_ld(&(bar)[XB_TMO])) break; if (_sp > XB_SPIN_CAP) { atomicAdd(&(bar)[XB_TMO], 1u); break; } } } } while (0)

struct XcdBarrier {
    unsigned* bar; unsigned x;
    volatile LAS unsigned* st;
};

__device__ __forceinline__ XcdBarrier xcd_barrier_post(unsigned* bar, volatile LAS unsigned* st) {
    XcdBarrier b; b.bar = bar; b.x = xb_xcc_id(); b.st = st;
    if (threadIdx.x == 0) (void)xb_add(&bar[XB_XCNT(b.x)], 1u);
    return b;
}
__device__ __forceinline__ void xcd_barrier_complete(unsigned* bar, unsigned x, unsigned& nloc, unsigned& nx) {
    const unsigned G = gridDim.x * gridDim.y * gridDim.z;
    unsigned sum, cnt, mine, sp = 0u;
    for (;;) {
        sum = 0u; cnt = 0u; mine = 0u;
#pragma unroll
        for (unsigned j = 0; j < 16; ++j) { const unsigned c = xb_ld(&bar[XB_XCNT(j)]); sum += c; cnt += (c > 0u) ? 1u : 0u; mine = (j == x) ? c : mine; }
        if (sum == G) break;
        __builtin_amdgcn_s_sleep(1);
        if ((++sp & 255u) == 0u) { if (xb_ld(&bar[XB_TMO])) break; if (sp > XB_SPIN_CAP) { atomicAdd(&bar[XB_TMO], 1u); break; } }
    }
    nloc = mine > 0u ? mine : 1u; nx = cnt > 0u ? cnt : 1u;
}

__device__ __forceinline__ void xcd_barrier(const XcdBarrier& b) {
    asm volatile("s_waitcnt vmcnt(0)" ::: "memory");
    __syncthreads();
    if (threadIdx.x == 0) {
        unsigned* bar = b.bar;
        __builtin_amdgcn_s_waitcnt(0);
        unsigned nloc = b.st[0], nx = b.st[1];
        if (nloc == 0u) { xcd_barrier_complete(bar, b.x, nloc, nx); b.st[0] = nloc; b.st[1] = nx; }
        const unsigned old = xb_add(&bar[XB_XSUB(b.x)], 1u);
        const unsigned gen = old / nloc;
        if (old + 1u == (gen + 1u) * nloc) {
            __builtin_amdgcn_fence(__ATOMIC_RELEASE, "agent");
            asm volatile("s_waitcnt vmcnt(0)" ::: "memory");
            const unsigned og = xb_add(&bar[XB_TOP], 1u);
            const unsigned tg = og / nx;
            if (og + 1u == (tg + 1u) * nx) xb_add(&bar[XB_TOPGEN], 1u);
            else XB_SPIN(xb_ld(&bar[XB_TOPGEN]) == tg, bar);
            __builtin_amdgcn_fence(__ATOMIC_ACQUIRE, "agent");
            xb_add(&bar[XB_XGEN(b.x)], 1u);
            asm volatile("s_waitcnt vmcnt(0)" ::: "memory");
        } else {
            XB_SPIN(xb_ld(&bar[XB_XGEN(b.x)]) == gen, bar);
            __builtin_amdgcn_fence(__ATOMIC_ACQUIRE, "agent");
            asm volatile("s_waitcnt vmcnt(0)" ::: "memory");
        }
    }
    __syncthreads();
}


struct Args { const float* in[14]; float* out; unsigned char* ws; };

__global__ void __launch_bounds__(512) mk_fwd(Args args) {
    extern __shared__ __attribute__((aligned(16))) unsigned char lds[];
    cg::grid_group grid = cg::this_grid();
    const int tid0 = threadIdx.x, wave = __builtin_amdgcn_readfirstlane(tid0 >> 6);
#define FRESH_LANE() int tid = tid0; asm volatile("" : "+v"(tid)); const int lane = tid & 63
    const int G = gridDim.x, bx = blockIdx.x;
    const int vcu = (G % 8 == 0) ? (bx % 8) * (G / 8) + bx / 8 : bx;
    const int gw = vcu * 8 + wave, NGW = G * 8;
    LAS unsigned char* ldsl = (LAS unsigned char*)lds;
    if (tid0 < 8) ((LAS unsigned*)(ldsl + MISC_OFF))[tid0] = 0u;
    __syncthreads();
    const XcdBarrier xbar = xcd_barrier_post((unsigned*)(args.ws + WS_BAR), (volatile LAS unsigned*)(ldsl + MISC_OFF));
#define ws (args.ws)
#define x_in (args.in[0])
#define norm_mix (args.in[1])
#define w_in (args.in[2])
#define b_gate (args.in[3])
#define diff_lambda (args.in[4])
#define diff_subln (args.in[5])
#define na_rpb (args.in[6])
#define qk_norm (args.in[7])
#define w_branch (args.in[8])
#define w_out (args.in[9])
#define norm_ffn (args.in[10])
#define w_ff1 (args.in[11])
#define w_ff2 (args.in[12])
#define norm_final (args.in[13])
#define xout (args.out)
#define WinT ((bf16_t*)(ws + WS_WIN))
#define WbrT ((bf16_t*)(ws + WS_WBR))
#define WoutT ((bf16_t*)(ws + WS_WOUT))
#define W1T ((bf16_t*)(ws + WS_W1))
#define W2T ((bf16_t*)(ws + WS_W2))
#define STAT ((float*)(ws + WS_STAT))
#define H ((bf16_t*)(ws + WS_H))
#define ATMP ((bf16_t*)(ws + WS_ATMP))
#define BTMP ((bf16_t*)(ws + WS_BTMP))
#define Y ((bf16_t*)(ws + WS_Y))
#define MERGED ((bf16_t*)(ws + WS_MERGED))
#define Z ((bf16_t*)(ws + WS_Z))
#define U ((bf16_t*)(ws + WS_Z))
#define PROJ ((bf16_t*)(ws + WS_PROJ))
#define XB ((bf16_t*)(ws + WS_XB))
#define SSQM ((float*)(ws + WS_SSQM))
#define SSQF ((float*)(ws + WS_SSQF))
#define NRMQ ((unsigned*)(ws + WS_NRM))
#define NRMK ((unsigned*)(ws + WS_NRM) + 1024)

    {
        FRESH_LANE();
        LAS float* scr = (LAS float*)(ldsl + wave * 16384);
        constexpr int I_IN = (DM / 64) * (INW / 32), I_BR = (512 / 64) * (DM / 32), I_OUT = (DM / 64) * (DM / 32), I_1 = (DM / 64) * (DFF / 32), I_2 = (DFF / 64) * (DM / 32);
        constexpr int NITEMS = 2 * I_IN + 8 * I_BR + 2 * I_OUT + 2 * I_1 + 2 * I_2;
        for (int it = gw; it < NITEMS; it += NGW) {
            int r = it;
            if (r < 2 * I_IN) { const int l = r / I_IN; transpose_item(w_in + (size_t)l * DM * INW, DM, INW, WinT + (size_t)l * INW * DM, scr, r % I_IN, lane, norm_mix + l * DM); continue; } r -= 2 * I_IN;
            if (r < 8 * I_BR) { const int ln = r / I_BR; transpose_item(w_branch + (size_t)ln * 512 * DM, 512, DM, WbrT + (size_t)ln * DM * 512, scr, r % I_BR, lane); continue; } r -= 8 * I_BR;
            if (r < 2 * I_OUT) { const int l = r / I_OUT; transpose_item(w_out + (size_t)l * DM * DM, DM, DM, WoutT + (size_t)l * DM * DM, scr, r % I_OUT, lane); continue; } r -= 2 * I_OUT;
            if (r < 2 * I_1) { const int l = r / I_1; transpose_item(w_ff1 + (size_t)l * DM * DFF, DM, DFF, W1T + (size_t)l * DFF * DM, scr, r % I_1, lane, norm_ffn + l * DM); continue; } r -= 2 * I_1;
            { const int l = r / I_2; transpose_item(w_ff2 + (size_t)l * DFF * DM, DFF, DM, W2T + (size_t)l * DM * DFF, scr, r % I_2, lane); }
        }
        {
            f32x4 v[4], vn[4] = {};
            if (gw < NTOK) { const f32x4* xr = (const f32x4*)(x_in + (size_t)gw * DM) + lane;
#pragma unroll
                for (int j = 0; j < 4; ++j) v[j] = xr[64 * j]; }
            for (int m = gw; m < NTOK; m += NGW) {
                if (m + NGW < NTOK) { const f32x4* xr = (const f32x4*)(x_in + (size_t)(m + NGW) * DM) + lane;
#pragma unroll
                    for (int j = 0; j < 4; ++j) vn[j] = xr[64 * j]; }
                u32x2* o8 = (u32x2*)(XB + (size_t)m * DM) + lane; float sq = 0.f;
#pragma unroll
                for (int j = 0; j < 4; ++j) { sq += (v[j].x * v[j].x + v[j].y * v[j].y) + (v[j].z * v[j].z + v[j].w * v[j].w); u32x2 w; w.x = pk2(v[j].x, v[j].y); w.y = pk2(v[j].z, v[j].w); o8[64 * j] = w; }
                sq = wave_sum(sq);
                if (lane == 0) *(f32x4*)(SSQM + (size_t)m * 4) = (f32x4){sq, 0.f, 0.f, 0.f};
#pragma unroll
                for (int j = 0; j < 4; ++j) v[j] = vn[j];
            }
        }
    }
    grid.sync();

    for (int l = 0; l < DEPTH; ++l) {
        { FRESH_LANE(); LAS float* tab = (LAS float*)(ldsl + TAB_OFF); for (int i = tid; i < 8 * 465; i += 512) tab[i] = na_rpb[l * 8 * 465 + i] * LOG2E; }
        __syncthreads();
        for (int grp = 0; grp < NGRP; ++grp) {
            const size_t tok0 = (size_t)grp * TG;
            const float* xsrc = (l == 0) ? x_in : xout;
            {
                pg8::Gemm g{XB + tok0 * DM, WinT + (size_t)l * INW * DM, DM, DM, DM, 1 << 30, 0}; pg8::StaticOrder S; S.init(TG, INW, G, bx);
                if (bx == 0) { FRESH_LANE(); NRMQ[tid] = 0u; NRMQ[tid + 512] = 0u; if (tid < 16) NRMQ[1024 + tid] = 0u; (void)lane; }
                pg8::Epi<0> E{PROJ, nullptr, nullptr, b_gate + l * 4096, INW, SSQM + tok0 * 4, nullptr, nullptr, nullptr};
                pg8::gemm_phase(ldsl, g, S, E);
            }
            xcd_barrier(xbar);
            {
                FRESH_LANE();
                const float inv = exp2f(-(float)(lane & 15) * 0.8304820237218406f);
                const float gq = qk_norm[l * 128 + lane], gk = qk_norm[l * 128 + 64 + lane];
                const int per = (TG + NGW - 1) / NGW;
                float mq = 0.f, mk = 0.f; int cu = -1;
                u32x4 qv, kv, qvn = {}, kvn = {}; unsigned short rw[10], rwn[10] = {};
#define P3_LOAD(QV, KV, RW, mm) do { const bf16_t* ar_ = PROJ + (size_t)(mm) * INW; QV = *(const u32x4*)(ar_ + COL_AQ + lane * 8); KV = *(const u32x4*)(ar_ + COL_AK + lane * 8); \
                    _Pragma("unroll") for (int hd = 0; hd < 10; ++hd) RW[hd] = ar_[COL_DQ + hd * 64 + lane]; } while (0)
                if (gw * per < TG) P3_LOAD(qv, kv, rw, gw * per);
                for (int i = 0; i < per; ++i) {
                    const int m = gw * per + i; if (m >= TG) break;
                    if (i + 1 < per && m + 1 < TG) P3_LOAD(qvn, kvn, rwn, m + 1);
                    if ((m >> 8) != cu) { if (cu >= 0 && (lane & 7) == 0) { atomicMax(NRMQ + cu * 8 + (lane >> 3), __float_as_uint(mq)); atomicMax(NRMK + (cu >> 5) * 8 + (lane >> 3), __float_as_uint(mk)); } cu = m >> 8; mq = 0.f; mk = 0.f; }
                    const int s = (int)((tok0 + m) % SEQ); const float pos = (float)((lane < 32) ? (s >> 6) : (s & 63));
                    float sn, cs; sincos_red(pos * inv, sn, cs);
                    { float nq = 0.f, nk = 0.f;
#pragma unroll
                      for (int e = 0; e < 4; ++e) { nq += bflo(qv[e]) * bflo(qv[e]) + bfhi(qv[e]) * bfhi(qv[e]); nk += bflo(kv[e]) * bflo(kv[e]) + bfhi(kv[e]) * bfhi(kv[e]); }
                      nq += __shfl_xor(nq, 1); nk += __shfl_xor(nk, 1); nq += __shfl_xor(nq, 2); nk += __shfl_xor(nk, 2); nq += __shfl_xor(nq, 4); nk += __shfl_xor(nk, 4);
                      mq = fmaxf(mq, sqrtf(nq)); mk = fmaxf(mk, sqrtf(nk)); }
                    bf16_t* row = PROJ + (size_t)m * INW + COL_DQ;
#pragma unroll
                    for (int hd = 0; hd < 10; ++hd) {
                        const float v = __uint_as_float((unsigned)rw[hd] << 16);
                        const float rn = rsqrtf(wave_sum(v * v) * (1.f / 64.f) + EPS);
                        const float y = v * rn * (hd < 8 ? gq : gk);
                        const float p = __shfl_xor(y, 16);
                        float o = ((lane >> 4) & 1) ? (y * cs + p * sn) : (y * cs - p * sn);
                        if (hd < 8) o *= C2;
                        row[hd * 64 + lane] = (bf16_t)f2bf(o);
                    }
                    qv = qvn; kv = kvn;
#pragma unroll
                    for (int hd = 0; hd < 10; ++hd) rw[hd] = rwn[hd];
                }
#undef P3_LOAD
                if (cu >= 0 && (lane & 7) == 0) { atomicMax(NRMQ + cu * 8 + (lane >> 3), __float_as_uint(mq)); atomicMax(NRMK + (cu >> 5) * 8 + (lane >> 3), __float_as_uint(mk)); }
            }
            xcd_barrier(xbar);
            {
                using namespace attn_body;
                char* shm = (char*)lds;
                {
                    unsigned* qctr = (unsigned*)(ws + WS_BAR) + 3584 + (l * NGRP + grp) * 8;
                    volatile LAS unsigned* slot = (volatile LAS unsigned*)(ldsl + MISC_OFF + 32);
                    const int myx = (G % 8 == 0) ? (vcu / (G / 8)) : 0;
                    int qq = 0;
                    for (;;) {
                        if (tid0 == 0) { int fj = -1, fx = 0;
                            for (; qq < 8; ++qq) { const int x_ = (myx + qq) & 7; const int j_ = (int)atomicAdd(qctr + x_, 1u); if (j_ < 288) { fj = j_; fx = x_; break; } }
                            slot[0] = (unsigned)fj; slot[1] = (unsigned)fx; }
                        __syncthreads();
                        const int j = (int)slot[0], sx = (int)slot[1];
                        __syncthreads();
                        if (j < 0) break;
                        if (j < 128) {
                            AttnArgs a{}; a.qs = INW; a.ks = INW; a.NT = 128; a.tlo = 0; a.thi = 127;
                            if (j >= 32 && j < 96) { const int qb = j & 31, ds = 2 * sx + ((j - 32) >> 5), bb = ds >> 3, h = ds & 7; const size_t tb = (size_t)bb * SEQ;
                                a.Q = (const bf16*)(PROJ + (tb + qb * 256) * INW + COL_DQ + h * 64); a.K = (const bf16*)(PROJ + tb * INW + COL_DK + (h >> 2) * 64);
                                a.V = (const bf16*)(PROJ + tb * INW + COL_DV + (h >> 2) * 64); a.O = (bf16*)(Y + (tb + qb * 256) * 2048 + 1536 + h * 64); a.os = 2048;
                                attn_unit<MD, 16>(a, shm);
                            } else {
                                int bb, hh, comp, qb;
                                if (j < 32) { bb = sx >> 2; hh = 2 + ((sx >> 1) & 1); comp = sx & 1; qb = j; }
                                else { const int s1 = sx >> 1; bb = s1 >> 1; comp = s1 & 1; hh = (j < 112) ? 1 : 0; qb = (sx & 1) * 16 + ((j - 96) & 15); }
                                const size_t tb = (size_t)bb * SEQ;
                                a.Q = (const bf16*)(PROJ + (tb + qb * 256) * INW + COL_AQ + hh * 128 + comp * 64); a.K = (const bf16*)(PROJ + tb * INW + COL_AK + hh * 128 + comp * 64);
                                a.V = (const bf16*)(PROJ + tb * INW + COL_AV + hh * 128); a.O = (bf16*)(ATMP + (tb + qb * 256) * 1024 + (hh * 2 + comp) * 128); a.os = 1024;
                                a.s2 = exp2f(-2.f * (float)(hh + 1)) * LOG2E;
                                const float Bs = __uint_as_float(NRMQ[(bb * 32 + qb) * 8 + hh * 2 + comp]) * __uint_as_float(NRMK[bb * 8 + hh * 2 + comp]) * 1.02f + 0.25f;
                                const float dlim = fminf((150.f + 2.f * Bs) / a.s2, 1.0e6f), q0f = (float)(qb * 256);
                                int tlo = max(0, (int)floorf((q0f - 63.f - dlim) * (1.f / 64.f))), thi = min(127, (int)ceilf((q0f + 255.f + dlim) * (1.f / 64.f)));
                                if (((thi - tlo + 1) & 1) != 0) { if (tlo > 0) --tlo; else ++thi; }
                                tlo = __builtin_amdgcn_readfirstlane(tlo); thi = __builtin_amdgcn_readfirstlane(thi);
                                a.K += (size_t)tlo * 64 * INW; a.V += (size_t)tlo * 64 * INW; a.q0 = qb * 256 - 64 * tlo; a.NT = thi - tlo + 1;
                                attn_unit128<16>(a, shm);
                            }
                        } else if (j < 192) {
                            const int cs = 2 * sx + ((j - 128) >> 5), qb = (j - 128) & 31, bb = cs >> 3, h = cs & 7, r0 = 4 * qb, kb = min(max(r0 - 4, 0), 116); const size_t tb = (size_t)bb * SEQ;
                            AttnArgs a{}; a.qs = INW; a.ks = INW; a.os = 2048; a.NT = 12; a.tlo = 0; a.thi = 11; a.q0 = r0; a.kb = kb;
                            a.Q = (const bf16*)(PROJ + (tb + r0 * 64) * INW + COL_CQ + h * 64); a.K = (const bf16*)(PROJ + (tb + kb * 64) * INW + COL_CK + h * 64);
                            a.V = (const bf16*)(PROJ + (tb + kb * 64) * INW + COL_CV + h * 64); a.O = (bf16*)(Y + (tb + r0 * 64) * 2048 + 1024 + h * 64);
                            a.tab = (lds_fptr)((lds_cptr)shm + TAB_OFF) + h * 465;
                            attn_unit<MC, 8>(a, shm);
                        } else {
                            const int p = j - 192, sg = 6 * sx + (p >> 4);
                            for (int e = 0; e < 2; ++e) {
                                const int blk = 2 * (p & 15) + e, bb = sg / 24, k = sg % 24, gp = k >> 3, h = k & 7, dsh = 2 * gp, dil = 1 << dsh;
                                const int nblk = 32 >> dsh, res = blk / nblk, i0 = (blk % nblk) * 256, L = SEQ >> dsh;
                                const long tq = (long)bb * SEQ + res + (long)i0 * dil, tk = (long)bb * SEQ + res + (long)(i0 - 64) * dil;
                                AttnArgs a{}; a.qs = dil * INW; a.ks = dil * INW; a.os = dil * 1536; a.NT = 6; a.tlo = (i0 == 0) ? 1 : 0; a.thi = (i0 + 256 == L) ? 4 : 5;
                                const int cq = COL_B + gp * 1536 + h * 64;
                                a.Q = (const bf16*)(PROJ + tq * INW + cq); a.K = (const bf16*)(PROJ + tk * INW + cq + 512); a.V = (const bf16*)(PROJ + tk * INW + cq + 1024);
                                a.O = (bf16*)(BTMP + tq * 1536 + gp * 512 + h * 64);
                                a.s2 = exp2f(-(float)(h + 1)) * (float)dil * LOG2E; a.stat = STAT + (tq * 24 + gp * 8 + h) * 2; a.ss = dil * 48;
                                attn_unit<MB, 8>(a, shm);
                            }
                        }
                    }
                }
            }
            xcd_barrier(xbar);
            {
                FRESH_LANE();
                int l_ = l; asm volatile("" : "+s"(l_));
                const float lam_init = (l_ == 0) ? 0.2f : (0.8f - 0.6f * 0.7408182206817179f);
                float lam;
                { const float* lp = diff_lambda + l * 256; const float a = lp[lane] * lp[64 + lane], b = lp[128 + lane] * lp[192 + lane]; lam = expf(wave_sum(a)) - expf(wave_sum(b)) + lam_init; lam = __uint_as_float(__builtin_amdgcn_readfirstlane(__float_as_uint(lam))); }
                const float out_scale = 1.f - lam_init;
                const float g0 = diff_subln[l * 128 + 2 * lane], g1 = diff_subln[l * 128 + 2 * lane + 1];
                const int h = lane >> 3, d8 = (lane & 7) * 8;
                unsigned aw[8]; u32x4 bw[3]; float sv[6];
#define P5_LOAD(AW, BW, SV, mm) do { const unsigned* at_ = (const unsigned*)(ATMP + (size_t)(mm) * 1024); _Pragma("unroll") for (int q = 0; q < 8; ++q) AW[q] = at_[q * 64 + lane]; \
                    const bf16_t* bt_ = BTMP + (size_t)(mm) * 1536 + h * 64 + d8; _Pragma("unroll") for (int g = 0; g < 3; ++g) BW[g] = *(const u32x4*)(bt_ + g * 512); \
                    const float* st_ = STAT + (size_t)(mm) * 48 + h * 2; _Pragma("unroll") for (int g = 0; g < 3; ++g) { SV[2 * g] = st_[16 * g]; SV[2 * g + 1] = st_[16 * g + 1]; } } while (0)
                for (int m = gw; m < TG; m += NGW) {
                    P5_LOAD(aw, bw, sv, m);
                    unsigned* yr = (unsigned*)(Y + (size_t)m * 2048);
#pragma unroll
                    for (int hh = 0; hh < 4; ++hh) {
                        const unsigned w0 = aw[hh * 2], w1 = aw[hh * 2 + 1];
                        const float d0 = bflo(w0) - lam * bflo(w1), d1 = bfhi(w0) - lam * bfhi(w1);
                        const float rn = rsqrtf(wave_sum(d0 * d0 + d1 * d1) * (1.f / 128.f) + EPS) * out_scale;
                        yr[hh * 64 + lane] = pk2(d0 * rn * g0, d1 * rn * g1);
                    }
                    const float m0 = sv[0], l0 = sv[1], m1 = sv[2], l1 = sv[3], m2 = sv[4], l2 = sv[5];
                    const float ms = fmaxf(m0, fmaxf(m1, m2));
                    const float w0 = l0 * exp2f(m0 - ms), w1 = l1 * exp2f(m1 - ms), w2 = l2 * exp2f(m2 - ms); const float inv = 1.f / (w0 + w1 + w2);
                    const u32x4 a0 = bw[0], a1 = bw[1], a2 = bw[2];
                    u32x4 o;
#pragma unroll
                    for (int e = 0; e < 4; ++e) { const float lo = (w0 * bflo(a0[e]) + w1 * bflo(a1[e]) + w2 * bflo(a2[e])) * inv, hi = (w0 * bfhi(a0[e]) + w1 * bfhi(a1[e]) + w2 * bfhi(a2[e])) * inv; o[e] = pk2(lo, hi); }
                    *(u32x4*)(Y + (size_t)m * 2048 + 512 + h * 64 + d8) = o;
                }
#undef P5_LOAD
            }
            xcd_barrier(xbar);
            {
                pg8::Gemm g{Y, WbrT + (size_t)l * 4096 * 512, 2048, 512, 512, 4, 512}; pg8::StaticOrder S; S.init(TG, 4096, G, bx);
                pg8::Epi<1> E{Z, nullptr, nullptr, nullptr, 4096, nullptr, nullptr, nullptr, nullptr};
                pg8::gemm_phase(ldsl, g, S, E);
            }
            xcd_barrier(xbar);
            { FRESH_LANE();
            u32x4 gv[2][4], zv[2][4];
#define P7_LOAD(GV, ZV, mm) do { const bf16_t* gr_ = PROJ + (size_t)(mm) * INW + COL_GATE + lane * 8; const bf16_t* zr_ = Z + (size_t)(mm) * 4096 + lane * 8; \
                _Pragma("unroll") for (int jj = 0; jj < 2; ++jj) _Pragma("unroll") for (int n = 0; n < 4; ++n) { GV[jj][n] = *(const u32x4*)(gr_ + n * 1024 + jj * 512); ZV[jj][n] = *(const u32x4*)(zr_ + n * 1024 + jj * 512); } } while (0)
            for (int m = gw; m < TG; m += NGW) {
                P7_LOAD(gv, zv, m);
#pragma unroll
                for (int j = 0; j < 2; ++j) { const int c = lane * 8 + j * 512; float acc[8] = {0.f, 0.f, 0.f, 0.f, 0.f, 0.f, 0.f, 0.f};
#pragma unroll
                    for (int n = 0; n < 4; ++n) {
#pragma unroll
                        for (int e = 0; e < 4; ++e) { acc[2 * e] += bflo(gv[j][n][e]) * bflo(zv[j][n][e]); acc[2 * e + 1] += bfhi(gv[j][n][e]) * bfhi(zv[j][n][e]); } }
                    u32x4 o; o.x = pk2(acc[0], acc[1]); o.y = pk2(acc[2], acc[3]); o.z = pk2(acc[4], acc[5]); o.w = pk2(acc[6], acc[7]);
                    *(u32x4*)(MERGED + (size_t)m * DM + c) = o; }
#undef P7_LOAD
            } }
            xcd_barrier(xbar);
            {
                pg8::Gemm g{MERGED, WoutT + (size_t)l * DM * DM, DM, DM, DM, 1 << 30, 0}; pg8::StaticOrder S; S.init(TG, DM, G, bx);
                pg8::Epi<3> E{nullptr, xout + tok0 * DM, xsrc + tok0 * DM, nullptr, DM, nullptr, H, SSQF, (LAS float*)(ldsl + SSQ_OFF)};
                pg8::gemm_phase(ldsl, g, S, E);
            }
            xcd_barrier(xbar);
            {
                pg8::Gemm g{H, W1T + (size_t)l * DFF * DM, DM, DM, DM, 1 << 30, 0}; pg8::StaticOrder S; S.init(TG, DFF, G, bx);
                pg8::Epi<2> E{U, nullptr, nullptr, nullptr, DFF, SSQF, nullptr, nullptr, nullptr};
                pg8::gemm_phase(ldsl, g, S, E);
            }
            xcd_barrier(xbar);
            {
                pg8::Gemm g{U, W2T + (size_t)l * DM * DFF, DFF, DFF, DFF, 1 << 30, 0}; pg8::StaticOrder S; S.init(TG, DM, G, bx);
                pg8::Epi<3> E{nullptr, xout + tok0 * DM, xout + tok0 * DM, nullptr, DM, nullptr, XB + tok0 * DM, SSQM + tok0 * 4, (LAS float*)(ldsl + SSQ_OFF)};
                pg8::gemm_phase(ldsl, g, S, E);
            }
            if (l == DEPTH - 1 && grp == NGRP - 1) xcd_barrier(xbar);
        }
    }
    {
        FRESH_LANE();
        const f32x4* g4 = (const f32x4*)norm_final + lane; f32x4 gg[4];
#pragma unroll
        for (int j = 0; j < 4; ++j) gg[j] = g4[64 * j];
        f32x4 v[4], vn[4] = {};
        if (gw < NTOK) { const f32x4* o = (const f32x4*)(xout + (size_t)gw * DM) + lane;
#pragma unroll
            for (int j = 0; j < 4; ++j) v[j] = o[64 * j]; }
        for (int m = gw; m < NTOK; m += NGW) {
            if (m + NGW < NTOK) { const f32x4* on = (const f32x4*)(xout + (size_t)(m + NGW) * DM) + lane;
#pragma unroll
                for (int j = 0; j < 4; ++j) vn[j] = on[64 * j]; }
            f32x4* o = (f32x4*)(xout + (size_t)m * DM) + lane; float sq = 0.f;
#pragma unroll
            for (int j = 0; j < 4; ++j) sq += (v[j].x * v[j].x + v[j].y * v[j].y) + (v[j].z * v[j].z + v[j].w * v[j].w);
            const float r = rsqrtf(wave_sum(sq) * (1.f / DM) + EPS);
#pragma unroll
            for (int j = 0; j < 4; ++j) o[64 * j] = (f32x4){v[j].x * r * gg[j].x, v[j].y * r * gg[j].y, v[j].z * r * gg[j].z, v[j].w * r * gg[j].w};
#pragma unroll
            for (int j = 0; j < 4; ++j) v[j] = vn[j];
        }
    }
}

#undef ws
#undef x_in
#undef norm_mix
#undef w_in
#undef b_gate
#undef diff_lambda
#undef diff_subln
#undef na_rpb
#undef qk_norm
#undef w_branch
#undef w_out
#undef norm_ffn
#undef w_ff1
#undef w_ff2
#undef norm_final
#undef xout
#undef WinT
#undef WbrT
#undef WoutT
#undef W1T
#undef W2T
#undef STAT
#undef H
#undef ATMP
#undef BTMP
#undef Y
#undef MERGED
#undef Z
#undef U
#undef PROJ
#undef NRMQ
#undef XB
#undef SSQM
#undef SSQF
#undef NRMK

extern "C" void kernel_launch(void* const* d_in, const int* in_sizes, int n_in, void* d_out, int out_size, void* d_ws, size_t ws_size, hipStream_t stream) {
    static int grid_blocks = 0;
    if (!grid_blocks) {
        int dev = 0, cus = 0, per_cu = 0;
        (void)hipGetDevice(&dev);
        (void)hipDeviceGetAttribute(&cus, hipDeviceAttributeMultiprocessorCount, dev);
        (void)hipFuncSetAttribute((const void*)mk_fwd, hipFuncAttributeMaxDynamicSharedMemorySize, LDS_BYTES);
        (void)hipOccupancyMaxActiveBlocksPerMultiprocessor(&per_cu, (const void*)mk_fwd, 512, LDS_BYTES);
        if (per_cu < 1) per_cu = 1;
        grid_blocks = cus * per_cu;
        if (ws_size < WS_END || n_in != 14) { fprintf(stderr, "kernel_launch: workspace %zu < %zu or n_in %d != 14\n", ws_size, (size_t)WS_END, n_in); grid_blocks = -1; }
    }
    if (grid_blocks < 0) return;
    (void)hipMemsetAsync((char*)d_ws + WS_BAR, 0, 16384, stream);
    Args a{};
    for (int i = 0; i < 14; ++i) a.in[i] = (const float*)d_in[i];
    a.out = (float*)d_out; a.ws = (unsigned char*)d_ws;
    void* kargs[] = {&a};
    hipError_t e = hipLaunchCooperativeKernel((const void*)mk_fwd, dim3(grid_blocks), dim3(512), kargs, LDS_BYTES, stream);
    if (e != hipSuccess) fprintf(stderr, "cooperative launch failed: %s (grid %d)\n", hipGetErrorString(e), grid_blocks);
}
```

```cpp
#include <hip/hip_runtime.h>
#include <hip/hip_cooperative_groups.h>
#include <hip/hip_bf16.h>
#include <cstdio>
#include <cstdint>
#include <cmath>
namespace cg = cooperative_groups;

constexpr int BATCH = 8, SEQ = 8192, DM = 1024, NTOK = BATCH * SEQ, INW = 12544, DFF = 4096, DEPTH = 2;
constexpr int GB = 2, TG = GB * SEQ, NGRP = BATCH / GB;
constexpr float EPS = 1e-6f;
constexpr float LOG2E = 1.4426950408889634f;
constexpr float C2 = 0.125f * LOG2E;
constexpr int COL_AQ = 0, COL_AK = 512, COL_AV = 1024, COL_B = 1536, COL_CQ = 6144, COL_CK = 6656, COL_CV = 7168, COL_DQ = 7680, COL_DK = 8192, COL_DV = 8320, COL_GATE = 8448;
constexpr size_t MiB = 1u << 20;
constexpr size_t WS_WIN = 0, WS_WBR = 49 * MiB, WS_WOUT = 57 * MiB, WS_W1 = 61 * MiB, WS_W2 = 77 * MiB, WS_STAT = 93 * MiB, WS_H = 96 * MiB, WS_ATMP = 128 * MiB,
                 WS_BTMP = 160 * MiB, WS_Y = 208 * MiB, WS_MERGED = 272 * MiB, WS_Z = 304 * MiB, WS_PROJ = 432 * MiB, WS_NRM = 824 * MiB, WS_BAR = 824 * MiB + 512 * 1024, WS_SSQM = 825 * MiB, WS_SSQF = 826 * MiB, WS_XB = 827 * MiB, WS_END = 955 * MiB;
constexpr int LDS_BYTES = 151552, TAB_OFF = 131072, MISC_OFF = 147072, SSQ_OFF = 147456;

#define LAS __attribute__((address_space(3)))
typedef unsigned short bf16_t;
typedef short bf16x8 __attribute__((ext_vector_type(8)));
typedef float f32x4 __attribute__((ext_vector_type(4)));
typedef unsigned u32x4 __attribute__((ext_vector_type(4)));
typedef unsigned u32x2 __attribute__((ext_vector_type(2)));

__device__ __forceinline__ unsigned f2bf(float f) { unsigned u = __builtin_bit_cast(unsigned, f); return (u + 0x7fffu + ((u >> 16) & 1u)) >> 16; }
__device__ __forceinline__ unsigned pk2(float lo, float hi) { return f2bf(lo) | (f2bf(hi) << 16); }
__device__ __forceinline__ float bflo(unsigned w) { return __uint_as_float(w << 16); }
__device__ __forceinline__ float bfhi(unsigned w) { return __uint_as_float(w & 0xffff0000u); }
__device__ __forceinline__ float wave_sum(float v) {
#pragma unroll
    for (int o = 1; o < 64; o <<= 1) v += __shfl_xor(v, o);
    return v;
}

namespace pg8 {
constexpr int BM = 256, BK = 64, HALF = 128, HTB = HALF * BK * 2, STAGE_BYTES = 8 * HTB, NXCD = 8, WGM = 4;
__host__ __device__ __forceinline__ int lds_byte(int r, int c) { const int st = (r >> 4) * 2 + (c >> 5), rr = r & 15, cc = c & 31, ob = rr * 64 + cc * 2; return st * 1024 + (ob ^ (((ob >> 9) & 1) << 5)); }
__host__ __device__ __forceinline__ void stage_rc(int b, int& R, int& C) { const int st = b / 1024, sb = b % 1024, swz = sb ^ (((sb >> 9) & 1) << 5); R = (st >> 1) * 16 + swz / 64; C = (st & 1) * 32 + (swz % 64) / 2; }
__host__ __device__ __forceinline__ int perm32(int rho) { const int n = rho >> 4, i = rho & 15; return 8 * (i >> 2) + 4 * n + (i & 3); }

struct Unit { int pm, pn; };
struct Gemm { const bf16_t* A; const bf16_t* Bt; int lda, ldb, K, adiv, astride; };

struct StaticOrder {
    int nM, nN, nwg, G, c;
    __device__ void init(int M, int N, int G_, int c_) { nM = M / BM; nN = N / BM; nwg = nM * nN; G = G_; c = c_; }
    __device__ bool next(int i, Unit& u) const {
        const long L = (long)i * G + c; if (L >= nwg) return false;
        int wgid = (int)L; { const int q = nwg / NXCD, r = nwg % NXCD, xcd = wgid % NXCD, off = wgid / NXCD; wgid = (xcd < r ? xcd * (q + 1) : r * (q + 1) + (xcd - r) * q) + off; }
        const int nig = WGM * nN, gid = wgid / nig, fm = gid * WGM, gsz = (nM - fm) < WGM ? (nM - fm) : WGM;
        u.pm = fm + ((wgid % nig) % gsz); u.pn = (wgid % nig) / gsz; return true;
    }
};

__device__ __forceinline__ unsigned cvt_pk_bf16(float lo, float hi) { unsigned r; asm volatile("v_cvt_pk_bf16_f32 %0, %1, %2" : "=v"(r) : "v"(lo), "v"(hi)); return r; }

template <int MODE> struct Epi {
    bf16_t* O; float* Of; const float* base; const float* bias; int ldc;
    const float* ssq;
    bf16_t* XBo; float* SSQo; LAS float* lx;
    __device__ __forceinline__ void operator()(const f32x4 (&acc)[2][2][4][2], const Unit& u, int wr, int wc, int fr, int fq) const {
        const int row0 = u.pm * BM + wr * 64 + fr, col0 = u.pn * BM + wc * 32 + 8 * fq;
        int kind = 0; float sc = 1.f;
        if (MODE == 0) { const int pn = u.pn; if (pn >= 33) kind = 2; else if (pn < 2 || pn == 6 || pn == 7 || pn == 12 || pn == 13 || pn == 18 || pn == 19 || pn == 24 || pn == 25) sc = C2; }
        float rsv[2][4]; f32x4 bv[2][2];
#pragma unroll
        for (int ai = 0; ai < 2; ++ai)
#pragma unroll
            for (int m = 0; m < 4; ++m) { rsv[ai][m] = 1.f;
                if (MODE == 0 || MODE == 2) { const f32x4 q = *(const f32x4*)(ssq + (size_t)(row0 + ai * HALF + m * 16) * 4); rsv[ai][m] = rsqrtf(((q[0] + q[1]) + (q[2] + q[3])) * (1.f / 1024.f) + EPS); } }
#pragma unroll
        for (int bj = 0; bj < 2; ++bj)
#pragma unroll
            for (int n = 0; n < 2; ++n) { bv[bj][n] = (f32x4){0.f, 0.f, 0.f, 0.f}; if (MODE == 0) { if (kind == 2) bv[bj][n] = *(const f32x4*)(bias + col0 + bj * HALF - COL_GATE + 4 * n); } }
        f32x4 nb[2][2];
        if (MODE == 3) {
#pragma unroll
            for (int bj = 0; bj < 2; ++bj)
#pragma unroll
                for (int n = 0; n < 2; ++n) nb[bj][n] = *(const f32x4*)(base + (size_t)row0 * ldc + col0 + bj * HALF + 4 * n);
        }
#pragma unroll
        for (int ai = 0; ai < 2; ++ai)
#pragma unroll
            for (int m = 0; m < 4; ++m) { const size_t roff = (size_t)(row0 + ai * HALF + m * 16) * ldc; float psq = 0.f; const float rs = rsv[ai][m];
                f32x4 cb[2][2];
                if (MODE == 3) {
#pragma unroll
                    for (int bj = 0; bj < 2; ++bj)
#pragma unroll
                        for (int n = 0; n < 2; ++n) cb[bj][n] = nb[bj][n];
                    const int g1 = ai * 4 + m + 1;
                    if (g1 < 8) { const size_t r1 = (size_t)(row0 + (g1 >> 2) * HALF + (g1 & 3) * 16) * ldc;
#pragma unroll
                        for (int bj = 0; bj < 2; ++bj)
#pragma unroll
                            for (int n = 0; n < 2; ++n) nb[bj][n] = *(const f32x4*)(base + r1 + col0 + bj * HALF + 4 * n); }
                }
#pragma unroll
                for (int bj = 0; bj < 2; ++bj) { const int col = col0 + bj * HALF; f32x4 v0 = acc[ai][bj][m][0], v1 = acc[ai][bj][m][1];
                    if (MODE == 3) {
                        v0 = cb[bj][0] + v0; v1 = cb[bj][1] + v1;
                        *(f32x4*)(Of + roff + col) = v0; *(f32x4*)(Of + roff + col + 4) = v1;
                        psq += (v0[0] * v0[0] + v0[1] * v0[1]) + (v0[2] * v0[2] + v0[3] * v0[3]) + (v1[0] * v1[0] + v1[1] * v1[1]) + (v1[2] * v1[2] + v1[3] * v1[3]);
                        u32x4 w; w.x = cvt_pk_bf16(v0[0], v0[1]); w.y = cvt_pk_bf16(v0[2], v0[3]); w.z = cvt_pk_bf16(v1[0], v1[1]); w.w = cvt_pk_bf16(v1[2], v1[3]);
                        *(u32x4*)(XBo + roff + col) = w;
                    } else {
                        if (MODE == 0 || MODE == 2) { v0 = v0 * rs; v1 = v1 * rs; }
                        if (MODE == 0) {
                            if (kind == 2) {
#pragma unroll
                                for (int e = 0; e < 4; ++e) { v0[e] = 1.f / (1.f + __expf(-(v0[e] + bv[bj][0][e]))); v1[e] = 1.f / (1.f + __expf(-(v1[e] + bv[bj][1][e]))); } }
                            else { v0 = v0 * sc; v1 = v1 * sc; }
                        }
                        if (MODE == 2) {
#pragma unroll
                            for (int e = 0; e < 4; ++e) { const float a = fmaxf(v0[e], 0.f), b = fmaxf(v1[e], 0.f); v0[e] = a * a; v1[e] = b * b; } }
                        u32x4 w; w.x = cvt_pk_bf16(v0[0], v0[1]); w.y = cvt_pk_bf16(v0[2], v0[3]); w.z = cvt_pk_bf16(v1[0], v1[1]); w.w = cvt_pk_bf16(v1[2], v1[3]);
                        *(u32x4*)(O + roff + col) = w;
                    } }
                if (MODE == 3) { psq += __shfl_xor(psq, 16); psq += __shfl_xor(psq, 32); if (fq == 0) lx[(ai * HALF + wr * 64 + m * 16 + fr) * 4 + wc] = psq; }
            }
        if (MODE == 3) {
            asm volatile("s_waitcnt lgkmcnt(0)" ::: "memory"); __builtin_amdgcn_s_barrier(); asm volatile("" ::: "memory");
            const int t = threadIdx.x;
            if (t < 256) { const f32x4 q = *(const LAS f32x4*)(lx + t * 4); SSQo[(size_t)(u.pm * BM + t) * 4 + u.pn] = (q[0] + q[1]) + (q[2] + q[3]); }
        }
    }
};

template <class EpiT>
__device__ __forceinline__ void gemm_phase(LAS unsigned char* lds, const Gemm g, const StaticOrder& S, const EpiT& E) {
    int tid_ = threadIdx.x; asm volatile("" : "+v"(tid_));
    const int tid = tid_, wid = __builtin_amdgcn_readfirstlane(tid >> 6), lane = tid & 63, wr = wid >> 2, wc = wid & 3, fr = lane & 15, fq = lane >> 4;
    const int K = g.K, nt = K / BK;
    unsigned voffA[2], voffB[2];
#pragma unroll
    for (int i = 0; i < 2; ++i) { int R, C; stage_rc(tid * 16 + i * 8192, R, C); const int Rb = (R & ~31) + perm32(R & 31);
        voffA[i] = (unsigned)(R * g.lda + C) * 2u; voffB[i] = (unsigned)(Rb * g.ldb + C) * 2u; }
    const size_t kstep = (size_t)(BK * 2);
    const size_t hA = (size_t)HALF * g.lda * 2, hB = (size_t)HALF * g.ldb * 2;
    const size_t tA = 2 * hA, tB = 2 * hB;
    const unsigned ldsw = (unsigned)wid * 1024u;
    const int aoff = lds_byte(wr * 64 + fr, fq * 8), boff = lds_byte(wc * 32 + fr, fq * 8);
#define PG8_SA(b, h) (((b) * 2 + (h)) * HTB)
#define PG8_SB(b, h) ((4 + (b) * 2 + (h)) * HTB)
#define PG8_STAGE(bufoff, gbase, voff) do { _Pragma("unroll") for (int _i = 0; _i < 2; ++_i) \
        __builtin_amdgcn_global_load_lds((const unsigned*)((const char*)(gbase) + (voff)[_i]), (LAS unsigned*)(lds + (bufoff) + ldsw + _i * 8192), 16, 0, 0); } while (0)
#define PG8_LDA(dst, b, h) do { _Pragma("unroll") for (int m = 0; m < 4; ++m) _Pragma("unroll") for (int k = 0; k < 2; ++k) dst[m][k] = *(const LAS bf16x8*)(lds + PG8_SA(b, h) + aoff + m * 2048 + k * 1024); } while (0)
#define PG8_LDB(dst, b, h) do { _Pragma("unroll") for (int n = 0; n < 2; ++n) _Pragma("unroll") for (int k = 0; k < 2; ++k) dst[n][k] = *(const LAS bf16x8*)(lds + PG8_SB(b, h) + boff + n * 2048 + k * 1024); } while (0)
#define PG8_MMA(ai, bj, At, Bt) do { __builtin_amdgcn_s_setprio(1); _Pragma("unroll") for (int m = 0; m < 4; ++m) _Pragma("unroll") for (int n = 0; n < 2; ++n) _Pragma("unroll") for (int k = 0; k < 2; ++k) \
        acc[ai][bj][m][n] = __builtin_amdgcn_mfma_f32_16x16x32_bf16(Bt[n][k], At[m][k], acc[ai][bj][m][n], 0, 0, 0); __builtin_amdgcn_s_setprio(0); } while (0)
#define PG8_WAIT_V(n) asm volatile("s_waitcnt vmcnt(" #n ")" ::: "memory")
#define PG8_WAIT_L(n) asm volatile("s_waitcnt lgkmcnt(" #n ")" ::: "memory")
#define PG8_BAR __builtin_amdgcn_s_barrier()
#define PG8_SCHED __builtin_amdgcn_sched_barrier(0)
#define PG8_PA(u) ((const char*)g.A + (size_t)(u).pm * tA + (size_t)((u).pn / g.adiv) * (size_t)g.astride * 2)
#define PG8_PB(u) ((const char*)g.Bt + (size_t)(u).pn * tB)
    Unit cur, nxt; int ui = 0;
    if (!S.next(0, cur)) return;
    f32x4 acc[2][2][4][2];
#pragma unroll
    for (int a = 0; a < 2; ++a)
#pragma unroll
        for (int b = 0; b < 2; ++b)
#pragma unroll
            for (int m = 0; m < 4; ++m)
#pragma unroll
                for (int n = 0; n < 2; ++n) acc[a][b][m][n] = (f32x4){0.f, 0.f, 0.f, 0.f};
    bf16x8 At[4][2], B0[2][2], B1[2][2];
    const char* cA = PG8_PA(cur); const char* cB = PG8_PB(cur);
    PG8_STAGE(PG8_SB(0, 0), cB, voffB); PG8_STAGE(PG8_SB(0, 1), cB + hB, voffB); PG8_STAGE(PG8_SA(0, 0), cA, voffA); PG8_STAGE(PG8_SA(0, 1), cA + hA, voffA);
    if (wr == 1) PG8_BAR;
    PG8_WAIT_V(2); PG8_BAR;
    PG8_STAGE(PG8_SB(1, 0), cB + kstep, voffB); PG8_STAGE(PG8_SA(1, 0), cA + kstep, voffA); PG8_STAGE(PG8_SB(1, 1), cB + hB + kstep, voffB);
    PG8_WAIT_V(6); PG8_BAR;
    for (;;) {
        const bool has_next = S.next(ui + 1, nxt);
        const char* nA = has_next ? PG8_PA(nxt) : cA; const char* nB = has_next ? PG8_PB(nxt) : cB;
        for (int t = 0; t < nt; t += 2) {
            const bool last = (t == nt - 2);
            const char* a1 = cA + (size_t)(t + 1) * kstep;
            const char* a2 = last ? nA : cA + (size_t)(t + 2) * kstep; const char* b2 = last ? nB : cB + (size_t)(t + 2) * kstep;
            const char* a3 = a2 + kstep; const char* b3 = b2 + kstep;
            PG8_LDB(B0, 0, 0); PG8_LDB(B1, 0, 1); PG8_SCHED; PG8_LDA(At, 0, 0); PG8_STAGE(PG8_SA(1, 1), a1 + hA, voffA);
            PG8_WAIT_V(8); PG8_WAIT_L(0); PG8_BAR; PG8_MMA(0, 0, At, B0); PG8_MMA(0, 1, At, B1); PG8_BAR; PG8_SCHED;
            PG8_LDA(At, 0, 1); PG8_STAGE(PG8_SB(0, 0), b2, voffB); PG8_STAGE(PG8_SB(0, 1), b2 + hB, voffB); PG8_STAGE(PG8_SA(0, 0), a2, voffA);
            PG8_WAIT_V(8); PG8_WAIT_L(0); PG8_BAR; PG8_MMA(1, 0, At, B0); PG8_MMA(1, 1, At, B1); PG8_BAR; PG8_SCHED;
            PG8_LDB(B0, 1, 0); PG8_LDB(B1, 1, 1); PG8_SCHED; PG8_LDA(At, 1, 0); PG8_STAGE(PG8_SA(0, 1), a2 + hA, voffA);
            PG8_WAIT_V(8); PG8_WAIT_L(0); PG8_BAR; PG8_MMA(0, 0, At, B0); PG8_MMA(0, 1, At, B1); PG8_BAR; PG8_SCHED;
            PG8_LDA(At, 1, 1); PG8_STAGE(PG8_SB(1, 0), b3, voffB); PG8_STAGE(PG8_SB(1, 1), b3 + hB, voffB); PG8_STAGE(PG8_SA(1, 0), a3, voffA);
            PG8_WAIT_V(8); PG8_WAIT_L(0); PG8_BAR; PG8_MMA(1, 0, At, B0); PG8_MMA(1, 1, At, B1); PG8_BAR; PG8_SCHED;
        }
        if (wr == 0) PG8_BAR;
        E(acc, cur, wr, wc, fr, fq);
        if (!has_next) break;
#pragma unroll
        for (int a = 0; a < 2; ++a)
#pragma unroll
            for (int b = 0; b < 2; ++b)
#pragma unroll
                for (int m = 0; m < 4; ++m)
#pragma unroll
                    for (int n = 0; n < 2; ++n) acc[a][b][m][n] = (f32x4){0.f, 0.f, 0.f, 0.f};
        cur = nxt; cA = nA; cB = nB; ++ui;
        if (wr == 1) PG8_BAR;
    }
    PG8_WAIT_V(0);
    PG8_BAR;
#undef PG8_SA
#undef PG8_SB
#undef PG8_STAGE
#undef PG8_LDA
#undef PG8_LDB
#undef PG8_MMA
#undef PG8_WAIT_V
#undef PG8_WAIT_L
#undef PG8_BAR
#undef PG8_SCHED
#undef PG8_PA
#undef PG8_PB
}
}

__device__ __forceinline__ void sincos_red(float a, float& s, float& c) {
    const float q = rintf(a * 0.636619772367581f); const int iq = (int)q;
    float r = fmaf(q, -1.5703125f, a); r = fmaf(q, -4.837512969970703125e-4f, r); r = fmaf(q, -7.54978995489188216e-8f, r);
    const float r2 = r * r;
    const float sp = r + r * r2 * (-1.6666654611e-1f + r2 * (8.3321608736e-3f + r2 * (-1.9515295891e-4f)));
    const float cp = 1.0f - 0.5f * r2 + r2 * r2 * (4.166664568298827e-2f + r2 * (-1.388731625493765e-3f + r2 * 2.443315711809948e-5f));
    const int k = iq & 3;
    s = (k == 0) ? sp : (k == 1) ? cp : (k == 2) ? -sp : -cp;
    c = (k == 0) ? cp : (k == 1) ? -sp : (k == 2) ? -cp : sp;
}

namespace attn_body {
using bf16 = __hip_bfloat16;
using s16x4 = __attribute__((ext_vector_type(4))) short;
using f32x16 = __attribute__((ext_vector_type(16))) float;
constexpr int NW = 8, QBLK = 32, QB = QBLK * NW, KVBLK = 64;
constexpr int MA = 0, MB = 1, MC = 2, MD = 3;
__device__ __forceinline__ int crow(int r, int hi) { return (r & 3) + 8 * (r >> 2) + 4 * hi; }
#define SBAR() __builtin_amdgcn_sched_barrier(0)
constexpr int NSLOT = 3, SLOTB = 8192;
constexpr int LDS_K = 0, LDS_V = NSLOT * SLOTB, LDS_WS = 2 * NSLOT * SLOTB, LDS_OST = LDS_WS + NW * 64 * 4, LDS_ATT = LDS_OST + NW * 4096;
typedef __attribute__((address_space(3))) const char* lds_cptr;
typedef __attribute__((address_space(3))) const float* lds_fptr;

struct AttnArgs {
    const bf16* Q; const bf16* K; const bf16* V; bf16* O;
    int qs, ks, os;
    int NT, tlo, thi;
    float s2;
    int q0;
    int kb;
    float* stat; int ss;
    lds_fptr tab;
    const float* gq;
};

__device__ __forceinline__ void glds16(const void* gsrc, unsigned lds_dst) { unsigned keep;
  asm volatile("s_mov_b32 %0, m0\n\ts_mov_b32 m0, %2\n\ts_nop 0\n\tglobal_load_lds_dwordx4 %1, off\n\ts_mov_b32 m0, %0" : "=&s"(keep) : "v"(gsrc), "s"(lds_dst) : "memory"); }
__device__ __forceinline__ float max3f(float a, float b, float c) { float r; asm("v_max3_f32 %0, %1, %2, %3" : "=v"(r) : "v"(a), "v"(b), "v"(c)); return r; }
__device__ __forceinline__ float max2f(float a, float b) { float r; asm("v_max_f32_e32 %0, %1, %2" : "=v"(r) : "v"(a), "v"(b)); return r; }
__device__ __forceinline__ float fadd_s(float a, float b) { float r; asm("v_add_f32_e32 %0, %1, %2" : "=v"(r) : "v"(a), "v"(b)); return r; }
__device__ __forceinline__ float fsub_s(float a, float b) { float r; asm("v_sub_f32_e32 %0, %1, %2" : "=v"(r) : "v"(a), "v"(b)); return r; }
typedef float f32x2_t __attribute__((ext_vector_type(2))); typedef __bf16 bf16x2_t __attribute__((ext_vector_type(2)));
__device__ __forceinline__ unsigned cvtpk_s(float lo, float hi) { f32x2_t v = {lo, hi}; bf16x2_t b = __builtin_convertvector(v, bf16x2_t); return __builtin_bit_cast(unsigned, b); }
#define WAIT_BAR(N) asm volatile("s_waitcnt vmcnt(" #N ") lgkmcnt(0)\n\ts_barrier" ::: "memory")

__device__ __forceinline__ void qkt(f32x16& p0, f32x16& p1, const char* Kslot, const bf16x8* qr, const f32x16& negm, int r32, int hi) {
  const char* kb = Kslot + hi * 1024 + r32 * 16;
  #pragma unroll
  for (int d0 = 0; d0 < 4; ++d0) {
    const bf16x8 b0 = *reinterpret_cast<const bf16x8*>(kb + d0 * 2048);
    const bf16x8 b1 = *reinterpret_cast<const bf16x8*>(kb + d0 * 2048 + 512);
    if (d0 == 0) { p0 = __builtin_amdgcn_mfma_f32_32x32x16_bf16(b0, qr[0], negm, 0, 0, 0); p1 = __builtin_amdgcn_mfma_f32_32x32x16_bf16(b1, qr[0], negm, 0, 0, 0); }
    else { p0 = __builtin_amdgcn_mfma_f32_32x32x16_bf16(b0, qr[d0], p0, 0, 0, 0); p1 = __builtin_amdgcn_mfma_f32_32x32x16_bf16(b1, qr[d0], p1, 0, 0, 0); } }
}
typedef short v4i16_t __attribute__((ext_vector_type(4)));
__device__ __forceinline__ void kload8(bf16x8* kf, lds_cptr kp) {
  kf[0] = *(const LAS bf16x8*)(kp);        kf[1] = *(const LAS bf16x8*)(kp + 512);
  kf[2] = *(const LAS bf16x8*)(kp + 2048); kf[3] = *(const LAS bf16x8*)(kp + 2560);
  kf[4] = *(const LAS bf16x8*)(kp + 4096); kf[5] = *(const LAS bf16x8*)(kp + 4608);
  kf[6] = *(const LAS bf16x8*)(kp + 6144); kf[7] = *(const LAS bf16x8*)(kp + 6656);
}
__device__ __forceinline__ void kload2(bf16x8* kf, lds_cptr kp, int j) { kf[2 * j] = *(const LAS bf16x8*)(kp + j * 2048); kf[2 * j + 1] = *(const LAS bf16x8*)(kp + j * 2048 + 512); }
__device__ __forceinline__ s16x4 vtr(lds_cptr p) { return __builtin_bit_cast(s16x4, __builtin_amdgcn_ds_read_tr16_b64_v4i16((LAS v4i16_t*)p)); }
__device__ __forceinline__ float rowmax(const f32x16& p0, const f32x16& p1) {
  float a = max3f(p0[0], p0[1], p1[0]), b = max3f(p0[2], p0[3], p1[1]); a = max3f(a, p1[2], p1[3]);
  #pragma unroll
  for (int r = 4; r < 16; r += 4) { a = max3f(a, p0[r], p0[r + 1]); b = max3f(b, p0[r + 2], p0[r + 3]); a = max3f(a, p1[r], p1[r + 1]); b = max3f(b, p1[r + 2], p1[r + 3]); }
  const float m = max2f(a, b);
  auto rr = __builtin_amdgcn_permlane32_swap(__float_as_uint(m), __float_as_uint(m), false, false);
  return max2f(__uint_as_float(rr[0]), __uint_as_float(rr[1]));
}
__device__ __forceinline__ void pv(f32x16* o, int vb, bf16x8 pa0, bf16x8 pa1, bf16x8 pa2, bf16x8 pa3) {
  #pragma unroll
  for (int d0 = 0; d0 < 2; ++d0) { s16x4 lo[4], hi[4];
    #pragma unroll
    for (int ks = 0; ks < 4; ++ks) {
      asm volatile("ds_read_b64_tr_b16 %0,%1 offset:%c2" : "=&v"(lo[ks]) : "v"(vb), "i"(d0 * 4096 + ks * 1024) : "memory");
      asm volatile("ds_read_b64_tr_b16 %0,%1 offset:%c2" : "=&v"(hi[ks]) : "v"(vb), "i"(d0 * 4096 + ks * 1024 + 512) : "memory"); }
    asm volatile("s_waitcnt lgkmcnt(0)" ::: "memory"); SBAR();
    #define PK(k) (bf16x8){lo[k][0], lo[k][1], lo[k][2], lo[k][3], hi[k][0], hi[k][1], hi[k][2], hi[k][3]}
    o[d0] = __builtin_amdgcn_mfma_f32_32x32x16_bf16(pa0, PK(0), o[d0], 0, 0, 0);
    o[d0] = __builtin_amdgcn_mfma_f32_32x32x16_bf16(pa1, PK(1), o[d0], 0, 0, 0);
    o[d0] = __builtin_amdgcn_mfma_f32_32x32x16_bf16(pa2, PK(2), o[d0], 0, 0, 0);
    o[d0] = __builtin_amdgcn_mfma_f32_32x32x16_bf16(pa3, PK(3), o[d0], 0, 0, 0);
    #undef PK
  }
}

__device__ __forceinline__ float opq(float x) { asm("" : "+v"(x)); return x; }
template <int MODE> __device__ __forceinline__ void score_hook(f32x16& c0, f32x16& c1, int t, const AttnArgs& a, int qrel, int hi, int wid, int r32, float mh) {
  if constexpr (MODE == MA) {
    const int wlo = a.q0 + wid * QBLK, sd = (64 * t + 63 < wlo) ? 1 : ((64 * t > wlo + 31) ? -1 : 0);
    if (sd != 0) { const float sv = (float)sd * a.s2;
      #pragma unroll
      for (int r = 0; r < 16; ++r) { const float kf = (float)((r & 3) + 8 * (r >> 2)); c0[r] = opq(fmaf(kf, sv, c0[r])); c1[r] = opq(fmaf(kf + 32.f, sv, c1[r])); if ((r & 3) == 3) __builtin_amdgcn_sched_barrier(0); }
    } else {
      const float dq = (float)(a.q0 + qrel - 64 * t - 4 * hi), ns = -a.s2;
      #pragma unroll
      for (int r = 0; r < 16; ++r) { const float kf = (float)((r & 3) + 8 * (r >> 2)); c0[r] = opq(fmaf(ns, fabsf(opq(dq - kf)), c0[r])); c1[r] = opq(fmaf(ns, fabsf(opq(dq - (kf + 32.f))), c1[r])); if ((r & 1) == 1) __builtin_amdgcn_sched_barrier(0); }
    }
  }
  if constexpr (MODE == MB) {
    const bool tv = (t >= a.tlo) && (t <= a.thi);
    const float dq = (float)(qrel + 64 - 64 * t - 4 * hi), ns = -a.s2;
    #pragma unroll
    for (int r = 0; r < 16; ++r) { const float kf = (float)((r & 3) + 8 * (r >> 2)); const float d0 = fabsf(opq(dq - kf)), d1 = fabsf(opq(dq - (kf + 32.f)));
      const float v0_ = opq(fmaf(ns, d0, opq(c0[r] - mh))), v1_ = opq(fmaf(ns, d1, opq(c1[r] - mh)));
      c0[r] = (tv && d0 <= 64.f) ? v0_ : -INFINITY; c1[r] = (tv && d1 <= 64.f) ? v1_ : -INFINITY;
      if ((r & 3) == 3) __builtin_amdgcn_sched_barrier(0); }
  }
  if constexpr (MODE == MC) {
    const int qrow = a.q0 + (wid >> 1), rs = min(max(qrow - 4, 0), 120), krow = a.kb + t;
    if (krow < rs || krow >= rs + 8) {
      #pragma unroll
      for (int r = 0; r < 16; ++r) { c0[r] = -INFINITY; c1[r] = -INFINITY; }
    } else {
      const int qc = (wid & 1) * 32 + r32, cs = min(max(qc - 8, 0), 48);
      const lds_fptr tp = a.tab + (krow - qrow + 7) * 31 + (15 - qc + 4 * hi);
      const int kd = 4 * hi - cs;
      #pragma unroll
      for (int r = 0; r < 16; ++r) { const int kc = (r & 3) + 8 * (r >> 2);
        const float b0 = tp[kc], b1 = tp[kc + 32];
        const float v0_ = opq(c0[r] + opq(b0 - mh)), v1_ = opq(c1[r] + opq(b1 - mh));
        c0[r] = ((unsigned)(kd + kc) < 16u) ? v0_ : -INFINITY; c1[r] = ((unsigned)(kd + kc + 32) < 16u) ? v1_ : -INFINITY;
        if ((r & 3) == 3) __builtin_amdgcn_sched_barrier(0); }
    }
  }
}

template <int MODE, int THRL> __device__ __forceinline__ void attn_unit(const AttnArgs& A_, char* shm) {
  int tid_ = threadIdx.x; asm volatile("" : "+v"(tid_));
  const int tid = tid_, lane = tid & 63, r32 = lane & 31, hi = lane >> 5; const int wid = __builtin_amdgcn_readfirstlane(tid >> 6);
  const bf16* Qw = A_.Q + (wid * QBLK) * A_.qs;
  const unsigned lds0 = (unsigned)(uintptr_t)shm;
  float* wsf = (float*)(shm + LDS_WS) + wid * 64;
  const int ks = A_.ks;
  const bf16* ksrc = A_.K + (lane * ks + wid * 8);
  const bf16* vsrc = A_.V + ((16 * (wid & 3) + (lane >> 2)) * ks + (wid >> 2) * 32 + (lane & 3) * 8);
  const unsigned kdst = lds0 + LDS_K + wid * 1024, vdst = lds0 + LDS_V + wid * 1024;
  #define TT(t) ((MODE == MB) ? min(max((int)(t), A_.tlo), A_.thi) : (int)(t))
  #define DMA_K(t, slot) glds16(ksrc + TT(t) * KVBLK * ks, (unsigned)__builtin_amdgcn_readfirstlane(kdst + (slot)))
  #define DMA_V(t, slot) glds16(vsrc + TT(t) * KVBLK * ks, (unsigned)__builtin_amdgcn_readfirstlane(vdst + (slot)))
  const int vb0 = (int)(lds0 + LDS_V) + ((lane >> 4) & 1) * 32 + (lane & 3) * 8 + (4 * hi + ((lane & 15) >> 2)) * 64;
  const char* Kbase = shm + LDS_K; bf16x8 kf[8];
  const lds_cptr shm3 = (lds_cptr)shm; const lds_cptr kp0 = shm3 + LDS_K + hi * 1024 + r32 * 16; const lds_cptr vp0 = shm3 + LDS_V + ((lane >> 4) & 1) * 32 + (lane & 3) * 8 + (4 * hi + ((lane & 15) >> 2)) * 64;
  const int NT = A_.NT;
  DMA_K(0, 0); DMA_V(0, 0); DMA_K(1, SLOTB);
  bf16x8 qr[4];
  #pragma unroll
  for (int d0 = 0; d0 < 4; ++d0) qr[d0] = *reinterpret_cast<const bf16x8*>(&Qw[r32 * A_.qs + d0 * 16 + hi * 8]);
  if constexpr (MODE == MD) {
    float x[4][8]; float ssq = 0.f;
    #pragma unroll
    for (int d0 = 0; d0 < 4; ++d0)
      #pragma unroll
      for (int j = 0; j < 8; ++j) { x[d0][j] = __uint_as_float((unsigned)(unsigned short)qr[d0][j] << 16); ssq += x[d0][j] * x[d0][j]; }
    { auto rr = __builtin_amdgcn_permlane32_swap(__float_as_uint(ssq), __float_as_uint(ssq), false, false); ssq = __uint_as_float(rr[0]) + __uint_as_float(rr[1]); }
    const float rn = rsqrtf(ssq * (1.f / 64.f) + EPS) * C2;
    const int spos = A_.q0 + wid * QBLK + r32; const float prow = (float)(spos >> 6), pcol = (float)(spos & 63);
    #pragma unroll
    for (int j = 0; j < 8; ++j) { const float inv = exp2f(-(float)(8 * hi + j) * 0.8304820237218406f);
      float sr, cr, sc_, cc_; sincos_red(prow * inv, sr, cr); sincos_red(pcol * inv, sc_, cc_);
      const float g0 = A_.gq[8 * hi + j], g1 = A_.gq[16 + 8 * hi + j], g2 = A_.gq[32 + 8 * hi + j], g3 = A_.gq[48 + 8 * hi + j];
      const float y0 = x[0][j] * rn * g0, y1 = x[1][j] * rn * g1, y2 = x[2][j] * rn * g2, y3 = x[3][j] * rn * g3;
      x[0][j] = y0 * cr - y1 * sr; x[1][j] = y1 * cr + y0 * sr; x[2][j] = y2 * cc_ - y3 * sc_; x[3][j] = y3 * cc_ + y2 * sc_; }
    #pragma unroll
    for (int d0 = 0; d0 < 4; ++d0) { u32x4 w; w.x = pk2(x[d0][0], x[d0][1]); w.y = pk2(x[d0][2], x[d0][3]); w.z = pk2(x[d0][4], x[d0][5]); w.w = pk2(x[d0][6], x[d0][7]); qr[d0] = __builtin_bit_cast(bf16x8, w); }
  }
  float mhat = 0.f, l_reg = 0.f; f32x16 o[2]; o[0] = f32x16{}; o[1] = f32x16{}; f32x16 negm = f32x16{}; asm volatile("" : "+v"(negm));
  const int qrel = wid * QBLK + r32;
  constexpr bool NEGM = (MODE == MA || MODE == MD);
  #define CIN (NEGM ? negm : f32x16{})
  #define NEGM_SET(tn) do { float nb_ = -mhat; \
      if (MODE == MA) { const int wlo_ = A_.q0 + wid * QBLK, sd_ = (64 * (tn) + 63 < wlo_) ? 1 : ((64 * (tn) > wlo_ + 31) ? -1 : 0); \
        if (sd_ != 0) nb_ = fmaf(-(float)sd_ * A_.s2, (float)(A_.q0 + qrel - 64 * (tn) - 4 * hi), nb_); } \
      _Pragma("unroll") for (int r = 0; r < 16; ++r) negm[r] = nb_; asm volatile("" : "+v"(negm)); } while (0)
  #define CMASK(P0, P1, t) score_hook<MODE>(P0, P1, (t), A_, qrel, hi, wid, r32, mhat)
  bool resc = false;
  #define START(P0, P1) do { const float rm = rowmax(P0, P1); resc = false; \
    { const float dl = (MODE == MB || MODE == MC) ? fmaxf(rm, -2048.f) : rm; mhat = fadd_s(mhat, dl); \
      _Pragma("unroll") for (int r = 0; r < 16; ++r) { P0[r] = fsub_s(P0[r], dl); P1[r] = fsub_s(P1[r], dl); } \
      if (NEGM) { NEGM_SET(1); } } \
    _Pragma("unroll") for (int r = 0; r < 16; ++r) P0[r] = __builtin_amdgcn_exp2f(P0[r]); } while (0)
  #define RESC() do { if (resc) { asm volatile("s_waitcnt lgkmcnt(0)" ::: "memory"); \
      _Pragma("unroll") for (int d_ = 0; d_ < 2; ++d_) _Pragma("unroll") for (int r = 0; r < 16; ++r) o[d_][r] *= wsf[crow(r, hi)]; } } while (0)
  f32x16 pA0, pA1, pB0, pB1;
  int sl_prev = 0, sl_cur = 0, sl_next = SLOTB;
  #define ROT() do { sl_prev = sl_cur; sl_cur = sl_next; sl_next = (sl_next == (NSLOT - 1) * SLOTB) ? 0 : sl_next + SLOTB; } while (0)
  DMA_K(2, 2 * SLOTB);
  if (MODE == MA) { NEGM_SET(0); }
  WAIT_BAR(3);
  qkt(pA0, pA1, Kbase, qr, negm, r32, hi); asm volatile("s_nop 15\n\ts_nop 7" : "+v"(pA0), "+v"(pA1)); CMASK(pA0, pA1, 0);
  START(pA0, pA1);
  _Pragma("unroll") for (int r = 0; r < 16; ++r) pA1[r] = __builtin_amdgcn_exp2f(pA1[r]);
  WAIT_BAR(0);
  DMA_K(3, 0); DMA_V(1, SLOTB);
  ROT();
  kload8(kf, kp0 + sl_cur);
  WAIT_BAR(2);
  s16x4 vlo[8], vhi[8]; u32x4 pw0, pw1, pw2, pw3;
  #define PKW(P, B) cvtpk_s(P[B], P[B + 1])
  #define PAF(k) __builtin_bit_cast(bf16x8, pw##k)
  #define VFR(i) (bf16x8){vlo[i][0], vlo[i][1], vlo[i][2], vlo[i][3], vhi[i][0], vhi[i][1], vhi[i][2], vhi[i][3]}
  #define PIN(x) asm volatile("" : "+v"(x))
  #define MX3(a, b, c) __builtin_fmaxf(__builtin_fmaxf((a), (b)), (c))
  #define GAPA(MF, A0, A1, A2, A3, W0, W1, PW) do { MF; sacc += A0; sacc += A1; sacc += A2; sacc += A3; PIN(sacc); W0; W1; PIN(PW); SBAR(); } while (0)
  #define EX(v) __builtin_amdgcn_exp2f(v)
  #define GAPB(MF, X, B) do { MF; X[B] = EX(X[B]); X[B + 1] = EX(X[B + 1]); X[B + 2] = EX(X[B + 2]); X[B + 3] = EX(X[B + 3]); PIN(X); SBAR(); } while (0)
  #define VRD(i) do { vlo[i] = vtr(vp_ + (((i) >> 2) * 4096 + ((i) & 3) * 1024)); vhi[i] = vtr(vp_ + (((i) >> 2) * 4096 + ((i) & 3) * 1024 + 512)); } while (0)
  #define KRD(G, j) do { if (G) { kload2(kf, kp0 + sl_next, j); SBAR(); } } while (0)
  #define STEP(C0, C1, P0, P1, t, GK, GV, GL) do { SBAR(); \
    const lds_cptr vp_ = vp0 + sl_prev; \
    VRD(0); SBAR(); float sacc = (P0[0] + P0[1]); \
    GAPA(C0 = __builtin_amdgcn_mfma_f32_32x32x16_bf16(kf[0], qr[0], CIN, 0, 0, 0), P0[2], P0[3], P0[4], P0[5],     pw0[0] = PKW(P0, 0), pw0[1] = PKW(P0, 2), pw0); \
    VRD(4); SBAR(); GAPA(C1 = __builtin_amdgcn_mfma_f32_32x32x16_bf16(kf[1], qr[0], CIN, 0, 0, 0), P0[6], P0[7], P0[8], P0[9],     pw0[2] = PKW(P0, 4), pw0[3] = PKW(P0, 6), pw0); \
    VRD(1); SBAR(); GAPA(C0 = __builtin_amdgcn_mfma_f32_32x32x16_bf16(kf[2], qr[1], C0, 0, 0, 0),   P0[10], P0[11], P0[12], P0[13], pw1[0] = PKW(P0, 8), pw1[1] = PKW(P0, 10), pw1); \
    VRD(5); SBAR(); GAPA(C1 = __builtin_amdgcn_mfma_f32_32x32x16_bf16(kf[3], qr[1], C1, 0, 0, 0),   P0[14], P0[15], P1[0], P1[1],   pw1[2] = PKW(P0, 12), pw1[3] = PKW(P0, 14), pw1); \
    VRD(2); SBAR(); GAPA(C0 = __builtin_amdgcn_mfma_f32_32x32x16_bf16(kf[4], qr[2], C0, 0, 0, 0),   P1[2], P1[3], P1[4], P1[5],     pw2[0] = PKW(P1, 0), pw2[1] = PKW(P1, 2), pw2); \
    VRD(6); SBAR(); GAPA(C1 = __builtin_amdgcn_mfma_f32_32x32x16_bf16(kf[5], qr[2], C1, 0, 0, 0),   P1[6], P1[7], P1[8], P1[9],     pw2[2] = PKW(P1, 4), pw2[3] = PKW(P1, 6), pw2); \
    VRD(3); SBAR(); GAPA(C0 = __builtin_amdgcn_mfma_f32_32x32x16_bf16(kf[6], qr[3], C0, 0, 0, 0),   P1[10], P1[11], P1[12], P1[13], pw3[0] = PKW(P1, 8), pw3[1] = PKW(P1, 10), pw3); \
    VRD(7); SBAR(); GAPA(C1 = __builtin_amdgcn_mfma_f32_32x32x16_bf16(kf[7], qr[3], C1, 0, 0, 0),   P1[14], P1[15], 0.f, 0.f,       pw3[2] = PKW(P1, 12), pw3[3] = PKW(P1, 14), pw3); \
    l_reg += sacc; \
    if (GK) { DMA_K((t) + 3, sl_cur); } if (GV) { DMA_V((t) + 1, sl_next); } \
    CMASK(C0, C1, t); \
    { float a = MX3(C0[0], C0[1], C1[0]), b = MX3(C0[2], C0[3], C1[1]); a = MX3(a, C1[2], C1[3]); \
      _Pragma("unroll") for (int r = 4; r < 16; r += 4) { a = MX3(a, C0[r], C0[r + 1]); b = MX3(b, C0[r + 2], C0[r + 3]); a = MX3(a, C1[r], C1[r + 1]); b = MX3(b, C1[r + 2], C1[r + 3]); } \
      float rm = __builtin_fmaxf(a, b); { auto rr = __builtin_amdgcn_permlane32_swap(__float_as_uint(rm), __float_as_uint(rm), false, false); rm = __builtin_fmaxf(__uint_as_float(rr[0]), __uint_as_float(rr[1])); } \
      resc = false; \
      if (__builtin_expect(__any(rm > (float)THRL), 0)) { const float dl = __builtin_fmaxf(rm, 0.f); mhat += dl; \
        _Pragma("unroll") for (int r = 0; r < 16; ++r) { C0[r] -= dl; C1[r] -= dl; } \
        if (MODE == MD) { NEGM_SET(0); } \
        const float f = __builtin_amdgcn_exp2f(-dl); l_reg *= f; if (hi == 0) wsf[r32] = f; resc = true; } \
      if (MODE == MA) { NEGM_SET((t) + 1); } } \
    SBAR(); \
    GAPB(o[0] = __builtin_amdgcn_mfma_f32_32x32x16_bf16(PAF(0), VFR(0), o[0], 0, 0, 0), C0, 0); \
    GAPB(o[1] = __builtin_amdgcn_mfma_f32_32x32x16_bf16(PAF(0), VFR(4), o[1], 0, 0, 0), C0, 4); \
    KRD(GL, 0); GAPB(o[0] = __builtin_amdgcn_mfma_f32_32x32x16_bf16(PAF(1), VFR(1), o[0], 0, 0, 0), C0, 8); \
    KRD(GL, 1); GAPB(o[1] = __builtin_amdgcn_mfma_f32_32x32x16_bf16(PAF(1), VFR(5), o[1], 0, 0, 0), C0, 12); \
    KRD(GL, 2); GAPB(o[0] = __builtin_amdgcn_mfma_f32_32x32x16_bf16(PAF(2), VFR(2), o[0], 0, 0, 0), C1, 0); \
    KRD(GL, 3); GAPB(o[1] = __builtin_amdgcn_mfma_f32_32x32x16_bf16(PAF(2), VFR(6), o[1], 0, 0, 0), C1, 4); \
    GAPB(o[0] = __builtin_amdgcn_mfma_f32_32x32x16_bf16(PAF(3), VFR(3), o[0], 0, 0, 0), C1, 8); \
    GAPB(o[1] = __builtin_amdgcn_mfma_f32_32x32x16_bf16(PAF(3), VFR(7), o[1], 0, 0, 0), C1, 12); \
    } while (0)
  int t = 1;
  for (; t + 5 < NT; t += 2) {
    STEP(pB0, pB1, pA0, pA1, t, true, true, true);     WAIT_BAR(2); RESC(); ROT();
    STEP(pA0, pA1, pB0, pB1, t + 1, true, true, true); WAIT_BAR(2); RESC(); ROT();
  }
  #define ENDW(tt) do { if ((tt) + 3 < NT) { WAIT_BAR(2); } else if ((tt) + 2 < NT) { WAIT_BAR(1); } else { WAIT_BAR(0); } } while (0)
  for (; t + 1 < NT; t += 2) {
    STEP(pB0, pB1, pA0, pA1, t, (t + 3 < NT), (t + 1 < NT), (t + 1 < NT));         ENDW(t);     RESC(); ROT();
    STEP(pA0, pA1, pB0, pB1, t + 1, (t + 4 < NT), (t + 2 < NT), (t + 2 < NT));     ENDW(t + 1); RESC(); ROT();
  }
  STEP(pB0, pB1, pA0, pA1, NT - 1, false, false, false); RESC();
  { float sacc = pB0[0] + pB0[1]; _Pragma("unroll") for (int r = 2; r < 16; ++r) sacc += pB0[r]; _Pragma("unroll") for (int r = 0; r < 16; ++r) sacc += pB1[r]; l_reg += sacc;
    pw0 = (u32x4){PKW(pB0, 0), PKW(pB0, 2), PKW(pB0, 4), PKW(pB0, 6)}; pw1 = (u32x4){PKW(pB0, 8), PKW(pB0, 10), PKW(pB0, 12), PKW(pB0, 14)}; pw2 = (u32x4){PKW(pB1, 0), PKW(pB1, 2), PKW(pB1, 4), PKW(pB1, 6)}; pw3 = (u32x4){PKW(pB1, 8), PKW(pB1, 10), PKW(pB1, 12), PKW(pB1, 14)};
    SBAR(); pv(o, vb0 + sl_cur, PAF(0), PAF(1), PAF(2), PAF(3)); }
  #undef PKW
  #undef PAF
  #undef VFR
  #undef PIN
  #undef MX3
  #undef GAPA
  #undef GAPB
  #undef EX
  #undef VRD
  #undef KRD
  #undef STEP
  #undef ENDW
  { auto rr = __builtin_amdgcn_permlane32_swap(__float_as_uint(l_reg), __float_as_uint(l_reg), false, false); l_reg = __uint_as_float(rr[0]) + __uint_as_float(rr[1]); }
  if (MODE == MB) { if (hi == 0) { float* sp = A_.stat + (wid * QBLK + r32) * A_.ss; sp[0] = mhat; sp[1] = l_reg; } }
  if (hi == 0) wsf[32 + r32] = l_reg; asm volatile("s_waitcnt lgkmcnt(0)" ::: "memory");
  float rli[16];
  #pragma unroll
  for (int r = 0; r < 16; ++r) rli[r] = __builtin_amdgcn_rcpf(wsf[32 + crow(r, hi)]);
  bf16* Ow = A_.O + (wid * QBLK) * A_.os;
  { bf16* stg = (bf16*)(shm + LDS_OST) + wid * 2048;
    #pragma unroll
    for (int r = 0; r < 16; ++r) { const int orow = crow(r, hi);
      #pragma unroll
      for (int d0 = 0; d0 < 2; ++d0) stg[orow * 64 + d0 * 32 + r32] = __float2bfloat16(o[d0][r] * rli[r]); }
    asm volatile("s_waitcnt lgkmcnt(0)" ::: "memory");
    #pragma unroll
    for (int i = 0; i < 4; ++i) { const int row = i * 8 + (lane >> 3), ch = lane & 7; const u32x4 v = *(const u32x4*)(stg + row * 64 + ch * 8); *(u32x4*)(Ow + row * A_.os + ch * 8) = v; } }
  asm volatile("s_waitcnt lgkmcnt(0)\n\ts_barrier" ::: "memory");
  #undef DMA_K
  #undef DMA_V
  #undef TT
  #undef CMASK
  #undef CIN
  #undef NEGM_SET
  #undef START
  #undef RESC
  #undef ROT
}

constexpr int L8_K = 0, L8_V = 3 * 8192, L8_WS = L8_V + 3 * 16384, L8_QO = L8_WS + 2048, L8_END = L8_QO + 8 * 4096;
template <int THRL> __device__ __forceinline__ void attn_unit128(const AttnArgs& A_, char* shm) {
  int tid_ = threadIdx.x; asm volatile("" : "+v"(tid_));
  const int tid = tid_, lane = tid & 63, r32 = lane & 31, hi = lane >> 5; const int wid = __builtin_amdgcn_readfirstlane(tid >> 6);
  const bf16* Qw = A_.Q + (wid * QBLK) * A_.qs;
  const unsigned lds0 = (unsigned)(uintptr_t)shm;
  float* wsf = (float*)(shm + L8_WS) + wid * 64;
  const int ks = A_.ks;
  const bf16* ksrc = A_.K + (lane * ks + wid * 8);
  const bf16* vsrc = A_.V + ((16 * (wid & 3) + (lane >> 2)) * ks + (wid >> 2) * 32 + (lane & 3) * 8);
  const unsigned kdst = lds0 + L8_K + wid * 1024, vdst = lds0 + L8_V + wid * 1024;
  #define DMA_K(t, slot) glds16(ksrc + (int)(t) * KVBLK * ks, (unsigned)__builtin_amdgcn_readfirstlane(kdst + (slot)))
  #define DMA_V(t, slot) do { glds16(vsrc + (int)(t) * KVBLK * ks, (unsigned)__builtin_amdgcn_readfirstlane(vdst + 2 * (slot))); \
                              glds16(vsrc + (int)(t) * KVBLK * ks + 64, (unsigned)__builtin_amdgcn_readfirstlane(vdst + 2 * (slot) + 8192)); } while (0)
  const int vb0 = (int)(lds0 + L8_V) + ((lane >> 4) & 1) * 32 + (lane & 3) * 8 + (4 * hi + ((lane & 15) >> 2)) * 64;
  const char* Kbase = shm + L8_K; bf16x8 kf[8];
  const lds_cptr shm3 = (lds_cptr)shm; const lds_cptr kp0 = shm3 + L8_K + hi * 1024 + r32 * 16; const lds_cptr vp0 = shm3 + L8_V + ((lane >> 4) & 1) * 32 + (lane & 3) * 8 + (4 * hi + ((lane & 15) >> 2)) * 64;
  const lds_cptr qst = shm3 + L8_QO + wid * 4096 + lane * 16;
  const int NT = A_.NT;
  DMA_K(0, 0); DMA_V(0, 0); DMA_K(1, SLOTB);
  { bf16x8 qr[4];
    #pragma unroll
    for (int d0 = 0; d0 < 4; ++d0) qr[d0] = *reinterpret_cast<const bf16x8*>(&Qw[r32 * A_.qs + d0 * 16 + hi * 8]);
    #pragma unroll
    for (int d0 = 0; d0 < 4; ++d0) *(LAS bf16x8*)(shm3 + L8_QO + wid * 4096 + lane * 16 + d0 * 1024) = qr[d0]; }
  #define QLD(d0) (*(const LAS bf16x8*)(qst + (d0) * 1024))
  float mhat = 0.f, l_reg = 0.f; f32x16 o[4]; o[0] = f32x16{}; o[1] = f32x16{}; o[2] = f32x16{}; o[3] = f32x16{};
  const int qrel = wid * QBLK + r32;
  #define NB(tn) ({ float nb_ = -mhat; const int wlo_ = A_.q0 + wid * QBLK, sd_ = (64 * (tn) + 63 < wlo_) ? 1 : ((64 * (tn) > wlo_ + 31) ? -1 : 0); \
      if (sd_ != 0) nb_ = fmaf(-(float)sd_ * A_.s2, (float)(A_.q0 + qrel - 64 * (tn) - 4 * hi), nb_); nb_; })
  #define CMASK(P0, P1, t) score_hook<MA>(P0, P1, (t), A_, qrel, hi, wid, r32, mhat)
  bool resc = false;
  #define RESC() do { if (resc) { asm volatile("s_waitcnt lgkmcnt(0)" ::: "memory"); \
      _Pragma("unroll") for (int d_ = 0; d_ < 4; ++d_) _Pragma("unroll") for (int r = 0; r < 16; ++r) o[d_][r] *= wsf[crow(r, hi)]; } } while (0)
  f32x16 pA0, pA1, pB0, pB1;
  int sl_prev = 0, sl_cur = 0, sl_next = SLOTB;
  #define ROT() do { sl_prev = sl_cur; sl_cur = sl_next; sl_next = (sl_next == (NSLOT - 1) * SLOTB) ? 0 : sl_next + SLOTB; } while (0)
  DMA_K(2, 2 * SLOTB);
  WAIT_BAR(4);
  { f32x16 cin; const float nb0 = NB(0);
    #pragma unroll
    for (int r = 0; r < 16; ++r) cin[r] = nb0;
    bf16x8 qr[4];
    #pragma unroll
    for (int d0 = 0; d0 < 4; ++d0) qr[d0] = QLD(d0);
    qkt(pA0, pA1, Kbase, qr, cin, r32, hi); }
  asm volatile("s_nop 15\n\ts_nop 7" : "+v"(pA0), "+v"(pA1)); CMASK(pA0, pA1, 0);
  { const float rm = rowmax(pA0, pA1); mhat = fadd_s(mhat, rm);
    #pragma unroll
    for (int r = 0; r < 16; ++r) { pA0[r] = fsub_s(pA0[r], rm); pA1[r] = fsub_s(pA1[r], rm); }
    #pragma unroll
    for (int r = 0; r < 16; ++r) pA0[r] = __builtin_amdgcn_exp2f(pA0[r]);
    #pragma unroll
    for (int r = 0; r < 16; ++r) pA1[r] = __builtin_amdgcn_exp2f(pA1[r]); }
  WAIT_BAR(0);
  DMA_K(3, 0); DMA_V(1, SLOTB);
  ROT();
  kload8(kf, kp0 + sl_cur);
  WAIT_BAR(3);
  u32x4 pw0, pw1, pw2, pw3;
  #define PKW(P, B) cvtpk_s(P[B], P[B + 1])
  #define PAF(k) __builtin_bit_cast(bf16x8, pw##k)
  #define PIN(x) asm volatile("" : "+v"(x))
  #define MX3(a, b, c) __builtin_fmaxf(__builtin_fmaxf((a), (b)), (c))
  #define GAPA(MF, A0, A1, A2, A3, W0, W1, PW) do { MF; sacc += A0; sacc += A1; sacc += A2; sacc += A3; PIN(sacc); W0; W1; PIN(PW); SBAR(); } while (0)
  #define EX(v) __builtin_amdgcn_exp2f(v)
  #define GAPB(MF, X, B) do { MF; X[B] = EX(X[B]); X[B + 1] = EX(X[B + 1]); PIN(X); SBAR(); } while (0)
  #define KRD(G, j) do { if (G) { kload2(kf, kp0 + sl_next, j); SBAR(); } } while (0)
  #define FOFF(j) (((((j) & 1) + 2 * ((j) >> 3)) * 4096) + ((((j) >> 1) & 3) * 1024))
  #define FRD(j) do { fl[j] = vtr(vp_ + FOFF(j)); fh[j] = vtr(vp_ + FOFF(j) + 512); SBAR(); } while (0)
  #define FFR(j) (bf16x8){fl[j][0], fl[j][1], fl[j][2], fl[j][3], fh[j][0], fh[j][1], fh[j][2], fh[j][3]}
  #define STEP(C0, C1, P0, P1, t, GK, GV, GL) do { SBAR(); \
    const lds_cptr vp_ = vp0 + 2 * sl_prev; s16x4 fl[16], fh[16]; \
    { const float nb_t = NB(t); _Pragma("unroll") for (int r = 0; r < 16; ++r) { C0[r] = nb_t; C1[r] = nb_t; } } \
    bf16x8 q0_ = QLD(0), q1_ = QLD(1); SBAR(); float sacc = (P0[0] + P0[1]); \
    GAPA(C0 = __builtin_amdgcn_mfma_f32_32x32x16_bf16(kf[0], q0_, C0, 0, 0, 0), P0[2], P0[3], P0[4], P0[5],     pw0[0] = PKW(P0, 0), pw0[1] = PKW(P0, 2), pw0); \
    GAPA(C1 = __builtin_amdgcn_mfma_f32_32x32x16_bf16(kf[1], q0_, C1, 0, 0, 0), P0[6], P0[7], P0[8], P0[9],     pw0[2] = PKW(P0, 4), pw0[3] = PKW(P0, 6), pw0); \
    q0_ = QLD(2); SBAR(); \
    GAPA(C0 = __builtin_amdgcn_mfma_f32_32x32x16_bf16(kf[2], q1_, C0, 0, 0, 0),   P0[10], P0[11], P0[12], P0[13], pw1[0] = PKW(P0, 8), pw1[1] = PKW(P0, 10), pw1); \
    GAPA(C1 = __builtin_amdgcn_mfma_f32_32x32x16_bf16(kf[3], q1_, C1, 0, 0, 0),   P0[14], P0[15], P1[0], P1[1],   pw1[2] = PKW(P0, 12), pw1[3] = PKW(P0, 14), pw1); \
    q1_ = QLD(3); SBAR(); \
    GAPA(C0 = __builtin_amdgcn_mfma_f32_32x32x16_bf16(kf[4], q0_, C0, 0, 0, 0),   P1[2], P1[3], P1[4], P1[5],     pw2[0] = PKW(P1, 0), pw2[1] = PKW(P1, 2), pw2); \
    GAPA(C1 = __builtin_amdgcn_mfma_f32_32x32x16_bf16(kf[5], q0_, C1, 0, 0, 0),   P1[6], P1[7], P1[8], P1[9],     pw2[2] = PKW(P1, 4), pw2[3] = PKW(P1, 6), pw2); \
    GAPA(C0 = __builtin_amdgcn_mfma_f32_32x32x16_bf16(kf[6], q1_, C0, 0, 0, 0),   P1[10], P1[11], P1[12], P1[13], pw3[0] = PKW(P1, 8), pw3[1] = PKW(P1, 10), pw3); \
    GAPA(C1 = __builtin_amdgcn_mfma_f32_32x32x16_bf16(kf[7], q1_, C1, 0, 0, 0),   P1[14], P1[15], 0.f, 0.f,       pw3[2] = PKW(P1, 12), pw3[3] = PKW(P1, 14), pw3); \
    l_reg += sacc; \
    if (GK) { DMA_K((t) + 3, sl_cur); } if (GV) { DMA_V((t) + 1, sl_next); } \
    FRD(0); FRD(1); FRD(2); \
    CMASK(C0, C1, t); \
    { float a = MX3(C0[0], C0[1], C1[0]), b = MX3(C0[2], C0[3], C1[1]); a = MX3(a, C1[2], C1[3]); \
      _Pragma("unroll") for (int r = 4; r < 16; r += 4) { a = MX3(a, C0[r], C0[r + 1]); b = MX3(b, C0[r + 2], C0[r + 3]); a = MX3(a, C1[r], C1[r + 1]); b = MX3(b, C1[r + 2], C1[r + 3]); } \
      float rm = __builtin_fmaxf(a, b); { auto rr = __builtin_amdgcn_permlane32_swap(__float_as_uint(rm), __float_as_uint(rm), false, false); rm = __builtin_fmaxf(__uint_as_float(rr[0]), __uint_as_float(rr[1])); } \
      resc = false; \
      if (__builtin_expect(__any(rm > (float)THRL), 0)) { const float dl = __builtin_fmaxf(rm, 0.f); mhat += dl; \
        _Pragma("unroll") for (int r = 0; r < 16; ++r) { C0[r] -= dl; C1[r] -= dl; } \
        const float f = __builtin_amdgcn_exp2f(-dl); l_reg *= f; if (hi == 0) wsf[r32] = f; resc = true; } } \
    SBAR(); \
    GAPB(o[0] = __builtin_amdgcn_mfma_f32_32x32x16_bf16(PAF(0), FFR(0), o[0], 0, 0, 0), C0, 0);   FRD(3); \
    GAPB(o[1] = __builtin_amdgcn_mfma_f32_32x32x16_bf16(PAF(0), FFR(1), o[1], 0, 0, 0), C0, 2);   FRD(4); \
    GAPB(o[0] = __builtin_amdgcn_mfma_f32_32x32x16_bf16(PAF(1), FFR(2), o[0], 0, 0, 0), C0, 4);   FRD(5); \
    GAPB(o[1] = __builtin_amdgcn_mfma_f32_32x32x16_bf16(PAF(1), FFR(3), o[1], 0, 0, 0), C0, 6);   FRD(6); \
    GAPB(o[0] = __builtin_amdgcn_mfma_f32_32x32x16_bf16(PAF(2), FFR(4), o[0], 0, 0, 0), C0, 8);   FRD(7); \
    GAPB(o[1] = __builtin_amdgcn_mfma_f32_32x32x16_bf16(PAF(2), FFR(5), o[1], 0, 0, 0), C0, 10);  FRD(8); \
    GAPB(o[0] = __builtin_amdgcn_mfma_f32_32x32x16_bf16(PAF(3), FFR(6), o[0], 0, 0, 0), C0, 12);  FRD(9); \
    GAPB(o[1] = __builtin_amdgcn_mfma_f32_32x32x16_bf16(PAF(3), FFR(7), o[1], 0, 0, 0), C0, 14);  FRD(10); \
    KRD(GL, 0); GAPB(o[2] = __builtin_amdgcn_mfma_f32_32x32x16_bf16(PAF(0), FFR(8), o[2], 0, 0, 0), C1, 0);   FRD(11); \
    KRD(GL, 1); GAPB(o[3] = __builtin_amdgcn_mfma_f32_32x32x16_bf16(PAF(0), FFR(9), o[3], 0, 0, 0), C1, 2);   FRD(12); \
    KRD(GL, 2); GAPB(o[2] = __builtin_amdgcn_mfma_f32_32x32x16_bf16(PAF(1), FFR(10), o[2], 0, 0, 0), C1, 4);  FRD(13); \
    KRD(GL, 3); GAPB(o[3] = __builtin_amdgcn_mfma_f32_32x32x16_bf16(PAF(1), FFR(11), o[3], 0, 0, 0), C1, 6);  FRD(14); \
    GAPB(o[2] = __builtin_amdgcn_mfma_f32_32x32x16_bf16(PAF(2), FFR(12), o[2], 0, 0, 0), C1, 8);  FRD(15); \
    GAPB(o[3] = __builtin_amdgcn_mfma_f32_32x32x16_bf16(PAF(2), FFR(13), o[3], 0, 0, 0), C1, 10); \
    GAPB(o[2] = __builtin_amdgcn_mfma_f32_32x32x16_bf16(PAF(3), FFR(14), o[2], 0, 0, 0), C1, 12); \
    GAPB(o[3] = __builtin_amdgcn_mfma_f32_32x32x16_bf16(PAF(3), FFR(15), o[3], 0, 0, 0), C1, 14); \
    } while (0)
  int t = 1;
  for (; t + 5 < NT; t += 2) {
    STEP(pB0, pB1, pA0, pA1, t, true, true, true);     WAIT_BAR(3); RESC(); ROT();
    STEP(pA0, pA1, pB0, pB1, t + 1, true, true, true); WAIT_BAR(3); RESC(); ROT();
  }
  #define ENDW(tt) do { if ((tt) + 3 < NT) { WAIT_BAR(3); } else if ((tt) + 2 < NT) { WAIT_BAR(2); } else { WAIT_BAR(0); } } while (0)
  for (; t + 1 < NT; t += 2) {
    STEP(pB0, pB1, pA0, pA1, t, (t + 3 < NT), (t + 1 < NT), (t + 1 < NT));         ENDW(t);     RESC(); ROT();
    STEP(pA0, pA1, pB0, pB1, t + 1, (t + 4 < NT), (t + 2 < NT), (t + 2 < NT));     ENDW(t + 1); RESC(); ROT();
  }
  STEP(pB0, pB1, pA0, pA1, NT - 1, false, false, false); RESC();
  { float sacc = pB0[0] + pB0[1]; _Pragma("unroll") for (int r = 2; r < 16; ++r) sacc += pB0[r]; _Pragma("unroll") for (int r = 0; r < 16; ++r) sacc += pB1[r]; l_reg += sacc;
    pw0 = (u32x4){PKW(pB0, 0), PKW(pB0, 2), PKW(pB0, 4), PKW(pB0, 6)}; pw1 = (u32x4){PKW(pB0, 8), PKW(pB0, 10), PKW(pB0, 12), PKW(pB0, 14)}; pw2 = (u32x4){PKW(pB1, 0), PKW(pB1, 2), PKW(pB1, 4), PKW(pB1, 6)}; pw3 = (u32x4){PKW(pB1, 8), PKW(pB1, 10), PKW(pB1, 12), PKW(pB1, 14)};
    SBAR(); pv(o, vb0 + 2 * sl_cur, PAF(0), PAF(1), PAF(2), PAF(3)); pv(o + 2, vb0 + 2 * sl_cur + 8192, PAF(0), PAF(1), PAF(2), PAF(3)); }
  #undef PKW
  #undef PAF
  #undef PIN
  #undef MX3
  #undef GAPA
  #undef GAPB
  #undef EX
  #undef FOFF
  #undef FRD
  #undef FFR
  #undef KRD
  #undef STEP
  #undef ENDW
  { auto rr = __builtin_amdgcn_permlane32_swap(__float_as_uint(l_reg), __float_as_uint(l_reg), false, false); l_reg = __uint_as_float(rr[0]) + __uint_as_float(rr[1]); }
  if (hi == 0) wsf[32 + r32] = l_reg; asm volatile("s_waitcnt lgkmcnt(0)" ::: "memory");
  float rli[16];
  #pragma unroll
  for (int r = 0; r < 16; ++r) rli[r] = __builtin_amdgcn_rcpf(wsf[32 + crow(r, hi)]);
  bf16* Ow = A_.O + (wid * QBLK) * A_.os;
  { bf16* stg = (bf16*)(shm + L8_QO) + wid * 2048;
    #pragma unroll
    for (int hv = 0; hv < 2; ++hv) {
      #pragma unroll
      for (int r = 0; r < 16; ++r) { const int orow = crow(r, hi);
        #pragma unroll
        for (int d0 = 0; d0 < 2; ++d0) stg[orow * 64 + d0 * 32 + r32] = __float2bfloat16(o[2 * hv + d0][r] * rli[r]); }
      asm volatile("s_waitcnt lgkmcnt(0)" ::: "memory");
      #pragma unroll
      for (int i = 0; i < 4; ++i) { const int row = i * 8 + (lane >> 3), ch = lane & 7; const u32x4 v = *(const u32x4*)(stg + row * 64 + ch * 8); *(u32x4*)(Ow + row * A_.os + hv * 64 + ch * 8) = v; }
      asm volatile("s_waitcnt lgkmcnt(0)" ::: "memory"); } }
  asm volatile("s_waitcnt lgkmcnt(0)\n\ts_barrier" ::: "memory");
  #undef DMA_K
  #undef DMA_V
  #undef QLD
  #undef NB
  #undef CMASK
  #undef RESC
  #undef ROT
}
#undef SBAR
#undef WAIT_BAR
}

__device__ __forceinline__ void transpose_item(const float* W, int K, int N, bf16_t* WT, LAS float* scr, int item, int lane, const float* gk = nullptr) {
    const int nblk = N / 32, kb = item / nblk, nb = item % nblk, k0 = 64 * kb, n0 = 32 * nb;
#pragma unroll 8
    for (int i = 0; i < 32; ++i) { const int kk = 2 * i + (lane >> 5); const float gg = gk ? gk[k0 + kk] : 1.f; scr[kk * 33 + (lane & 31)] = W[(size_t)(k0 + kk) * N + n0 + (lane & 31)] * gg; }
    asm volatile("s_waitcnt lgkmcnt(0)" ::: "memory");
    const int c = lane & 7;
#pragma unroll
    for (int j = 0; j < 4; ++j) { const int n = (lane >> 3) + 8 * j; const LAS float* s = scr + (8 * c) * 33 + n;
        u32x4 o; o.x = pk2(s[0 * 33], s[1 * 33]); o.y = pk2(s[2 * 33], s[3 * 33]); o.z = pk2(s[4 * 33], s[5 * 33]); o.w = pk2(s[6 * 33], s[7 * 33]);
        *(u32x4*)(WT + (size_t)(n0 + n) * K + k0 + 8 * c) = o; }
    asm volatile("s_waitcnt lgkmcnt(0)" ::: "memory");
}
__device__ __forceinline__ void rms_row_bf16(const float* xrow, const float* g, bf16_t* orow, int lane) {
    const f32x4* xr = (const f32x4*)xrow + lane; const f32x4* gr = (const f32x4*)g + lane;
    f32x4 v[4]; float s = 0.f;
#pragma unroll
    for (int j = 0; j < 4; ++j) { v[j] = xr[64 * j]; s += (v[j].x * v[j].x + v[j].y * v[j].y) + (v[j].z * v[j].z + v[j].w * v[j].w); }
    const float rs = rsqrtf(wave_sum(s) * (1.f / DM) + EPS);
    u32x2* o8 = (u32x2*)orow + lane;
#pragma unroll
    for (int j = 0; j < 4; ++j) { const f32x4 gg = gr[64 * j]; u32x2 w; w.x = pk2(v[j].x * rs * gg.x, v[j].y * rs * gg.y); w.y = pk2(v[j].z * rs * gg.z, v[j].w * rs * gg.w); o8[64 * j] = w; }
}

#define XB_TMO      128
#define XB_XCNT(j)  (256  + 64 * (j))
#define XB_XSUB(j)  (1280 + 64 * (j))
#define XB_XGEN(j)  (2304 + 64 * (j))
#define XB_TOP      3328
#define XB_TOPGEN   3392
#define XCD_BAR_WORDS 3456
#define XB_SPIN_CAP (1u << 18)

__device__ __forceinline__ unsigned xb_ld(unsigned* p)              { return __hip_atomic_load(p, __ATOMIC_RELAXED, __HIP_MEMORY_SCOPE_AGENT); }
__device__ __forceinline__ unsigned xb_add(unsigned* p, unsigned v) { return __hip_atomic_fetch_add(p, v, __ATOMIC_RELAXED, __HIP_MEMORY_SCOPE_AGENT); }
__device__ __forceinline__ unsigned xb_xcc_id() { return (unsigned)__builtin_amdgcn_s_getreg((3 << 11) | 20) & 0xFu; }
#define XB_SPIN(cond, bar) do { unsigned _sp = 0; while (cond) { __builtin_amdgcn_s_sleep(1); \
    if ((++_sp & 255u) == 0u) { if (xb_ld(&(bar)[XB_TMO])) break; if (_sp > XB_SPIN_CAP) { atomicAdd(&(bar)[XB_TMO], 1u); break; } } } } while (0)

struct XcdBarrier {
    unsigned* bar; unsigned x;
    volatile LAS unsigned* st;
};

__device__ __forceinline__ XcdBarrier xcd_barrier_post(unsigned* bar, volatile LAS unsigned* st) {
    XcdBarrier b; b.bar = bar; b.x = xb_xcc_id(); b.st = st;
    if (threadIdx.x == 0) (void)xb_add(&bar[XB_XCNT(b.x)], 1u);
    return b;
}
__device__ __forceinline__ void xcd_barrier_complete(unsigned* bar, unsigned x, unsigned& nloc, unsigned& nx) {
    const unsigned G = gridDim.x * gridDim.y * gridDim.z;
    unsigned sum, cnt, mine, sp = 0u;
    for (;;) {
        sum = 0u; cnt = 0u; mine = 0u;
#pragma unroll
        for (unsigned j = 0; j < 16; ++j) { const unsigned c = xb_ld(&bar[XB_XCNT(j)]); sum += c; cnt += (c > 0u) ? 1u : 0u; mine = (j == x) ? c : mine; }
        if (sum == G) break;
        __builtin_amdgcn_s_sleep(1);
        if ((++sp & 255u) == 0u) { if (xb_ld(&bar[XB_TMO])) break; if (sp > XB_SPIN_CAP) { atomicAdd(&bar[XB_TMO], 1u); break; } }
    }
    nloc = mine > 0u ? mine : 1u; nx = cnt > 0u ? cnt : 1u;
}

__device__ __forceinline__ void xcd_barrier(const XcdBarrier& b) {
    asm volatile("s_waitcnt vmcnt(0)" ::: "memory");
    __syncthreads();
    if (threadIdx.x == 0) {
        unsigned* bar = b.bar;
        __builtin_amdgcn_s_waitcnt(0);
        unsigned nloc = b.st[0], nx = b.st[1];
        if (nloc == 0u) { xcd_barrier_complete(bar, b.x, nloc, nx); b.st[0] = nloc; b.st[1] = nx; }
        const unsigned old = xb_add(&bar[XB_XSUB(b.x)], 1u);
        const unsigned gen = old / nloc;
        if (old + 1u == (gen + 1u) * nloc) {
            __builtin_amdgcn_fence(__ATOMIC_RELEASE, "agent");
            asm volatile("s_waitcnt vmcnt(0)" ::: "memory");
            const unsigned og = xb_add(&bar[XB_TOP], 1u);
            const unsigned tg = og / nx;
            if (og + 1u == (tg + 1u) * nx) xb_add(&bar[XB_TOPGEN], 1u);
            else XB_SPIN(xb_ld(&bar[XB_TOPGEN]) == tg, bar);
            __builtin_amdgcn_fence(__ATOMIC_ACQUIRE, "agent");
            xb_add(&bar[XB_XGEN(b.x)], 1u);
            asm volatile("s_waitcnt vmcnt(0)" ::: "memory");
        } else {
            XB_SPIN(xb_ld(&bar[XB_XGEN(b.x)]) == gen, bar);
            __builtin_amdgcn_fence(__ATOMIC_ACQUIRE, "agent");
            asm volatile("s_waitcnt vmcnt(0)" ::: "memory");
        }
    }
    __syncthreads();
}


struct Args { const float* in[14]; float* out; unsigned char* ws; };

__global__ void __launch_bounds__(512) mk_fwd(Args args) {
    extern __shared__ __attribute__((aligned(16))) unsigned char lds[];
    cg::grid_group grid = cg::this_grid();
    const int tid0 = threadIdx.x, wave = __builtin_amdgcn_readfirstlane(tid0 >> 6);
#define FRESH_LANE() int tid = tid0; asm volatile("" : "+v"(tid)); const int lane = tid & 63
    const int G = gridDim.x, bx = blockIdx.x;
    const int vcu = (G % 8 == 0) ? (bx % 8) * (G / 8) + bx / 8 : bx;
    const int gw = vcu * 8 + wave, NGW = G * 8;
    LAS unsigned char* ldsl = (LAS unsigned char*)lds;
    if (tid0 < 8) ((LAS unsigned*)(ldsl + MISC_OFF))[tid0] = 0u;
    __syncthreads();
    const XcdBarrier xbar = xcd_barrier_post((unsigned*)(args.ws + WS_BAR), (volatile LAS unsigned*)(ldsl + MISC_OFF));
#define ws (args.ws)
#define x_in (args.in[0])
#define norm_mix (args.in[1])
#define w_in (args.in[2])
#define b_gate (args.in[3])
#define diff_lambda (args.in[4])
#define diff_subln (args.in[5])
#define na_rpb (args.in[6])
#define qk_norm (args.in[7])
#define w_branch (args.in[8])
#define w_out (args.in[9])
#define norm_ffn (args.in[10])
#define w_ff1 (args.in[11])
#define w_ff2 (args.in[12])
#define norm_final (args.in[13])
#define xout (args.out)
#define WinT ((bf16_t*)(ws + WS_WIN))
#define WbrT ((bf16_t*)(ws + WS_WBR))
#define WoutT ((bf16_t*)(ws + WS_WOUT))
#define W1T ((bf16_t*)(ws + WS_W1))
#define W2T ((bf16_t*)(ws + WS_W2))
#define STAT ((float*)(ws + WS_STAT))
#define H ((bf16_t*)(ws + WS_H))
#define ATMP ((bf16_t*)(ws + WS_ATMP))
#define BTMP ((bf16_t*)(ws + WS_BTMP))
#define Y ((bf16_t*)(ws + WS_Y))
#define MERGED ((bf16_t*)(ws + WS_MERGED))
#define Z ((bf16_t*)(ws + WS_Z))
#define U ((bf16_t*)(ws + WS_Z))
#define PROJ ((bf16_t*)(ws + WS_PROJ))
#define XB ((bf16_t*)(ws + WS_XB))
#define SSQM ((float*)(ws + WS_SSQM))
#define SSQF ((float*)(ws + WS_SSQF))
#define NRMQ ((unsigned*)(ws + WS_NRM))
#define NRMK ((unsigned*)(ws + WS_NRM) + 1024)

    {
        FRESH_LANE();
        LAS float* scr = (LAS float*)(ldsl + wave * 16384);
        constexpr int I_IN = (DM / 64) * (INW / 32), I_BR = (512 / 64) * (DM / 32), I_OUT = (DM / 64) * (DM / 32), I_1 = (DM / 64) * (DFF / 32), I_2 = (DFF / 64) * (DM / 32);
        constexpr int NITEMS = 2 * I_IN + 8 * I_BR + 2 * I_OUT + 2 * I_1 + 2 * I_2;
        for (int it = gw; it < NITEMS; it += NGW) {
            int r = it;
            if (r < 2 * I_IN) { const int l = r / I_IN; transpose_item(w_in + (size_t)l * DM * INW, DM, INW, WinT + (size_t)l * INW * DM, scr, r % I_IN, lane, norm_mix + l * DM); continue; } r -= 2 * I_IN;
            if (r < 8 * I_BR) { const int ln = r / I_BR; transpose_item(w_branch + (size_t)ln * 512 * DM, 512, DM, WbrT + (size_t)ln * DM * 512, scr, r % I_BR, lane); continue; } r -= 8 * I_BR;
            if (r < 2 * I_OUT) { const int l = r / I_OUT; transpose_item(w_out + (size_t)l * DM * DM, DM, DM, WoutT + (size_t)l * DM * DM, scr, r % I_OUT, lane); continue; } r -= 2 * I_OUT;
            if (r < 2 * I_1) { const int l = r / I_1; transpose_item(w_ff1 + (size_t)l * DM * DFF, DM, DFF, W1T + (size_t)l * DFF * DM, scr, r % I_1, lane, norm_ffn + l * DM); continue; } r -= 2 * I_1;
            { const int l = r / I_2; transpose_item(w_ff2 + (size_t)l * DFF * DM, DFF, DM, W2T + (size_t)l * DM * DFF, scr, r % I_2, lane); }
        }
        {
            f32x4 v[4], vn[4] = {};
            if (gw < NTOK) { const f32x4* xr = (const f32x4*)(x_in + (size_t)gw * DM) + lane;
#pragma unroll
                for (int j = 0; j < 4; ++j) v[j] = xr[64 * j]; }
            for (int m = gw; m < NTOK; m += NGW) {
                if (m + NGW < NTOK) { const f32x4* xr = (const f32x4*)(x_in + (size_t)(m + NGW) * DM) + lane;
#pragma unroll
                    for (int j = 0; j < 4; ++j) vn[j] = xr[64 * j]; }
                u32x2* o8 = (u32x2*)(XB + (size_t)m * DM) + lane; float sq = 0.f;
#pragma unroll
                for (int j = 0; j < 4; ++j) { sq += (v[j].x * v[j].x + v[j].y * v[j].y) + (v[j].z * v[j].z + v[j].w * v[j].w); u32x2 w; w.x = pk2(v[j].x, v[j].y); w.y = pk2(v[j].z, v[j].w); o8[64 * j] = w; }
                sq = wave_sum(sq);
                if (lane == 0) *(f32x4*)(SSQM + (size_t)m * 4) = (f32x4){sq, 0.f, 0.f, 0.f};
#pragma unroll
                for (int j = 0; j < 4; ++j) v[j] = vn[j];
            }
        }
    }
    grid.sync();

    for (int l = 0; l < DEPTH; ++l) {
        { FRESH_LANE(); LAS float* tab = (LAS float*)(ldsl + TAB_OFF); for (int i = tid; i < 8 * 465; i += 512) tab[i] = na_rpb[l * 8 * 465 + i] * LOG2E; }
        __syncthreads();
        for (int grp = 0; grp < NGRP; ++grp) {
            const size_t tok0 = (size_t)grp * TG;
            const float* xsrc = (l == 0) ? x_in : xout;
            {
                pg8::Gemm g{XB + tok0 * DM, WinT + (size_t)l * INW * DM, DM, DM, DM, 1 << 30, 0}; pg8::StaticOrder S; S.init(TG, INW, G, bx);
                if (bx == 0) { FRESH_LANE(); NRMQ[tid] = 0u; NRMQ[tid + 512] = 0u; if (tid < 16) NRMQ[1024 + tid] = 0u; (void)lane; }
                pg8::Epi<0> E{PROJ, nullptr, nullptr, b_gate + l * 4096, INW, SSQM + tok0 * 4, nullptr, nullptr, nullptr};
                pg8::gemm_phase(ldsl, g, S, E);
            }
            xcd_barrier(xbar);
            {
                FRESH_LANE();
                const float inv = exp2f(-(float)(lane & 15) * 0.8304820237218406f);
                const float gk = qk_norm[l * 128 + 64 + lane];
                const int per = (TG + NGW - 1) / NGW;
                float mq = 0.f, mk = 0.f; int cu = -1;
                u32x4 qv, kv, qvn = {}, kvn = {}; unsigned short rw[2], rwn[2] = {};
#define P3_LOAD(QV, KV, RW, mm) do { const bf16_t* ar_ = PROJ + (size_t)(mm) * INW; QV = *(const u32x4*)(ar_ + COL_AQ + lane * 8); KV = *(const u32x4*)(ar_ + COL_AK + lane * 8); \
                    _Pragma("unroll") for (int hd = 0; hd < 2; ++hd) RW[hd] = ar_[COL_DK + hd * 64 + lane]; } while (0)
                if (gw * per < TG) P3_LOAD(qv, kv, rw, gw * per);
                for (int i = 0; i < per; ++i) {
                    const int m = gw * per + i; if (m >= TG) break;
                    if (i + 1 < per && m + 1 < TG) P3_LOAD(qvn, kvn, rwn, m + 1);
                    if ((m >> 8) != cu) { if (cu >= 0 && (lane & 7) == 0) { atomicMax(NRMQ + cu * 8 + (lane >> 3), __float_as_uint(mq)); atomicMax(NRMK + (cu >> 5) * 8 + (lane >> 3), __float_as_uint(mk)); } cu = m >> 8; mq = 0.f; mk = 0.f; }
                    const int s = (int)((tok0 + m) % SEQ); const float pos = (float)((lane < 32) ? (s >> 6) : (s & 63));
                    float sn, cs; sincos_red(pos * inv, sn, cs);
                    { float nq = 0.f, nk = 0.f;
#pragma unroll
                      for (int e = 0; e < 4; ++e) { nq += bflo(qv[e]) * bflo(qv[e]) + bfhi(qv[e]) * bfhi(qv[e]); nk += bflo(kv[e]) * bflo(kv[e]) + bfhi(kv[e]) * bfhi(kv[e]); }
                      nq += __shfl_xor(nq, 1); nk += __shfl_xor(nk, 1); nq += __shfl_xor(nq, 2); nk += __shfl_xor(nk, 2); nq += __shfl_xor(nq, 4); nk += __shfl_xor(nk, 4);
                      mq = fmaxf(mq, sqrtf(nq)); mk = fmaxf(mk, sqrtf(nk)); }
                    bf16_t* row = PROJ + (size_t)m * INW + COL_DK;
#pragma unroll
                    for (int hd = 0; hd < 2; ++hd) {
                        const float v = __uint_as_float((unsigned)rw[hd] << 16);
                        const float rn = rsqrtf(wave_sum(v * v) * (1.f / 64.f) + EPS);
                        const float y = v * rn * gk;
                        const float p = __shfl_xor(y, 16);
                        const float o = ((lane >> 4) & 1) ? (y * cs + p * sn) : (y * cs - p * sn);
                        row[hd * 64 + lane] = (bf16_t)f2bf(o);
                    }
                    qv = qvn; kv = kvn;
#pragma unroll
                    for (int hd = 0; hd < 2; ++hd) rw[hd] = rwn[hd];
                }
#undef P3_LOAD
                if (cu >= 0 && (lane & 7) == 0) { atomicMax(NRMQ + cu * 8 + (lane >> 3), __float_as_uint(mq)); atomicMax(NRMK + (cu >> 5) * 8 + (lane >> 3), __float_as_uint(mk)); }
            }
            xcd_barrier(xbar);
            {
                using namespace attn_body;
                char* shm = (char*)lds;
                {
                    unsigned* qctr = (unsigned*)(ws + WS_BAR) + 3584 + (l * NGRP + grp) * 8;
                    volatile LAS unsigned* slot = (volatile LAS unsigned*)(ldsl + MISC_OFF + 32);
                    const int myx = (G % 8 == 0) ? (vcu / (G / 8)) : 0;
                    int qq = 0;
                    for (;;) {
                        if (tid0 == 0) { int fj = -1, fx = 0;
                            for (; qq < 8; ++qq) { const int x_ = (myx + qq) & 7; const int j_ = (int)atomicAdd(qctr + x_, 1u); if (j_ < 288) { fj = j_; fx = x_; break; } }
                            slot[0] = (unsigned)fj; slot[1] = (unsigned)fx; }
                        __syncthreads();
                        const int j = (int)slot[0], sx = (int)slot[1];
                        __syncthreads();
                        if (j < 0) break;
                        if (j < 128) {
                            AttnArgs a{}; a.qs = INW; a.ks = INW; a.NT = 128; a.tlo = 0; a.thi = 127;
                            if (j >= 32 && j < 96) { const int qb = j & 31, ds = 2 * sx + ((j - 32) >> 5), bb = ds >> 3, h = ds & 7; const size_t tb = (size_t)bb * SEQ;
                                a.Q = (const bf16*)(PROJ + (tb + qb * 256) * INW + COL_DQ + h * 64); a.K = (const bf16*)(PROJ + tb * INW + COL_DK + (h >> 2) * 64);
                                a.V = (const bf16*)(PROJ + tb * INW + COL_DV + (h >> 2) * 64); a.O = (bf16*)(Y + (tb + qb * 256) * 2048 + 1536 + h * 64); a.os = 2048;
                                a.q0 = qb * 256; a.gq = qk_norm + l * 128;
                                attn_unit<MD, 16>(a, shm);
                            } else {
                                int bb, hh, comp, qb;
                                if (j < 32) { bb = sx >> 2; hh = 2 + ((sx >> 1) & 1); comp = sx & 1; qb = j; }
                                else { const int s1 = sx >> 1; bb = s1 >> 1; comp = s1 & 1; hh = (j < 112) ? 1 : 0; qb = (sx & 1) * 16 + ((j - 96) & 15); }
                                const size_t tb = (size_t)bb * SEQ;
                                a.Q = (const bf16*)(PROJ + (tb + qb * 256) * INW + COL_AQ + hh * 128 + comp * 64); a.K = (const bf16*)(PROJ + tb * INW + COL_AK + hh * 128 + comp * 64);
                                a.V = (const bf16*)(PROJ + tb * INW + COL_AV + hh * 128); a.O = (bf16*)(ATMP + (tb + qb * 256) * 1024 + (hh * 2 + comp) * 128); a.os = 1024;
                                a.s2 = exp2f(-2.f * (float)(hh + 1)) * LOG2E;
                                const float Bs = __uint_as_float(NRMQ[(bb * 32 + qb) * 8 + hh * 2 + comp]) * __uint_as_float(NRMK[bb * 8 + hh * 2 + comp]) * 1.02f + 0.25f;
                                const float dlim = fminf((150.f + 2.f * Bs) / a.s2, 1.0e6f), q0f = (float)(qb * 256);
                                int tlo = max(0, (int)floorf((q0f - 63.f - dlim) * (1.f / 64.f))), thi = min(127, (int)ceilf((q0f + 255.f + dlim) * (1.f / 64.f)));
                                if (((thi - tlo + 1) & 1) != 0) { if (tlo > 0) --tlo; else ++thi; }
                                tlo = __builtin_amdgcn_readfirstlane(tlo); thi = __builtin_amdgcn_readfirstlane(thi);
                                a.K += (size_t)tlo * 64 * INW; a.V += (size_t)tlo * 64 * INW; a.q0 = qb * 256 - 64 * tlo; a.NT = thi - tlo + 1;
                                attn_unit128<16>(a, shm);
                            }
                        } else if (j < 192) {
                            const int cs = 2 * sx + ((j - 128) >> 5), qb = (j - 128) & 31, bb = cs >> 3, h = cs & 7, r0 = 4 * qb, kb = min(max(r0 - 4, 0), 116); const size_t tb = (size_t)bb * SEQ;
                            AttnArgs a{}; a.qs = INW; a.ks = INW; a.os = 2048; a.NT = 12; a.tlo = 0; a.thi = 11; a.q0 = r0; a.kb = kb;
                            a.Q = (const bf16*)(PROJ + (tb + r0 * 64) * INW + COL_CQ + h * 64); a.K = (const bf16*)(PROJ + (tb + kb * 64) * INW + COL_CK + h * 64);
                            a.V = (const bf16*)(PROJ + (tb + kb * 64) * INW + COL_CV + h * 64); a.O = (bf16*)(Y + (tb + r0 * 64) * 2048 + 1024 + h * 64);
                            a.tab = (lds_fptr)((lds_cptr)shm + TAB_OFF) + h * 465;
                            attn_unit<MC, 8>(a, shm);
                        } else {
                            const int p = j - 192, sg = 6 * sx + (p >> 4);
                            for (int e = 0; e < 2; ++e) {
                                const int blk = 2 * (p & 15) + e, bb = sg / 24, k = sg % 24, gp = k >> 3, h = k & 7, dsh = 2 * gp, dil = 1 << dsh;
                                const int nblk = 32 >> dsh, res = blk / nblk, i0 = (blk % nblk) * 256, L = SEQ >> dsh;
                                const long tq = (long)bb * SEQ + res + (long)i0 * dil, tk = (long)bb * SEQ + res + (long)(i0 - 64) * dil;
                                AttnArgs a{}; a.qs = dil * INW; a.ks = dil * INW; a.os = dil * 1536; a.NT = 6; a.tlo = (i0 == 0) ? 1 : 0; a.thi = (i0 + 256 == L) ? 4 : 5;
                                const int cq = COL_B + gp * 1536 + h * 64;
                                a.Q = (const bf16*)(PROJ + tq * INW + cq); a.K = (const bf16*)(PROJ + tk * INW + cq + 512); a.V = (const bf16*)(PROJ + tk * INW + cq + 1024);
                                a.O = (bf16*)(BTMP + tq * 1536 + gp * 512 + h * 64);
                                a.s2 = exp2f(-(float)(h + 1)) * (float)dil * LOG2E; a.stat = STAT + (tq * 24 + gp * 8 + h) * 2; a.ss = dil * 48;
                                attn_unit<MB, 8>(a, shm);
                            }
                        }
                    }
                }
            }
            xcd_barrier(xbar);
            {
                FRESH_LANE();
                int l_ = l; asm volatile("" : "+s"(l_));
                const float lam_init = (l_ == 0) ? 0.2f : (0.8f - 0.6f * 0.7408182206817179f);
                float lam;
                { const float* lp = diff_lambda + l * 256; const float a = lp[lane] * lp[64 + lane], b = lp[128 + lane] * lp[192 + lane]; lam = expf(wave_sum(a)) - expf(wave_sum(b)) + lam_init; lam = __uint_as_float(__builtin_amdgcn_readfirstlane(__float_as_uint(lam))); }
                const float out_scale = 1.f - lam_init;
                const float g0 = diff_subln[l * 128 + 2 * lane], g1 = diff_subln[l * 128 + 2 * lane + 1];
                const int h = lane >> 3, d8 = (lane & 7) * 8;
                unsigned aw[8]; u32x4 bw[3]; float sv[6];
#define P5_LOAD(AW, BW, SV, mm) do { const unsigned* at_ = (const unsigned*)(ATMP + (size_t)(mm) * 1024); _Pragma("unroll") for (int q = 0; q < 8; ++q) AW[q] = at_[q * 64 + lane]; \
                    const bf16_t* bt_ = BTMP + (size_t)(mm) * 1536 + h * 64 + d8; _Pragma("unroll") for (int g = 0; g < 3; ++g) BW[g] = *(const u32x4*)(bt_ + g * 512); \
                    const float* st_ = STAT + (size_t)(mm) * 48 + h * 2; _Pragma("unroll") for (int g = 0; g < 3; ++g) { SV[2 * g] = st_[16 * g]; SV[2 * g + 1] = st_[16 * g + 1]; } } while (0)
                for (int m = gw; m < TG; m += NGW) {
                    P5_LOAD(aw, bw, sv, m);
                    unsigned* yr = (unsigned*)(Y + (size_t)m * 2048);
#pragma unroll
                    for (int hh = 0; hh < 4; ++hh) {
                        const unsigned w0 = aw[hh * 2], w1 = aw[hh * 2 + 1];
                        const float d0 = bflo(w0) - lam * bflo(w1), d1 = bfhi(w0) - lam * bfhi(w1);
                        const float rn = rsqrtf(wave_sum(d0 * d0 + d1 * d1) * (1.f / 128.f) + EPS) * out_scale;
                        yr[hh * 64 + lane] = pk2(d0 * rn * g0, d1 * rn * g1);
                    }
                    const float m0 = sv[0], l0 = sv[1], m1 = sv[2], l1 = sv[3], m2 = sv[4], l2 = sv[5];
                    const float ms = fmaxf(m0, fmaxf(m1, m2));
                    const float w0 = l0 * exp2f(m0 - ms), w1 = l1 * exp2f(m1 - ms), w2 = l2 * exp2f(m2 - ms); const float inv = 1.f / (w0 + w1 + w2);
                    const u32x4 a0 = bw[0], a1 = bw[1], a2 = bw[2];
                    u32x4 o;
#pragma unroll
                    for (int e = 0; e < 4; ++e) { const float lo = (w0 * bflo(a0[e]) + w1 * bflo(a1[e]) + w2 * bflo(a2[e])) * inv, hi = (w0 * bfhi(a0[e]) + w1 * bfhi(a1[e]) + w2 * bfhi(a2[e])) * inv; o[e] = pk2(lo, hi); }
                    *(u32x4*)(Y + (size_t)m * 2048 + 512 + h * 64 + d8) = o;
                }
#undef P5_LOAD
            }
            xcd_barrier(xbar);
            {
                pg8::Gemm g{Y, WbrT + (size_t)l * 4096 * 512, 2048, 512, 512, 4, 512}; pg8::StaticOrder S; S.init(TG, 4096, G, bx);
                pg8::Epi<1> E{Z, nullptr, nullptr, nullptr, 4096, nullptr, nullptr, nullptr, nullptr};
                pg8::gemm_phase(ldsl, g, S, E);
            }
            xcd_barrier(xbar);
            { FRESH_LANE();
            u32x4 gv[2][4], zv[2][4];
#define P7_LOAD(GV, ZV, mm) do { const bf16_t* gr_ = PROJ + (size_t)(mm) * INW + COL_GATE + lane * 8; const bf16_t* zr_ = Z + (size_t)(mm) * 4096 + lane * 8; \
                _Pragma("unroll") for (int jj = 0; jj < 2; ++jj) _Pragma("unroll") for (int n = 0; n < 4; ++n) { GV[jj][n] = *(const u32x4*)(gr_ + n * 1024 + jj * 512); ZV[jj][n] = *(const u32x4*)(zr_ + n * 1024 + jj * 512); } } while (0)
            for (int m = gw; m < TG; m += NGW) {
                P7_LOAD(gv, zv, m);
#pragma unroll
                for (int j = 0; j < 2; ++j) { const int c = lane * 8 + j * 512; float acc[8] = {0.f, 0.f, 0.f, 0.f, 0.f, 0.f, 0.f, 0.f};
#pragma unroll
                    for (int n = 0; n < 4; ++n) {
#pragma unroll
                        for (int e = 0; e < 4; ++e) { acc[2 * e] += bflo(gv[j][n][e]) * bflo(zv[j][n][e]); acc[2 * e + 1] += bfhi(gv[j][n][e]) * bfhi(zv[j][n][e]); } }
                    u32x4 o; o.x = pk2(acc[0], acc[1]); o.y = pk2(acc[2], acc[3]); o.z = pk2(acc[4], acc[5]); o.w = pk2(acc[6], acc[7]);
                    *(u32x4*)(MERGED + (size_t)m * DM + c) = o; }
#undef P7_LOAD
            } }
            xcd_barrier(xbar);
            {
                pg8::Gemm g{MERGED, WoutT + (size_t)l * DM * DM, DM, DM, DM, 1 << 30, 0}; pg8::StaticOrder S; S.init(TG, DM, G, bx);
                pg8::Epi<3> E{nullptr, xout + tok0 * DM, xsrc + tok0 * DM, nullptr, DM, nullptr, H, SSQF, (LAS float*)(ldsl + SSQ_OFF)};
                pg8::gemm_phase(ldsl, g, S, E);
            }
            xcd_barrier(xbar);
            {
                pg8::Gemm g{H, W1T + (size_t)l * DFF * DM, DM, DM, DM, 1 << 30, 0}; pg8::StaticOrder S; S.init(TG, DFF, G, bx);
                pg8::Epi<2> E{U, nullptr, nullptr, nullptr, DFF, SSQF, nullptr, nullptr, nullptr};
                pg8::gemm_phase(ldsl, g, S, E);
            }
            xcd_barrier(xbar);
            {
                pg8::Gemm g{U, W2T + (size_t)l * DM * DFF, DFF, DFF, DFF, 1 << 30, 0}; pg8::StaticOrder S; S.init(TG, DM, G, bx);
                pg8::Epi<3> E{nullptr, xout + tok0 * DM, xout + tok0 * DM, nullptr, DM, nullptr, XB + tok0 * DM, SSQM + tok0 * 4, (LAS float*)(ldsl + SSQ_OFF)};
                pg8::gemm_phase(ldsl, g, S, E);
            }
            if (l == DEPTH - 1 && grp == NGRP - 1) xcd_barrier(xbar);
        }
    }
    {
        FRESH_LANE();
        const f32x4* g4 = (const f32x4*)norm_final + lane; f32x4 gg[4];
#pragma unroll
        for (int j = 0; j < 4; ++j) gg[j] = g4[64 * j];
        f32x4 v[4], vn[4] = {};
        if (gw < NTOK) { const f32x4* o = (const f32x4*)(xout + (size_t)gw * DM) + lane;
#pragma unroll
            for (int j = 0; j < 4; ++j) v[j] = o[64 * j]; }
        for (int m = gw; m < NTOK; m += NGW) {
            if (m + NGW < NTOK) { const f32x4* on = (const f32x4*)(xout + (size_t)(m + NGW) * DM) + lane;
#pragma unroll
                for (int j = 0; j < 4; ++j) vn[j] = on[64 * j]; }
            f32x4* o = (f32x4*)(xout + (size_t)m * DM) + lane; float sq = 0.f;
#pragma unroll
            for (int j = 0; j < 4; ++j) sq += (v[j].x * v[j].x + v[j].y * v[j].y) + (v[j].z * v[j].z + v[j].w * v[j].w);
            const float r = rsqrtf(wave_sum(sq) * (1.f / DM) + EPS);
#pragma unroll
            for (int j = 0; j < 4; ++j) o[64 * j] = (f32x4){v[j].x * r * gg[j].x, v[j].y * r * gg[j].y, v[j].z * r * gg[j].z, v[j].w * r * gg[j].w};
#pragma unroll
            for (int j = 0; j < 4; ++j) v[j] = vn[j];
        }
    }
}

#undef ws
#undef x_in
#undef norm_mix
#undef w_in
#undef b_gate
#undef diff_lambda
#undef diff_subln
#undef na_rpb
#undef qk_norm
#undef w_branch
#undef w_out
#undef norm_ffn
#undef w_ff1
#undef w_ff2
#undef norm_final
#undef xout
#undef WinT
#undef WbrT
#undef WoutT
#undef W1T
#undef W2T
#undef STAT
#undef H
#undef ATMP
#undef BTMP
#undef Y
#undef MERGED
#undef Z
#undef U
#undef PROJ
#undef NRMQ
#undef XB
#undef SSQM
#undef SSQF
#undef NRMK

extern "C" void kernel_launch(void* const* d_in, const int* in_sizes, int n_in, void* d_out, int out_size, void* d_ws, size_t ws_size, hipStream_t stream) {
    static int grid_blocks = 0;
    if (!grid_blocks) {
        int dev = 0, cus = 0, per_cu = 0;
        (void)hipGetDevice(&dev);
        (void)hipDeviceGetAttribute(&cus, hipDeviceAttributeMultiprocessorCount, dev);
        (void)hipFuncSetAttribute((const void*)mk_fwd, hipFuncAttributeMaxDynamicSharedMemorySize, LDS_BYTES);
        (void)hipOccupancyMaxActiveBlocksPerMultiprocessor(&per_cu, (const void*)mk_fwd, 512, LDS_BYTES);
        if (per_cu < 1) per_cu = 1;
        grid_blocks = cus * per_cu;
        if (ws_size < WS_END || n_in != 14) { fprintf(stderr, "kernel_launch: workspace %zu < %zu or n_in %d != 14\n", ws_size, (size_t)WS_END, n_in); grid_blocks = -1; }
    }
    if (grid_blocks < 0) return;
    (void)hipMemsetAsync((char*)d_ws + WS_BAR, 0, 16384, stream);
    Args a{};
    for (int i = 0; i < 14; ++i) a.in[i] = (const float*)d_in[i];
    a.out = (float*)d_out; a.ws = (unsigned char*)d_ws;
    void* kargs[] = {&a};
    hipError_t e = hipLaunchCooperativeKernel((const void*)mk_fwd, dim3(grid_blocks), dim3(512), kargs, LDS_BYTES, stream);
    if (e != hipSuccess) fprintf(stderr, "cooperative launch failed: %s (grid %d)\n", hipGetErrorString(e), grid_blocks);
}
```

```cpp
#include <hip/hip_runtime.h>
#include <hip/hip_cooperative_groups.h>
#include <hip/hip_bf16.h>
#include <cstdio>
#include <cstdint>
#include <cmath>
namespace cg = cooperative_groups;

constexpr int BATCH = 8, SEQ = 8192, DM = 1024, NTOK = BATCH * SEQ, INW = 12544, DFF = 4096, DEPTH = 2;
constexpr int GB = 2, TG = GB * SEQ, NGRP = BATCH / GB;
constexpr float EPS = 1e-6f;
constexpr float LOG2E = 1.4426950408889634f;
constexpr float C2 = 0.125f * LOG2E;
constexpr int COL_AQ = 0, COL_AK = 512, COL_AV = 1024, COL_B = 1536, COL_CQ = 6144, COL_CK = 6656, COL_CV = 7168, COL_DQ = 7680, COL_DK = 8192, COL_DV = 8320, COL_GATE = 8448;
constexpr size_t MiB = 1u << 20;
constexpr size_t WS_WIN = 0, WS_WBR = 49 * MiB, WS_WOUT = 57 * MiB, WS_W1 = 61 * MiB, WS_W2 = 77 * MiB, WS_STAT = 93 * MiB, WS_H = 96 * MiB, WS_ATMP = 128 * MiB,
                 WS_BTMP = 160 * MiB, WS_Y = 208 * MiB, WS_MERGED = 272 * MiB, WS_Z = 304 * MiB, WS_PROJ = 432 * MiB, WS_NRM = 824 * MiB, WS_BAR = 824 * MiB + 512 * 1024, WS_SSQM = 825 * MiB, WS_SSQF = 826 * MiB, WS_XB = 827 * MiB, WS_END = 955 * MiB;
constexpr int LDS_BYTES = 151552, TAB_OFF = 131072, MISC_OFF = 147072, SSQ_OFF = 147456;

#define LAS __attribute__((address_space(3)))
typedef unsigned short bf16_t;
typedef short bf16x8 __attribute__((ext_vector_type(8)));
typedef float f32x4 __attribute__((ext_vector_type(4)));
typedef unsigned u32x4 __attribute__((ext_vector_type(4)));
typedef unsigned u32x2 __attribute__((ext_vector_type(2)));

__device__ __forceinline__ unsigned f2bf(float f) { unsigned u = __builtin_bit_cast(unsigned, f); return (u + 0x7fffu + ((u >> 16) & 1u)) >> 16; }
__device__ __forceinline__ unsigned pk2(float lo, float hi) { return f2bf(lo) | (f2bf(hi) << 16); }
__device__ __forceinline__ float bflo(unsigned w) { return __uint_as_float(w << 16); }
__device__ __forceinline__ float bfhi(unsigned w) { return __uint_as_float(w & 0xffff0000u); }
__device__ __forceinline__ float wave_sum(float v) {
#pragma unroll
    for (int o = 1; o < 64; o <<= 1) v += __shfl_xor(v, o);
    return v;
}

namespace pg8 {
constexpr int BM = 256, BK = 64, HALF = 128, HTB = HALF * BK * 2, STAGE_BYTES = 8 * HTB, NXCD = 8, WGM = 4;
__host__ __device__ __forceinline__ int lds_byte(int r, int c) { const int st = (r >> 4) * 2 + (c >> 5), rr = r & 15, cc = c & 31, ob = rr * 64 + cc * 2; return st * 1024 + (ob ^ (((ob >> 9) & 1) << 5)); }
__host__ __device__ __forceinline__ void stage_rc(int b, int& R, int& C) { const int st = b / 1024, sb = b % 1024, swz = sb ^ (((sb >> 9) & 1) << 5); R = (st >> 1) * 16 + swz / 64; C = (st & 1) * 32 + (swz % 64) / 2; }
__host__ __device__ __forceinline__ int perm32(int rho) { const int n = rho >> 4, i = rho & 15; return 8 * (i >> 2) + 4 * n + (i & 3); }

struct Unit { int pm, pn; };
struct Gemm { const bf16_t* A; const bf16_t* Bt; int lda, ldb, K, adiv, astride; };

struct StaticOrder {
    int nM, nN, nwg, G, c;
    __device__ void init(int M, int N, int G_, int c_) { nM = M / BM; nN = N / BM; nwg = nM * nN; G = G_; c = c_; }
    __device__ bool next(int i, Unit& u) const {
        const long L = (long)i * G + c; if (L >= nwg) return false;
        int wgid = (int)L; { const int q = nwg / NXCD, r = nwg % NXCD, xcd = wgid % NXCD, off = wgid / NXCD; wgid = (xcd < r ? xcd * (q + 1) : r * (q + 1) + (xcd - r) * q) + off; }
        const int nig = WGM * nN, gid = wgid / nig, fm = gid * WGM, gsz = (nM - fm) < WGM ? (nM - fm) : WGM;
        u.pm = fm + ((wgid % nig) % gsz); u.pn = (wgid % nig) / gsz; return true;
    }
};

__device__ __forceinline__ unsigned cvt_pk_bf16(float lo, float hi) { unsigned r; asm volatile("v_cvt_pk_bf16_f32 %0, %1, %2" : "=v"(r) : "v"(lo), "v"(hi)); return r; }

template <int MODE> struct Epi {
    bf16_t* O; float* Of; const float* base; const float* bias; int ldc;
    const float* ssq;
    bf16_t* XBo; float* SSQo; LAS float* lx;
    __device__ __forceinline__ void operator()(const f32x4 (&acc)[2][2][4][2], const Unit& u, int wr, int wc, int fr, int fq) const {
        const int row0 = u.pm * BM + wr * 64 + fr, col0 = u.pn * BM + wc * 32 + 8 * fq;
        int kind = 0; float sc = 1.f;
        if (MODE == 0) { const int pn = u.pn; if (pn >= 33) kind = 2; else if (pn < 2 || pn == 6 || pn == 7 || pn == 12 || pn == 13 || pn == 18 || pn == 19 || pn == 24 || pn == 25) sc = C2; }
        float rsv[2][4]; f32x4 bv[2][2];
#pragma unroll
        for (int ai = 0; ai < 2; ++ai)
#pragma unroll
            for (int m = 0; m < 4; ++m) { rsv[ai][m] = 1.f;
                if (MODE == 0 || MODE == 2) { const f32x4 q = *(const f32x4*)(ssq + (size_t)(row0 + ai * HALF + m * 16) * 4); rsv[ai][m] = rsqrtf(((q[0] + q[1]) + (q[2] + q[3])) * (1.f / 1024.f) + EPS); } }
#pragma unroll
        for (int bj = 0; bj < 2; ++bj)
#pragma unroll
            for (int n = 0; n < 2; ++n) { bv[bj][n] = (f32x4){0.f, 0.f, 0.f, 0.f}; if (MODE == 0) { if (kind == 2) bv[bj][n] = *(const f32x4*)(bias + col0 + bj * HALF - COL_GATE + 4 * n); } }
        f32x4 nb[2][2];
        if (MODE == 3) {
#pragma unroll
            for (int bj = 0; bj < 2; ++bj)
#pragma unroll
                for (int n = 0; n < 2; ++n) nb[bj][n] = *(const f32x4*)(base + (size_t)row0 * ldc + col0 + bj * HALF + 4 * n);
        }
#pragma unroll
        for (int ai = 0; ai < 2; ++ai)
#pragma unroll
            for (int m = 0; m < 4; ++m) { const size_t roff = (size_t)(row0 + ai * HALF + m * 16) * ldc; float psq = 0.f; const float rs = rsv[ai][m];
                f32x4 cb[2][2];
                if (MODE == 3) {
#pragma unroll
                    for (int bj = 0; bj < 2; ++bj)
#pragma unroll
                        for (int n = 0; n < 2; ++n) cb[bj][n] = nb[bj][n];
                    const int g1 = ai * 4 + m + 1;
                    if (g1 < 8) { const size_t r1 = (size_t)(row0 + (g1 >> 2) * HALF + (g1 & 3) * 16) * ldc;
#pragma unroll
                        for (int bj = 0; bj < 2; ++bj)
#pragma unroll
                            for (int n = 0; n < 2; ++n) nb[bj][n] = *(const f32x4*)(base + r1 + col0 + bj * HALF + 4 * n); }
                }
#pragma unroll
                for (int bj = 0; bj < 2; ++bj) { const int col = col0 + bj * HALF; f32x4 v0 = acc[ai][bj][m][0], v1 = acc[ai][bj][m][1];
                    if (MODE == 3) {
                        v0 = cb[bj][0] + v0; v1 = cb[bj][1] + v1;
                        *(f32x4*)(Of + roff + col) = v0; *(f32x4*)(Of + roff + col + 4) = v1;
                        psq += (v0[0] * v0[0] + v0[1] * v0[1]) + (v0[2] * v0[2] + v0[3] * v0[3]) + (v1[0] * v1[0] + v1[1] * v1[1]) + (v1[2] * v1[2] + v1[3] * v1[3]);
                        u32x4 w; w.x = cvt_pk_bf16(v0[0], v0[1]); w.y = cvt_pk_bf16(v0[2], v0[3]); w.z = cvt_pk_bf16(v1[0], v1[1]); w.w = cvt_pk_bf16(v1[2], v1[3]);
                        *(u32x4*)(XBo + roff + col) = w;
                    } else {
                        if (MODE == 0 || MODE == 2) { v0 = v0 * rs; v1 = v1 * rs; }
                        if (MODE == 0) {
                            if (kind == 2) {
#pragma unroll
                                for (int e = 0; e < 4; ++e) { v0[e] = __builtin_amdgcn_rcpf(1.f + __expf(-(v0[e] + bv[bj][0][e]))); v1[e] = __builtin_amdgcn_rcpf(1.f + __expf(-(v1[e] + bv[bj][1][e]))); } }
                            else { v0 = v0 * sc; v1 = v1 * sc; }
                        }
                        if (MODE == 2) {
#pragma unroll
                            for (int e = 0; e < 4; ++e) { const float a = fmaxf(v0[e], 0.f), b = fmaxf(v1[e], 0.f); v0[e] = a * a; v1[e] = b * b; } }
                        u32x4 w; w.x = cvt_pk_bf16(v0[0], v0[1]); w.y = cvt_pk_bf16(v0[2], v0[3]); w.z = cvt_pk_bf16(v1[0], v1[1]); w.w = cvt_pk_bf16(v1[2], v1[3]);
                        *(u32x4*)(O + roff + col) = w;
                    } }
                if (MODE == 3) { psq += __shfl_xor(psq, 16); psq += __shfl_xor(psq, 32); if (fq == 0) lx[(ai * HALF + wr * 64 + m * 16 + fr) * 4 + wc] = psq; }
            }
        if (MODE == 3) {
            asm volatile("s_waitcnt lgkmcnt(0)" ::: "memory"); __builtin_amdgcn_s_barrier(); asm volatile("" ::: "memory");
            const int t = threadIdx.x;
            if (t < 256) { const f32x4 q = *(const LAS f32x4*)(lx + t * 4); SSQo[(size_t)(u.pm * BM + t) * 4 + u.pn] = (q[0] + q[1]) + (q[2] + q[3]); }
        }
    }
};

template <class EpiT>
__device__ __forceinline__ void gemm_phase(LAS unsigned char* lds, const Gemm g, const StaticOrder& S, const EpiT& E) {
    int tid_ = threadIdx.x; asm volatile("" : "+v"(tid_));
    const int tid = tid_, wid = __builtin_amdgcn_readfirstlane(tid >> 6), lane = tid & 63, wr = wid >> 2, wc = wid & 3, fr = lane & 15, fq = lane >> 4;
    const int K = g.K, nt = K / BK;
    unsigned voffA[2], voffB[2];
#pragma unroll
    for (int i = 0; i < 2; ++i) { int R, C; stage_rc(tid * 16 + i * 8192, R, C); const int Rb = (R & ~31) + perm32(R & 31);
        voffA[i] = (unsigned)(R * g.lda + C) * 2u; voffB[i] = (unsigned)(Rb * g.ldb + C) * 2u; }
    const size_t kstep = (size_t)(BK * 2);
    const size_t hA = (size_t)HALF * g.lda * 2, hB = (size_t)HALF * g.ldb * 2;
    const size_t tA = 2 * hA, tB = 2 * hB;
    const unsigned ldsw = (unsigned)wid * 1024u;
    const int aoff = lds_byte(wr * 64 + fr, fq * 8), boff = lds_byte(wc * 32 + fr, fq * 8);
#define PG8_SA(b, h) (((b) * 2 + (h)) * HTB)
#define PG8_SB(b, h) ((4 + (b) * 2 + (h)) * HTB)
#define PG8_STAGE(bufoff, gbase, voff) do { _Pragma("unroll") for (int _i = 0; _i < 2; ++_i) \
        __builtin_amdgcn_global_load_lds((const unsigned*)((const char*)(gbase) + (voff)[_i]), (LAS unsigned*)(lds + (bufoff) + ldsw + _i * 8192), 16, 0, 0); } while (0)
#define PG8_LDA(dst, b, h) do { _Pragma("unroll") for (int m = 0; m < 4; ++m) _Pragma("unroll") for (int k = 0; k < 2; ++k) dst[m][k] = *(const LAS bf16x8*)(lds + PG8_SA(b, h) + aoff + m * 2048 + k * 1024); } while (0)
#define PG8_LDB(dst, b, h) do { _Pragma("unroll") for (int n = 0; n < 2; ++n) _Pragma("unroll") for (int k = 0; k < 2; ++k) dst[n][k] = *(const LAS bf16x8*)(lds + PG8_SB(b, h) + boff + n * 2048 + k * 1024); } while (0)
#define PG8_MMA(ai, bj, At, Bt) do { __builtin_amdgcn_s_setprio(1); _Pragma("unroll") for (int m = 0; m < 4; ++m) _Pragma("unroll") for (int n = 0; n < 2; ++n) _Pragma("unroll") for (int k = 0; k < 2; ++k) \
        acc[ai][bj][m][n] = __builtin_amdgcn_mfma_f32_16x16x32_bf16(Bt[n][k], At[m][k], acc[ai][bj][m][n], 0, 0, 0); __builtin_amdgcn_s_setprio(0); } while (0)
#define PG8_WAIT_V(n) asm volatile("s_waitcnt vmcnt(" #n ")" ::: "memory")
#define PG8_WAIT_L(n) asm volatile("s_waitcnt lgkmcnt(" #n ")" ::: "memory")
#define PG8_BAR __builtin_amdgcn_s_barrier()
#define PG8_SCHED __builtin_amdgcn_sched_barrier(0)
#define PG8_PA(u) ((const char*)g.A + (size_t)(u).pm * tA + (size_t)((u).pn / g.adiv) * (size_t)g.astride * 2)
#define PG8_PB(u) ((const char*)g.Bt + (size_t)(u).pn * tB)
    Unit cur, nxt; int ui = 0;
    if (!S.next(0, cur)) return;
    f32x4 acc[2][2][4][2];
#pragma unroll
    for (int a = 0; a < 2; ++a)
#pragma unroll
        for (int b = 0; b < 2; ++b)
#pragma unroll
            for (int m = 0; m < 4; ++m)
#pragma unroll
                for (int n = 0; n < 2; ++n) acc[a][b][m][n] = (f32x4){0.f, 0.f, 0.f, 0.f};
    bf16x8 At[4][2], B0[2][2], B1[2][2];
    const char* cA = PG8_PA(cur); const char* cB = PG8_PB(cur);
    PG8_STAGE(PG8_SB(0, 0), cB, voffB); PG8_STAGE(PG8_SB(0, 1), cB + hB, voffB); PG8_STAGE(PG8_SA(0, 0), cA, voffA); PG8_STAGE(PG8_SA(0, 1), cA + hA, voffA);
    if (wr == 1) PG8_BAR;
    PG8_WAIT_V(2); PG8_BAR;
    PG8_STAGE(PG8_SB(1, 0), cB + kstep, voffB); PG8_STAGE(PG8_SA(1, 0), cA + kstep, voffA); PG8_STAGE(PG8_SB(1, 1), cB + hB + kstep, voffB);
    PG8_WAIT_V(6); PG8_BAR;
    for (;;) {
        const bool has_next = S.next(ui + 1, nxt);
        const char* nA = has_next ? PG8_PA(nxt) : cA; const char* nB = has_next ? PG8_PB(nxt) : cB;
        for (int t = 0; t < nt; t += 2) {
            const bool last = (t == nt - 2);
            const char* a1 = cA + (size_t)(t + 1) * kstep;
            const char* a2 = last ? nA : cA + (size_t)(t + 2) * kstep; const char* b2 = last ? nB : cB + (size_t)(t + 2) * kstep;
            const char* a3 = a2 + kstep; const char* b3 = b2 + kstep;
            PG8_LDB(B0, 0, 0); PG8_LDB(B1, 0, 1); PG8_SCHED; PG8_LDA(At, 0, 0); PG8_STAGE(PG8_SA(1, 1), a1 + hA, voffA);
            PG8_WAIT_V(8); PG8_WAIT_L(0); PG8_BAR; PG8_MMA(0, 0, At, B0); PG8_MMA(0, 1, At, B1); PG8_BAR; PG8_SCHED;
            PG8_LDA(At, 0, 1); PG8_STAGE(PG8_SB(0, 0), b2, voffB); PG8_STAGE(PG8_SB(0, 1), b2 + hB, voffB); PG8_STAGE(PG8_SA(0, 0), a2, voffA);
            PG8_WAIT_V(8); PG8_WAIT_L(0); PG8_BAR; PG8_MMA(1, 0, At, B0); PG8_MMA(1, 1, At, B1); PG8_BAR; PG8_SCHED;
            PG8_LDB(B0, 1, 0); PG8_LDB(B1, 1, 1); PG8_SCHED; PG8_LDA(At, 1, 0); PG8_STAGE(PG8_SA(0, 1), a2 + hA, voffA);
            PG8_WAIT_V(8); PG8_WAIT_L(0); PG8_BAR; PG8_MMA(0, 0, At, B0); PG8_MMA(0, 1, At, B1); PG8_BAR; PG8_SCHED;
            PG8_LDA(At, 1, 1); PG8_STAGE(PG8_SB(1, 0), b3, voffB); PG8_STAGE(PG8_SB(1, 1), b3 + hB, voffB); PG8_STAGE(PG8_SA(1, 0), a3, voffA);
            PG8_WAIT_V(8); PG8_WAIT_L(0); PG8_BAR; PG8_MMA(1, 0, At, B0); PG8_MMA(1, 1, At, B1); PG8_BAR; PG8_SCHED;
        }
        if (wr == 0) PG8_BAR;
        E(acc, cur, wr, wc, fr, fq);
        if (!has_next) break;
#pragma unroll
        for (int a = 0; a < 2; ++a)
#pragma unroll
            for (int b = 0; b < 2; ++b)
#pragma unroll
                for (int m = 0; m < 4; ++m)
#pragma unroll
                    for (int n = 0; n < 2; ++n) acc[a][b][m][n] = (f32x4){0.f, 0.f, 0.f, 0.f};
        cur = nxt; cA = nA; cB = nB; ++ui;
        if (wr == 1) PG8_BAR;
    }
    PG8_WAIT_V(0);
    PG8_BAR;
#undef PG8_SA
#undef PG8_SB
#undef PG8_STAGE
#undef PG8_LDA
#undef PG8_LDB
#undef PG8_MMA
#undef PG8_WAIT_V
#undef PG8_WAIT_L
#undef PG8_BAR
#undef PG8_SCHED
#undef PG8_PA
#undef PG8_PB
}
}

__device__ __forceinline__ void sincos_red(float a, float& s, float& c) {
    const float q = rintf(a * 0.636619772367581f); const int iq = (int)q;
    float r = fmaf(q, -1.5703125f, a); r = fmaf(q, -4.837512969970703125e-4f, r); r = fmaf(q, -7.54978995489188216e-8f, r);
    const float r2 = r * r;
    const float sp = r + r * r2 * (-1.6666654611e-1f + r2 * (8.3321608736e-3f + r2 * (-1.9515295891e-4f)));
    const float cp = 1.0f - 0.5f * r2 + r2 * r2 * (4.166664568298827e-2f + r2 * (-1.388731625493765e-3f + r2 * 2.443315711809948e-5f));
    const int k = iq & 3;
    s = (k == 0) ? sp : (k == 1) ? cp : (k == 2) ? -sp : -cp;
    c = (k == 0) ? cp : (k == 1) ? -sp : (k == 2) ? -cp : sp;
}

namespace attn_body {
using bf16 = __hip_bfloat16;
using s16x4 = __attribute__((ext_vector_type(4))) short;
using f32x16 = __attribute__((ext_vector_type(16))) float;
constexpr int NW = 8, QBLK = 32, QB = QBLK * NW, KVBLK = 64;
constexpr int MA = 0, MB = 1, MC = 2, MD = 3;
__device__ __forceinline__ int crow(int r, int hi) { return (r & 3) + 8 * (r >> 2) + 4 * hi; }
#define SBAR() __builtin_amdgcn_sched_barrier(0)
constexpr int NSLOT = 3, SLOTB = 8192;
constexpr int LDS_K = 0, LDS_V = NSLOT * SLOTB, LDS_WS = 2 * NSLOT * SLOTB, LDS_OST = LDS_WS + NW * 64 * 4, LDS_ATT = LDS_OST + NW * 4096;
typedef __attribute__((address_space(3))) const char* lds_cptr;
typedef __attribute__((address_space(3))) const float* lds_fptr;

struct AttnArgs {
    const bf16* Q; const bf16* K; const bf16* V; bf16* O;
    int qs, ks, os;
    int NT, tlo, thi;
    float s2;
    int q0;
    int kb;
    float* stat; int ss;
    lds_fptr tab;
    const float* gq;
};

__device__ __forceinline__ void glds16(const void* gsrc, unsigned lds_dst) { unsigned keep;
  asm volatile("s_mov_b32 %0, m0\n\ts_mov_b32 m0, %2\n\ts_nop 0\n\tglobal_load_lds_dwordx4 %1, off\n\ts_mov_b32 m0, %0" : "=&s"(keep) : "v"(gsrc), "s"(lds_dst) : "memory"); }
__device__ __forceinline__ float max3f(float a, float b, float c) { float r; asm("v_max3_f32 %0, %1, %2, %3" : "=v"(r) : "v"(a), "v"(b), "v"(c)); return r; }
__device__ __forceinline__ float max2f(float a, float b) { float r; asm("v_max_f32_e32 %0, %1, %2" : "=v"(r) : "v"(a), "v"(b)); return r; }
__device__ __forceinline__ float fadd_s(float a, float b) { float r; asm("v_add_f32_e32 %0, %1, %2" : "=v"(r) : "v"(a), "v"(b)); return r; }
__device__ __forceinline__ float fsub_s(float a, float b) { float r; asm("v_sub_f32_e32 %0, %1, %2" : "=v"(r) : "v"(a), "v"(b)); return r; }
typedef float f32x2_t __attribute__((ext_vector_type(2))); typedef __bf16 bf16x2_t __attribute__((ext_vector_type(2)));
__device__ __forceinline__ unsigned cvtpk_s(float lo, float hi) { f32x2_t v = {lo, hi}; bf16x2_t b = __builtin_convertvector(v, bf16x2_t); return __builtin_bit_cast(unsigned, b); }
#define WAIT_BAR(N) asm volatile("s_waitcnt vmcnt(" #N ") lgkmcnt(0)\n\ts_barrier" ::: "memory")

__device__ __forceinline__ void qkt(f32x16& p0, f32x16& p1, const char* Kslot, const bf16x8* qr, const f32x16& negm, int r32, int hi) {
  const char* kb = Kslot + hi * 1024 + r32 * 16;
  #pragma unroll
  for (int d0 = 0; d0 < 4; ++d0) {
    const bf16x8 b0 = *reinterpret_cast<const bf16x8*>(kb + d0 * 2048);
    const bf16x8 b1 = *reinterpret_cast<const bf16x8*>(kb + d0 * 2048 + 512);
    if (d0 == 0) { p0 = __builtin_amdgcn_mfma_f32_32x32x16_bf16(b0, qr[0], negm, 0, 0, 0); p1 = __builtin_amdgcn_mfma_f32_32x32x16_bf16(b1, qr[0], negm, 0, 0, 0); }
    else { p0 = __builtin_amdgcn_mfma_f32_32x32x16_bf16(b0, qr[d0], p0, 0, 0, 0); p1 = __builtin_amdgcn_mfma_f32_32x32x16_bf16(b1, qr[d0], p1, 0, 0, 0); } }
}
typedef short v4i16_t __attribute__((ext_vector_type(4)));
__device__ __forceinline__ void kload8(bf16x8* kf, lds_cptr kp) {
  kf[0] = *(const LAS bf16x8*)(kp);        kf[1] = *(const LAS bf16x8*)(kp + 512);
  kf[2] = *(const LAS bf16x8*)(kp + 2048); kf[3] = *(const LAS bf16x8*)(kp + 2560);
  kf[4] = *(const LAS bf16x8*)(kp + 4096); kf[5] = *(const LAS bf16x8*)(kp + 4608);
  kf[6] = *(const LAS bf16x8*)(kp + 6144); kf[7] = *(const LAS bf16x8*)(kp + 6656);
}
__device__ __forceinline__ void kload2(bf16x8* kf, lds_cptr kp, int j) { kf[2 * j] = *(const LAS bf16x8*)(kp + j * 2048); kf[2 * j + 1] = *(const LAS bf16x8*)(kp + j * 2048 + 512); }
__device__ __forceinline__ s16x4 vtr(lds_cptr p) { return __builtin_bit_cast(s16x4, __builtin_amdgcn_ds_read_tr16_b64_v4i16((LAS v4i16_t*)p)); }
__device__ __forceinline__ float rowmax(const f32x16& p0, const f32x16& p1) {
  float a = max3f(p0[0], p0[1], p1[0]), b = max3f(p0[2], p0[3], p1[1]); a = max3f(a, p1[2], p1[3]);
  #pragma unroll
  for (int r = 4; r < 16; r += 4) { a = max3f(a, p0[r], p0[r + 1]); b = max3f(b, p0[r + 2], p0[r + 3]); a = max3f(a, p1[r], p1[r + 1]); b = max3f(b, p1[r + 2], p1[r + 3]); }
  const float m = max2f(a, b);
  auto rr = __builtin_amdgcn_permlane32_swap(__float_as_uint(m), __float_as_uint(m), false, false);
  return max2f(__uint_as_float(rr[0]), __uint_as_float(rr[1]));
}
__device__ __forceinline__ void pv(f32x16* o, int vb, bf16x8 pa0, bf16x8 pa1, bf16x8 pa2, bf16x8 pa3) {
  #pragma unroll
  for (int d0 = 0; d0 < 2; ++d0) { s16x4 lo[4], hi[4];
    #pragma unroll
    for (int ks = 0; ks < 4; ++ks) {
      asm volatile("ds_read_b64_tr_b16 %0,%1 offset:%c2" : "=&v"(lo[ks]) : "v"(vb), "i"(d0 * 4096 + ks * 1024) : "memory");
      asm volatile("ds_read_b64_tr_b16 %0,%1 offset:%c2" : "=&v"(hi[ks]) : "v"(vb), "i"(d0 * 4096 + ks * 1024 + 512) : "memory"); }
    asm volatile("s_waitcnt lgkmcnt(0)" ::: "memory"); SBAR();
    #define PK(k) (bf16x8){lo[k][0], lo[k][1], lo[k][2], lo[k][3], hi[k][0], hi[k][1], hi[k][2], hi[k][3]}
    o[d0] = __builtin_amdgcn_mfma_f32_32x32x16_bf16(pa0, PK(0), o[d0], 0, 0, 0);
    o[d0] = __builtin_amdgcn_mfma_f32_32x32x16_bf16(pa1, PK(1), o[d0], 0, 0, 0);
    o[d0] = __builtin_amdgcn_mfma_f32_32x32x16_bf16(pa2, PK(2), o[d0], 0, 0, 0);
    o[d0] = __builtin_amdgcn_mfma_f32_32x32x16_bf16(pa3, PK(3), o[d0], 0, 0, 0);
    #undef PK
  }
}

__device__ __forceinline__ float opq(float x) { asm("" : "+v"(x)); return x; }
template <int MODE> __device__ __forceinline__ void score_hook(f32x16& c0, f32x16& c1, int t, const AttnArgs& a, int qrel, int hi, int wid, int r32, float mh) {
  if constexpr (MODE == MA) {
    const int wlo = a.q0 + wid * QBLK, sd = (64 * t + 63 < wlo) ? 1 : ((64 * t > wlo + 31) ? -1 : 0);
    if (sd != 0) { const float sv = (float)sd * a.s2;
      #pragma unroll
      for (int r = 0; r < 16; ++r) { const float kf = (float)((r & 3) + 8 * (r >> 2)); c0[r] = opq(fmaf(kf, sv, c0[r])); c1[r] = opq(fmaf(kf + 32.f, sv, c1[r])); if ((r & 3) == 3) __builtin_amdgcn_sched_barrier(0); }
    } else {
      const float dq = (float)(a.q0 + qrel - 64 * t - 4 * hi), ns = -a.s2;
      #pragma unroll
      for (int r = 0; r < 16; ++r) { const float kf = (float)((r & 3) + 8 * (r >> 2)); c0[r] = opq(fmaf(ns, fabsf(opq(dq - kf)), c0[r])); c1[r] = opq(fmaf(ns, fabsf(opq(dq - (kf + 32.f))), c1[r])); if ((r & 1) == 1) __builtin_amdgcn_sched_barrier(0); }
    }
  }
  if constexpr (MODE == MB) {
    const bool tv = (t >= a.tlo) && (t <= a.thi);
    const float dq = (float)(qrel + 64 - 64 * t - 4 * hi), ns = -a.s2;
    #pragma unroll
    for (int r = 0; r < 16; ++r) { const float kf = (float)((r & 3) + 8 * (r >> 2)); const float d0 = fabsf(opq(dq - kf)), d1 = fabsf(opq(dq - (kf + 32.f)));
      const float v0_ = opq(fmaf(ns, d0, opq(c0[r] - mh))), v1_ = opq(fmaf(ns, d1, opq(c1[r] - mh)));
      c0[r] = (tv && d0 <= 64.f) ? v0_ : -INFINITY; c1[r] = (tv && d1 <= 64.f) ? v1_ : -INFINITY;
      if ((r & 3) == 3) __builtin_amdgcn_sched_barrier(0); }
  }
  if constexpr (MODE == MC) {
    const int qrow = a.q0 + (wid >> 1), rs = min(max(qrow - 4, 0), 120), krow = a.kb + t;
    if (krow < rs || krow >= rs + 8) {
      #pragma unroll
      for (int r = 0; r < 16; ++r) { c0[r] = -INFINITY; c1[r] = -INFINITY; }
    } else {
      const int qc = (wid & 1) * 32 + r32, cs = min(max(qc - 8, 0), 48);
      const lds_fptr tp = a.tab + (krow - qrow + 7) * 31 + (15 - qc + 4 * hi);
      const int kd = 4 * hi - cs;
      #pragma unroll
      for (int r = 0; r < 16; ++r) { const int kc = (r & 3) + 8 * (r >> 2);
        const float b0 = tp[kc], b1 = tp[kc + 32];
        const float v0_ = opq(c0[r] + opq(b0 - mh)), v1_ = opq(c1[r] + opq(b1 - mh));
        c0[r] = ((unsigned)(kd + kc) < 16u) ? v0_ : -INFINITY; c1[r] = ((unsigned)(kd + kc + 32) < 16u) ? v1_ : -INFINITY;
        if ((r & 3) == 3) __builtin_amdgcn_sched_barrier(0); }
    }
  }
}

template <int MODE, int THRL> __device__ __forceinline__ void attn_unit(const AttnArgs& A_, char* shm) {
  int tid_ = threadIdx.x; asm volatile("" : "+v"(tid_));
  const int tid = tid_, lane = tid & 63, r32 = lane & 31, hi = lane >> 5; const int wid = __builtin_amdgcn_readfirstlane(tid >> 6);
  const bf16* Qw = A_.Q + (wid * QBLK) * A_.qs;
  const unsigned lds0 = (unsigned)(uintptr_t)shm;
  float* wsf = (float*)(shm + LDS_WS) + wid * 64;
  const int ks = A_.ks;
  const bf16* ksrc = A_.K + (lane * ks + wid * 8);
  const bf16* vsrc = A_.V + ((16 * (wid & 3) + (lane >> 2)) * ks + (wid >> 2) * 32 + (lane & 3) * 8);
  const unsigned kdst = lds0 + LDS_K + wid * 1024, vdst = lds0 + LDS_V + wid * 1024;
  #define TT(t) ((MODE == MB) ? min(max((int)(t), A_.tlo), A_.thi) : (int)(t))
  #define DMA_K(t, slot) glds16(ksrc + TT(t) * KVBLK * ks, (unsigned)__builtin_amdgcn_readfirstlane(kdst + (slot)))
  #define DMA_V(t, slot) glds16(vsrc + TT(t) * KVBLK * ks, (unsigned)__builtin_amdgcn_readfirstlane(vdst + (slot)))
  const int vb0 = (int)(lds0 + LDS_V) + ((lane >> 4) & 1) * 32 + (lane & 3) * 8 + (4 * hi + ((lane & 15) >> 2)) * 64;
  const char* Kbase = shm + LDS_K; bf16x8 kf[8];
  const lds_cptr shm3 = (lds_cptr)shm; const lds_cptr kp0 = shm3 + LDS_K + hi * 1024 + r32 * 16; const lds_cptr vp0 = shm3 + LDS_V + ((lane >> 4) & 1) * 32 + (lane & 3) * 8 + (4 * hi + ((lane & 15) >> 2)) * 64;
  const int NT = A_.NT;
  DMA_K(0, 0); DMA_V(0, 0); DMA_K(1, SLOTB);
  bf16x8 qr[4];
  #pragma unroll
  for (int d0 = 0; d0 < 4; ++d0) qr[d0] = *reinterpret_cast<const bf16x8*>(&Qw[r32 * A_.qs + d0 * 16 + hi * 8]);
  if constexpr (MODE == MD) {
    float x[4][8]; float ssq = 0.f;
    #pragma unroll
    for (int d0 = 0; d0 < 4; ++d0)
      #pragma unroll
      for (int j = 0; j < 8; ++j) { x[d0][j] = __uint_as_float((unsigned)(unsigned short)qr[d0][j] << 16); ssq += x[d0][j] * x[d0][j]; }
    { auto rr = __builtin_amdgcn_permlane32_swap(__float_as_uint(ssq), __float_as_uint(ssq), false, false); ssq = __uint_as_float(rr[0]) + __uint_as_float(rr[1]); }
    const float rn = rsqrtf(ssq * (1.f / 64.f) + EPS) * C2;
    const int spos = A_.q0 + wid * QBLK + r32; const float prow = (float)(spos >> 6), pcol = (float)(spos & 63);
    #pragma unroll
    for (int j = 0; j < 8; ++j) { const float inv = exp2f(-(float)(8 * hi + j) * 0.8304820237218406f);
      float sr, cr, sc_, cc_; sincos_red(prow * inv, sr, cr); sincos_red(pcol * inv, sc_, cc_);
      const float g0 = A_.gq[8 * hi + j], g1 = A_.gq[16 + 8 * hi + j], g2 = A_.gq[32 + 8 * hi + j], g3 = A_.gq[48 + 8 * hi + j];
      const float y0 = x[0][j] * rn * g0, y1 = x[1][j] * rn * g1, y2 = x[2][j] * rn * g2, y3 = x[3][j] * rn * g3;
      x[0][j] = y0 * cr - y1 * sr; x[1][j] = y1 * cr + y0 * sr; x[2][j] = y2 * cc_ - y3 * sc_; x[3][j] = y3 * cc_ + y2 * sc_; }
    #pragma unroll
    for (int d0 = 0; d0 < 4; ++d0) { u32x4 w; w.x = pk2(x[d0][0], x[d0][1]); w.y = pk2(x[d0][2], x[d0][3]); w.z = pk2(x[d0][4], x[d0][5]); w.w = pk2(x[d0][6], x[d0][7]); qr[d0] = __builtin_bit_cast(bf16x8, w); }
  }
  float mhat = 0.f, l_reg = 0.f; f32x16 o[2]; o[0] = f32x16{}; o[1] = f32x16{}; f32x16 negm = f32x16{}; asm volatile("" : "+v"(negm));
  const int qrel = wid * QBLK + r32;
  constexpr bool NEGM = (MODE == MA || MODE == MD);
  #define CIN (NEGM ? negm : f32x16{})
  #define NEGM_SET(tn) do { float nb_ = -mhat; \
      if (MODE == MA) { const int wlo_ = A_.q0 + wid * QBLK, sd_ = (64 * (tn) + 63 < wlo_) ? 1 : ((64 * (tn) > wlo_ + 31) ? -1 : 0); \
        if (sd_ != 0) nb_ = fmaf(-(float)sd_ * A_.s2, (float)(A_.q0 + qrel - 64 * (tn) - 4 * hi), nb_); } \
      _Pragma("unroll") for (int r = 0; r < 16; ++r) negm[r] = nb_; asm volatile("" : "+v"(negm)); } while (0)
  #define CMASK(P0, P1, t) score_hook<MODE>(P0, P1, (t), A_, qrel, hi, wid, r32, mhat)
  bool resc = false;
  #define START(P0, P1) do { const float rm = rowmax(P0, P1); resc = false; \
    { const float dl = (MODE == MB || MODE == MC) ? fmaxf(rm, -2048.f) : rm; mhat = fadd_s(mhat, dl); \
      _Pragma("unroll") for (int r = 0; r < 16; ++r) { P0[r] = fsub_s(P0[r], dl); P1[r] = fsub_s(P1[r], dl); } \
      if (NEGM) { NEGM_SET(1); } } \
    _Pragma("unroll") for (int r = 0; r < 16; ++r) P0[r] = __builtin_amdgcn_exp2f(P0[r]); } while (0)
  #define RESC() do { if (resc) { asm volatile("s_waitcnt lgkmcnt(0)" ::: "memory"); \
      _Pragma("unroll") for (int d_ = 0; d_ < 2; ++d_) _Pragma("unroll") for (int r = 0; r < 16; ++r) o[d_][r] *= wsf[crow(r, hi)]; } } while (0)
  f32x16 pA0, pA1, pB0, pB1;
  int sl_prev = 0, sl_cur = 0, sl_next = SLOTB;
  #define ROT() do { sl_prev = sl_cur; sl_cur = sl_next; sl_next = (sl_next == (NSLOT - 1) * SLOTB) ? 0 : sl_next + SLOTB; } while (0)
  DMA_K(2, 2 * SLOTB);
  if (MODE == MA) { NEGM_SET(0); }
  WAIT_BAR(3);
  qkt(pA0, pA1, Kbase, qr, negm, r32, hi); asm volatile("s_nop 15\n\ts_nop 7" : "+v"(pA0), "+v"(pA1)); CMASK(pA0, pA1, 0);
  START(pA0, pA1);
  _Pragma("unroll") for (int r = 0; r < 16; ++r) pA1[r] = __builtin_amdgcn_exp2f(pA1[r]);
  WAIT_BAR(0);
  DMA_K(3, 0); DMA_V(1, SLOTB);
  ROT();
  kload8(kf, kp0 + sl_cur);
  WAIT_BAR(2);
  s16x4 vlo[8], vhi[8]; u32x4 pw0, pw1, pw2, pw3;
  #define PKW(P, B) cvtpk_s(P[B], P[B + 1])
  #define PAF(k) __builtin_bit_cast(bf16x8, pw##k)
  #define VFR(i) (bf16x8){vlo[i][0], vlo[i][1], vlo[i][2], vlo[i][3], vhi[i][0], vhi[i][1], vhi[i][2], vhi[i][3]}
  #define PIN(x) asm volatile("" : "+v"(x))
  #define MX3(a, b, c) __builtin_fmaxf(__builtin_fmaxf((a), (b)), (c))
  #define GAPA(MF, A0, A1, A2, A3, W0, W1, PW) do { MF; sacc += A0; sacc += A1; sacc += A2; sacc += A3; PIN(sacc); W0; W1; PIN(PW); SBAR(); } while (0)
  #define EX(v) __builtin_amdgcn_exp2f(v)
  #define GAPB(MF, X, B) do { MF; X[B] = EX(X[B]); X[B + 1] = EX(X[B + 1]); X[B + 2] = EX(X[B + 2]); X[B + 3] = EX(X[B + 3]); PIN(X); SBAR(); } while (0)
  #define VRD(i) do { vlo[i] = vtr(vp_ + (((i) >> 2) * 4096 + ((i) & 3) * 1024)); vhi[i] = vtr(vp_ + (((i) >> 2) * 4096 + ((i) & 3) * 1024 + 512)); } while (0)
  #define KRD(G, j) do { if (G) { kload2(kf, kp0 + sl_next, j); SBAR(); } } while (0)
  #define STEP(C0, C1, P0, P1, t, GK, GV, GL) do { SBAR(); \
    const lds_cptr vp_ = vp0 + sl_prev; \
    VRD(0); SBAR(); float sacc = (P0[0] + P0[1]); \
    GAPA(C0 = __builtin_amdgcn_mfma_f32_32x32x16_bf16(kf[0], qr[0], CIN, 0, 0, 0), P0[2], P0[3], P0[4], P0[5],     pw0[0] = PKW(P0, 0), pw0[1] = PKW(P0, 2), pw0); \
    VRD(4); SBAR(); GAPA(C1 = __builtin_amdgcn_mfma_f32_32x32x16_bf16(kf[1], qr[0], CIN, 0, 0, 0), P0[6], P0[7], P0[8], P0[9],     pw0[2] = PKW(P0, 4), pw0[3] = PKW(P0, 6), pw0); \
    VRD(1); SBAR(); GAPA(C0 = __builtin_amdgcn_mfma_f32_32x32x16_bf16(kf[2], qr[1], C0, 0, 0, 0),   P0[10], P0[11], P0[12], P0[13], pw1[0] = PKW(P0, 8), pw1[1] = PKW(P0, 10), pw1); \
    VRD(5); SBAR(); GAPA(C1 = __builtin_amdgcn_mfma_f32_32x32x16_bf16(kf[3], qr[1], C1, 0, 0, 0),   P0[14], P0[15], P1[0], P1[1],   pw1[2] = PKW(P0, 12), pw1[3] = PKW(P0, 14), pw1); \
    VRD(2); SBAR(); GAPA(C0 = __builtin_amdgcn_mfma_f32_32x32x16_bf16(kf[4], qr[2], C0, 0, 0, 0),   P1[2], P1[3], P1[4], P1[5],     pw2[0] = PKW(P1, 0), pw2[1] = PKW(P1, 2), pw2); \
    VRD(6); SBAR(); GAPA(C1 = __builtin_amdgcn_mfma_f32_32x32x16_bf16(kf[5], qr[2], C1, 0, 0, 0),   P1[6], P1[7], P1[8], P1[9],     pw2[2] = PKW(P1, 4), pw2[3] = PKW(P1, 6), pw2); \
    VRD(3); SBAR(); GAPA(C0 = __builtin_amdgcn_mfma_f32_32x32x16_bf16(kf[6], qr[3], C0, 0, 0, 0),   P1[10], P1[11], P1[12], P1[13], pw3[0] = PKW(P1, 8), pw3[1] = PKW(P1, 10), pw3); \
    VRD(7); SBAR(); GAPA(C1 = __builtin_amdgcn_mfma_f32_32x32x16_bf16(kf[7], qr[3], C1, 0, 0, 0),   P1[14], P1[15], 0.f, 0.f,       pw3[2] = PKW(P1, 12), pw3[3] = PKW(P1, 14), pw3); \
    l_reg += sacc; \
    if (GK) { DMA_K((t) + 3, sl_cur); } if (GV) { DMA_V((t) + 1, sl_next); } \
    CMASK(C0, C1, t); \
    { float a = MX3(C0[0], C0[1], C1[0]), b = MX3(C0[2], C0[3], C1[1]); a = MX3(a, C1[2], C1[3]); \
      _Pragma("unroll") for (int r = 4; r < 16; r += 4) { a = MX3(a, C0[r], C0[r + 1]); b = MX3(b, C0[r + 2], C0[r + 3]); a = MX3(a, C1[r], C1[r + 1]); b = MX3(b, C1[r + 2], C1[r + 3]); } \
      float rm = __builtin_fmaxf(a, b); { auto rr = __builtin_amdgcn_permlane32_swap(__float_as_uint(rm), __float_as_uint(rm), false, false); rm = __builtin_fmaxf(__uint_as_float(rr[0]), __uint_as_float(rr[1])); } \
      resc = false; \
      if (__builtin_expect(__any(rm > (float)THRL), 0)) { const float dl = __builtin_fmaxf(rm, 0.f); mhat += dl; \
        _Pragma("unroll") for (int r = 0; r < 16; ++r) { C0[r] -= dl; C1[r] -= dl; } \
        if (MODE == MD) { NEGM_SET(0); } \
        const float f = __builtin_amdgcn_exp2f(-dl); l_reg *= f; if (hi == 0) wsf[r32] = f; resc = true; } \
      if (MODE == MA) { NEGM_SET((t) + 1); } } \
    SBAR(); \
    GAPB(o[0] = __builtin_amdgcn_mfma_f32_32x32x16_bf16(PAF(0), VFR(0), o[0], 0, 0, 0), C0, 0); \
    GAPB(o[1] = __builtin_amdgcn_mfma_f32_32x32x16_bf16(PAF(0), VFR(4), o[1], 0, 0, 0), C0, 4); \
    KRD(GL, 0); GAPB(o[0] = __builtin_amdgcn_mfma_f32_32x32x16_bf16(PAF(1), VFR(1), o[0], 0, 0, 0), C0, 8); \
    KRD(GL, 1); GAPB(o[1] = __builtin_amdgcn_mfma_f32_32x32x16_bf16(PAF(1), VFR(5), o[1], 0, 0, 0), C0, 12); \
    KRD(GL, 2); GAPB(o[0] = __builtin_amdgcn_mfma_f32_32x32x16_bf16(PAF(2), VFR(2), o[0], 0, 0, 0), C1, 0); \
    KRD(GL, 3); GAPB(o[1] = __builtin_amdgcn_mfma_f32_32x32x16_bf16(PAF(2), VFR(6), o[1], 0, 0, 0), C1, 4); \
    GAPB(o[0] = __builtin_amdgcn_mfma_f32_32x32x16_bf16(PAF(3), VFR(3), o[0], 0, 0, 0), C1, 8); \
    GAPB(o[1] = __builtin_amdgcn_mfma_f32_32x32x16_bf16(PAF(3), VFR(7), o[1], 0, 0, 0), C1, 12); \
    } while (0)
  int t = 1;
  for (; t + 5 < NT; t += 2) {
    STEP(pB0, pB1, pA0, pA1, t, true, true, true);     WAIT_BAR(2); RESC(); ROT();
    STEP(pA0, pA1, pB0, pB1, t + 1, true, true, true); WAIT_BAR(2); RESC(); ROT();
  }
  #define ENDW(tt) do { if ((tt) + 3 < NT) { WAIT_BAR(2); } else if ((tt) + 2 < NT) { WAIT_BAR(1); } else { WAIT_BAR(0); } } while (0)
  for (; t + 1 < NT; t += 2) {
    STEP(pB0, pB1, pA0, pA1, t, (t + 3 < NT), (t + 1 < NT), (t + 1 < NT));         ENDW(t);     RESC(); ROT();
    STEP(pA0, pA1, pB0, pB1, t + 1, (t + 4 < NT), (t + 2 < NT), (t + 2 < NT));     ENDW(t + 1); RESC(); ROT();
  }
  STEP(pB0, pB1, pA0, pA1, NT - 1, false, false, false); RESC();
  { float sacc = pB0[0] + pB0[1]; _Pragma("unroll") for (int r = 2; r < 16; ++r) sacc += pB0[r]; _Pragma("unroll") for (int r = 0; r < 16; ++r) sacc += pB1[r]; l_reg += sacc;
    pw0 = (u32x4){PKW(pB0, 0), PKW(pB0, 2), PKW(pB0, 4), PKW(pB0, 6)}; pw1 = (u32x4){PKW(pB0, 8), PKW(pB0, 10), PKW(pB0, 12), PKW(pB0, 14)}; pw2 = (u32x4){PKW(pB1, 0), PKW(pB1, 2), PKW(pB1, 4), PKW(pB1, 6)}; pw3 = (u32x4){PKW(pB1, 8), PKW(pB1, 10), PKW(pB1, 12), PKW(pB1, 14)};
    SBAR(); pv(o, vb0 + sl_cur, PAF(0), PAF(1), PAF(2), PAF(3)); }
  #undef PKW
  #undef PAF
  #undef VFR
  #undef PIN
  #undef MX3
  #undef GAPA
  #undef GAPB
  #undef EX
  #undef VRD
  #undef KRD
  #undef STEP
  #undef ENDW
  { auto rr = __builtin_amdgcn_permlane32_swap(__float_as_uint(l_reg), __float_as_uint(l_reg), false, false); l_reg = __uint_as_float(rr[0]) + __uint_as_float(rr[1]); }
  if (MODE == MB) { if (hi == 0) { float* sp = A_.stat + (wid * QBLK + r32) * A_.ss; sp[0] = mhat; sp[1] = l_reg; } }
  if (hi == 0) wsf[32 + r32] = l_reg; asm volatile("s_waitcnt lgkmcnt(0)" ::: "memory");
  float rli[16];
  #pragma unroll
  for (int r = 0; r < 16; ++r) rli[r] = __builtin_amdgcn_rcpf(wsf[32 + crow(r, hi)]);
  bf16* Ow = A_.O + (wid * QBLK) * A_.os;
  { bf16* stg = (bf16*)(shm + LDS_OST) + wid * 2048;
    #pragma unroll
    for (int r = 0; r < 16; ++r) { const int orow = crow(r, hi);
      #pragma unroll
      for (int d0 = 0; d0 < 2; ++d0) stg[orow * 64 + d0 * 32 + r32] = __float2bfloat16(o[d0][r] * rli[r]); }
    asm volatile("s_waitcnt lgkmcnt(0)" ::: "memory");
    #pragma unroll
    for (int i = 0; i < 4; ++i) { const int row = i * 8 + (lane >> 3), ch = lane & 7; const u32x4 v = *(const u32x4*)(stg + row * 64 + ch * 8); *(u32x4*)(Ow + row * A_.os + ch * 8) = v; } }
  asm volatile("s_waitcnt lgkmcnt(0)\n\ts_barrier" ::: "memory");
  #undef DMA_K
  #undef DMA_V
  #undef TT
  #undef CMASK
  #undef CIN
  #undef NEGM_SET
  #undef START
  #undef RESC
  #undef ROT
}

constexpr int L8_K = 0, L8_V = 3 * 8192, L8_WS = L8_V + 3 * 16384, L8_QO = L8_WS + 2048, L8_END = L8_QO + 8 * 4096;
template <int THRL> __device__ __forceinline__ void attn_unit128(const AttnArgs& A_, char* shm) {
  int tid_ = threadIdx.x; asm volatile("" : "+v"(tid_));
  const int tid = tid_, lane = tid & 63, r32 = lane & 31, hi = lane >> 5; const int wid = __builtin_amdgcn_readfirstlane(tid >> 6);
  const bf16* Qw = A_.Q + (wid * QBLK) * A_.qs;
  const unsigned lds0 = (unsigned)(uintptr_t)shm;
  float* wsf = (float*)(shm + L8_WS) + wid * 64;
  const int ks = A_.ks;
  const bf16* ksrc = A_.K + (lane * ks + wid * 8);
  const bf16* vsrc = A_.V + ((16 * (wid & 3) + (lane >> 2)) * ks + (wid >> 2) * 32 + (lane & 3) * 8);
  const unsigned kdst = lds0 + L8_K + wid * 1024, vdst = lds0 + L8_V + wid * 1024;
  #define DMA_K(t, slot) glds16(ksrc + (int)(t) * KVBLK * ks, (unsigned)__builtin_amdgcn_readfirstlane(kdst + (slot)))
  #define DMA_V(t, slot) do { glds16(vsrc + (int)(t) * KVBLK * ks, (unsigned)__builtin_amdgcn_readfirstlane(vdst + 2 * (slot))); \
                              glds16(vsrc + (int)(t) * KVBLK * ks + 64, (unsigned)__builtin_amdgcn_readfirstlane(vdst + 2 * (slot) + 8192)); } while (0)
  const int vb0 = (int)(lds0 + L8_V) + ((lane >> 4) & 1) * 32 + (lane & 3) * 8 + (4 * hi + ((lane & 15) >> 2)) * 64;
  const char* Kbase = shm + L8_K; bf16x8 kf[8];
  const lds_cptr shm3 = (lds_cptr)shm; const lds_cptr kp0 = shm3 + L8_K + hi * 1024 + r32 * 16; const lds_cptr vp0 = shm3 + L8_V + ((lane >> 4) & 1) * 32 + (lane & 3) * 8 + (4 * hi + ((lane & 15) >> 2)) * 64;
  const lds_cptr qst = shm3 + L8_QO + wid * 4096 + lane * 16;
  const int NT = A_.NT;
  DMA_K(0, 0); DMA_V(0, 0); DMA_K(1, SLOTB);
  { bf16x8 qr[4];
    #pragma unroll
    for (int d0 = 0; d0 < 4; ++d0) qr[d0] = *reinterpret_cast<const bf16x8*>(&Qw[r32 * A_.qs + d0 * 16 + hi * 8]);
    #pragma unroll
    for (int d0 = 0; d0 < 4; ++d0) *(LAS bf16x8*)(shm3 + L8_QO + wid * 4096 + lane * 16 + d0 * 1024) = qr[d0]; }
  #define QLD(d0) (*(const LAS bf16x8*)(qst + (d0) * 1024))
  float mhat = 0.f, l_reg = 0.f; f32x16 o[4]; o[0] = f32x16{}; o[1] = f32x16{}; o[2] = f32x16{}; o[3] = f32x16{};
  const int qrel = wid * QBLK + r32;
  #define NB(tn) ({ float nb_ = -mhat; const int wlo_ = A_.q0 + wid * QBLK, sd_ = (64 * (tn) + 63 < wlo_) ? 1 : ((64 * (tn) > wlo_ + 31) ? -1 : 0); \
      if (sd_ != 0) nb_ = fmaf(-(float)sd_ * A_.s2, (float)(A_.q0 + qrel - 64 * (tn) - 4 * hi), nb_); nb_; })
  #define CMASK(P0, P1, t) score_hook<MA>(P0, P1, (t), A_, qrel, hi, wid, r32, mhat)
  bool resc = false;
  #define RESC() do { if (resc) { asm volatile("s_waitcnt lgkmcnt(0)" ::: "memory"); \
      _Pragma("unroll") for (int d_ = 0; d_ < 4; ++d_) _Pragma("unroll") for (int r = 0; r < 16; ++r) o[d_][r] *= wsf[crow(r, hi)]; } } while (0)
  f32x16 pA0, pA1, pB0, pB1;
  int sl_prev = 0, sl_cur = 0, sl_next = SLOTB;
  #define ROT() do { sl_prev = sl_cur; sl_cur = sl_next; sl_next = (sl_next == (NSLOT - 1) * SLOTB) ? 0 : sl_next + SLOTB; } while (0)
  DMA_K(2, 2 * SLOTB);
  WAIT_BAR(4);
  { f32x16 cin; const float nb0 = NB(0);
    #pragma unroll
    for (int r = 0; r < 16; ++r) cin[r] = nb0;
    bf16x8 qr[4];
    #pragma unroll
    for (int d0 = 0; d0 < 4; ++d0) qr[d0] = QLD(d0);
    qkt(pA0, pA1, Kbase, qr, cin, r32, hi); }
  asm volatile("s_nop 15\n\ts_nop 7" : "+v"(pA0), "+v"(pA1)); CMASK(pA0, pA1, 0);
  { const float rm = rowmax(pA0, pA1); mhat = fadd_s(mhat, rm);
    #pragma unroll
    for (int r = 0; r < 16; ++r) { pA0[r] = fsub_s(pA0[r], rm); pA1[r] = fsub_s(pA1[r], rm); }
    #pragma unroll
    for (int r = 0; r < 16; ++r) pA0[r] = __builtin_amdgcn_exp2f(pA0[r]);
    #pragma unroll
    for (int r = 0; r < 16; ++r) pA1[r] = __builtin_amdgcn_exp2f(pA1[r]); }
  WAIT_BAR(0);
  DMA_K(3, 0); DMA_V(1, SLOTB);
  ROT();
  kload8(kf, kp0 + sl_cur);
  WAIT_BAR(3);
  u32x4 pw0, pw1, pw2, pw3;
  #define PKW(P, B) cvtpk_s(P[B], P[B + 1])
  #define PAF(k) __builtin_bit_cast(bf16x8, pw##k)
  #define PIN(x) asm volatile("" : "+v"(x))
  #define MX3(a, b, c) __builtin_fmaxf(__builtin_fmaxf((a), (b)), (c))
  #define GAPA(MF, A0, A1, A2, A3, W0, W1, PW) do { MF; sacc += A0; sacc += A1; sacc += A2; sacc += A3; PIN(sacc); W0; W1; PIN(PW); SBAR(); } while (0)
  #define EX(v) __builtin_amdgcn_exp2f(v)
  #define GAPB(MF, X, B) do { MF; X[B] = EX(X[B]); X[B + 1] = EX(X[B + 1]); PIN(X); SBAR(); } while (0)
  #define KRD(G, j) do { if (G) { kload2(kf, kp0 + sl_next, j); SBAR(); } } while (0)
  #define FOFF(j) (((((j) & 1) + 2 * ((j) >> 3)) * 4096) + ((((j) >> 1) & 3) * 1024))
  #define FRD(j) do { fl[j] = vtr(vp_ + FOFF(j)); fh[j] = vtr(vp_ + FOFF(j) + 512); SBAR(); } while (0)
  #define FFR(j) (bf16x8){fl[j][0], fl[j][1], fl[j][2], fl[j][3], fh[j][0], fh[j][1], fh[j][2], fh[j][3]}
  #define STEP(C0, C1, P0, P1, t, GK, GV, GL) do { SBAR(); \
    const lds_cptr vp_ = vp0 + 2 * sl_prev; s16x4 fl[16], fh[16]; \
    { const float nb_t = NB(t); _Pragma("unroll") for (int r = 0; r < 16; ++r) { C0[r] = nb_t; C1[r] = nb_t; } } \
    bf16x8 q0_ = QLD(0), q1_ = QLD(1); SBAR(); float sacc = (P0[0] + P0[1]); \
    GAPA(C0 = __builtin_amdgcn_mfma_f32_32x32x16_bf16(kf[0], q0_, C0, 0, 0, 0), P0[2], P0[3], P0[4], P0[5],     pw0[0] = PKW(P0, 0), pw0[1] = PKW(P0, 2), pw0); \
    GAPA(C1 = __builtin_amdgcn_mfma_f32_32x32x16_bf16(kf[1], q0_, C1, 0, 0, 0), P0[6], P0[7], P0[8], P0[9],     pw0[2] = PKW(P0, 4), pw0[3] = PKW(P0, 6), pw0); \
    q0_ = QLD(2); SBAR(); \
    GAPA(C0 = __builtin_amdgcn_mfma_f32_32x32x16_bf16(kf[2], q1_, C0, 0, 0, 0),   P0[10], P0[11], P0[12], P0[13], pw1[0] = PKW(P0, 8), pw1[1] = PKW(P0, 10), pw1); \
    GAPA(C1 = __builtin_amdgcn_mfma_f32_32x32x16_bf16(kf[3], q1_, C1, 0, 0, 0),   P0[14], P0[15], P1[0], P1[1],   pw1[2] = PKW(P0, 12), pw1[3] = PKW(P0, 14), pw1); \
    q1_ = QLD(3); SBAR(); \
    GAPA(C0 = __builtin_amdgcn_mfma_f32_32x32x16_bf16(kf[4], q0_, C0, 0, 0, 0),   P1[2], P1[3], P1[4], P1[5],     pw2[0] = PKW(P1, 0), pw2[1] = PKW(P1, 2), pw2); \
    GAPA(C1 = __builtin_amdgcn_mfma_f32_32x32x16_bf16(kf[5], q0_, C1, 0, 0, 0),   P1[6], P1[7], P1[8], P1[9],     pw2[2] = PKW(P1, 4), pw2[3] = PKW(P1, 6), pw2); \
    GAPA(C0 = __builtin_amdgcn_mfma_f32_32x32x16_bf16(kf[6], q1_, C0, 0, 0, 0),   P1[10], P1[11], P1[12], P1[13], pw3[0] = PKW(P1, 8), pw3[1] = PKW(P1, 10), pw3); \
    GAPA(C1 = __builtin_amdgcn_mfma_f32_32x32x16_bf16(kf[7], q1_, C1, 0, 0, 0),   P1[14], P1[15], 0.f, 0.f,       pw3[2] = PKW(P1, 12), pw3[3] = PKW(P1, 14), pw3); \
    l_reg += sacc; \
    if (GK) { DMA_K((t) + 3, sl_cur); } if (GV) { DMA_V((t) + 1, sl_next); } \
    FRD(0); FRD(1); FRD(2); \
    CMASK(C0, C1, t); \
    { float a = MX3(C0[0], C0[1], C1[0]), b = MX3(C0[2], C0[3], C1[1]); a = MX3(a, C1[2], C1[3]); \
      _Pragma("unroll") for (int r = 4; r < 16; r += 4) { a = MX3(a, C0[r], C0[r + 1]); b = MX3(b, C0[r + 2], C0[r + 3]); a = MX3(a, C1[r], C1[r + 1]); b = MX3(b, C1[r + 2], C1[r + 3]); } \
      float rm = __builtin_fmaxf(a, b); { auto rr = __builtin_amdgcn_permlane32_swap(__float_as_uint(rm), __float_as_uint(rm), false, false); rm = __builtin_fmaxf(__uint_as_float(rr[0]), __uint_as_float(rr[1])); } \
      resc = false; \
      if (__builtin_expect(__any(rm > (float)THRL), 0)) { const float dl = __builtin_fmaxf(rm, 0.f); mhat += dl; \
        _Pragma("unroll") for (int r = 0; r < 16; ++r) { C0[r] -= dl; C1[r] -= dl; } \
        const float f = __builtin_amdgcn_exp2f(-dl); l_reg *= f; if (hi == 0) wsf[r32] = f; resc = true; } } \
    SBAR(); \
    GAPB(o[0] = __builtin_amdgcn_mfma_f32_32x32x16_bf16(PAF(0), FFR(0), o[0], 0, 0, 0), C0, 0);   FRD(3); \
    GAPB(o[1] = __builtin_amdgcn_mfma_f32_32x32x16_bf16(PAF(0), FFR(1), o[1], 0, 0, 0), C0, 2);   FRD(4); \
    GAPB(o[0] = __builtin_amdgcn_mfma_f32_32x32x16_bf16(PAF(1), FFR(2), o[0], 0, 0, 0), C0, 4);   FRD(5); \
    GAPB(o[1] = __builtin_amdgcn_mfma_f32_32x32x16_bf16(PAF(1), FFR(3), o[1], 0, 0, 0), C0, 6);   FRD(6); \
    GAPB(o[0] = __builtin_amdgcn_mfma_f32_32x32x16_bf16(PAF(2), FFR(4), o[0], 0, 0, 0), C0, 8);   FRD(7); \
    GAPB(o[1] = __builtin_amdgcn_mfma_f32_32x32x16_bf16(PAF(2), FFR(5), o[1], 0, 0, 0), C0, 10);  FRD(8); \
    GAPB(o[0] = __builtin_amdgcn_mfma_f32_32x32x16_bf16(PAF(3), FFR(6), o[0], 0, 0, 0), C0, 12);  FRD(9); \
    GAPB(o[1] = __builtin_amdgcn_mfma_f32_32x32x16_bf16(PAF(3), FFR(7), o[1], 0, 0, 0), C0, 14);  FRD(10); \
    KRD(GL, 0); GAPB(o[2] = __builtin_amdgcn_mfma_f32_32x32x16_bf16(PAF(0), FFR(8), o[2], 0, 0, 0), C1, 0);   FRD(11); \
    KRD(GL, 1); GAPB(o[3] = __builtin_amdgcn_mfma_f32_32x32x16_bf16(PAF(0), FFR(9), o[3], 0, 0, 0), C1, 2);   FRD(12); \
    KRD(GL, 2); GAPB(o[2] = __builtin_amdgcn_mfma_f32_32x32x16_bf16(PAF(1), FFR(10), o[2], 0, 0, 0), C1, 4);  FRD(13); \
    KRD(GL, 3); GAPB(o[3] = __builtin_amdgcn_mfma_f32_32x32x16_bf16(PAF(1), FFR(11), o[3], 0, 0, 0), C1, 6);  FRD(14); \
    GAPB(o[2] = __builtin_amdgcn_mfma_f32_32x32x16_bf16(PAF(2), FFR(12), o[2], 0, 0, 0), C1, 8);  FRD(15); \
    GAPB(o[3] = __builtin_amdgcn_mfma_f32_32x32x16_bf16(PAF(2), FFR(13), o[3], 0, 0, 0), C1, 10); \
    GAPB(o[2] = __builtin_amdgcn_mfma_f32_32x32x16_bf16(PAF(3), FFR(14), o[2], 0, 0, 0), C1, 12); \
    GAPB(o[3] = __builtin_amdgcn_mfma_f32_32x32x16_bf16(PAF(3), FFR(15), o[3], 0, 0, 0), C1, 14); \
    } while (0)
  int t = 1;
  for (; t + 5 < NT; t += 2) {
    STEP(pB0, pB1, pA0, pA1, t, true, true, true);     WAIT_BAR(3); RESC(); ROT();
    STEP(pA0, pA1, pB0, pB1, t + 1, true, true, true); WAIT_BAR(3); RESC(); ROT();
  }
  #define ENDW(tt) do { if ((tt) + 3 < NT) { WAIT_BAR(3); } else if ((tt) + 2 < NT) { WAIT_BAR(2); } else { WAIT_BAR(0); } } while (0)
  for (; t + 1 < NT; t += 2) {
    STEP(pB0, pB1, pA0, pA1, t, (t + 3 < NT), (t + 1 < NT), (t + 1 < NT));         ENDW(t);     RESC(); ROT();
    STEP(pA0, pA1, pB0, pB1, t + 1, (t + 4 < NT), (t + 2 < NT), (t + 2 < NT));     ENDW(t + 1); RESC(); ROT();
  }
  STEP(pB0, pB1, pA0, pA1, NT - 1, false, false, false); RESC();
  { float sacc = pB0[0] + pB0[1]; _Pragma("unroll") for (int r = 2; r < 16; ++r) sacc += pB0[r]; _Pragma("unroll") for (int r = 0; r < 16; ++r) sacc += pB1[r]; l_reg += sacc;
    pw0 = (u32x4){PKW(pB0, 0), PKW(pB0, 2), PKW(pB0, 4), PKW(pB0, 6)}; pw1 = (u32x4){PKW(pB0, 8), PKW(pB0, 10), PKW(pB0, 12), PKW(pB0, 14)}; pw2 = (u32x4){PKW(pB1, 0), PKW(pB1, 2), PKW(pB1, 4), PKW(pB1, 6)}; pw3 = (u32x4){PKW(pB1, 8), PKW(pB1, 10), PKW(pB1, 12), PKW(pB1, 14)};
    SBAR(); pv(o, vb0 + 2 * sl_cur, PAF(0), PAF(1), PAF(2), PAF(3)); pv(o + 2, vb0 + 2 * sl_cur + 8192, PAF(0), PAF(1), PAF(2), PAF(3)); }
  #undef PKW
  #undef PAF
  #undef PIN
  #undef MX3
  #undef GAPA
  #undef GAPB
  #undef EX
  #undef FOFF
  #undef FRD
  #undef FFR
  #undef KRD
  #undef STEP
  #undef ENDW
  { auto rr = __builtin_amdgcn_permlane32_swap(__float_as_uint(l_reg), __float_as_uint(l_reg), false, false); l_reg = __uint_as_float(rr[0]) + __uint_as_float(rr[1]); }
  if (hi == 0) wsf[32 + r32] = l_reg; asm volatile("s_waitcnt lgkmcnt(0)" ::: "memory");
  float rli[16];
  #pragma unroll
  for (int r = 0; r < 16; ++r) rli[r] = __builtin_amdgcn_rcpf(wsf[32 + crow(r, hi)]);
  bf16* Ow = A_.O + (wid * QBLK) * A_.os;
  { bf16* stg = (bf16*)(shm + L8_QO) + wid * 2048;
    #pragma unroll
    for (int hv = 0; hv < 2; ++hv) {
      #pragma unroll
      for (int r = 0; r < 16; ++r) { const int orow = crow(r, hi);
        #pragma unroll
        for (int d0 = 0; d0 < 2; ++d0) stg[orow * 64 + d0 * 32 + r32] = __float2bfloat16(o[2 * hv + d0][r] * rli[r]); }
      asm volatile("s_waitcnt lgkmcnt(0)" ::: "memory");
      #pragma unroll
      for (int i = 0; i < 4; ++i) { const int row = i * 8 + (lane >> 3), ch = lane & 7; const u32x4 v = *(const u32x4*)(stg + row * 64 + ch * 8); *(u32x4*)(Ow + row * A_.os + hv * 64 + ch * 8) = v; }
      asm volatile("s_waitcnt lgkmcnt(0)" ::: "memory"); } }
  asm volatile("s_waitcnt lgkmcnt(0)\n\ts_barrier" ::: "memory");
  #undef DMA_K
  #undef DMA_V
  #undef QLD
  #undef NB
  #undef CMASK
  #undef RESC
  #undef ROT
}
#undef SBAR
#undef WAIT_BAR
}

__device__ __forceinline__ void transpose_item(const float* W, int K, int N, bf16_t* WT, LAS float* scr, int item, int lane, const float* gk = nullptr) {
    const int nblk = N / 32, kb = item / nblk, nb = item % nblk, k0 = 64 * kb, n0 = 32 * nb;
#pragma unroll 8
    for (int i = 0; i < 32; ++i) { const int kk = 2 * i + (lane >> 5); const float gg = gk ? gk[k0 + kk] : 1.f; scr[kk * 33 + (lane & 31)] = W[(size_t)(k0 + kk) * N + n0 + (lane & 31)] * gg; }
    asm volatile("s_waitcnt lgkmcnt(0)" ::: "memory");
    const int c = lane & 7;
#pragma unroll
    for (int j = 0; j < 4; ++j) { const int n = (lane >> 3) + 8 * j; const LAS float* s = scr + (8 * c) * 33 + n;
        u32x4 o; o.x = pk2(s[0 * 33], s[1 * 33]); o.y = pk2(s[2 * 33], s[3 * 33]); o.z = pk2(s[4 * 33], s[5 * 33]); o.w = pk2(s[6 * 33], s[7 * 33]);
        *(u32x4*)(WT + (size_t)(n0 + n) * K + k0 + 8 * c) = o; }
    asm volatile("s_waitcnt lgkmcnt(0)" ::: "memory");
}
__device__ __forceinline__ void rms_row_bf16(const float* xrow, const float* g, bf16_t* orow, int lane) {
    const f32x4* xr = (const f32x4*)xrow + lane; const f32x4* gr = (const f32x4*)g + lane;
    f32x4 v[4]; float s = 0.f;
#pragma unroll
    for (int j = 0; j < 4; ++j) { v[j] = xr[64 * j]; s += (v[j].x * v[j].x + v[j].y * v[j].y) + (v[j].z * v[j].z + v[j].w * v[j].w); }
    const float rs = rsqrtf(wave_sum(s) * (1.f / DM) + EPS);
    u32x2* o8 = (u32x2*)orow + lane;
#pragma unroll
    for (int j = 0; j < 4; ++j) { const f32x4 gg = gr[64 * j]; u32x2 w; w.x = pk2(v[j].x * rs * gg.x, v[j].y * rs * gg.y); w.y = pk2(v[j].z * rs * gg.z, v[j].w * rs * gg.w); o8[64 * j] = w; }
}

#define XB_TMO      128
#define XB_XCNT(j)  (256  + 64 * (j))
#define XB_XSUB(j)  (1280 + 64 * (j))
#define XB_XGEN(j)  (2304 + 64 * (j))
#define XB_TOP      3328
#define XB_TOPGEN   3392
#define XCD_BAR_WORDS 3456
#define XB_SPIN_CAP (1u << 18)

__device__ __forceinline__ unsigned xb_ld(unsigned* p)              { return __hip_atomic_load(p, __ATOMIC_RELAXED, __HIP_MEMORY_SCOPE_AGENT); }
__device__ __forceinline__ unsigned xb_add(unsigned* p, unsigned v) { return __hip_atomic_fetch_add(p, v, __ATOMIC_RELAXED, __HIP_MEMORY_SCOPE_AGENT); }
__device__ __forceinline__ unsigned xb_xcc_id() { return (unsigned)__builtin_amdgcn_s_getreg((3 << 11) | 20) & 0xFu; }
#define XB_SPIN(cond, bar) do { unsigned _sp = 0; while (cond) { __builtin_amdgcn_s_sleep(1); \
    if ((++_sp & 255u) == 0u) { if (xb_ld(&(bar)[XB_TMO])) break; if (_sp > XB_SPIN_CAP) { atomicAdd(&(bar)[XB_TMO], 1u); break; } } } } while (0)

struct XcdBarrier {
    unsigned* bar; unsigned x;
    volatile LAS unsigned* st;
};

__device__ __forceinline__ XcdBarrier xcd_barrier_post(unsigned* bar, volatile LAS unsigned* st) {
    XcdBarrier b; b.bar = bar; b.x = xb_xcc_id(); b.st = st;
    if (threadIdx.x == 0) (void)xb_add(&bar[XB_XCNT(b.x)], 1u);
    return b;
}
__device__ __forceinline__ void xcd_barrier_complete(unsigned* bar, unsigned x, unsigned& nloc, unsigned& nx) {
    const unsigned G = gridDim.x * gridDim.y * gridDim.z;
    unsigned sum, cnt, mine, sp = 0u;
    for (;;) {
        sum = 0u; cnt = 0u; mine = 0u;
#pragma unroll
        for (unsigned j = 0; j < 16; ++j) { const unsigned c = xb_ld(&bar[XB_XCNT(j)]); sum += c; cnt += (c > 0u) ? 1u : 0u; mine = (j == x) ? c : mine; }
        if (sum == G) break;
        __builtin_amdgcn_s_sleep(1);
        if ((++sp & 255u) == 0u) { if (xb_ld(&bar[XB_TMO])) break; if (sp > XB_SPIN_CAP) { atomicAdd(&bar[XB_TMO], 1u); break; } }
    }
    nloc = mine > 0u ? mine : 1u; nx = cnt > 0u ? cnt : 1u;
}

__device__ __forceinline__ void xcd_barrier(const XcdBarrier& b) {
    asm volatile("s_waitcnt vmcnt(0)" ::: "memory");
    __syncthreads();
    if (threadIdx.x == 0) {
        unsigned* bar = b.bar;
        __builtin_amdgcn_s_waitcnt(0);
        unsigned nloc = b.st[0], nx = b.st[1];
        if (nloc == 0u) { xcd_barrier_complete(bar, b.x, nloc, nx); b.st[0] = nloc; b.st[1] = nx; }
        const unsigned old = xb_add(&bar[XB_XSUB(b.x)], 1u);
        const unsigned gen = old / nloc;
        if (old + 1u == (gen + 1u) * nloc) {
            __builtin_amdgcn_fence(__ATOMIC_RELEASE, "agent");
            asm volatile("s_waitcnt vmcnt(0)" ::: "memory");
            const unsigned og = xb_add(&bar[XB_TOP], 1u);
            const unsigned tg = og / nx;
            if (og + 1u == (tg + 1u) * nx) xb_add(&bar[XB_TOPGEN], 1u);
            else XB_SPIN(xb_ld(&bar[XB_TOPGEN]) == tg, bar);
            __builtin_amdgcn_fence(__ATOMIC_ACQUIRE, "agent");
            xb_add(&bar[XB_XGEN(b.x)], 1u);
            asm volatile("s_waitcnt vmcnt(0)" ::: "memory");
        } else {
            XB_SPIN(xb_ld(&bar[XB_XGEN(b.x)]) == gen, bar);
            __builtin_amdgcn_fence(__ATOMIC_ACQUIRE, "agent");
            asm volatile("s_waitcnt vmcnt(0)" ::: "memory");
        }
    }
    __syncthreads();
}


struct Args { const float* in[14]; float* out; unsigned char* ws; };

__global__ void __launch_bounds__(512) mk_fwd(Args args) {
    extern __shared__ __attribute__((aligned(16))) unsigned char lds[];
    cg::grid_group grid = cg::this_grid();
    const int tid0 = threadIdx.x, wave = __builtin_amdgcn_readfirstlane(tid0 >> 6);
#define FRESH_LANE() int tid = tid0; asm volatile("" : "+v"(tid)); const int lane = tid & 63
    const int G = gridDim.x, bx = blockIdx.x;
    const int vcu = (G % 8 == 0) ? (bx % 8) * (G / 8) + bx / 8 : bx;
    const int gw = vcu * 8 + wave, NGW = G * 8;
    LAS unsigned char* ldsl = (LAS unsigned char*)lds;
    if (tid0 < 8) ((LAS unsigned*)(ldsl + MISC_OFF))[tid0] = 0u;
    __syncthreads();
    const XcdBarrier xbar = xcd_barrier_post((unsigned*)(args.ws + WS_BAR), (volatile LAS unsigned*)(ldsl + MISC_OFF));
#define ws (args.ws)
#define x_in (args.in[0])
#define norm_mix (args.in[1])
#define w_in (args.in[2])
#define b_gate (args.in[3])
#define diff_lambda (args.in[4])
#define diff_subln (args.in[5])
#define na_rpb (args.in[6])
#define qk_norm (args.in[7])
#define w_branch (args.in[8])
#define w_out (args.in[9])
#define norm_ffn (args.in[10])
#define w_ff1 (args.in[11])
#define w_ff2 (args.in[12])
#define norm_final (args.in[13])
#define xout (args.out)
#define WinT ((bf16_t*)(ws + WS_WIN))
#define WbrT ((bf16_t*)(ws + WS_WBR))
#define WoutT ((bf16_t*)(ws + WS_WOUT))
#define W1T ((bf16_t*)(ws + WS_W1))
#define W2T ((bf16_t*)(ws + WS_W2))
#define STAT ((float*)(ws + WS_STAT))
#define H ((bf16_t*)(ws + WS_H))
#define ATMP ((bf16_t*)(ws + WS_ATMP))
#define BTMP ((bf16_t*)(ws + WS_BTMP))
#define Y ((bf16_t*)(ws + WS_Y))
#define MERGED ((bf16_t*)(ws + WS_MERGED))
#define Z ((bf16_t*)(ws + WS_Z))
#define U ((bf16_t*)(ws + WS_Z))
#define PROJ ((bf16_t*)(ws + WS_PROJ))
#define XB ((bf16_t*)(ws + WS_XB))
#define SSQM ((float*)(ws + WS_SSQM))
#define SSQF ((float*)(ws + WS_SSQF))
#define NRMQ ((unsigned*)(ws + WS_NRM))
#define NRMK ((unsigned*)(ws + WS_NRM) + 1024)

    {
        FRESH_LANE();
        LAS float* scr = (LAS float*)(ldsl + wave * 16384);
        constexpr int I_IN = (DM / 64) * (INW / 32), I_BR = (512 / 64) * (DM / 32), I_OUT = (DM / 64) * (DM / 32), I_1 = (DM / 64) * (DFF / 32), I_2 = (DFF / 64) * (DM / 32);
        constexpr int NITEMS = 2 * I_IN + 8 * I_BR + 2 * I_OUT + 2 * I_1 + 2 * I_2;
        for (int it = gw; it < NITEMS; it += NGW) {
            int r = it;
            if (r < 2 * I_IN) { const int l = r / I_IN; transpose_item(w_in + (size_t)l * DM * INW, DM, INW, WinT + (size_t)l * INW * DM, scr, r % I_IN, lane, norm_mix + l * DM); continue; } r -= 2 * I_IN;
            if (r < 8 * I_BR) { const int ln = r / I_BR; transpose_item(w_branch + (size_t)ln * 512 * DM, 512, DM, WbrT + (size_t)ln * DM * 512, scr, r % I_BR, lane); continue; } r -= 8 * I_BR;
            if (r < 2 * I_OUT) { const int l = r / I_OUT; transpose_item(w_out + (size_t)l * DM * DM, DM, DM, WoutT + (size_t)l * DM * DM, scr, r % I_OUT, lane); continue; } r -= 2 * I_OUT;
            if (r < 2 * I_1) { const int l = r / I_1; transpose_item(w_ff1 + (size_t)l * DM * DFF, DM, DFF, W1T + (size_t)l * DFF * DM, scr, r % I_1, lane, norm_ffn + l * DM); continue; } r -= 2 * I_1;
            { const int l = r / I_2; transpose_item(w_ff2 + (size_t)l * DFF * DM, DFF, DM, W2T + (size_t)l * DM * DFF, scr, r % I_2, lane); }
        }
        {
            f32x4 v[4], vn[4] = {};
            if (gw < NTOK) { const f32x4* xr = (const f32x4*)(x_in + (size_t)gw * DM) + lane;
#pragma unroll
                for (int j = 0; j < 4; ++j) v[j] = xr[64 * j]; }
            for (int m = gw; m < NTOK; m += NGW) {
                if (m + NGW < NTOK) { const f32x4* xr = (const f32x4*)(x_in + (size_t)(m + NGW) * DM) + lane;
#pragma unroll
                    for (int j = 0; j < 4; ++j) vn[j] = xr[64 * j]; }
                u32x2* o8 = (u32x2*)(XB + (size_t)m * DM) + lane; float sq = 0.f;
#pragma unroll
                for (int j = 0; j < 4; ++j) { sq += (v[j].x * v[j].x + v[j].y * v[j].y) + (v[j].z * v[j].z + v[j].w * v[j].w); u32x2 w; w.x = pk2(v[j].x, v[j].y); w.y = pk2(v[j].z, v[j].w); o8[64 * j] = w; }
                sq = wave_sum(sq);
                if (lane == 0) *(f32x4*)(SSQM + (size_t)m * 4) = (f32x4){sq, 0.f, 0.f, 0.f};
#pragma unroll
                for (int j = 0; j < 4; ++j) v[j] = vn[j];
            }
        }
    }
    grid.sync();

    for (int l = 0; l < DEPTH; ++l) {
        { FRESH_LANE(); LAS float* tab = (LAS float*)(ldsl + TAB_OFF); for (int i = tid; i < 8 * 465; i += 512) tab[i] = na_rpb[l * 8 * 465 + i] * LOG2E; }
        __syncthreads();
        for (int grp = 0; grp < NGRP; ++grp) {
            const size_t tok0 = (size_t)grp * TG;
            const float* xsrc = (l == 0) ? x_in : xout;
            {
                pg8::Gemm g{XB + tok0 * DM, WinT + (size_t)l * INW * DM, DM, DM, DM, 1 << 30, 0}; pg8::StaticOrder S; S.init(TG, INW, G, bx);
                if (bx == 0) { FRESH_LANE(); NRMQ[tid] = 0u; NRMQ[tid + 512] = 0u; if (tid < 16) NRMQ[1024 + tid] = 0u; (void)lane; }
                pg8::Epi<0> E{PROJ, nullptr, nullptr, b_gate + l * 4096, INW, SSQM + tok0 * 4, nullptr, nullptr, nullptr};
                pg8::gemm_phase(ldsl, g, S, E);
            }
            xcd_barrier(xbar);
            {
                FRESH_LANE();
                const float inv = exp2f(-(float)(lane & 15) * 0.8304820237218406f);
                const float gk = qk_norm[l * 128 + 64 + lane];
                const int per = (TG + NGW - 1) / NGW;
                float mq = 0.f, mk = 0.f; int cu = -1;
                u32x4 qv, kv, qvn = {}, kvn = {}; unsigned short rw[2], rwn[2] = {};
#define P3_LOAD(QV, KV, RW, mm) do { const bf16_t* ar_ = PROJ + (size_t)(mm) * INW; QV = *(const u32x4*)(ar_ + COL_AQ + lane * 8); KV = *(const u32x4*)(ar_ + COL_AK + lane * 8); \
                    _Pragma("unroll") for (int hd = 0; hd < 2; ++hd) RW[hd] = ar_[COL_DK + hd * 64 + lane]; } while (0)
                if (gw * per < TG) P3_LOAD(qv, kv, rw, gw * per);
                for (int i = 0; i < per; ++i) {
                    const int m = gw * per + i; if (m >= TG) break;
                    if (i + 1 < per && m + 1 < TG) P3_LOAD(qvn, kvn, rwn, m + 1);
                    if ((m >> 8) != cu) { if (cu >= 0 && (lane & 7) == 0) { atomicMax(NRMQ + cu * 8 + (lane >> 3), __float_as_uint(mq)); atomicMax(NRMK + (cu >> 5) * 8 + (lane >> 3), __float_as_uint(mk)); } cu = m >> 8; mq = 0.f; mk = 0.f; }
                    const int s = (int)((tok0 + m) % SEQ); const float pos = (float)((lane < 32) ? (s >> 6) : (s & 63));
                    float sn, cs; sincos_red(pos * inv, sn, cs);
                    { float nq = 0.f, nk = 0.f;
#pragma unroll
                      for (int e = 0; e < 4; ++e) { nq += bflo(qv[e]) * bflo(qv[e]) + bfhi(qv[e]) * bfhi(qv[e]); nk += bflo(kv[e]) * bflo(kv[e]) + bfhi(kv[e]) * bfhi(kv[e]); }
                      nq += __shfl_xor(nq, 1); nk += __shfl_xor(nk, 1); nq += __shfl_xor(nq, 2); nk += __shfl_xor(nk, 2); nq += __shfl_xor(nq, 4); nk += __shfl_xor(nk, 4);
                      mq = fmaxf(mq, sqrtf(nq)); mk = fmaxf(mk, sqrtf(nk)); }
                    bf16_t* row = PROJ + (size_t)m * INW + COL_DK;
#pragma unroll
                    for (int hd = 0; hd < 2; ++hd) {
                        const float v = __uint_as_float((unsigned)rw[hd] << 16);
                        const float rn = rsqrtf(wave_sum(v * v) * (1.f / 64.f) + EPS);
                        const float y = v * rn * gk;
                        const float p = __shfl_xor(y, 16);
                        const float o = ((lane >> 4) & 1) ? (y * cs + p * sn) : (y * cs - p * sn);
                        row[hd * 64 + lane] = (bf16_t)f2bf(o);
                    }
                    qv = qvn; kv = kvn;
#pragma unroll
                    for (int hd = 0; hd < 2; ++hd) rw[hd] = rwn[hd];
                }
#undef P3_LOAD
                if (cu >= 0 && (lane & 7) == 0) { atomicMax(NRMQ + cu * 8 + (lane >> 3), __float_as_uint(mq)); atomicMax(NRMK + (cu >> 5) * 8 + (lane >> 3), __float_as_uint(mk)); }
            }
            xcd_barrier(xbar);
            {
                using namespace attn_body;
                char* shm = (char*)lds;
                {
                    unsigned* qctr = (unsigned*)(ws + WS_BAR) + 3584 + (l * NGRP + grp) * 8;
                    volatile LAS unsigned* slot = (volatile LAS unsigned*)(ldsl + MISC_OFF + 32);
                    const int myx = (G % 8 == 0) ? (vcu / (G / 8)) : 0;
                    int qq = 0;
                    for (;;) {
                        if (tid0 == 0) { int fj = -1, fx = 0;
                            for (; qq < 8; ++qq) { const int x_ = (myx + qq) & 7; const int j_ = (int)atomicAdd(qctr + x_, 1u); if (j_ < 288) { fj = j_; fx = x_; break; } }
                            slot[0] = (unsigned)fj; slot[1] = (unsigned)fx; }
                        __syncthreads();
                        const int j = (int)slot[0], sx = (int)slot[1];
                        __syncthreads();
                        if (j < 0) break;
                        if (j < 128) {
                            AttnArgs a{}; a.qs = INW; a.ks = INW; a.NT = 128; a.tlo = 0; a.thi = 127;
                            if (j >= 32 && j < 96) { const int qb = j & 31, ds = 2 * sx + ((j - 32) >> 5), bb = ds >> 3, h = ds & 7; const size_t tb = (size_t)bb * SEQ;
                                a.Q = (const bf16*)(PROJ + (tb + qb * 256) * INW + COL_DQ + h * 64); a.K = (const bf16*)(PROJ + tb * INW + COL_DK + (h >> 2) * 64);
                                a.V = (const bf16*)(PROJ + tb * INW + COL_DV + (h >> 2) * 64); a.O = (bf16*)(Y + (tb + qb * 256) * 2048 + 1536 + h * 64); a.os = 2048;
                                a.q0 = qb * 256; a.gq = qk_norm + l * 128;
                                attn_unit<MD, 16>(a, shm);
                            } else {
                                int bb, hh, comp, qb;
                                if (j < 32) { bb = sx >> 2; hh = 2 + ((sx >> 1) & 1); comp = sx & 1; qb = j; }
                                else { const int s1 = sx >> 1; bb = s1 >> 1; comp = s1 & 1; hh = (j < 112) ? 1 : 0; qb = (sx & 1) * 16 + ((j - 96) & 15); }
                                const size_t tb = (size_t)bb * SEQ;
                                a.Q = (const bf16*)(PROJ + (tb + qb * 256) * INW + COL_AQ + hh * 128 + comp * 64); a.K = (const bf16*)(PROJ + tb * INW + COL_AK + hh * 128 + comp * 64);
                                a.V = (const bf16*)(PROJ + tb * INW + COL_AV + hh * 128); a.O = (bf16*)(ATMP + (tb + qb * 256) * 1024 + (hh * 2 + comp) * 128); a.os = 1024;
                                a.s2 = exp2f(-2.f * (float)(hh + 1)) * LOG2E;
                                const float Bs = __uint_as_float(NRMQ[(bb * 32 + qb) * 8 + hh * 2 + comp]) * __uint_as_float(NRMK[bb * 8 + hh * 2 + comp]) * 1.02f + 0.25f;
                                const float dlim = fminf((150.f + 2.f * Bs) / a.s2, 1.0e6f), q0f = (float)(qb * 256);
                                int tlo = max(0, (int)floorf((q0f - 63.f - dlim) * (1.f / 64.f))), thi = min(127, (int)ceilf((q0f + 255.f + dlim) * (1.f / 64.f)));
                                if (((thi - tlo + 1) & 1) != 0) { if (tlo > 0) --tlo; else ++thi; }
                                tlo = __builtin_amdgcn_readfirstlane(tlo); thi = __builtin_amdgcn_readfirstlane(thi);
                                a.K += (size_t)tlo * 64 * INW; a.V += (size_t)tlo * 64 * INW; a.q0 = qb * 256 - 64 * tlo; a.NT = thi - tlo + 1;
                                attn_unit128<16>(a, shm);
                            }
                        } else if (j < 192) {
                            const int cs = 2 * sx + ((j - 128) >> 5), qb = (j - 128) & 31, bb = cs >> 3, h = cs & 7, r0 = 4 * qb, kb = min(max(r0 - 4, 0), 116); const size_t tb = (size_t)bb * SEQ;
                            AttnArgs a{}; a.qs = INW; a.ks = INW; a.os = 2048; a.NT = 12; a.tlo = 0; a.thi = 11; a.q0 = r0; a.kb = kb;
                            a.Q = (const bf16*)(PROJ + (tb + r0 * 64) * INW + COL_CQ + h * 64); a.K = (const bf16*)(PROJ + (tb + kb * 64) * INW + COL_CK + h * 64);
                            a.V = (const bf16*)(PROJ + (tb + kb * 64) * INW + COL_CV + h * 64); a.O = (bf16*)(Y + (tb + r0 * 64) * 2048 + 1024 + h * 64);
                            a.tab = (lds_fptr)((lds_cptr)shm + TAB_OFF) + h * 465;
                            attn_unit<MC, 8>(a, shm);
                        } else {
                            const int p = j - 192, sg = 6 * sx + (p >> 4);
                            for (int e = 0; e < 2; ++e) {
                                const int blk = 2 * (p & 15) + e, bb = sg / 24, k = sg % 24, gp = k >> 3, h = k & 7, dsh = 2 * gp, dil = 1 << dsh;
                                const int nblk = 32 >> dsh, res = blk / nblk, i0 = (blk % nblk) * 256, L = SEQ >> dsh;
                                const long tq = (long)bb * SEQ + res + (long)i0 * dil, tk = (long)bb * SEQ + res + (long)(i0 - 64) * dil;
                                AttnArgs a{}; a.qs = dil * INW; a.ks = dil * INW; a.os = dil * 1536; a.NT = 6; a.tlo = (i0 == 0) ? 1 : 0; a.thi = (i0 + 256 == L) ? 4 : 5;
                                const int cq = COL_B + gp * 1536 + h * 64;
                                a.Q = (const bf16*)(PROJ + tq * INW + cq); a.K = (const bf16*)(PROJ + tk * INW + cq + 512); a.V = (const bf16*)(PROJ + tk * INW + cq + 1024);
                                a.O = (bf16*)(BTMP + tq * 1536 + gp * 512 + h * 64);
                                a.s2 = exp2f(-(float)(h + 1)) * (float)dil * LOG2E; a.stat = STAT + (tq * 24 + gp * 8 + h) * 2; a.ss = dil * 48;
                                attn_unit<MB, 8>(a, shm);
                            }
                        }
                    }
                }
            }
            xcd_barrier(xbar);
            {
                FRESH_LANE();
                int l_ = l; asm volatile("" : "+s"(l_));
                const float lam_init = (l_ == 0) ? 0.2f : (0.8f - 0.6f * 0.7408182206817179f);
                float lam;
                { const float* lp = diff_lambda + l * 256; const float a = lp[lane] * lp[64 + lane], b = lp[128 + lane] * lp[192 + lane]; lam = expf(wave_sum(a)) - expf(wave_sum(b)) + lam_init; lam = __uint_as_float(__builtin_amdgcn_readfirstlane(__float_as_uint(lam))); }
                const float out_scale = 1.f - lam_init;
                const float g0 = diff_subln[l * 128 + 2 * lane], g1 = diff_subln[l * 128 + 2 * lane + 1];
                const int h = lane >> 3, d8 = (lane & 7) * 8;
                unsigned aw[8]; u32x4 bw[3]; float sv[6];
#define P5_LOAD(AW, BW, SV, mm) do { const unsigned* at_ = (const unsigned*)(ATMP + (size_t)(mm) * 1024); _Pragma("unroll") for (int q = 0; q < 8; ++q) AW[q] = at_[q * 64 + lane]; \
                    const bf16_t* bt_ = BTMP + (size_t)(mm) * 1536 + h * 64 + d8; _Pragma("unroll") for (int g = 0; g < 3; ++g) BW[g] = *(const u32x4*)(bt_ + g * 512); \
                    const float* st_ = STAT + (size_t)(mm) * 48 + h * 2; _Pragma("unroll") for (int g = 0; g < 3; ++g) { SV[2 * g] = st_[16 * g]; SV[2 * g + 1] = st_[16 * g + 1]; } } while (0)
                for (int m = gw; m < TG; m += NGW) {
                    P5_LOAD(aw, bw, sv, m);
                    unsigned* yr = (unsigned*)(Y + (size_t)m * 2048);
#pragma unroll
                    for (int hh = 0; hh < 4; ++hh) {
                        const unsigned w0 = aw[hh * 2], w1 = aw[hh * 2 + 1];
                        const float d0 = bflo(w0) - lam * bflo(w1), d1 = bfhi(w0) - lam * bfhi(w1);
                        const float rn = rsqrtf(wave_sum(d0 * d0 + d1 * d1) * (1.f / 128.f) + EPS) * out_scale;
                        yr[hh * 64 + lane] = pk2(d0 * rn * g0, d1 * rn * g1);
                    }
                    const float m0 = sv[0], l0 = sv[1], m1 = sv[2], l1 = sv[3], m2 = sv[4], l2 = sv[5];
                    const float ms = fmaxf(m0, fmaxf(m1, m2));
                    const float w0 = l0 * exp2f(m0 - ms), w1 = l1 * exp2f(m1 - ms), w2 = l2 * exp2f(m2 - ms); const float inv = 1.f / (w0 + w1 + w2);
                    const u32x4 a0 = bw[0], a1 = bw[1], a2 = bw[2];
                    u32x4 o;
#pragma unroll
                    for (int e = 0; e < 4; ++e) { const float lo = (w0 * bflo(a0[e]) + w1 * bflo(a1[e]) + w2 * bflo(a2[e])) * inv, hi = (w0 * bfhi(a0[e]) + w1 * bfhi(a1[e]) + w2 * bfhi(a2[e])) * inv; o[e] = pk2(lo, hi); }
                    *(u32x4*)(Y + (size_t)m * 2048 + 512 + h * 64 + d8) = o;
                }
#undef P5_LOAD
            }
            xcd_barrier(xbar);
            {
                pg8::Gemm g{Y, WbrT + (size_t)l * 4096 * 512, 2048, 512, 512, 4, 512}; pg8::StaticOrder S; S.init(TG, 4096, G, bx);
                pg8::Epi<1> E{Z, nullptr, nullptr, nullptr, 4096, nullptr, nullptr, nullptr, nullptr};
                pg8::gemm_phase(ldsl, g, S, E);
            }
            xcd_barrier(xbar);
            { FRESH_LANE();
            u32x4 gv[2][4], zv[2][4];
#define P7_LOAD(GV, ZV, mm) do { const bf16_t* gr_ = PROJ + (size_t)(mm) * INW + COL_GATE + lane * 8; const bf16_t* zr_ = Z + (size_t)(mm) * 4096 + lane * 8; \
                _Pragma("unroll") for (int jj = 0; jj < 2; ++jj) _Pragma("unroll") for (int n = 0; n < 4; ++n) { GV[jj][n] = *(const u32x4*)(gr_ + n * 1024 + jj * 512); ZV[jj][n] = *(const u32x4*)(zr_ + n * 1024 + jj * 512); } } while (0)
            for (int m = gw; m < TG; m += NGW) {
                P7_LOAD(gv, zv, m);
#pragma unroll
                for (int j = 0; j < 2; ++j) { const int c = lane * 8 + j * 512; float acc[8] = {0.f, 0.f, 0.f, 0.f, 0.f, 0.f, 0.f, 0.f};
#pragma unroll
                    for (int n = 0; n < 4; ++n) {
#pragma unroll
                        for (int e = 0; e < 4; ++e) { acc[2 * e] += bflo(gv[j][n][e]) * bflo(zv[j][n][e]); acc[2 * e + 1] += bfhi(gv[j][n][e]) * bfhi(zv[j][n][e]); } }
                    u32x4 o; o.x = pk2(acc[0], acc[1]); o.y = pk2(acc[2], acc[3]); o.z = pk2(acc[4], acc[5]); o.w = pk2(acc[6], acc[7]);
                    *(u32x4*)(MERGED + (size_t)m * DM + c) = o; }
#undef P7_LOAD
            } }
            xcd_barrier(xbar);
            {
                pg8::Gemm g{MERGED, WoutT + (size_t)l * DM * DM, DM, DM, DM, 1 << 30, 0}; pg8::StaticOrder S; S.init(TG, DM, G, bx);
                pg8::Epi<3> E{nullptr, xout + tok0 * DM, xsrc + tok0 * DM, nullptr, DM, nullptr, H, SSQF, (LAS float*)(ldsl + SSQ_OFF)};
                pg8::gemm_phase(ldsl, g, S, E);
            }
            xcd_barrier(xbar);
            {
                pg8::Gemm g{H, W1T + (size_t)l * DFF * DM, DM, DM, DM, 1 << 30, 0}; pg8::StaticOrder S; S.init(TG, DFF, G, bx);
                pg8::Epi<2> E{U, nullptr, nullptr, nullptr, DFF, SSQF, nullptr, nullptr, nullptr};
                pg8::gemm_phase(ldsl, g, S, E);
            }
            xcd_barrier(xbar);
            {
                pg8::Gemm g{U, W2T + (size_t)l * DM * DFF, DFF, DFF, DFF, 1 << 30, 0}; pg8::StaticOrder S; S.init(TG, DM, G, bx);
                pg8::Epi<3> E{nullptr, xout + tok0 * DM, xout + tok0 * DM, nullptr, DM, nullptr, XB + tok0 * DM, SSQM + tok0 * 4, (LAS float*)(ldsl + SSQ_OFF)};
                pg8::gemm_phase(ldsl, g, S, E);
            }
            if (l == DEPTH - 1 && grp == NGRP - 1) xcd_barrier(xbar);
        }
    }
    {
        FRESH_LANE();
        const f32x4* g4 = (const f32x4*)norm_final + lane; f32x4 gg[4];
#pragma unroll
        for (int j = 0; j < 4; ++j) gg[j] = g4[64 * j];
        f32x4 v[4], vn[4] = {};
        if (gw < NTOK) { const f32x4* o = (const f32x4*)(xout + (size_t)gw * DM) + lane;
#pragma unroll
            for (int j = 0; j < 4; ++j) v[j] = o[64 * j]; }
        for (int m = gw; m < NTOK; m += NGW) {
            if (m + NGW < NTOK) { const f32x4* on = (const f32x4*)(xout + (size_t)(m + NGW) * DM) + lane;
#pragma unroll
                for (int j = 0; j < 4; ++j) vn[j] = on[64 * j]; }
            f32x4* o = (f32x4*)(xout + (size_t)m * DM) + lane; float sq = 0.f;
#pragma unroll
            for (int j = 0; j < 4; ++j) sq += (v[j].x * v[j].x + v[j].y * v[j].y) + (v[j].z * v[j].z + v[j].w * v[j].w);
            const float r = rsqrtf(wave_sum(sq) * (1.f / DM) + EPS);
#pragma unroll
            for (int j = 0; j < 4; ++j) o[64 * j] = (f32x4){v[j].x * r * gg[j].x, v[j].y * r * gg[j].y, v[j].z * r * gg[j].z, v[j].w * r * gg[j].w};
#pragma unroll
            for (int j = 0; j < 4; ++j) v[j] = vn[j];
        }
    }
}

#undef ws
#undef x_in
#undef norm_mix
#undef w_in
#undef b_gate
#undef diff_lambda
#undef diff_subln
#undef na_rpb
#undef qk_norm
#undef w_branch
#undef w_out
#undef norm_ffn
#undef w_ff1
#undef w_ff2
#undef norm_final
#undef xout
#undef WinT
#undef WbrT
#undef WoutT
#undef W1T
#undef W2T
#undef STAT
#undef H
#undef ATMP
#undef BTMP
#undef Y
#undef MERGED
#undef Z
#undef U
#undef PROJ
#undef NRMQ
#undef XB
#undef SSQM
#undef SSQF
#undef NRMK

extern "C" void kernel_launch(void* const* d_in, const int* in_sizes, int n_in, void* d_out, int out_size, void* d_ws, size_t ws_size, hipStream_t stream) {
    static int grid_blocks = 0;
    if (!grid_blocks) {
        int dev = 0, cus = 0, per_cu = 0;
        (void)hipGetDevice(&dev);
        (void)hipDeviceGetAttribute(&cus, hipDeviceAttributeMultiprocessorCount, dev);
        (void)hipFuncSetAttribute((const void*)mk_fwd, hipFuncAttributeMaxDynamicSharedMemorySize, LDS_BYTES);
        (void)hipOccupancyMaxActiveBlocksPerMultiprocessor(&per_cu, (const void*)mk_fwd, 512, LDS_BYTES);
        if (per_cu < 1) per_cu = 1;
        grid_blocks = cus * per_cu;
        if (ws_size < WS_END || n_in != 14) { fprintf(stderr, "kernel_launch: workspace %zu < %zu or n_in %d != 14\n", ws_size, (size_t)WS_END, n_in); grid_blocks = -1; }
    }
    if (grid_blocks < 0) return;
    (void)hipMemsetAsync((char*)d_ws + WS_BAR, 0, 16384, stream);
    Args a{};
    for (int i = 0; i < 14; ++i) a.in[i] = (const float*)d_in[i];
    a.out = (float*)d_out; a.ws = (unsigned char*)d_ws;
    void* kargs[] = {&a};
    hipError_t e = hipLaunchCooperativeKernel((const void*)mk_fwd, dim3(grid_blocks), dim3(512), kargs, LDS_BYTES, stream);
    if (e != hipSuccess) fprintf(stderr, "cooperative launch failed: %s (grid %d)\n", hipGetErrorString(e), grid_blocks);
}
```

```cpp
#include <hip/hip_runtime.h>
#include <hip/hip_cooperative_groups.h>
#include <hip/hip_bf16.h>
#include <cstdio>
#include <cstdint>
#include <cmath>
namespace cg = cooperative_groups;

constexpr int BATCH = 8, SEQ = 8192, DM = 1024, NTOK = BATCH * SEQ, INW = 12544, DFF = 4096, DEPTH = 2;
constexpr int GB = 2, TG = GB * SEQ, NGRP = BATCH / GB;
constexpr float EPS = 1e-6f;
constexpr float LOG2E = 1.4426950408889634f;
constexpr float C2 = 0.125f * LOG2E;
constexpr int COL_AQ = 0, COL_AK = 512, COL_AV = 1024, COL_B = 1536, COL_CQ = 6144, COL_CK = 6656, COL_CV = 7168, COL_DQ = 7680, COL_DK = 8192, COL_DV = 8320, COL_GATE = 8448;
constexpr size_t MiB = 1u << 20;
constexpr size_t WS_WIN = 0, WS_WBR = 49 * MiB, WS_WOUT = 57 * MiB, WS_W1 = 61 * MiB, WS_W2 = 77 * MiB, WS_STAT = 93 * MiB, WS_H = 96 * MiB, WS_ATMP = 128 * MiB,
                 WS_BTMP = 160 * MiB, WS_Y = 208 * MiB, WS_MERGED = 272 * MiB, WS_Z = 304 * MiB, WS_PROJ = 432 * MiB, WS_NRM = 824 * MiB, WS_BAR = 824 * MiB + 512 * 1024, WS_SSQM = 825 * MiB, WS_SSQF = 826 * MiB, WS_XB = 827 * MiB, WS_END = 955 * MiB;
constexpr int LDS_BYTES = 151552, TAB_OFF = 131072, MISC_OFF = 147072, SSQ_OFF = 147456;

#define LAS __attribute__((address_space(3)))
typedef unsigned short bf16_t;
typedef short bf16x8 __attribute__((ext_vector_type(8)));
typedef float f32x4 __attribute__((ext_vector_type(4)));
typedef unsigned u32x4 __attribute__((ext_vector_type(4)));
typedef unsigned u32x2 __attribute__((ext_vector_type(2)));

__device__ __forceinline__ unsigned f2bf(float f) { unsigned u = __builtin_bit_cast(unsigned, f); return (u + 0x7fffu + ((u >> 16) & 1u)) >> 16; }
typedef float f32x2_pk __attribute__((ext_vector_type(2))); typedef __bf16 bf16x2_pk __attribute__((ext_vector_type(2)));
__device__ __forceinline__ unsigned pk2(float lo, float hi) { f32x2_pk v = {lo, hi}; bf16x2_pk b = __builtin_convertvector(v, bf16x2_pk); return __builtin_bit_cast(unsigned, b); }
__device__ __forceinline__ float bflo(unsigned w) { return __uint_as_float(w << 16); }
__device__ __forceinline__ float bfhi(unsigned w) { return __uint_as_float(w & 0xffff0000u); }
__device__ __forceinline__ float wave_sum(float v) {
#pragma unroll
    for (int o = 1; o < 64; o <<= 1) v += __shfl_xor(v, o);
    return v;
}

namespace pg8 {
constexpr int BM = 256, BK = 64, HALF = 128, HTB = HALF * BK * 2, STAGE_BYTES = 8 * HTB, NXCD = 8, WGM = 4;
__host__ __device__ __forceinline__ int lds_byte(int r, int c) { const int st = (r >> 4) * 2 + (c >> 5), rr = r & 15, cc = c & 31, ob = rr * 64 + cc * 2; return st * 1024 + (ob ^ (((ob >> 9) & 1) << 5)); }
__host__ __device__ __forceinline__ void stage_rc(int b, int& R, int& C) { const int st = b / 1024, sb = b % 1024, swz = sb ^ (((sb >> 9) & 1) << 5); R = (st >> 1) * 16 + swz / 64; C = (st & 1) * 32 + (swz % 64) / 2; }
__host__ __device__ __forceinline__ int perm32(int rho) { const int n = rho >> 4, i = rho & 15; return 8 * (i >> 2) + 4 * n + (i & 3); }

struct Unit { int pm, pn; };
struct Gemm { const bf16_t* A; const bf16_t* Bt; int lda, ldb, K, adiv, astride; };

struct StaticOrder {
    int nM, nN, nwg, G, c;
    __device__ void init(int M, int N, int G_, int c_) { nM = M / BM; nN = N / BM; nwg = nM * nN; G = G_; c = c_; }
    __device__ bool next(int i, Unit& u) const {
        const long L = (long)i * G + c; if (L >= nwg) return false;
        int wgid = (int)L; { const int q = nwg / NXCD, r = nwg % NXCD, xcd = wgid % NXCD, off = wgid / NXCD; wgid = (xcd < r ? xcd * (q + 1) : r * (q + 1) + (xcd - r) * q) + off; }
        const int nig = WGM * nN, gid = wgid / nig, fm = gid * WGM, gsz = (nM - fm) < WGM ? (nM - fm) : WGM;
        u.pm = fm + ((wgid % nig) % gsz); u.pn = (wgid % nig) / gsz; return true;
    }
};

__device__ __forceinline__ unsigned cvt_pk_bf16(float lo, float hi) { unsigned r; asm volatile("v_cvt_pk_bf16_f32 %0, %1, %2" : "=v"(r) : "v"(lo), "v"(hi)); return r; }

template <int MODE> struct Epi {
    bf16_t* O; float* Of; const float* base; const float* bias; int ldc;
    const float* ssq;
    bf16_t* XBo; float* SSQo; LAS float* lx;
    __device__ __forceinline__ void operator()(const f32x4 (&acc)[2][2][4][2], const Unit& u, int wr, int wc, int fr, int fq) const {
        const int row0 = u.pm * BM + wr * 64 + fr, col0 = u.pn * BM + wc * 32 + 8 * fq;
        int kind = 0; float sc = 1.f;
        if (MODE == 0) { const int pn = u.pn; if (pn >= 33) kind = 2; else if (pn < 2 || pn == 6 || pn == 7 || pn == 12 || pn == 13 || pn == 18 || pn == 19 || pn == 24 || pn == 25) sc = C2; }
        float rsv[2][4]; f32x4 bv[2][2];
#pragma unroll
        for (int ai = 0; ai < 2; ++ai)
#pragma unroll
            for (int m = 0; m < 4; ++m) { rsv[ai][m] = 1.f;
                if (MODE == 0 || MODE == 2) { const f32x4 q = *(const f32x4*)(ssq + (size_t)(row0 + ai * HALF + m * 16) * 4); rsv[ai][m] = rsqrtf(((q[0] + q[1]) + (q[2] + q[3])) * (1.f / 1024.f) + EPS); } }
#pragma unroll
        for (int bj = 0; bj < 2; ++bj)
#pragma unroll
            for (int n = 0; n < 2; ++n) { bv[bj][n] = (f32x4){0.f, 0.f, 0.f, 0.f}; if (MODE == 0) { if (kind == 2) bv[bj][n] = *(const f32x4*)(bias + col0 + bj * HALF - COL_GATE + 4 * n); } }
        f32x4 nb[2][2];
        if (MODE == 3) {
#pragma unroll
            for (int bj = 0; bj < 2; ++bj)
#pragma unroll
                for (int n = 0; n < 2; ++n) nb[bj][n] = *(const f32x4*)(base + (size_t)row0 * ldc + col0 + bj * HALF + 4 * n);
        }
#pragma unroll
        for (int ai = 0; ai < 2; ++ai)
#pragma unroll
            for (int m = 0; m < 4; ++m) { const size_t roff = (size_t)(row0 + ai * HALF + m * 16) * ldc; float psq = 0.f; const float rs = rsv[ai][m];
                f32x4 cb[2][2];
                if (MODE == 3) {
#pragma unroll
                    for (int bj = 0; bj < 2; ++bj)
#pragma unroll
                        for (int n = 0; n < 2; ++n) cb[bj][n] = nb[bj][n];
                    const int g1 = ai * 4 + m + 1;
                    if (g1 < 8) { const size_t r1 = (size_t)(row0 + (g1 >> 2) * HALF + (g1 & 3) * 16) * ldc;
#pragma unroll
                        for (int bj = 0; bj < 2; ++bj)
#pragma unroll
                            for (int n = 0; n < 2; ++n) nb[bj][n] = *(const f32x4*)(base + r1 + col0 + bj * HALF + 4 * n); }
                }
#pragma unroll
                for (int bj = 0; bj < 2; ++bj) { const int col = col0 + bj * HALF; f32x4 v0 = acc[ai][bj][m][0], v1 = acc[ai][bj][m][1];
                    if (MODE == 3) {
                        v0 = cb[bj][0] + v0; v1 = cb[bj][1] + v1;
                        *(f32x4*)(Of + roff + col) = v0; *(f32x4*)(Of + roff + col + 4) = v1;
                        psq += (v0[0] * v0[0] + v0[1] * v0[1]) + (v0[2] * v0[2] + v0[3] * v0[3]) + (v1[0] * v1[0] + v1[1] * v1[1]) + (v1[2] * v1[2] + v1[3] * v1[3]);
                        u32x4 w; w.x = cvt_pk_bf16(v0[0], v0[1]); w.y = cvt_pk_bf16(v0[2], v0[3]); w.z = cvt_pk_bf16(v1[0], v1[1]); w.w = cvt_pk_bf16(v1[2], v1[3]);
                        *(u32x4*)(XBo + roff + col) = w;
                    } else {
                        if (MODE == 0 || MODE == 2) { v0 = v0 * rs; v1 = v1 * rs; }
                        if (MODE == 0) {
                            if (kind == 2) {
#pragma unroll
                                for (int e = 0; e < 4; ++e) { v0[e] = __builtin_amdgcn_rcpf(1.f + __expf(-(v0[e] + bv[bj][0][e]))); v1[e] = __builtin_amdgcn_rcpf(1.f + __expf(-(v1[e] + bv[bj][1][e]))); } }
                            else { v0 = v0 * sc; v1 = v1 * sc; }
                        }
                        if (MODE == 2) {
#pragma unroll
                            for (int e = 0; e < 4; ++e) { const float a = fmaxf(v0[e], 0.f), b = fmaxf(v1[e], 0.f); v0[e] = a * a; v1[e] = b * b; } }
                        u32x4 w; w.x = cvt_pk_bf16(v0[0], v0[1]); w.y = cvt_pk_bf16(v0[2], v0[3]); w.z = cvt_pk_bf16(v1[0], v1[1]); w.w = cvt_pk_bf16(v1[2], v1[3]);
                        *(u32x4*)(O + roff + col) = w;
                    } }
                if (MODE == 3) { psq += __shfl_xor(psq, 16); psq += __shfl_xor(psq, 32); if (fq == 0) lx[(ai * HALF + wr * 64 + m * 16 + fr) * 4 + wc] = psq; }
            }
        if (MODE == 3) {
            asm volatile("s_waitcnt lgkmcnt(0)" ::: "memory"); __builtin_amdgcn_s_barrier(); asm volatile("" ::: "memory");
            const int t = threadIdx.x;
            if (t < 256) { const f32x4 q = *(const LAS f32x4*)(lx + t * 4); SSQo[(size_t)(u.pm * BM + t) * 4 + u.pn] = (q[0] + q[1]) + (q[2] + q[3]); }
        }
    }
};

template <class EpiT>
__device__ __forceinline__ void gemm_phase(LAS unsigned char* lds, const Gemm g, const StaticOrder& S, const EpiT& E) {
    int tid_ = threadIdx.x; asm volatile("" : "+v"(tid_));
    const int tid = tid_, wid = __builtin_amdgcn_readfirstlane(tid >> 6), lane = tid & 63, wr = wid >> 2, wc = wid & 3, fr = lane & 15, fq = lane >> 4;
    const int K = g.K, nt = K / BK;
    unsigned voffA[2], voffB[2];
#pragma unroll
    for (int i = 0; i < 2; ++i) { int R, C; stage_rc(tid * 16 + i * 8192, R, C); const int Rb = (R & ~31) + perm32(R & 31);
        voffA[i] = (unsigned)(R * g.lda + C) * 2u; voffB[i] = (unsigned)(Rb * g.ldb + C) * 2u; }
    const size_t kstep = (size_t)(BK * 2);
    const size_t hA = (size_t)HALF * g.lda * 2, hB = (size_t)HALF * g.ldb * 2;
    const size_t tA = 2 * hA, tB = 2 * hB;
    const unsigned ldsw = (unsigned)wid * 1024u;
    const int aoff = lds_byte(wr * 64 + fr, fq * 8), boff = lds_byte(wc * 32 + fr, fq * 8);
#define PG8_SA(b, h) (((b) * 2 + (h)) * HTB)
#define PG8_SB(b, h) ((4 + (b) * 2 + (h)) * HTB)
#define PG8_STAGE(bufoff, gbase, voff) do { _Pragma("unroll") for (int _i = 0; _i < 2; ++_i) \
        __builtin_amdgcn_global_load_lds((const unsigned*)((const char*)(gbase) + (voff)[_i]), (LAS unsigned*)(lds + (bufoff) + ldsw + _i * 8192), 16, 0, 0); } while (0)
#define PG8_LDA(dst, b, h) do { _Pragma("unroll") for (int m = 0; m < 4; ++m) _Pragma("unroll") for (int k = 0; k < 2; ++k) dst[m][k] = *(const LAS bf16x8*)(lds + PG8_SA(b, h) + aoff + m * 2048 + k * 1024); } while (0)
#define PG8_LDB(dst, b, h) do { _Pragma("unroll") for (int n = 0; n < 2; ++n) _Pragma("unroll") for (int k = 0; k < 2; ++k) dst[n][k] = *(const LAS bf16x8*)(lds + PG8_SB(b, h) + boff + n * 2048 + k * 1024); } while (0)
#define PG8_MMA(ai, bj, At, Bt) do { __builtin_amdgcn_s_setprio(1); _Pragma("unroll") for (int m = 0; m < 4; ++m) _Pragma("unroll") for (int n = 0; n < 2; ++n) _Pragma("unroll") for (int k = 0; k < 2; ++k) \
        acc[ai][bj][m][n] = __builtin_amdgcn_mfma_f32_16x16x32_bf16(Bt[n][k], At[m][k], acc[ai][bj][m][n], 0, 0, 0); __builtin_amdgcn_s_setprio(0); } while (0)
#define PG8_WAIT_V(n) asm volatile("s_waitcnt vmcnt(" #n ")" ::: "memory")
#define PG8_WAIT_L(n) asm volatile("s_waitcnt lgkmcnt(" #n ")" ::: "memory")
#define PG8_BAR __builtin_amdgcn_s_barrier()
#define PG8_SCHED __builtin_amdgcn_sched_barrier(0)
#define PG8_PA(u) ((const char*)g.A + (size_t)(u).pm * tA + (size_t)((u).pn / g.adiv) * (size_t)g.astride * 2)
#define PG8_PB(u) ((const char*)g.Bt + (size_t)(u).pn * tB)
    Unit cur, nxt; int ui = 0;
    if (!S.next(0, cur)) return;
    f32x4 acc[2][2][4][2];
#pragma unroll
    for (int a = 0; a < 2; ++a)
#pragma unroll
        for (int b = 0; b < 2; ++b)
#pragma unroll
            for (int m = 0; m < 4; ++m)
#pragma unroll
                for (int n = 0; n < 2; ++n) acc[a][b][m][n] = (f32x4){0.f, 0.f, 0.f, 0.f};
    bf16x8 At[4][2], B0[2][2], B1[2][2];
    const char* cA = PG8_PA(cur); const char* cB = PG8_PB(cur);
    PG8_STAGE(PG8_SB(0, 0), cB, voffB); PG8_STAGE(PG8_SB(0, 1), cB + hB, voffB); PG8_STAGE(PG8_SA(0, 0), cA, voffA); PG8_STAGE(PG8_SA(0, 1), cA + hA, voffA);
    if (wr == 1) PG8_BAR;
    PG8_WAIT_V(2); PG8_BAR;
    PG8_STAGE(PG8_SB(1, 0), cB + kstep, voffB); PG8_STAGE(PG8_SA(1, 0), cA + kstep, voffA); PG8_STAGE(PG8_SB(1, 1), cB + hB + kstep, voffB);
    PG8_WAIT_V(6); PG8_BAR;
    for (;;) {
        const bool has_next = S.next(ui + 1, nxt);
        const char* nA = has_next ? PG8_PA(nxt) : cA; const char* nB = has_next ? PG8_PB(nxt) : cB;
        for (int t = 0; t < nt; t += 2) {
            const bool last = (t == nt - 2);
            const char* a1 = cA + (size_t)(t + 1) * kstep;
            const char* a2 = last ? nA : cA + (size_t)(t + 2) * kstep; const char* b2 = last ? nB : cB + (size_t)(t + 2) * kstep;
            const char* a3 = a2 + kstep; const char* b3 = b2 + kstep;
            PG8_LDB(B0, 0, 0); PG8_LDB(B1, 0, 1); PG8_SCHED; PG8_LDA(At, 0, 0); PG8_STAGE(PG8_SA(1, 1), a1 + hA, voffA);
            PG8_WAIT_V(8); PG8_WAIT_L(0); PG8_BAR; PG8_MMA(0, 0, At, B0); PG8_MMA(0, 1, At, B1); PG8_BAR; PG8_SCHED;
            PG8_LDA(At, 0, 1); PG8_STAGE(PG8_SB(0, 0), b2, voffB); PG8_STAGE(PG8_SB(0, 1), b2 + hB, voffB); PG8_STAGE(PG8_SA(0, 0), a2, voffA);
            PG8_WAIT_V(8); PG8_WAIT_L(0); PG8_BAR; PG8_MMA(1, 0, At, B0); PG8_MMA(1, 1, At, B1); PG8_BAR; PG8_SCHED;
            PG8_LDB(B0, 1, 0); PG8_LDB(B1, 1, 1); PG8_SCHED; PG8_LDA(At, 1, 0); PG8_STAGE(PG8_SA(0, 1), a2 + hA, voffA);
            PG8_WAIT_V(8); PG8_WAIT_L(0); PG8_BAR; PG8_MMA(0, 0, At, B0); PG8_MMA(0, 1, At, B1); PG8_BAR; PG8_SCHED;
            PG8_LDA(At, 1, 1); PG8_STAGE(PG8_SB(1, 0), b3, voffB); PG8_STAGE(PG8_SB(1, 1), b3 + hB, voffB); PG8_STAGE(PG8_SA(1, 0), a3, voffA);
            PG8_WAIT_V(8); PG8_WAIT_L(0); PG8_BAR; PG8_MMA(1, 0, At, B0); PG8_MMA(1, 1, At, B1); PG8_BAR; PG8_SCHED;
        }
        if (wr == 0) PG8_BAR;
        E(acc, cur, wr, wc, fr, fq);
        if (!has_next) break;
#pragma unroll
        for (int a = 0; a < 2; ++a)
#pragma unroll
            for (int b = 0; b < 2; ++b)
#pragma unroll
                for (int m = 0; m < 4; ++m)
#pragma unroll
                    for (int n = 0; n < 2; ++n) acc[a][b][m][n] = (f32x4){0.f, 0.f, 0.f, 0.f};
        cur = nxt; cA = nA; cB = nB; ++ui;
        if (wr == 1) PG8_BAR;
    }
    PG8_WAIT_V(0);
    PG8_BAR;
#undef PG8_SA
#undef PG8_SB
#undef PG8_STAGE
#undef PG8_LDA
#undef PG8_LDB
#undef PG8_MMA
#undef PG8_WAIT_V
#undef PG8_WAIT_L
#undef PG8_BAR
#undef PG8_SCHED
#undef PG8_PA
#undef PG8_PB
}
}

__device__ __forceinline__ void sincos_red(float a, float& s, float& c) {
    const float q = rintf(a * 0.636619772367581f); const int iq = (int)q;
    float r = fmaf(q, -1.5703125f, a); r = fmaf(q, -4.837512969970703125e-4f, r); r = fmaf(q, -7.54978995489188216e-8f, r);
    const float r2 = r * r;
    const float sp = r + r * r2 * (-1.6666654611e-1f + r2 * (8.3321608736e-3f + r2 * (-1.9515295891e-4f)));
    const float cp = 1.0f - 0.5f * r2 + r2 * r2 * (4.166664568298827e-2f + r2 * (-1.388731625493765e-3f + r2 * 2.443315711809948e-5f));
    const int k = iq & 3;
    s = (k == 0) ? sp : (k == 1) ? cp : (k == 2) ? -sp : -cp;
    c = (k == 0) ? cp : (k == 1) ? -sp : (k == 2) ? -cp : sp;
}

namespace attn_body {
using bf16 = __hip_bfloat16;
using s16x4 = __attribute__((ext_vector_type(4))) short;
using f32x16 = __attribute__((ext_vector_type(16))) float;
constexpr int NW = 8, QBLK = 32, QB = QBLK * NW, KVBLK = 64;
constexpr int MA = 0, MB = 1, MC = 2, MD = 3;
__device__ __forceinline__ int crow(int r, int hi) { return (r & 3) + 8 * (r >> 2) + 4 * hi; }
#define SBAR() __builtin_amdgcn_sched_barrier(0)
constexpr int NSLOT = 3, SLOTB = 8192;
constexpr int LDS_K = 0, LDS_V = NSLOT * SLOTB, LDS_WS = 2 * NSLOT * SLOTB, LDS_OST = LDS_WS + NW * 64 * 4, LDS_ATT = LDS_OST + NW * 4096;
typedef __attribute__((address_space(3))) const char* lds_cptr;
typedef __attribute__((address_space(3))) const float* lds_fptr;

struct AttnArgs {
    const bf16* Q; const bf16* K; const bf16* V; bf16* O;
    int qs, ks, os;
    int NT, tlo, thi;
    float s2;
    int q0;
    int kb;
    float* stat; int ss;
    lds_fptr tab;
    const float* gq;
};

__device__ __forceinline__ void glds16(const void* gsrc, unsigned lds_dst) { unsigned keep;
  asm volatile("s_mov_b32 %0, m0\n\ts_mov_b32 m0, %2\n\ts_nop 0\n\tglobal_load_lds_dwordx4 %1, off\n\ts_mov_b32 m0, %0" : "=&s"(keep) : "v"(gsrc), "s"(lds_dst) : "memory"); }
__device__ __forceinline__ float max3f(float a, float b, float c) { float r; asm("v_max3_f32 %0, %1, %2, %3" : "=v"(r) : "v"(a), "v"(b), "v"(c)); return r; }
__device__ __forceinline__ float max2f(float a, float b) { float r; asm("v_max_f32_e32 %0, %1, %2" : "=v"(r) : "v"(a), "v"(b)); return r; }
__device__ __forceinline__ float fadd_s(float a, float b) { float r; asm("v_add_f32_e32 %0, %1, %2" : "=v"(r) : "v"(a), "v"(b)); return r; }
__device__ __forceinline__ float fsub_s(float a, float b) { float r; asm("v_sub_f32_e32 %0, %1, %2" : "=v"(r) : "v"(a), "v"(b)); return r; }
typedef float f32x2_t __attribute__((ext_vector_type(2))); typedef __bf16 bf16x2_t __attribute__((ext_vector_type(2)));
__device__ __forceinline__ unsigned cvtpk_s(float lo, float hi) { f32x2_t v = {lo, hi}; bf16x2_t b = __builtin_convertvector(v, bf16x2_t); return __builtin_bit_cast(unsigned, b); }
#define WAIT_BAR(N) asm volatile("s_waitcnt vmcnt(" #N ") lgkmcnt(0)\n\ts_barrier" ::: "memory")

__device__ __forceinline__ void qkt(f32x16& p0, f32x16& p1, const char* Kslot, const bf16x8* qr, const f32x16& negm, int r32, int hi) {
  const char* kb = Kslot + hi * 1024 + r32 * 16;
  #pragma unroll
  for (int d0 = 0; d0 < 4; ++d0) {
    const bf16x8 b0 = *reinterpret_cast<const bf16x8*>(kb + d0 * 2048);
    const bf16x8 b1 = *reinterpret_cast<const bf16x8*>(kb + d0 * 2048 + 512);
    if (d0 == 0) { p0 = __builtin_amdgcn_mfma_f32_32x32x16_bf16(b0, qr[0], negm, 0, 0, 0); p1 = __builtin_amdgcn_mfma_f32_32x32x16_bf16(b1, qr[0], negm, 0, 0, 0); }
    else { p0 = __builtin_amdgcn_mfma_f32_32x32x16_bf16(b0, qr[d0], p0, 0, 0, 0); p1 = __builtin_amdgcn_mfma_f32_32x32x16_bf16(b1, qr[d0], p1, 0, 0, 0); } }
}
typedef short v4i16_t __attribute__((ext_vector_type(4)));
__device__ __forceinline__ void kload8(bf16x8* kf, lds_cptr kp) {
  kf[0] = *(const LAS bf16x8*)(kp);        kf[1] = *(const LAS bf16x8*)(kp + 512);
  kf[2] = *(const LAS bf16x8*)(kp + 2048); kf[3] = *(const LAS bf16x8*)(kp + 2560);
  kf[4] = *(const LAS bf16x8*)(kp + 4096); kf[5] = *(const LAS bf16x8*)(kp + 4608);
  kf[6] = *(const LAS bf16x8*)(kp + 6144); kf[7] = *(const LAS bf16x8*)(kp + 6656);
}
__device__ __forceinline__ void kload2(bf16x8* kf, lds_cptr kp, int j) { kf[2 * j] = *(const LAS bf16x8*)(kp + j * 2048); kf[2 * j + 1] = *(const LAS bf16x8*)(kp + j * 2048 + 512); }
__device__ __forceinline__ s16x4 vtr(lds_cptr p) { return __builtin_bit_cast(s16x4, __builtin_amdgcn_ds_read_tr16_b64_v4i16((LAS v4i16_t*)p)); }
__device__ __forceinline__ float rowmax(const f32x16& p0, const f32x16& p1) {
  float a = max3f(p0[0], p0[1], p1[0]), b = max3f(p0[2], p0[3], p1[1]); a = max3f(a, p1[2], p1[3]);
  #pragma unroll
  for (int r = 4; r < 16; r += 4) { a = max3f(a, p0[r], p0[r + 1]); b = max3f(b, p0[r + 2], p0[r + 3]); a = max3f(a, p1[r], p1[r + 1]); b = max3f(b, p1[r + 2], p1[r + 3]); }
  const float m = max2f(a, b);
  auto rr = __builtin_amdgcn_permlane32_swap(__float_as_uint(m), __float_as_uint(m), false, false);
  return max2f(__uint_as_float(rr[0]), __uint_as_float(rr[1]));
}
__device__ __forceinline__ void pv(f32x16* o, int vb, bf16x8 pa0, bf16x8 pa1, bf16x8 pa2, bf16x8 pa3) {
  #pragma unroll
  for (int d0 = 0; d0 < 2; ++d0) { s16x4 lo[4], hi[4];
    #pragma unroll
    for (int ks = 0; ks < 4; ++ks) {
      asm volatile("ds_read_b64_tr_b16 %0,%1 offset:%c2" : "=&v"(lo[ks]) : "v"(vb), "i"(d0 * 4096 + ks * 1024) : "memory");
      asm volatile("ds_read_b64_tr_b16 %0,%1 offset:%c2" : "=&v"(hi[ks]) : "v"(vb), "i"(d0 * 4096 + ks * 1024 + 512) : "memory"); }
    asm volatile("s_waitcnt lgkmcnt(0)" ::: "memory"); SBAR();
    #define PK(k) (bf16x8){lo[k][0], lo[k][1], lo[k][2], lo[k][3], hi[k][0], hi[k][1], hi[k][2], hi[k][3]}
    o[d0] = __builtin_amdgcn_mfma_f32_32x32x16_bf16(pa0, PK(0), o[d0], 0, 0, 0);
    o[d0] = __builtin_amdgcn_mfma_f32_32x32x16_bf16(pa1, PK(1), o[d0], 0, 0, 0);
    o[d0] = __builtin_amdgcn_mfma_f32_32x32x16_bf16(pa2, PK(2), o[d0], 0, 0, 0);
    o[d0] = __builtin_amdgcn_mfma_f32_32x32x16_bf16(pa3, PK(3), o[d0], 0, 0, 0);
    #undef PK
  }
}

__device__ __forceinline__ float opq(float x) { asm("" : "+v"(x)); return x; }
template <int MODE> __device__ __forceinline__ void score_hook(f32x16& c0, f32x16& c1, int t, const AttnArgs& a, int qrel, int hi, int wid, int r32, float mh) {
  if constexpr (MODE == MA) {
    const int wlo = a.q0 + wid * QBLK, sd = (64 * t + 63 < wlo) ? 1 : ((64 * t > wlo + 31) ? -1 : 0);
    if (sd != 0) { const float sv = (float)sd * a.s2;
      #pragma unroll
      for (int r = 0; r < 16; ++r) { const float kf = (float)((r & 3) + 8 * (r >> 2)); c0[r] = opq(fmaf(kf, sv, c0[r])); c1[r] = opq(fmaf(kf + 32.f, sv, c1[r])); if ((r & 3) == 3) __builtin_amdgcn_sched_barrier(0); }
    } else {
      const float dq = (float)(a.q0 + qrel - 64 * t - 4 * hi), ns = -a.s2;
      #pragma unroll
      for (int r = 0; r < 16; ++r) { const float kf = (float)((r & 3) + 8 * (r >> 2)); c0[r] = opq(fmaf(ns, fabsf(opq(dq - kf)), c0[r])); c1[r] = opq(fmaf(ns, fabsf(opq(dq - (kf + 32.f))), c1[r])); if ((r & 1) == 1) __builtin_amdgcn_sched_barrier(0); }
    }
  }
  if constexpr (MODE == MB) {
    const bool tv = (t >= a.tlo) && (t <= a.thi);
    const float dq = (float)(qrel + 64 - 64 * t - 4 * hi), ns = -a.s2;
    #pragma unroll
    for (int r = 0; r < 16; ++r) { const float kf = (float)((r & 3) + 8 * (r >> 2)); const float d0 = fabsf(opq(dq - kf)), d1 = fabsf(opq(dq - (kf + 32.f)));
      const float v0_ = opq(fmaf(ns, d0, opq(c0[r] - mh))), v1_ = opq(fmaf(ns, d1, opq(c1[r] - mh)));
      c0[r] = (tv && d0 <= 64.f) ? v0_ : -INFINITY; c1[r] = (tv && d1 <= 64.f) ? v1_ : -INFINITY;
      if ((r & 3) == 3) __builtin_amdgcn_sched_barrier(0); }
  }
  if constexpr (MODE == MC) {
    const int qrow = a.q0 + (wid >> 1), rs = min(max(qrow - 4, 0), 120), krow = a.kb + t;
    if (krow < rs || krow >= rs + 8) {
      #pragma unroll
      for (int r = 0; r < 16; ++r) { c0[r] = -INFINITY; c1[r] = -INFINITY; }
    } else {
      const int qc = (wid & 1) * 32 + r32, cs = min(max(qc - 8, 0), 48);
      const lds_fptr tp = a.tab + (krow - qrow + 7) * 31 + (15 - qc + 4 * hi);
      const int kd = 4 * hi - cs;
      #pragma unroll
      for (int r = 0; r < 16; ++r) { const int kc = (r & 3) + 8 * (r >> 2);
        const float b0 = tp[kc], b1 = tp[kc + 32];
        const float v0_ = opq(c0[r] + opq(b0 - mh)), v1_ = opq(c1[r] + opq(b1 - mh));
        c0[r] = ((unsigned)(kd + kc) < 16u) ? v0_ : -INFINITY; c1[r] = ((unsigned)(kd + kc + 32) < 16u) ? v1_ : -INFINITY;
        if ((r & 3) == 3) __builtin_amdgcn_sched_barrier(0); }
    }
  }
}

template <int MODE, int THRL> __device__ __forceinline__ void attn_unit(const AttnArgs& A_, char* shm) {
  int tid_ = threadIdx.x; asm volatile("" : "+v"(tid_));
  const int tid = tid_, lane = tid & 63, r32 = lane & 31, hi = lane >> 5; const int wid = __builtin_amdgcn_readfirstlane(tid >> 6);
  const bf16* Qw = A_.Q + (wid * QBLK) * A_.qs;
  const unsigned lds0 = (unsigned)(uintptr_t)shm;
  float* wsf = (float*)(shm + LDS_WS) + wid * 64;
  const int ks = A_.ks;
  const bf16* ksrc = A_.K + (lane * ks + wid * 8);
  const bf16* vsrc = A_.V + ((16 * (wid & 3) + (lane >> 2)) * ks + (wid >> 2) * 32 + (lane & 3) * 8);
  const unsigned kdst = lds0 + LDS_K + wid * 1024, vdst = lds0 + LDS_V + wid * 1024;
  #define TT(t) ((MODE == MB) ? min(max((int)(t), A_.tlo), A_.thi) : (int)(t))
  #define DMA_K(t, slot) glds16(ksrc + TT(t) * KVBLK * ks, (unsigned)__builtin_amdgcn_readfirstlane(kdst + (slot)))
  #define DMA_V(t, slot) glds16(vsrc + TT(t) * KVBLK * ks, (unsigned)__builtin_amdgcn_readfirstlane(vdst + (slot)))
  const int vb0 = (int)(lds0 + LDS_V) + ((lane >> 4) & 1) * 32 + (lane & 3) * 8 + (4 * hi + ((lane & 15) >> 2)) * 64;
  const char* Kbase = shm + LDS_K; bf16x8 kf[8];
  const lds_cptr shm3 = (lds_cptr)shm; const lds_cptr kp0 = shm3 + LDS_K + hi * 1024 + r32 * 16; const lds_cptr vp0 = shm3 + LDS_V + ((lane >> 4) & 1) * 32 + (lane & 3) * 8 + (4 * hi + ((lane & 15) >> 2)) * 64;
  const int NT = A_.NT;
  DMA_K(0, 0); DMA_V(0, 0); DMA_K(1, SLOTB);
  bf16x8 qr[4];
  #pragma unroll
  for (int d0 = 0; d0 < 4; ++d0) qr[d0] = *reinterpret_cast<const bf16x8*>(&Qw[r32 * A_.qs + d0 * 16 + hi * 8]);
  if constexpr (MODE == MD) {
    float x[4][8]; float ssq = 0.f;
    #pragma unroll
    for (int d0 = 0; d0 < 4; ++d0)
      #pragma unroll
      for (int j = 0; j < 8; ++j) { x[d0][j] = __uint_as_float((unsigned)(unsigned short)qr[d0][j] << 16); ssq += x[d0][j] * x[d0][j]; }
    { auto rr = __builtin_amdgcn_permlane32_swap(__float_as_uint(ssq), __float_as_uint(ssq), false, false); ssq = __uint_as_float(rr[0]) + __uint_as_float(rr[1]); }
    const float rn = rsqrtf(ssq * (1.f / 64.f) + EPS) * C2;
    const int spos = A_.q0 + wid * QBLK + r32; const float prow = (float)(spos >> 6), pcol = (float)(spos & 63);
    #pragma unroll
    for (int j = 0; j < 8; ++j) { const float inv = exp2f(-(float)(8 * hi + j) * 0.8304820237218406f);
      float sr, cr, sc_, cc_; sincos_red(prow * inv, sr, cr); sincos_red(pcol * inv, sc_, cc_);
      const float g0 = A_.gq[8 * hi + j], g1 = A_.gq[16 + 8 * hi + j], g2 = A_.gq[32 + 8 * hi + j], g3 = A_.gq[48 + 8 * hi + j];
      const float y0 = x[0][j] * rn * g0, y1 = x[1][j] * rn * g1, y2 = x[2][j] * rn * g2, y3 = x[3][j] * rn * g3;
      x[0][j] = y0 * cr - y1 * sr; x[1][j] = y1 * cr + y0 * sr; x[2][j] = y2 * cc_ - y3 * sc_; x[3][j] = y3 * cc_ + y2 * sc_; }
    #pragma unroll
    for (int d0 = 0; d0 < 4; ++d0) { u32x4 w; w.x = pk2(x[d0][0], x[d0][1]); w.y = pk2(x[d0][2], x[d0][3]); w.z = pk2(x[d0][4], x[d0][5]); w.w = pk2(x[d0][6], x[d0][7]); qr[d0] = __builtin_bit_cast(bf16x8, w); }
  }
  float mhat = 0.f, l_reg = 0.f; f32x16 o[2]; o[0] = f32x16{}; o[1] = f32x16{}; f32x16 negm = f32x16{}; asm volatile("" : "+v"(negm));
  const int qrel = wid * QBLK + r32;
  constexpr bool NEGM = (MODE == MA || MODE == MD);
  #define CIN (NEGM ? negm : f32x16{})
  #define NEGM_SET(tn) do { float nb_ = -mhat; \
      if (MODE == MA) { const int wlo_ = A_.q0 + wid * QBLK, sd_ = (64 * (tn) + 63 < wlo_) ? 1 : ((64 * (tn) > wlo_ + 31) ? -1 : 0); \
        if (sd_ != 0) nb_ = fmaf(-(float)sd_ * A_.s2, (float)(A_.q0 + qrel - 64 * (tn) - 4 * hi), nb_); } \
      _Pragma("unroll") for (int r = 0; r < 16; ++r) negm[r] = nb_; asm volatile("" : "+v"(negm)); } while (0)
  #define CMASK(P0, P1, t) score_hook<MODE>(P0, P1, (t), A_, qrel, hi, wid, r32, mhat)
  bool resc = false;
  #define START(P0, P1) do { const float rm = rowmax(P0, P1); resc = false; \
    { const float dl = (MODE == MB || MODE == MC) ? fmaxf(rm, -2048.f) : rm; mhat = fadd_s(mhat, dl); \
      _Pragma("unroll") for (int r = 0; r < 16; ++r) { P0[r] = fsub_s(P0[r], dl); P1[r] = fsub_s(P1[r], dl); } \
      if (NEGM) { NEGM_SET(1); } } \
    _Pragma("unroll") for (int r = 0; r < 16; ++r) P0[r] = __builtin_amdgcn_exp2f(P0[r]); } while (0)
  #define RESC() do { if (resc) { asm volatile("s_waitcnt lgkmcnt(0)" ::: "memory"); \
      _Pragma("unroll") for (int d_ = 0; d_ < 2; ++d_) _Pragma("unroll") for (int r = 0; r < 16; ++r) o[d_][r] *= wsf[crow(r, hi)]; } } while (0)
  f32x16 pA0, pA1, pB0, pB1;
  int sl_prev = 0, sl_cur = 0, sl_next = SLOTB;
  #define ROT() do { sl_prev = sl_cur; sl_cur = sl_next; sl_next = (sl_next == (NSLOT - 1) * SLOTB) ? 0 : sl_next + SLOTB; } while (0)
  DMA_K(2, 2 * SLOTB);
  if (MODE == MA) { NEGM_SET(0); }
  WAIT_BAR(3);
  qkt(pA0, pA1, Kbase, qr, negm, r32, hi); asm volatile("s_nop 15\n\ts_nop 7" : "+v"(pA0), "+v"(pA1)); CMASK(pA0, pA1, 0);
  START(pA0, pA1);
  _Pragma("unroll") for (int r = 0; r < 16; ++r) pA1[r] = __builtin_amdgcn_exp2f(pA1[r]);
  WAIT_BAR(0);
  DMA_K(3, 0); DMA_V(1, SLOTB);
  ROT();
  kload8(kf, kp0 + sl_cur);
  WAIT_BAR(2);
  s16x4 vlo[8], vhi[8]; u32x4 pw0, pw1, pw2, pw3;
  #define PKW(P, B) cvtpk_s(P[B], P[B + 1])
  #define PAF(k) __builtin_bit_cast(bf16x8, pw##k)
  #define VFR(i) (bf16x8){vlo[i][0], vlo[i][1], vlo[i][2], vlo[i][3], vhi[i][0], vhi[i][1], vhi[i][2], vhi[i][3]}
  #define PIN(x) asm volatile("" : "+v"(x))
  #define MX3(a, b, c) __builtin_fmaxf(__builtin_fmaxf((a), (b)), (c))
  #define GAPA(MF, A0, A1, A2, A3, W0, W1, PW) do { MF; sacc += A0; sacc += A1; sacc += A2; sacc += A3; PIN(sacc); W0; W1; PIN(PW); SBAR(); } while (0)
  #define EX(v) __builtin_amdgcn_exp2f(v)
  #define GAPB(MF, X, B) do { MF; X[B] = EX(X[B]); X[B + 1] = EX(X[B + 1]); X[B + 2] = EX(X[B + 2]); X[B + 3] = EX(X[B + 3]); PIN(X); SBAR(); } while (0)
  #define VRD(i) do { vlo[i] = vtr(vp_ + (((i) >> 2) * 4096 + ((i) & 3) * 1024)); vhi[i] = vtr(vp_ + (((i) >> 2) * 4096 + ((i) & 3) * 1024 + 512)); } while (0)
  #define KRD(G, j) do { if (G) { kload2(kf, kp0 + sl_next, j); SBAR(); } } while (0)
  #define STEP(C0, C1, P0, P1, t, GK, GV, GL) do { SBAR(); \
    const lds_cptr vp_ = vp0 + sl_prev; \
    VRD(0); SBAR(); float sacc = (P0[0] + P0[1]); \
    GAPA(C0 = __builtin_amdgcn_mfma_f32_32x32x16_bf16(kf[0], qr[0], CIN, 0, 0, 0), P0[2], P0[3], P0[4], P0[5],     pw0[0] = PKW(P0, 0), pw0[1] = PKW(P0, 2), pw0); \
    VRD(4); SBAR(); GAPA(C1 = __builtin_amdgcn_mfma_f32_32x32x16_bf16(kf[1], qr[0], CIN, 0, 0, 0), P0[6], P0[7], P0[8], P0[9],     pw0[2] = PKW(P0, 4), pw0[3] = PKW(P0, 6), pw0); \
    VRD(1); SBAR(); GAPA(C0 = __builtin_amdgcn_mfma_f32_32x32x16_bf16(kf[2], qr[1], C0, 0, 0, 0),   P0[10], P0[11], P0[12], P0[13], pw1[0] = PKW(P0, 8), pw1[1] = PKW(P0, 10), pw1); \
    VRD(5); SBAR(); GAPA(C1 = __builtin_amdgcn_mfma_f32_32x32x16_bf16(kf[3], qr[1], C1, 0, 0, 0),   P0[14], P0[15], P1[0], P1[1],   pw1[2] = PKW(P0, 12), pw1[3] = PKW(P0, 14), pw1); \
    VRD(2); SBAR(); GAPA(C0 = __builtin_amdgcn_mfma_f32_32x32x16_bf16(kf[4], qr[2], C0, 0, 0, 0),   P1[2], P1[3], P1[4], P1[5],     pw2[0] = PKW(P1, 0), pw2[1] = PKW(P1, 2), pw2); \
    VRD(6); SBAR(); GAPA(C1 = __builtin_amdgcn_mfma_f32_32x32x16_bf16(kf[5], qr[2], C1, 0, 0, 0),   P1[6], P1[7], P1[8], P1[9],     pw2[2] = PKW(P1, 4), pw2[3] = PKW(P1, 6), pw2); \
    VRD(3); SBAR(); GAPA(C0 = __builtin_amdgcn_mfma_f32_32x32x16_bf16(kf[6], qr[3], C0, 0, 0, 0),   P1[10], P1[11], P1[12], P1[13], pw3[0] = PKW(P1, 8), pw3[1] = PKW(P1, 10), pw3); \
    VRD(7); SBAR(); GAPA(C1 = __builtin_amdgcn_mfma_f32_32x32x16_bf16(kf[7], qr[3], C1, 0, 0, 0),   P1[14], P1[15], 0.f, 0.f,       pw3[2] = PKW(P1, 12), pw3[3] = PKW(P1, 14), pw3); \
    l_reg += sacc; \
    if (GK) { DMA_K((t) + 3, sl_cur); } if (GV) { DMA_V((t) + 1, sl_next); } \
    CMASK(C0, C1, t); \
    { float a = MX3(C0[0], C0[1], C1[0]), b = MX3(C0[2], C0[3], C1[1]); a = MX3(a, C1[2], C1[3]); \
      _Pragma("unroll") for (int r = 4; r < 16; r += 4) { a = MX3(a, C0[r], C0[r + 1]); b = MX3(b, C0[r + 2], C0[r + 3]); a = MX3(a, C1[r], C1[r + 1]); b = MX3(b, C1[r + 2], C1[r + 3]); } \
      float rm = __builtin_fmaxf(a, b); { auto rr = __builtin_amdgcn_permlane32_swap(__float_as_uint(rm), __float_as_uint(rm), false, false); rm = __builtin_fmaxf(__uint_as_float(rr[0]), __uint_as_float(rr[1])); } \
      resc = false; \
      if (__builtin_expect(__any(rm > (float)THRL), 0)) { const float dl = __builtin_fmaxf(rm, 0.f); mhat += dl; \
        _Pragma("unroll") for (int r = 0; r < 16; ++r) { C0[r] -= dl; C1[r] -= dl; } \
        if (MODE == MD) { NEGM_SET(0); } \
        const float f = __builtin_amdgcn_exp2f(-dl); l_reg *= f; if (hi == 0) wsf[r32] = f; resc = true; } \
      if (MODE == MA) { NEGM_SET((t) + 1); } } \
    SBAR(); \
    GAPB(o[0] = __builtin_amdgcn_mfma_f32_32x32x16_bf16(PAF(0), VFR(0), o[0], 0, 0, 0), C0, 0); \
    GAPB(o[1] = __builtin_amdgcn_mfma_f32_32x32x16_bf16(PAF(0), VFR(4), o[1], 0, 0, 0), C0, 4); \
    KRD(GL, 0); GAPB(o[0] = __builtin_amdgcn_mfma_f32_32x32x16_bf16(PAF(1), VFR(1), o[0], 0, 0, 0), C0, 8); \
    KRD(GL, 1); GAPB(o[1] = __builtin_amdgcn_mfma_f32_32x32x16_bf16(PAF(1), VFR(5), o[1], 0, 0, 0), C0, 12); \
    KRD(GL, 2); GAPB(o[0] = __builtin_amdgcn_mfma_f32_32x32x16_bf16(PAF(2), VFR(2), o[0], 0, 0, 0), C1, 0); \
    KRD(GL, 3); GAPB(o[1] = __builtin_amdgcn_mfma_f32_32x32x16_bf16(PAF(2), VFR(6), o[1], 0, 0, 0), C1, 4); \
    GAPB(o[0] = __builtin_amdgcn_mfma_f32_32x32x16_bf16(PAF(3), VFR(3), o[0], 0, 0, 0), C1, 8); \
    GAPB(o[1] = __builtin_amdgcn_mfma_f32_32x32x16_bf16(PAF(3), VFR(7), o[1], 0, 0, 0), C1, 12); \
    } while (0)
  int t = 1;
  for (; t + 5 < NT; t += 2) {
    STEP(pB0, pB1, pA0, pA1, t, true, true, true);     WAIT_BAR(2); RESC(); ROT();
    STEP(pA0, pA1, pB0, pB1, t + 1, true, true, true); WAIT_BAR(2); RESC(); ROT();
  }
  #define ENDW(tt) do { if ((tt) + 3 < NT) { WAIT_BAR(2); } else if ((tt) + 2 < NT) { WAIT_BAR(1); } else { WAIT_BAR(0); } } while (0)
  for (; t + 1 < NT; t += 2) {
    STEP(pB0, pB1, pA0, pA1, t, (t + 3 < NT), (t + 1 < NT), (t + 1 < NT));         ENDW(t);     RESC(); ROT();
    STEP(pA0, pA1, pB0, pB1, t + 1, (t + 4 < NT), (t + 2 < NT), (t + 2 < NT));     ENDW(t + 1); RESC(); ROT();
  }
  STEP(pB0, pB1, pA0, pA1, NT - 1, false, false, false); RESC();
  { float sacc = pB0[0] + pB0[1]; _Pragma("unroll") for (int r = 2; r < 16; ++r) sacc += pB0[r]; _Pragma("unroll") for (int r = 0; r < 16; ++r) sacc += pB1[r]; l_reg += sacc;
    pw0 = (u32x4){PKW(pB0, 0), PKW(pB0, 2), PKW(pB0, 4), PKW(pB0, 6)}; pw1 = (u32x4){PKW(pB0, 8), PKW(pB0, 10), PKW(pB0, 12), PKW(pB0, 14)}; pw2 = (u32x4){PKW(pB1, 0), PKW(pB1, 2), PKW(pB1, 4), PKW(pB1, 6)}; pw3 = (u32x4){PKW(pB1, 8), PKW(pB1, 10), PKW(pB1, 12), PKW(pB1, 14)};
    SBAR(); pv(o, vb0 + sl_cur, PAF(0), PAF(1), PAF(2), PAF(3)); }
  #undef PKW
  #undef PAF
  #undef VFR
  #undef PIN
  #undef MX3
  #undef GAPA
  #undef GAPB
  #undef EX
  #undef VRD
  #undef KRD
  #undef STEP
  #undef ENDW
  { auto rr = __builtin_amdgcn_permlane32_swap(__float_as_uint(l_reg), __float_as_uint(l_reg), false, false); l_reg = __uint_as_float(rr[0]) + __uint_as_float(rr[1]); }
  if (MODE == MB) { if (hi == 0) { float* sp = A_.stat + (wid * QBLK + r32) * A_.ss; sp[0] = mhat; sp[1] = l_reg; } }
  if (hi == 0) wsf[32 + r32] = l_reg; asm volatile("s_waitcnt lgkmcnt(0)" ::: "memory");
  float rli[16];
  #pragma unroll
  for (int r = 0; r < 16; ++r) rli[r] = __builtin_amdgcn_rcpf(wsf[32 + crow(r, hi)]);
  bf16* Ow = A_.O + (wid * QBLK) * A_.os;
  { bf16* stg = (bf16*)(shm + LDS_OST) + wid * 2048;
    #pragma unroll
    for (int r = 0; r < 16; ++r) { const int orow = crow(r, hi);
      #pragma unroll
      for (int d0 = 0; d0 < 2; ++d0) stg[orow * 64 + d0 * 32 + r32] = __float2bfloat16(o[d0][r] * rli[r]); }
    asm volatile("s_waitcnt lgkmcnt(0)" ::: "memory");
    #pragma unroll
    for (int i = 0; i < 4; ++i) { const int row = i * 8 + (lane >> 3), ch = lane & 7; const u32x4 v = *(const u32x4*)(stg + row * 64 + ch * 8); *(u32x4*)(Ow + row * A_.os + ch * 8) = v; } }
  asm volatile("s_waitcnt lgkmcnt(0)\n\ts_barrier" ::: "memory");
  #undef DMA_K
  #undef DMA_V
  #undef TT
  #undef CMASK
  #undef CIN
  #undef NEGM_SET
  #undef START
  #undef RESC
  #undef ROT
}

constexpr int L8_K = 0, L8_V = 3 * 8192, L8_WS = L8_V + 3 * 16384, L8_QO = L8_WS + 2048, L8_END = L8_QO + 8 * 4096;
template <int THRL> __device__ __forceinline__ void attn_unit128(const AttnArgs& A_, char* shm) {
  int tid_ = threadIdx.x; asm volatile("" : "+v"(tid_));
  const int tid = tid_, lane = tid & 63, r32 = lane & 31, hi = lane >> 5; const int wid = __builtin_amdgcn_readfirstlane(tid >> 6);
  const bf16* Qw = A_.Q + (wid * QBLK) * A_.qs;
  const unsigned lds0 = (unsigned)(uintptr_t)shm;
  float* wsf = (float*)(shm + L8_WS) + wid * 64;
  const int ks = A_.ks;
  const bf16* ksrc = A_.K + (lane * ks + wid * 8);
  const bf16* vsrc = A_.V + ((16 * (wid & 3) + (lane >> 2)) * ks + (wid >> 2) * 32 + (lane & 3) * 8);
  const unsigned kdst = lds0 + L8_K + wid * 1024, vdst = lds0 + L8_V + wid * 1024;
  #define DMA_K(t, slot) glds16(ksrc + (int)(t) * KVBLK * ks, (unsigned)__builtin_amdgcn_readfirstlane(kdst + (slot)))
  #define DMA_V(t, slot) do { glds16(vsrc + (int)(t) * KVBLK * ks, (unsigned)__builtin_amdgcn_readfirstlane(vdst + 2 * (slot))); \
                              glds16(vsrc + (int)(t) * KVBLK * ks + 64, (unsigned)__builtin_amdgcn_readfirstlane(vdst + 2 * (slot) + 8192)); } while (0)
  const int vb0 = (int)(lds0 + L8_V) + ((lane >> 4) & 1) * 32 + (lane & 3) * 8 + (4 * hi + ((lane & 15) >> 2)) * 64;
  const char* Kbase = shm + L8_K; bf16x8 kf[8];
  const lds_cptr shm3 = (lds_cptr)shm; const lds_cptr kp0 = shm3 + L8_K + hi * 1024 + r32 * 16; const lds_cptr vp0 = shm3 + L8_V + ((lane >> 4) & 1) * 32 + (lane & 3) * 8 + (4 * hi + ((lane & 15) >> 2)) * 64;
  const lds_cptr qst = shm3 + L8_QO + wid * 4096 + lane * 16;
  const int NT = A_.NT;
  DMA_K(0, 0); DMA_V(0, 0); DMA_K(1, SLOTB);
  { bf16x8 qr[4];
    #pragma unroll
    for (int d0 = 0; d0 < 4; ++d0) qr[d0] = *reinterpret_cast<const bf16x8*>(&Qw[r32 * A_.qs + d0 * 16 + hi * 8]);
    #pragma unroll
    for (int d0 = 0; d0 < 4; ++d0) *(LAS bf16x8*)(shm3 + L8_QO + wid * 4096 + lane * 16 + d0 * 1024) = qr[d0]; }
  #define QLD(d0) (*(const LAS bf16x8*)(qst + (d0) * 1024))
  float mhat = 0.f, l_reg = 0.f; f32x16 o[4]; o[0] = f32x16{}; o[1] = f32x16{}; o[2] = f32x16{}; o[3] = f32x16{};
  const int qrel = wid * QBLK + r32;
  #define NB(tn) ({ float nb_ = -mhat; const int wlo_ = A_.q0 + wid * QBLK, sd_ = (64 * (tn) + 63 < wlo_) ? 1 : ((64 * (tn) > wlo_ + 31) ? -1 : 0); \
      if (sd_ != 0) nb_ = fmaf(-(float)sd_ * A_.s2, (float)(A_.q0 + qrel - 64 * (tn) - 4 * hi), nb_); nb_; })
  #define CMASK(P0, P1, t) score_hook<MA>(P0, P1, (t), A_, qrel, hi, wid, r32, mhat)
  bool resc = false;
  #define RESC() do { if (resc) { asm volatile("s_waitcnt lgkmcnt(0)" ::: "memory"); \
      _Pragma("unroll") for (int d_ = 0; d_ < 4; ++d_) _Pragma("unroll") for (int r = 0; r < 16; ++r) o[d_][r] *= wsf[crow(r, hi)]; } } while (0)
  f32x16 pA0, pA1, pB0, pB1;
  int sl_prev = 0, sl_cur = 0, sl_next = SLOTB;
  #define ROT() do { sl_prev = sl_cur; sl_cur = sl_next; sl_next = (sl_next == (NSLOT - 1) * SLOTB) ? 0 : sl_next + SLOTB; } while (0)
  DMA_K(2, 2 * SLOTB);
  WAIT_BAR(4);
  { f32x16 cin; const float nb0 = NB(0);
    #pragma unroll
    for (int r = 0; r < 16; ++r) cin[r] = nb0;
    bf16x8 qr[4];
    #pragma unroll
    for (int d0 = 0; d0 < 4; ++d0) qr[d0] = QLD(d0);
    qkt(pA0, pA1, Kbase, qr, cin, r32, hi); }
  asm volatile("s_nop 15\n\ts_nop 7" : "+v"(pA0), "+v"(pA1)); CMASK(pA0, pA1, 0);
  { const float rm = rowmax(pA0, pA1); mhat = fadd_s(mhat, rm);
    #pragma unroll
    for (int r = 0; r < 16; ++r) { pA0[r] = fsub_s(pA0[r], rm); pA1[r] = fsub_s(pA1[r], rm); }
    #pragma unroll
    for (int r = 0; r < 16; ++r) pA0[r] = __builtin_amdgcn_exp2f(pA0[r]);
    #pragma unroll
    for (int r = 0; r < 16; ++r) pA1[r] = __builtin_amdgcn_exp2f(pA1[r]); }
  WAIT_BAR(0);
  DMA_K(3, 0); DMA_V(1, SLOTB);
  ROT();
  kload8(kf, kp0 + sl_cur);
  WAIT_BAR(3);
  u32x4 pw0, pw1, pw2, pw3;
  #define PKW(P, B) cvtpk_s(P[B], P[B + 1])
  #define PAF(k) __builtin_bit_cast(bf16x8, pw##k)
  #define PIN(x) asm volatile("" : "+v"(x))
  #define MX3(a, b, c) __builtin_fmaxf(__builtin_fmaxf((a), (b)), (c))
  #define GAPA(MF, A0, A1, A2, A3, W0, W1, PW) do { MF; sacc += A0; sacc += A1; sacc += A2; sacc += A3; PIN(sacc); W0; W1; PIN(PW); SBAR(); } while (0)
  #define EX(v) __builtin_amdgcn_exp2f(v)
  #define GAPB(MF, X, B) do { MF; X[B] = EX(X[B]); X[B + 1] = EX(X[B + 1]); PIN(X); SBAR(); } while (0)
  #define KRD(G, j) do { if (G) { kload2(kf, kp0 + sl_next, j); SBAR(); } } while (0)
  #define FOFF(j) (((((j) & 1) + 2 * ((j) >> 3)) * 4096) + ((((j) >> 1) & 3) * 1024))
  #define FRD(j) do { fl[j] = vtr(vp_ + FOFF(j)); fh[j] = vtr(vp_ + FOFF(j) + 512); SBAR(); } while (0)
  #define FFR(j) (bf16x8){fl[j][0], fl[j][1], fl[j][2], fl[j][3], fh[j][0], fh[j][1], fh[j][2], fh[j][3]}
  #define STEP(C0, C1, P0, P1, t, GK, GV, GL) do { SBAR(); \
    const lds_cptr vp_ = vp0 + 2 * sl_prev; s16x4 fl[16], fh[16]; \
    { const float nb_t = NB(t); _Pragma("unroll") for (int r = 0; r < 16; ++r) { C0[r] = nb_t; C1[r] = nb_t; } } \
    bf16x8 q0_ = QLD(0), q1_ = QLD(1); SBAR(); float sacc = (P0[0] + P0[1]); \
    GAPA(C0 = __builtin_amdgcn_mfma_f32_32x32x16_bf16(kf[0], q0_, C0, 0, 0, 0), P0[2], P0[3], P0[4], P0[5],     pw0[0] = PKW(P0, 0), pw0[1] = PKW(P0, 2), pw0); \
    GAPA(C1 = __builtin_amdgcn_mfma_f32_32x32x16_bf16(kf[1], q0_, C1, 0, 0, 0), P0[6], P0[7], P0[8], P0[9],     pw0[2] = PKW(P0, 4), pw0[3] = PKW(P0, 6), pw0); \
    q0_ = QLD(2); SBAR(); \
    GAPA(C0 = __builtin_amdgcn_mfma_f32_32x32x16_bf16(kf[2], q1_, C0, 0, 0, 0),   P0[10], P0[11], P0[12], P0[13], pw1[0] = PKW(P0, 8), pw1[1] = PKW(P0, 10), pw1); \
    GAPA(C1 = __builtin_amdgcn_mfma_f32_32x32x16_bf16(kf[3], q1_, C1, 0, 0, 0),   P0[14], P0[15], P1[0], P1[1],   pw1[2] = PKW(P0, 12), pw1[3] = PKW(P0, 14), pw1); \
    q1_ = QLD(3); SBAR(); \
    GAPA(C0 = __builtin_amdgcn_mfma_f32_32x32x16_bf16(kf[4], q0_, C0, 0, 0, 0),   P1[2], P1[3], P1[4], P1[5],     pw2[0] = PKW(P1, 0), pw2[1] = PKW(P1, 2), pw2); \
    GAPA(C1 = __builtin_amdgcn_mfma_f32_32x32x16_bf16(kf[5], q0_, C1, 0, 0, 0),   P1[6], P1[7], P1[8], P1[9],     pw2[2] = PKW(P1, 4), pw2[3] = PKW(P1, 6), pw2); \
    GAPA(C0 = __builtin_amdgcn_mfma_f32_32x32x16_bf16(kf[6], q1_, C0, 0, 0, 0),   P1[10], P1[11], P1[12], P1[13], pw3[0] = PKW(P1, 8), pw3[1] = PKW(P1, 10), pw3); \
    GAPA(C1 = __builtin_amdgcn_mfma_f32_32x32x16_bf16(kf[7], q1_, C1, 0, 0, 0),   P1[14], P1[15], 0.f, 0.f,       pw3[2] = PKW(P1, 12), pw3[3] = PKW(P1, 14), pw3); \
    l_reg += sacc; \
    if (GK) { DMA_K((t) + 3, sl_cur); } if (GV) { DMA_V((t) + 1, sl_next); } \
    FRD(0); FRD(1); FRD(2); \
    CMASK(C0, C1, t); \
    { float a = MX3(C0[0], C0[1], C1[0]), b = MX3(C0[2], C0[3], C1[1]); a = MX3(a, C1[2], C1[3]); \
      _Pragma("unroll") for (int r = 4; r < 16; r += 4) { a = MX3(a, C0[r], C0[r + 1]); b = MX3(b, C0[r + 2], C0[r + 3]); a = MX3(a, C1[r], C1[r + 1]); b = MX3(b, C1[r + 2], C1[r + 3]); } \
      float rm = __builtin_fmaxf(a, b); { auto rr = __builtin_amdgcn_permlane32_swap(__float_as_uint(rm), __float_as_uint(rm), false, false); rm = __builtin_fmaxf(__uint_as_float(rr[0]), __uint_as_float(rr[1])); } \
      resc = false; \
      if (__builtin_expect(__any(rm > (float)THRL), 0)) { const float dl = __builtin_fmaxf(rm, 0.f); mhat += dl; \
        _Pragma("unroll") for (int r = 0; r < 16; ++r) { C0[r] -= dl; C1[r] -= dl; } \
        const float f = __builtin_amdgcn_exp2f(-dl); l_reg *= f; if (hi == 0) wsf[r32] = f; resc = true; } } \
    SBAR(); \
    GAPB(o[0] = __builtin_amdgcn_mfma_f32_32x32x16_bf16(PAF(0), FFR(0), o[0], 0, 0, 0), C0, 0);   FRD(3); \
    GAPB(o[1] = __builtin_amdgcn_mfma_f32_32x32x16_bf16(PAF(0), FFR(1), o[1], 0, 0, 0), C0, 2);   FRD(4); \
    GAPB(o[0] = __builtin_amdgcn_mfma_f32_32x32x16_bf16(PAF(1), FFR(2), o[0], 0, 0, 0), C0, 4);   FRD(5); \
    GAPB(o[1] = __builtin_amdgcn_mfma_f32_32x32x16_bf16(PAF(1), FFR(3), o[1], 0, 0, 0), C0, 6);   FRD(6); \
    GAPB(o[0] = __builtin_amdgcn_mfma_f32_32x32x16_bf16(PAF(2), FFR(4), o[0], 0, 0, 0), C0, 8);   FRD(7); \
    GAPB(o[1] = __builtin_amdgcn_mfma_f32_32x32x16_bf16(PAF(2), FFR(5), o[1], 0, 0, 0), C0, 10);  FRD(8); \
    GAPB(o[0] = __builtin_amdgcn_mfma_f32_32x32x16_bf16(PAF(3), FFR(6), o[0], 0, 0, 0), C0, 12);  FRD(9); \
    GAPB(o[1] = __builtin_amdgcn_mfma_f32_32x32x16_bf16(PAF(3), FFR(7), o[1], 0, 0, 0), C0, 14);  FRD(10); \
    KRD(GL, 0); GAPB(o[2] = __builtin_amdgcn_mfma_f32_32x32x16_bf16(PAF(0), FFR(8), o[2], 0, 0, 0), C1, 0);   FRD(11); \
    KRD(GL, 1); GAPB(o[3] = __builtin_amdgcn_mfma_f32_32x32x16_bf16(PAF(0), FFR(9), o[3], 0, 0, 0), C1, 2);   FRD(12); \
    KRD(GL, 2); GAPB(o[2] = __builtin_amdgcn_mfma_f32_32x32x16_bf16(PAF(1), FFR(10), o[2], 0, 0, 0), C1, 4);  FRD(13); \
    KRD(GL, 3); GAPB(o[3] = __builtin_amdgcn_mfma_f32_32x32x16_bf16(PAF(1), FFR(11), o[3], 0, 0, 0), C1, 6);  FRD(14); \
    GAPB(o[2] = __builtin_amdgcn_mfma_f32_32x32x16_bf16(PAF(2), FFR(12), o[2], 0, 0, 0), C1, 8);  FRD(15); \
    GAPB(o[3] = __builtin_amdgcn_mfma_f32_32x32x16_bf16(PAF(2), FFR(13), o[3], 0, 0, 0), C1, 10); \
    GAPB(o[2] = __builtin_amdgcn_mfma_f32_32x32x16_bf16(PAF(3), FFR(14), o[2], 0, 0, 0), C1, 12); \
    GAPB(o[3] = __builtin_amdgcn_mfma_f32_32x32x16_bf16(PAF(3), FFR(15), o[3], 0, 0, 0), C1, 14); \
    } while (0)
  int t = 1;
  for (; t + 5 < NT; t += 2) {
    STEP(pB0, pB1, pA0, pA1, t, true, true, true);     WAIT_BAR(3); RESC(); ROT();
    STEP(pA0, pA1, pB0, pB1, t + 1, true, true, true); WAIT_BAR(3); RESC(); ROT();
  }
  #define ENDW(tt) do { if ((tt) + 3 < NT) { WAIT_BAR(3); } else if ((tt) + 2 < NT) { WAIT_BAR(2); } else { WAIT_BAR(0); } } while (0)
  for (; t + 1 < NT; t += 2) {
    STEP(pB0, pB1, pA0, pA1, t, (t + 3 < NT), (t + 1 < NT), (t + 1 < NT));         ENDW(t);     RESC(); ROT();
    STEP(pA0, pA1, pB0, pB1, t + 1, (t + 4 < NT), (t + 2 < NT), (t + 2 < NT));     ENDW(t + 1); RESC(); ROT();
  }
  STEP(pB0, pB1, pA0, pA1, NT - 1, false, false, false); RESC();
  { float sacc = pB0[0] + pB0[1]; _Pragma("unroll") for (int r = 2; r < 16; ++r) sacc += pB0[r]; _Pragma("unroll") for (int r = 0; r < 16; ++r) sacc += pB1[r]; l_reg += sacc;
    pw0 = (u32x4){PKW(pB0, 0), PKW(pB0, 2), PKW(pB0, 4), PKW(pB0, 6)}; pw1 = (u32x4){PKW(pB0, 8), PKW(pB0, 10), PKW(pB0, 12), PKW(pB0, 14)}; pw2 = (u32x4){PKW(pB1, 0), PKW(pB1, 2), PKW(pB1, 4), PKW(pB1, 6)}; pw3 = (u32x4){PKW(pB1, 8), PKW(pB1, 10), PKW(pB1, 12), PKW(pB1, 14)};
    SBAR(); pv(o, vb0 + 2 * sl_cur, PAF(0), PAF(1), PAF(2), PAF(3)); pv(o + 2, vb0 + 2 * sl_cur + 8192, PAF(0), PAF(1), PAF(2), PAF(3)); }
  #undef PKW
  #undef PAF
  #undef PIN
  #undef MX3
  #undef GAPA
  #undef GAPB
  #undef EX
  #undef FOFF
  #undef FRD
  #undef FFR
  #undef KRD
  #undef STEP
  #undef ENDW
  { auto rr = __builtin_amdgcn_permlane32_swap(__float_as_uint(l_reg), __float_as_uint(l_reg), false, false); l_reg = __uint_as_float(rr[0]) + __uint_as_float(rr[1]); }
  if (hi == 0) wsf[32 + r32] = l_reg; asm volatile("s_waitcnt lgkmcnt(0)" ::: "memory");
  float rli[16];
  #pragma unroll
  for (int r = 0; r < 16; ++r) rli[r] = __builtin_amdgcn_rcpf(wsf[32 + crow(r, hi)]);
  bf16* Ow = A_.O + (wid * QBLK) * A_.os;
  { bf16* stg = (bf16*)(shm + L8_QO) + wid * 2048;
    #pragma unroll
    for (int hv = 0; hv < 2; ++hv) {
      #pragma unroll
      for (int r = 0; r < 16; ++r) { const int orow = crow(r, hi);
        #pragma unroll
        for (int d0 = 0; d0 < 2; ++d0) stg[orow * 64 + d0 * 32 + r32] = __float2bfloat16(o[2 * hv + d0][r] * rli[r]); }
      asm volatile("s_waitcnt lgkmcnt(0)" ::: "memory");
      #pragma unroll
      for (int i = 0; i < 4; ++i) { const int row = i * 8 + (lane >> 3), ch = lane & 7; const u32x4 v = *(const u32x4*)(stg + row * 64 + ch * 8); *(u32x4*)(Ow + row * A_.os + hv * 64 + ch * 8) = v; }
      asm volatile("s_waitcnt lgkmcnt(0)" ::: "memory"); } }
  asm volatile("s_waitcnt lgkmcnt(0)\n\ts_barrier" ::: "memory");
  #undef DMA_K
  #undef DMA_V
  #undef QLD
  #undef NB
  #undef CMASK
  #undef RESC
  #undef ROT
}
#undef SBAR
#undef WAIT_BAR
}

__device__ __forceinline__ void transpose_item(const float* W, int K, int N, bf16_t* WT, LAS float* scr, int item, int lane, const float* gk = nullptr) {
    const int nblk = N / 32, kb = item / nblk, nb = item % nblk, k0 = 64 * kb, n0 = 32 * nb;
#pragma unroll 8
    for (int i = 0; i < 32; ++i) { const int kk = 2 * i + (lane >> 5); const float gg = gk ? gk[k0 + kk] : 1.f; scr[kk * 33 + (lane & 31)] = W[(size_t)(k0 + kk) * N + n0 + (lane & 31)] * gg; }
    asm volatile("s_waitcnt lgkmcnt(0)" ::: "memory");
    const int c = lane & 7;
#pragma unroll
    for (int j = 0; j < 4; ++j) { const int n = (lane >> 3) + 8 * j; const LAS float* s = scr + (8 * c) * 33 + n;
        u32x4 o; o.x = pk2(s[0 * 33], s[1 * 33]); o.y = pk2(s[2 * 33], s[3 * 33]); o.z = pk2(s[4 * 33], s[5 * 33]); o.w = pk2(s[6 * 33], s[7 * 33]);
        *(u32x4*)(WT + (size_t)(n0 + n) * K + k0 + 8 * c) = o; }
    asm volatile("s_waitcnt lgkmcnt(0)" ::: "memory");
}
__device__ __forceinline__ void rms_row_bf16(const float* xrow, const float* g, bf16_t* orow, int lane) {
    const f32x4* xr = (const f32x4*)xrow + lane; const f32x4* gr = (const f32x4*)g + lane;
    f32x4 v[4]; float s = 0.f;
#pragma unroll
    for (int j = 0; j < 4; ++j) { v[j] = xr[64 * j]; s += (v[j].x * v[j].x + v[j].y * v[j].y) + (v[j].z * v[j].z + v[j].w * v[j].w); }
    const float rs = rsqrtf(wave_sum(s) * (1.f / DM) + EPS);
    u32x2* o8 = (u32x2*)orow + lane;
#pragma unroll
    for (int j = 0; j < 4; ++j) { const f32x4 gg = gr[64 * j]; u32x2 w; w.x = pk2(v[j].x * rs * gg.x, v[j].y * rs * gg.y); w.y = pk2(v[j].z * rs * gg.z, v[j].w * rs * gg.w); o8[64 * j] = w; }
}

#define XB_TMO      128
#define XB_XCNT(j)  (256  + 64 * (j))
#define XB_XSUB(j)  (1280 + 64 * (j))
#define XB_XGEN(j)  (2304 + 64 * (j))
#define XB_TOP      3328
#define XB_TOPGEN   3392
#define XCD_BAR_WORDS 3456
#define XB_SPIN_CAP (1u << 18)

__device__ __forceinline__ unsigned xb_ld(unsigned* p)              { return __hip_atomic_load(p, __ATOMIC_RELAXED, __HIP_MEMORY_SCOPE_AGENT); }
__device__ __forceinline__ unsigned xb_add(unsigned* p, unsigned v) { return __hip_atomic_fetch_add(p, v, __ATOMIC_RELAXED, __HIP_MEMORY_SCOPE_AGENT); }
__device__ __forceinline__ unsigned xb_xcc_id() { return (unsigned)__builtin_amdgcn_s_getreg((3 << 11) | 20) & 0xFu; }
#define XB_SPIN(cond, bar) do { unsigned _sp = 0; while (cond) { __builtin_amdgcn_s_sleep(1); \
    if ((++_sp & 255u) == 0u) { if (xb_ld(&(bar)[XB_TMO])) break; if (_sp > XB_SPIN_CAP) { atomicAdd(&(bar)[XB_TMO], 1u); break; } } } } while (0)

struct XcdBarrier {
    unsigned* bar; unsigned x;
    volatile LAS unsigned* st;
};

__device__ __forceinline__ XcdBarrier xcd_barrier_post(unsigned* bar, volatile LAS unsigned* st) {
    XcdBarrier b; b.bar = bar; b.x = xb_xcc_id(); b.st = st;
    if (threadIdx.x == 0) (void)xb_add(&bar[XB_XCNT(b.x)], 1u);
    return b;
}
__device__ __forceinline__ void xcd_barrier_complete(unsigned* bar, unsigned x, unsigned& nloc, unsigned& nx) {
    const unsigned G = gridDim.x * gridDim.y * gridDim.z;
    unsigned sum, cnt, mine, sp = 0u;
    for (;;) {
        sum = 0u; cnt = 0u; mine = 0u;
#pragma unroll
        for (unsigned j = 0; j < 16; ++j) { const unsigned c = xb_ld(&bar[XB_XCNT(j)]); sum += c; cnt += (c > 0u) ? 1u : 0u; mine = (j == x) ? c : mine; }
        if (sum == G) break;
        __builtin_amdgcn_s_sleep(1);
        if ((++sp & 255u) == 0u) { if (xb_ld(&bar[XB_TMO])) break; if (sp > XB_SPIN_CAP) { atomicAdd(&bar[XB_TMO], 1u); break; } }
    }
    nloc = mine > 0u ? mine : 1u; nx = cnt > 0u ? cnt : 1u;
}

__device__ __forceinline__ void xcd_barrier(const XcdBarrier& b) {
    asm volatile("s_waitcnt vmcnt(0)" ::: "memory");
    __syncthreads();
    if (threadIdx.x == 0) {
        unsigned* bar = b.bar;
        __builtin_amdgcn_s_waitcnt(0);
        unsigned nloc = b.st[0], nx = b.st[1];
        if (nloc == 0u) { xcd_barrier_complete(bar, b.x, nloc, nx); b.st[0] = nloc; b.st[1] = nx; }
        const unsigned old = xb_add(&bar[XB_XSUB(b.x)], 1u);
        const unsigned gen = old / nloc;
        if (old + 1u == (gen + 1u) * nloc) {
            __builtin_amdgcn_fence(__ATOMIC_RELEASE, "agent");
            asm volatile("s_waitcnt vmcnt(0)" ::: "memory");
            const unsigned og = xb_add(&bar[XB_TOP], 1u);
            const unsigned tg = og / nx;
            if (og + 1u == (tg + 1u) * nx) xb_add(&bar[XB_TOPGEN], 1u);
            else XB_SPIN(xb_ld(&bar[XB_TOPGEN]) == tg, bar);
            __builtin_amdgcn_fence(__ATOMIC_ACQUIRE, "agent");
            xb_add(&bar[XB_XGEN(b.x)], 1u);
            asm volatile("s_waitcnt vmcnt(0)" ::: "memory");
        } else {
            XB_SPIN(xb_ld(&bar[XB_XGEN(b.x)]) == gen, bar);
            __builtin_amdgcn_fence(__ATOMIC_ACQUIRE, "agent");
            asm volatile("s_waitcnt vmcnt(0)" ::: "memory");
        }
    }
    __syncthreads();
}


struct Args { const float* in[14]; float* out; unsigned char* ws; };

__global__ void __launch_bounds__(512) mk_fwd(Args args) {
    extern __shared__ __attribute__((aligned(16))) unsigned char lds[];
    cg::grid_group grid = cg::this_grid();
    const int tid0 = threadIdx.x, wave = __builtin_amdgcn_readfirstlane(tid0 >> 6);
#define FRESH_LANE() int tid = tid0; asm volatile("" : "+v"(tid)); const int lane = tid & 63
    const int G = gridDim.x, bx = blockIdx.x;
    const int vcu = (G % 8 == 0) ? (bx % 8) * (G / 8) + bx / 8 : bx;
    const int gw = vcu * 8 + wave, NGW = G * 8;
    LAS unsigned char* ldsl = (LAS unsigned char*)lds;
    if (tid0 < 8) ((LAS unsigned*)(ldsl + MISC_OFF))[tid0] = 0u;
    __syncthreads();
    const XcdBarrier xbar = xcd_barrier_post((unsigned*)(args.ws + WS_BAR), (volatile LAS unsigned*)(ldsl + MISC_OFF));
#define ws (args.ws)
#define x_in (args.in[0])
#define norm_mix (args.in[1])
#define w_in (args.in[2])
#define b_gate (args.in[3])
#define diff_lambda (args.in[4])
#define diff_subln (args.in[5])
#define na_rpb (args.in[6])
#define qk_norm (args.in[7])
#define w_branch (args.in[8])
#define w_out (args.in[9])
#define norm_ffn (args.in[10])
#define w_ff1 (args.in[11])
#define w_ff2 (args.in[12])
#define norm_final (args.in[13])
#define xout (args.out)
#define WinT ((bf16_t*)(ws + WS_WIN))
#define WbrT ((bf16_t*)(ws + WS_WBR))
#define WoutT ((bf16_t*)(ws + WS_WOUT))
#define W1T ((bf16_t*)(ws + WS_W1))
#define W2T ((bf16_t*)(ws + WS_W2))
#define STAT ((float*)(ws + WS_STAT))
#define H ((bf16_t*)(ws + WS_H))
#define ATMP ((bf16_t*)(ws + WS_ATMP))
#define BTMP ((bf16_t*)(ws + WS_BTMP))
#define Y ((bf16_t*)(ws + WS_Y))
#define MERGED ((bf16_t*)(ws + WS_MERGED))
#define Z ((bf16_t*)(ws + WS_Z))
#define U ((bf16_t*)(ws + WS_Z))
#define PROJ ((bf16_t*)(ws + WS_PROJ))
#define XB ((bf16_t*)(ws + WS_XB))
#define SSQM ((float*)(ws + WS_SSQM))
#define SSQF ((float*)(ws + WS_SSQF))
#define NRMQ ((unsigned*)(ws + WS_NRM))
#define NRMK ((unsigned*)(ws + WS_NRM) + 1024)

    {
        FRESH_LANE();
        LAS float* scr = (LAS float*)(ldsl + wave * 16384);
        constexpr int I_IN = (DM / 64) * (INW / 32), I_BR = (512 / 64) * (DM / 32), I_OUT = (DM / 64) * (DM / 32), I_1 = (DM / 64) * (DFF / 32), I_2 = (DFF / 64) * (DM / 32);
        constexpr int NITEMS = 2 * I_IN + 8 * I_BR + 2 * I_OUT + 2 * I_1 + 2 * I_2;
        for (int it = gw; it < NITEMS; it += NGW) {
            int r = it;
            if (r < 2 * I_IN) { const int l = r / I_IN; transpose_item(w_in + (size_t)l * DM * INW, DM, INW, WinT + (size_t)l * INW * DM, scr, r % I_IN, lane, norm_mix + l * DM); continue; } r -= 2 * I_IN;
            if (r < 8 * I_BR) { const int ln = r / I_BR; transpose_item(w_branch + (size_t)ln * 512 * DM, 512, DM, WbrT + (size_t)ln * DM * 512, scr, r % I_BR, lane); continue; } r -= 8 * I_BR;
            if (r < 2 * I_OUT) { const int l = r / I_OUT; transpose_item(w_out + (size_t)l * DM * DM, DM, DM, WoutT + (size_t)l * DM * DM, scr, r % I_OUT, lane); continue; } r -= 2 * I_OUT;
            if (r < 2 * I_1) { const int l = r / I_1; transpose_item(w_ff1 + (size_t)l * DM * DFF, DM, DFF, W1T + (size_t)l * DFF * DM, scr, r % I_1, lane, norm_ffn + l * DM); continue; } r -= 2 * I_1;
            { const int l = r / I_2; transpose_item(w_ff2 + (size_t)l * DFF * DM, DFF, DM, W2T + (size_t)l * DM * DFF, scr, r % I_2, lane); }
        }
        {
            f32x4 v[4], vn[4] = {};
            if (gw < NTOK) { const f32x4* xr = (const f32x4*)(x_in + (size_t)gw * DM) + lane;
#pragma unroll
                for (int j = 0; j < 4; ++j) v[j] = xr[64 * j]; }
            for (int m = gw; m < NTOK; m += NGW) {
                if (m + NGW < NTOK) { const f32x4* xr = (const f32x4*)(x_in + (size_t)(m + NGW) * DM) + lane;
#pragma unroll
                    for (int j = 0; j < 4; ++j) vn[j] = xr[64 * j]; }
                u32x2* o8 = (u32x2*)(XB + (size_t)m * DM) + lane; float sq = 0.f;
#pragma unroll
                for (int j = 0; j < 4; ++j) { sq += (v[j].x * v[j].x + v[j].y * v[j].y) + (v[j].z * v[j].z + v[j].w * v[j].w); u32x2 w; w.x = pk2(v[j].x, v[j].y); w.y = pk2(v[j].z, v[j].w); o8[64 * j] = w; }
                sq = wave_sum(sq);
                if (lane == 0) *(f32x4*)(SSQM + (size_t)m * 4) = (f32x4){sq, 0.f, 0.f, 0.f};
#pragma unroll
                for (int j = 0; j < 4; ++j) v[j] = vn[j];
            }
        }
    }
    grid.sync();

    for (int l = 0; l < DEPTH; ++l) {
        { FRESH_LANE(); LAS float* tab = (LAS float*)(ldsl + TAB_OFF); for (int i = tid; i < 8 * 465; i += 512) tab[i] = na_rpb[l * 8 * 465 + i] * LOG2E; }
        __syncthreads();
        for (int grp = 0; grp < NGRP; ++grp) {
            const size_t tok0 = (size_t)grp * TG;
            const float* xsrc = (l == 0) ? x_in : xout;
            {
                pg8::Gemm g{XB + tok0 * DM, WinT + (size_t)l * INW * DM, DM, DM, DM, 1 << 30, 0}; pg8::StaticOrder S; S.init(TG, INW, G, bx);
                if (bx == 0) { FRESH_LANE(); NRMQ[tid] = 0u; NRMQ[tid + 512] = 0u; if (tid < 16) NRMQ[1024 + tid] = 0u; (void)lane; }
                pg8::Epi<0> E{PROJ, nullptr, nullptr, b_gate + l * 4096, INW, SSQM + tok0 * 4, nullptr, nullptr, nullptr};
                pg8::gemm_phase(ldsl, g, S, E);
            }
            xcd_barrier(xbar);
            {
                FRESH_LANE();
                const float inv = exp2f(-(float)(lane & 15) * 0.8304820237218406f);
                const float gk = qk_norm[l * 128 + 64 + lane];
                const int per = (TG + NGW - 1) / NGW;
                float mq = 0.f, mk = 0.f; int cu = -1;
                u32x4 qv, kv, qvn = {}, kvn = {}; unsigned short rw[2], rwn[2] = {};
#define P3_LOAD(QV, KV, RW, mm) do { const bf16_t* ar_ = PROJ + (size_t)(mm) * INW; QV = *(const u32x4*)(ar_ + COL_AQ + lane * 8); KV = *(const u32x4*)(ar_ + COL_AK + lane * 8); \
                    _Pragma("unroll") for (int hd = 0; hd < 2; ++hd) RW[hd] = ar_[COL_DK + hd * 64 + lane]; } while (0)
                if (gw * per < TG) P3_LOAD(qv, kv, rw, gw * per);
                for (int i = 0; i < per; ++i) {
                    const int m = gw * per + i; if (m >= TG) break;
                    if (i + 1 < per && m + 1 < TG) P3_LOAD(qvn, kvn, rwn, m + 1);
                    if ((m >> 8) != cu) { if (cu >= 0 && (lane & 7) == 0) { atomicMax(NRMQ + cu * 8 + (lane >> 3), __float_as_uint(mq)); atomicMax(NRMK + (cu >> 5) * 8 + (lane >> 3), __float_as_uint(mk)); } cu = m >> 8; mq = 0.f; mk = 0.f; }
                    const int s = (int)((tok0 + m) % SEQ); const float pos = (float)((lane < 32) ? (s >> 6) : (s & 63));
                    float sn, cs; sincos_red(pos * inv, sn, cs);
                    { float nq = 0.f, nk = 0.f;
#pragma unroll
                      for (int e = 0; e < 4; ++e) { nq += bflo(qv[e]) * bflo(qv[e]) + bfhi(qv[e]) * bfhi(qv[e]); nk += bflo(kv[e]) * bflo(kv[e]) + bfhi(kv[e]) * bfhi(kv[e]); }
                      nq += __shfl_xor(nq, 1); nk += __shfl_xor(nk, 1); nq += __shfl_xor(nq, 2); nk += __shfl_xor(nk, 2); nq += __shfl_xor(nq, 4); nk += __shfl_xor(nk, 4);
                      mq = fmaxf(mq, sqrtf(nq)); mk = fmaxf(mk, sqrtf(nk)); }
                    bf16_t* row = PROJ + (size_t)m * INW + COL_DK;
#pragma unroll
                    for (int hd = 0; hd < 2; ++hd) {
                        const float v = __uint_as_float((unsigned)rw[hd] << 16);
                        const float rn = rsqrtf(wave_sum(v * v) * (1.f / 64.f) + EPS);
                        const float y = v * rn * gk;
                        const float p = __shfl_xor(y, 16);
                        const float o = ((lane >> 4) & 1) ? (y * cs + p * sn) : (y * cs - p * sn);
                        row[hd * 64 + lane] = (bf16_t)f2bf(o);
                    }
                    qv = qvn; kv = kvn;
#pragma unroll
                    for (int hd = 0; hd < 2; ++hd) rw[hd] = rwn[hd];
                }
#undef P3_LOAD
                if (cu >= 0 && (lane & 7) == 0) { atomicMax(NRMQ + cu * 8 + (lane >> 3), __float_as_uint(mq)); atomicMax(NRMK + (cu >> 5) * 8 + (lane >> 3), __float_as_uint(mk)); }
            }
            xcd_barrier(xbar);
            {
                using namespace attn_body;
                char* shm = (char*)lds;
                {
                    unsigned* qctr = (unsigned*)(ws + WS_BAR) + 3584 + (l * NGRP + grp) * 8;
                    volatile LAS unsigned* slot = (volatile LAS unsigned*)(ldsl + MISC_OFF + 32);
                    const int myx = (G % 8 == 0) ? (vcu / (G / 8)) : 0;
                    int qq = 0;
                    for (;;) {
                        if (tid0 == 0) { int fj = -1, fx = 0;
                            for (; qq < 8; ++qq) { const int x_ = (myx + qq) & 7; const int j_ = (int)atomicAdd(qctr + x_, 1u); if (j_ < 288) { fj = j_; fx = x_; break; } }
                            slot[0] = (unsigned)fj; slot[1] = (unsigned)fx; }
                        __syncthreads();
                        const int j = (int)slot[0], sx = (int)slot[1];
                        __syncthreads();
                        if (j < 0) break;
                        if (j < 128) {
                            AttnArgs a{}; a.qs = INW; a.ks = INW; a.NT = 128; a.tlo = 0; a.thi = 127;
                            if (j >= 32 && j < 96) { const int qb = j & 31, ds = 2 * sx + ((j - 32) >> 5), bb = ds >> 3, h = ds & 7; const size_t tb = (size_t)bb * SEQ;
                                a.Q = (const bf16*)(PROJ + (tb + qb * 256) * INW + COL_DQ + h * 64); a.K = (const bf16*)(PROJ + tb * INW + COL_DK + (h >> 2) * 64);
                                a.V = (const bf16*)(PROJ + tb * INW + COL_DV + (h >> 2) * 64); a.O = (bf16*)(Y + (tb + qb * 256) * 2048 + 1536 + h * 64); a.os = 2048;
                                a.q0 = qb * 256; a.gq = qk_norm + l * 128;
                                attn_unit<MD, 16>(a, shm);
                            } else {
                                int bb, hh, comp, qb;
                                if (j < 32) { bb = sx >> 2; hh = 2 + ((sx >> 1) & 1); comp = sx & 1; qb = j; }
                                else { const int s1 = sx >> 1; bb = s1 >> 1; comp = s1 & 1; hh = (j < 112) ? 1 : 0; qb = (sx & 1) * 16 + ((j - 96) & 15); }
                                const size_t tb = (size_t)bb * SEQ;
                                a.Q = (const bf16*)(PROJ + (tb + qb * 256) * INW + COL_AQ + hh * 128 + comp * 64); a.K = (const bf16*)(PROJ + tb * INW + COL_AK + hh * 128 + comp * 64);
                                a.V = (const bf16*)(PROJ + tb * INW + COL_AV + hh * 128); a.O = (bf16*)(ATMP + (tb + qb * 256) * 1024 + (hh * 2 + comp) * 128); a.os = 1024;
                                a.s2 = exp2f(-2.f * (float)(hh + 1)) * LOG2E;
                                const float Bs = __uint_as_float(NRMQ[(bb * 32 + qb) * 8 + hh * 2 + comp]) * __uint_as_float(NRMK[bb * 8 + hh * 2 + comp]) * 1.02f + 0.25f;
                                const float dlim = fminf((150.f + 2.f * Bs) / a.s2, 1.0e6f), q0f = (float)(qb * 256);
                                int tlo = max(0, (int)floorf((q0f - 63.f - dlim) * (1.f / 64.f))), thi = min(127, (int)ceilf((q0f + 255.f + dlim) * (1.f / 64.f)));
                                if (((thi - tlo + 1) & 1) != 0) { if (tlo > 0) --tlo; else ++thi; }
                                tlo = __builtin_amdgcn_readfirstlane(tlo); thi = __builtin_amdgcn_readfirstlane(thi);
                                a.K += (size_t)tlo * 64 * INW; a.V += (size_t)tlo * 64 * INW; a.q0 = qb * 256 - 64 * tlo; a.NT = thi - tlo + 1;
                                attn_unit128<16>(a, shm);
                            }
                        } else if (j < 192) {
                            const int cs = 2 * sx + ((j - 128) >> 5), qb = (j - 128) & 31, bb = cs >> 3, h = cs & 7, r0 = 4 * qb, kb = min(max(r0 - 4, 0), 116); const size_t tb = (size_t)bb * SEQ;
                            AttnArgs a{}; a.qs = INW; a.ks = INW; a.os = 2048; a.NT = 12; a.tlo = 0; a.thi = 11; a.q0 = r0; a.kb = kb;
                            a.Q = (const bf16*)(PROJ + (tb + r0 * 64) * INW + COL_CQ + h * 64); a.K = (const bf16*)(PROJ + (tb + kb * 64) * INW + COL_CK + h * 64);
                            a.V = (const bf16*)(PROJ + (tb + kb * 64) * INW + COL_CV + h * 64); a.O = (bf16*)(Y + (tb + r0 * 64) * 2048 + 1024 + h * 64);
                            a.tab = (lds_fptr)((lds_cptr)shm + TAB_OFF) + h * 465;
                            attn_unit<MC, 8>(a, shm);
                        } else {
                            const int p = j - 192, sg = 6 * sx + (p >> 4);
                            for (int e = 0; e < 2; ++e) {
                                const int blk = 2 * (p & 15) + e, bb = sg / 24, k = sg % 24, gp = k >> 3, h = k & 7, dsh = 2 * gp, dil = 1 << dsh;
                                const int nblk = 32 >> dsh, res = blk / nblk, i0 = (blk % nblk) * 256, L = SEQ >> dsh;
                                const long tq = (long)bb * SEQ + res + (long)i0 * dil, tk = (long)bb * SEQ + res + (long)(i0 - 64) * dil;
                                AttnArgs a{}; a.qs = dil * INW; a.ks = dil * INW; a.os = dil * 1536; a.NT = 6; a.tlo = (i0 == 0) ? 1 : 0; a.thi = (i0 + 256 == L) ? 4 : 5;
                                const int cq = COL_B + gp * 1536 + h * 64;
                                a.Q = (const bf16*)(PROJ + tq * INW + cq); a.K = (const bf16*)(PROJ + tk * INW + cq + 512); a.V = (const bf16*)(PROJ + tk * INW + cq + 1024);
                                a.O = (bf16*)(BTMP + tq * 1536 + gp * 512 + h * 64);
                                a.s2 = exp2f(-(float)(h + 1)) * (float)dil * LOG2E; a.stat = STAT + (tq * 24 + gp * 8 + h) * 2; a.ss = dil * 48;
                                attn_unit<MB, 8>(a, shm);
                            }
                        }
                    }
                }
            }
            xcd_barrier(xbar);
            {
                FRESH_LANE();
                int l_ = l; asm volatile("" : "+s"(l_));
                const float lam_init = (l_ == 0) ? 0.2f : (0.8f - 0.6f * 0.7408182206817179f);
                float lam;
                { const float* lp = diff_lambda + l * 256; const float a = lp[lane] * lp[64 + lane], b = lp[128 + lane] * lp[192 + lane]; lam = expf(wave_sum(a)) - expf(wave_sum(b)) + lam_init; lam = __uint_as_float(__builtin_amdgcn_readfirstlane(__float_as_uint(lam))); }
                const float out_scale = 1.f - lam_init;
                const float g0 = diff_subln[l * 128 + 2 * lane], g1 = diff_subln[l * 128 + 2 * lane + 1];
                const int h = lane >> 3, d8 = (lane & 7) * 8;
                unsigned aw[8]; u32x4 bw[3]; float sv[6];
#define P5_LOAD(AW, BW, SV, mm) do { const unsigned* at_ = (const unsigned*)(ATMP + (size_t)(mm) * 1024); _Pragma("unroll") for (int q = 0; q < 8; ++q) AW[q] = at_[q * 64 + lane]; \
                    const bf16_t* bt_ = BTMP + (size_t)(mm) * 1536 + h * 64 + d8; _Pragma("unroll") for (int g = 0; g < 3; ++g) BW[g] = *(const u32x4*)(bt_ + g * 512); \
                    const float* st_ = STAT + (size_t)(mm) * 48 + h * 2; _Pragma("unroll") for (int g = 0; g < 3; ++g) { SV[2 * g] = st_[16 * g]; SV[2 * g + 1] = st_[16 * g + 1]; } } while (0)
                for (int m = gw; m < TG; m += NGW) {
                    P5_LOAD(aw, bw, sv, m);
                    unsigned* yr = (unsigned*)(Y + (size_t)m * 2048);
#pragma unroll
                    for (int hh = 0; hh < 4; ++hh) {
                        const unsigned w0 = aw[hh * 2], w1 = aw[hh * 2 + 1];
                        const float d0 = bflo(w0) - lam * bflo(w1), d1 = bfhi(w0) - lam * bfhi(w1);
                        const float rn = rsqrtf(wave_sum(d0 * d0 + d1 * d1) * (1.f / 128.f) + EPS) * out_scale;
                        yr[hh * 64 + lane] = pk2(d0 * rn * g0, d1 * rn * g1);
                    }
                    const float m0 = sv[0], l0 = sv[1], m1 = sv[2], l1 = sv[3], m2 = sv[4], l2 = sv[5];
                    const float ms = fmaxf(m0, fmaxf(m1, m2));
                    const float w0 = l0 * exp2f(m0 - ms), w1 = l1 * exp2f(m1 - ms), w2 = l2 * exp2f(m2 - ms); const float inv = 1.f / (w0 + w1 + w2);
                    const u32x4 a0 = bw[0], a1 = bw[1], a2 = bw[2];
                    u32x4 o;
#pragma unroll
                    for (int e = 0; e < 4; ++e) { const float lo = (w0 * bflo(a0[e]) + w1 * bflo(a1[e]) + w2 * bflo(a2[e])) * inv, hi = (w0 * bfhi(a0[e]) + w1 * bfhi(a1[e]) + w2 * bfhi(a2[e])) * inv; o[e] = pk2(lo, hi); }
                    *(u32x4*)(Y + (size_t)m * 2048 + 512 + h * 64 + d8) = o;
                }
#undef P5_LOAD
            }
            xcd_barrier(xbar);
            {
                pg8::Gemm g{Y, WbrT + (size_t)l * 4096 * 512, 2048, 512, 512, 4, 512}; pg8::StaticOrder S; S.init(TG, 4096, G, bx);
                pg8::Epi<1> E{Z, nullptr, nullptr, nullptr, 4096, nullptr, nullptr, nullptr, nullptr};
                pg8::gemm_phase(ldsl, g, S, E);
            }
            xcd_barrier(xbar);
            { FRESH_LANE();
            u32x4 gv[2][4], zv[2][4];
#define P7_LOAD(GV, ZV, mm) do { const bf16_t* gr_ = PROJ + (size_t)(mm) * INW + COL_GATE + lane * 8; const bf16_t* zr_ = Z + (size_t)(mm) * 4096 + lane * 8; \
                _Pragma("unroll") for (int jj = 0; jj < 2; ++jj) _Pragma("unroll") for (int n = 0; n < 4; ++n) { GV[jj][n] = *(const u32x4*)(gr_ + n * 1024 + jj * 512); ZV[jj][n] = *(const u32x4*)(zr_ + n * 1024 + jj * 512); } } while (0)
            for (int m = gw; m < TG; m += NGW) {
                P7_LOAD(gv, zv, m);
#pragma unroll
                for (int j = 0; j < 2; ++j) { const int c = lane * 8 + j * 512; float acc[8] = {0.f, 0.f, 0.f, 0.f, 0.f, 0.f, 0.f, 0.f};
#pragma unroll
                    for (int n = 0; n < 4; ++n) {
#pragma unroll
                        for (int e = 0; e < 4; ++e) { acc[2 * e] += bflo(gv[j][n][e]) * bflo(zv[j][n][e]); acc[2 * e + 1] += bfhi(gv[j][n][e]) * bfhi(zv[j][n][e]); } }
                    u32x4 o; o.x = pk2(acc[0], acc[1]); o.y = pk2(acc[2], acc[3]); o.z = pk2(acc[4], acc[5]); o.w = pk2(acc[6], acc[7]);
                    *(u32x4*)(MERGED + (size_t)m * DM + c) = o; }
#undef P7_LOAD
            } }
            xcd_barrier(xbar);
            {
                pg8::Gemm g{MERGED, WoutT + (size_t)l * DM * DM, DM, DM, DM, 1 << 30, 0}; pg8::StaticOrder S; S.init(TG, DM, G, bx);
                pg8::Epi<3> E{nullptr, xout + tok0 * DM, xsrc + tok0 * DM, nullptr, DM, nullptr, H, SSQF, (LAS float*)(ldsl + SSQ_OFF)};
                pg8::gemm_phase(ldsl, g, S, E);
            }
            xcd_barrier(xbar);
            {
                pg8::Gemm g{H, W1T + (size_t)l * DFF * DM, DM, DM, DM, 1 << 30, 0}; pg8::StaticOrder S; S.init(TG, DFF, G, bx);
                pg8::Epi<2> E{U, nullptr, nullptr, nullptr, DFF, SSQF, nullptr, nullptr, nullptr};
                pg8::gemm_phase(ldsl, g, S, E);
            }
            xcd_barrier(xbar);
            {
                pg8::Gemm g{U, W2T + (size_t)l * DM * DFF, DFF, DFF, DFF, 1 << 30, 0}; pg8::StaticOrder S; S.init(TG, DM, G, bx);
                pg8::Epi<3> E{nullptr, xout + tok0 * DM, xout + tok0 * DM, nullptr, DM, nullptr, XB + tok0 * DM, SSQM + tok0 * 4, (LAS float*)(ldsl + SSQ_OFF)};
                pg8::gemm_phase(ldsl, g, S, E);
            }
            if (l == DEPTH - 1 && grp == NGRP - 1) xcd_barrier(xbar);
        }
    }
    {
        FRESH_LANE();
        const f32x4* g4 = (const f32x4*)norm_final + lane; f32x4 gg[4];
#pragma unroll
        for (int j = 0; j < 4; ++j) gg[j] = g4[64 * j];
        f32x4 v[4], vn[4] = {};
        if (gw < NTOK) { const f32x4* o = (const f32x4*)(xout + (size_t)gw * DM) + lane;
#pragma unroll
            for (int j = 0; j < 4; ++j) v[j] = o[64 * j]; }
        for (int m = gw; m < NTOK; m += NGW) {
            if (m + NGW < NTOK) { const f32x4* on = (const f32x4*)(xout + (size_t)(m + NGW) * DM) + lane;
#pragma unroll
                for (int j = 0; j < 4; ++j) vn[j] = on[64 * j]; }
            f32x4* o = (f32x4*)(xout + (size_t)m * DM) + lane; float sq = 0.f;
#pragma unroll
            for (int j = 0; j < 4; ++j) sq += (v[j].x * v[j].x + v[j].y * v[j].y) + (v[j].z * v[j].z + v[j].w * v[j].w);
            const float r = rsqrtf(wave_sum(sq) * (1.f / DM) + EPS);
#pragma unroll
            for (int j = 0; j < 4; ++j) o[64 * j] = (f32x4){v[j].x * r * gg[j].x, v[j].y * r * gg[j].y, v[j].z * r * gg[j].z, v[j].w * r * gg[j].w};
#pragma unroll
            for (int j = 0; j < 4; ++j) v[j] = vn[j];
        }
    }
}

#undef ws
#undef x_in
#undef norm_mix
#undef w_in
#undef b_gate
#undef diff_lambda
#undef diff_subln
#undef na_rpb
#undef qk_norm
#undef w_branch
#undef w_out
#undef norm_ffn
#undef w_ff1
#undef w_ff2
#undef norm_final
#undef xout
#undef WinT
#undef WbrT
#undef WoutT
#undef W1T
#undef W2T
#undef STAT
#undef H
#undef ATMP
#undef BTMP
#undef Y
#undef MERGED
#undef Z
#undef U
#undef PROJ
#undef NRMQ
#undef XB
#undef SSQM
#undef SSQF
#undef NRMK

extern "C" void kernel_launch(void* const* d_in, const int* in_sizes, int n_in, void* d_out, int out_size, void* d_ws, size_t ws_size, hipStream_t stream) {
    static int grid_blocks = 0;
    if (!grid_blocks) {
        int dev = 0, cus = 0, per_cu = 0;
        (void)hipGetDevice(&dev);
        (void)hipDeviceGetAttribute(&cus, hipDeviceAttributeMultiprocessorCount, dev);
        (void)hipFuncSetAttribute((const void*)mk_fwd, hipFuncAttributeMaxDynamicSharedMemorySize, LDS_BYTES);
        (void)hipOccupancyMaxActiveBlocksPerMultiprocessor(&per_cu, (const void*)mk_fwd, 512, LDS_BYTES);
        if (per_cu < 1) per_cu = 1;
        grid_blocks = cus * per_cu;
        if (ws_size < WS_END || n_in != 14) { fprintf(stderr, "kernel_launch: workspace %zu < %zu or n_in %d != 14\n", ws_size, (size_t)WS_END, n_in); grid_blocks = -1; }
    }
    if (grid_blocks < 0) return;
    (void)hipMemsetAsync((char*)d_ws + WS_BAR, 0, 16384, stream);
    Args a{};
    for (int i = 0; i < 14; ++i) a.in[i] = (const float*)d_in[i];
    a.out = (float*)d_out; a.ws = (unsigned char*)d_ws;
    void* kargs[] = {&a};
    hipError_t e = hipLaunchCooperativeKernel((const void*)mk_fwd, dim3(grid_blocks), dim3(512), kargs, LDS_BYTES, stream);
    if (e != hipSuccess) fprintf(stderr, "cooperative launch failed: %s (grid %d)\n", hipGetErrorString(e), grid_blocks);
}
```

```cpp
#include <hip/hip_runtime.h>
#include <hip/hip_cooperative_groups.h>
#include <hip/hip_bf16.h>
#include <cstdio>
#include <cstdint>
#include <cmath>
namespace cg = cooperative_groups;

constexpr int BATCH = 8, SEQ = 8192, DM = 1024, NTOK = BATCH * SEQ, INW = 12544, DFF = 4096, DEPTH = 2;
constexpr int GB = 2, TG = GB * SEQ, NGRP = BATCH / GB;
constexpr float EPS = 1e-6f;
constexpr float LOG2E = 1.4426950408889634f;
constexpr float C2 = 0.125f * LOG2E;
constexpr int COL_AQ = 0, COL_AK = 512, COL_AV = 1024, COL_B = 1536, COL_CQ = 6144, COL_CK = 6656, COL_CV = 7168, COL_DQ = 7680, COL_DK = 8192, COL_DV = 8320, COL_GATE = 8448;
constexpr size_t MiB = 1u << 20;
constexpr size_t WS_WIN = 0, WS_WBR = 49 * MiB, WS_WOUT = 57 * MiB, WS_W1 = 61 * MiB, WS_W2 = 77 * MiB, WS_STAT = 93 * MiB, WS_H = 96 * MiB, WS_ATMP = 128 * MiB,
                 WS_BTMP = 160 * MiB, WS_Y = 208 * MiB, WS_MERGED = 272 * MiB, WS_Z = 304 * MiB, WS_PROJ = 432 * MiB, WS_NRM = 824 * MiB, WS_BAR = 824 * MiB + 512 * 1024, WS_SSQM = 825 * MiB, WS_SSQF = 826 * MiB, WS_XB = 827 * MiB, WS_END = 955 * MiB;
constexpr int LDS_BYTES = 151552, TAB_OFF = 131072, MISC_OFF = 147072, SSQ_OFF = 147456;

#define LAS __attribute__((address_space(3)))
typedef unsigned short bf16_t;
typedef short bf16x8 __attribute__((ext_vector_type(8)));
typedef float f32x4 __attribute__((ext_vector_type(4)));
typedef unsigned u32x4 __attribute__((ext_vector_type(4)));
typedef unsigned u32x2 __attribute__((ext_vector_type(2)));

__device__ __forceinline__ unsigned f2bf(float f) { unsigned u = __builtin_bit_cast(unsigned, f); return (u + 0x7fffu + ((u >> 16) & 1u)) >> 16; }
typedef float f32x2_pk __attribute__((ext_vector_type(2))); typedef __bf16 bf16x2_pk __attribute__((ext_vector_type(2)));
__device__ __forceinline__ unsigned pk2(float lo, float hi) { f32x2_pk v = {lo, hi}; bf16x2_pk b = __builtin_convertvector(v, bf16x2_pk); return __builtin_bit_cast(unsigned, b); }
__device__ __forceinline__ float bflo(unsigned w) { return __uint_as_float(w << 16); }
__device__ __forceinline__ float bfhi(unsigned w) { return __uint_as_float(w & 0xffff0000u); }
__device__ __forceinline__ float wave_sum(float v) {
#pragma unroll
    for (int o = 1; o < 64; o <<= 1) v += __shfl_xor(v, o);
    return v;
}

namespace pg8 {
constexpr int BM = 256, BK = 64, HALF = 128, HTB = HALF * BK * 2, STAGE_BYTES = 8 * HTB, NXCD = 8, WGM = 4;
__host__ __device__ __forceinline__ int lds_byte(int r, int c) { const int st = (r >> 4) * 2 + (c >> 5), rr = r & 15, cc = c & 31, ob = rr * 64 + cc * 2; return st * 1024 + (ob ^ (((ob >> 9) & 1) << 5)); }
__host__ __device__ __forceinline__ void stage_rc(int b, int& R, int& C) { const int st = b / 1024, sb = b % 1024, swz = sb ^ (((sb >> 9) & 1) << 5); R = (st >> 1) * 16 + swz / 64; C = (st & 1) * 32 + (swz % 64) / 2; }
__host__ __device__ __forceinline__ int perm32(int rho) { const int n = rho >> 4, i = rho & 15; return 8 * (i >> 2) + 4 * n + (i & 3); }

struct Unit { int pm, pn; };
struct Gemm { const bf16_t* A; const bf16_t* Bt; int lda, ldb, K, adiv, astride; };

struct StaticOrder {
    int nM, nN, nwg, G, c;
    __device__ void init(int M, int N, int G_, int c_) { nM = M / BM; nN = N / BM; nwg = nM * nN; G = G_; c = c_; }
    __device__ bool next(int i, Unit& u) const {
        const long L = (long)i * G + c; if (L >= nwg) return false;
        int wgid = (int)L; { const int q = nwg / NXCD, r = nwg % NXCD, xcd = wgid % NXCD, off = wgid / NXCD; wgid = (xcd < r ? xcd * (q + 1) : r * (q + 1) + (xcd - r) * q) + off; }
        const int nig = WGM * nN, gid = wgid / nig, fm = gid * WGM, gsz = (nM - fm) < WGM ? (nM - fm) : WGM;
        u.pm = fm + ((wgid % nig) % gsz); u.pn = (wgid % nig) / gsz; return true;
    }
};

__device__ __forceinline__ unsigned cvt_pk_bf16(float lo, float hi) { unsigned r; asm volatile("v_cvt_pk_bf16_f32 %0, %1, %2" : "=v"(r) : "v"(lo), "v"(hi)); return r; }

template <int MODE> struct Epi {
    bf16_t* O; float* Of; const float* base; const float* bias; int ldc;
    const float* ssq;
    bf16_t* XBo; float* SSQo; LAS float* lx;
    __device__ __forceinline__ void operator()(const f32x4 (&acc)[2][2][4][2], const Unit& u, int wr, int wc, int fr, int fq) const {
        const int row0 = u.pm * BM + wr * 64 + fr, col0 = u.pn * BM + wc * 32 + 8 * fq;
        int kind = 0; float sc = 1.f;
        if (MODE == 0) { const int pn = u.pn; if (pn >= 33) kind = 2; else if (pn < 2 || pn == 6 || pn == 7 || pn == 12 || pn == 13 || pn == 18 || pn == 19 || pn == 24 || pn == 25) sc = C2; }
        float rsv[2][4]; f32x4 bv[2][2];
#pragma unroll
        for (int ai = 0; ai < 2; ++ai)
#pragma unroll
            for (int m = 0; m < 4; ++m) { rsv[ai][m] = 1.f;
                if (MODE == 0 || MODE == 2) { const f32x4 q = *(const f32x4*)(ssq + (size_t)(row0 + ai * HALF + m * 16) * 4); rsv[ai][m] = rsqrtf(((q[0] + q[1]) + (q[2] + q[3])) * (1.f / 1024.f) + EPS); } }
#pragma unroll
        for (int bj = 0; bj < 2; ++bj)
#pragma unroll
            for (int n = 0; n < 2; ++n) { bv[bj][n] = (f32x4){0.f, 0.f, 0.f, 0.f}; if (MODE == 0) { if (kind == 2) bv[bj][n] = *(const f32x4*)(bias + col0 + bj * HALF - COL_GATE + 4 * n); } }
        f32x4 nb[2][2];
        if (MODE == 3) {
#pragma unroll
            for (int bj = 0; bj < 2; ++bj)
#pragma unroll
                for (int n = 0; n < 2; ++n) nb[bj][n] = *(const f32x4*)(base + (size_t)row0 * ldc + col0 + bj * HALF + 4 * n);
        }
#pragma unroll
        for (int ai = 0; ai < 2; ++ai)
#pragma unroll
            for (int m = 0; m < 4; ++m) { const size_t roff = (size_t)(row0 + ai * HALF + m * 16) * ldc; float psq = 0.f; const float rs = rsv[ai][m];
                f32x4 cb[2][2];
                if (MODE == 3) {
#pragma unroll
                    for (int bj = 0; bj < 2; ++bj)
#pragma unroll
                        for (int n = 0; n < 2; ++n) cb[bj][n] = nb[bj][n];
                    const int g1 = ai * 4 + m + 1;
                    if (g1 < 8) { const size_t r1 = (size_t)(row0 + (g1 >> 2) * HALF + (g1 & 3) * 16) * ldc;
#pragma unroll
                        for (int bj = 0; bj < 2; ++bj)
#pragma unroll
                            for (int n = 0; n < 2; ++n) nb[bj][n] = *(const f32x4*)(base + r1 + col0 + bj * HALF + 4 * n); }
                }
#pragma unroll
                for (int bj = 0; bj < 2; ++bj) { const int col = col0 + bj * HALF; f32x4 v0 = acc[ai][bj][m][0], v1 = acc[ai][bj][m][1];
                    if (MODE == 3) {
                        v0 = cb[bj][0] + v0; v1 = cb[bj][1] + v1;
                        *(f32x4*)(Of + roff + col) = v0; *(f32x4*)(Of + roff + col + 4) = v1;
                        psq += (v0[0] * v0[0] + v0[1] * v0[1]) + (v0[2] * v0[2] + v0[3] * v0[3]) + (v1[0] * v1[0] + v1[1] * v1[1]) + (v1[2] * v1[2] + v1[3] * v1[3]);
                        u32x4 w; w.x = cvt_pk_bf16(v0[0], v0[1]); w.y = cvt_pk_bf16(v0[2], v0[3]); w.z = cvt_pk_bf16(v1[0], v1[1]); w.w = cvt_pk_bf16(v1[2], v1[3]);
                        *(u32x4*)(XBo + roff + col) = w;
                    } else {
                        if (MODE == 0 || MODE == 2) { v0 = v0 * rs; v1 = v1 * rs; }
                        if (MODE == 0) {
                            if (kind == 2) {
#pragma unroll
                                for (int e = 0; e < 4; ++e) { v0[e] = __builtin_amdgcn_rcpf(1.f + __expf(-(v0[e] + bv[bj][0][e]))); v1[e] = __builtin_amdgcn_rcpf(1.f + __expf(-(v1[e] + bv[bj][1][e]))); } }
                            else { v0 = v0 * sc; v1 = v1 * sc; }
                        }
                        if (MODE == 2) {
#pragma unroll
                            for (int e = 0; e < 4; ++e) { const float a = fmaxf(v0[e], 0.f), b = fmaxf(v1[e], 0.f); v0[e] = a * a; v1[e] = b * b; } }
                        u32x4 w; w.x = cvt_pk_bf16(v0[0], v0[1]); w.y = cvt_pk_bf16(v0[2], v0[3]); w.z = cvt_pk_bf16(v1[0], v1[1]); w.w = cvt_pk_bf16(v1[2], v1[3]);
                        *(u32x4*)(O + roff + col) = w;
                    } }
                if (MODE == 3) { psq += __shfl_xor(psq, 16); psq += __shfl_xor(psq, 32); if (fq == 0) lx[(ai * HALF + wr * 64 + m * 16 + fr) * 4 + wc] = psq; }
            }
        if (MODE == 3) {
            asm volatile("s_waitcnt lgkmcnt(0)" ::: "memory"); __builtin_amdgcn_s_barrier(); asm volatile("" ::: "memory");
            const int t = threadIdx.x;
            if (t < 256) { const f32x4 q = *(const LAS f32x4*)(lx + t * 4); SSQo[(size_t)(u.pm * BM + t) * 4 + u.pn] = (q[0] + q[1]) + (q[2] + q[3]); }
        }
    }
};

template <class EpiT>
__device__ __forceinline__ void gemm_phase(LAS unsigned char* lds, const Gemm g, const StaticOrder& S, const EpiT& E) {
    int tid_ = threadIdx.x; asm volatile("" : "+v"(tid_));
    const int tid = tid_, wid = __builtin_amdgcn_readfirstlane(tid >> 6), lane = tid & 63, wr = wid >> 2, wc = wid & 3, fr = lane & 15, fq = lane >> 4;
    const int K = g.K, nt = K / BK;
    unsigned voffA[2], voffB[2];
#pragma unroll
    for (int i = 0; i < 2; ++i) { int R, C; stage_rc(tid * 16 + i * 8192, R, C); const int Rb = (R & ~31) + perm32(R & 31);
        voffA[i] = (unsigned)(R * g.lda + C) * 2u; voffB[i] = (unsigned)(Rb * g.ldb + C) * 2u; }
    const size_t kstep = (size_t)(BK * 2);
    const size_t hA = (size_t)HALF * g.lda * 2, hB = (size_t)HALF * g.ldb * 2;
    const size_t tA = 2 * hA, tB = 2 * hB;
    const unsigned ldsw = (unsigned)wid * 1024u;
    const int aoff = lds_byte(wr * 64 + fr, fq * 8), boff = lds_byte(wc * 32 + fr, fq * 8);
#define PG8_SA(b, h) (((b) * 2 + (h)) * HTB)
#define PG8_SB(b, h) ((4 + (b) * 2 + (h)) * HTB)
#define PG8_STAGE(bufoff, gbase, voff) do { _Pragma("unroll") for (int _i = 0; _i < 2; ++_i) \
        __builtin_amdgcn_global_load_lds((const unsigned*)((const char*)(gbase) + (voff)[_i]), (LAS unsigned*)(lds + (bufoff) + ldsw + _i * 8192), 16, 0, 0); } while (0)
#define PG8_LDA(dst, b, h) do { _Pragma("unroll") for (int m = 0; m < 4; ++m) _Pragma("unroll") for (int k = 0; k < 2; ++k) dst[m][k] = *(const LAS bf16x8*)(lds + PG8_SA(b, h) + aoff + m * 2048 + k * 1024); } while (0)
#define PG8_LDB(dst, b, h) do { _Pragma("unroll") for (int n = 0; n < 2; ++n) _Pragma("unroll") for (int k = 0; k < 2; ++k) dst[n][k] = *(const LAS bf16x8*)(lds + PG8_SB(b, h) + boff + n * 2048 + k * 1024); } while (0)
#define PG8_MMA(ai, bj, At, Bt) do { __builtin_amdgcn_s_setprio(1); _Pragma("unroll") for (int m = 0; m < 4; ++m) _Pragma("unroll") for (int n = 0; n < 2; ++n) _Pragma("unroll") for (int k = 0; k < 2; ++k) \
        acc[ai][bj][m][n] = __builtin_amdgcn_mfma_f32_16x16x32_bf16(Bt[n][k], At[m][k], acc[ai][bj][m][n], 0, 0, 0); __builtin_amdgcn_s_setprio(0); } while (0)
#define PG8_WAIT_V(n) asm volatile("s_waitcnt vmcnt(" #n ")" ::: "memory")
#define PG8_WAIT_L(n) asm volatile("s_waitcnt lgkmcnt(" #n ")" ::: "memory")
#define PG8_BAR __builtin_amdgcn_s_barrier()
#define PG8_SCHED __builtin_amdgcn_sched_barrier(0)
#define PG8_PA(u) ((const char*)g.A + (size_t)(u).pm * tA + (size_t)((u).pn / g.adiv) * (size_t)g.astride * 2)
#define PG8_PB(u) ((const char*)g.Bt + (size_t)(u).pn * tB)
    Unit cur, nxt; int ui = 0;
    if (!S.next(0, cur)) return;
    f32x4 acc[2][2][4][2];
#pragma unroll
    for (int a = 0; a < 2; ++a)
#pragma unroll
        for (int b = 0; b < 2; ++b)
#pragma unroll
            for (int m = 0; m < 4; ++m)
#pragma unroll
                for (int n = 0; n < 2; ++n) acc[a][b][m][n] = (f32x4){0.f, 0.f, 0.f, 0.f};
    bf16x8 At[4][2], B0[2][2], B1[2][2];
    const char* cA = PG8_PA(cur); const char* cB = PG8_PB(cur);
    PG8_STAGE(PG8_SB(0, 0), cB, voffB); PG8_STAGE(PG8_SB(0, 1), cB + hB, voffB); PG8_STAGE(PG8_SA(0, 0), cA, voffA); PG8_STAGE(PG8_SA(0, 1), cA + hA, voffA);
    if (wr == 1) PG8_BAR;
    PG8_WAIT_V(2); PG8_BAR;
    PG8_STAGE(PG8_SB(1, 0), cB + kstep, voffB); PG8_STAGE(PG8_SA(1, 0), cA + kstep, voffA); PG8_STAGE(PG8_SB(1, 1), cB + hB + kstep, voffB);
    PG8_WAIT_V(6); PG8_BAR;
    for (;;) {
        const bool has_next = S.next(ui + 1, nxt);
        const char* nA = has_next ? PG8_PA(nxt) : cA; const char* nB = has_next ? PG8_PB(nxt) : cB;
        for (int t = 0; t < nt; t += 2) {
            const bool last = (t == nt - 2);
            const char* a1 = cA + (size_t)(t + 1) * kstep;
            const char* a2 = last ? nA : cA + (size_t)(t + 2) * kstep; const char* b2 = last ? nB : cB + (size_t)(t + 2) * kstep;
            const char* a3 = a2 + kstep; const char* b3 = b2 + kstep;
            PG8_LDB(B0, 0, 0); PG8_LDB(B1, 0, 1); PG8_SCHED; PG8_LDA(At, 0, 0); PG8_STAGE(PG8_SA(1, 1), a1 + hA, voffA);
            PG8_WAIT_V(8); PG8_WAIT_L(0); PG8_BAR; PG8_MMA(0, 0, At, B0); PG8_MMA(0, 1, At, B1); PG8_BAR; PG8_SCHED;
            PG8_LDA(At, 0, 1); PG8_STAGE(PG8_SB(0, 0), b2, voffB); PG8_STAGE(PG8_SB(0, 1), b2 + hB, voffB); PG8_STAGE(PG8_SA(0, 0), a2, voffA);
            PG8_WAIT_V(8); PG8_WAIT_L(0); PG8_BAR; PG8_MMA(1, 0, At, B0); PG8_MMA(1, 1, At, B1); PG8_BAR; PG8_SCHED;
            PG8_LDB(B0, 1, 0); PG8_LDB(B1, 1, 1); PG8_SCHED; PG8_LDA(At, 1, 0); PG8_STAGE(PG8_SA(0, 1), a2 + hA, voffA);
            PG8_WAIT_V(8); PG8_WAIT_L(0); PG8_BAR; PG8_MMA(0, 0, At, B0); PG8_MMA(0, 1, At, B1); PG8_BAR; PG8_SCHED;
            PG8_LDA(At, 1, 1); PG8_STAGE(PG8_SB(1, 0), b3, voffB); PG8_STAGE(PG8_SB(1, 1), b3 + hB, voffB); PG8_STAGE(PG8_SA(1, 0), a3, voffA);
            PG8_WAIT_V(8); PG8_WAIT_L(0); PG8_BAR; PG8_MMA(1, 0, At, B0); PG8_MMA(1, 1, At, B1); PG8_BAR; PG8_SCHED;
        }
        if (wr == 0) PG8_BAR;
        E(acc, cur, wr, wc, fr, fq);
        if (!has_next) break;
#pragma unroll
        for (int a = 0; a < 2; ++a)
#pragma unroll
            for (int b = 0; b < 2; ++b)
#pragma unroll
                for (int m = 0; m < 4; ++m)
#pragma unroll
                    for (int n = 0; n < 2; ++n) acc[a][b][m][n] = (f32x4){0.f, 0.f, 0.f, 0.f};
        cur = nxt; cA = nA; cB = nB; ++ui;
        if (wr == 1) PG8_BAR;
    }
    PG8_WAIT_V(0);
    PG8_BAR;
#undef PG8_SA
#undef PG8_SB
#undef PG8_STAGE
#undef PG8_LDA
#undef PG8_LDB
#undef PG8_MMA
#undef PG8_WAIT_V
#undef PG8_WAIT_L
#undef PG8_BAR
#undef PG8_SCHED
#undef PG8_PA
#undef PG8_PB
}
}

__device__ __forceinline__ void sincos_red(float a, float& s, float& c) {
    const float q = rintf(a * 0.636619772367581f); const int iq = (int)q;
    float r = fmaf(q, -1.5703125f, a); r = fmaf(q, -4.837512969970703125e-4f, r); r = fmaf(q, -7.54978995489188216e-8f, r);
    const float r2 = r * r;
    const float sp = r + r * r2 * (-1.6666654611e-1f + r2 * (8.3321608736e-3f + r2 * (-1.9515295891e-4f)));
    const float cp = 1.0f - 0.5f * r2 + r2 * r2 * (4.166664568298827e-2f + r2 * (-1.388731625493765e-3f + r2 * 2.443315711809948e-5f));
    const int k = iq & 3;
    s = (k == 0) ? sp : (k == 1) ? cp : (k == 2) ? -sp : -cp;
    c = (k == 0) ? cp : (k == 1) ? -sp : (k == 2) ? -cp : sp;
}

namespace attn_body {
using bf16 = __hip_bfloat16;
using s16x4 = __attribute__((ext_vector_type(4))) short;
using f32x16 = __attribute__((ext_vector_type(16))) float;
constexpr int NW = 8, QBLK = 32, QB = QBLK * NW, KVBLK = 64;
constexpr int MA = 0, MB = 1, MC = 2, MD = 3;
__device__ __forceinline__ int crow(int r, int hi) { return (r & 3) + 8 * (r >> 2) + 4 * hi; }
#define SBAR() __builtin_amdgcn_sched_barrier(0)
constexpr int NSLOT = 3, SLOTB = 8192;
constexpr int LDS_K = 0, LDS_V = NSLOT * SLOTB, LDS_WS = 2 * NSLOT * SLOTB, LDS_OST = LDS_WS + NW * 64 * 4, LDS_ATT = LDS_OST + NW * 4096;
typedef __attribute__((address_space(3))) const char* lds_cptr;
typedef __attribute__((address_space(3))) const float* lds_fptr;

struct AttnArgs {
    const bf16* Q; const bf16* K; const bf16* V; bf16* O;
    int qs, ks, os;
    int NT, tlo, thi;
    float s2;
    int q0;
    int kb;
    float* stat; int ss;
    lds_fptr tab;
    const float* gq;
};

__device__ __forceinline__ void glds16(const void* gsrc, unsigned lds_dst) { unsigned keep;
  asm volatile("s_mov_b32 %0, m0\n\ts_mov_b32 m0, %2\n\ts_nop 0\n\tglobal_load_lds_dwordx4 %1, off\n\ts_mov_b32 m0, %0" : "=&s"(keep) : "v"(gsrc), "s"(lds_dst) : "memory"); }
__device__ __forceinline__ float max3f(float a, float b, float c) { float r; asm("v_max3_f32 %0, %1, %2, %3" : "=v"(r) : "v"(a), "v"(b), "v"(c)); return r; }
__device__ __forceinline__ float max2f(float a, float b) { float r; asm("v_max_f32_e32 %0, %1, %2" : "=v"(r) : "v"(a), "v"(b)); return r; }
__device__ __forceinline__ float fadd_s(float a, float b) { float r; asm("v_add_f32_e32 %0, %1, %2" : "=v"(r) : "v"(a), "v"(b)); return r; }
__device__ __forceinline__ float fsub_s(float a, float b) { float r; asm("v_sub_f32_e32 %0, %1, %2" : "=v"(r) : "v"(a), "v"(b)); return r; }
typedef float f32x2_t __attribute__((ext_vector_type(2))); typedef __bf16 bf16x2_t __attribute__((ext_vector_type(2)));
__device__ __forceinline__ unsigned cvtpk_s(float lo, float hi) { f32x2_t v = {lo, hi}; bf16x2_t b = __builtin_convertvector(v, bf16x2_t); return __builtin_bit_cast(unsigned, b); }
#define WAIT_BAR(N) asm volatile("s_waitcnt vmcnt(" #N ") lgkmcnt(0)\n\ts_barrier" ::: "memory")

__device__ __forceinline__ void qkt(f32x16& p0, f32x16& p1, const char* Kslot, const bf16x8* qr, const f32x16& negm, int r32, int hi) {
  const char* kb = Kslot + hi * 1024 + r32 * 16;
  #pragma unroll
  for (int d0 = 0; d0 < 4; ++d0) {
    const bf16x8 b0 = *reinterpret_cast<const bf16x8*>(kb + d0 * 2048);
    const bf16x8 b1 = *reinterpret_cast<const bf16x8*>(kb + d0 * 2048 + 512);
    if (d0 == 0) { p0 = __builtin_amdgcn_mfma_f32_32x32x16_bf16(b0, qr[0], negm, 0, 0, 0); p1 = __builtin_amdgcn_mfma_f32_32x32x16_bf16(b1, qr[0], negm, 0, 0, 0); }
    else { p0 = __builtin_amdgcn_mfma_f32_32x32x16_bf16(b0, qr[d0], p0, 0, 0, 0); p1 = __builtin_amdgcn_mfma_f32_32x32x16_bf16(b1, qr[d0], p1, 0, 0, 0); } }
}
typedef short v4i16_t __attribute__((ext_vector_type(4)));
__device__ __forceinline__ void kload8(bf16x8* kf, lds_cptr kp) {
  kf[0] = *(const LAS bf16x8*)(kp);        kf[1] = *(const LAS bf16x8*)(kp + 512);
  kf[2] = *(const LAS bf16x8*)(kp + 2048); kf[3] = *(const LAS bf16x8*)(kp + 2560);
  kf[4] = *(const LAS bf16x8*)(kp + 4096); kf[5] = *(const LAS bf16x8*)(kp + 4608);
  kf[6] = *(const LAS bf16x8*)(kp + 6144); kf[7] = *(const LAS bf16x8*)(kp + 6656);
}
__device__ __forceinline__ void kload2(bf16x8* kf, lds_cptr kp, int j) { kf[2 * j] = *(const LAS bf16x8*)(kp + j * 2048); kf[2 * j + 1] = *(const LAS bf16x8*)(kp + j * 2048 + 512); }
__device__ __forceinline__ s16x4 vtr(lds_cptr p) { return __builtin_bit_cast(s16x4, __builtin_amdgcn_ds_read_tr16_b64_v4i16((LAS v4i16_t*)p)); }
__device__ __forceinline__ float rowmax(const f32x16& p0, const f32x16& p1) {
  float a = max3f(p0[0], p0[1], p1[0]), b = max3f(p0[2], p0[3], p1[1]); a = max3f(a, p1[2], p1[3]);
  #pragma unroll
  for (int r = 4; r < 16; r += 4) { a = max3f(a, p0[r], p0[r + 1]); b = max3f(b, p0[r + 2], p0[r + 3]); a = max3f(a, p1[r], p1[r + 1]); b = max3f(b, p1[r + 2], p1[r + 3]); }
  const float m = max2f(a, b);
  auto rr = __builtin_amdgcn_permlane32_swap(__float_as_uint(m), __float_as_uint(m), false, false);
  return max2f(__uint_as_float(rr[0]), __uint_as_float(rr[1]));
}
__device__ __forceinline__ void pv(f32x16* o, int vb, bf16x8 pa0, bf16x8 pa1, bf16x8 pa2, bf16x8 pa3) {
  #pragma unroll
  for (int d0 = 0; d0 < 2; ++d0) { s16x4 lo[4], hi[4];
    #pragma unroll
    for (int ks = 0; ks < 4; ++ks) {
      asm volatile("ds_read_b64_tr_b16 %0,%1 offset:%c2" : "=&v"(lo[ks]) : "v"(vb), "i"(d0 * 4096 + ks * 1024) : "memory");
      asm volatile("ds_read_b64_tr_b16 %0,%1 offset:%c2" : "=&v"(hi[ks]) : "v"(vb), "i"(d0 * 4096 + ks * 1024 + 512) : "memory"); }
    asm volatile("s_waitcnt lgkmcnt(0)" ::: "memory"); SBAR();
    #define PK(k) (bf16x8){lo[k][0], lo[k][1], lo[k][2], lo[k][3], hi[k][0], hi[k][1], hi[k][2], hi[k][3]}
    o[d0] = __builtin_amdgcn_mfma_f32_32x32x16_bf16(pa0, PK(0), o[d0], 0, 0, 0);
    o[d0] = __builtin_amdgcn_mfma_f32_32x32x16_bf16(pa1, PK(1), o[d0], 0, 0, 0);
    o[d0] = __builtin_amdgcn_mfma_f32_32x32x16_bf16(pa2, PK(2), o[d0], 0, 0, 0);
    o[d0] = __builtin_amdgcn_mfma_f32_32x32x16_bf16(pa3, PK(3), o[d0], 0, 0, 0);
    #undef PK
  }
}

__device__ __forceinline__ float opq(float x) { asm("" : "+v"(x)); return x; }
template <int MODE> __device__ __forceinline__ void score_hook(f32x16& c0, f32x16& c1, int t, const AttnArgs& a, int qrel, int hi, int wid, int r32, float mh) {
  if constexpr (MODE == MA) {
    const int wlo = a.q0 + wid * QBLK, sd = (64 * t + 63 < wlo) ? 1 : ((64 * t > wlo + 31) ? -1 : 0);
    if (sd != 0) { const float sv = (float)sd * a.s2;
      #pragma unroll
      for (int r = 0; r < 16; ++r) { const float kf = (float)((r & 3) + 8 * (r >> 2)); c0[r] = opq(fmaf(kf, sv, c0[r])); c1[r] = opq(fmaf(kf + 32.f, sv, c1[r])); if ((r & 3) == 3) __builtin_amdgcn_sched_barrier(0); }
    } else {
      const float dq = (float)(a.q0 + qrel - 64 * t - 4 * hi), ns = -a.s2;
      #pragma unroll
      for (int r = 0; r < 16; ++r) { const float kf = (float)((r & 3) + 8 * (r >> 2)); c0[r] = opq(fmaf(ns, fabsf(opq(dq - kf)), c0[r])); c1[r] = opq(fmaf(ns, fabsf(opq(dq - (kf + 32.f))), c1[r])); if ((r & 1) == 1) __builtin_amdgcn_sched_barrier(0); }
    }
  }
  if constexpr (MODE == MB) {
    const bool tv = (t >= a.tlo) && (t <= a.thi);
    const float dq = (float)(qrel + 64 - 64 * t - 4 * hi), ns = -a.s2;
    #pragma unroll
    for (int r = 0; r < 16; ++r) { const float kf = (float)((r & 3) + 8 * (r >> 2)); const float d0 = fabsf(opq(dq - kf)), d1 = fabsf(opq(dq - (kf + 32.f)));
      const float v0_ = opq(fmaf(ns, d0, opq(c0[r] - mh))), v1_ = opq(fmaf(ns, d1, opq(c1[r] - mh)));
      c0[r] = (tv && d0 <= 64.f) ? v0_ : -INFINITY; c1[r] = (tv && d1 <= 64.f) ? v1_ : -INFINITY;
      if ((r & 3) == 3) __builtin_amdgcn_sched_barrier(0); }
  }
  if constexpr (MODE == MC) {
    const int qrow = a.q0 + (wid >> 1), rs = min(max(qrow - 4, 0), 120), krow = a.kb + t;
    if (krow < rs || krow >= rs + 8) {
      #pragma unroll
      for (int r = 0; r < 16; ++r) { c0[r] = -INFINITY; c1[r] = -INFINITY; }
    } else {
      const int qc = (wid & 1) * 32 + r32, cs = min(max(qc - 8, 0), 48);
      const lds_fptr tp = a.tab + (krow - qrow + 7) * 31 + (15 - qc + 4 * hi);
      const int kd = 4 * hi - cs;
      #pragma unroll
      for (int r = 0; r < 16; ++r) { const int kc = (r & 3) + 8 * (r >> 2);
        const float b0 = tp[kc], b1 = tp[kc + 32];
        const float v0_ = opq(c0[r] + opq(b0 - mh)), v1_ = opq(c1[r] + opq(b1 - mh));
        c0[r] = ((unsigned)(kd + kc) < 16u) ? v0_ : -INFINITY; c1[r] = ((unsigned)(kd + kc + 32) < 16u) ? v1_ : -INFINITY;
        if ((r & 3) == 3) __builtin_amdgcn_sched_barrier(0); }
    }
  }
}

template <int MODE, int THRL> __device__ __forceinline__ void attn_unit(const AttnArgs& A_, char* shm) {
  int tid_ = threadIdx.x; asm volatile("" : "+v"(tid_));
  const int tid = tid_, lane = tid & 63, r32 = lane & 31, hi = lane >> 5; const int wid = __builtin_amdgcn_readfirstlane(tid >> 6);
  const bf16* Qw = A_.Q + (wid * QBLK) * A_.qs;
  const unsigned lds0 = (unsigned)(uintptr_t)shm;
  float* wsf = (float*)(shm + LDS_WS) + wid * 64;
  const int ks = A_.ks;
  const bf16* ksrc = A_.K + (lane * ks + wid * 8);
  const bf16* vsrc = A_.V + ((16 * (wid & 3) + (lane >> 2)) * ks + (wid >> 2) * 32 + (lane & 3) * 8);
  const unsigned kdst = lds0 + LDS_K + wid * 1024, vdst = lds0 + LDS_V + wid * 1024;
  #define TT(t) ((MODE == MB) ? min(max((int)(t), A_.tlo), A_.thi) : (int)(t))
  #define DMA_K(t, slot) glds16(ksrc + TT(t) * KVBLK * ks, (unsigned)__builtin_amdgcn_readfirstlane(kdst + (slot)))
  #define DMA_V(t, slot) glds16(vsrc + TT(t) * KVBLK * ks, (unsigned)__builtin_amdgcn_readfirstlane(vdst + (slot)))
  const int vb0 = (int)(lds0 + LDS_V) + ((lane >> 4) & 1) * 32 + (lane & 3) * 8 + (4 * hi + ((lane & 15) >> 2)) * 64;
  const char* Kbase = shm + LDS_K; bf16x8 kf[8];
  const lds_cptr shm3 = (lds_cptr)shm; const lds_cptr kp0 = shm3 + LDS_K + hi * 1024 + r32 * 16; const lds_cptr vp0 = shm3 + LDS_V + ((lane >> 4) & 1) * 32 + (lane & 3) * 8 + (4 * hi + ((lane & 15) >> 2)) * 64;
  const int NT = A_.NT;
  DMA_K(0, 0); DMA_V(0, 0); DMA_K(1, SLOTB);
  bf16x8 qr[4];
  #pragma unroll
  for (int d0 = 0; d0 < 4; ++d0) qr[d0] = *reinterpret_cast<const bf16x8*>(&Qw[r32 * A_.qs + d0 * 16 + hi * 8]);
  if constexpr (MODE == MD) {
    float x[4][8]; float ssq = 0.f;
    #pragma unroll
    for (int d0 = 0; d0 < 4; ++d0)
      #pragma unroll
      for (int j = 0; j < 8; ++j) { x[d0][j] = __uint_as_float((unsigned)(unsigned short)qr[d0][j] << 16); ssq += x[d0][j] * x[d0][j]; }
    { auto rr = __builtin_amdgcn_permlane32_swap(__float_as_uint(ssq), __float_as_uint(ssq), false, false); ssq = __uint_as_float(rr[0]) + __uint_as_float(rr[1]); }
    const float rn = rsqrtf(ssq * (1.f / 64.f) + EPS) * C2;
    const int spos = A_.q0 + wid * QBLK + r32; const float prow = (float)(spos >> 6), pcol = (float)(spos & 63);
    #pragma unroll
    for (int j = 0; j < 8; ++j) { const float inv = exp2f(-(float)(8 * hi + j) * 0.8304820237218406f);
      float sr, cr, sc_, cc_; sincos_red(prow * inv, sr, cr); sincos_red(pcol * inv, sc_, cc_);
      const float g0 = A_.gq[8 * hi + j], g1 = A_.gq[16 + 8 * hi + j], g2 = A_.gq[32 + 8 * hi + j], g3 = A_.gq[48 + 8 * hi + j];
      const float y0 = x[0][j] * rn * g0, y1 = x[1][j] * rn * g1, y2 = x[2][j] * rn * g2, y3 = x[3][j] * rn * g3;
      x[0][j] = y0 * cr - y1 * sr; x[1][j] = y1 * cr + y0 * sr; x[2][j] = y2 * cc_ - y3 * sc_; x[3][j] = y3 * cc_ + y2 * sc_; }
    #pragma unroll
    for (int d0 = 0; d0 < 4; ++d0) { u32x4 w; w.x = pk2(x[d0][0], x[d0][1]); w.y = pk2(x[d0][2], x[d0][3]); w.z = pk2(x[d0][4], x[d0][5]); w.w = pk2(x[d0][6], x[d0][7]); qr[d0] = __builtin_bit_cast(bf16x8, w); }
  }
  float mhat = 0.f, l_reg = 0.f; f32x16 o[2]; o[0] = f32x16{}; o[1] = f32x16{}; f32x16 negm = f32x16{}; asm volatile("" : "+v"(negm));
  const int qrel = wid * QBLK + r32;
  constexpr bool NEGM = (MODE == MA || MODE == MD);
  #define CIN (NEGM ? negm : f32x16{})
  #define NEGM_SET(tn) do { float nb_ = -mhat; \
      if (MODE == MA) { const int wlo_ = A_.q0 + wid * QBLK, sd_ = (64 * (tn) + 63 < wlo_) ? 1 : ((64 * (tn) > wlo_ + 31) ? -1 : 0); \
        if (sd_ != 0) nb_ = fmaf(-(float)sd_ * A_.s2, (float)(A_.q0 + qrel - 64 * (tn) - 4 * hi), nb_); } \
      _Pragma("unroll") for (int r = 0; r < 16; ++r) negm[r] = nb_; asm volatile("" : "+v"(negm)); } while (0)
  #define CMASK(P0, P1, t) score_hook<MODE>(P0, P1, (t), A_, qrel, hi, wid, r32, mhat)
  bool resc = false;
  #define START(P0, P1) do { const float rm = rowmax(P0, P1); resc = false; \
    { const float dl = (MODE == MB || MODE == MC) ? fmaxf(rm, -2048.f) : rm; mhat = fadd_s(mhat, dl); \
      _Pragma("unroll") for (int r = 0; r < 16; ++r) { P0[r] = fsub_s(P0[r], dl); P1[r] = fsub_s(P1[r], dl); } \
      if (NEGM) { NEGM_SET(1); } } \
    _Pragma("unroll") for (int r = 0; r < 16; ++r) P0[r] = __builtin_amdgcn_exp2f(P0[r]); } while (0)
  #define RESC() do { if (resc) { asm volatile("s_waitcnt lgkmcnt(0)" ::: "memory"); \
      _Pragma("unroll") for (int d_ = 0; d_ < 2; ++d_) _Pragma("unroll") for (int r = 0; r < 16; ++r) o[d_][r] *= wsf[crow(r, hi)]; } } while (0)
  f32x16 pA0, pA1, pB0, pB1;
  int sl_prev = 0, sl_cur = 0, sl_next = SLOTB;
  #define ROT() do { sl_prev = sl_cur; sl_cur = sl_next; sl_next = (sl_next == (NSLOT - 1) * SLOTB) ? 0 : sl_next + SLOTB; } while (0)
  DMA_K(2, 2 * SLOTB);
  if (MODE == MA) { NEGM_SET(0); }
  WAIT_BAR(3);
  qkt(pA0, pA1, Kbase, qr, negm, r32, hi); asm volatile("s_nop 15\n\ts_nop 7" : "+v"(pA0), "+v"(pA1)); CMASK(pA0, pA1, 0);
  START(pA0, pA1);
  _Pragma("unroll") for (int r = 0; r < 16; ++r) pA1[r] = __builtin_amdgcn_exp2f(pA1[r]);
  WAIT_BAR(0);
  DMA_K(3, 0); DMA_V(1, SLOTB);
  ROT();
  kload8(kf, kp0 + sl_cur);
  WAIT_BAR(2);
  s16x4 vlo[8], vhi[8]; u32x4 pw0, pw1, pw2, pw3;
  #define PKW(P, B) cvtpk_s(P[B], P[B + 1])
  #define PAF(k) __builtin_bit_cast(bf16x8, pw##k)
  #define VFR(i) (bf16x8){vlo[i][0], vlo[i][1], vlo[i][2], vlo[i][3], vhi[i][0], vhi[i][1], vhi[i][2], vhi[i][3]}
  #define PIN(x) asm volatile("" : "+v"(x))
  #define MX3(a, b, c) __builtin_fmaxf(__builtin_fmaxf((a), (b)), (c))
  #define GAPA(MF, A0, A1, A2, A3, W0, W1, PW) do { MF; sacc += A0; sacc += A1; sacc += A2; sacc += A3; PIN(sacc); W0; W1; PIN(PW); SBAR(); } while (0)
  #define EX(v) __builtin_amdgcn_exp2f(v)
  #define GAPB(MF, X, B) do { MF; X[B] = EX(X[B]); X[B + 1] = EX(X[B + 1]); X[B + 2] = EX(X[B + 2]); X[B + 3] = EX(X[B + 3]); PIN(X); SBAR(); } while (0)
  #define VRD(i) do { vlo[i] = vtr(vp_ + (((i) >> 2) * 4096 + ((i) & 3) * 1024)); vhi[i] = vtr(vp_ + (((i) >> 2) * 4096 + ((i) & 3) * 1024 + 512)); } while (0)
  #define KRD(G, j) do { if (G) { kload2(kf, kp0 + sl_next, j); SBAR(); } } while (0)
  #define STEP(C0, C1, P0, P1, t, GK, GV, GL) do { SBAR(); \
    const lds_cptr vp_ = vp0 + sl_prev; \
    VRD(0); SBAR(); float sacc = (P0[0] + P0[1]); \
    GAPA(C0 = __builtin_amdgcn_mfma_f32_32x32x16_bf16(kf[0], qr[0], CIN, 0, 0, 0), P0[2], P0[3], P0[4], P0[5],     pw0[0] = PKW(P0, 0), pw0[1] = PKW(P0, 2), pw0); \
    VRD(4); SBAR(); GAPA(C1 = __builtin_amdgcn_mfma_f32_32x32x16_bf16(kf[1], qr[0], CIN, 0, 0, 0), P0[6], P0[7], P0[8], P0[9],     pw0[2] = PKW(P0, 4), pw0[3] = PKW(P0, 6), pw0); \
    VRD(1); SBAR(); GAPA(C0 = __builtin_amdgcn_mfma_f32_32x32x16_bf16(kf[2], qr[1], C0, 0, 0, 0),   P0[10], P0[11], P0[12], P0[13], pw1[0] = PKW(P0, 8), pw1[1] = PKW(P0, 10), pw1); \
    VRD(5); SBAR(); GAPA(C1 = __builtin_amdgcn_mfma_f32_32x32x16_bf16(kf[3], qr[1], C1, 0, 0, 0),   P0[14], P0[15], P1[0], P1[1],   pw1[2] = PKW(P0, 12), pw1[3] = PKW(P0, 14), pw1); \
    VRD(2); SBAR(); GAPA(C0 = __builtin_amdgcn_mfma_f32_32x32x16_bf16(kf[4], qr[2], C0, 0, 0, 0),   P1[2], P1[3], P1[4], P1[5],     pw2[0] = PKW(P1, 0), pw2[1] = PKW(P1, 2), pw2); \
    VRD(6); SBAR(); GAPA(C1 = __builtin_amdgcn_mfma_f32_32x32x16_bf16(kf[5], qr[2], C1, 0, 0, 0),   P1[6], P1[7], P1[8], P1[9],     pw2[2] = PKW(P1, 4), pw2[3] = PKW(P1, 6), pw2); \
    VRD(3); SBAR(); GAPA(C0 = __builtin_amdgcn_mfma_f32_32x32x16_bf16(kf[6], qr[3], C0, 0, 0, 0),   P1[10], P1[11], P1[12], P1[13], pw3[0] = PKW(P1, 8), pw3[1] = PKW(P1, 10), pw3); \
    VRD(7); SBAR(); GAPA(C1 = __builtin_amdgcn_mfma_f32_32x32x16_bf16(kf[7], qr[3], C1, 0, 0, 0),   P1[14], P1[15], 0.f, 0.f,       pw3[2] = PKW(P1, 12), pw3[3] = PKW(P1, 14), pw3); \
    l_reg += sacc; \
    if (GK) { DMA_K((t) + 3, sl_cur); } if (GV) { DMA_V((t) + 1, sl_next); } \
    CMASK(C0, C1, t); \
    { float a = MX3(C0[0], C0[1], C1[0]), b = MX3(C0[2], C0[3], C1[1]); a = MX3(a, C1[2], C1[3]); \
      _Pragma("unroll") for (int r = 4; r < 16; r += 4) { a = MX3(a, C0[r], C0[r + 1]); b = MX3(b, C0[r + 2], C0[r + 3]); a = MX3(a, C1[r], C1[r + 1]); b = MX3(b, C1[r + 2], C1[r + 3]); } \
      float rm = __builtin_fmaxf(a, b); { auto rr = __builtin_amdgcn_permlane32_swap(__float_as_uint(rm), __float_as_uint(rm), false, false); rm = __builtin_fmaxf(__uint_as_float(rr[0]), __uint_as_float(rr[1])); } \
      resc = false; \
      if (__builtin_expect(__any(rm > (float)THRL), 0)) { const float dl = __builtin_fmaxf(rm, 0.f); mhat += dl; \
        _Pragma("unroll") for (int r = 0; r < 16; ++r) { C0[r] -= dl; C1[r] -= dl; } \
        if (MODE == MD) { NEGM_SET(0); } \
        const float f = __builtin_amdgcn_exp2f(-dl); l_reg *= f; if (hi == 0) wsf[r32] = f; resc = true; } \
      if (MODE == MA) { NEGM_SET((t) + 1); } } \
    SBAR(); \
    GAPB(o[0] = __builtin_amdgcn_mfma_f32_32x32x16_bf16(PAF(0), VFR(0), o[0], 0, 0, 0), C0, 0); \
    GAPB(o[1] = __builtin_amdgcn_mfma_f32_32x32x16_bf16(PAF(0), VFR(4), o[1], 0, 0, 0), C0, 4); \
    KRD(GL, 0); GAPB(o[0] = __builtin_amdgcn_mfma_f32_32x32x16_bf16(PAF(1), VFR(1), o[0], 0, 0, 0), C0, 8); \
    KRD(GL, 1); GAPB(o[1] = __builtin_amdgcn_mfma_f32_32x32x16_bf16(PAF(1), VFR(5), o[1], 0, 0, 0), C0, 12); \
    KRD(GL, 2); GAPB(o[0] = __builtin_amdgcn_mfma_f32_32x32x16_bf16(PAF(2), VFR(2), o[0], 0, 0, 0), C1, 0); \
    KRD(GL, 3); GAPB(o[1] = __builtin_amdgcn_mfma_f32_32x32x16_bf16(PAF(2), VFR(6), o[1], 0, 0, 0), C1, 4); \
    GAPB(o[0] = __builtin_amdgcn_mfma_f32_32x32x16_bf16(PAF(3), VFR(3), o[0], 0, 0, 0), C1, 8); \
    GAPB(o[1] = __builtin_amdgcn_mfma_f32_32x32x16_bf16(PAF(3), VFR(7), o[1], 0, 0, 0), C1, 12); \
    } while (0)
  int t = 1;
  for (; t + 5 < NT; t += 2) {
    STEP(pB0, pB1, pA0, pA1, t, true, true, true);     WAIT_BAR(2); RESC(); ROT();
    STEP(pA0, pA1, pB0, pB1, t + 1, true, true, true); WAIT_BAR(2); RESC(); ROT();
  }
  #define ENDW(tt) do { if ((tt) + 3 < NT) { WAIT_BAR(2); } else if ((tt) + 2 < NT) { WAIT_BAR(1); } else { WAIT_BAR(0); } } while (0)
  for (; t + 1 < NT; t += 2) {
    STEP(pB0, pB1, pA0, pA1, t, (t + 3 < NT), (t + 1 < NT), (t + 1 < NT));         ENDW(t);     RESC(); ROT();
    STEP(pA0, pA1, pB0, pB1, t + 1, (t + 4 < NT), (t + 2 < NT), (t + 2 < NT));     ENDW(t + 1); RESC(); ROT();
  }
  STEP(pB0, pB1, pA0, pA1, NT - 1, false, false, false); RESC();
  { float sacc = pB0[0] + pB0[1]; _Pragma("unroll") for (int r = 2; r < 16; ++r) sacc += pB0[r]; _Pragma("unroll") for (int r = 0; r < 16; ++r) sacc += pB1[r]; l_reg += sacc;
    pw0 = (u32x4){PKW(pB0, 0), PKW(pB0, 2), PKW(pB0, 4), PKW(pB0, 6)}; pw1 = (u32x4){PKW(pB0, 8), PKW(pB0, 10), PKW(pB0, 12), PKW(pB0, 14)}; pw2 = (u32x4){PKW(pB1, 0), PKW(pB1, 2), PKW(pB1, 4), PKW(pB1, 6)}; pw3 = (u32x4){PKW(pB1, 8), PKW(pB1, 10), PKW(pB1, 12), PKW(pB1, 14)};
    SBAR(); pv(o, vb0 + sl_cur, PAF(0), PAF(1), PAF(2), PAF(3)); }
  #undef PKW
  #undef PAF
  #undef VFR
  #undef PIN
  #undef MX3
  #undef GAPA
  #undef GAPB
  #undef EX
  #undef VRD
  #undef KRD
  #undef STEP
  #undef ENDW
  { auto rr = __builtin_amdgcn_permlane32_swap(__float_as_uint(l_reg), __float_as_uint(l_reg), false, false); l_reg = __uint_as_float(rr[0]) + __uint_as_float(rr[1]); }
  if (MODE == MB) { if (hi == 0) { float* sp = A_.stat + (wid * QBLK + r32) * A_.ss; sp[0] = mhat; sp[1] = l_reg; } }
  if (hi == 0) wsf[32 + r32] = l_reg; asm volatile("s_waitcnt lgkmcnt(0)" ::: "memory");
  float rli[16];
  #pragma unroll
  for (int r = 0; r < 16; ++r) rli[r] = __builtin_amdgcn_rcpf(wsf[32 + crow(r, hi)]);
  bf16* Ow = A_.O + (wid * QBLK) * A_.os;
  { bf16* stg = (bf16*)(shm + LDS_OST) + wid * 2048;
    #pragma unroll
    for (int r = 0; r < 16; ++r) { const int orow = crow(r, hi);
      #pragma unroll
      for (int d0 = 0; d0 < 2; ++d0) stg[orow * 64 + d0 * 32 + r32] = __float2bfloat16(o[d0][r] * rli[r]); }
    asm volatile("s_waitcnt lgkmcnt(0)" ::: "memory");
    #pragma unroll
    for (int i = 0; i < 4; ++i) { const int row = i * 8 + (lane >> 3), ch = lane & 7; const u32x4 v = *(const u32x4*)(stg + row * 64 + ch * 8); *(u32x4*)(Ow + row * A_.os + ch * 8) = v; } }
  asm volatile("s_waitcnt lgkmcnt(0)\n\ts_barrier" ::: "memory");
  #undef DMA_K
  #undef DMA_V
  #undef TT
  #undef CMASK
  #undef CIN
  #undef NEGM_SET
  #undef START
  #undef RESC
  #undef ROT
}

constexpr int L8_K = 0, L8_V = 3 * 8192, L8_WS = L8_V + 3 * 16384, L8_QO = L8_WS + 2048, L8_END = L8_QO + 8 * 4096;
template <int THRL> __device__ __forceinline__ void attn_unit128(const AttnArgs& A_, char* shm) {
  int tid_ = threadIdx.x; asm volatile("" : "+v"(tid_));
  const int tid = tid_, lane = tid & 63, r32 = lane & 31, hi = lane >> 5; const int wid = __builtin_amdgcn_readfirstlane(tid >> 6);
  const bf16* Qw = A_.Q + (wid * QBLK) * A_.qs;
  const unsigned lds0 = (unsigned)(uintptr_t)shm;
  float* wsf = (float*)(shm + L8_WS) + wid * 64;
  const int ks = A_.ks;
  const bf16* ksrc = A_.K + (lane * ks + wid * 8);
  const bf16* vsrc = A_.V + ((16 * (wid & 3) + (lane >> 2)) * ks + (wid >> 2) * 32 + (lane & 3) * 8);
  const unsigned kdst = lds0 + L8_K + wid * 1024, vdst = lds0 + L8_V + wid * 1024;
  #define DMA_K(t, slot) glds16(ksrc + (int)(t) * KVBLK * ks, (unsigned)__builtin_amdgcn_readfirstlane(kdst + (slot)))
  #define DMA_V(t, slot) do { glds16(vsrc + (int)(t) * KVBLK * ks, (unsigned)__builtin_amdgcn_readfirstlane(vdst + 2 * (slot))); \
                              glds16(vsrc + (int)(t) * KVBLK * ks + 64, (unsigned)__builtin_amdgcn_readfirstlane(vdst + 2 * (slot) + 8192)); } while (0)
  const int vb0 = (int)(lds0 + L8_V) + ((lane >> 4) & 1) * 32 + (lane & 3) * 8 + (4 * hi + ((lane & 15) >> 2)) * 64;
  const char* Kbase = shm + L8_K; bf16x8 kf[8];
  const lds_cptr shm3 = (lds_cptr)shm; const lds_cptr kp0 = shm3 + L8_K + hi * 1024 + r32 * 16; const lds_cptr vp0 = shm3 + L8_V + ((lane >> 4) & 1) * 32 + (lane & 3) * 8 + (4 * hi + ((lane & 15) >> 2)) * 64;
  const lds_cptr qst = shm3 + L8_QO + wid * 4096 + lane * 16;
  const int NT = A_.NT;
  DMA_K(0, 0); DMA_V(0, 0); DMA_K(1, SLOTB);
  { bf16x8 qr[4];
    #pragma unroll
    for (int d0 = 0; d0 < 4; ++d0) qr[d0] = *reinterpret_cast<const bf16x8*>(&Qw[r32 * A_.qs + d0 * 16 + hi * 8]);
    #pragma unroll
    for (int d0 = 0; d0 < 4; ++d0) *(LAS bf16x8*)(shm3 + L8_QO + wid * 4096 + lane * 16 + d0 * 1024) = qr[d0]; }
  #define QLD(d0) (*(const LAS bf16x8*)(qst + (d0) * 1024))
  float mhat = 0.f, l_reg = 0.f; f32x16 o[4]; o[0] = f32x16{}; o[1] = f32x16{}; o[2] = f32x16{}; o[3] = f32x16{};
  const int qrel = wid * QBLK + r32;
  #define NB(tn) ({ float nb_ = -mhat; const int wlo_ = A_.q0 + wid * QBLK, sd_ = (64 * (tn) + 63 < wlo_) ? 1 : ((64 * (tn) > wlo_ + 31) ? -1 : 0); \
      if (sd_ != 0) nb_ = fmaf(-(float)sd_ * A_.s2, (float)(A_.q0 + qrel - 64 * (tn) - 4 * hi), nb_); nb_; })
  #define CMASK(P0, P1, t) score_hook<MA>(P0, P1, (t), A_, qrel, hi, wid, r32, mhat)
  bool resc = false;
  #define RESC() do { if (resc) { asm volatile("s_waitcnt lgkmcnt(0)" ::: "memory"); \
      _Pragma("unroll") for (int d_ = 0; d_ < 4; ++d_) _Pragma("unroll") for (int r = 0; r < 16; ++r) o[d_][r] *= wsf[crow(r, hi)]; } } while (0)
  f32x16 pA0, pA1, pB0, pB1;
  int sl_prev = 0, sl_cur = 0, sl_next = SLOTB;
  #define ROT() do { sl_prev = sl_cur; sl_cur = sl_next; sl_next = (sl_next == (NSLOT - 1) * SLOTB) ? 0 : sl_next + SLOTB; } while (0)
  DMA_K(2, 2 * SLOTB);
  WAIT_BAR(4);
  { f32x16 cin; const float nb0 = NB(0);
    #pragma unroll
    for (int r = 0; r < 16; ++r) cin[r] = nb0;
    bf16x8 qr[4];
    #pragma unroll
    for (int d0 = 0; d0 < 4; ++d0) qr[d0] = QLD(d0);
    qkt(pA0, pA1, Kbase, qr, cin, r32, hi); }
  asm volatile("s_nop 15\n\ts_nop 7" : "+v"(pA0), "+v"(pA1)); CMASK(pA0, pA1, 0);
  { const float rm = rowmax(pA0, pA1); mhat = fadd_s(mhat, rm);
    #pragma unroll
    for (int r = 0; r < 16; ++r) { pA0[r] = fsub_s(pA0[r], rm); pA1[r] = fsub_s(pA1[r], rm); }
    #pragma unroll
    for (int r = 0; r < 16; ++r) pA0[r] = __builtin_amdgcn_exp2f(pA0[r]);
    #pragma unroll
    for (int r = 0; r < 16; ++r) pA1[r] = __builtin_amdgcn_exp2f(pA1[r]); }
  WAIT_BAR(0);
  DMA_K(3, 0); DMA_V(1, SLOTB);
  ROT();
  kload8(kf, kp0 + sl_cur);
  WAIT_BAR(3);
  u32x4 pw0, pw1, pw2, pw3;
  #define PKW(P, B) cvtpk_s(P[B], P[B + 1])
  #define PAF(k) __builtin_bit_cast(bf16x8, pw##k)
  #define PIN(x) asm volatile("" : "+v"(x))
  #define MX3(a, b, c) __builtin_fmaxf(__builtin_fmaxf((a), (b)), (c))
  #define GAPA(MF, A0, A1, A2, A3, W0, W1, PW) do { MF; sacc += A0; sacc += A1; sacc += A2; sacc += A3; PIN(sacc); W0; W1; PIN(PW); SBAR(); } while (0)
  #define EX(v) __builtin_amdgcn_exp2f(v)
  #define GAPB(MF, X, B) do { MF; X[B] = EX(X[B]); X[B + 1] = EX(X[B + 1]); PIN(X); SBAR(); } while (0)
  #define KRD(G, j) do { if (G) { kload2(kf, kp0 + sl_next, j); SBAR(); } } while (0)
  #define FOFF(j) (((((j) & 1) + 2 * ((j) >> 3)) * 4096) + ((((j) >> 1) & 3) * 1024))
  #define FRD(j) do { fl[j] = vtr(vp_ + FOFF(j)); fh[j] = vtr(vp_ + FOFF(j) + 512); SBAR(); } while (0)
  #define FFR(j) (bf16x8){fl[j][0], fl[j][1], fl[j][2], fl[j][3], fh[j][0], fh[j][1], fh[j][2], fh[j][3]}
  #define STEP(C0, C1, P0, P1, t, GK, GV, GL) do { SBAR(); \
    const lds_cptr vp_ = vp0 + 2 * sl_prev; s16x4 fl[16], fh[16]; \
    { const float nb_t = NB(t); _Pragma("unroll") for (int r = 0; r < 16; ++r) { C0[r] = nb_t; C1[r] = nb_t; } } \
    bf16x8 q0_ = QLD(0), q1_ = QLD(1); SBAR(); float sacc = (P0[0] + P0[1]); \
    GAPA(C0 = __builtin_amdgcn_mfma_f32_32x32x16_bf16(kf[0], q0_, C0, 0, 0, 0), P0[2], P0[3], P0[4], P0[5],     pw0[0] = PKW(P0, 0), pw0[1] = PKW(P0, 2), pw0); \
    GAPA(C1 = __builtin_amdgcn_mfma_f32_32x32x16_bf16(kf[1], q0_, C1, 0, 0, 0), P0[6], P0[7], P0[8], P0[9],     pw0[2] = PKW(P0, 4), pw0[3] = PKW(P0, 6), pw0); \
    q0_ = QLD(2); SBAR(); \
    GAPA(C0 = __builtin_amdgcn_mfma_f32_32x32x16_bf16(kf[2], q1_, C0, 0, 0, 0),   P0[10], P0[11], P0[12], P0[13], pw1[0] = PKW(P0, 8), pw1[1] = PKW(P0, 10), pw1); \
    GAPA(C1 = __builtin_amdgcn_mfma_f32_32x32x16_bf16(kf[3], q1_, C1, 0, 0, 0),   P0[14], P0[15], P1[0], P1[1],   pw1[2] = PKW(P0, 12), pw1[3] = PKW(P0, 14), pw1); \
    q1_ = QLD(3); SBAR(); \
    GAPA(C0 = __builtin_amdgcn_mfma_f32_32x32x16_bf16(kf[4], q0_, C0, 0, 0, 0),   P1[2], P1[3], P1[4], P1[5],     pw2[0] = PKW(P1, 0), pw2[1] = PKW(P1, 2), pw2); \
    GAPA(C1 = __builtin_amdgcn_mfma_f32_32x32x16_bf16(kf[5], q0_, C1, 0, 0, 0),   P1[6], P1[7], P1[8], P1[9],     pw2[2] = PKW(P1, 4), pw2[3] = PKW(P1, 6), pw2); \
    GAPA(C0 = __builtin_amdgcn_mfma_f32_32x32x16_bf16(kf[6], q1_, C0, 0, 0, 0),   P1[10], P1[11], P1[12], P1[13], pw3[0] = PKW(P1, 8), pw3[1] = PKW(P1, 10), pw3); \
    GAPA(C1 = __builtin_amdgcn_mfma_f32_32x32x16_bf16(kf[7], q1_, C1, 0, 0, 0),   P1[14], P1[15], 0.f, 0.f,       pw3[2] = PKW(P1, 12), pw3[3] = PKW(P1, 14), pw3); \
    l_reg += sacc; \
    if (GK) { DMA_K((t) + 3, sl_cur); } if (GV) { DMA_V((t) + 1, sl_next); } \
    FRD(0); FRD(1); FRD(2); \
    CMASK(C0, C1, t); \
    { float a = MX3(C0[0], C0[1], C1[0]), b = MX3(C0[2], C0[3], C1[1]); a = MX3(a, C1[2], C1[3]); \
      _Pragma("unroll") for (int r = 4; r < 16; r += 4) { a = MX3(a, C0[r], C0[r + 1]); b = MX3(b, C0[r + 2], C0[r + 3]); a = MX3(a, C1[r], C1[r + 1]); b = MX3(b, C1[r + 2], C1[r + 3]); } \
      float rm = __builtin_fmaxf(a, b); { auto rr = __builtin_amdgcn_permlane32_swap(__float_as_uint(rm), __float_as_uint(rm), false, false); rm = __builtin_fmaxf(__uint_as_float(rr[0]), __uint_as_float(rr[1])); } \
      resc = false; \
      if (__builtin_expect(__any(rm > (float)THRL), 0)) { const float dl = __builtin_fmaxf(rm, 0.f); mhat += dl; \
        _Pragma("unroll") for (int r = 0; r < 16; ++r) { C0[r] -= dl; C1[r] -= dl; } \
        const float f = __builtin_amdgcn_exp2f(-dl); l_reg *= f; if (hi == 0) wsf[r32] = f; resc = true; } } \
    SBAR(); \
    GAPB(o[0] = __builtin_amdgcn_mfma_f32_32x32x16_bf16(PAF(0), FFR(0), o[0], 0, 0, 0), C0, 0);   FRD(3); \
    GAPB(o[1] = __builtin_amdgcn_mfma_f32_32x32x16_bf16(PAF(0), FFR(1), o[1], 0, 0, 0), C0, 2);   FRD(4); \
    GAPB(o[0] = __builtin_amdgcn_mfma_f32_32x32x16_bf16(PAF(1), FFR(2), o[0], 0, 0, 0), C0, 4);   FRD(5); \
    GAPB(o[1] = __builtin_amdgcn_mfma_f32_32x32x16_bf16(PAF(1), FFR(3), o[1], 0, 0, 0), C0, 6);   FRD(6); \
    GAPB(o[0] = __builtin_amdgcn_mfma_f32_32x32x16_bf16(PAF(2), FFR(4), o[0], 0, 0, 0), C0, 8);   FRD(7); \
    GAPB(o[1] = __builtin_amdgcn_mfma_f32_32x32x16_bf16(PAF(2), FFR(5), o[1], 0, 0, 0), C0, 10);  FRD(8); \
    GAPB(o[0] = __builtin_amdgcn_mfma_f32_32x32x16_bf16(PAF(3), FFR(6), o[0], 0, 0, 0), C0, 12);  FRD(9); \
    GAPB(o[1] = __builtin_amdgcn_mfma_f32_32x32x16_bf16(PAF(3), FFR(7), o[1], 0, 0, 0), C0, 14);  FRD(10); \
    KRD(GL, 0); GAPB(o[2] = __builtin_amdgcn_mfma_f32_32x32x16_bf16(PAF(0), FFR(8), o[2], 0, 0, 0), C1, 0);   FRD(11); \
    KRD(GL, 1); GAPB(o[3] = __builtin_amdgcn_mfma_f32_32x32x16_bf16(PAF(0), FFR(9), o[3], 0, 0, 0), C1, 2);   FRD(12); \
    KRD(GL, 2); GAPB(o[2] = __builtin_amdgcn_mfma_f32_32x32x16_bf16(PAF(1), FFR(10), o[2], 0, 0, 0), C1, 4);  FRD(13); \
    KRD(GL, 3); GAPB(o[3] = __builtin_amdgcn_mfma_f32_32x32x16_bf16(PAF(1), FFR(11), o[3], 0, 0, 0), C1, 6);  FRD(14); \
    GAPB(o[2] = __builtin_amdgcn_mfma_f32_32x32x16_bf16(PAF(2), FFR(12), o[2], 0, 0, 0), C1, 8);  FRD(15); \
    GAPB(o[3] = __builtin_amdgcn_mfma_f32_32x32x16_bf16(PAF(2), FFR(13), o[3], 0, 0, 0), C1, 10); \
    GAPB(o[2] = __builtin_amdgcn_mfma_f32_32x32x16_bf16(PAF(3), FFR(14), o[2], 0, 0, 0), C1, 12); \
    GAPB(o[3] = __builtin_amdgcn_mfma_f32_32x32x16_bf16(PAF(3), FFR(15), o[3], 0, 0, 0), C1, 14); \
    } while (0)
  int t = 1;
  for (; t + 5 < NT; t += 2) {
    STEP(pB0, pB1, pA0, pA1, t, true, true, true);     WAIT_BAR(3); RESC(); ROT();
    STEP(pA0, pA1, pB0, pB1, t + 1, true, true, true); WAIT_BAR(3); RESC(); ROT();
  }
  #define ENDW(tt) do { if ((tt) + 3 < NT) { WAIT_BAR(3); } else if ((tt) + 2 < NT) { WAIT_BAR(2); } else { WAIT_BAR(0); } } while (0)
  for (; t + 1 < NT; t += 2) {
    STEP(pB0, pB1, pA0, pA1, t, (t + 3 < NT), (t + 1 < NT), (t + 1 < NT));         ENDW(t);     RESC(); ROT();
    STEP(pA0, pA1, pB0, pB1, t + 1, (t + 4 < NT), (t + 2 < NT), (t + 2 < NT));     ENDW(t + 1); RESC(); ROT();
  }
  STEP(pB0, pB1, pA0, pA1, NT - 1, false, false, false); RESC();
  { float sacc = pB0[0] + pB0[1]; _Pragma("unroll") for (int r = 2; r < 16; ++r) sacc += pB0[r]; _Pragma("unroll") for (int r = 0; r < 16; ++r) sacc += pB1[r]; l_reg += sacc;
    pw0 = (u32x4){PKW(pB0, 0), PKW(pB0, 2), PKW(pB0, 4), PKW(pB0, 6)}; pw1 = (u32x4){PKW(pB0, 8), PKW(pB0, 10), PKW(pB0, 12), PKW(pB0, 14)}; pw2 = (u32x4){PKW(pB1, 0), PKW(pB1, 2), PKW(pB1, 4), PKW(pB1, 6)}; pw3 = (u32x4){PKW(pB1, 8), PKW(pB1, 10), PKW(pB1, 12), PKW(pB1, 14)};
    SBAR(); pv(o, vb0 + 2 * sl_cur, PAF(0), PAF(1), PAF(2), PAF(3)); pv(o + 2, vb0 + 2 * sl_cur + 8192, PAF(0), PAF(1), PAF(2), PAF(3)); }
  #undef PKW
  #undef PAF
  #undef PIN
  #undef MX3
  #undef GAPA
  #undef GAPB
  #undef EX
  #undef FOFF
  #undef FRD
  #undef FFR
  #undef KRD
  #undef STEP
  #undef ENDW
  { auto rr = __builtin_amdgcn_permlane32_swap(__float_as_uint(l_reg), __float_as_uint(l_reg), false, false); l_reg = __uint_as_float(rr[0]) + __uint_as_float(rr[1]); }
  if (hi == 0) wsf[32 + r32] = l_reg; asm volatile("s_waitcnt lgkmcnt(0)" ::: "memory");
  float rli[16];
  #pragma unroll
  for (int r = 0; r < 16; ++r) rli[r] = __builtin_amdgcn_rcpf(wsf[32 + crow(r, hi)]);
  bf16* Ow = A_.O + (wid * QBLK) * A_.os;
  { bf16* stg = (bf16*)(shm + L8_QO) + wid * 2048;
    #pragma unroll
    for (int hv = 0; hv < 2; ++hv) {
      #pragma unroll
      for (int r = 0; r < 16; ++r) { const int orow = crow(r, hi);
        #pragma unroll
        for (int d0 = 0; d0 < 2; ++d0) stg[orow * 64 + d0 * 32 + r32] = __float2bfloat16(o[2 * hv + d0][r] * rli[r]); }
      asm volatile("s_waitcnt lgkmcnt(0)" ::: "memory");
      #pragma unroll
      for (int i = 0; i < 4; ++i) { const int row = i * 8 + (lane >> 3), ch = lane & 7; const u32x4 v = *(const u32x4*)(stg + row * 64 + ch * 8); *(u32x4*)(Ow + row * A_.os + hv * 64 + ch * 8) = v; }
      asm volatile("s_waitcnt lgkmcnt(0)" ::: "memory"); } }
  asm volatile("s_waitcnt lgkmcnt(0)\n\ts_barrier" ::: "memory");
  #undef DMA_K
  #undef DMA_V
  #undef QLD
  #undef NB
  #undef CMASK
  #undef RESC
  #undef ROT
}
#undef SBAR
#undef WAIT_BAR
}

__device__ __forceinline__ void transpose_item(const float* W, int K, int N, bf16_t* WT, LAS float* scr, int item, int lane, const float* gk = nullptr) {
    const int nblk = N / 32, kb = item / nblk, nb = item % nblk, k0 = 64 * kb, n0 = 32 * nb;
#pragma unroll 8
    for (int i = 0; i < 32; ++i) { const int kk = 2 * i + (lane >> 5); const float gg = gk ? gk[k0 + kk] : 1.f; scr[kk * 33 + (lane & 31)] = W[(size_t)(k0 + kk) * N + n0 + (lane & 31)] * gg; }
    asm volatile("s_waitcnt lgkmcnt(0)" ::: "memory");
    const int c = lane & 7;
#pragma unroll
    for (int j = 0; j < 4; ++j) { const int n = (lane >> 3) + 8 * j; const LAS float* s = scr + (8 * c) * 33 + n;
        u32x4 o; o.x = pk2(s[0 * 33], s[1 * 33]); o.y = pk2(s[2 * 33], s[3 * 33]); o.z = pk2(s[4 * 33], s[5 * 33]); o.w = pk2(s[6 * 33], s[7 * 33]);
        *(u32x4*)(WT + (size_t)(n0 + n) * K + k0 + 8 * c) = o; }
    asm volatile("s_waitcnt lgkmcnt(0)" ::: "memory");
}
__device__ __forceinline__ void rms_row_bf16(const float* xrow, const float* g, bf16_t* orow, int lane) {
    const f32x4* xr = (const f32x4*)xrow + lane; const f32x4* gr = (const f32x4*)g + lane;
    f32x4 v[4]; float s = 0.f;
#pragma unroll
    for (int j = 0; j < 4; ++j) { v[j] = xr[64 * j]; s += (v[j].x * v[j].x + v[j].y * v[j].y) + (v[j].z * v[j].z + v[j].w * v[j].w); }
    const float rs = rsqrtf(wave_sum(s) * (1.f / DM) + EPS);
    u32x2* o8 = (u32x2*)orow + lane;
#pragma unroll
    for (int j = 0; j < 4; ++j) { const f32x4 gg = gr[64 * j]; u32x2 w; w.x = pk2(v[j].x * rs * gg.x, v[j].y * rs * gg.y); w.y = pk2(v[j].z * rs * gg.z, v[j].w * rs * gg.w); o8[64 * j] = w; }
}

#define XB_TMO      128
#define XB_XCNT(j)  (256  + 64 * (j))
#define XB_XSUB(j)  (1280 + 64 * (j))
#define XB_XGEN(j)  (2304 + 64 * (j))
#define XB_TOP      3328
#define XB_TOPGEN   3392
#define XCD_BAR_WORDS 3456
#define XB_SPIN_CAP (1u << 18)

__device__ __forceinline__ unsigned xb_ld(unsigned* p)              { return __hip_atomic_load(p, __ATOMIC_RELAXED, __HIP_MEMORY_SCOPE_AGENT); }
__device__ __forceinline__ unsigned xb_add(unsigned* p, unsigned v) { return __hip_atomic_fetch_add(p, v, __ATOMIC_RELAXED, __HIP_MEMORY_SCOPE_AGENT); }
__device__ __forceinline__ unsigned xb_xcc_id() { return (unsigned)__builtin_amdgcn_s_getreg((3 << 11) | 20) & 0xFu; }
#define XB_SPIN(cond, bar) do { unsigned _sp = 0; while (cond) { __builtin_amdgcn_s_sleep(1); \
    if ((++_sp & 255u) == 0u) { if (xb_ld(&(bar)[XB_TMO])) break; if (_sp > XB_SPIN_CAP) { atomicAdd(&(bar)[XB_TMO], 1u); break; } } } } while (0)

struct XcdBarrier {
    unsigned* bar; unsigned x;
    volatile LAS unsigned* st;
};

__device__ __forceinline__ XcdBarrier xcd_barrier_post(unsigned* bar, volatile LAS unsigned* st) {
    XcdBarrier b; b.bar = bar; b.x = xb_xcc_id(); b.st = st;
    if (threadIdx.x == 0) (void)xb_add(&bar[XB_XCNT(b.x)], 1u);
    return b;
}
__device__ __forceinline__ void xcd_barrier_complete(unsigned* bar, unsigned x, unsigned& nloc, unsigned& nx) {
    const unsigned G = gridDim.x * gridDim.y * gridDim.z;
    unsigned sum, cnt, mine, sp = 0u;
    for (;;) {
        sum = 0u; cnt = 0u; mine = 0u;
#pragma unroll
        for (unsigned j = 0; j < 16; ++j) { const unsigned c = xb_ld(&bar[XB_XCNT(j)]); sum += c; cnt += (c > 0u) ? 1u : 0u; mine = (j == x) ? c : mine; }
        if (sum == G) break;
        __builtin_amdgcn_s_sleep(1);
        if ((++sp & 255u) == 0u) { if (xb_ld(&bar[XB_TMO])) break; if (sp > XB_SPIN_CAP) { atomicAdd(&bar[XB_TMO], 1u); break; } }
    }
    nloc = mine > 0u ? mine : 1u; nx = cnt > 0u ? cnt : 1u;
}

__device__ __forceinline__ void xcd_barrier(const XcdBarrier& b) {
    asm volatile("s_waitcnt vmcnt(0)" ::: "memory");
    __syncthreads();
    if (threadIdx.x == 0) {
        unsigned* bar = b.bar;
        __builtin_amdgcn_s_waitcnt(0);
        unsigned nloc = b.st[0], nx = b.st[1];
        if (nloc == 0u) { xcd_barrier_complete(bar, b.x, nloc, nx); b.st[0] = nloc; b.st[1] = nx; }
        const unsigned old = xb_add(&bar[XB_XSUB(b.x)], 1u);
        const unsigned gen = old / nloc;
        if (old + 1u == (gen + 1u) * nloc) {
            __builtin_amdgcn_fence(__ATOMIC_RELEASE, "agent");
            asm volatile("s_waitcnt vmcnt(0)" ::: "memory");
            const unsigned og = xb_add(&bar[XB_TOP], 1u);
            const unsigned tg = og / nx;
            if (og + 1u == (tg + 1u) * nx) xb_add(&bar[XB_TOPGEN], 1u);
            else XB_SPIN(xb_ld(&bar[XB_TOPGEN]) == tg, bar);
            __builtin_amdgcn_fence(__ATOMIC_ACQUIRE, "agent");
            xb_add(&bar[XB_XGEN(b.x)], 1u);
            asm volatile("s_waitcnt vmcnt(0)" ::: "memory");
        } else {
            XB_SPIN(xb_ld(&bar[XB_XGEN(b.x)]) == gen, bar);
            __builtin_amdgcn_fence(__ATOMIC_ACQUIRE, "agent");
            asm volatile("s_waitcnt vmcnt(0)" ::: "memory");
        }
    }
    __syncthreads();
}


struct Args { const float* in[14]; float* out; unsigned char* ws; };

__global__ void __launch_bounds__(512) mk_fwd(Args args) {
    extern __shared__ __attribute__((aligned(16))) unsigned char lds[];
    cg::grid_group grid = cg::this_grid();
    const int tid0 = threadIdx.x, wave = __builtin_amdgcn_readfirstlane(tid0 >> 6);
#define FRESH_LANE() int tid = tid0; asm volatile("" : "+v"(tid)); const int lane = tid & 63
    const int G = gridDim.x, bx = blockIdx.x;
    const int vcu = (G % 8 == 0) ? (bx % 8) * (G / 8) + bx / 8 : bx;
    const int gw = vcu * 8 + wave, NGW = G * 8;
    LAS unsigned char* ldsl = (LAS unsigned char*)lds;
    if (tid0 < 8) ((LAS unsigned*)(ldsl + MISC_OFF))[tid0] = 0u;
    __syncthreads();
    const XcdBarrier xbar = xcd_barrier_post((unsigned*)(args.ws + WS_BAR), (volatile LAS unsigned*)(ldsl + MISC_OFF));
#define ws (args.ws)
#define x_in (args.in[0])
#define norm_mix (args.in[1])
#define w_in (args.in[2])
#define b_gate (args.in[3])
#define diff_lambda (args.in[4])
#define diff_subln (args.in[5])
#define na_rpb (args.in[6])
#define qk_norm (args.in[7])
#define w_branch (args.in[8])
#define w_out (args.in[9])
#define norm_ffn (args.in[10])
#define w_ff1 (args.in[11])
#define w_ff2 (args.in[12])
#define norm_final (args.in[13])
#define xout (args.out)
#define WinT ((bf16_t*)(ws + WS_WIN))
#define WbrT ((bf16_t*)(ws + WS_WBR))
#define WoutT ((bf16_t*)(ws + WS_WOUT))
#define W1T ((bf16_t*)(ws + WS_W1))
#define W2T ((bf16_t*)(ws + WS_W2))
#define STAT ((float*)(ws + WS_STAT))
#define H ((bf16_t*)(ws + WS_H))
#define ATMP ((bf16_t*)(ws + WS_ATMP))
#define BTMP ((bf16_t*)(ws + WS_BTMP))
#define Y ((bf16_t*)(ws + WS_Y))
#define MERGED ((bf16_t*)(ws + WS_MERGED))
#define Z ((bf16_t*)(ws + WS_Z))
#define U ((bf16_t*)(ws + WS_Z))
#define PROJ ((bf16_t*)(ws + WS_PROJ))
#define XB ((bf16_t*)(ws + WS_XB))
#define SSQM ((float*)(ws + WS_SSQM))
#define SSQF ((float*)(ws + WS_SSQF))
#define NRMQ ((unsigned*)(ws + WS_NRM))
#define NRMK ((unsigned*)(ws + WS_NRM) + 1024)

    {
        FRESH_LANE();
        LAS float* scr = (LAS float*)(ldsl + wave * 16384);
        constexpr int I_IN = (DM / 64) * (INW / 32), I_BR = (512 / 64) * (DM / 32), I_OUT = (DM / 64) * (DM / 32), I_1 = (DM / 64) * (DFF / 32), I_2 = (DFF / 64) * (DM / 32);
        constexpr int NITEMS = 2 * I_IN + 8 * I_BR + 2 * I_OUT + 2 * I_1 + 2 * I_2;
        for (int it = gw; it < NITEMS; it += NGW) {
            int r = it;
            if (r < 2 * I_IN) { const int l = r / I_IN; transpose_item(w_in + (size_t)l * DM * INW, DM, INW, WinT + (size_t)l * INW * DM, scr, r % I_IN, lane, norm_mix + l * DM); continue; } r -= 2 * I_IN;
            if (r < 8 * I_BR) { const int ln = r / I_BR; transpose_item(w_branch + (size_t)ln * 512 * DM, 512, DM, WbrT + (size_t)ln * DM * 512, scr, r % I_BR, lane); continue; } r -= 8 * I_BR;
            if (r < 2 * I_OUT) { const int l = r / I_OUT; transpose_item(w_out + (size_t)l * DM * DM, DM, DM, WoutT + (size_t)l * DM * DM, scr, r % I_OUT, lane); continue; } r -= 2 * I_OUT;
            if (r < 2 * I_1) { const int l = r / I_1; transpose_item(w_ff1 + (size_t)l * DM * DFF, DM, DFF, W1T + (size_t)l * DFF * DM, scr, r % I_1, lane, norm_ffn + l * DM); continue; } r -= 2 * I_1;
            { const int l = r / I_2; transpose_item(w_ff2 + (size_t)l * DFF * DM, DFF, DM, W2T + (size_t)l * DM * DFF, scr, r % I_2, lane); }
        }
        {
            f32x4 v[4], vn[4] = {};
            if (gw < NTOK) { const f32x4* xr = (const f32x4*)(x_in + (size_t)gw * DM) + lane;
#pragma unroll
                for (int j = 0; j < 4; ++j) v[j] = xr[64 * j]; }
            for (int m = gw; m < NTOK; m += NGW) {
                if (m + NGW < NTOK) { const f32x4* xr = (const f32x4*)(x_in + (size_t)(m + NGW) * DM) + lane;
#pragma unroll
                    for (int j = 0; j < 4; ++j) vn[j] = xr[64 * j]; }
                u32x2* o8 = (u32x2*)(XB + (size_t)m * DM) + lane; float sq = 0.f;
#pragma unroll
                for (int j = 0; j < 4; ++j) { sq += (v[j].x * v[j].x + v[j].y * v[j].y) + (v[j].z * v[j].z + v[j].w * v[j].w); u32x2 w; w.x = pk2(v[j].x, v[j].y); w.y = pk2(v[j].z, v[j].w); o8[64 * j] = w; }
                sq = wave_sum(sq);
                if (lane == 0) *(f32x4*)(SSQM + (size_t)m * 4) = (f32x4){sq, 0.f, 0.f, 0.f};
#pragma unroll
                for (int j = 0; j < 4; ++j) v[j] = vn[j];
            }
        }
    }
    grid.sync();

    for (int l = 0; l < DEPTH; ++l) {
        { FRESH_LANE(); LAS float* tab = (LAS float*)(ldsl + TAB_OFF); for (int i = tid; i < 8 * 465; i += 512) tab[i] = na_rpb[l * 8 * 465 + i] * LOG2E; }
        __syncthreads();
        for (int grp = 0; grp < NGRP; ++grp) {
            const size_t tok0 = (size_t)grp * TG;
            const float* xsrc = (l == 0) ? x_in : xout;
            {
                pg8::Gemm g{XB + tok0 * DM, WinT + (size_t)l * INW * DM, DM, DM, DM, 1 << 30, 0}; pg8::StaticOrder S; S.init(TG, INW, G, bx);
                if (bx == 0) { FRESH_LANE(); NRMQ[tid] = 0u; NRMQ[tid + 512] = 0u; if (tid < 16) NRMQ[1024 + tid] = 0u; (void)lane; }
                pg8::Epi<0> E{PROJ, nullptr, nullptr, b_gate + l * 4096, INW, SSQM + tok0 * 4, nullptr, nullptr, nullptr};
                pg8::gemm_phase(ldsl, g, S, E);
            }
            xcd_barrier(xbar);
            {
                FRESH_LANE();
                const float inv = exp2f(-(float)(lane & 15) * 0.8304820237218406f);
                const float gk = qk_norm[l * 128 + 64 + lane];
                const int per = (TG + NGW - 1) / NGW;
                float mq = 0.f, mk = 0.f; int cu = -1;
                u32x4 qv, kv, qvn = {}, kvn = {}; unsigned short rw[2], rwn[2] = {};
#define P3_LOAD(QV, KV, RW, mm) do { const bf16_t* ar_ = PROJ + (size_t)(mm) * INW; QV = *(const u32x4*)(ar_ + COL_AQ + lane * 8); KV = *(const u32x4*)(ar_ + COL_AK + lane * 8); \
                    _Pragma("unroll") for (int hd = 0; hd < 2; ++hd) RW[hd] = ar_[COL_DK + hd * 64 + lane]; } while (0)
                if (gw * per < TG) P3_LOAD(qv, kv, rw, gw * per);
                for (int i = 0; i < per; ++i) {
                    const int m = gw * per + i; if (m >= TG) break;
                    if (i + 1 < per && m + 1 < TG) P3_LOAD(qvn, kvn, rwn, m + 1);
                    if ((m >> 8) != cu) { if (cu >= 0 && (lane & 7) == 0) { atomicMax(NRMQ + cu * 8 + (lane >> 3), __float_as_uint(mq)); atomicMax(NRMK + (cu >> 5) * 8 + (lane >> 3), __float_as_uint(mk)); } cu = m >> 8; mq = 0.f; mk = 0.f; }
                    const int s = (int)((tok0 + m) % SEQ); const float pos = (float)((lane < 32) ? (s >> 6) : (s & 63));
                    float sn, cs; sincos_red(pos * inv, sn, cs);
                    { float nq = 0.f, nk = 0.f;
#pragma unroll
                      for (int e = 0; e < 4; ++e) { nq += bflo(qv[e]) * bflo(qv[e]) + bfhi(qv[e]) * bfhi(qv[e]); nk += bflo(kv[e]) * bflo(kv[e]) + bfhi(kv[e]) * bfhi(kv[e]); }
                      nq += __shfl_xor(nq, 1); nk += __shfl_xor(nk, 1); nq += __shfl_xor(nq, 2); nk += __shfl_xor(nk, 2); nq += __shfl_xor(nq, 4); nk += __shfl_xor(nk, 4);
                      mq = fmaxf(mq, sqrtf(nq)); mk = fmaxf(mk, sqrtf(nk)); }
                    bf16_t* row = PROJ + (size_t)m * INW + COL_DK;
#pragma unroll
                    for (int hd = 0; hd < 2; ++hd) {
                        const float v = __uint_as_float((unsigned)rw[hd] << 16);
                        const float rn = rsqrtf(wave_sum(v * v) * (1.f / 64.f) + EPS);
                        const float y = v * rn * gk;
                        const float p = __shfl_xor(y, 16);
                        const float o = ((lane >> 4) & 1) ? (y * cs + p * sn) : (y * cs - p * sn);
                        row[hd * 64 + lane] = (bf16_t)f2bf(o);
                    }
                    qv = qvn; kv = kvn;
#pragma unroll
                    for (int hd = 0; hd < 2; ++hd) rw[hd] = rwn[hd];
                }
#undef P3_LOAD
                const int m_first = vcu * 8 * per, m_last = (vcu * 8 + 7) * per + per - 1;
                if (m_last < TG && (m_first >> 8) == (m_last >> 8)) {
                    LAS float* red = (LAS float*)(ldsl + SSQ_OFF);
                    if ((lane & 7) == 0) { red[(wave * 8 + (lane >> 3)) * 2] = mq; red[(wave * 8 + (lane >> 3)) * 2 + 1] = mk; }
                    __syncthreads();
                    if (tid < 16) { const int hc = tid & 7, which = tid >> 3; float mx = 0.f;
#pragma unroll
                        for (int w = 0; w < 8; ++w) mx = fmaxf(mx, red[(w * 8 + hc) * 2 + which]);
                        const int cw = m_first >> 8;
                        if (which == 0) atomicMax(NRMQ + cw * 8 + hc, __float_as_uint(mx)); else atomicMax(NRMK + (cw >> 5) * 8 + hc, __float_as_uint(mx)); }
                } else if (cu >= 0 && (lane & 7) == 0) { atomicMax(NRMQ + cu * 8 + (lane >> 3), __float_as_uint(mq)); atomicMax(NRMK + (cu >> 5) * 8 + (lane >> 3), __float_as_uint(mk)); }
            }
            xcd_barrier(xbar);
            {
                using namespace attn_body;
                char* shm = (char*)lds;
                {
                    unsigned* qctr = (unsigned*)(ws + WS_BAR) + 3584 + (l * NGRP + grp) * 8;
                    volatile LAS unsigned* slot = (volatile LAS unsigned*)(ldsl + MISC_OFF + 32);
                    const int myx = (G % 8 == 0) ? (vcu / (G / 8)) : 0;
                    int qq = 0;
                    for (;;) {
                        if (tid0 == 0) { int fj = -1, fx = 0;
                            for (; qq < 8; ++qq) { const int x_ = (myx + qq) & 7; const int j_ = (int)atomicAdd(qctr + x_, 1u); if (j_ < 288) { fj = j_; fx = x_; break; } }
                            slot[0] = (unsigned)fj; slot[1] = (unsigned)fx; }
                        __syncthreads();
                        const int j = (int)slot[0], sx = (int)slot[1];
                        __syncthreads();
                        if (j < 0) break;
                        if (j < 128) {
                            AttnArgs a{}; a.qs = INW; a.ks = INW; a.NT = 128; a.tlo = 0; a.thi = 127;
                            if (j >= 32 && j < 96) { const int qb = j & 31, ds = 2 * sx + ((j - 32) >> 5), bb = ds >> 3, h = ds & 7; const size_t tb = (size_t)bb * SEQ;
                                a.Q = (const bf16*)(PROJ + (tb + qb * 256) * INW + COL_DQ + h * 64); a.K = (const bf16*)(PROJ + tb * INW + COL_DK + (h >> 2) * 64);
                                a.V = (const bf16*)(PROJ + tb * INW + COL_DV + (h >> 2) * 64); a.O = (bf16*)(Y + (tb + qb * 256) * 2048 + 1536 + h * 64); a.os = 2048;
                                a.q0 = qb * 256; a.gq = qk_norm + l * 128;
                                attn_unit<MD, 16>(a, shm);
                            } else {
                                int bb, hh, comp, qb;
                                if (j < 32) { bb = sx >> 2; hh = 2 + ((sx >> 1) & 1); comp = sx & 1; qb = j; }
                                else { const int s1 = sx >> 1; bb = s1 >> 1; comp = s1 & 1; hh = (j < 112) ? 1 : 0; qb = (sx & 1) * 16 + ((j - 96) & 15); }
                                const size_t tb = (size_t)bb * SEQ;
                                a.Q = (const bf16*)(PROJ + (tb + qb * 256) * INW + COL_AQ + hh * 128 + comp * 64); a.K = (const bf16*)(PROJ + tb * INW + COL_AK + hh * 128 + comp * 64);
                                a.V = (const bf16*)(PROJ + tb * INW + COL_AV + hh * 128); a.O = (bf16*)(ATMP + (tb + qb * 256) * 1024 + (hh * 2 + comp) * 128); a.os = 1024;
                                a.s2 = exp2f(-2.f * (float)(hh + 1)) * LOG2E;
                                const float Bs = __uint_as_float(NRMQ[(bb * 32 + qb) * 8 + hh * 2 + comp]) * __uint_as_float(NRMK[bb * 8 + hh * 2 + comp]) * 1.02f + 0.25f;
                                const float dlim = fminf((150.f + 2.f * Bs) / a.s2, 1.0e6f), q0f = (float)(qb * 256);
                                int tlo = max(0, (int)floorf((q0f - 63.f - dlim) * (1.f / 64.f))), thi = min(127, (int)ceilf((q0f + 255.f + dlim) * (1.f / 64.f)));
                                if (((thi - tlo + 1) & 1) != 0) { if (tlo > 0) --tlo; else ++thi; }
                                tlo = __builtin_amdgcn_readfirstlane(tlo); thi = __builtin_amdgcn_readfirstlane(thi);
                                a.K += (size_t)tlo * 64 * INW; a.V += (size_t)tlo * 64 * INW; a.q0 = qb * 256 - 64 * tlo; a.NT = thi - tlo + 1;
                                attn_unit128<16>(a, shm);
                            }
                        } else if (j < 192) {
                            const int cs = 2 * sx + ((j - 128) >> 5), qb = (j - 128) & 31, bb = cs >> 3, h = cs & 7, r0 = 4 * qb, kb = min(max(r0 - 4, 0), 116); const size_t tb = (size_t)bb * SEQ;
                            AttnArgs a{}; a.qs = INW; a.ks = INW; a.os = 2048; a.NT = 12; a.tlo = 0; a.thi = 11; a.q0 = r0; a.kb = kb;
                            a.Q = (const bf16*)(PROJ + (tb + r0 * 64) * INW + COL_CQ + h * 64); a.K = (const bf16*)(PROJ + (tb + kb * 64) * INW + COL_CK + h * 64);
                            a.V = (const bf16*)(PROJ + (tb + kb * 64) * INW + COL_CV + h * 64); a.O = (bf16*)(Y + (tb + r0 * 64) * 2048 + 1024 + h * 64);
                            a.tab = (lds_fptr)((lds_cptr)shm + TAB_OFF) + h * 465;
                            attn_unit<MC, 8>(a, shm);
                        } else {
                            const int p = j - 192, sg = 6 * sx + (p >> 4);
                            for (int e = 0; e < 2; ++e) {
                                const int blk = 2 * (p & 15) + e, bb = sg / 24, k = sg % 24, gp = k >> 3, h = k & 7, dsh = 2 * gp, dil = 1 << dsh;
                                const int nblk = 32 >> dsh, res = blk / nblk, i0 = (blk % nblk) * 256, L = SEQ >> dsh;
                                const long tq = (long)bb * SEQ + res + (long)i0 * dil, tk = (long)bb * SEQ + res + (long)(i0 - 64) * dil;
                                AttnArgs a{}; a.qs = dil * INW; a.ks = dil * INW; a.os = dil * 1536; a.NT = 6; a.tlo = (i0 == 0) ? 1 : 0; a.thi = (i0 + 256 == L) ? 4 : 5;
                                const int cq = COL_B + gp * 1536 + h * 64;
                                a.Q = (const bf16*)(PROJ + tq * INW + cq); a.K = (const bf16*)(PROJ + tk * INW + cq + 512); a.V = (const bf16*)(PROJ + tk * INW + cq + 1024);
                                a.O = (bf16*)(BTMP + tq * 1536 + gp * 512 + h * 64);
                                a.s2 = exp2f(-(float)(h + 1)) * (float)dil * LOG2E; a.stat = STAT + (tq * 24 + gp * 8 + h) * 2; a.ss = dil * 48;
                                attn_unit<MB, 8>(a, shm);
                            }
                        }
                    }
                }
            }
            xcd_barrier(xbar);
            {
                FRESH_LANE();
                int l_ = l; asm volatile("" : "+s"(l_));
                const float lam_init = (l_ == 0) ? 0.2f : (0.8f - 0.6f * 0.7408182206817179f);
                float lam;
                { const float* lp = diff_lambda + l * 256; const float a = lp[lane] * lp[64 + lane], b = lp[128 + lane] * lp[192 + lane]; lam = expf(wave_sum(a)) - expf(wave_sum(b)) + lam_init; lam = __uint_as_float(__builtin_amdgcn_readfirstlane(__float_as_uint(lam))); }
                const float out_scale = 1.f - lam_init;
                const float g0 = diff_subln[l * 128 + 2 * lane], g1 = diff_subln[l * 128 + 2 * lane + 1];
                const int h = lane >> 3, d8 = (lane & 7) * 8;
                unsigned aw[8]; u32x4 bw[3]; float sv[6];
#define P5_LOAD(AW, BW, SV, mm) do { const unsigned* at_ = (const unsigned*)(ATMP + (size_t)(mm) * 1024); _Pragma("unroll") for (int q = 0; q < 8; ++q) AW[q] = at_[q * 64 + lane]; \
                    const bf16_t* bt_ = BTMP + (size_t)(mm) * 1536 + h * 64 + d8; _Pragma("unroll") for (int g = 0; g < 3; ++g) BW[g] = *(const u32x4*)(bt_ + g * 512); \
                    const float* st_ = STAT + (size_t)(mm) * 48 + h * 2; _Pragma("unroll") for (int g = 0; g < 3; ++g) { SV[2 * g] = st_[16 * g]; SV[2 * g + 1] = st_[16 * g + 1]; } } while (0)
                for (int m = gw; m < TG; m += NGW) {
                    P5_LOAD(aw, bw, sv, m);
                    unsigned* yr = (unsigned*)(Y + (size_t)m * 2048);
#pragma unroll
                    for (int hh = 0; hh < 4; ++hh) {
                        const unsigned w0 = aw[hh * 2], w1 = aw[hh * 2 + 1];
                        const float d0 = bflo(w0) - lam * bflo(w1), d1 = bfhi(w0) - lam * bfhi(w1);
                        const float rn = rsqrtf(wave_sum(d0 * d0 + d1 * d1) * (1.f / 128.f) + EPS) * out_scale;
                        yr[hh * 64 + lane] = pk2(d0 * rn * g0, d1 * rn * g1);
                    }
                    const float m0 = sv[0], l0 = sv[1], m1 = sv[2], l1 = sv[3], m2 = sv[4], l2 = sv[5];
                    const float ms = fmaxf(m0, fmaxf(m1, m2));
                    const float w0 = l0 * exp2f(m0 - ms), w1 = l1 * exp2f(m1 - ms), w2 = l2 * exp2f(m2 - ms); const float inv = 1.f / (w0 + w1 + w2);
                    const u32x4 a0 = bw[0], a1 = bw[1], a2 = bw[2];
                    u32x4 o;
#pragma unroll
                    for (int e = 0; e < 4; ++e) { const float lo = (w0 * bflo(a0[e]) + w1 * bflo(a1[e]) + w2 * bflo(a2[e])) * inv, hi = (w0 * bfhi(a0[e]) + w1 * bfhi(a1[e]) + w2 * bfhi(a2[e])) * inv; o[e] = pk2(lo, hi); }
                    *(u32x4*)(Y + (size_t)m * 2048 + 512 + h * 64 + d8) = o;
                }
#undef P5_LOAD
            }
            xcd_barrier(xbar);
            {
                pg8::Gemm g{Y, WbrT + (size_t)l * 4096 * 512, 2048, 512, 512, 4, 512}; pg8::StaticOrder S; S.init(TG, 4096, G, bx);
                pg8::Epi<1> E{Z, nullptr, nullptr, nullptr, 4096, nullptr, nullptr, nullptr, nullptr};
                pg8::gemm_phase(ldsl, g, S, E);
            }
            xcd_barrier(xbar);
            { FRESH_LANE();
            u32x4 gv[2][4], zv[2][4];
#define P7_LOAD(GV, ZV, mm) do { const bf16_t* gr_ = PROJ + (size_t)(mm) * INW + COL_GATE + lane * 8; const bf16_t* zr_ = Z + (size_t)(mm) * 4096 + lane * 8; \
                _Pragma("unroll") for (int jj = 0; jj < 2; ++jj) _Pragma("unroll") for (int n = 0; n < 4; ++n) { GV[jj][n] = *(const u32x4*)(gr_ + n * 1024 + jj * 512); ZV[jj][n] = *(const u32x4*)(zr_ + n * 1024 + jj * 512); } } while (0)
            for (int m = gw; m < TG; m += NGW) {
                P7_LOAD(gv, zv, m);
#pragma unroll
                for (int j = 0; j < 2; ++j) { const int c = lane * 8 + j * 512; float acc[8] = {0.f, 0.f, 0.f, 0.f, 0.f, 0.f, 0.f, 0.f};
#pragma unroll
                    for (int n = 0; n < 4; ++n) {
#pragma unroll
                        for (int e = 0; e < 4; ++e) { acc[2 * e] += bflo(gv[j][n][e]) * bflo(zv[j][n][e]); acc[2 * e + 1] += bfhi(gv[j][n][e]) * bfhi(zv[j][n][e]); } }
                    u32x4 o; o.x = pk2(acc[0], acc[1]); o.y = pk2(acc[2], acc[3]); o.z = pk2(acc[4], acc[5]); o.w = pk2(acc[6], acc[7]);
                    *(u32x4*)(MERGED + (size_t)m * DM + c) = o; }
#undef P7_LOAD
            } }
            xcd_barrier(xbar);
            {
                pg8::Gemm g{MERGED, WoutT + (size_t)l * DM * DM, DM, DM, DM, 1 << 30, 0}; pg8::StaticOrder S; S.init(TG, DM, G, bx);
                pg8::Epi<3> E{nullptr, xout + tok0 * DM, xsrc + tok0 * DM, nullptr, DM, nullptr, H, SSQF, (LAS float*)(ldsl + SSQ_OFF)};
                pg8::gemm_phase(ldsl, g, S, E);
            }
            xcd_barrier(xbar);
            {
                pg8::Gemm g{H, W1T + (size_t)l * DFF * DM, DM, DM, DM, 1 << 30, 0}; pg8::StaticOrder S; S.init(TG, DFF, G, bx);
                pg8::Epi<2> E{U, nullptr, nullptr, nullptr, DFF, SSQF, nullptr, nullptr, nullptr};
                pg8::gemm_phase(ldsl, g, S, E);
            }
            xcd_barrier(xbar);
            {
                pg8::Gemm g{U, W2T + (size_t)l * DM * DFF, DFF, DFF, DFF, 1 << 30, 0}; pg8::StaticOrder S; S.init(TG, DM, G, bx);
                pg8::Epi<3> E{nullptr, xout + tok0 * DM, xout + tok0 * DM, nullptr, DM, nullptr, XB + tok0 * DM, SSQM + tok0 * 4, (LAS float*)(ldsl + SSQ_OFF)};
                pg8::gemm_phase(ldsl, g, S, E);
            }
            if (l == DEPTH - 1 && grp == NGRP - 1) xcd_barrier(xbar);
        }
    }
    {
        FRESH_LANE();
        const f32x4* g4 = (const f32x4*)norm_final + lane; f32x4 gg[4];
#pragma unroll
        for (int j = 0; j < 4; ++j) gg[j] = g4[64 * j];
        f32x4 v[4], vn[4] = {};
        if (gw < NTOK) { const f32x4* o = (const f32x4*)(xout + (size_t)gw * DM) + lane;
#pragma unroll
            for (int j = 0; j < 4; ++j) v[j] = o[64 * j]; }
        for (int m = gw; m < NTOK; m += NGW) {
            if (m + NGW < NTOK) { const f32x4* on = (const f32x4*)(xout + (size_t)(m + NGW) * DM) + lane;
#pragma unroll
                for (int j = 0; j < 4; ++j) vn[j] = on[64 * j]; }
            f32x4* o = (f32x4*)(xout + (size_t)m * DM) + lane; float sq = 0.f;
#pragma unroll
            for (int j = 0; j < 4; ++j) sq += (v[j].x * v[j].x + v[j].y * v[j].y) + (v[j].z * v[j].z + v[j].w * v[j].w);
            const float r = rsqrtf(wave_sum(sq) * (1.f / DM) + EPS);
#pragma unroll
            for (int j = 0; j < 4; ++j) o[64 * j] = (f32x4){v[j].x * r * gg[j].x, v[j].y * r * gg[j].y, v[j].z * r * gg[j].z, v[j].w * r * gg[j].w};
#pragma unroll
            for (int j = 0; j < 4; ++j) v[j] = vn[j];
        }
    }
}

#undef ws
#undef x_in
#undef norm_mix
#undef w_in
#undef b_gate
#undef diff_lambda
#undef diff_subln
#undef na_rpb
#undef qk_norm
#undef w_branch
#undef w_out
#undef norm_ffn
#undef w_ff1
#undef w_ff2
#undef norm_final
#undef xout
#undef WinT
#undef WbrT
#undef WoutT
#undef W1T
#undef W2T
#undef STAT
#undef H
#undef ATMP
#undef BTMP
#undef Y
#undef MERGED
#undef Z
#undef U
#undef PROJ
#undef NRMQ
#undef XB
#undef SSQM
#undef SSQF
#undef NRMK

extern "C" void kernel_launch(void* const* d_in, const int* in_sizes, int n_in, void* d_out, int out_size, void* d_ws, size_t ws_size, hipStream_t stream) {
    static int grid_blocks = 0;
    if (!grid_blocks) {
        int dev = 0, cus = 0, per_cu = 0;
        (void)hipGetDevice(&dev);
        (void)hipDeviceGetAttribute(&cus, hipDeviceAttributeMultiprocessorCount, dev);
        (void)hipFuncSetAttribute((const void*)mk_fwd, hipFuncAttributeMaxDynamicSharedMemorySize, LDS_BYTES);
        (void)hipOccupancyMaxActiveBlocksPerMultiprocessor(&per_cu, (const void*)mk_fwd, 512, LDS_BYTES);
        if (per_cu < 1) per_cu = 1;
        grid_blocks = cus * per_cu;
        if (ws_size < WS_END || n_in != 14) { fprintf(stderr, "kernel_launch: workspace %zu < %zu or n_in %d != 14\n", ws_size, (size_t)WS_END, n_in); grid_blocks = -1; }
    }
    if (grid_blocks < 0) return;
    (void)hipMemsetAsync((char*)d_ws + WS_BAR, 0, 16384, stream);
    Args a{};
    for (int i = 0; i < 14; ++i) a.in[i] = (const float*)d_in[i];
    a.out = (float*)d_out; a.ws = (unsigned char*)d_ws;
    void* kargs[] = {&a};
    hipError_t e = hipLaunchCooperativeKernel((const void*)mk_fwd, dim3(grid_blocks), dim3(512), kargs, LDS_BYTES, stream);
    if (e != hipSuccess) fprintf(stderr, "cooperative launch failed: %s (grid %d)\n", hipGetErrorString(e), grid_blocks);
}
```
